# Optimizing an MI355X kernel written in HIP

```python
import math
import jax
import jax.numpy as jnp
from jax import lax
import numpy as np

D_MODEL = 1024
BATCH = 2
SEQ = 16384
DEPTH = 4

N_MIXERS = 3
NORM_EPS = 1e-6

GM_CHUNK = 128
GM_WIDTH = D_MODEL
GM_GROUPS = 8
GM_GROUP_DIM = GM_WIDTH // GM_GROUPS

DN_QK_HEADS = 4
DN_V_HEADS = 8
DN_HEAD_DIM = D_MODEL // DN_V_HEADS
DN_CONV = 4
DN_CHUNK = 64
DN_KEY_WIDTH = DN_QK_HEADS * DN_HEAD_DIM
DN_VAL_WIDTH = DN_V_HEADS * DN_HEAD_DIM
DN_CONV_WIDTH = 2 * DN_KEY_WIDTH + DN_VAL_WIDTH
DN_PROJ_WIDTH = DN_CONV_WIDTH + DN_VAL_WIDTH + 2 * DN_V_HEADS

SWA_HEAD_DIM = 64
SWA_Q_HEADS = D_MODEL // SWA_HEAD_DIM
SWA_KV_HEADS = 4
SWA_GROUP = SWA_Q_HEADS // SWA_KV_HEADS
SWA_WINDOW = 128
SWA_BLOCK = 128
SWA_PROJ_WIDTH = (SWA_Q_HEADS + 2 * SWA_KV_HEADS) * SWA_HEAD_DIM

MOE_GROUPS = 4
MOE_EXPERTS_PER_GROUP = 8
MOE_EXPERTS = MOE_GROUPS * MOE_EXPERTS_PER_GROUP
MOE_TOP_K = 2
MOE_FF = D_MODEL // 2
MOE_BLOCK = 128

kernel_name = 'hybrid_gmlp_deltanet_swa_hmoe'


def rms_norm(x, gain):
    xf = x.astype(jnp.float32)
    y = xf * lax.rsqrt(jnp.mean(xf * xf, axis=-1, keepdims=True) + NORM_EPS)
    return (y * gain.astype(jnp.float32)).astype(x.dtype)


def l2_norm(x):
    xf = x.astype(jnp.float32)
    return xf * lax.rsqrt(jnp.sum(xf * xf, axis=-1, keepdims=True) + NORM_EPS)


def causal_depthwise_conv(x, w):
    s = x.shape[1]
    taps = w.shape[0]
    xp = jnp.pad(x, ((0, 0), (taps - 1, 0), (0, 0)))
    return sum(xp[:, j:j + s] * w[j] for j in range(taps))


def gmlp_mixer(h, w_in, v_norm, w_s, b_s, w_out):
    b, s, _ = h.shape
    z = jax.nn.gelu(h @ w_in)
    u, v = jnp.split(z, 2, axis=-1)
    v = rms_norm(v, v_norm)
    v = v.reshape(b, s // GM_CHUNK, GM_CHUNK, GM_GROUPS, GM_GROUP_DIM)
    causal = jnp.tril(jnp.ones((GM_CHUNK, GM_CHUNK), dtype=bool))
    w_causal = jnp.where(causal, w_s, 0).astype(v.dtype)
    sv = jnp.einsum('gts,bcsgd->bctgd', w_causal, v) + b_s.T[:, :, None]
    return (u * sv.reshape(b, s, GM_WIDTH)) @ w_out


def _to_chunks(t):
    b, s, h, d = t.shape
    return t.reshape(b, s // DN_CHUNK, DN_CHUNK, h, d).transpose(0, 3, 1, 2, 4)


def chunk_gated_delta_rule(q, k, v, g, beta):
    b, s, h, dk = q.shape
    dv = v.shape[-1]
    n = s // DN_CHUNK
    q = _to_chunks(q) * dk ** -0.5
    k = _to_chunks(k)
    v = _to_chunks(v)
    beta = beta.reshape(b, n, DN_CHUNK, h).transpose(0, 3, 1, 2)
    gc = jnp.cumsum(g.reshape(b, n, DN_CHUNK, h).transpose(0, 3, 1, 2), axis=-1)
    lower = jnp.tril(jnp.ones((DN_CHUNK, DN_CHUNK), dtype=bool))
    strict = jnp.tril(jnp.ones((DN_CHUNK, DN_CHUNK), dtype=bool), k=-1)
    diff = gc[..., :, None] - gc[..., None, :]
    decay = jnp.where(lower, jnp.exp(jnp.where(lower, diff, 0.0)), 0.0)
    k_beta = k * beta[..., None]
    v_beta = v * beta[..., None]
    kk = jnp.einsum('bhncd,bhnsd->bhncs', k_beta, k) * decay
    tri = jnp.where(strict, kk, 0.0) + jnp.eye(DN_CHUNK, dtype=jnp.float32)
    u = lax.linalg.triangular_solve(tri, v_beta, left_side=True, lower=True, unit_diagonal=True)
    w = lax.linalg.triangular_solve(tri, k_beta * jnp.exp(gc)[..., None],
                                    left_side=True, lower=True, unit_diagonal=True)
    qk = jnp.einsum('bhncd,bhnsd->bhncs', q, k) * decay
    q_dec = q * jnp.exp(gc)[..., None]
    k_dec = k * jnp.exp(gc[..., -1:] - gc)[..., None]
    g_last = jnp.exp(gc[..., -1])

    def step(state, inp):
        u_n, w_n, qk_n, qd_n, kd_n, gl_n = inp
        v_new = u_n - jnp.einsum('bhcd,bhde->bhce', w_n, state)
        o_n = jnp.einsum('bhcd,bhde->bhce', qd_n, state) + jnp.einsum('bhcs,bhse->bhce', qk_n, v_new)
        state = state * gl_n[..., None, None] + jnp.einsum('bhcd,bhce->bhde', kd_n, v_new)
        return state, o_n

    xs = tuple(jnp.moveaxis(t, 2, 0) for t in (u, w, qk, q_dec, k_dec, g_last))
    state0 = jnp.zeros((b, h, dk, dv), jnp.float32)
    _, o = lax.scan(step, state0, xs)
    return o.transpose(1, 0, 3, 2, 4).reshape(b, s, h, dv)


def deltanet_mixer(h, w_in, conv_w, a_log, dt_bias, o_norm, w_out):
    b, s, _ = h.shape
    proj = h @ w_in
    split_at = [DN_CONV_WIDTH, DN_CONV_WIDTH + DN_VAL_WIDTH, DN_CONV_WIDTH + DN_VAL_WIDTH + DN_V_HEADS]
    qkv, z, beta_in, alpha_in = jnp.split(proj, split_at, axis=-1)
    qkv = jax.nn.silu(causal_depthwise_conv(qkv, conv_w))
    q, k, v = jnp.split(qkv, [DN_KEY_WIDTH, 2 * DN_KEY_WIDTH], axis=-1)
    rep = DN_V_HEADS // DN_QK_HEADS
    q = jnp.repeat(l2_norm(q.reshape(b, s, DN_QK_HEADS, DN_HEAD_DIM)), rep, axis=2)
    k = jnp.repeat(l2_norm(k.reshape(b, s, DN_QK_HEADS, DN_HEAD_DIM)), rep, axis=2)
    v = v.reshape(b, s, DN_V_HEADS, DN_HEAD_DIM).astype(jnp.float32)
    beta = jax.nn.sigmoid(beta_in.astype(jnp.float32))
    g = -jnp.exp(a_log.astype(jnp.float32)) * jax.nn.softplus(
        alpha_in.astype(jnp.float32) + dt_bias.astype(jnp.float32))
    o = chunk_gated_delta_rule(q, k, v, g, beta)
    o = rms_norm(o, o_norm) * jax.nn.silu(z.reshape(b, s, DN_V_HEADS, DN_HEAD_DIM).astype(jnp.float32))
    return o.reshape(b, s, DN_VAL_WIDTH).astype(h.dtype) @ w_out


def swa_mixer(h, w_in, q_norm, k_norm, sinks, w_out):
    b, s, _ = h.shape
    nb = s // SWA_BLOCK
    hd = SWA_HEAD_DIM
    proj = h @ w_in
    q, k, v = jnp.split(proj, [SWA_Q_HEADS * hd, (SWA_Q_HEADS + SWA_KV_HEADS) * hd], axis=-1)
    q = rms_norm(q.reshape(b, s, SWA_Q_HEADS, hd), q_norm).astype(jnp.float32) * hd ** -0.5
    k = rms_norm(k.reshape(b, s, SWA_KV_HEADS, hd), k_norm).astype(jnp.float32)
    v = v.reshape(b, s, SWA_KV_HEADS, hd).astype(jnp.float32)
    q = q.reshape(b, nb, SWA_BLOCK, SWA_KV_HEADS, SWA_GROUP, hd)
    k = k.reshape(b, nb, SWA_BLOCK, SWA_KV_HEADS, hd)
    v = v.reshape(b, nb, SWA_BLOCK, SWA_KV_HEADS, hd)

    def with_prev(t):
        prev = jnp.concatenate([jnp.zeros_like(t[:, :1]), t[:, :-1]], axis=1)
        return jnp.concatenate([prev, t], axis=2)

    kk, vv = with_prev(k), with_prev(v)
    scores = jnp.einsum('bnqhgd,bnkhd->bnhgqk', q, kk)
    qi = jnp.arange(SWA_BLOCK)[:, None]
    kj = jnp.arange(2 * SWA_BLOCK)[None, :]
    offset = SWA_BLOCK + qi - kj
    band = (offset >= 0) & (offset < SWA_WINDOW)
    has_key = (jnp.arange(nb) > 0)[:, None, None] | (kj >= SWA_BLOCK)[None]
    mask = band[None] & has_key
    scores = jnp.where(mask[None, :, None, None], scores, -jnp.inf)
    sink = sinks.astype(jnp.float32).reshape(SWA_KV_HEADS, SWA_GROUP)[None, None, :, :, None, None]
    m = jnp.maximum(scores.max(axis=-1, keepdims=True), sink)
    p = jnp.exp(scores - m)
    denom = p.sum(axis=-1, keepdims=True) + jnp.exp(sink - m)
    out = jnp.einsum('bnhgqk,bnkhd->bnqhgd', p / denom, vv)
    return out.reshape(b, s, SWA_Q_HEADS * hd).astype(h.dtype) @ w_out


def hierarchical_moe(h, router_w, router_b, w_in, w_out):
    b, s, d = h.shape
    t = b * s
    xt = h.reshape(t, d)
    logits = (xt @ router_w + router_b).astype(jnp.float32)
    p_group = jax.nn.softmax(logits[:, :MOE_GROUPS], axis=-1)
    pg_top, g_sel = lax.top_k(p_group, 1)
    exp_logits = logits[:, MOE_GROUPS:].reshape(t, MOE_GROUPS, MOE_EXPERTS_PER_GROUP)
    sel_logits = jnp.take_along_axis(exp_logits, g_sel[:, :, None], axis=1)[:, 0]
    p_exp = jax.nn.softmax(sel_logits, axis=-1)
    pe_top, e_sel = lax.top_k(p_exp, MOE_TOP_K)
    gates = pg_top * pe_top / pe_top.sum(axis=-1, keepdims=True)
    expert_id = g_sel * MOE_EXPERTS_PER_GROUP + e_sel

    n_assign = t * MOE_TOP_K
    flat_e = expert_id.reshape(n_assign)
    flat_tok = jnp.repeat(jnp.arange(t, dtype=jnp.int32), MOE_TOP_K)
    flat_gate = gates.reshape(n_assign)
    order = jnp.argsort(flat_e)
    e_sorted = flat_e[order]
    tok_sorted = flat_tok[order]
    gate_sorted = flat_gate[order]
    counts = jnp.bincount(flat_e, length=MOE_EXPERTS)
    padded = (counts + MOE_BLOCK - 1) // MOE_BLOCK * MOE_BLOCK
    pad_end = jnp.cumsum(padded)
    pad_start = pad_end - padded
    seg_start = jnp.cumsum(counts) - counts
    dest = pad_start[e_sorted] + jnp.arange(n_assign) - seg_start[e_sorted]
    n_blocks = n_assign // MOE_BLOCK + MOE_EXPERTS
    slot_tok = jnp.full((n_blocks * MOE_BLOCK,), t, dtype=jnp.int32).at[dest].set(tok_sorted)
    x_pad = jnp.concatenate([xt, jnp.zeros((1, d), xt.dtype)], axis=0)
    x_blocks = x_pad[slot_tok].reshape(n_blocks, MOE_BLOCK, d)
    block_e = jnp.minimum(jnp.searchsorted(pad_end, jnp.arange(n_blocks) * MOE_BLOCK, side='right'),
                          MOE_EXPERTS - 1)

    def expert_block(args):
        xb, e = args
        a, gl = jnp.split(xb @ w_in[e], 2, axis=-1)
        return (jax.nn.silu(a) * gl) @ w_out[e]

    y_blocks = lax.map(expert_block, (x_blocks, block_e))
    y_slots = y_blocks.reshape(n_blocks * MOE_BLOCK, d)
    contrib = y_slots[dest] * gate_sorted[:, None].astype(h.dtype)
    out = jax.ops.segment_sum(contrib, tok_sorted, num_segments=t)
    return out.reshape(b, s, d)


def setup_inputs(seed: int = 0) -> dict:
    key = jax.random.key(seed)
    keys = iter(jax.random.split(key, 128))

    def normal(shape, scale):
        return jax.random.normal(next(keys), shape, jnp.float32) * scale

    def gain(n):
        return 1.0 + 0.05 * normal((n,), 1.0)

    p = {}
    p['x'] = normal((BATCH, SEQ, D_MODEL), 1.0)
    p['c'] = normal((BATCH, D_MODEL), 1.0)
    for i in range(DEPTH):
        pre = 'l%d_' % i
        p[pre + 'norm_mix'] = gain(D_MODEL)
        p[pre + 'norm_ffn'] = gain(D_MODEL)
        p[pre + 'ada_w'] = normal((D_MODEL, 6 * D_MODEL), 0.5 * D_MODEL ** -0.5)
        p[pre + 'ada_b'] = normal((6 * D_MODEL,), 0.02)
        kind = i % N_MIXERS
        if kind == 0:
            p[pre + 'gm_w_in'] = normal((D_MODEL, 2 * GM_WIDTH), D_MODEL ** -0.5)
            p[pre + 'gm_v_norm'] = gain(GM_WIDTH)
            p[pre + 'gm_w_s'] = normal((GM_GROUPS, GM_CHUNK, GM_CHUNK), GM_CHUNK ** -0.5)
            p[pre + 'gm_b_s'] = 1.0 + normal((GM_GROUPS, GM_CHUNK), 0.1)
            p[pre + 'gm_w_out'] = normal((GM_WIDTH, D_MODEL), GM_WIDTH ** -0.5)
        elif kind == 1:
            p[pre + 'dn_w_in'] = normal((D_MODEL, DN_PROJ_WIDTH), D_MODEL ** -0.5)
            p[pre + 'dn_conv_w'] = normal((DN_CONV, DN_CONV_WIDTH), DN_CONV ** -0.5)
            p[pre + 'dn_a_log'] = jnp.log(jax.random.uniform(next(keys), (DN_V_HEADS,), jnp.float32, 1.0, 16.0))
            dt = jnp.exp(jax.random.uniform(next(keys), (DN_V_HEADS,), jnp.float32,
                                            math.log(1e-3), math.log(1e-1)))
            p[pre + 'dn_dt_bias'] = dt + jnp.log(-jnp.expm1(-dt))
            p[pre + 'dn_o_norm'] = gain(DN_HEAD_DIM)
            p[pre + 'dn_w_out'] = normal((DN_VAL_WIDTH, D_MODEL), DN_VAL_WIDTH ** -0.5)
        else:
            p[pre + 'swa_w_in'] = normal((D_MODEL, SWA_PROJ_WIDTH), D_MODEL ** -0.5)
            p[pre + 'swa_q_norm'] = gain(SWA_HEAD_DIM)
            p[pre + 'swa_k_norm'] = gain(SWA_HEAD_DIM)
            p[pre + 'swa_sinks'] = normal((SWA_Q_HEADS,), 1.0)
            p[pre + 'swa_w_out'] = normal((SWA_Q_HEADS * SWA_HEAD_DIM, D_MODEL), (SWA_Q_HEADS * SWA_HEAD_DIM) ** -0.5)
        p[pre + 'router_w'] = normal((D_MODEL, MOE_GROUPS + MOE_EXPERTS), D_MODEL ** -0.5)
        p[pre + 'router_b'] = normal((MOE_GROUPS + MOE_EXPERTS,), 0.01)
        p[pre + 'expert_w_in'] = normal((MOE_EXPERTS, D_MODEL, 2 * MOE_FF), D_MODEL ** -0.5)
        p[pre + 'expert_w_out'] = normal((MOE_EXPERTS, MOE_FF, D_MODEL), MOE_FF ** -0.5)
    return p


def reference(x, c,
              l0_norm_mix, l0_norm_ffn, l0_ada_w, l0_ada_b,
              l0_gm_w_in, l0_gm_v_norm, l0_gm_w_s, l0_gm_b_s, l0_gm_w_out,
              l0_router_w, l0_router_b, l0_expert_w_in, l0_expert_w_out,
              l1_norm_mix, l1_norm_ffn, l1_ada_w, l1_ada_b,
              l1_dn_w_in, l1_dn_conv_w, l1_dn_a_log, l1_dn_dt_bias, l1_dn_o_norm, l1_dn_w_out,
              l1_router_w, l1_router_b, l1_expert_w_in, l1_expert_w_out,
              l2_norm_mix, l2_norm_ffn, l2_ada_w, l2_ada_b,
              l2_swa_w_in, l2_swa_q_norm, l2_swa_k_norm, l2_swa_sinks, l2_swa_w_out,
              l2_router_w, l2_router_b, l2_expert_w_in, l2_expert_w_out,
              l3_norm_mix, l3_norm_ffn, l3_ada_w, l3_ada_b,
              l3_gm_w_in, l3_gm_v_norm, l3_gm_w_s, l3_gm_b_s, l3_gm_w_out,
              l3_router_w, l3_router_b, l3_expert_w_in, l3_expert_w_out):
    layers = [
        ((l0_norm_mix, l0_norm_ffn, l0_ada_w, l0_ada_b),
         (l0_gm_w_in, l0_gm_v_norm, l0_gm_w_s, l0_gm_b_s, l0_gm_w_out),
         (l0_router_w, l0_router_b, l0_expert_w_in, l0_expert_w_out)),
        ((l1_norm_mix, l1_norm_ffn, l1_ada_w, l1_ada_b),
         (l1_dn_w_in, l1_dn_conv_w, l1_dn_a_log, l1_dn_dt_bias, l1_dn_o_norm, l1_dn_w_out),
         (l1_router_w, l1_router_b, l1_expert_w_in, l1_expert_w_out)),
        ((l2_norm_mix, l2_norm_ffn, l2_ada_w, l2_ada_b),
         (l2_swa_w_in, l2_swa_q_norm, l2_swa_k_norm, l2_swa_sinks, l2_swa_w_out),
         (l2_router_w, l2_router_b, l2_expert_w_in, l2_expert_w_out)),
        ((l3_norm_mix, l3_norm_ffn, l3_ada_w, l3_ada_b),
         (l3_gm_w_in, l3_gm_v_norm, l3_gm_w_s, l3_gm_b_s, l3_gm_w_out),
         (l3_router_w, l3_router_b, l3_expert_w_in, l3_expert_w_out)),
    ]
    mixers = (gmlp_mixer, deltanet_mixer, swa_mixer)
    c_act = jax.nn.silu(c)
    for i in range(DEPTH):
        (norm_mix, norm_ffn, ada_w, ada_b), mixer_params, moe_params = layers[i]
        mod = (c_act @ ada_w + ada_b)[:, None, :]
        shift_m, scale_m, gate_m, shift_f, scale_f, gate_f = jnp.split(mod, 6, axis=-1)
        h = rms_norm(x, norm_mix) * (1 + scale_m) + shift_m
        x = x + gate_m * mixers[i % N_MIXERS](h, *mixer_params)
        h = rms_norm(x, norm_ffn) * (1 + scale_f) + shift_f
        x = x + gate_f * hierarchical_moe(h, *moe_params)
    return x
```

```cpp
#include <hip/hip_runtime.h>
#include <cstdio>
#include <cstdint>
#ifndef MK_LAUNCH_MODE
#define MK_LAUNCH_MODE 0
#endif
namespace pg8 {
#define PG8_LAS __attribute__((address_space(3)))
typedef unsigned short bf16_t;
typedef short bf16x8 __attribute__((ext_vector_type(8)));
typedef float f32x4 __attribute__((ext_vector_type(4)));
typedef unsigned u32x4 __attribute__((ext_vector_type(4)));
constexpr int BM = 256, BK = 64, HALF = 128, HTB = HALF * BK * 2  , STAGE_BYTES = 8 * HTB, NXCD = 8, WGM = 8;

__host__ __device__ __forceinline__ int lds_byte(int r, int c) { const int st = (r >> 4) * 2 + (c >> 5), rr = r & 15, cc = c & 31, ob = rr * 64 + cc * 2; return st * 1024 + (ob ^ (((ob >> 9) & 1) << 5)); }
__host__ __device__ __forceinline__ void stage_rc(int b, int& R, int& C) { const int st = b / 1024, sb = b % 1024, swz = sb ^ (((sb >> 9) & 1) << 5); R = (st >> 1) * 16 + swz / 64; C = (st & 1) * 32 + (swz % 64) / 2; }
__host__ __device__ __forceinline__ int perm32(int rho) { const int n = rho >> 4, i = rho & 15; return 8 * (i >> 2) + 4 * n + (i & 3); }

struct Unit { int pm, pn; };
struct Gemm { const bf16_t* A; const bf16_t* Bt; int M, N, K; };

struct StaticOrder {
    int nM, nN, nwg, G, c;
    __host__ __device__ void init(int M, int N, int G_, int c_) { nM = M / BM; nN = N / BM; nwg = nM * nN; G = G_; c = c_; }
    __host__ __device__ bool next(int i, Unit& u) const {
        const long L = (long)i * G + c; if (L >= nwg) return false;
        int wgid = (int)L; { const int q = nwg / NXCD, r = nwg % NXCD, xcd = wgid % NXCD, off = wgid / NXCD; wgid = (xcd < r ? xcd * (q + 1) : r * (q + 1) + (xcd - r) * q) + off; }
        const int nig = WGM * nN, gid = wgid / nig, fm = gid * WGM, gsz = (nM - fm) < WGM ? (nM - fm) : WGM;
        u.pm = fm + ((wgid % nig) % gsz); u.pn = (wgid % nig) / gsz; return true;
    }
    __device__ __forceinline__ void a_ready(const Unit&) const {}
    __device__ __forceinline__ void done(const Unit&) const {}
};
__device__ __forceinline__ unsigned cvt_pk_bf16(float lo, float hi) { unsigned r; asm volatile("v_cvt_pk_bf16_f32 %0, %1, %2" : "=v"(r) : "v"(lo), "v"(hi)); return r; }
typedef float f32x2 __attribute__((ext_vector_type(2)));
template <class Epi, class Sched, bool ALIGN_EPI = false, bool SP2 = false>
__device__ __forceinline__ void gemm_phase(PG8_LAS unsigned char* lds, const Gemm g, const Sched& S, const Epi& E) {
    const int tid = threadIdx.x, wid = __builtin_amdgcn_readfirstlane(tid >> 6), lane = tid & 63, wr = wid >> 2, wc = wid & 3, fr = lane & 15, fq = lane >> 4;
    const int K = g.K, nt = K / BK;
    unsigned voffA[2], voffB[2];
#pragma unroll
    for (int i = 0; i < 2; ++i) { int R, C; stage_rc(tid * 16 + i * 8192, R, C); const int Rb = Epi::PERM ? ((R & ~31) + perm32(R & 31)) : R;
        voffA[i] = (unsigned)(R * K + C) * 2u; voffB[i] = (unsigned)(Rb * K + C) * 2u; }
    const size_t kstep = (size_t)(BK * 2);
    const size_t hstep = (size_t)HALF * K * 2;
    const size_t tstep = 2 * hstep;
    const unsigned ldsw = (unsigned)wid * 1024u;
    const int aoff = lds_byte(wr * 64 + fr, fq * 8), boff = lds_byte(wc * 32 + fr, fq * 8);
#define PG8_SA(b, h) (((b) * 2 + (h)) * HTB)
#define PG8_SB(b, h) ((4 + (b) * 2 + (h)) * HTB)
#define PG8_STAGE(bufoff, gbase, voff) do { _Pragma("unroll") for (int _i = 0; _i < 2; ++_i) \
        __builtin_amdgcn_global_load_lds((const unsigned*)((const char*)(gbase) + (voff)[_i]), (PG8_LAS unsigned*)(lds + (bufoff) + ldsw + _i * 8192), 16, 0, 0); } while (0)
#define PG8_LDA(dst, b, h) do { _Pragma("unroll") for (int m = 0; m < 4; ++m) _Pragma("unroll") for (int k = 0; k < 2; ++k) dst[m][k] = *(const PG8_LAS bf16x8*)(lds + PG8_SA(b, h) + aoff + m * 2048 + k * 1024); } while (0)
#define PG8_LDB(dst, b, h) do { _Pragma("unroll") for (int n = 0; n < 2; ++n) _Pragma("unroll") for (int k = 0; k < 2; ++k) dst[n][k] = *(const PG8_LAS bf16x8*)(lds + PG8_SB(b, h) + boff + n * 2048 + k * 1024); } while (0)
#define PG8_MMA(ai, bj, At, Bt) do { __builtin_amdgcn_s_setprio(1); _Pragma("unroll") for (int m = 0; m < 4; ++m) _Pragma("unroll") for (int n = 0; n < 2; ++n) _Pragma("unroll") for (int k = 0; k < 2; ++k) \
        acc[ai][bj][m][n] = __builtin_amdgcn_mfma_f32_16x16x32_bf16(Bt[n][k], At[m][k], acc[ai][bj][m][n], 0, 0, 0); __builtin_amdgcn_s_setprio(0); } while (0)
#define PG8_WAIT_V(n) asm volatile("s_waitcnt vmcnt(" #n ")" ::: "memory")
#define PG8_WAIT_L(n) asm volatile("s_waitcnt lgkmcnt(" #n ")" ::: "memory")
#define PG8_BAR __builtin_amdgcn_s_barrier()
#define PG8_SCHED __builtin_amdgcn_sched_barrier(0)
    Unit cur, nxt; int ui = 0;
    if (!S.next(0, cur)) return;
    f32x4 acc[2][2][4][2];
#pragma unroll
    for (int a = 0; a < 2; ++a)
#pragma unroll
        for (int b = 0; b < 2; ++b)
#pragma unroll
            for (int m = 0; m < 4; ++m)
#pragma unroll
                for (int n = 0; n < 2; ++n) acc[a][b][m][n] = (f32x4){0.f, 0.f, 0.f, 0.f};
    bf16x8 At[4][2], B0[2][2], B1[2][2];
    const char* cA = (const char*)g.A + (size_t)cur.pm * tstep; const char* cB = (const char*)g.Bt + (size_t)cur.pn * tstep;
    S.a_ready(cur);
    if constexpr (SP2) {
        PG8_STAGE(PG8_SB(0, 0), cB, voffB); PG8_STAGE(PG8_SB(0, 1), cB + hstep, voffB); PG8_STAGE(PG8_SA(0, 0), cA, voffA); PG8_STAGE(PG8_SA(0, 1), cA + hstep, voffA);
        if (wr == 1) PG8_BAR;
        PG8_WAIT_V(2); PG8_BAR;
        PG8_STAGE(PG8_SB(1, 0), cB + kstep, voffB); PG8_STAGE(PG8_SA(1, 0), cA + kstep, voffA); PG8_STAGE(PG8_SB(1, 1), cB + hstep + kstep, voffB);
        PG8_WAIT_V(6); PG8_BAR;
    } else {
        PG8_STAGE(PG8_SB(0, 0), cB, voffB); PG8_STAGE(PG8_SA(0, 0), cA, voffA); PG8_STAGE(PG8_SB(0, 1), cB + hstep, voffB); PG8_STAGE(PG8_SA(0, 1), cA + hstep, voffA);
        if (wr == 1) PG8_BAR;
        PG8_WAIT_V(4); PG8_BAR;
        PG8_STAGE(PG8_SB(1, 0), cB + kstep, voffB); PG8_STAGE(PG8_SA(1, 0), cA + kstep, voffA); PG8_STAGE(PG8_SB(1, 1), cB + hstep + kstep, voffB);
        PG8_WAIT_V(6); PG8_BAR;
    }
    for (;;) {
        const bool has_next = S.next(ui + 1, nxt);
        const char* nA = has_next ? (const char*)g.A + (size_t)nxt.pm * tstep : cA; const char* nB = has_next ? (const char*)g.Bt + (size_t)nxt.pn * tstep : cB;
        for (int t = 0; t < nt; t += 2) {
            const bool last = (t == nt - 2);
            const char* a1 = cA + (size_t)(t + 1) * kstep;
            const char* a2 = last ? nA : cA + (size_t)(t + 2) * kstep; const char* b2 = last ? nB : cB + (size_t)(t + 2) * kstep;
            const char* a3 = a2 + kstep; const char* b3 = b2 + kstep;
            if (last && has_next) S.a_ready(nxt);
            if constexpr (SP2) {
            PG8_LDB(B0, 0, 0); PG8_LDB(B1, 0, 1); PG8_SCHED; PG8_LDA(At, 0, 0); PG8_STAGE(PG8_SA(1, 1), a1 + hstep, voffA);
            PG8_WAIT_V(8); PG8_WAIT_L(0); PG8_BAR; PG8_MMA(0, 0, At, B0); PG8_MMA(0, 1, At, B1); PG8_BAR; PG8_SCHED;
            PG8_LDA(At, 0, 1); PG8_STAGE(PG8_SB(0, 0), b2, voffB); PG8_STAGE(PG8_SB(0, 1), b2 + hstep, voffB); PG8_STAGE(PG8_SA(0, 0), a2, voffA);
            PG8_WAIT_V(8); PG8_WAIT_L(0); PG8_BAR; PG8_MMA(1, 0, At, B0); PG8_MMA(1, 1, At, B1); PG8_BAR; PG8_SCHED;
            PG8_LDB(B0, 1, 0); PG8_LDB(B1, 1, 1); PG8_SCHED; PG8_LDA(At, 1, 0); PG8_STAGE(PG8_SA(0, 1), a2 + hstep, voffA);
            PG8_WAIT_V(8); PG8_WAIT_L(0); PG8_BAR; PG8_MMA(0, 0, At, B0); PG8_MMA(0, 1, At, B1); PG8_BAR; PG8_SCHED;
            PG8_LDA(At, 1, 1); PG8_STAGE(PG8_SB(1, 0), b3, voffB); PG8_STAGE(PG8_SB(1, 1), b3 + hstep, voffB); PG8_STAGE(PG8_SA(1, 0), a3, voffA);
            PG8_WAIT_V(8); PG8_WAIT_L(0); PG8_BAR; PG8_MMA(1, 0, At, B0); PG8_MMA(1, 1, At, B1); PG8_BAR; PG8_SCHED;
            } else {
            PG8_LDB(B0, 0, 0); PG8_SCHED; PG8_LDA(At, 0, 0); PG8_STAGE(PG8_SA(1, 1), a1 + hstep, voffA);
            PG8_WAIT_L(8); PG8_BAR; PG8_WAIT_L(0); PG8_MMA(0, 0, At, B0); PG8_BAR; PG8_SCHED;
            PG8_LDB(B1, 0, 1); PG8_STAGE(PG8_SB(0, 0), b2, voffB);
            PG8_BAR; PG8_WAIT_L(0); PG8_MMA(0, 1, At, B1); PG8_BAR;
            PG8_LDA(At, 0, 1); PG8_STAGE(PG8_SA(0, 0), a2, voffA);
            PG8_BAR; PG8_WAIT_L(0); PG8_MMA(1, 0, At, B0); PG8_BAR; PG8_SCHED;
            PG8_STAGE(PG8_SB(0, 1), b2 + hstep, voffB);
            PG8_WAIT_V(6); PG8_BAR; PG8_MMA(1, 1, At, B1); PG8_BAR;
            PG8_LDB(B0, 1, 0); PG8_SCHED; PG8_LDA(At, 1, 0); PG8_STAGE(PG8_SA(0, 1), a2 + hstep, voffA);
            PG8_WAIT_L(8); PG8_BAR; PG8_WAIT_L(0); PG8_MMA(0, 0, At, B0); PG8_BAR; PG8_SCHED;
            PG8_LDB(B1, 1, 1); PG8_STAGE(PG8_SB(1, 0), b3, voffB);
            PG8_BAR; PG8_WAIT_L(0); PG8_MMA(0, 1, At, B1); PG8_BAR;
            PG8_LDA(At, 1, 1); PG8_STAGE(PG8_SA(1, 0), a3, voffA);
            PG8_BAR; PG8_WAIT_L(0); PG8_MMA(1, 0, At, B0); PG8_BAR; PG8_SCHED;
            PG8_STAGE(PG8_SB(1, 1), b3 + hstep, voffB);
            PG8_WAIT_V(6); PG8_BAR; PG8_MMA(1, 1, At, B1); PG8_BAR;
            }
        }
        if constexpr (ALIGN_EPI) { if (wr == 0) PG8_BAR; }
        if constexpr (!Epi::AFTER_DRAIN) { E(acc, cur, wr, wc, fr, fq); S.done(cur); }
        if (!has_next) break;
#pragma unroll
        for (int a = 0; a < 2; ++a)
#pragma unroll
            for (int b = 0; b < 2; ++b)
#pragma unroll
                for (int m = 0; m < 4; ++m)
#pragma unroll
                    for (int n = 0; n < 2; ++n) acc[a][b][m][n] = (f32x4){0.f, 0.f, 0.f, 0.f};
        cur = nxt; cA = nA; cB = nB; ++ui;
        if constexpr (ALIGN_EPI) { if (wr == 1) PG8_BAR; }
    }
    PG8_WAIT_V(0);
    if constexpr (!ALIGN_EPI) { if (wr == 0) PG8_BAR; }
    PG8_BAR;
    if constexpr (Epi::AFTER_DRAIN) { E.fused(acc, cur, wr, wc, fr, fq, lds, wid, lane); S.done(cur); }
#undef PG8_SA
#undef PG8_SB
#undef PG8_STAGE
#undef PG8_LDA
#undef PG8_LDB
#undef PG8_MMA
#undef PG8_WAIT_V
#undef PG8_WAIT_L
#undef PG8_BAR
#undef PG8_SCHED
}
}

constexpr int NB = 2, SEQ = 16384, T = NB * SEQ, D = 1024;
constexpr float EPS = 1e-6f;
constexpr int NWAVES = 8, NTHR = 512;
constexpr int N_IN = 55;
__host__ __device__ constexpr int LBASE(int L) { return L == 0 ? 2 : (L == 1 ? 15 : (L == 2 ? 29 : 42)); }
__host__ __device__ constexpr int NMIX(int L) { return L == 1 ? 6 : 5; }

constexpr size_t MiB = 1u << 20;
constexpr size_t WS_CTL = 0, CTL_ZERO_BYTES = 1 * MiB;
constexpr size_t WS_MOD = 1 * MiB;
constexpr size_t WS_CNT = WS_MOD + 256 * 1024;
constexpr size_t WS_TILEE = WS_CNT + 64 * 1024;
constexpr size_t WS_EID = 2 * MiB;
constexpr size_t WS_GATE = WS_EID + 256 * 1024;
constexpr size_t WS_SLOT = WS_GATE + 256 * 1024;
constexpr size_t WS_VSSP = 3 * MiB;
constexpr size_t WS_BA = 5 * MiB;
constexpr size_t WS_DNB = 7 * MiB;
constexpr size_t WS_RTR = 9 * MiB;
constexpr size_t WS_W = 16 * MiB;
constexpr size_t WS_WMIX = WS_W + 384 * MiB;
constexpr size_t WMIX_GM_IN0 = 0, WMIX_GM_OUT0 = 4 * MiB, WMIX_DN_IN = 6 * MiB, WMIX_DN_OUT = 13 * MiB, WMIX_SWA_IN = 15 * MiB, WMIX_SWA_OUT = 18 * MiB, WMIX_GM_IN3 = 20 * MiB, WMIX_GM_OUT3 = 24 * MiB;
constexpr size_t WS_ACT = 432 * MiB;
constexpr size_t A_H = 0;
constexpr size_t A_U = 64 * MiB, A_V = 128 * MiB, A_GATED = 192 * MiB;
constexpr size_t A_QKV = 64 * MiB, A_Z = 192 * MiB, A_QN = 256 * MiB, A_KN = 320 * MiB, A_VV = 384 * MiB, A_O = 448 * MiB;
constexpr size_t A_XG = 64 * MiB, A_ACTV = 208 * MiB, A_Y = 280 * MiB;
constexpr size_t WS_END = WS_ACT + 512 * MiB;
constexpr int MAXROWS = 73728;

constexpr int RING_BYTES = 131072;
constexpr int LDSCTL_OFF = RING_BYTES, MISC_OFF = LDSCTL_OFF + 320;
constexpr int LDS_BYTES = 147456;

#define LAS __attribute__((address_space(3)))
typedef unsigned short bf16;
typedef unsigned v4u __attribute__((ext_vector_type(4)));
typedef unsigned v2u __attribute__((ext_vector_type(2)));
typedef float f32x4 __attribute__((ext_vector_type(4)));
typedef short bf16x8 __attribute__((ext_vector_type(8)));
typedef short bf16x4 __attribute__((ext_vector_type(4)));
#define LDS_WAIT() asm volatile("s_waitcnt lgkmcnt(0)" ::: "memory")
#define VM_WAIT() asm volatile("s_waitcnt vmcnt(0)" ::: "memory")
__device__ __forceinline__ unsigned pk2(float lo, float hi) { return pg8::cvt_pk_bf16(lo, hi); }
__device__ __forceinline__ float bflo(unsigned w) { return __uint_as_float(w << 16); }
__device__ __forceinline__ float bfhi(unsigned w) { return __uint_as_float(w & 0xffff0000u); }
__device__ __forceinline__ float bf1(unsigned short b) { return __uint_as_float(((unsigned)b) << 16); }
__device__ __forceinline__ float wave_sum(float v) {
#pragma unroll
    for (int o = 1; o < 64; o <<= 1) v += __shfl_xor(v, o);
    return v;
}
__device__ __forceinline__ float fast_exp(float x) { return __builtin_amdgcn_exp2f(x * 1.44269504089f); }
__device__ __forceinline__ float sigmoidf_(float x) { return __builtin_amdgcn_rcpf(1.0f + fast_exp(-x)); }
__device__ __forceinline__ float siluf_(float x) { return x * sigmoidf_(x); }
__device__ __forceinline__ float gelu_tanh(float x) { const float y = 1.5957691216057308f * (x + 0.044715f * x * x * x); return x * __builtin_amdgcn_rcpf(1.0f + fast_exp(-y)); }

#define RLX_AGENT __ATOMIC_RELAXED, __HIP_MEMORY_SCOPE_AGENT
__device__ __forceinline__ unsigned char* uni_ptr(unsigned char* p) { const unsigned long long w = (unsigned long long)p; const unsigned lo = __builtin_amdgcn_readfirstlane((unsigned)w), hi = __builtin_amdgcn_readfirstlane((unsigned)(w >> 32)); return (unsigned char*)(__attribute__((address_space(1))) unsigned char*)(((unsigned long long)hi << 32) | lo); }
#define XB_TMO      128
#define XB_XCNT(j)  (256  + 64 * (j))
#define XB_XSUB(j)  (1280 + 64 * (j))
#define XB_XGEN(j)  (2304 + 64 * (j))
#define XB_TOP      3328
#define XB_TOPGEN   3392
#define XCD_BAR_WORDS 3456
#define XB_SPIN_CAP (1u << 18)

__device__ __forceinline__ unsigned xb_ld(unsigned* p)              { return __hip_atomic_load(p, __ATOMIC_RELAXED, __HIP_MEMORY_SCOPE_AGENT); }
__device__ __forceinline__ unsigned xb_add(unsigned* p, unsigned v) { return __hip_atomic_fetch_add(p, v, __ATOMIC_RELAXED, __HIP_MEMORY_SCOPE_AGENT); }
__device__ __forceinline__ unsigned xb_xcc_id() { return (unsigned)__builtin_amdgcn_s_getreg((3 << 11) | 20) & 0xFu; }
#define XB_SPIN(cond, bar) do { unsigned _sp = 0; while (cond) { __builtin_amdgcn_s_sleep(1); \
    if ((++_sp & 255u) == 0u) { if (xb_ld(&(bar)[XB_TMO])) break; if (_sp > XB_SPIN_CAP) { atomicAdd(&(bar)[XB_TMO], 1u); break; } } } } while (0)

struct XcdBarrier {
    unsigned* bar; unsigned x;
    volatile LAS unsigned* st;
};

__device__ __forceinline__ XcdBarrier xcd_barrier_post(unsigned* bar, volatile LAS unsigned* st) {
    XcdBarrier b; b.bar = bar; b.x = xb_xcc_id(); b.st = st;
    if (threadIdx.x == 0) (void)xb_add(&bar[XB_XCNT(b.x)], 1u);
    return b;
}
__device__ __forceinline__ void xcd_barrier_complete(unsigned* bar, unsigned x, unsigned& nloc, unsigned& nx) {
    const unsigned G = gridDim.x * gridDim.y * gridDim.z;
    unsigned sum, cnt, mine, sp = 0u;
    for (;;) {
        sum = 0u; cnt = 0u; mine = 0u;
#pragma unroll
        for (unsigned j = 0; j < 16; ++j) { const unsigned c = xb_ld(&bar[XB_XCNT(j)]); sum += c; cnt += (c > 0u) ? 1u : 0u; mine = (j == x) ? c : mine; }
        if (sum == G) break;
        __builtin_amdgcn_s_sleep(1);
        if ((++sp & 255u) == 0u) { if (xb_ld(&bar[XB_TMO])) break; if (sp > XB_SPIN_CAP) { atomicAdd(&bar[XB_TMO], 1u); break; } }
    }
    nloc = mine > 0u ? mine : 1u; nx = cnt > 0u ? cnt : 1u;
}

__device__ __forceinline__ void xcd_barrier(const XcdBarrier& b) {
    asm volatile("s_waitcnt vmcnt(0)" ::: "memory");
    __syncthreads();
    if (threadIdx.x == 0) {
        unsigned* bar = b.bar;
        __builtin_amdgcn_s_waitcnt(0);
        unsigned nloc = b.st[0], nx = b.st[1];
        if (nloc == 0u) { xcd_barrier_complete(bar, b.x, nloc, nx); b.st[0] = nloc; b.st[1] = nx; }
        const unsigned old = xb_add(&bar[XB_XSUB(b.x)], 1u);
        const unsigned gen = old / nloc;
        if (old + 1u == (gen + 1u) * nloc) {
            __builtin_amdgcn_fence(__ATOMIC_RELEASE, "agent");
            asm volatile("s_waitcnt vmcnt(0)" ::: "memory");
            const unsigned og = xb_add(&bar[XB_TOP], 1u);
            const unsigned tg = og / nx;
            if (og + 1u == (tg + 1u) * nx) xb_add(&bar[XB_TOPGEN], 1u);
            else XB_SPIN(xb_ld(&bar[XB_TOPGEN]) == tg, bar);
            __builtin_amdgcn_fence(__ATOMIC_ACQUIRE, "agent");
            xb_add(&bar[XB_XGEN(b.x)], 1u);
            asm volatile("s_waitcnt vmcnt(0)" ::: "memory");
        } else {
            XB_SPIN(xb_ld(&bar[XB_XGEN(b.x)]) == gen, bar);
            __builtin_amdgcn_fence(__ATOMIC_ACQUIRE, "agent");
            asm volatile("s_waitcnt vmcnt(0)" ::: "memory");
        }
    }
    __syncthreads();
}

typedef const pg8::f32x4 (&AccRef)[2][2][4][2];

struct EpiGm1 {
    static constexpr bool PERM = true, AFTER_DRAIN = false;
    bf16* U; bf16* V; float* vssp;
    __device__ __forceinline__ void operator()(AccRef acc, const pg8::Unit& u, int wr, int wc, int fr, int fq) const {
        const int row0 = u.pm * 256 + wr * 64 + fr; const bool isV = u.pn >= 4; const int col0 = (u.pn & 3) * 256 + wc * 32 + 8 * fq;
        bf16* base = isV ? V : U;
#pragma unroll
        for (int ai = 0; ai < 2; ++ai)
#pragma unroll
            for (int m = 0; m < 4; ++m) { const int row = row0 + ai * 128 + m * 16; bf16* rowp = base + (size_t)row * 1024 + col0; float ss = 0.f;
#pragma unroll
                for (int bj = 0; bj < 2; ++bj) { f32x4 v0 = acc[ai][bj][m][0], v1 = acc[ai][bj][m][1];
#pragma unroll
                    for (int j = 0; j < 4; ++j) { v0[j] = gelu_tanh(v0[j]); v1[j] = gelu_tanh(v1[j]); ss += v0[j] * v0[j] + v1[j] * v1[j]; }
                    v4u w; w.x = pk2(v0[0], v0[1]); w.y = pk2(v0[2], v0[3]); w.z = pk2(v1[0], v1[1]); w.w = pk2(v1[2], v1[3]);
                    *(v4u*)(rowp + bj * 128) = w; }
                if (isV) { ss += __shfl_xor(ss, 16); ss += __shfl_xor(ss, 32); if (fq == 0) vssp[(size_t)row * 16 + (u.pn - 4) * 4 + wc] = ss; } }
    }
};
struct EpiRes {
    static constexpr bool PERM = false, AFTER_DRAIN = false;
    const float* src; float* dst; const float* gate;
    __device__ __forceinline__ void operator()(AccRef acc, const pg8::Unit& u, int wr, int wc, int fr, int fq) const {
        const int row0 = u.pm * 256 + wr * 64 + fr, col0 = u.pn * 256 + wc * 32 + 4 * fq; const int b = (u.pm * 256) / SEQ;
        f32x4 gv[2][2];
#pragma unroll
        for (int bj = 0; bj < 2; ++bj)
#pragma unroll
            for (int n = 0; n < 2; ++n) gv[bj][n] = *(const f32x4*)(gate + (size_t)b * 6144 + col0 + bj * 128 + n * 16);
#pragma unroll
        for (int ai = 0; ai < 2; ++ai)
#pragma unroll
            for (int m = 0; m < 4; ++m) { const size_t off = (size_t)(row0 + ai * 128 + m * 16) * 1024 + col0;
#pragma unroll
                for (int bj = 0; bj < 2; ++bj)
#pragma unroll
                    for (int n = 0; n < 2; ++n) { const f32x4 xs = *(const f32x4*)(src + off + bj * 128 + n * 16); *(f32x4*)(dst + off + bj * 128 + n * 16) = xs + gv[bj][n] * acc[ai][bj][m][n]; } }
    }
};
struct EpiBf {
    static constexpr bool PERM = true, AFTER_DRAIN = false;
    bf16* O; int ldc; int nmask;
    __device__ __forceinline__ void operator()(AccRef acc, const pg8::Unit& u, int wr, int wc, int fr, int fq) const {
        const int row0 = u.pm * 256 + wr * 64 + fr, col0 = (u.pn & nmask) * 256 + wc * 32 + 8 * fq;
#pragma unroll
        for (int ai = 0; ai < 2; ++ai)
#pragma unroll
            for (int m = 0; m < 4; ++m) { bf16* rowp = O + (size_t)(row0 + ai * 128 + m * 16) * ldc + col0;
#pragma unroll
                for (int bj = 0; bj < 2; ++bj) { const f32x4 v0 = acc[ai][bj][m][0], v1 = acc[ai][bj][m][1];
                    v4u w; w.x = pk2(v0[0], v0[1]); w.y = pk2(v0[2], v0[3]); w.z = pk2(v1[0], v1[1]); w.w = pk2(v1[2], v1[3]);
                    *(v4u*)(rowp + bj * 128) = w; } }
    }
};
struct EpiDn1 {
    static constexpr bool PERM = true, AFTER_DRAIN = false;
    bf16* QKV; bf16* Z; float* BA;
    __device__ __forceinline__ void operator()(AccRef acc, const pg8::Unit& u, int wr, int wc, int fr, int fq) const {
        const int row0 = u.pm * 256 + wr * 64 + fr;
        if (u.pn < 12) {
            bf16* base = u.pn < 8 ? QKV : Z; const int ldc = u.pn < 8 ? 2048 : 1024; const int col0 = (u.pn < 8 ? u.pn : u.pn - 8) * 256 + wc * 32 + 8 * fq;
#pragma unroll
            for (int ai = 0; ai < 2; ++ai)
#pragma unroll
                for (int m = 0; m < 4; ++m) { bf16* rowp = base + (size_t)(row0 + ai * 128 + m * 16) * ldc + col0;
#pragma unroll
                    for (int bj = 0; bj < 2; ++bj) { const f32x4 v0 = acc[ai][bj][m][0], v1 = acc[ai][bj][m][1];
                        v4u w; w.x = pk2(v0[0], v0[1]); w.y = pk2(v0[2], v0[3]); w.z = pk2(v1[0], v1[1]); w.w = pk2(v1[2], v1[3]);
                        *(v4u*)(rowp + bj * 128) = w; } }
        } else if (wc == 0 && fq < 2) {
#pragma unroll
            for (int ai = 0; ai < 2; ++ai)
#pragma unroll
                for (int m = 0; m < 4; ++m) { float* rowp = BA + (size_t)(row0 + ai * 128 + m * 16) * 16 + 8 * fq;
                    *(f32x4*)(rowp) = acc[ai][0][m][0]; *(f32x4*)(rowp + 4) = acc[ai][0][m][1]; }
        }
    }
};
struct EpiMoe1 {
    static constexpr bool PERM = true, AFTER_DRAIN = false;
    bf16* O;
    __device__ __forceinline__ void operator()(AccRef acc, const pg8::Unit& u, int wr, int wc, int fr, int fq) const {
        const int row0 = u.pm * 256 + wr * 64 + fr, col0 = (u.pn & 3) * 128 + wc * 32 + 8 * fq;
#pragma unroll
        for (int ai = 0; ai < 2; ++ai)
#pragma unroll
            for (int m = 0; m < 4; ++m) { bf16* rowp = O + (size_t)(row0 + ai * 128 + m * 16) * 512 + col0; float r[8];
#pragma unroll
                for (int n = 0; n < 2; ++n)
#pragma unroll
                    for (int j = 0; j < 4; ++j) { const float a = acc[ai][0][m][n][j], g = acc[ai][1][m][n][j]; r[4 * n + j] = siluf_(a) * g; }
                v4u w; w.x = pk2(r[0], r[1]); w.y = pk2(r[2], r[3]); w.z = pk2(r[4], r[5]); w.w = pk2(r[6], r[7]);
                *(v4u*)rowp = w; }
    }
};
struct MoeOrder {
    const int* tile_e; int total, G, c;
    __device__ __forceinline__ void init(const int* te, int ntiles, int G_, int c_) { tile_e = te; total = ntiles * 4; G = G_; c = c_; }
    __device__ __forceinline__ bool next(int i, pg8::Unit& u) const {
        const long Lx = (long)i * G + c; if (Lx >= total) return false;
        const int w0 = (int)Lx, q = total / 8, r = total % 8, xcd = w0 % 8, off = w0 / 8;
        const int wgid = (xcd < r ? xcd * (q + 1) : r * (q + 1) + (xcd - r) * q) + off;
        const int rt = wgid >> 2; u.pm = rt; u.pn = tile_e[rt] * 4 + (wgid & 3); return true;
    }
    __device__ __forceinline__ void a_ready(const pg8::Unit&) const {}
    __device__ __forceinline__ void done(const pg8::Unit&) const {}
};

struct Args { const float* in[N_IN]; float* out; unsigned char* ws; int ph_lo, ph_hi, li, pad; };

__device__ __forceinline__ void tr_item(const float* __restrict__ W, int ldn, int k0, int n0, bf16* __restrict__ WT, int Kd, int drow0, LAS float* scr, int lane) {
#pragma unroll 8
    for (int i = 0; i < 32; ++i) { const int kk = 2 * i + (lane >> 5); scr[kk * 33 + (lane & 31)] = W[(size_t)(k0 + kk) * ldn + n0 + (lane & 31)]; }
    LDS_WAIT(); asm volatile("" ::: "memory");
    const int c = lane & 7;
#pragma unroll
    for (int j = 0; j < 4; ++j) { const int n = (lane >> 3) + 8 * j; const LAS float* s = scr + (8 * c) * 33 + n;
        v4u o; o.x = pk2(s[0 * 33], s[1 * 33]); o.y = pk2(s[2 * 33], s[3 * 33]); o.z = pk2(s[4 * 33], s[5 * 33]); o.w = pk2(s[6 * 33], s[7 * 33]);
        *(v4u*)(WT + (size_t)(drow0 + n) * Kd + k0 + 8 * c) = o; }
    LDS_WAIT(); asm volatile("" ::: "memory");
}

__device__ __forceinline__ void phase_prologue(const Args& args, LAS unsigned char* lds) {
    int tid_ = threadIdx.x; asm volatile("" : "+v"(tid_)); const int tid = tid_, lane = tid & 63, wave = __builtin_amdgcn_readfirstlane(tid >> 6), G = gridDim.x, bid = blockIdx.x; (void)tid; (void)lane; (void)wave;
    unsigned char* ws = uni_ptr(args.ws);
    LAS float* cact = (LAS float*)(lds + 69632);
    LAS float* red = (LAS float*)(lds + 77824);
    for (int k = tid; k < 2048; k += NTHR) cact[k] = siluf_(args.in[1][k]);
    __syncthreads();
    float* MOD = (float*)(ws + WS_MOD);
    for (int item = bid; item < 384; item += G) {
        const int L = item / 96, cg = item % 96, c4 = tid & 15, ks = tid >> 4;
        const float* w = args.in[LBASE(L) + 2] + (size_t)(ks * 32) * 6144 + cg * 64 + c4 * 4;
        f32x4 a0 = {0.f, 0.f, 0.f, 0.f}, a1 = {0.f, 0.f, 0.f, 0.f};
#pragma unroll 8
        for (int kk = 0; kk < 32; ++kk) { const f32x4 wv = *(const f32x4*)(w + (size_t)kk * 6144); a0 += cact[ks * 32 + kk] * wv; a1 += cact[1024 + ks * 32 + kk] * wv; }
        *(LAS f32x4*)(red + (ks * 2 + 0) * 64 + c4 * 4) = a0; *(LAS f32x4*)(red + (ks * 2 + 1) * 64 + c4 * 4) = a1;
        __syncthreads();
        if (tid < 128) { const int b = tid >> 6, col = tid & 63; float s = 0.f;
#pragma unroll
            for (int k2 = 0; k2 < 32; ++k2) s += red[(k2 * 2 + b) * 64 + col];
            MOD[(size_t)(L * 2 + b) * 6144 + cg * 64 + col] = s + args.in[LBASE(L) + 3][cg * 64 + col]; }
        __syncthreads();
    }
    LAS float* scr = (LAS float*)(lds + wave * 8448);
    const int gw = bid * NWAVES + wave, NGW = G * NWAVES;
    constexpr int PER_L = 24576, N_EXP = 4 * PER_L, N_MIXI = 1536 + 2048 + 1280 + 1536;
    for (int it = gw; it < N_EXP + N_MIXI; it += NGW) {
        const float* src; bf16* dst; int ldn, k0, n0, Kd, drow0;
        if (it < N_EXP) {
            const int L = it / PER_L; int r = it % PER_L; const int ib = LBASE(L) + 4 + NMIX(L);
            if (r < 16384) { const int e = r >> 9, rr = r & 511; k0 = (rr >> 5) * 64; n0 = (rr & 31) * 32; ldn = 1024; Kd = 1024;
                src = args.in[ib + 2] + (size_t)e * 1048576; dst = (bf16*)(ws + WS_W + (size_t)L * 96 * MiB) + (size_t)e * 1048576;
                drow0 = (n0 < 512) ? ((n0 >> 7) * 256 + (n0 & 127)) : ((((n0 - 512) >> 7) * 256) + 128 + ((n0 - 512) & 127)); }
            else { r -= 16384; const int e = r >> 8, rr = r & 255; k0 = (rr >> 5) * 64; n0 = (rr & 31) * 32; ldn = 1024; Kd = 512;
                src = args.in[ib + 3] + (size_t)e * 524288; dst = (bf16*)(ws + WS_W + (size_t)L * 96 * MiB + 64 * MiB) + (size_t)e * 524288; drow0 = n0; }
        } else {
            int r = it - N_EXP; int idx, nblk; size_t woff;
            if (r < 1024) { idx = 6; ldn = 2048; nblk = 64; woff = WMIX_GM_IN0; }
            else if ((r -= 1024) < 512) { idx = 10; ldn = 1024; nblk = 32; woff = WMIX_GM_OUT0; }
            else if ((r -= 512) < 1536) { idx = 19; ldn = 3088; nblk = 96; woff = WMIX_DN_IN; }
            else if ((r -= 1536) < 512) { idx = 24; ldn = 1024; nblk = 32; woff = WMIX_DN_OUT; }
            else if ((r -= 512) < 768) { idx = 33; ldn = 1536; nblk = 48; woff = WMIX_SWA_IN; }
            else if ((r -= 768) < 512) { idx = 37; ldn = 1024; nblk = 32; woff = WMIX_SWA_OUT; }
            else if ((r -= 512) < 1024) { idx = 46; ldn = 2048; nblk = 64; woff = WMIX_GM_IN3; }
            else { r -= 1024; idx = 50; ldn = 1024; nblk = 32; woff = WMIX_GM_OUT3; }
            src = args.in[idx]; dst = (bf16*)(ws + WS_WMIX + woff); k0 = (r / nblk) * 64; n0 = (r % nblk) * 32; Kd = 1024; drow0 = n0;
        }
        tr_item(src, ldn, k0, n0, dst, Kd, drow0, scr, lane);
    }
    const int gt = bid * NTHR + tid, NGT = G * NTHR;
    { bf16* dst = (bf16*)(ws + WS_WMIX + WMIX_DN_IN) + (size_t)3072 * 1024; const float* w = args.in[19];
      for (int i = gt; i < 256 * 1024; i += NGT) { const int n = i >> 10, k = i & 1023; const float v = n < 16 ? w[(size_t)k * 3088 + 3072 + n] : 0.f; dst[i] = (bf16)(pk2(v, 0.f) & 0xffffu); } }
    for (int i = gt; i < 4 * 48 * 1024; i += NGT) {
        const int L = i / 49152, rem = i % 49152, n = rem >> 10, k = rem & 1023;
        const float w = n < 36 ? args.in[LBASE(L) + 4 + NMIX(L)][(size_t)k * 36 + n] : 0.f;
        const unsigned hi = pk2(w, 0.f) & 0xffffu; const float lo = w - bf1((unsigned short)hi);
        bf16* RH = (bf16*)(ws + WS_RTR + (size_t)L * 196608); RH[rem] = (bf16)hi; RH[49152 + rem] = (bf16)(pk2(lo, 0.f) & 0xffffu);
    }
}

__device__ __forceinline__ void norm_store_row(const f32x4 (&v)[4], const float* __restrict__ gain, const float* __restrict__ shift, const float* __restrict__ scale, bf16* __restrict__ hrow, int lane) {
    float ss = 0.f;
#pragma unroll
    for (int j = 0; j < 4; ++j) ss += (v[j][0] * v[j][0] + v[j][1] * v[j][1]) + (v[j][2] * v[j][2] + v[j][3] * v[j][3]);
    const float rstd = __builtin_amdgcn_rsqf(wave_sum(ss) * (1.0f / 1024.0f) + EPS);
#pragma unroll
    for (int j = 0; j < 4; ++j) { const int c = 4 * lane + 256 * j;
        const f32x4 g = *(const f32x4*)(gain + c), sc = *(const f32x4*)(scale + c), sh = *(const f32x4*)(shift + c);
        const f32x4 h = v[j] * rstd * (g * (1.0f + sc)) + sh;
        v2u w; w.x = pk2(h[0], h[1]); w.y = pk2(h[2], h[3]); *(v2u*)(hrow + c) = w; }
}
__device__ __forceinline__ void phase_norm0(const Args& args) {
    int tid_ = threadIdx.x; asm volatile("" : "+v"(tid_)); const int tid = tid_, lane = tid & 63, wave = __builtin_amdgcn_readfirstlane(tid >> 6), G = gridDim.x, bid = blockIdx.x; (void)tid; (void)lane; (void)wave;
    const float* X = args.in[0]; bf16* H = (bf16*)(args.ws + WS_ACT + A_H); const float* MOD = (const float*)(args.ws + WS_MOD);
    for (int t = bid * NWAVES + wave; t < T; t += G * NWAVES) { const int b = t / SEQ; f32x4 v[4];
#pragma unroll
        for (int j = 0; j < 4; ++j) v[j] = *(const f32x4*)(X + (size_t)t * 1024 + 4 * lane + 256 * j);
        const float* m = MOD + (size_t)b * 6144;
        norm_store_row(v, args.in[2], m, m + 1024, H + (size_t)t * 1024, lane); }
}

__device__ __forceinline__ void phase_gm_spatial(const Args& args, int L, LAS unsigned char* lds) {
    int tid_ = threadIdx.x; asm volatile("" : "+v"(tid_)); const int tid = tid_, lane = tid & 63, wave = __builtin_amdgcn_readfirstlane(tid >> 6), G = gridDim.x, bid = blockIdx.x; (void)tid; (void)lane; (void)wave;
    unsigned char* ws = uni_ptr(args.ws); const int ib = LBASE(L) + 4;
    const float* v_norm = args.in[ib + 1]; const float* w_s = args.in[ib + 2]; const float* b_s = args.in[ib + 3];
    const bf16* U = (const bf16*)(ws + WS_ACT + A_U); const bf16* V = (const bf16*)(ws + WS_ACT + A_V); bf16* GT = (bf16*)(ws + WS_ACT + A_GATED);
    const float* VSSP = (const float*)(ws + WS_VSSP);
    LAS bf16* WL = (LAS bf16*)lds; LAS bf16* VT = (LAS bf16*)(lds + 34816); LAS float* rs = (LAS float*)(lds + 69632);
    const int wr = wave >> 2, wc = wave & 3, fr = lane & 15, fq = lane >> 4;
    for (int u = bid; u < 2048; u += G) {
        const int c = u >> 3, g = u & 7; const size_t tok0 = (size_t)c * 128;
        if (tid < 128) { const float* p = VSSP + (tok0 + tid) * 16; float s = 0.f;
#pragma unroll
            for (int i = 0; i < 4; ++i) { const f32x4 q = *(const f32x4*)(p + 4 * i); s += (q[0] + q[1]) + (q[2] + q[3]); }
            rs[tid] = __builtin_amdgcn_rsqf(s * (1.0f / 1024.0f) + EPS); }
        { const int s = tid & 127, dq = tid >> 7; const bf16* vp = V + (tok0 + s) * 1024 + g * 128 + dq * 32;
#pragma unroll
          for (int i = 0; i < 4; ++i) { const v4u q = *(const v4u*)(vp + 8 * i); const unsigned w[4] = {q.x, q.y, q.z, q.w};
#pragma unroll
              for (int e = 0; e < 4; ++e) { VT[(dq * 32 + 8 * i + 2 * e) * 136 + s] = (bf16)(w[e] & 0xffffu); VT[(dq * 32 + 8 * i + 2 * e + 1) * 136 + s] = (bf16)(w[e] >> 16); } } }
        __syncthreads();
        { const int tr = tid >> 2, sq = (tid & 3) * 32; const float* wp = w_s + ((size_t)g * 128 + tr) * 128 + sq;
#pragma unroll
          for (int i = 0; i < 8; ++i) { const f32x4 q = *(const f32x4*)(wp + 4 * i); float o[4];
#pragma unroll
              for (int e = 0; e < 4; ++e) { const int s = sq + 4 * i + e; o[e] = (s <= tr) ? q[e] * rs[s] : 0.f; }
              v2u w; w.x = pk2(o[0], o[1]); w.y = pk2(o[2], o[3]); *(LAS v2u*)(WL + tr * 136 + sq + 4 * i) = w; } }
        __syncthreads();
        f32x4 acc[2][4];
#pragma unroll
        for (int n = 0; n < 2; ++n)
#pragma unroll
            for (int m = 0; m < 4; ++m) acc[n][m] = (f32x4){0.f, 0.f, 0.f, 0.f};
#pragma unroll
        for (int ks = 0; ks < 4; ++ks) { bf16x8 vf[2], wf[4];
#pragma unroll
            for (int n = 0; n < 2; ++n) vf[n] = *(const LAS bf16x8*)(VT + (32 * wc + 16 * n + fr) * 136 + 32 * ks + 8 * fq);
#pragma unroll
            for (int m = 0; m < 4; ++m) wf[m] = *(const LAS bf16x8*)(WL + (64 * wr + 16 * m + fr) * 136 + 32 * ks + 8 * fq);
#pragma unroll
            for (int n = 0; n < 2; ++n)
#pragma unroll
                for (int m = 0; m < 4; ++m) acc[n][m] = __builtin_amdgcn_mfma_f32_16x16x32_bf16(vf[n], wf[m], acc[n][m], 0, 0, 0); }
#pragma unroll
        for (int m = 0; m < 4; ++m) { const int t = 64 * wr + 16 * m + fr; const float bs = b_s[g * 128 + t];
#pragma unroll
            for (int n = 0; n < 2; ++n) { const int d0 = g * 128 + 32 * wc + 16 * n + 4 * fq; const size_t off = (tok0 + t) * 1024 + d0;
                const v2u uu = *(const v2u*)(U + off); const f32x4 vn = *(const f32x4*)(v_norm + d0);
                const float o0 = bflo(uu.x) * (acc[n][m][0] * vn[0] + bs), o1 = bfhi(uu.x) * (acc[n][m][1] * vn[1] + bs), o2 = bflo(uu.y) * (acc[n][m][2] * vn[2] + bs), o3 = bfhi(uu.y) * (acc[n][m][3] * vn[3] + bs);
                v2u w; w.x = pk2(o0, o1); w.y = pk2(o2, o3); *(v2u*)(GT + off) = w; } }
        __syncthreads();
    }
}

__device__ __forceinline__ void phase_swa_attn(const Args& args, LAS unsigned char* lds) {
    int tid_ = threadIdx.x; asm volatile("" : "+v"(tid_)); const int tid = tid_, lane = tid & 63, wave = __builtin_amdgcn_readfirstlane(tid >> 6), G = gridDim.x, bid = blockIdx.x; (void)tid; (void)lane; (void)wave;
    unsigned char* ws = uni_ptr(args.ws);
    const float* q_norm = args.in[34]; const float* k_norm = args.in[35]; const float* sinks = args.in[36];
    const bf16* QKV = (const bf16*)(ws + WS_ACT + A_QKV); bf16* O = (bf16*)(ws + WS_ACT + A_H);
    LAS bf16* KL = (LAS bf16*)lds; LAS bf16* VT = (LAS bf16*)(lds + 36864);
    const int fr = lane & 15, fq = lane >> 4;
    for (int u = bid; u < 1024; u += G) {
        const int n = u & 127, kvh = (u >> 7) & 3, b = u >> 9; const long tok0 = (long)b * SEQ + (long)n * 128;
        { const int key = tid >> 1, half = tid & 1; const long tk = tok0 - 128 + key; float x[32]; float ss = 0.f;
          const bool ok = (n > 0) || (key >= 128);
          const bf16* kp = QKV + (size_t)(ok ? tk : tok0) * 1536 + 1024 + kvh * 64 + half * 32;
#pragma unroll
          for (int i = 0; i < 4; ++i) { const v4u q = *(const v4u*)(kp + 8 * i); const unsigned w[4] = {q.x, q.y, q.z, q.w};
#pragma unroll
              for (int e = 0; e < 4; ++e) { x[8 * i + 2 * e] = bflo(w[e]); x[8 * i + 2 * e + 1] = bfhi(w[e]); } }
#pragma unroll
          for (int i = 0; i < 32; ++i) ss += x[i] * x[i];
          ss += __shfl_xor(ss, 1);
          const float rstd = ok ? __builtin_amdgcn_rsqf(ss * (1.0f / 64.0f) + EPS) : 0.f;
#pragma unroll
          for (int i = 0; i < 4; ++i) { float o[8];
#pragma unroll
              for (int e = 0; e < 8; ++e) o[e] = x[8 * i + e] * rstd * k_norm[half * 32 + 8 * i + e];
              v4u w; w.x = pk2(o[0], o[1]); w.y = pk2(o[2], o[3]); w.z = pk2(o[4], o[5]); w.w = pk2(o[6], o[7]);
              *(LAS v4u*)(KL + key * 72 + half * 32 + 8 * i) = w; } }
        { const int key = tid & 255, dh = tid >> 8; const long tk = tok0 - 128 + key; const bool ok = (n > 0) || (key >= 128);
          const bf16* vp = QKV + (size_t)(ok ? tk : tok0) * 1536 + 1280 + kvh * 64 + dh * 32;
#pragma unroll
          for (int i = 0; i < 4; ++i) { v4u q = *(const v4u*)(vp + 8 * i); if (!ok) q = (v4u){0u, 0u, 0u, 0u}; const unsigned w[4] = {q.x, q.y, q.z, q.w};
#pragma unroll
              for (int e = 0; e < 4; ++e) { VT[(dh * 32 + 8 * i + 2 * e) * 264 + key] = (bf16)(w[e] & 0xffffu); VT[(dh * 32 + 8 * i + 2 * e + 1) * 264 + key] = (bf16)(w[e] >> 16); } } }
        __syncthreads();
        const int g = wave >> 1, qh = wave & 1, hq = kvh * 4 + g; const float sink = sinks[hq];
        for (int mt = 0; mt < 4; ++mt) {
            const int qi = qh * 64 + mt * 16 + fr;
            bf16x8 qf[2];
            { float x[16]; float ss = 0.f; const bf16* qp = QKV + (size_t)(tok0 + qi) * 1536 + hq * 64 + 8 * fq;
#pragma unroll
              for (int ks = 0; ks < 2; ++ks) { const v4u q = *(const v4u*)(qp + 32 * ks); const unsigned w[4] = {q.x, q.y, q.z, q.w};
#pragma unroll
                  for (int e = 0; e < 4; ++e) { x[8 * ks + 2 * e] = bflo(w[e]); x[8 * ks + 2 * e + 1] = bfhi(w[e]); } }
#pragma unroll
              for (int i = 0; i < 16; ++i) ss += x[i] * x[i];
              ss += __shfl_xor(ss, 16); ss += __shfl_xor(ss, 32);
              const float rstd = __builtin_amdgcn_rsqf(ss * (1.0f / 64.0f) + EPS) * 0.125f;
#pragma unroll
              for (int ks = 0; ks < 2; ++ks) { float o[8];
#pragma unroll
                  for (int e = 0; e < 8; ++e) o[e] = x[8 * ks + e] * rstd * q_norm[32 * ks + 8 * fq + e];
                  v4u w; w.x = pk2(o[0], o[1]); w.y = pk2(o[2], o[3]); w.z = pk2(o[4], o[5]); w.w = pk2(o[6], o[7]); qf[ks] = __builtin_bit_cast(bf16x8, w); } }
            f32x4 s[16]; float mx = -INFINITY;
#pragma unroll
            for (int nt = 0; nt < 16; ++nt) { f32x4 a = {0.f, 0.f, 0.f, 0.f};
#pragma unroll
                for (int ks = 0; ks < 2; ++ks) { const bf16x8 kf = *(const LAS bf16x8*)(KL + (16 * nt + fr) * 72 + 32 * ks + 8 * fq); a = __builtin_amdgcn_mfma_f32_16x16x32_bf16(kf, qf[ks], a, 0, 0, 0); }
#pragma unroll
                for (int i = 0; i < 4; ++i) { const int kj = 16 * nt + 4 * fq + i; const bool valid = (kj > qi) && (kj <= qi + 128) && ((n > 0) || (kj >= 128)); a[i] = valid ? a[i] : -INFINITY; mx = fmaxf(mx, a[i]); }
                s[nt] = a; }
            mx = fmaxf(mx, __shfl_xor(mx, 16)); mx = fmaxf(mx, __shfl_xor(mx, 32)); mx = fmaxf(mx, sink);
            float l = 0.f;
#pragma unroll
            for (int nt = 0; nt < 16; ++nt)
#pragma unroll
                for (int i = 0; i < 4; ++i) { const float p = fast_exp(s[nt][i] - mx); s[nt][i] = p; l += p; }
            l += __shfl_xor(l, 16); l += __shfl_xor(l, 32); l += fast_exp(sink - mx);
            f32x4 o[4];
#pragma unroll
            for (int dt = 0; dt < 4; ++dt) o[dt] = (f32x4){0.f, 0.f, 0.f, 0.f};
#pragma unroll
            for (int st = 0; st < 8; ++st) {
                v4u pw; pw.x = pk2(s[2 * st][0], s[2 * st][1]); pw.y = pk2(s[2 * st][2], s[2 * st][3]); pw.z = pk2(s[2 * st + 1][0], s[2 * st + 1][1]); pw.w = pk2(s[2 * st + 1][2], s[2 * st + 1][3]);
                const bf16x8 pf = __builtin_bit_cast(bf16x8, pw);
#pragma unroll
                for (int dt = 0; dt < 4; ++dt) { const LAS bf16* vp = VT + (16 * dt + fr) * 264 + 32 * st + 4 * fq;
                    const v2u v0 = *(const LAS v2u*)vp, v1 = *(const LAS v2u*)(vp + 16); v4u vw; vw.x = v0.x; vw.y = v0.y; vw.z = v1.x; vw.w = v1.y;
                    o[dt] = __builtin_amdgcn_mfma_f32_16x16x32_bf16(__builtin_bit_cast(bf16x8, vw), pf, o[dt], 0, 0, 0); } }
            const float inv = 1.0f / l;
#pragma unroll
            for (int dt = 0; dt < 4; ++dt) { v2u w; w.x = pk2(o[dt][0] * inv, o[dt][1] * inv); w.y = pk2(o[dt][2] * inv, o[dt][3] * inv);
                *(v2u*)(O + (size_t)(tok0 + qi) * 1024 + hq * 64 + 16 * dt + 4 * fq) = w; }
        }
        __syncthreads();
    }
}

__device__ __forceinline__ void phase_dn_prep(const Args& args) {
    int tid_ = threadIdx.x; asm volatile("" : "+v"(tid_)); const int tid = tid_, lane = tid & 63, wave = __builtin_amdgcn_readfirstlane(tid >> 6), G = gridDim.x, bid = blockIdx.x; (void)tid; (void)lane; (void)wave;
    unsigned char* ws = uni_ptr(args.ws); const float* conv_w = args.in[20]; const float* a_log = args.in[21]; const float* dt_bias = args.in[22];
    const bf16* QKV = (const bf16*)(ws + WS_ACT + A_QKV); float* QN = (float*)(ws + WS_ACT + A_QN); float* KN = (float*)(ws + WS_ACT + A_KN); bf16* VV = (bf16*)(ws + WS_ACT + A_VV);
    const float* BA = (const float*)(ws + WS_BA); float* DNB = (float*)(ws + WS_DNB);
    for (int t = bid * NWAVES + wave; t < T; t += G * NWAVES) { const int pos = t % SEQ;
#pragma unroll
        for (int j = 0; j < 4; ++j) { const int ch = 8 * lane + 512 * j; float a[8];
#pragma unroll
            for (int e = 0; e < 8; ++e) a[e] = 0.f;
#pragma unroll
            for (int tap = 0; tap < 4; ++tap) { if (pos - 3 + tap >= 0) { const v4u q = *(const v4u*)(QKV + (size_t)(t - 3 + tap) * 2048 + ch); const f32x4 w0 = *(const f32x4*)(conv_w + tap * 2048 + ch), w1 = *(const f32x4*)(conv_w + tap * 2048 + ch + 4);
                a[0] += w0[0] * bflo(q.x); a[1] += w0[1] * bfhi(q.x); a[2] += w0[2] * bflo(q.y); a[3] += w0[3] * bfhi(q.y); a[4] += w1[0] * bflo(q.z); a[5] += w1[1] * bfhi(q.z); a[6] += w1[2] * bflo(q.w); a[7] += w1[3] * bfhi(q.w); } }
            float ss = 0.f;
#pragma unroll
            for (int e = 0; e < 8; ++e) { a[e] = siluf_(a[e]); ss += a[e] * a[e]; }
            if (j < 2) { ss += __shfl_xor(ss, 1); ss += __shfl_xor(ss, 2); ss += __shfl_xor(ss, 4); ss += __shfl_xor(ss, 8);
                const float r = __builtin_amdgcn_rsqf(ss + EPS); float* dst = (j == 0 ? QN : KN) + (size_t)t * 512 + 8 * lane;
                *(f32x4*)dst = (f32x4){a[0] * r, a[1] * r, a[2] * r, a[3] * r}; *(f32x4*)(dst + 4) = (f32x4){a[4] * r, a[5] * r, a[6] * r, a[7] * r}; }
            else { v4u w; w.x = pk2(a[0], a[1]); w.y = pk2(a[2], a[3]); w.z = pk2(a[4], a[5]); w.w = pk2(a[6], a[7]); *(v4u*)(VV + (size_t)t * 1024 + 8 * lane + 512 * (j - 2)) = w; } }
        if (lane < 8) { const float bi = BA[(size_t)t * 16 + lane], ai = BA[(size_t)t * 16 + 8 + lane] + dt_bias[lane];
            const float sp = fmaxf(ai, 0.f) + log1pf(expf(-fabsf(ai)));
            DNB[(size_t)t * 16 + lane] = 1.0f / (1.0f + expf(-bi)); DNB[(size_t)t * 16 + 8 + lane] = -expf(a_log[lane]) * sp; }
    }
}
__device__ __forceinline__ void phase_dn_scan_naive(const Args& args, LAS unsigned char* lds) {
    int tid_ = threadIdx.x; asm volatile("" : "+v"(tid_)); const int tid = tid_, lane = tid & 63, wave = __builtin_amdgcn_readfirstlane(tid >> 6), G = gridDim.x, bid = blockIdx.x; (void)tid; (void)lane; (void)wave;
    unsigned char* ws = uni_ptr(args.ws);
    const float* QN = (const float*)(ws + WS_ACT + A_QN); const float* KN = (const float*)(ws + WS_ACT + A_KN); const bf16* VV = (const bf16*)(ws + WS_ACT + A_VV);
    const float* DNB = (const float*)(ws + WS_DNB); bf16* O = (bf16*)(ws + WS_ACT + A_O);
    LAS float* kq = (LAS float*)lds;
    LAS float* vv = (LAS float*)(lds + 65536);
    LAS float* bg = (LAS float*)(lds + 98304);
    const int e = tid >> 1, hf = tid & 1;
    for (int it = bid; it < 16; it += G) {
        const int b = it >> 3, hv = it & 7, hq = hv >> 1;
        float s[64];
#pragma unroll
        for (int d = 0; d < 64; ++d) s[d] = 0.f;
        for (int nn = 0; nn < SEQ / 64; ++nn) { const size_t t0 = (size_t)b * SEQ + (size_t)nn * 64;
            __syncthreads();
            for (int i = tid; i < 64 * 64; i += NTHR) { const int tk = i >> 6, c4 = (i & 63) * 4;
                const float* src = (c4 < 128 ? KN : QN) + (t0 + tk) * 512 + hq * 128 + (c4 & 127);
                *(LAS f32x4*)(kq + tk * 256 + c4) = *(const f32x4*)src; }
            for (int i = tid; i < 64 * 128; i += NTHR) { const int tk = i >> 7, ee = i & 127; vv[i] = bf1(VV[(t0 + tk) * 1024 + hv * 128 + ee]); }
            if (tid < 64) { bg[tid * 2] = DNB[(t0 + tid) * 16 + hv]; bg[tid * 2 + 1] = expf(DNB[(t0 + tid) * 16 + 8 + hv]); }
            __syncthreads();
            if (tid < 256) {
                for (int tk = 0; tk < 64; ++tk) { const LAS float* kp = kq + tk * 256 + hf * 64; const float beta = bg[tk * 2], a = bg[tk * 2 + 1]; float dot = 0.f;
#pragma unroll
                    for (int d4 = 0; d4 < 16; ++d4) { const f32x4 k4 = *(const LAS f32x4*)(kp + 4 * d4); dot += k4[0] * s[4 * d4] + k4[1] * s[4 * d4 + 1] + k4[2] * s[4 * d4 + 2] + k4[3] * s[4 * d4 + 3]; }
                    dot += __shfl_xor(dot, 1);
                    const float cc = beta * (vv[tk * 128 + e] - a * dot); float o = 0.f;
#pragma unroll
                    for (int d4 = 0; d4 < 16; ++d4) { const f32x4 k4 = *(const LAS f32x4*)(kp + 4 * d4), q4 = *(const LAS f32x4*)(kp + 128 + 4 * d4);
#pragma unroll
                        for (int j = 0; j < 4; ++j) { s[4 * d4 + j] = a * s[4 * d4 + j] + k4[j] * cc; o += q4[j] * s[4 * d4 + j]; } }
                    o += __shfl_xor(o, 1);
                    if (hf == 0) O[(t0 + tk) * 1024 + hv * 128 + e] = (bf16)(pk2(o * 0.08838834764831845f, 0.f) & 0xffffu); }
            }
        }
    }
}
__device__ __forceinline__ void phase_dn_ogate(const Args& args) {
    int tid_ = threadIdx.x; asm volatile("" : "+v"(tid_)); const int tid = tid_, lane = tid & 63, wave = __builtin_amdgcn_readfirstlane(tid >> 6), G = gridDim.x, bid = blockIdx.x; (void)tid; (void)lane; (void)wave;
    unsigned char* ws = uni_ptr(args.ws); const float* o_norm = args.in[23];
    const bf16* O = (const bf16*)(ws + WS_ACT + A_O); const bf16* Z = (const bf16*)(ws + WS_ACT + A_Z); bf16* GT = (bf16*)(ws + WS_ACT + A_H);
    for (int t = bid * NWAVES + wave; t < T; t += G * NWAVES) {
#pragma unroll
        for (int j = 0; j < 2; ++j) { const int ch = 8 * lane + 512 * j; const v4u q = *(const v4u*)(O + (size_t)t * 1024 + ch), z = *(const v4u*)(Z + (size_t)t * 1024 + ch);
            float o[8] = {bflo(q.x), bfhi(q.x), bflo(q.y), bfhi(q.y), bflo(q.z), bfhi(q.z), bflo(q.w), bfhi(q.w)}; const float zz[8] = {bflo(z.x), bfhi(z.x), bflo(z.y), bfhi(z.y), bflo(z.z), bfhi(z.z), bflo(z.w), bfhi(z.w)};
            float ss = 0.f;
#pragma unroll
            for (int e = 0; e < 8; ++e) ss += o[e] * o[e];
            ss += __shfl_xor(ss, 1); ss += __shfl_xor(ss, 2); ss += __shfl_xor(ss, 4); ss += __shfl_xor(ss, 8);
            const float r = __builtin_amdgcn_rsqf(ss * (1.0f / 128.0f) + EPS);
#pragma unroll
            for (int e = 0; e < 8; ++e) o[e] = o[e] * r * o_norm[(ch & 127) + e] * siluf_(zz[e]);
            v4u w; w.x = pk2(o[0], o[1]); w.y = pk2(o[2], o[3]); w.z = pk2(o[4], o[5]); w.w = pk2(o[6], o[7]); *(v4u*)(GT + (size_t)t * 1024 + ch) = w; }
    }
}

__device__ __forceinline__ void phase_moe_router(const Args& args, int L, LAS unsigned char* lds) {
    int tid_ = threadIdx.x; asm volatile("" : "+v"(tid_)); const int tid = tid_, lane = tid & 63, wave = __builtin_amdgcn_readfirstlane(tid >> 6), G = gridDim.x, bid = blockIdx.x; (void)tid; (void)lane; (void)wave;
    unsigned char* ws = uni_ptr(args.ws); const int ib = LBASE(L) + 4 + NMIX(L);
    const float* X = args.out; bf16* H = (bf16*)(ws + WS_ACT + A_H); const float* MOD = (const float*)(ws + WS_MOD) + (size_t)L * 2 * 6144;
    const float* nf = args.in[LBASE(L) + 1]; const float* rb = args.in[ib + 1];
    const bf16* RH = (const bf16*)(ws + WS_RTR + (size_t)L * 196608); const bf16* RLo = RH + 49152;
    int* EID = (int*)(ws + WS_EID); float* GATE = (float*)(ws + WS_GATE); int* CNT = (int*)(ws + WS_CNT);
    LAS float* gs = (LAS float*)lds; LAS float* sh = gs + 1024; LAS int* lcnt = (LAS int*)(lds + 8192); LAS float* scr = (LAS float*)(lds + 8448 + wave * 3072);
    const int r = lane & 15, q = lane >> 4;
    for (int item = bid; item < T / 128; item += G) {
        const int r0 = item * 128, b = r0 / SEQ; const float* m = MOD + (size_t)b * 6144;
        __syncthreads();
        for (int k = tid; k < 1024; k += NTHR) { gs[k] = nf[k] * (1.0f + m[4096 + k]); sh[k] = m[3072 + k]; }
        if (tid < 32) lcnt[tid] = 0;
        __syncthreads();
        const int row = r0 + 16 * wave + r; const float* xp = X + (size_t)row * 1024 + 8 * q;
        float ss = 0.f;
#pragma unroll 8
        for (int j = 0; j < 32; ++j) { const f32x4 v0 = *(const f32x4*)(xp + 32 * j), v1 = *(const f32x4*)(xp + 32 * j + 4); ss += (v0[0] * v0[0] + v0[1] * v0[1]) + (v0[2] * v0[2] + v0[3] * v0[3]) + (v1[0] * v1[0] + v1[1] * v1[1]) + (v1[2] * v1[2] + v1[3] * v1[3]); }
        ss += __shfl_xor(ss, 16); ss += __shfl_xor(ss, 32);
        const float rstd = __builtin_amdgcn_rsqf(ss * (1.0f / 1024.0f) + EPS);
        f32x4 acc[3];
#pragma unroll
        for (int nt = 0; nt < 3; ++nt) acc[nt] = (f32x4){0.f, 0.f, 0.f, 0.f};
#pragma unroll 2
        for (int j = 0; j < 32; ++j) { const int k0 = 32 * j + 8 * q; const f32x4 v0 = *(const f32x4*)(xp + 32 * j), v1 = *(const f32x4*)(xp + 32 * j + 4);
            const f32x4 g0 = *(const LAS f32x4*)(gs + k0), g1 = *(const LAS f32x4*)(gs + k0 + 4), s0 = *(const LAS f32x4*)(sh + k0), s1 = *(const LAS f32x4*)(sh + k0 + 4);
            const f32x4 h0 = v0 * rstd * g0 + s0, h1 = v1 * rstd * g1 + s1;
            v4u hi; hi.x = pk2(h0[0], h0[1]); hi.y = pk2(h0[2], h0[3]); hi.z = pk2(h1[0], h1[1]); hi.w = pk2(h1[2], h1[3]);
            v4u lo; lo.x = pk2(h0[0] - bflo(hi.x), h0[1] - bfhi(hi.x)); lo.y = pk2(h0[2] - bflo(hi.y), h0[3] - bfhi(hi.y)); lo.z = pk2(h1[0] - bflo(hi.z), h1[1] - bfhi(hi.z)); lo.w = pk2(h1[2] - bflo(hi.w), h1[3] - bfhi(hi.w));
            *(v4u*)(H + (size_t)row * 1024 + k0) = hi;
            const bf16x8 ahi = __builtin_bit_cast(bf16x8, hi), alo = __builtin_bit_cast(bf16x8, lo);
#pragma unroll
            for (int nt = 0; nt < 3; ++nt) { const bf16x8 bh = *(const bf16x8*)(RH + (size_t)(nt * 16 + r) * 1024 + k0), bl = *(const bf16x8*)(RLo + (size_t)(nt * 16 + r) * 1024 + k0);
                acc[nt] = __builtin_amdgcn_mfma_f32_16x16x32_bf16(bh, ahi, acc[nt], 0, 0, 0); acc[nt] = __builtin_amdgcn_mfma_f32_16x16x32_bf16(bl, ahi, acc[nt], 0, 0, 0); acc[nt] = __builtin_amdgcn_mfma_f32_16x16x32_bf16(bh, alo, acc[nt], 0, 0, 0); } }
#pragma unroll
        for (int nt = 0; nt < 3; ++nt) *(LAS f32x4*)(scr + r * 48 + 16 * nt + 4 * q) = acc[nt];
        LDS_WAIT(); asm volatile("" ::: "memory");
        if (lane < 16) { float lg[36];
#pragma unroll
            for (int i = 0; i < 9; ++i) { const f32x4 v = *(const LAS f32x4*)(scr + r * 48 + 4 * i); lg[4 * i] = v[0] + rb[4 * i]; lg[4 * i + 1] = v[1] + rb[4 * i + 1]; lg[4 * i + 2] = v[2] + rb[4 * i + 2]; lg[4 * i + 3] = v[3] + rb[4 * i + 3]; }
            int gsel = 0; float gm = lg[0];
#pragma unroll
            for (int i = 1; i < 4; ++i) if (lg[i] > gm) { gm = lg[i]; gsel = i; }
            float gsum = 0.f;
#pragma unroll
            for (int i = 0; i < 4; ++i) gsum += expf(lg[i] - gm);
            const float pg = 1.0f / gsum;
            float le[8];
#pragma unroll
            for (int i = 0; i < 8; ++i) le[i] = gsel == 0 ? lg[4 + i] : (gsel == 1 ? lg[12 + i] : (gsel == 2 ? lg[20 + i] : lg[28 + i]));
            int j1 = 0; float m1 = le[0];
#pragma unroll
            for (int i = 1; i < 8; ++i) if (le[i] > m1) { m1 = le[i]; j1 = i; }
            int j2 = -1; float m2 = -INFINITY;
#pragma unroll
            for (int i = 0; i < 8; ++i) if (i != j1 && le[i] > m2) { m2 = le[i]; j2 = i; }
            const float p2 = expf(m2 - m1), den = 1.0f / (1.0f + p2);
            const int e1 = gsel * 8 + j1, e2 = gsel * 8 + j2;
            EID[(size_t)row * 2] = e1; EID[(size_t)row * 2 + 1] = e2; GATE[(size_t)row * 2] = pg * den; GATE[(size_t)row * 2 + 1] = pg * p2 * den;
            __hip_atomic_fetch_add(lcnt + e1, 1, __ATOMIC_RELAXED, __HIP_MEMORY_SCOPE_WORKGROUP); __hip_atomic_fetch_add(lcnt + e2, 1, __ATOMIC_RELAXED, __HIP_MEMORY_SCOPE_WORKGROUP); }
        __syncthreads();
        if (tid < 32) CNT[item * 32 + tid] = lcnt[tid];
    }
}
__device__ __forceinline__ void phase_moe_scatter(const Args& args, LAS unsigned char* lds) {
    int tid_ = threadIdx.x; asm volatile("" : "+v"(tid_)); const int tid = tid_, lane = tid & 63, wave = __builtin_amdgcn_readfirstlane(tid >> 6), G = gridDim.x, bid = blockIdx.x; (void)tid; (void)lane; (void)wave;
    unsigned char* ws = uni_ptr(args.ws);
    const bf16* H = (const bf16*)(ws + WS_ACT + A_H); bf16* XG = (bf16*)(ws + WS_ACT + A_XG);
    const int* EID = (const int*)(ws + WS_EID); int* SLOT = (int*)(ws + WS_SLOT); const int* CNT = (const int*)(ws + WS_CNT); int* TILEE = (int*)(ws + WS_TILEE);
    LAS int* tot = (LAS int*)lds; LAS int* before = tot + 32; LAS int* pstart = tot + 64; LAS int* lcnt = tot + 96; LAS int* lslot = tot + 128;
    for (int item = bid; item < T / 128; item += G) {
        const int r0 = item * 128;
        __syncthreads();
        if (tid < 32) { int t_ = 0, b_ = 0;
            for (int w = 0; w < T / 128; ++w) { const int c = CNT[w * 32 + tid]; t_ += c; b_ += (w < item) ? c : 0; }
            tot[tid] = t_; before[tid] = b_; lcnt[tid] = 0; }
        __syncthreads();
        if (tid == 0) { int ps = 0; for (int e = 0; e < 32; ++e) { pstart[e] = ps; ps += (tot[e] + 255) & ~255; }
            if (item == 0) { TILEE[0] = ps >> 8; for (int e = 0; e < 32; ++e) { const int t0 = pstart[e] >> 8, nt = ((tot[e] + 255) >> 8); for (int i = 0; i < nt; ++i) TILEE[16 + t0 + i] = e; } } }
        __syncthreads();
        if (tid < 256) { const int e = EID[(size_t)r0 * 2 + tid]; const int rank = __hip_atomic_fetch_add(lcnt + e, 1, __ATOMIC_RELAXED, __HIP_MEMORY_SCOPE_WORKGROUP); const int slot = pstart[e] + before[e] + rank; SLOT[(size_t)r0 * 2 + tid] = slot; lslot[tid] = slot; }
        __syncthreads();
        for (int rr = 0; rr < 16; ++rr) { const int row = 16 * wave + rr; const bf16* src = H + (size_t)(r0 + row) * 1024;
            const v4u a = *(const v4u*)(src + 8 * lane), c = *(const v4u*)(src + 512 + 8 * lane); const int s0 = lslot[2 * row], s1 = lslot[2 * row + 1];
            bf16* d0 = XG + (size_t)s0 * 1024; bf16* d1 = XG + (size_t)s1 * 1024;
            *(v4u*)(d0 + 8 * lane) = a; *(v4u*)(d0 + 512 + 8 * lane) = c; *(v4u*)(d1 + 8 * lane) = a; *(v4u*)(d1 + 512 + 8 * lane) = c; }
        { const int e = item & 31, part = item >> 5; const int p0 = pstart[e] + tot[e], npad = ((tot[e] + 255) & ~255) - tot[e]; const v4u z = {0u, 0u, 0u, 0u};
          for (int pr = part * 8 + wave; pr < npad; pr += 64) { bf16* d = XG + (size_t)(p0 + pr) * 1024; *(v4u*)(d + 8 * lane) = z; *(v4u*)(d + 512 + 8 * lane) = z; } }
    }
}
__device__ __forceinline__ void phase_moe_combine(const Args& args, int L) {
    int tid_ = threadIdx.x; asm volatile("" : "+v"(tid_)); const int tid = tid_, lane = tid & 63, wave = __builtin_amdgcn_readfirstlane(tid >> 6), G = gridDim.x, bid = blockIdx.x; (void)tid; (void)lane; (void)wave;
    unsigned char* ws = uni_ptr(args.ws); float* X = args.out; const bf16* Y = (const bf16*)(ws + WS_ACT + A_Y); bf16* H = (bf16*)(ws + WS_ACT + A_H);
    const int* SLOT = (const int*)(ws + WS_SLOT); const float* GATE = (const float*)(ws + WS_GATE); const float* MOD = (const float*)(ws + WS_MOD);
    for (int t = bid * NWAVES + wave; t < T; t += G * NWAVES) { const int b = t / SEQ;
        const int s0 = SLOT[(size_t)t * 2], s1 = SLOT[(size_t)t * 2 + 1]; const float g0 = GATE[(size_t)t * 2], g1 = GATE[(size_t)t * 2 + 1];
        const float* gf = MOD + (size_t)(L * 2 + b) * 6144 + 5120; f32x4 v[4];
#pragma unroll
        for (int j = 0; j < 4; ++j) { const int c = 4 * lane + 256 * j; const f32x4 x = *(const f32x4*)(X + (size_t)t * 1024 + c), gg = *(const f32x4*)(gf + c);
            const v2u y0 = *(const v2u*)(Y + (size_t)s0 * 1024 + c), y1 = *(const v2u*)(Y + (size_t)s1 * 1024 + c);
            f32x4 mo; mo[0] = g0 * bflo(y0.x) + g1 * bflo(y1.x); mo[1] = g0 * bfhi(y0.x) + g1 * bfhi(y1.x); mo[2] = g0 * bflo(y0.y) + g1 * bflo(y1.y); mo[3] = g0 * bfhi(y0.y) + g1 * bfhi(y1.y);
            v[j] = x + gg * mo; *(f32x4*)(X + (size_t)t * 1024 + c) = v[j]; }
        if (L < 3) { const float* m = MOD + (size_t)((L + 1) * 2 + b) * 6144; norm_store_row(v, args.in[LBASE(L + 1)], m, m + 1024, H + (size_t)t * 1024, lane); }
    }
}

constexpr int N_PHASES = 36;

#define PHASE(k) if ((lo <= (k) && (k) < hi) && ((started ? (xcd_barrier(bar), 0) : 0), started = true, true))
template <int L> __device__ __forceinline__ void run_layer(const Args& args, LAS unsigned char* lds, const XcdBarrier& bar, bool& started, const int lo, const int hi) {
    const int G = gridDim.x, bid = blockIdx.x;
    unsigned char* ws = uni_ptr(args.ws);
    const float* MOD = (const float*)(ws + WS_MOD);
    bf16* Hb = (bf16*)(ws + WS_ACT + A_H);

        const int pb = (L == 0) ? 1 : (L == 1 ? 10 : (L == 2 ? 20 : 28));
        const float* xsrc = (L == 0) ? args.in[0] : (const float*)args.out;
        const float* gate_m = MOD + (size_t)L * 2 * 6144 + 2048;
        int mb;
        if constexpr (L == 0 || L == 3) {
            int g0 = pb;
            if (L == 0) { PHASE(pb) { phase_norm0(args); } g0 = pb + 1; }
            const bf16* Win = (const bf16*)(ws + WS_WMIX + (L == 0 ? WMIX_GM_IN0 : WMIX_GM_IN3)); const bf16* Wout = (const bf16*)(ws + WS_WMIX + (L == 0 ? WMIX_GM_OUT0 : WMIX_GM_OUT3));
            PHASE(g0) { pg8::Gemm g{Hb, Win, T, 2048, 1024}; pg8::StaticOrder S; S.init(T, 2048, G, bid);
                EpiGm1 E{(bf16*)(ws + WS_ACT + A_U), (bf16*)(ws + WS_ACT + A_V), (float*)(ws + WS_VSSP)};
                pg8::gemm_phase<EpiGm1, pg8::StaticOrder, true, true>(lds, g, S, E); }
            PHASE(g0 + 1) { phase_gm_spatial(args, L, lds); }
            PHASE(g0 + 2) { pg8::Gemm g{(const bf16*)(ws + WS_ACT + A_GATED), Wout, T, 1024, 1024}; pg8::StaticOrder S; S.init(T, 1024, G, bid);
                EpiRes E{xsrc, args.out, gate_m};
                pg8::gemm_phase<EpiRes, pg8::StaticOrder, true, true>(lds, g, S, E); }
            mb = g0 + 3;
        } else if constexpr (L == 1) {
            PHASE(pb) { pg8::Gemm g{Hb, (const bf16*)(ws + WS_WMIX + WMIX_DN_IN), T, 3328, 1024}; pg8::StaticOrder S; S.init(T, 3328, G, bid);
                EpiDn1 E{(bf16*)(ws + WS_ACT + A_QKV), (bf16*)(ws + WS_ACT + A_Z), (float*)(ws + WS_BA)};
                pg8::gemm_phase<EpiDn1, pg8::StaticOrder, true, true>(lds, g, S, E); }
            PHASE(pb + 1) { phase_dn_prep(args); }
            PHASE(pb + 2) { phase_dn_scan_naive(args, lds); }
            PHASE(pb + 3) { phase_dn_ogate(args); }
            PHASE(pb + 4) { pg8::Gemm g{Hb, (const bf16*)(ws + WS_WMIX + WMIX_DN_OUT), T, 1024, 1024}; pg8::StaticOrder S; S.init(T, 1024, G, bid);
                EpiRes E{xsrc, args.out, gate_m};
                pg8::gemm_phase<EpiRes, pg8::StaticOrder, true, true>(lds, g, S, E); }
            mb = pb + 5;
        } else {
            PHASE(pb) { pg8::Gemm g{Hb, (const bf16*)(ws + WS_WMIX + WMIX_SWA_IN), T, 1536, 1024}; pg8::StaticOrder S; S.init(T, 1536, G, bid);
                EpiBf E{(bf16*)(ws + WS_ACT + A_QKV), 1536, 0xffff};
                pg8::gemm_phase<EpiBf, pg8::StaticOrder, true, true>(lds, g, S, E); }
            PHASE(pb + 1) { phase_swa_attn(args, lds); }
            PHASE(pb + 2) { pg8::Gemm g{Hb, (const bf16*)(ws + WS_WMIX + WMIX_SWA_OUT), T, 1024, 1024}; pg8::StaticOrder S; S.init(T, 1024, G, bid);
                EpiRes E{xsrc, args.out, gate_m};
                pg8::gemm_phase<EpiRes, pg8::StaticOrder, true, true>(lds, g, S, E); }
            mb = pb + 3;
        }
        PHASE(mb) { phase_moe_router(args, L, lds); }
        PHASE(mb + 1) { phase_moe_scatter(args, lds); }
        const int* TILEE = (const int*)(ws + WS_TILEE);
        PHASE(mb + 2) { const int ntiles = TILEE[0]; pg8::Gemm g{(const bf16*)(ws + WS_ACT + A_XG), (const bf16*)(ws + WS_W + (size_t)L * 96 * MiB), MAXROWS, 1024, 1024};
            MoeOrder S; S.init(TILEE + 16, ntiles, G, bid); EpiMoe1 E{(bf16*)(ws + WS_ACT + A_ACTV)};
            pg8::gemm_phase<EpiMoe1, MoeOrder, true, true>(lds, g, S, E); }
        PHASE(mb + 3) { const int ntiles = TILEE[0]; pg8::Gemm g{(const bf16*)(ws + WS_ACT + A_ACTV), (const bf16*)(ws + WS_W + (size_t)L * 96 * MiB + 64 * MiB), MAXROWS, 1024, 512};
            MoeOrder S; S.init(TILEE + 16, ntiles, G, bid); EpiBf E{(bf16*)(ws + WS_ACT + A_Y), 1024, 3};
            pg8::gemm_phase<EpiBf, MoeOrder, true, true>(lds, g, S, E); }
        PHASE(mb + 4) { phase_moe_combine(args, L); }

}
__global__ void __launch_bounds__(NTHR, 2) fwd_kernel(Args args) {
    extern __shared__ __attribute__((aligned(16))) unsigned char lds_raw[];
    LAS unsigned char* lds = (LAS unsigned char*)lds_raw;
    const int tid = threadIdx.x;
    unsigned char* ws = uni_ptr(args.ws);
    for (int u = tid; u < (LDS_BYTES - LDSCTL_OFF) / 4; u += NTHR) ((LAS unsigned*)(lds + LDSCTL_OFF))[u] = 0u;
    __syncthreads();
    volatile LAS unsigned* MISC = (volatile LAS unsigned*)(lds + MISC_OFF);
    XcdBarrier bar = xcd_barrier_post((unsigned*)(ws + WS_CTL) + 4096 + (size_t)args.li * XCD_BAR_WORDS, MISC + 8);
    const int lo = args.ph_lo, hi = args.ph_hi; bool started = false;
    const float* MOD = (const float*)(ws + WS_MOD);
    bf16* Hb = (bf16*)(ws + WS_ACT + A_H);

    PHASE(0) { phase_prologue(args, lds); }

    run_layer<0>(args, lds, bar, started, lo, hi);
    run_layer<1>(args, lds, bar, started, lo, hi);
    run_layer<2>(args, lds, bar, started, lo, hi);
    run_layer<3>(args, lds, bar, started, lo, hi);
#undef PHASE
}

extern "C" void kernel_launch(void* const* d_in, const int* in_sizes, int n_in, void* d_out, int out_size, void* d_ws, size_t ws_size, hipStream_t stream) {
    static int grid = 0;
    if (grid == 0) {
        if (n_in != N_IN || in_sizes[0] != T * D || out_size != T * D || ws_size < WS_END) { fprintf(stderr, "kernel_launch: unexpected shapes (n_in %d, in0 %d, out %d, ws %zu < %zu)\n", n_in, n_in > 0 ? in_sizes[0] : -1, out_size, ws_size, (size_t)WS_END); grid = -1; return; }
        int dev = 0, cus = 0, per_cu = 0;
        if (hipGetDevice(&dev) != hipSuccess || hipDeviceGetAttribute(&cus, hipDeviceAttributeMultiprocessorCount, dev) != hipSuccess) { grid = -1; return; }
        if (hipFuncSetAttribute((const void*)fwd_kernel, hipFuncAttributeMaxDynamicSharedMemorySize, LDS_BYTES) != hipSuccess) { fprintf(stderr, "kernel_launch: hipFuncSetAttribute failed\n"); grid = -1; return; }
        if (hipOccupancyMaxActiveBlocksPerMultiprocessor(&per_cu, (const void*)fwd_kernel, NTHR, LDS_BYTES) != hipSuccess || per_cu < 1) fprintf(stderr, "kernel_launch: occupancy query reports %d\n", per_cu);
        (void)hipGetLastError();
        grid = cus;
    }
    if (grid < 0) return;
    if (hipMemsetAsync((char*)d_ws + WS_CTL, 0, CTL_ZERO_BYTES, stream) != hipSuccess) return;
    Args a{};
    for (int i = 0; i < N_IN; ++i) a.in[i] = (const float*)d_in[i];
    a.out = (float*)d_out; a.ws = (unsigned char*)d_ws; a.pad = 0;
#if MK_LAUNCH_MODE == 1
    a.ph_lo = 0; a.ph_hi = N_PHASES; a.li = 0;
    hipLaunchKernelGGL(fwd_kernel, dim3(grid), dim3(NTHR), LDS_BYTES, stream, a);
#else
    for (int p = 0; p < N_PHASES; ++p) { a.ph_lo = p; a.ph_hi = p + 1; a.li = 0;
        hipLaunchKernelGGL(fwd_kernel, dim3(grid), dim3(NTHR), LDS_BYTES, stream, a); }
#endif
}
```

```cpp
#include <hip/hip_runtime.h>
#include <cstdio>
#include <cstdint>
#ifndef MK_LAUNCH_MODE
#define MK_LAUNCH_MODE 1
#endif
namespace pg8 {
#define PG8_LAS __attribute__((address_space(3)))
typedef unsigned short bf16_t;
typedef short bf16x8 __attribute__((ext_vector_type(8)));
typedef float f32x4 __attribute__((ext_vector_type(4)));
typedef unsigned u32x4 __attribute__((ext_vector_type(4)));
constexpr int BM = 256, BK = 64, HALF = 128, HTB = HALF * BK * 2  , STAGE_BYTES = 8 * HTB, NXCD = 8, WGM = 8;

__host__ __device__ __forceinline__ int lds_byte(int r, int c) { const int st = (r >> 4) * 2 + (c >> 5), rr = r & 15, cc = c & 31, ob = rr * 64 + cc * 2; return st * 1024 + (ob ^ (((ob >> 9) & 1) << 5)); }
__host__ __device__ __forceinline__ void stage_rc(int b, int& R, int& C) { const int st = b / 1024, sb = b % 1024, swz = sb ^ (((sb >> 9) & 1) << 5); R = (st >> 1) * 16 + swz / 64; C = (st & 1) * 32 + (swz % 64) / 2; }
__host__ __device__ __forceinline__ int perm32(int rho) { const int n = rho >> 4, i = rho & 15; return 8 * (i >> 2) + 4 * n + (i & 3); }

struct Unit { int pm, pn; };
struct Gemm { const bf16_t* A; const bf16_t* Bt; int M, N, K; };

struct StaticOrder {
    int nM, nN, nwg, G, c;
    __host__ __device__ void init(int M, int N, int G_, int c_) { nM = M / BM; nN = N / BM; nwg = nM * nN; G = G_; c = c_; }
    __host__ __device__ bool next(int i, Unit& u) const {
        const long L = (long)i * G + c; if (L >= nwg) return false;
        int wgid = (int)L; { const int q = nwg / NXCD, r = nwg % NXCD, xcd = wgid % NXCD, off = wgid / NXCD; wgid = (xcd < r ? xcd * (q + 1) : r * (q + 1) + (xcd - r) * q) + off; }
        const int nig = WGM * nN, gid = wgid / nig, fm = gid * WGM, gsz = (nM - fm) < WGM ? (nM - fm) : WGM;
        u.pm = fm + ((wgid % nig) % gsz); u.pn = (wgid % nig) / gsz; return true;
    }
    __device__ __forceinline__ void a_ready(const Unit&) const {}
    __device__ __forceinline__ void done(const Unit&) const {}
};
__device__ __forceinline__ unsigned cvt_pk_bf16(float lo, float hi) { unsigned r; asm volatile("v_cvt_pk_bf16_f32 %0, %1, %2" : "=v"(r) : "v"(lo), "v"(hi)); return r; }
typedef float f32x2 __attribute__((ext_vector_type(2)));
template <class Epi, class Sched, bool ALIGN_EPI = false, bool SP2 = false>
__device__ __forceinline__ void gemm_phase(PG8_LAS unsigned char* lds, const Gemm g, const Sched& S, const Epi& E) {
    const int tid = threadIdx.x, wid = __builtin_amdgcn_readfirstlane(tid >> 6), lane = tid & 63, wr = wid >> 2, wc = wid & 3, fr = lane & 15, fq = lane >> 4;
    const int K = g.K, nt = K / BK;
    unsigned voffA[2], voffB[2];
#pragma unroll
    for (int i = 0; i < 2; ++i) { int R, C; stage_rc(tid * 16 + i * 8192, R, C); const int Rb = Epi::PERM ? ((R & ~31) + perm32(R & 31)) : R;
        voffA[i] = (unsigned)(R * K + C) * 2u; voffB[i] = (unsigned)(Rb * K + C) * 2u; }
    const size_t kstep = (size_t)(BK * 2);
    const size_t hstep = (size_t)HALF * K * 2;
    const size_t tstep = 2 * hstep;
    const unsigned ldsw = (unsigned)wid * 1024u;
    const int aoff = lds_byte(wr * 64 + fr, fq * 8), boff = lds_byte(wc * 32 + fr, fq * 8);
#define PG8_SA(b, h) (((b) * 2 + (h)) * HTB)
#define PG8_SB(b, h) ((4 + (b) * 2 + (h)) * HTB)
#define PG8_STAGE(bufoff, gbase, voff) do { _Pragma("unroll") for (int _i = 0; _i < 2; ++_i) \
        __builtin_amdgcn_global_load_lds((const unsigned*)((const char*)(gbase) + (voff)[_i]), (PG8_LAS unsigned*)(lds + (bufoff) + ldsw + _i * 8192), 16, 0, 0); } while (0)
#define PG8_LDA(dst, b, h) do { _Pragma("unroll") for (int m = 0; m < 4; ++m) _Pragma("unroll") for (int k = 0; k < 2; ++k) dst[m][k] = *(const PG8_LAS bf16x8*)(lds + PG8_SA(b, h) + aoff + m * 2048 + k * 1024); } while (0)
#define PG8_LDB(dst, b, h) do { _Pragma("unroll") for (int n = 0; n < 2; ++n) _Pragma("unroll") for (int k = 0; k < 2; ++k) dst[n][k] = *(const PG8_LAS bf16x8*)(lds + PG8_SB(b, h) + boff + n * 2048 + k * 1024); } while (0)
#define PG8_MMA(ai, bj, At, Bt) do { __builtin_amdgcn_s_setprio(1); _Pragma("unroll") for (int m = 0; m < 4; ++m) _Pragma("unroll") for (int n = 0; n < 2; ++n) _Pragma("unroll") for (int k = 0; k < 2; ++k) \
        acc[ai][bj][m][n] = __builtin_amdgcn_mfma_f32_16x16x32_bf16(Bt[n][k], At[m][k], acc[ai][bj][m][n], 0, 0, 0); __builtin_amdgcn_s_setprio(0); } while (0)
#define PG8_WAIT_V(n) asm volatile("s_waitcnt vmcnt(" #n ")" ::: "memory")
#define PG8_WAIT_L(n) asm volatile("s_waitcnt lgkmcnt(" #n ")" ::: "memory")
#define PG8_BAR __builtin_amdgcn_s_barrier()
#define PG8_SCHED __builtin_amdgcn_sched_barrier(0)
    Unit cur, nxt; int ui = 0;
    if (!S.next(0, cur)) return;
    f32x4 acc[2][2][4][2];
#pragma unroll
    for (int a = 0; a < 2; ++a)
#pragma unroll
        for (int b = 0; b < 2; ++b)
#pragma unroll
            for (int m = 0; m < 4; ++m)
#pragma unroll
                for (int n = 0; n < 2; ++n) acc[a][b][m][n] = (f32x4){0.f, 0.f, 0.f, 0.f};
    bf16x8 At[4][2], B0[2][2], B1[2][2];
    const char* cA = (const char*)g.A + (size_t)cur.pm * tstep; const char* cB = (const char*)g.Bt + (size_t)cur.pn * tstep;
    S.a_ready(cur);
    if constexpr (SP2) {
        PG8_STAGE(PG8_SB(0, 0), cB, voffB); PG8_STAGE(PG8_SB(0, 1), cB + hstep, voffB); PG8_STAGE(PG8_SA(0, 0), cA, voffA); PG8_STAGE(PG8_SA(0, 1), cA + hstep, voffA);
        if (wr == 1) PG8_BAR;
        PG8_WAIT_V(2); PG8_BAR;
        PG8_STAGE(PG8_SB(1, 0), cB + kstep, voffB); PG8_STAGE(PG8_SA(1, 0), cA + kstep, voffA); PG8_STAGE(PG8_SB(1, 1), cB + hstep + kstep, voffB);
        PG8_WAIT_V(6); PG8_BAR;
    } else {
        PG8_STAGE(PG8_SB(0, 0), cB, voffB); PG8_STAGE(PG8_SA(0, 0), cA, voffA); PG8_STAGE(PG8_SB(0, 1), cB + hstep, voffB); PG8_STAGE(PG8_SA(0, 1), cA + hstep, voffA);
        if (wr == 1) PG8_BAR;
        PG8_WAIT_V(4); PG8_BAR;
        PG8_STAGE(PG8_SB(1, 0), cB + kstep, voffB); PG8_STAGE(PG8_SA(1, 0), cA + kstep, voffA); PG8_STAGE(PG8_SB(1, 1), cB + hstep + kstep, voffB);
        PG8_WAIT_V(6); PG8_BAR;
    }
    for (;;) {
        const bool has_next = S.next(ui + 1, nxt);
        const char* nA = has_next ? (const char*)g.A + (size_t)nxt.pm * tstep : cA; const char* nB = has_next ? (const char*)g.Bt + (size_t)nxt.pn * tstep : cB;
        for (int t = 0; t < nt; t += 2) {
            const bool last = (t == nt - 2);
            const char* a1 = cA + (size_t)(t + 1) * kstep;
            const char* a2 = last ? nA : cA + (size_t)(t + 2) * kstep; const char* b2 = last ? nB : cB + (size_t)(t + 2) * kstep;
            const char* a3 = a2 + kstep; const char* b3 = b2 + kstep;
            if (last && has_next) S.a_ready(nxt);
            if constexpr (SP2) {
            PG8_LDB(B0, 0, 0); PG8_LDB(B1, 0, 1); PG8_SCHED; PG8_LDA(At, 0, 0); PG8_STAGE(PG8_SA(1, 1), a1 + hstep, voffA);
            PG8_WAIT_V(8); PG8_WAIT_L(0); PG8_BAR; PG8_MMA(0, 0, At, B0); PG8_MMA(0, 1, At, B1); PG8_BAR; PG8_SCHED;
            PG8_LDA(At, 0, 1); PG8_STAGE(PG8_SB(0, 0), b2, voffB); PG8_STAGE(PG8_SB(0, 1), b2 + hstep, voffB); PG8_STAGE(PG8_SA(0, 0), a2, voffA);
            PG8_WAIT_V(8); PG8_WAIT_L(0); PG8_BAR; PG8_MMA(1, 0, At, B0); PG8_MMA(1, 1, At, B1); PG8_BAR; PG8_SCHED;
            PG8_LDB(B0, 1, 0); PG8_LDB(B1, 1, 1); PG8_SCHED; PG8_LDA(At, 1, 0); PG8_STAGE(PG8_SA(0, 1), a2 + hstep, voffA);
            PG8_WAIT_V(8); PG8_WAIT_L(0); PG8_BAR; PG8_MMA(0, 0, At, B0); PG8_MMA(0, 1, At, B1); PG8_BAR; PG8_SCHED;
            PG8_LDA(At, 1, 1); PG8_STAGE(PG8_SB(1, 0), b3, voffB); PG8_STAGE(PG8_SB(1, 1), b3 + hstep, voffB); PG8_STAGE(PG8_SA(1, 0), a3, voffA);
            PG8_WAIT_V(8); PG8_WAIT_L(0); PG8_BAR; PG8_MMA(1, 0, At, B0); PG8_MMA(1, 1, At, B1); PG8_BAR; PG8_SCHED;
            } else {
            PG8_LDB(B0, 0, 0); PG8_SCHED; PG8_LDA(At, 0, 0); PG8_STAGE(PG8_SA(1, 1), a1 + hstep, voffA);
            PG8_WAIT_L(8); PG8_BAR; PG8_WAIT_L(0); PG8_MMA(0, 0, At, B0); PG8_BAR; PG8_SCHED;
            PG8_LDB(B1, 0, 1); PG8_STAGE(PG8_SB(0, 0), b2, voffB);
            PG8_BAR; PG8_WAIT_L(0); PG8_MMA(0, 1, At, B1); PG8_BAR;
            PG8_LDA(At, 0, 1); PG8_STAGE(PG8_SA(0, 0), a2, voffA);
            PG8_BAR; PG8_WAIT_L(0); PG8_MMA(1, 0, At, B0); PG8_BAR; PG8_SCHED;
            PG8_STAGE(PG8_SB(0, 1), b2 + hstep, voffB);
            PG8_WAIT_V(6); PG8_BAR; PG8_MMA(1, 1, At, B1); PG8_BAR;
            PG8_LDB(B0, 1, 0); PG8_SCHED; PG8_LDA(At, 1, 0); PG8_STAGE(PG8_SA(0, 1), a2 + hstep, voffA);
            PG8_WAIT_L(8); PG8_BAR; PG8_WAIT_L(0); PG8_MMA(0, 0, At, B0); PG8_BAR; PG8_SCHED;
            PG8_LDB(B1, 1, 1); PG8_STAGE(PG8_SB(1, 0), b3, voffB);
            PG8_BAR; PG8_WAIT_L(0); PG8_MMA(0, 1, At, B1); PG8_BAR;
            PG8_LDA(At, 1, 1); PG8_STAGE(PG8_SA(1, 0), a3, voffA);
            PG8_BAR; PG8_WAIT_L(0); PG8_MMA(1, 0, At, B0); PG8_BAR; PG8_SCHED;
            PG8_STAGE(PG8_SB(1, 1), b3 + hstep, voffB);
            PG8_WAIT_V(6); PG8_BAR; PG8_MMA(1, 1, At, B1); PG8_BAR;
            }
        }
        if constexpr (ALIGN_EPI) { if (wr == 0) PG8_BAR; }
        if constexpr (!Epi::AFTER_DRAIN) { E(acc, cur, wr, wc, fr, fq); S.done(cur); }
        if (!has_next) break;
#pragma unroll
        for (int a = 0; a < 2; ++a)
#pragma unroll
            for (int b = 0; b < 2; ++b)
#pragma unroll
                for (int m = 0; m < 4; ++m)
#pragma unroll
                    for (int n = 0; n < 2; ++n) acc[a][b][m][n] = (f32x4){0.f, 0.f, 0.f, 0.f};
        cur = nxt; cA = nA; cB = nB; ++ui;
        if constexpr (ALIGN_EPI) { if (wr == 1) PG8_BAR; }
    }
    PG8_WAIT_V(0);
    if constexpr (!ALIGN_EPI) { if (wr == 0) PG8_BAR; }
    PG8_BAR;
    if constexpr (Epi::AFTER_DRAIN) { E.fused(acc, cur, wr, wc, fr, fq, lds, wid, lane); S.done(cur); }
#undef PG8_SA
#undef PG8_SB
#undef PG8_STAGE
#undef PG8_LDA
#undef PG8_LDB
#undef PG8_MMA
#undef PG8_WAIT_V
#undef PG8_WAIT_L
#undef PG8_BAR
#undef PG8_SCHED
}
}

constexpr int NB = 2, SEQ = 16384, T = NB * SEQ, D = 1024;
constexpr float EPS = 1e-6f;
constexpr int NWAVES = 8, NTHR = 512;
constexpr int N_IN = 55;
__host__ __device__ constexpr int LBASE(int L) { return L == 0 ? 2 : (L == 1 ? 15 : (L == 2 ? 29 : 42)); }
__host__ __device__ constexpr int NMIX(int L) { return L == 1 ? 6 : 5; }

constexpr size_t MiB = 1u << 20;
constexpr size_t WS_CTL = 0, CTL_ZERO_BYTES = 1 * MiB;
constexpr size_t WS_MOD = 1 * MiB;
constexpr size_t WS_CNT = WS_MOD + 256 * 1024;
constexpr size_t WS_TILEE = WS_CNT + 64 * 1024;
constexpr size_t WS_EID = 2 * MiB;
constexpr size_t WS_GATE = WS_EID + 256 * 1024;
constexpr size_t WS_SLOT = WS_GATE + 256 * 1024;
constexpr size_t WS_VSSP = 3 * MiB;
constexpr size_t WS_BA = 5 * MiB;
constexpr size_t WS_DNB = 7 * MiB;
constexpr size_t WS_RTR = 9 * MiB;
constexpr size_t WS_W = 16 * MiB;
constexpr size_t WS_WMIX = WS_W + 384 * MiB;
constexpr size_t WMIX_GM_IN0 = 0, WMIX_GM_OUT0 = 4 * MiB, WMIX_DN_IN = 6 * MiB, WMIX_DN_OUT = 13 * MiB, WMIX_SWA_IN = 15 * MiB, WMIX_SWA_OUT = 18 * MiB, WMIX_GM_IN3 = 20 * MiB, WMIX_GM_OUT3 = 24 * MiB;
constexpr size_t WS_ACT = 432 * MiB;
constexpr size_t A_H = 0;
constexpr size_t A_U = 64 * MiB, A_V = 128 * MiB, A_GATED = 192 * MiB;
constexpr size_t A_QKV = 64 * MiB, A_Z = 192 * MiB, A_QN = 256 * MiB, A_KN = 320 * MiB, A_VV = 384 * MiB, A_O = 448 * MiB;
constexpr size_t A_XG = 64 * MiB, A_ACTV = 208 * MiB, A_Y = 280 * MiB;
constexpr size_t WS_END = WS_ACT + 512 * MiB;
constexpr int MAXROWS = 73728;

constexpr int RING_BYTES = 131072;
constexpr int LDSCTL_OFF = RING_BYTES, MISC_OFF = LDSCTL_OFF + 320;
constexpr int LDS_BYTES = 147456;

#define LAS __attribute__((address_space(3)))
typedef unsigned short bf16;
typedef unsigned v4u __attribute__((ext_vector_type(4)));
typedef unsigned v2u __attribute__((ext_vector_type(2)));
typedef float f32x4 __attribute__((ext_vector_type(4)));
typedef short bf16x8 __attribute__((ext_vector_type(8)));
typedef short bf16x4 __attribute__((ext_vector_type(4)));
#define LDS_WAIT() asm volatile("s_waitcnt lgkmcnt(0)" ::: "memory")
#define VM_WAIT() asm volatile("s_waitcnt vmcnt(0)" ::: "memory")
__device__ __forceinline__ unsigned pk2(float lo, float hi) { return pg8::cvt_pk_bf16(lo, hi); }
__device__ __forceinline__ float bflo(unsigned w) { return __uint_as_float(w << 16); }
__device__ __forceinline__ float bfhi(unsigned w) { return __uint_as_float(w & 0xffff0000u); }
__device__ __forceinline__ float bf1(unsigned short b) { return __uint_as_float(((unsigned)b) << 16); }
__device__ __forceinline__ float wave_sum(float v) {
#pragma unroll
    for (int o = 1; o < 64; o <<= 1) v += __shfl_xor(v, o);
    return v;
}
__device__ __forceinline__ float fast_exp(float x) { return __builtin_amdgcn_exp2f(x * 1.44269504089f); }
__device__ __forceinline__ float sigmoidf_(float x) { return __builtin_amdgcn_rcpf(1.0f + fast_exp(-x)); }
__device__ __forceinline__ float siluf_(float x) { return x * sigmoidf_(x); }
__device__ __forceinline__ float gelu_tanh(float x) { const float y = 1.5957691216057308f * (x + 0.044715f * x * x * x); return x * __builtin_amdgcn_rcpf(1.0f + fast_exp(-y)); }

#define RLX_AGENT __ATOMIC_RELAXED, __HIP_MEMORY_SCOPE_AGENT
__device__ __forceinline__ unsigned char* uni_ptr(unsigned char* p) { const unsigned long long w = (unsigned long long)p; const unsigned lo = __builtin_amdgcn_readfirstlane((unsigned)w), hi = __builtin_amdgcn_readfirstlane((unsigned)(w >> 32)); return (unsigned char*)(__attribute__((address_space(1))) unsigned char*)(((unsigned long long)hi << 32) | lo); }
#define XB_TMO      128
#define XB_XCNT(j)  (256  + 64 * (j))
#define XB_XSUB(j)  (1280 + 64 * (j))
#define XB_XGEN(j)  (2304 + 64 * (j))
#define XB_TOP      3328
#define XB_TOPGEN   3392
#define XCD_BAR_WORDS 3456
#define XB_SPIN_CAP (1u << 18)

__device__ __forceinline__ unsigned xb_ld(unsigned* p)              { return __hip_atomic_load(p, __ATOMIC_RELAXED, __HIP_MEMORY_SCOPE_AGENT); }
__device__ __forceinline__ unsigned xb_add(unsigned* p, unsigned v) { return __hip_atomic_fetch_add(p, v, __ATOMIC_RELAXED, __HIP_MEMORY_SCOPE_AGENT); }
__device__ __forceinline__ unsigned xb_xcc_id() { return (unsigned)__builtin_amdgcn_s_getreg((3 << 11) | 20) & 0xFu; }
#define XB_SPIN(cond, bar) do { unsigned _sp = 0; while (cond) { __builtin_amdgcn_s_sleep(1); \
    if ((++_sp & 255u) == 0u) { if (xb_ld(&(bar)[XB_TMO])) break; if (_sp > XB_SPIN_CAP) { atomicAdd(&(bar)[XB_TMO], 1u); break; } } } } while (0)

struct XcdBarrier {
    unsigned* bar; unsigned x;
    volatile LAS unsigned* st;
};

__device__ __forceinline__ XcdBarrier xcd_barrier_post(unsigned* bar, volatile LAS unsigned* st) {
    XcdBarrier b; b.bar = bar; b.x = xb_xcc_id(); b.st = st;
    if (threadIdx.x == 0) (void)xb_add(&bar[XB_XCNT(b.x)], 1u);
    return b;
}
__device__ __forceinline__ void xcd_barrier_complete(unsigned* bar, unsigned x, unsigned& nloc, unsigned& nx) {
    const unsigned G = gridDim.x * gridDim.y * gridDim.z;
    unsigned sum, cnt, mine, sp = 0u;
    for (;;) {
        sum = 0u; cnt = 0u; mine = 0u;
#pragma unroll
        for (unsigned j = 0; j < 16; ++j) { const unsigned c = xb_ld(&bar[XB_XCNT(j)]); sum += c; cnt += (c > 0u) ? 1u : 0u; mine = (j == x) ? c : mine; }
        if (sum == G) break;
        __builtin_amdgcn_s_sleep(1);
        if ((++sp & 255u) == 0u) { if (xb_ld(&bar[XB_TMO])) break; if (sp > XB_SPIN_CAP) { atomicAdd(&bar[XB_TMO], 1u); break; } }
    }
    nloc = mine > 0u ? mine : 1u; nx = cnt > 0u ? cnt : 1u;
}

__device__ __forceinline__ void xcd_barrier(const XcdBarrier& b) {
    asm volatile("s_waitcnt vmcnt(0)" ::: "memory");
    __syncthreads();
    if (threadIdx.x == 0) {
        unsigned* bar = b.bar;
        __builtin_amdgcn_s_waitcnt(0);
        unsigned nloc = b.st[0], nx = b.st[1];
        if (nloc == 0u) { xcd_barrier_complete(bar, b.x, nloc, nx); b.st[0] = nloc; b.st[1] = nx; }
        const unsigned old = xb_add(&bar[XB_XSUB(b.x)], 1u);
        const unsigned gen = old / nloc;
        if (old + 1u == (gen + 1u) * nloc) {
            __builtin_amdgcn_fence(__ATOMIC_RELEASE, "agent");
            asm volatile("s_waitcnt vmcnt(0)" ::: "memory");
            const unsigned og = xb_add(&bar[XB_TOP], 1u);
            const unsigned tg = og / nx;
            if (og + 1u == (tg + 1u) * nx) xb_add(&bar[XB_TOPGEN], 1u);
            else XB_SPIN(xb_ld(&bar[XB_TOPGEN]) == tg, bar);
            __builtin_amdgcn_fence(__ATOMIC_ACQUIRE, "agent");
            xb_add(&bar[XB_XGEN(b.x)], 1u);
            asm volatile("s_waitcnt vmcnt(0)" ::: "memory");
        } else {
            XB_SPIN(xb_ld(&bar[XB_XGEN(b.x)]) == gen, bar);
            __builtin_amdgcn_fence(__ATOMIC_ACQUIRE, "agent");
            asm volatile("s_waitcnt vmcnt(0)" ::: "memory");
        }
    }
    __syncthreads();
}

typedef const pg8::f32x4 (&AccRef)[2][2][4][2];

struct EpiGm1 {
    static constexpr bool PERM = true, AFTER_DRAIN = false;
    bf16* U; bf16* V; float* vssp;
    __device__ __forceinline__ void operator()(AccRef acc, const pg8::Unit& u, int wr, int wc, int fr, int fq) const {
        const int row0 = u.pm * 256 + wr * 64 + fr; const bool isV = u.pn >= 4; const int col0 = (u.pn & 3) * 256 + wc * 32 + 8 * fq;
        bf16* base = isV ? V : U;
#pragma unroll
        for (int ai = 0; ai < 2; ++ai)
#pragma unroll
            for (int m = 0; m < 4; ++m) { const int row = row0 + ai * 128 + m * 16; bf16* rowp = base + (size_t)row * 1024 + col0; float ss = 0.f;
#pragma unroll
                for (int bj = 0; bj < 2; ++bj) { f32x4 v0 = acc[ai][bj][m][0], v1 = acc[ai][bj][m][1];
#pragma unroll
                    for (int j = 0; j < 4; ++j) { v0[j] = gelu_tanh(v0[j]); v1[j] = gelu_tanh(v1[j]); ss += v0[j] * v0[j] + v1[j] * v1[j]; }
                    v4u w; w.x = pk2(v0[0], v0[1]); w.y = pk2(v0[2], v0[3]); w.z = pk2(v1[0], v1[1]); w.w = pk2(v1[2], v1[3]);
                    *(v4u*)(rowp + bj * 128) = w; }
                if (isV) { ss += __shfl_xor(ss, 16); ss += __shfl_xor(ss, 32); if (fq == 0) vssp[(size_t)row * 16 + (u.pn - 4) * 4 + wc] = ss; } }
    }
};
struct EpiRes {
    static constexpr bool PERM = false, AFTER_DRAIN = false;
    const float* src; float* dst; const float* gate;
    __device__ __forceinline__ void operator()(AccRef acc, const pg8::Unit& u, int wr, int wc, int fr, int fq) const {
        const int row0 = u.pm * 256 + wr * 64 + fr, col0 = u.pn * 256 + wc * 32 + 4 * fq; const int b = (u.pm * 256) / SEQ;
        f32x4 gv[2][2];
#pragma unroll
        for (int bj = 0; bj < 2; ++bj)
#pragma unroll
            for (int n = 0; n < 2; ++n) gv[bj][n] = *(const f32x4*)(gate + (size_t)b * 6144 + col0 + bj * 128 + n * 16);
#pragma unroll
        for (int ai = 0; ai < 2; ++ai)
#pragma unroll
            for (int m = 0; m < 4; ++m) { const size_t off = (size_t)(row0 + ai * 128 + m * 16) * 1024 + col0;
#pragma unroll
                for (int bj = 0; bj < 2; ++bj)
#pragma unroll
                    for (int n = 0; n < 2; ++n) { const f32x4 xs = *(const f32x4*)(src + off + bj * 128 + n * 16); *(f32x4*)(dst + off + bj * 128 + n * 16) = xs + gv[bj][n] * acc[ai][bj][m][n]; } }
    }
};
struct EpiBf {
    static constexpr bool PERM = true, AFTER_DRAIN = false;
    bf16* O; int ldc; int nmask;
    __device__ __forceinline__ void operator()(AccRef acc, const pg8::Unit& u, int wr, int wc, int fr, int fq) const {
        const int row0 = u.pm * 256 + wr * 64 + fr, col0 = (u.pn & nmask) * 256 + wc * 32 + 8 * fq;
#pragma unroll
        for (int ai = 0; ai < 2; ++ai)
#pragma unroll
            for (int m = 0; m < 4; ++m) { bf16* rowp = O + (size_t)(row0 + ai * 128 + m * 16) * ldc + col0;
#pragma unroll
                for (int bj = 0; bj < 2; ++bj) { const f32x4 v0 = acc[ai][bj][m][0], v1 = acc[ai][bj][m][1];
                    v4u w; w.x = pk2(v0[0], v0[1]); w.y = pk2(v0[2], v0[3]); w.z = pk2(v1[0], v1[1]); w.w = pk2(v1[2], v1[3]);
                    *(v4u*)(rowp + bj * 128) = w; } }
    }
};
struct EpiDn1 {
    static constexpr bool PERM = true, AFTER_DRAIN = false;
    bf16* QKV; bf16* Z; float* BA;
    __device__ __forceinline__ void operator()(AccRef acc, const pg8::Unit& u, int wr, int wc, int fr, int fq) const {
        const int row0 = u.pm * 256 + wr * 64 + fr;
        if (u.pn < 12) {
            bf16* base = u.pn < 8 ? QKV : Z; const int ldc = u.pn < 8 ? 2048 : 1024; const int col0 = (u.pn < 8 ? u.pn : u.pn - 8) * 256 + wc * 32 + 8 * fq;
#pragma unroll
            for (int ai = 0; ai < 2; ++ai)
#pragma unroll
                for (int m = 0; m < 4; ++m) { bf16* rowp = base + (size_t)(row0 + ai * 128 + m * 16) * ldc + col0;
#pragma unroll
                    for (int bj = 0; bj < 2; ++bj) { const f32x4 v0 = acc[ai][bj][m][0], v1 = acc[ai][bj][m][1];
                        v4u w; w.x = pk2(v0[0], v0[1]); w.y = pk2(v0[2], v0[3]); w.z = pk2(v1[0], v1[1]); w.w = pk2(v1[2], v1[3]);
                        *(v4u*)(rowp + bj * 128) = w; } }
        } else if (wc == 0 && fq < 2) {
#pragma unroll
            for (int ai = 0; ai < 2; ++ai)
#pragma unroll
                for (int m = 0; m < 4; ++m) { float* rowp = BA + (size_t)(row0 + ai * 128 + m * 16) * 16 + 8 * fq;
                    *(f32x4*)(rowp) = acc[ai][0][m][0]; *(f32x4*)(rowp + 4) = acc[ai][0][m][1]; }
        }
    }
};
struct EpiMoe1 {
    static constexpr bool PERM = true, AFTER_DRAIN = false;
    bf16* O;
    __device__ __forceinline__ void operator()(AccRef acc, const pg8::Unit& u, int wr, int wc, int fr, int fq) const {
        const int row0 = u.pm * 256 + wr * 64 + fr, col0 = (u.pn & 3) * 128 + wc * 32 + 8 * fq;
#pragma unroll
        for (int ai = 0; ai < 2; ++ai)
#pragma unroll
            for (int m = 0; m < 4; ++m) { bf16* rowp = O + (size_t)(row0 + ai * 128 + m * 16) * 512 + col0; float r[8];
#pragma unroll
                for (int n = 0; n < 2; ++n)
#pragma unroll
                    for (int j = 0; j < 4; ++j) { const float a = acc[ai][0][m][n][j], g = acc[ai][1][m][n][j]; r[4 * n + j] = siluf_(a) * g; }
                v4u w; w.x = pk2(r[0], r[1]); w.y = pk2(r[2], r[3]); w.z = pk2(r[4], r[5]); w.w = pk2(r[6], r[7]);
                *(v4u*)rowp = w; }
    }
};
struct MoeOrder {
    const int* tile_e; int total, G, c;
    __device__ __forceinline__ void init(const int* te, int ntiles, int G_, int c_) { tile_e = te; total = ntiles * 4; G = G_; c = c_; }
    __device__ __forceinline__ bool next(int i, pg8::Unit& u) const {
        const long Lx = (long)i * G + c; if (Lx >= total) return false;
        const int w0 = (int)Lx, q = total / 8, r = total % 8, xcd = w0 % 8, off = w0 / 8;
        const int wgid = (xcd < r ? xcd * (q + 1) : r * (q + 1) + (xcd - r) * q) + off;
        const int rt = wgid >> 2; u.pm = rt; u.pn = tile_e[rt] * 4 + (wgid & 3); return true;
    }
    __device__ __forceinline__ void a_ready(const pg8::Unit&) const {}
    __device__ __forceinline__ void done(const pg8::Unit&) const {}
};

struct Args { const float* in[N_IN]; float* out; unsigned char* ws; int ph_lo, ph_hi, li, pad; };

__device__ __forceinline__ void tr_item(const float* __restrict__ W, int ldn, int k0, int n0, bf16* __restrict__ WT, int Kd, int drow0, LAS float* scr, int lane) {
#pragma unroll 8
    for (int i = 0; i < 32; ++i) { const int kk = 2 * i + (lane >> 5); scr[kk * 33 + (lane & 31)] = W[(size_t)(k0 + kk) * ldn + n0 + (lane & 31)]; }
    LDS_WAIT(); asm volatile("" ::: "memory");
    const int c = lane & 7;
#pragma unroll
    for (int j = 0; j < 4; ++j) { const int n = (lane >> 3) + 8 * j; const LAS float* s = scr + (8 * c) * 33 + n;
        v4u o; o.x = pk2(s[0 * 33], s[1 * 33]); o.y = pk2(s[2 * 33], s[3 * 33]); o.z = pk2(s[4 * 33], s[5 * 33]); o.w = pk2(s[6 * 33], s[7 * 33]);
        *(v4u*)(WT + (size_t)(drow0 + n) * Kd + k0 + 8 * c) = o; }
    LDS_WAIT(); asm volatile("" ::: "memory");
}

__device__ __forceinline__ void phase_prologue(const Args& args, LAS unsigned char* lds) {
    int tid_ = threadIdx.x; asm volatile("" : "+v"(tid_)); const int tid = tid_, lane = tid & 63, wave = __builtin_amdgcn_readfirstlane(tid >> 6), G = gridDim.x, bid = blockIdx.x; (void)tid; (void)lane; (void)wave;
    unsigned char* ws = uni_ptr(args.ws);
    LAS float* cact = (LAS float*)(lds + 69632);
    LAS float* red = (LAS float*)(lds + 77824);
    for (int k = tid; k < 2048; k += NTHR) cact[k] = siluf_(args.in[1][k]);
    __syncthreads();
    float* MOD = (float*)(ws + WS_MOD);
    for (int item = bid; item < 384; item += G) {
        const int L = item / 96, cg = item % 96, c4 = tid & 15, ks = tid >> 4;
        const float* w = args.in[LBASE(L) + 2] + (size_t)(ks * 32) * 6144 + cg * 64 + c4 * 4;
        f32x4 a0 = {0.f, 0.f, 0.f, 0.f}, a1 = {0.f, 0.f, 0.f, 0.f};
#pragma unroll 8
        for (int kk = 0; kk < 32; ++kk) { const f32x4 wv = *(const f32x4*)(w + (size_t)kk * 6144); a0 += cact[ks * 32 + kk] * wv; a1 += cact[1024 + ks * 32 + kk] * wv; }
        *(LAS f32x4*)(red + (ks * 2 + 0) * 64 + c4 * 4) = a0; *(LAS f32x4*)(red + (ks * 2 + 1) * 64 + c4 * 4) = a1;
        __syncthreads();
        if (tid < 128) { const int b = tid >> 6, col = tid & 63; float s = 0.f;
#pragma unroll
            for (int k2 = 0; k2 < 32; ++k2) s += red[(k2 * 2 + b) * 64 + col];
            MOD[(size_t)(L * 2 + b) * 6144 + cg * 64 + col] = s + args.in[LBASE(L) + 3][cg * 64 + col]; }
        __syncthreads();
    }
    LAS float* scr = (LAS float*)(lds + wave * 8448);
    const int gw = bid * NWAVES + wave, NGW = G * NWAVES;
    constexpr int PER_L = 24576, N_EXP = 4 * PER_L, N_MIXI = 1536 + 2048 + 1280 + 1536;
    for (int it = gw; it < N_EXP + N_MIXI; it += NGW) {
        const float* src; bf16* dst; int ldn, k0, n0, Kd, drow0;
        if (it < N_EXP) {
            const int L = it / PER_L; int r = it % PER_L; const int ib = LBASE(L) + 4 + NMIX(L);
            if (r < 16384) { const int e = r >> 9, rr = r & 511; k0 = (rr >> 5) * 64; n0 = (rr & 31) * 32; ldn = 1024; Kd = 1024;
                src = args.in[ib + 2] + (size_t)e * 1048576; dst = (bf16*)(ws + WS_W + (size_t)L * 96 * MiB) + (size_t)e * 1048576;
                drow0 = (n0 < 512) ? ((n0 >> 7) * 256 + (n0 & 127)) : ((((n0 - 512) >> 7) * 256) + 128 + ((n0 - 512) & 127)); }
            else { r -= 16384; const int e = r >> 8, rr = r & 255; k0 = (rr >> 5) * 64; n0 = (rr & 31) * 32; ldn = 1024; Kd = 512;
                src = args.in[ib + 3] + (size_t)e * 524288; dst = (bf16*)(ws + WS_W + (size_t)L * 96 * MiB + 64 * MiB) + (size_t)e * 524288; drow0 = n0; }
        } else {
            int r = it - N_EXP; int idx, nblk; size_t woff;
            if (r < 1024) { idx = 6; ldn = 2048; nblk = 64; woff = WMIX_GM_IN0; }
            else if ((r -= 1024) < 512) { idx = 10; ldn = 1024; nblk = 32; woff = WMIX_GM_OUT0; }
            else if ((r -= 512) < 1536) { idx = 19; ldn = 3088; nblk = 96; woff = WMIX_DN_IN; }
            else if ((r -= 1536) < 512) { idx = 24; ldn = 1024; nblk = 32; woff = WMIX_DN_OUT; }
            else if ((r -= 512) < 768) { idx = 33; ldn = 1536; nblk = 48; woff = WMIX_SWA_IN; }
            else if ((r -= 768) < 512) { idx = 37; ldn = 1024; nblk = 32; woff = WMIX_SWA_OUT; }
            else if ((r -= 512) < 1024) { idx = 46; ldn = 2048; nblk = 64; woff = WMIX_GM_IN3; }
            else { r -= 1024; idx = 50; ldn = 1024; nblk = 32; woff = WMIX_GM_OUT3; }
            src = args.in[idx]; dst = (bf16*)(ws + WS_WMIX + woff); k0 = (r / nblk) * 64; n0 = (r % nblk) * 32; Kd = 1024; drow0 = n0;
        }
        tr_item(src, ldn, k0, n0, dst, Kd, drow0, scr, lane);
    }
    const int gt = bid * NTHR + tid, NGT = G * NTHR;
    { bf16* dst = (bf16*)(ws + WS_WMIX + WMIX_DN_IN) + (size_t)3072 * 1024; const float* w = args.in[19];
      for (int i = gt; i < 256 * 1024; i += NGT) { const int n = i >> 10, k = i & 1023; const float v = n < 16 ? w[(size_t)k * 3088 + 3072 + n] : 0.f; dst[i] = (bf16)(pk2(v, 0.f) & 0xffffu); } }
    for (int i = gt; i < 4 * 48 * 1024; i += NGT) {
        const int L = i / 49152, rem = i % 49152, n = rem >> 10, k = rem & 1023;
        const float w = n < 36 ? args.in[LBASE(L) + 4 + NMIX(L)][(size_t)k * 36 + n] : 0.f;
        const unsigned hi = pk2(w, 0.f) & 0xffffu; const float lo = w - bf1((unsigned short)hi);
        bf16* RH = (bf16*)(ws + WS_RTR + (size_t)L * 196608); RH[rem] = (bf16)hi; RH[49152 + rem] = (bf16)(pk2(lo, 0.f) & 0xffffu);
    }
}

__device__ __forceinline__ void norm_store_row(const f32x4 (&v)[4], const float* __restrict__ gain, const float* __restrict__ shift, const float* __restrict__ scale, bf16* __restrict__ hrow, int lane) {
    float ss = 0.f;
#pragma unroll
    for (int j = 0; j < 4; ++j) ss += (v[j][0] * v[j][0] + v[j][1] * v[j][1]) + (v[j][2] * v[j][2] + v[j][3] * v[j][3]);
    const float rstd = __builtin_amdgcn_rsqf(wave_sum(ss) * (1.0f / 1024.0f) + EPS);
#pragma unroll
    for (int j = 0; j < 4; ++j) { const int c = 4 * lane + 256 * j;
        const f32x4 g = *(const f32x4*)(gain + c), sc = *(const f32x4*)(scale + c), sh = *(const f32x4*)(shift + c);
        const f32x4 h = v[j] * rstd * (g * (1.0f + sc)) + sh;
        v2u w; w.x = pk2(h[0], h[1]); w.y = pk2(h[2], h[3]); *(v2u*)(hrow + c) = w; }
}
__device__ __forceinline__ void phase_norm0(const Args& args) {
    int tid_ = threadIdx.x; asm volatile("" : "+v"(tid_)); const int tid = tid_, lane = tid & 63, wave = __builtin_amdgcn_readfirstlane(tid >> 6), G = gridDim.x, bid = blockIdx.x; (void)tid; (void)lane; (void)wave;
    const float* X = args.in[0]; bf16* H = (bf16*)(args.ws + WS_ACT + A_H); const float* MOD = (const float*)(args.ws + WS_MOD);
    for (int t = bid * NWAVES + wave; t < T; t += G * NWAVES) { const int b = t / SEQ; f32x4 v[4];
#pragma unroll
        for (int j = 0; j < 4; ++j) v[j] = *(const f32x4*)(X + (size_t)t * 1024 + 4 * lane + 256 * j);
        const float* m = MOD + (size_t)b * 6144;
        norm_store_row(v, args.in[2], m, m + 1024, H + (size_t)t * 1024, lane); }
}

__device__ __forceinline__ void phase_gm_spatial(const Args& args, int L, LAS unsigned char* lds) {
    int tid_ = threadIdx.x; asm volatile("" : "+v"(tid_)); const int tid = tid_, lane = tid & 63, wave = __builtin_amdgcn_readfirstlane(tid >> 6), G = gridDim.x, bid = blockIdx.x; (void)tid; (void)lane; (void)wave;
    unsigned char* ws = uni_ptr(args.ws); const int ib = LBASE(L) + 4;
    const float* v_norm = args.in[ib + 1]; const float* w_s = args.in[ib + 2]; const float* b_s = args.in[ib + 3];
    const bf16* U = (const bf16*)(ws + WS_ACT + A_U); const bf16* V = (const bf16*)(ws + WS_ACT + A_V); bf16* GT = (bf16*)(ws + WS_ACT + A_GATED);
    const float* VSSP = (const float*)(ws + WS_VSSP);
    LAS bf16* WL = (LAS bf16*)lds; LAS bf16* VT = (LAS bf16*)(lds + 34816); LAS float* rs = (LAS float*)(lds + 69632);
    const int wr = wave >> 2, wc = wave & 3, fr = lane & 15, fq = lane >> 4;
    for (int u = bid; u < 2048; u += G) {
        const int c = u >> 3, g = u & 7; const size_t tok0 = (size_t)c * 128;
        if (tid < 128) { const float* p = VSSP + (tok0 + tid) * 16; float s = 0.f;
#pragma unroll
            for (int i = 0; i < 4; ++i) { const f32x4 q = *(const f32x4*)(p + 4 * i); s += (q[0] + q[1]) + (q[2] + q[3]); }
            rs[tid] = __builtin_amdgcn_rsqf(s * (1.0f / 1024.0f) + EPS); }
        { const int s = tid & 127, dq = tid >> 7; const bf16* vp = V + (tok0 + s) * 1024 + g * 128 + dq * 32;
#pragma unroll
          for (int i = 0; i < 4; ++i) { const v4u q = *(const v4u*)(vp + 8 * i); const unsigned w[4] = {q.x, q.y, q.z, q.w};
#pragma unroll
              for (int e = 0; e < 4; ++e) { VT[(dq * 32 + 8 * i + 2 * e) * 136 + s] = (bf16)(w[e] & 0xffffu); VT[(dq * 32 + 8 * i + 2 * e + 1) * 136 + s] = (bf16)(w[e] >> 16); } } }
        __syncthreads();
        { const int tr = tid >> 2, sq = (tid & 3) * 32; const float* wp = w_s + ((size_t)g * 128 + tr) * 128 + sq;
#pragma unroll
          for (int i = 0; i < 8; ++i) { const f32x4 q = *(const f32x4*)(wp + 4 * i); float o[4];
#pragma unroll
              for (int e = 0; e < 4; ++e) { const int s = sq + 4 * i + e; o[e] = (s <= tr) ? q[e] * rs[s] : 0.f; }
              v2u w; w.x = pk2(o[0], o[1]); w.y = pk2(o[2], o[3]); *(LAS v2u*)(WL + tr * 136 + sq + 4 * i) = w; } }
        __syncthreads();
        f32x4 acc[2][4];
#pragma unroll
        for (int n = 0; n < 2; ++n)
#pragma unroll
            for (int m = 0; m < 4; ++m) acc[n][m] = (f32x4){0.f, 0.f, 0.f, 0.f};
#pragma unroll
        for (int ks = 0; ks < 4; ++ks) { bf16x8 vf[2], wf[4];
#pragma unroll
            for (int n = 0; n < 2; ++n) vf[n] = *(const LAS bf16x8*)(VT + (32 * wc + 16 * n + fr) * 136 + 32 * ks + 8 * fq);
#pragma unroll
            for (int m = 0; m < 4; ++m) wf[m] = *(const LAS bf16x8*)(WL + (64 * wr + 16 * m + fr) * 136 + 32 * ks + 8 * fq);
#pragma unroll
            for (int n = 0; n < 2; ++n)
#pragma unroll
                for (int m = 0; m < 4; ++m) acc[n][m] = __builtin_amdgcn_mfma_f32_16x16x32_bf16(vf[n], wf[m], acc[n][m], 0, 0, 0); }
#pragma unroll
        for (int m = 0; m < 4; ++m) { const int t = 64 * wr + 16 * m + fr; const float bs = b_s[g * 128 + t];
#pragma unroll
            for (int n = 0; n < 2; ++n) { const int d0 = g * 128 + 32 * wc + 16 * n + 4 * fq; const size_t off = (tok0 + t) * 1024 + d0;
                const v2u uu = *(const v2u*)(U + off); const f32x4 vn = *(const f32x4*)(v_norm + d0);
                const float o0 = bflo(uu.x) * (acc[n][m][0] * vn[0] + bs), o1 = bfhi(uu.x) * (acc[n][m][1] * vn[1] + bs), o2 = bflo(uu.y) * (acc[n][m][2] * vn[2] + bs), o3 = bfhi(uu.y) * (acc[n][m][3] * vn[3] + bs);
                v2u w; w.x = pk2(o0, o1); w.y = pk2(o2, o3); *(v2u*)(GT + off) = w; } }
        __syncthreads();
    }
}

__device__ __forceinline__ void phase_swa_attn(const Args& args, LAS unsigned char* lds) {
    int tid_ = threadIdx.x; asm volatile("" : "+v"(tid_)); const int tid = tid_, lane = tid & 63, wave = __builtin_amdgcn_readfirstlane(tid >> 6), G = gridDim.x, bid = blockIdx.x; (void)tid; (void)lane; (void)wave;
    unsigned char* ws = uni_ptr(args.ws);
    const float* q_norm = args.in[34]; const float* k_norm = args.in[35]; const float* sinks = args.in[36];
    const bf16* QKV = (const bf16*)(ws + WS_ACT + A_QKV); bf16* O = (bf16*)(ws + WS_ACT + A_H);
    LAS bf16* KL = (LAS bf16*)lds; LAS bf16* VT = (LAS bf16*)(lds + 36864);
    const int fr = lane & 15, fq = lane >> 4;
    for (int u = bid; u < 1024; u += G) {
        const int n = u & 127, kvh = (u >> 7) & 3, b = u >> 9; const long tok0 = (long)b * SEQ + (long)n * 128;
        { const int key = tid >> 1, half = tid & 1; const long tk = tok0 - 128 + key; float x[32]; float ss = 0.f;
          const bool ok = (n > 0) || (key >= 128);
          const bf16* kp = QKV + (size_t)(ok ? tk : tok0) * 1536 + 1024 + kvh * 64 + half * 32;
#pragma unroll
          for (int i = 0; i < 4; ++i) { const v4u q = *(const v4u*)(kp + 8 * i); const unsigned w[4] = {q.x, q.y, q.z, q.w};
#pragma unroll
              for (int e = 0; e < 4; ++e) { x[8 * i + 2 * e] = bflo(w[e]); x[8 * i + 2 * e + 1] = bfhi(w[e]); } }
#pragma unroll
          for (int i = 0; i < 32; ++i) ss += x[i] * x[i];
          ss += __shfl_xor(ss, 1);
          const float rstd = ok ? __builtin_amdgcn_rsqf(ss * (1.0f / 64.0f) + EPS) : 0.f;
#pragma unroll
          for (int i = 0; i < 4; ++i) { float o[8];
#pragma unroll
              for (int e = 0; e < 8; ++e) o[e] = x[8 * i + e] * rstd * k_norm[half * 32 + 8 * i + e];
              v4u w; w.x = pk2(o[0], o[1]); w.y = pk2(o[2], o[3]); w.z = pk2(o[4], o[5]); w.w = pk2(o[6], o[7]);
              *(LAS v4u*)(KL + key * 72 + half * 32 + 8 * i) = w; } }
        { const int key = tid & 255, dh = tid >> 8; const long tk = tok0 - 128 + key; const bool ok = (n > 0) || (key >= 128);
          const bf16* vp = QKV + (size_t)(ok ? tk : tok0) * 1536 + 1280 + kvh * 64 + dh * 32;
#pragma unroll
          for (int i = 0; i < 4; ++i) { v4u q = *(const v4u*)(vp + 8 * i); if (!ok) q = (v4u){0u, 0u, 0u, 0u}; const unsigned w[4] = {q.x, q.y, q.z, q.w};
#pragma unroll
              for (int e = 0; e < 4; ++e) { VT[(dh * 32 + 8 * i + 2 * e) * 264 + key] = (bf16)(w[e] & 0xffffu); VT[(dh * 32 + 8 * i + 2 * e + 1) * 264 + key] = (bf16)(w[e] >> 16); } } }
        __syncthreads();
        const int g = wave >> 1, qh = wave & 1, hq = kvh * 4 + g; const float sink = sinks[hq];
        for (int mt = 0; mt < 4; ++mt) {
            const int qi = qh * 64 + mt * 16 + fr;
            bf16x8 qf[2];
            { float x[16]; float ss = 0.f; const bf16* qp = QKV + (size_t)(tok0 + qi) * 1536 + hq * 64 + 8 * fq;
#pragma unroll
              for (int ks = 0; ks < 2; ++ks) { const v4u q = *(const v4u*)(qp + 32 * ks); const unsigned w[4] = {q.x, q.y, q.z, q.w};
#pragma unroll
                  for (int e = 0; e < 4; ++e) { x[8 * ks + 2 * e] = bflo(w[e]); x[8 * ks + 2 * e + 1] = bfhi(w[e]); } }
#pragma unroll
              for (int i = 0; i < 16; ++i) ss += x[i] * x[i];
              ss += __shfl_xor(ss, 16); ss += __shfl_xor(ss, 32);
              const float rstd = __builtin_amdgcn_rsqf(ss * (1.0f / 64.0f) + EPS) * 0.125f;
#pragma unroll
              for (int ks = 0; ks < 2; ++ks) { float o[8];
#pragma unroll
                  for (int e = 0; e < 8; ++e) o[e] = x[8 * ks + e] * rstd * q_norm[32 * ks + 8 * fq + e];
                  v4u w; w.x = pk2(o[0], o[1]); w.y = pk2(o[2], o[3]); w.z = pk2(o[4], o[5]); w.w = pk2(o[6], o[7]); qf[ks] = __builtin_bit_cast(bf16x8, w); } }
            f32x4 s[16]; float mx = -INFINITY;
#pragma unroll
            for (int nt = 0; nt < 16; ++nt) { f32x4 a = {0.f, 0.f, 0.f, 0.f};
#pragma unroll
                for (int ks = 0; ks < 2; ++ks) { const bf16x8 kf = *(const LAS bf16x8*)(KL + (16 * nt + fr) * 72 + 32 * ks + 8 * fq); a = __builtin_amdgcn_mfma_f32_16x16x32_bf16(kf, qf[ks], a, 0, 0, 0); }
#pragma unroll
                for (int i = 0; i < 4; ++i) { const int kj = 16 * nt + 4 * fq + i; const bool valid = (kj > qi) && (kj <= qi + 128) && ((n > 0) || (kj >= 128)); a[i] = valid ? a[i] : -INFINITY; mx = fmaxf(mx, a[i]); }
                s[nt] = a; }
            mx = fmaxf(mx, __shfl_xor(mx, 16)); mx = fmaxf(mx, __shfl_xor(mx, 32)); mx = fmaxf(mx, sink);
            float l = 0.f;
#pragma unroll
            for (int nt = 0; nt < 16; ++nt)
#pragma unroll
                for (int i = 0; i < 4; ++i) { const float p = fast_exp(s[nt][i] - mx); s[nt][i] = p; l += p; }
            l += __shfl_xor(l, 16); l += __shfl_xor(l, 32); l += fast_exp(sink - mx);
            f32x4 o[4];
#pragma unroll
            for (int dt = 0; dt < 4; ++dt) o[dt] = (f32x4){0.f, 0.f, 0.f, 0.f};
#pragma unroll
            for (int st = 0; st < 8; ++st) {
                v4u pw; pw.x = pk2(s[2 * st][0], s[2 * st][1]); pw.y = pk2(s[2 * st][2], s[2 * st][3]); pw.z = pk2(s[2 * st + 1][0], s[2 * st + 1][1]); pw.w = pk2(s[2 * st + 1][2], s[2 * st + 1][3]);
                const bf16x8 pf = __builtin_bit_cast(bf16x8, pw);
#pragma unroll
                for (int dt = 0; dt < 4; ++dt) { const LAS bf16* vp = VT + (16 * dt + fr) * 264 + 32 * st + 4 * fq;
                    const v2u v0 = *(const LAS v2u*)vp, v1 = *(const LAS v2u*)(vp + 16); v4u vw; vw.x = v0.x; vw.y = v0.y; vw.z = v1.x; vw.w = v1.y;
                    o[dt] = __builtin_amdgcn_mfma_f32_16x16x32_bf16(__builtin_bit_cast(bf16x8, vw), pf, o[dt], 0, 0, 0); } }
            const float inv = 1.0f / l;
#pragma unroll
            for (int dt = 0; dt < 4; ++dt) { v2u w; w.x = pk2(o[dt][0] * inv, o[dt][1] * inv); w.y = pk2(o[dt][2] * inv, o[dt][3] * inv);
                *(v2u*)(O + (size_t)(tok0 + qi) * 1024 + hq * 64 + 16 * dt + 4 * fq) = w; }
        }
        __syncthreads();
    }
}

__device__ __forceinline__ void phase_dn_prep(const Args& args) {
    int tid_ = threadIdx.x; asm volatile("" : "+v"(tid_)); const int tid = tid_, lane = tid & 63, wave = __builtin_amdgcn_readfirstlane(tid >> 6), G = gridDim.x, bid = blockIdx.x; (void)tid; (void)lane; (void)wave;
    unsigned char* ws = uni_ptr(args.ws); const float* conv_w = args.in[20]; const float* a_log = args.in[21]; const float* dt_bias = args.in[22];
    const bf16* QKV = (const bf16*)(ws + WS_ACT + A_QKV); float* QN = (float*)(ws + WS_ACT + A_QN); float* KN = (float*)(ws + WS_ACT + A_KN); bf16* VV = (bf16*)(ws + WS_ACT + A_VV);
    const float* BA = (const float*)(ws + WS_BA); float* DNB = (float*)(ws + WS_DNB);
    for (int t = bid * NWAVES + wave; t < T; t += G * NWAVES) { const int pos = t % SEQ;
#pragma unroll
        for (int j = 0; j < 4; ++j) { const int ch = 8 * lane + 512 * j; float a[8];
#pragma unroll
            for (int e = 0; e < 8; ++e) a[e] = 0.f;
#pragma unroll
            for (int tap = 0; tap < 4; ++tap) { if (pos - 3 + tap >= 0) { const v4u q = *(const v4u*)(QKV + (size_t)(t - 3 + tap) * 2048 + ch); const f32x4 w0 = *(const f32x4*)(conv_w + tap * 2048 + ch), w1 = *(const f32x4*)(conv_w + tap * 2048 + ch + 4);
                a[0] += w0[0] * bflo(q.x); a[1] += w0[1] * bfhi(q.x); a[2] += w0[2] * bflo(q.y); a[3] += w0[3] * bfhi(q.y); a[4] += w1[0] * bflo(q.z); a[5] += w1[1] * bfhi(q.z); a[6] += w1[2] * bflo(q.w); a[7] += w1[3] * bfhi(q.w); } }
            float ss = 0.f;
#pragma unroll
            for (int e = 0; e < 8; ++e) { a[e] = siluf_(a[e]); ss += a[e] * a[e]; }
            if (j < 2) { ss += __shfl_xor(ss, 1); ss += __shfl_xor(ss, 2); ss += __shfl_xor(ss, 4); ss += __shfl_xor(ss, 8);
                const float r = __builtin_amdgcn_rsqf(ss + EPS); float* dst = (j == 0 ? QN : KN) + (size_t)t * 512 + 8 * lane;
                *(f32x4*)dst = (f32x4){a[0] * r, a[1] * r, a[2] * r, a[3] * r}; *(f32x4*)(dst + 4) = (f32x4){a[4] * r, a[5] * r, a[6] * r, a[7] * r}; }
            else { v4u w; w.x = pk2(a[0], a[1]); w.y = pk2(a[2], a[3]); w.z = pk2(a[4], a[5]); w.w = pk2(a[6], a[7]); *(v4u*)(VV + (size_t)t * 1024 + 8 * lane + 512 * (j - 2)) = w; } }
        if (lane < 8) { const float bi = BA[(size_t)t * 16 + lane], ai = BA[(size_t)t * 16 + 8 + lane] + dt_bias[lane];
            const float sp = fmaxf(ai, 0.f) + log1pf(expf(-fabsf(ai)));
            DNB[(size_t)t * 16 + lane] = 1.0f / (1.0f + expf(-bi)); DNB[(size_t)t * 16 + 8 + lane] = -expf(a_log[lane]) * sp; }
    }
}
__device__ __forceinline__ void phase_dn_scan_naive(const Args& args, LAS unsigned char* lds) {
    int tid_ = threadIdx.x; asm volatile("" : "+v"(tid_)); const int tid = tid_, lane = tid & 63, wave = __builtin_amdgcn_readfirstlane(tid >> 6), G = gridDim.x, bid = blockIdx.x; (void)tid; (void)lane; (void)wave;
    unsigned char* ws = uni_ptr(args.ws);
    const float* QN = (const float*)(ws + WS_ACT + A_QN); const float* KN = (const float*)(ws + WS_ACT + A_KN); const bf16* VV = (const bf16*)(ws + WS_ACT + A_VV);
    const float* DNB = (const float*)(ws + WS_DNB); bf16* O = (bf16*)(ws + WS_ACT + A_O);
    LAS float* kq = (LAS float*)lds;
    LAS float* vv = (LAS float*)(lds + 65536);
    LAS float* bg = (LAS float*)(lds + 98304);
    const int e = tid >> 1, hf = tid & 1;
    for (int it = bid; it < 16; it += G) {
        const int b = it >> 3, hv = it & 7, hq = hv >> 1;
        float s[64];
#pragma unroll
        for (int d = 0; d < 64; ++d) s[d] = 0.f;
        for (int nn = 0; nn < SEQ / 64; ++nn) { const size_t t0 = (size_t)b * SEQ + (size_t)nn * 64;
            __syncthreads();
            for (int i = tid; i < 64 * 64; i += NTHR) { const int tk = i >> 6, c4 = (i & 63) * 4;
                const float* src = (c4 < 128 ? KN : QN) + (t0 + tk) * 512 + hq * 128 + (c4 & 127);
                *(LAS f32x4*)(kq + tk * 256 + c4) = *(const f32x4*)src; }
            for (int i = tid; i < 64 * 128; i += NTHR) { const int tk = i >> 7, ee = i & 127; vv[i] = bf1(VV[(t0 + tk) * 1024 + hv * 128 + ee]); }
            if (tid < 64) { bg[tid * 2] = DNB[(t0 + tid) * 16 + hv]; bg[tid * 2 + 1] = expf(DNB[(t0 + tid) * 16 + 8 + hv]); }
            __syncthreads();
            if (tid < 256) {
                for (int tk = 0; tk < 64; ++tk) { const LAS float* kp = kq + tk * 256 + hf * 64; const float beta = bg[tk * 2], a = bg[tk * 2 + 1]; float dot = 0.f;
#pragma unroll
                    for (int d4 = 0; d4 < 16; ++d4) { const f32x4 k4 = *(const LAS f32x4*)(kp + 4 * d4); dot += k4[0] * s[4 * d4] + k4[1] * s[4 * d4 + 1] + k4[2] * s[4 * d4 + 2] + k4[3] * s[4 * d4 + 3]; }
                    dot += __shfl_xor(dot, 1);
                    const float cc = beta * (vv[tk * 128 + e] - a * dot); float o = 0.f;
#pragma unroll
                    for (int d4 = 0; d4 < 16; ++d4) { const f32x4 k4 = *(const LAS f32x4*)(kp + 4 * d4), q4 = *(const LAS f32x4*)(kp + 128 + 4 * d4);
#pragma unroll
                        for (int j = 0; j < 4; ++j) { s[4 * d4 + j] = a * s[4 * d4 + j] + k4[j] * cc; o += q4[j] * s[4 * d4 + j]; } }
                    o += __shfl_xor(o, 1);
                    if (hf == 0) O[(t0 + tk) * 1024 + hv * 128 + e] = (bf16)(pk2(o * 0.08838834764831845f, 0.f) & 0xffffu); }
            }
        }
    }
}
__device__ __forceinline__ void phase_dn_ogate(const Args& args) {
    int tid_ = threadIdx.x; asm volatile("" : "+v"(tid_)); const int tid = tid_, lane = tid & 63, wave = __builtin_amdgcn_readfirstlane(tid >> 6), G = gridDim.x, bid = blockIdx.x; (void)tid; (void)lane; (void)wave;
    unsigned char* ws = uni_ptr(args.ws); const float* o_norm = args.in[23];
    const bf16* O = (const bf16*)(ws + WS_ACT + A_O); const bf16* Z = (const bf16*)(ws + WS_ACT + A_Z); bf16* GT = (bf16*)(ws + WS_ACT + A_H);
    for (int t = bid * NWAVES + wave; t < T; t += G * NWAVES) {
#pragma unroll
        for (int j = 0; j < 2; ++j) { const int ch = 8 * lane + 512 * j; const v4u q = *(const v4u*)(O + (size_t)t * 1024 + ch), z = *(const v4u*)(Z + (size_t)t * 1024 + ch);
            float o[8] = {bflo(q.x), bfhi(q.x), bflo(q.y), bfhi(q.y), bflo(q.z), bfhi(q.z), bflo(q.w), bfhi(q.w)}; const float zz[8] = {bflo(z.x), bfhi(z.x), bflo(z.y), bfhi(z.y), bflo(z.z), bfhi(z.z), bflo(z.w), bfhi(z.w)};
            float ss = 0.f;
#pragma unroll
            for (int e = 0; e < 8; ++e) ss += o[e] * o[e];
            ss += __shfl_xor(ss, 1); ss += __shfl_xor(ss, 2); ss += __shfl_xor(ss, 4); ss += __shfl_xor(ss, 8);
            const float r = __builtin_amdgcn_rsqf(ss * (1.0f / 128.0f) + EPS);
#pragma unroll
            for (int e = 0; e < 8; ++e) o[e] = o[e] * r * o_norm[(ch & 127) + e] * siluf_(zz[e]);
            v4u w; w.x = pk2(o[0], o[1]); w.y = pk2(o[2], o[3]); w.z = pk2(o[4], o[5]); w.w = pk2(o[6], o[7]); *(v4u*)(GT + (size_t)t * 1024 + ch) = w; }
    }
}

__device__ __forceinline__ void phase_moe_router(const Args& args, int L, LAS unsigned char* lds) {
    int tid_ = threadIdx.x; asm volatile("" : "+v"(tid_)); const int tid = tid_, lane = tid & 63, wave = __builtin_amdgcn_readfirstlane(tid >> 6), G = gridDim.x, bid = blockIdx.x; (void)tid; (void)lane; (void)wave;
    unsigned char* ws = uni_ptr(args.ws); const int ib = LBASE(L) + 4 + NMIX(L);
    const float* X = args.out; bf16* H = (bf16*)(ws + WS_ACT + A_H); const float* MOD = (const float*)(ws + WS_MOD) + (size_t)L * 2 * 6144;
    const float* nf = args.in[LBASE(L) + 1]; const float* rb = args.in[ib + 1];
    const bf16* RH = (const bf16*)(ws + WS_RTR + (size_t)L * 196608); const bf16* RLo = RH + 49152;
    int* EID = (int*)(ws + WS_EID); float* GATE = (float*)(ws + WS_GATE); int* CNT = (int*)(ws + WS_CNT);
    LAS float* gs = (LAS float*)lds; LAS float* sh = gs + 1024; LAS int* lcnt = (LAS int*)(lds + 8192); LAS float* scr = (LAS float*)(lds + 8448 + wave * 3072);
    const int r = lane & 15, q = lane >> 4;
    for (int item = bid; item < T / 128; item += G) {
        const int r0 = item * 128, b = r0 / SEQ; const float* m = MOD + (size_t)b * 6144;
        __syncthreads();
        for (int k = tid; k < 1024; k += NTHR) { gs[k] = nf[k] * (1.0f + m[4096 + k]); sh[k] = m[3072 + k]; }
        if (tid < 32) lcnt[tid] = 0;
        __syncthreads();
        const int row = r0 + 16 * wave + r; const float* xp = X + (size_t)row * 1024 + 8 * q;
        float ss = 0.f;
#pragma unroll 8
        for (int j = 0; j < 32; ++j) { const f32x4 v0 = *(const f32x4*)(xp + 32 * j), v1 = *(const f32x4*)(xp + 32 * j + 4); ss += (v0[0] * v0[0] + v0[1] * v0[1]) + (v0[2] * v0[2] + v0[3] * v0[3]) + (v1[0] * v1[0] + v1[1] * v1[1]) + (v1[2] * v1[2] + v1[3] * v1[3]); }
        ss += __shfl_xor(ss, 16); ss += __shfl_xor(ss, 32);
        const float rstd = __builtin_amdgcn_rsqf(ss * (1.0f / 1024.0f) + EPS);
        f32x4 acc[3];
#pragma unroll
        for (int nt = 0; nt < 3; ++nt) acc[nt] = (f32x4){0.f, 0.f, 0.f, 0.f};
#pragma unroll 2
        for (int j = 0; j < 32; ++j) { const int k0 = 32 * j + 8 * q; const f32x4 v0 = *(const f32x4*)(xp + 32 * j), v1 = *(const f32x4*)(xp + 32 * j + 4);
            const f32x4 g0 = *(const LAS f32x4*)(gs + k0), g1 = *(const LAS f32x4*)(gs + k0 + 4), s0 = *(const LAS f32x4*)(sh + k0), s1 = *(const LAS f32x4*)(sh + k0 + 4);
            const f32x4 h0 = v0 * rstd * g0 + s0, h1 = v1 * rstd * g1 + s1;
            v4u hi; hi.x = pk2(h0[0], h0[1]); hi.y = pk2(h0[2], h0[3]); hi.z = pk2(h1[0], h1[1]); hi.w = pk2(h1[2], h1[3]);
            v4u lo; lo.x = pk2(h0[0] - bflo(hi.x), h0[1] - bfhi(hi.x)); lo.y = pk2(h0[2] - bflo(hi.y), h0[3] - bfhi(hi.y)); lo.z = pk2(h1[0] - bflo(hi.z), h1[1] - bfhi(hi.z)); lo.w = pk2(h1[2] - bflo(hi.w), h1[3] - bfhi(hi.w));
            *(v4u*)(H + (size_t)row * 1024 + k0) = hi;
            const bf16x8 ahi = __builtin_bit_cast(bf16x8, hi), alo = __builtin_bit_cast(bf16x8, lo);
#pragma unroll
            for (int nt = 0; nt < 3; ++nt) { const bf16x8 bh = *(const bf16x8*)(RH + (size_t)(nt * 16 + r) * 1024 + k0), bl = *(const bf16x8*)(RLo + (size_t)(nt * 16 + r) * 1024 + k0);
                acc[nt] = __builtin_amdgcn_mfma_f32_16x16x32_bf16(bh, ahi, acc[nt], 0, 0, 0); acc[nt] = __builtin_amdgcn_mfma_f32_16x16x32_bf16(bl, ahi, acc[nt], 0, 0, 0); acc[nt] = __builtin_amdgcn_mfma_f32_16x16x32_bf16(bh, alo, acc[nt], 0, 0, 0); } }
#pragma unroll
        for (int nt = 0; nt < 3; ++nt) *(LAS f32x4*)(scr + r * 48 + 16 * nt + 4 * q) = acc[nt];
        LDS_WAIT(); asm volatile("" ::: "memory");
        if (lane < 16) { float lg[36];
#pragma unroll
            for (int i = 0; i < 9; ++i) { const f32x4 v = *(const LAS f32x4*)(scr + r * 48 + 4 * i); lg[4 * i] = v[0] + rb[4 * i]; lg[4 * i + 1] = v[1] + rb[4 * i + 1]; lg[4 * i + 2] = v[2] + rb[4 * i + 2]; lg[4 * i + 3] = v[3] + rb[4 * i + 3]; }
            int gsel = 0; float gm = lg[0];
#pragma unroll
            for (int i = 1; i < 4; ++i) if (lg[i] > gm) { gm = lg[i]; gsel = i; }
            float gsum = 0.f;
#pragma unroll
            for (int i = 0; i < 4; ++i) gsum += expf(lg[i] - gm);
            const float pg = 1.0f / gsum;
            float le[8];
#pragma unroll
            for (int i = 0; i < 8; ++i) le[i] = gsel == 0 ? lg[4 + i] : (gsel == 1 ? lg[12 + i] : (gsel == 2 ? lg[20 + i] : lg[28 + i]));
            int j1 = 0; float m1 = le[0];
#pragma unroll
            for (int i = 1; i < 8; ++i) if (le[i] > m1) { m1 = le[i]; j1 = i; }
            int j2 = -1; float m2 = -INFINITY;
#pragma unroll
            for (int i = 0; i < 8; ++i) if (i != j1 && le[i] > m2) { m2 = le[i]; j2 = i; }
            const float p2 = expf(m2 - m1), den = 1.0f / (1.0f + p2);
            const int e1 = gsel * 8 + j1, e2 = gsel * 8 + j2;
            EID[(size_t)row * 2] = e1; EID[(size_t)row * 2 + 1] = e2; GATE[(size_t)row * 2] = pg * den; GATE[(size_t)row * 2 + 1] = pg * p2 * den;
            __hip_atomic_fetch_add(lcnt + e1, 1, __ATOMIC_RELAXED, __HIP_MEMORY_SCOPE_WORKGROUP); __hip_atomic_fetch_add(lcnt + e2, 1, __ATOMIC_RELAXED, __HIP_MEMORY_SCOPE_WORKGROUP); }
        __syncthreads();
        if (tid < 32) CNT[item * 32 + tid] = lcnt[tid];
    }
}
__device__ __forceinline__ void phase_moe_scatter(const Args& args, LAS unsigned char* lds) {
    int tid_ = threadIdx.x; asm volatile("" : "+v"(tid_)); const int tid = tid_, lane = tid & 63, wave = __builtin_amdgcn_readfirstlane(tid >> 6), G = gridDim.x, bid = blockIdx.x; (void)tid; (void)lane; (void)wave;
    unsigned char* ws = uni_ptr(args.ws);
    const bf16* H = (const bf16*)(ws + WS_ACT + A_H); bf16* XG = (bf16*)(ws + WS_ACT + A_XG);
    const int* EID = (const int*)(ws + WS_EID); int* SLOT = (int*)(ws + WS_SLOT); const int* CNT = (const int*)(ws + WS_CNT); int* TILEE = (int*)(ws + WS_TILEE);
    LAS int* tot = (LAS int*)lds; LAS int* before = tot + 32; LAS int* pstart = tot + 64; LAS int* lcnt = tot + 96; LAS int* lslot = tot + 128;
    for (int item = bid; item < T / 128; item += G) {
        const int r0 = item * 128;
        __syncthreads();
        if (tid < 32) { int t_ = 0, b_ = 0;
            for (int w = 0; w < T / 128; ++w) { const int c = CNT[w * 32 + tid]; t_ += c; b_ += (w < item) ? c : 0; }
            tot[tid] = t_; before[tid] = b_; lcnt[tid] = 0; }
        __syncthreads();
        if (tid == 0) { int ps = 0; for (int e = 0; e < 32; ++e) { pstart[e] = ps; ps += (tot[e] + 255) & ~255; }
            if (item == 0) { TILEE[0] = ps >> 8; for (int e = 0; e < 32; ++e) { const int t0 = pstart[e] >> 8, nt = ((tot[e] + 255) >> 8); for (int i = 0; i < nt; ++i) TILEE[16 + t0 + i] = e; } } }
        __syncthreads();
        if (tid < 256) { const int e = EID[(size_t)r0 * 2 + tid]; const int rank = __hip_atomic_fetch_add(lcnt + e, 1, __ATOMIC_RELAXED, __HIP_MEMORY_SCOPE_WORKGROUP); const int slot = pstart[e] + before[e] + rank; SLOT[(size_t)r0 * 2 + tid] = slot; lslot[tid] = slot; }
        __syncthreads();
        for (int rr = 0; rr < 16; ++rr) { const int row = 16 * wave + rr; const bf16* src = H + (size_t)(r0 + row) * 1024;
            const v4u a = *(const v4u*)(src + 8 * lane), c = *(const v4u*)(src + 512 + 8 * lane); const int s0 = lslot[2 * row], s1 = lslot[2 * row + 1];
            bf16* d0 = XG + (size_t)s0 * 1024; bf16* d1 = XG + (size_t)s1 * 1024;
            *(v4u*)(d0 + 8 * lane) = a; *(v4u*)(d0 + 512 + 8 * lane) = c; *(v4u*)(d1 + 8 * lane) = a; *(v4u*)(d1 + 512 + 8 * lane) = c; }
        { const int e = item & 31, part = item >> 5; const int p0 = pstart[e] + tot[e], npad = ((tot[e] + 255) & ~255) - tot[e]; const v4u z = {0u, 0u, 0u, 0u};
          for (int pr = part * 8 + wave; pr < npad; pr += 64) { bf16* d = XG + (size_t)(p0 + pr) * 1024; *(v4u*)(d + 8 * lane) = z; *(v4u*)(d + 512 + 8 * lane) = z; } }
    }
}
__device__ __forceinline__ void phase_moe_combine(const Args& args, int L) {
    int tid_ = threadIdx.x; asm volatile("" : "+v"(tid_)); const int tid = tid_, lane = tid & 63, wave = __builtin_amdgcn_readfirstlane(tid >> 6), G = gridDim.x, bid = blockIdx.x; (void)tid; (void)lane; (void)wave;
    unsigned char* ws = uni_ptr(args.ws); float* X = args.out; const bf16* Y = (const bf16*)(ws + WS_ACT + A_Y); bf16* H = (bf16*)(ws + WS_ACT + A_H);
    const int* SLOT = (const int*)(ws + WS_SLOT); const float* GATE = (const float*)(ws + WS_GATE); const float* MOD = (const float*)(ws + WS_MOD);
    for (int t = bid * NWAVES + wave; t < T; t += G * NWAVES) { const int b = t / SEQ;
        const int s0 = SLOT[(size_t)t * 2], s1 = SLOT[(size_t)t * 2 + 1]; const float g0 = GATE[(size_t)t * 2], g1 = GATE[(size_t)t * 2 + 1];
        const float* gf = MOD + (size_t)(L * 2 + b) * 6144 + 5120; f32x4 v[4];
#pragma unroll
        for (int j = 0; j < 4; ++j) { const int c = 4 * lane + 256 * j; const f32x4 x = *(const f32x4*)(X + (size_t)t * 1024 + c), gg = *(const f32x4*)(gf + c);
            const v2u y0 = *(const v2u*)(Y + (size_t)s0 * 1024 + c), y1 = *(const v2u*)(Y + (size_t)s1 * 1024 + c);
            f32x4 mo; mo[0] = g0 * bflo(y0.x) + g1 * bflo(y1.x); mo[1] = g0 * bfhi(y0.x) + g1 * bfhi(y1.x); mo[2] = g0 * bflo(y0.y) + g1 * bflo(y1.y); mo[3] = g0 * bfhi(y0.y) + g1 * bfhi(y1.y);
            v[j] = x + gg * mo; *(f32x4*)(X + (size_t)t * 1024 + c) = v[j]; }
        if (L < 3) { const float* m = MOD + (size_t)((L + 1) * 2 + b) * 6144; norm_store_row(v, args.in[LBASE(L + 1)], m, m + 1024, H + (size_t)t * 1024, lane); }
    }
}

constexpr int N_PHASES = 36;

#define PHASE(k) if ((lo <= (k) && (k) < hi) && ((started ? (xcd_barrier(bar), 0) : 0), started = true, true))
template <int L> __device__ __forceinline__ void run_layer(const Args& args, LAS unsigned char* lds, const XcdBarrier& bar, bool& started, const int lo, const int hi) {
    const int G = gridDim.x, bid = blockIdx.x;
    unsigned char* ws = uni_ptr(args.ws);
    const float* MOD = (const float*)(ws + WS_MOD);
    bf16* Hb = (bf16*)(ws + WS_ACT + A_H);

        const int pb = (L == 0) ? 1 : (L == 1 ? 10 : (L == 2 ? 20 : 28));
        const float* xsrc = (L == 0) ? args.in[0] : (const float*)args.out;
        const float* gate_m = MOD + (size_t)L * 2 * 6144 + 2048;
        int mb;
        if constexpr (L == 0 || L == 3) {
            int g0 = pb;
            if (L == 0) { PHASE(pb) { phase_norm0(args); } g0 = pb + 1; }
            const bf16* Win = (const bf16*)(ws + WS_WMIX + (L == 0 ? WMIX_GM_IN0 : WMIX_GM_IN3)); const bf16* Wout = (const bf16*)(ws + WS_WMIX + (L == 0 ? WMIX_GM_OUT0 : WMIX_GM_OUT3));
            PHASE(g0) { pg8::Gemm g{Hb, Win, T, 2048, 1024}; pg8::StaticOrder S; S.init(T, 2048, G, bid);
                EpiGm1 E{(bf16*)(ws + WS_ACT + A_U), (bf16*)(ws + WS_ACT + A_V), (float*)(ws + WS_VSSP)};
                pg8::gemm_phase<EpiGm1, pg8::StaticOrder, true, true>(lds, g, S, E); }
            PHASE(g0 + 1) { phase_gm_spatial(args, L, lds); }
            PHASE(g0 + 2) { pg8::Gemm g{(const bf16*)(ws + WS_ACT + A_GATED), Wout, T, 1024, 1024}; pg8::StaticOrder S; S.init(T, 1024, G, bid);
                EpiRes E{xsrc, args.out, gate_m};
                pg8::gemm_phase<EpiRes, pg8::StaticOrder, true, true>(lds, g, S, E); }
            mb = g0 + 3;
        } else if constexpr (L == 1) {
            PHASE(pb) { pg8::Gemm g{Hb, (const bf16*)(ws + WS_WMIX + WMIX_DN_IN), T, 3328, 1024}; pg8::StaticOrder S; S.init(T, 3328, G, bid);
                EpiDn1 E{(bf16*)(ws + WS_ACT + A_QKV), (bf16*)(ws + WS_ACT + A_Z), (float*)(ws + WS_BA)};
                pg8::gemm_phase<EpiDn1, pg8::StaticOrder, true, true>(lds, g, S, E); }
            PHASE(pb + 1) { phase_dn_prep(args); }
            PHASE(pb + 2) { phase_dn_scan_naive(args, lds); }
            PHASE(pb + 3) { phase_dn_ogate(args); }
            PHASE(pb + 4) { pg8::Gemm g{Hb, (const bf16*)(ws + WS_WMIX + WMIX_DN_OUT), T, 1024, 1024}; pg8::StaticOrder S; S.init(T, 1024, G, bid);
                EpiRes E{xsrc, args.out, gate_m};
                pg8::gemm_phase<EpiRes, pg8::StaticOrder, true, true>(lds, g, S, E); }
            mb = pb + 5;
        } else {
            PHASE(pb) { pg8::Gemm g{Hb, (const bf16*)(ws + WS_WMIX + WMIX_SWA_IN), T, 1536, 1024}; pg8::StaticOrder S; S.init(T, 1536, G, bid);
                EpiBf E{(bf16*)(ws + WS_ACT + A_QKV), 1536, 0xffff};
                pg8::gemm_phase<EpiBf, pg8::StaticOrder, true, true>(lds, g, S, E); }
            PHASE(pb + 1) { phase_swa_attn(args, lds); }
            PHASE(pb + 2) { pg8::Gemm g{Hb, (const bf16*)(ws + WS_WMIX + WMIX_SWA_OUT), T, 1024, 1024}; pg8::StaticOrder S; S.init(T, 1024, G, bid);
                EpiRes E{xsrc, args.out, gate_m};
                pg8::gemm_phase<EpiRes, pg8::StaticOrder, true, true>(lds, g, S, E); }
            mb = pb + 3;
        }
        PHASE(mb) { phase_moe_router(args, L, lds); }
        PHASE(mb + 1) { phase_moe_scatter(args, lds); }
        const int* TILEE = (const int*)(ws + WS_TILEE);
        PHASE(mb + 2) { const int ntiles = TILEE[0]; pg8::Gemm g{(const bf16*)(ws + WS_ACT + A_XG), (const bf16*)(ws + WS_W + (size_t)L * 96 * MiB), MAXROWS, 1024, 1024};
            MoeOrder S; S.init(TILEE + 16, ntiles, G, bid); EpiMoe1 E{(bf16*)(ws + WS_ACT + A_ACTV)};
            pg8::gemm_phase<EpiMoe1, MoeOrder, true, true>(lds, g, S, E); }
        PHASE(mb + 3) { const int ntiles = TILEE[0]; pg8::Gemm g{(const bf16*)(ws + WS_ACT + A_ACTV), (const bf16*)(ws + WS_W + (size_t)L * 96 * MiB + 64 * MiB), MAXROWS, 1024, 512};
            MoeOrder S; S.init(TILEE + 16, ntiles, G, bid); EpiBf E{(bf16*)(ws + WS_ACT + A_Y), 1024, 3};
            pg8::gemm_phase<EpiBf, MoeOrder, true, true>(lds, g, S, E); }
        PHASE(mb + 4) { phase_moe_combine(args, L); }

}
__global__ void __launch_bounds__(NTHR, 2) fwd_kernel(Args args) {
    extern __shared__ __attribute__((aligned(16))) unsigned char lds_raw[];
    LAS unsigned char* lds = (LAS unsigned char*)lds_raw;
    const int tid = threadIdx.x;
    unsigned char* ws = uni_ptr(args.ws);
    for (int u = tid; u < (LDS_BYTES - LDSCTL_OFF) / 4; u += NTHR) ((LAS unsigned*)(lds + LDSCTL_OFF))[u] = 0u;
    __syncthreads();
    volatile LAS unsigned* MISC = (volatile LAS unsigned*)(lds + MISC_OFF);
    XcdBarrier bar = xcd_barrier_post((unsigned*)(ws + WS_CTL) + 4096 + (size_t)args.li * XCD_BAR_WORDS, MISC + 8);
    const int lo = args.ph_lo, hi = args.ph_hi; bool started = false;
    const float* MOD = (const float*)(ws + WS_MOD);
    bf16* Hb = (bf16*)(ws + WS_ACT + A_H);

    PHASE(0) { phase_prologue(args, lds); }

    run_layer<0>(args, lds, bar, started, lo, hi);
    run_layer<1>(args, lds, bar, started, lo, hi);
    run_layer<2>(args, lds, bar, started, lo, hi);
    run_layer<3>(args, lds, bar, started, lo, hi);
#undef PHASE
}

extern "C" void kernel_launch(void* const* d_in, const int* in_sizes, int n_in, void* d_out, int out_size, void* d_ws, size_t ws_size, hipStream_t stream) {
    static int grid = 0;
    if (grid == 0) {
        if (n_in != N_IN || in_sizes[0] != T * D || out_size != T * D || ws_size < WS_END) { fprintf(stderr, "kernel_launch: unexpected shapes (n_in %d, in0 %d, out %d, ws %zu < %zu)\n", n_in, n_in > 0 ? in_sizes[0] : -1, out_size, ws_size, (size_t)WS_END); grid = -1; return; }
        int dev = 0, cus = 0, per_cu = 0;
        if (hipGetDevice(&dev) != hipSuccess || hipDeviceGetAttribute(&cus, hipDeviceAttributeMultiprocessorCount, dev) != hipSuccess) { grid = -1; return; }
        if (hipFuncSetAttribute((const void*)fwd_kernel, hipFuncAttributeMaxDynamicSharedMemorySize, LDS_BYTES) != hipSuccess) { fprintf(stderr, "kernel_launch: hipFuncSetAttribute failed\n"); grid = -1; return; }
        if (hipOccupancyMaxActiveBlocksPerMultiprocessor(&per_cu, (const void*)fwd_kernel, NTHR, LDS_BYTES) != hipSuccess || per_cu < 1) fprintf(stderr, "kernel_launch: occupancy query reports %d\n", per_cu);
        (void)hipGetLastError();
        grid = cus;
    }
    if (grid < 0) return;
    if (hipMemsetAsync((char*)d_ws + WS_CTL, 0, CTL_ZERO_BYTES, stream) != hipSuccess) return;
    Args a{};
    for (int i = 0; i < N_IN; ++i) a.in[i] = (const float*)d_in[i];
    a.out = (float*)d_out; a.ws = (unsigned char*)d_ws; a.pad = 0;
#if MK_LAUNCH_MODE == 1
    a.ph_lo = 0; a.ph_hi = N_PHASES; a.li = 0;
    hipLaunchKernelGGL(fwd_kernel, dim3(grid), dim3(NTHR), LDS_BYTES, stream, a);
#else
    for (int p = 0; p < N_PHASES; ++p) { a.ph_lo = p; a.ph_hi = p + 1; a.li = 0;
        hipLaunchKernelGGL(fwd_kernel, dim3(grid), dim3(NTHR), LDS_BYTES, stream, a); }
#endif
}
```

```cpp
#include <hip/hip_runtime.h>
#include <cstdio>
#include <cstdint>
#ifndef MK_LAUNCH_MODE
#define MK_LAUNCH_MODE 1
#endif
namespace pg8 {
#define PG8_LAS __attribute__((address_space(3)))
typedef unsigned short bf16_t;
typedef short bf16x8 __attribute__((ext_vector_type(8)));
typedef float f32x4 __attribute__((ext_vector_type(4)));
typedef unsigned u32x4 __attribute__((ext_vector_type(4)));
constexpr int BM = 256, BK = 64, HALF = 128, HTB = HALF * BK * 2  , STAGE_BYTES = 8 * HTB, NXCD = 8, WGM = 8;

__host__ __device__ __forceinline__ int lds_byte(int r, int c) { const int st = (r >> 4) * 2 + (c >> 5), rr = r & 15, cc = c & 31, ob = rr * 64 + cc * 2; return st * 1024 + (ob ^ (((ob >> 9) & 1) << 5)); }
__host__ __device__ __forceinline__ void stage_rc(int b, int& R, int& C) { const int st = b / 1024, sb = b % 1024, swz = sb ^ (((sb >> 9) & 1) << 5); R = (st >> 1) * 16 + swz / 64; C = (st & 1) * 32 + (swz % 64) / 2; }
__host__ __device__ __forceinline__ int perm32(int rho) { const int n = rho >> 4, i = rho & 15; return 8 * (i >> 2) + 4 * n + (i & 3); }

struct Unit { int pm, pn; };
struct Gemm { const bf16_t* A; const bf16_t* Bt; int M, N, K; };

struct StaticOrder {
    int nM, nN, nwg, G, c;
    __host__ __device__ void init(int M, int N, int G_, int c_) { nM = M / BM; nN = N / BM; nwg = nM * nN; G = G_; c = c_; }
    __host__ __device__ bool next(int i, Unit& u) const {
        const long L = (long)i * G + c; if (L >= nwg) return false;
        int wgid = (int)L; { const int q = nwg / NXCD, r = nwg % NXCD, xcd = wgid % NXCD, off = wgid / NXCD; wgid = (xcd < r ? xcd * (q + 1) : r * (q + 1) + (xcd - r) * q) + off; }
        const int nig = WGM * nN, gid = wgid / nig, fm = gid * WGM, gsz = (nM - fm) < WGM ? (nM - fm) : WGM;
        u.pm = fm + ((wgid % nig) % gsz); u.pn = (wgid % nig) / gsz; return true;
    }
    __device__ __forceinline__ void a_ready(const Unit&) const {}
    __device__ __forceinline__ void done(const Unit&) const {}
};
typedef float f32x2_ __attribute__((ext_vector_type(2))); typedef __bf16 bf16x2_ __attribute__((ext_vector_type(2)));
__device__ __forceinline__ unsigned cvt_pk_bf16(float lo, float hi) { const f32x2_ v = {lo, hi}; return __builtin_bit_cast(unsigned, __builtin_convertvector(v, bf16x2_)); }
typedef float f32x2 __attribute__((ext_vector_type(2)));
template <class Epi, class Sched, bool ALIGN_EPI = false, bool SP2 = false>
__device__ __forceinline__ void gemm_phase(PG8_LAS unsigned char* lds, const Gemm g, const Sched& S, const Epi& E) {
    const int tid = threadIdx.x, wid = __builtin_amdgcn_readfirstlane(tid >> 6), lane = tid & 63, wr = wid >> 2, wc = wid & 3, fr = lane & 15, fq = lane >> 4;
    const int K = g.K, nt = K / BK;
    unsigned voffA[2], voffB[2];
#pragma unroll
    for (int i = 0; i < 2; ++i) { int R, C; stage_rc(tid * 16 + i * 8192, R, C); const int Rb = Epi::PERM ? ((R & ~31) + perm32(R & 31)) : R;
        voffA[i] = (unsigned)(R * K + C) * 2u; voffB[i] = (unsigned)(Rb * K + C) * 2u; }
    const size_t kstep = (size_t)(BK * 2);
    const size_t hstep = (size_t)HALF * K * 2;
    const size_t tstep = 2 * hstep;
    const unsigned ldsw = (unsigned)wid * 1024u;
    const int aoff = lds_byte(wr * 64 + fr, fq * 8), boff = lds_byte(wc * 32 + fr, fq * 8);
#define PG8_SA(b, h) (((b) * 2 + (h)) * HTB)
#define PG8_SB(b, h) ((4 + (b) * 2 + (h)) * HTB)
#define PG8_STAGE(bufoff, gbase, voff) do { _Pragma("unroll") for (int _i = 0; _i < 2; ++_i) \
        __builtin_amdgcn_global_load_lds((const unsigned*)((const char*)(gbase) + (voff)[_i]), (PG8_LAS unsigned*)(lds + (bufoff) + ldsw + _i * 8192), 16, 0, 0); } while (0)
#define PG8_LDA(dst, b, h) do { _Pragma("unroll") for (int m = 0; m < 4; ++m) _Pragma("unroll") for (int k = 0; k < 2; ++k) dst[m][k] = *(const PG8_LAS bf16x8*)(lds + PG8_SA(b, h) + aoff + m * 2048 + k * 1024); } while (0)
#define PG8_LDB(dst, b, h) do { _Pragma("unroll") for (int n = 0; n < 2; ++n) _Pragma("unroll") for (int k = 0; k < 2; ++k) dst[n][k] = *(const PG8_LAS bf16x8*)(lds + PG8_SB(b, h) + boff + n * 2048 + k * 1024); } while (0)
#define PG8_MMA(ai, bj, At, Bt) do { __builtin_amdgcn_s_setprio(1); _Pragma("unroll") for (int m = 0; m < 4; ++m) _Pragma("unroll") for (int n = 0; n < 2; ++n) _Pragma("unroll") for (int k = 0; k < 2; ++k) \
        acc[ai][bj][m][n] = __builtin_amdgcn_mfma_f32_16x16x32_bf16(Bt[n][k], At[m][k], acc[ai][bj][m][n], 0, 0, 0); __builtin_amdgcn_s_setprio(0); } while (0)
#define PG8_WAIT_V(n) asm volatile("s_waitcnt vmcnt(" #n ")" ::: "memory")
#define PG8_WAIT_L(n) asm volatile("s_waitcnt lgkmcnt(" #n ")" ::: "memory")
#define PG8_BAR __builtin_amdgcn_s_barrier()
#define PG8_SCHED __builtin_amdgcn_sched_barrier(0)
    Unit cur, nxt; int ui = 0;
    if (!S.next(0, cur)) return;
    f32x4 acc[2][2][4][2];
#pragma unroll
    for (int a = 0; a < 2; ++a)
#pragma unroll
        for (int b = 0; b < 2; ++b)
#pragma unroll
            for (int m = 0; m < 4; ++m)
#pragma unroll
                for (int n = 0; n < 2; ++n) acc[a][b][m][n] = (f32x4){0.f, 0.f, 0.f, 0.f};
    bf16x8 At[4][2], B0[2][2], B1[2][2];
    const char* cA = (const char*)g.A + (size_t)cur.pm * tstep; const char* cB = (const char*)g.Bt + (size_t)cur.pn * tstep;
    S.a_ready(cur);
    if constexpr (SP2) {
        PG8_STAGE(PG8_SB(0, 0), cB, voffB); PG8_STAGE(PG8_SB(0, 1), cB + hstep, voffB); PG8_STAGE(PG8_SA(0, 0), cA, voffA); PG8_STAGE(PG8_SA(0, 1), cA + hstep, voffA);
        if (wr == 1) PG8_BAR;
        PG8_WAIT_V(2); PG8_BAR;
        PG8_STAGE(PG8_SB(1, 0), cB + kstep, voffB); PG8_STAGE(PG8_SA(1, 0), cA + kstep, voffA); PG8_STAGE(PG8_SB(1, 1), cB + hstep + kstep, voffB);
        PG8_WAIT_V(6); PG8_BAR;
    } else {
        PG8_STAGE(PG8_SB(0, 0), cB, voffB); PG8_STAGE(PG8_SA(0, 0), cA, voffA); PG8_STAGE(PG8_SB(0, 1), cB + hstep, voffB); PG8_STAGE(PG8_SA(0, 1), cA + hstep, voffA);
        if (wr == 1) PG8_BAR;
        PG8_WAIT_V(4); PG8_BAR;
        PG8_STAGE(PG8_SB(1, 0), cB + kstep, voffB); PG8_STAGE(PG8_SA(1, 0), cA + kstep, voffA); PG8_STAGE(PG8_SB(1, 1), cB + hstep + kstep, voffB);
        PG8_WAIT_V(6); PG8_BAR;
    }
    for (;;) {
        const bool has_next = S.next(ui + 1, nxt);
        const char* nA = has_next ? (const char*)g.A + (size_t)nxt.pm * tstep : cA; const char* nB = has_next ? (const char*)g.Bt + (size_t)nxt.pn * tstep : cB;
        for (int t = 0; t < nt; t += 2) {
            const bool last = (t == nt - 2);
            const char* a1 = cA + (size_t)(t + 1) * kstep;
            const char* a2 = last ? nA : cA + (size_t)(t + 2) * kstep; const char* b2 = last ? nB : cB + (size_t)(t + 2) * kstep;
            const char* a3 = a2 + kstep; const char* b3 = b2 + kstep;
            if (last && has_next) S.a_ready(nxt);
            if constexpr (SP2) {
            PG8_LDB(B0, 0, 0); PG8_LDB(B1, 0, 1); PG8_SCHED; PG8_LDA(At, 0, 0); PG8_STAGE(PG8_SA(1, 1), a1 + hstep, voffA);
            PG8_WAIT_V(8); PG8_WAIT_L(0); PG8_BAR; PG8_MMA(0, 0, At, B0); PG8_MMA(0, 1, At, B1); PG8_BAR; PG8_SCHED;
            PG8_LDA(At, 0, 1); PG8_STAGE(PG8_SB(0, 0), b2, voffB); PG8_STAGE(PG8_SB(0, 1), b2 + hstep, voffB); PG8_STAGE(PG8_SA(0, 0), a2, voffA);
            PG8_WAIT_V(8); PG8_WAIT_L(0); PG8_BAR; PG8_MMA(1, 0, At, B0); PG8_MMA(1, 1, At, B1); PG8_BAR; PG8_SCHED;
            PG8_LDB(B0, 1, 0); PG8_LDB(B1, 1, 1); PG8_SCHED; PG8_LDA(At, 1, 0); PG8_STAGE(PG8_SA(0, 1), a2 + hstep, voffA);
            PG8_WAIT_V(8); PG8_WAIT_L(0); PG8_BAR; PG8_MMA(0, 0, At, B0); PG8_MMA(0, 1, At, B1); PG8_BAR; PG8_SCHED;
            PG8_LDA(At, 1, 1); PG8_STAGE(PG8_SB(1, 0), b3, voffB); PG8_STAGE(PG8_SB(1, 1), b3 + hstep, voffB); PG8_STAGE(PG8_SA(1, 0), a3, voffA);
            PG8_WAIT_V(8); PG8_WAIT_L(0); PG8_BAR; PG8_MMA(1, 0, At, B0); PG8_MMA(1, 1, At, B1); PG8_BAR; PG8_SCHED;
            } else {
            PG8_LDB(B0, 0, 0); PG8_SCHED; PG8_LDA(At, 0, 0); PG8_STAGE(PG8_SA(1, 1), a1 + hstep, voffA);
            PG8_WAIT_L(8); PG8_BAR; PG8_WAIT_L(0); PG8_MMA(0, 0, At, B0); PG8_BAR; PG8_SCHED;
            PG8_LDB(B1, 0, 1); PG8_STAGE(PG8_SB(0, 0), b2, voffB);
            PG8_BAR; PG8_WAIT_L(0); PG8_MMA(0, 1, At, B1); PG8_BAR;
            PG8_LDA(At, 0, 1); PG8_STAGE(PG8_SA(0, 0), a2, voffA);
            PG8_BAR; PG8_WAIT_L(0); PG8_MMA(1, 0, At, B0); PG8_BAR; PG8_SCHED;
            PG8_STAGE(PG8_SB(0, 1), b2 + hstep, voffB);
            PG8_WAIT_V(6); PG8_BAR; PG8_MMA(1, 1, At, B1); PG8_BAR;
            PG8_LDB(B0, 1, 0); PG8_SCHED; PG8_LDA(At, 1, 0); PG8_STAGE(PG8_SA(0, 1), a2 + hstep, voffA);
            PG8_WAIT_L(8); PG8_BAR; PG8_WAIT_L(0); PG8_MMA(0, 0, At, B0); PG8_BAR; PG8_SCHED;
            PG8_LDB(B1, 1, 1); PG8_STAGE(PG8_SB(1, 0), b3, voffB);
            PG8_BAR; PG8_WAIT_L(0); PG8_MMA(0, 1, At, B1); PG8_BAR;
            PG8_LDA(At, 1, 1); PG8_STAGE(PG8_SA(1, 0), a3, voffA);
            PG8_BAR; PG8_WAIT_L(0); PG8_MMA(1, 0, At, B0); PG8_BAR; PG8_SCHED;
            PG8_STAGE(PG8_SB(1, 1), b3 + hstep, voffB);
            PG8_WAIT_V(6); PG8_BAR; PG8_MMA(1, 1, At, B1); PG8_BAR;
            }
        }
        if constexpr (ALIGN_EPI) { if (wr == 0) PG8_BAR; }
        if constexpr (!Epi::AFTER_DRAIN) { E(acc, cur, wr, wc, fr, fq); S.done(cur); }
        if (!has_next) break;
#pragma unroll
        for (int a = 0; a < 2; ++a)
#pragma unroll
            for (int b = 0; b < 2; ++b)
#pragma unroll
                for (int m = 0; m < 4; ++m)
#pragma unroll
                    for (int n = 0; n < 2; ++n) acc[a][b][m][n] = (f32x4){0.f, 0.f, 0.f, 0.f};
        cur = nxt; cA = nA; cB = nB; ++ui;
        if constexpr (ALIGN_EPI) { if (wr == 1) PG8_BAR; }
    }
    PG8_WAIT_V(0);
    if constexpr (!ALIGN_EPI) { if (wr == 0) PG8_BAR; }
    PG8_BAR;
    if constexpr (Epi::AFTER_DRAIN) { E.fused(acc, cur, wr, wc, fr, fq, lds, wid, lane); S.done(cur); }
#undef PG8_SA
#undef PG8_SB
#undef PG8_STAGE
#undef PG8_LDA
#undef PG8_LDB
#undef PG8_MMA
#undef PG8_WAIT_V
#undef PG8_WAIT_L
#undef PG8_BAR
#undef PG8_SCHED
}
}

constexpr int NB = 2, SEQ = 16384, T = NB * SEQ, D = 1024;
constexpr float EPS = 1e-6f;
constexpr int NWAVES = 8, NTHR = 512;
constexpr int N_IN = 55;
__host__ __device__ constexpr int LBASE(int L) { return L == 0 ? 2 : (L == 1 ? 15 : (L == 2 ? 29 : 42)); }
__host__ __device__ constexpr int NMIX(int L) { return L == 1 ? 6 : 5; }

constexpr size_t MiB = 1u << 20;
constexpr size_t WS_CTL = 0, CTL_ZERO_BYTES = 1 * MiB;
constexpr size_t WS_MOD = 1 * MiB;
constexpr size_t WS_CNT = WS_MOD + 256 * 1024;
constexpr size_t WS_TILEE = WS_CNT + 64 * 1024;
constexpr size_t WS_EID = 2 * MiB;
constexpr size_t WS_GATE = WS_EID + 256 * 1024;
constexpr size_t WS_SLOT = WS_GATE + 256 * 1024;
constexpr size_t WS_VSSP = 3 * MiB;
constexpr size_t WS_BA = 5 * MiB;
constexpr size_t WS_DNB = 7 * MiB;
constexpr size_t WS_RTR = 9 * MiB;
constexpr size_t WS_W = 16 * MiB;
constexpr size_t WS_WMIX = WS_W + 384 * MiB;
constexpr size_t WMIX_GM_IN0 = 0, WMIX_GM_OUT0 = 4 * MiB, WMIX_DN_IN = 6 * MiB, WMIX_DN_OUT = 13 * MiB, WMIX_SWA_IN = 15 * MiB, WMIX_SWA_OUT = 18 * MiB, WMIX_GM_IN3 = 20 * MiB, WMIX_GM_OUT3 = 24 * MiB;
constexpr size_t WS_ACT = 432 * MiB;
constexpr size_t A_H = 0;
constexpr size_t A_U = 64 * MiB, A_V = 128 * MiB, A_GATED = 192 * MiB;
constexpr size_t A_QKV = 64 * MiB, A_Z = 192 * MiB, A_QN = 256 * MiB, A_KN = 288 * MiB, A_VV = 320 * MiB, A_FA = 384 * MiB, A_FB = 484 * MiB, A_FU = 64 * MiB, A_O = 128 * MiB;
constexpr size_t A_XG = 64 * MiB, A_ACTV = 208 * MiB, A_Y = 280 * MiB;
constexpr size_t WS_END = WS_ACT + 548 * MiB;
constexpr int MAXROWS = 73728;

constexpr int RING_BYTES = 131072;
constexpr int LDSCTL_OFF = RING_BYTES, MISC_OFF = LDSCTL_OFF + 320;
constexpr int LDS_BYTES = 147456;

#define LAS __attribute__((address_space(3)))
typedef unsigned short bf16;
typedef unsigned v4u __attribute__((ext_vector_type(4)));
typedef unsigned v2u __attribute__((ext_vector_type(2)));
typedef float f32x4 __attribute__((ext_vector_type(4)));
typedef short bf16x8 __attribute__((ext_vector_type(8)));
typedef short bf16x4 __attribute__((ext_vector_type(4)));
#define LDS_WAIT() asm volatile("s_waitcnt lgkmcnt(0)" ::: "memory")
#define VM_WAIT() asm volatile("s_waitcnt vmcnt(0)" ::: "memory")
__device__ __forceinline__ unsigned pk2(float lo, float hi) { return pg8::cvt_pk_bf16(lo, hi); }
__device__ __forceinline__ float bflo(unsigned w) { return __uint_as_float(w << 16); }
__device__ __forceinline__ float bfhi(unsigned w) { return __uint_as_float(w & 0xffff0000u); }
__device__ __forceinline__ float bf1(unsigned short b) { return __uint_as_float(((unsigned)b) << 16); }
__device__ __forceinline__ float wave_sum(float v) {
#pragma unroll
    for (int o = 1; o < 64; o <<= 1) v += __shfl_xor(v, o);
    return v;
}
__device__ __forceinline__ float fast_exp(float x) { return __builtin_amdgcn_exp2f(x * 1.44269504089f); }
__device__ __forceinline__ float sigmoidf_(float x) { return __builtin_amdgcn_rcpf(1.0f + fast_exp(-x)); }
__device__ __forceinline__ float siluf_(float x) { return x * sigmoidf_(x); }
__device__ __forceinline__ float gelu_tanh(float x) { const float y = 1.5957691216057308f * (x + 0.044715f * x * x * x); return x * __builtin_amdgcn_rcpf(1.0f + fast_exp(-y)); }

#define RLX_AGENT __ATOMIC_RELAXED, __HIP_MEMORY_SCOPE_AGENT
__device__ __forceinline__ unsigned char* uni_ptr(unsigned char* p) { const unsigned long long w = (unsigned long long)p; const unsigned lo = __builtin_amdgcn_readfirstlane((unsigned)w), hi = __builtin_amdgcn_readfirstlane((unsigned)(w >> 32)); return (unsigned char*)(__attribute__((address_space(1))) unsigned char*)(((unsigned long long)hi << 32) | lo); }
#define XB_TMO      128
#define XB_XCNT(j)  (256  + 64 * (j))
#define XB_XSUB(j)  (1280 + 64 * (j))
#define XB_XGEN(j)  (2304 + 64 * (j))
#define XB_TOP      3328
#define XB_TOPGEN   3392
#define XCD_BAR_WORDS 3456
#define XB_SPIN_CAP (1u << 18)

__device__ __forceinline__ unsigned xb_ld(unsigned* p)              { return __hip_atomic_load(p, __ATOMIC_RELAXED, __HIP_MEMORY_SCOPE_AGENT); }
__device__ __forceinline__ unsigned xb_add(unsigned* p, unsigned v) { return __hip_atomic_fetch_add(p, v, __ATOMIC_RELAXED, __HIP_MEMORY_SCOPE_AGENT); }
__device__ __forceinline__ unsigned xb_xcc_id() { return (unsigned)__builtin_amdgcn_s_getreg((3 << 11) | 20) & 0xFu; }
#define XB_SPIN(cond, bar) do { unsigned _sp = 0; while (cond) { __builtin_amdgcn_s_sleep(1); \
    if ((++_sp & 255u) == 0u) { if (xb_ld(&(bar)[XB_TMO])) break; if (_sp > XB_SPIN_CAP) { atomicAdd(&(bar)[XB_TMO], 1u); break; } } } } while (0)

struct XcdBarrier {
    unsigned* bar; unsigned x;
    volatile LAS unsigned* st;
};

__device__ __forceinline__ XcdBarrier xcd_barrier_post(unsigned* bar, volatile LAS unsigned* st) {
    XcdBarrier b; b.bar = bar; b.x = xb_xcc_id(); b.st = st;
    if (threadIdx.x == 0) (void)xb_add(&bar[XB_XCNT(b.x)], 1u);
    return b;
}
__device__ __forceinline__ void xcd_barrier_complete(unsigned* bar, unsigned x, unsigned& nloc, unsigned& nx) {
    const unsigned G = gridDim.x * gridDim.y * gridDim.z;
    unsigned sum, cnt, mine, sp = 0u;
    for (;;) {
        sum = 0u; cnt = 0u; mine = 0u;
#pragma unroll
        for (unsigned j = 0; j < 16; ++j) { const unsigned c = xb_ld(&bar[XB_XCNT(j)]); sum += c; cnt += (c > 0u) ? 1u : 0u; mine = (j == x) ? c : mine; }
        if (sum == G) break;
        __builtin_amdgcn_s_sleep(1);
        if ((++sp & 255u) == 0u) { if (xb_ld(&bar[XB_TMO])) break; if (sp > XB_SPIN_CAP) { atomicAdd(&bar[XB_TMO], 1u); break; } }
    }
    nloc = mine > 0u ? mine : 1u; nx = cnt > 0u ? cnt : 1u;
}

__device__ __forceinline__ void xcd_barrier(const XcdBarrier& b) {
    asm volatile("s_waitcnt vmcnt(0)" ::: "memory");
    __syncthreads();
    if (threadIdx.x == 0) {
        unsigned* bar = b.bar;
        __builtin_amdgcn_s_waitcnt(0);
        unsigned nloc = b.st[0], nx = b.st[1];
        if (nloc == 0u) { xcd_barrier_complete(bar, b.x, nloc, nx); b.st[0] = nloc; b.st[1] = nx; }
        const unsigned old = xb_add(&bar[XB_XSUB(b.x)], 1u);
        const unsigned gen = old / nloc;
        if (old + 1u == (gen + 1u) * nloc) {
            __builtin_amdgcn_fence(__ATOMIC_RELEASE, "agent");
            asm volatile("s_waitcnt vmcnt(0)" ::: "memory");
            const unsigned og = xb_add(&bar[XB_TOP], 1u);
            const unsigned tg = og / nx;
            if (og + 1u == (tg + 1u) * nx) xb_add(&bar[XB_TOPGEN], 1u);
            else XB_SPIN(xb_ld(&bar[XB_TOPGEN]) == tg, bar);
            __builtin_amdgcn_fence(__ATOMIC_ACQUIRE, "agent");
            xb_add(&bar[XB_XGEN(b.x)], 1u);
            asm volatile("s_waitcnt vmcnt(0)" ::: "memory");
        } else {
            XB_SPIN(xb_ld(&bar[XB_XGEN(b.x)]) == gen, bar);
            __builtin_amdgcn_fence(__ATOMIC_ACQUIRE, "agent");
            asm volatile("s_waitcnt vmcnt(0)" ::: "memory");
        }
    }
    __syncthreads();
}

typedef const pg8::f32x4 (&AccRef)[2][2][4][2];

struct EpiGm1 {
    static constexpr bool PERM = true, AFTER_DRAIN = false;
    bf16* U; bf16* V; float* vssp;
    __device__ __forceinline__ void operator()(AccRef acc, const pg8::Unit& u, int wr, int wc, int fr, int fq) const {
        const int row0 = u.pm * 256 + wr * 64 + fr; const bool isV = u.pn >= 4; const int col0 = (u.pn & 3) * 256 + wc * 32 + 8 * fq;
        bf16* base = isV ? V : U;
#pragma unroll
        for (int ai = 0; ai < 2; ++ai)
#pragma unroll
            for (int m = 0; m < 4; ++m) { const int row = row0 + ai * 128 + m * 16; bf16* rowp = base + (size_t)row * 1024 + col0; float ss = 0.f;
#pragma unroll
                for (int bj = 0; bj < 2; ++bj) { f32x4 v0 = acc[ai][bj][m][0], v1 = acc[ai][bj][m][1];
#pragma unroll
                    for (int j = 0; j < 4; ++j) { v0[j] = gelu_tanh(v0[j]); v1[j] = gelu_tanh(v1[j]); ss += v0[j] * v0[j] + v1[j] * v1[j]; }
                    v4u w; w.x = pk2(v0[0], v0[1]); w.y = pk2(v0[2], v0[3]); w.z = pk2(v1[0], v1[1]); w.w = pk2(v1[2], v1[3]);
                    *(v4u*)(rowp + bj * 128) = w; }
                if (isV) { ss += __shfl_xor(ss, 16); ss += __shfl_xor(ss, 32); if (fq == 0) vssp[(size_t)row * 16 + (u.pn - 4) * 4 + wc] = ss; } }
    }
};
struct EpiRes {
    static constexpr bool PERM = false, AFTER_DRAIN = false;
    const float* src; float* dst; const float* gate;
    __device__ __forceinline__ void operator()(AccRef acc, const pg8::Unit& u, int wr, int wc, int fr, int fq) const {
        const int row0 = u.pm * 256 + wr * 64 + fr, col0 = u.pn * 256 + wc * 32 + 4 * fq; const int b = (u.pm * 256) / SEQ;
        f32x4 gv[2][2];
#pragma unroll
        for (int bj = 0; bj < 2; ++bj)
#pragma unroll
            for (int n = 0; n < 2; ++n) gv[bj][n] = *(const f32x4*)(gate + (size_t)b * 6144 + col0 + bj * 128 + n * 16);
#pragma unroll
        for (int ai = 0; ai < 2; ++ai)
#pragma unroll
            for (int m = 0; m < 4; ++m) { const size_t off = (size_t)(row0 + ai * 128 + m * 16) * 1024 + col0;
#pragma unroll
                for (int bj = 0; bj < 2; ++bj)
#pragma unroll
                    for (int n = 0; n < 2; ++n) { const f32x4 xs = *(const f32x4*)(src + off + bj * 128 + n * 16); *(f32x4*)(dst + off + bj * 128 + n * 16) = xs + gv[bj][n] * acc[ai][bj][m][n]; } }
    }
};
struct EpiBf {
    static constexpr bool PERM = true, AFTER_DRAIN = false;
    bf16* O; int ldc; int nmask;
    __device__ __forceinline__ void operator()(AccRef acc, const pg8::Unit& u, int wr, int wc, int fr, int fq) const {
        const int row0 = u.pm * 256 + wr * 64 + fr, col0 = (u.pn & nmask) * 256 + wc * 32 + 8 * fq;
#pragma unroll
        for (int ai = 0; ai < 2; ++ai)
#pragma unroll
            for (int m = 0; m < 4; ++m) { bf16* rowp = O + (size_t)(row0 + ai * 128 + m * 16) * ldc + col0;
#pragma unroll
                for (int bj = 0; bj < 2; ++bj) { const f32x4 v0 = acc[ai][bj][m][0], v1 = acc[ai][bj][m][1];
                    v4u w; w.x = pk2(v0[0], v0[1]); w.y = pk2(v0[2], v0[3]); w.z = pk2(v1[0], v1[1]); w.w = pk2(v1[2], v1[3]);
                    *(v4u*)(rowp + bj * 128) = w; } }
    }
};
struct EpiDn1 {
    static constexpr bool PERM = true, AFTER_DRAIN = false;
    bf16* QKV; bf16* Z; float* BA;
    __device__ __forceinline__ void operator()(AccRef acc, const pg8::Unit& u, int wr, int wc, int fr, int fq) const {
        const int row0 = u.pm * 256 + wr * 64 + fr;
        if (u.pn < 12) {
            bf16* base = u.pn < 8 ? QKV : Z; const int ldc = u.pn < 8 ? 2048 : 1024; const int col0 = (u.pn < 8 ? u.pn : u.pn - 8) * 256 + wc * 32 + 8 * fq;
#pragma unroll
            for (int ai = 0; ai < 2; ++ai)
#pragma unroll
                for (int m = 0; m < 4; ++m) { bf16* rowp = base + (size_t)(row0 + ai * 128 + m * 16) * ldc + col0;
#pragma unroll
                    for (int bj = 0; bj < 2; ++bj) { const f32x4 v0 = acc[ai][bj][m][0], v1 = acc[ai][bj][m][1];
                        v4u w; w.x = pk2(v0[0], v0[1]); w.y = pk2(v0[2], v0[3]); w.z = pk2(v1[0], v1[1]); w.w = pk2(v1[2], v1[3]);
                        *(v4u*)(rowp + bj * 128) = w; } }
        } else if (wc == 0 && fq < 2) {
#pragma unroll
            for (int ai = 0; ai < 2; ++ai)
#pragma unroll
                for (int m = 0; m < 4; ++m) { float* rowp = BA + (size_t)(row0 + ai * 128 + m * 16) * 16 + 8 * fq;
                    *(f32x4*)(rowp) = acc[ai][0][m][0]; *(f32x4*)(rowp + 4) = acc[ai][0][m][1]; }
        }
    }
};
struct EpiMoe1 {
    static constexpr bool PERM = true, AFTER_DRAIN = false;
    bf16* O;
    __device__ __forceinline__ void operator()(AccRef acc, const pg8::Unit& u, int wr, int wc, int fr, int fq) const {
        const int row0 = u.pm * 256 + wr * 64 + fr, col0 = (u.pn & 3) * 128 + wc * 32 + 8 * fq;
#pragma unroll
        for (int ai = 0; ai < 2; ++ai)
#pragma unroll
            for (int m = 0; m < 4; ++m) { bf16* rowp = O + (size_t)(row0 + ai * 128 + m * 16) * 512 + col0; float r[8];
#pragma unroll
                for (int n = 0; n < 2; ++n)
#pragma unroll
                    for (int j = 0; j < 4; ++j) { const float a = acc[ai][0][m][n][j], g = acc[ai][1][m][n][j]; r[4 * n + j] = siluf_(a) * g; }
                v4u w; w.x = pk2(r[0], r[1]); w.y = pk2(r[2], r[3]); w.z = pk2(r[4], r[5]); w.w = pk2(r[6], r[7]);
                *(v4u*)rowp = w; }
    }
};
struct MoeOrder {
    const int* tile_e; int total, G, c;
    __device__ __forceinline__ void init(const int* te, int ntiles, int G_, int c_) { tile_e = te; total = ntiles * 4; G = G_; c = c_; }
    __device__ __forceinline__ bool next(int i, pg8::Unit& u) const {
        const long Lx = (long)i * G + c; if (Lx >= total) return false;
        const int w0 = (int)Lx, q = total / 8, r = total % 8, xcd = w0 % 8, off = w0 / 8;
        const int wgid = (xcd < r ? xcd * (q + 1) : r * (q + 1) + (xcd - r) * q) + off;
        const int rt = wgid >> 2; u.pm = rt; u.pn = tile_e[rt] * 4 + (wgid & 3); return true;
    }
    __device__ __forceinline__ void a_ready(const pg8::Unit&) const {}
    __device__ __forceinline__ void done(const pg8::Unit&) const {}
};

struct Args { const float* in[N_IN]; float* out; unsigned char* ws; int ph_lo, ph_hi, li, pad; };

__device__ __forceinline__ void tr_item(const float* __restrict__ W, int ldn, int k0, int n0, bf16* __restrict__ WT, int Kd, int drow0, LAS float* scr, int lane) {
#pragma unroll 8
    for (int i = 0; i < 32; ++i) { const int kk = 2 * i + (lane >> 5); scr[kk * 33 + (lane & 31)] = W[(size_t)(k0 + kk) * ldn + n0 + (lane & 31)]; }
    LDS_WAIT(); asm volatile("" ::: "memory");
    const int c = lane & 7;
#pragma unroll
    for (int j = 0; j < 4; ++j) { const int n = (lane >> 3) + 8 * j; const LAS float* s = scr + (8 * c) * 33 + n;
        v4u o; o.x = pk2(s[0 * 33], s[1 * 33]); o.y = pk2(s[2 * 33], s[3 * 33]); o.z = pk2(s[4 * 33], s[5 * 33]); o.w = pk2(s[6 * 33], s[7 * 33]);
        *(v4u*)(WT + (size_t)(drow0 + n) * Kd + k0 + 8 * c) = o; }
    LDS_WAIT(); asm volatile("" ::: "memory");
}

__device__ __forceinline__ void phase_prologue(const Args& args, LAS unsigned char* lds) {
    int tid_ = threadIdx.x; asm volatile("" : "+v"(tid_)); const int tid = tid_, lane = tid & 63, wave = __builtin_amdgcn_readfirstlane(tid >> 6), G = gridDim.x, bid = blockIdx.x; (void)tid; (void)lane; (void)wave;
    unsigned char* ws = uni_ptr(args.ws);
    LAS float* cact = (LAS float*)(lds + 69632);
    LAS float* red = (LAS float*)(lds + 77824);
    for (int k = tid; k < 2048; k += NTHR) cact[k] = siluf_(args.in[1][k]);
    __syncthreads();
    float* MOD = (float*)(ws + WS_MOD);
    for (int item = bid; item < 384; item += G) {
        const int L = item / 96, cg = item % 96, c4 = tid & 15, ks = tid >> 4;
        const float* w = args.in[LBASE(L) + 2] + (size_t)(ks * 32) * 6144 + cg * 64 + c4 * 4;
        f32x4 a0 = {0.f, 0.f, 0.f, 0.f}, a1 = {0.f, 0.f, 0.f, 0.f};
#pragma unroll 8
        for (int kk = 0; kk < 32; ++kk) { const f32x4 wv = *(const f32x4*)(w + (size_t)kk * 6144); a0 += cact[ks * 32 + kk] * wv; a1 += cact[1024 + ks * 32 + kk] * wv; }
        *(LAS f32x4*)(red + (ks * 2 + 0) * 64 + c4 * 4) = a0; *(LAS f32x4*)(red + (ks * 2 + 1) * 64 + c4 * 4) = a1;
        __syncthreads();
        if (tid < 128) { const int b = tid >> 6, col = tid & 63; float s = 0.f;
#pragma unroll
            for (int k2 = 0; k2 < 32; ++k2) s += red[(k2 * 2 + b) * 64 + col];
            MOD[(size_t)(L * 2 + b) * 6144 + cg * 64 + col] = s + args.in[LBASE(L) + 3][cg * 64 + col]; }
        __syncthreads();
    }
    LAS float* scr = (LAS float*)(lds + wave * 8448);
    const int gw = bid * NWAVES + wave, NGW = G * NWAVES;
    constexpr int PER_L = 24576, N_EXP = 4 * PER_L, N_MIXI = 1536 + 2048 + 1280 + 1536;
    for (int it = gw; it < N_EXP + N_MIXI; it += NGW) {
        const float* src; bf16* dst; int ldn, k0, n0, Kd, drow0;
        if (it < N_EXP) {
            const int L = it / PER_L; int r = it % PER_L; const int ib = LBASE(L) + 4 + NMIX(L);
            if (r < 16384) { const int e = r >> 9, rr = r & 511; k0 = (rr >> 5) * 64; n0 = (rr & 31) * 32; ldn = 1024; Kd = 1024;
                src = args.in[ib + 2] + (size_t)e * 1048576; dst = (bf16*)(ws + WS_W + (size_t)L * 96 * MiB) + (size_t)e * 1048576;
                drow0 = (n0 < 512) ? ((n0 >> 7) * 256 + (n0 & 127)) : ((((n0 - 512) >> 7) * 256) + 128 + ((n0 - 512) & 127)); }
            else { r -= 16384; const int e = r >> 8, rr = r & 255; k0 = (rr >> 5) * 64; n0 = (rr & 31) * 32; ldn = 1024; Kd = 512;
                src = args.in[ib + 3] + (size_t)e * 524288; dst = (bf16*)(ws + WS_W + (size_t)L * 96 * MiB + 64 * MiB) + (size_t)e * 524288; drow0 = n0; }
        } else {
            int r = it - N_EXP; int idx, nblk; size_t woff;
            if (r < 1024) { idx = 6; ldn = 2048; nblk = 64; woff = WMIX_GM_IN0; }
            else if ((r -= 1024) < 512) { idx = 10; ldn = 1024; nblk = 32; woff = WMIX_GM_OUT0; }
            else if ((r -= 512) < 1536) { idx = 19; ldn = 3088; nblk = 96; woff = WMIX_DN_IN; }
            else if ((r -= 1536) < 512) { idx = 24; ldn = 1024; nblk = 32; woff = WMIX_DN_OUT; }
            else if ((r -= 512) < 768) { idx = 33; ldn = 1536; nblk = 48; woff = WMIX_SWA_IN; }
            else if ((r -= 768) < 512) { idx = 37; ldn = 1024; nblk = 32; woff = WMIX_SWA_OUT; }
            else if ((r -= 512) < 1024) { idx = 46; ldn = 2048; nblk = 64; woff = WMIX_GM_IN3; }
            else { r -= 1024; idx = 50; ldn = 1024; nblk = 32; woff = WMIX_GM_OUT3; }
            src = args.in[idx]; dst = (bf16*)(ws + WS_WMIX + woff); k0 = (r / nblk) * 64; n0 = (r % nblk) * 32; Kd = 1024; drow0 = n0;
        }
        tr_item(src, ldn, k0, n0, dst, Kd, drow0, scr, lane);
    }
    const int gt = bid * NTHR + tid, NGT = G * NTHR;
    { bf16* dst = (bf16*)(ws + WS_WMIX + WMIX_DN_IN) + (size_t)3072 * 1024; const float* w = args.in[19];
      for (int i = gt; i < 256 * 1024; i += NGT) { const int n = i >> 10, k = i & 1023; const float v = n < 16 ? w[(size_t)k * 3088 + 3072 + n] : 0.f; dst[i] = (bf16)(pk2(v, 0.f) & 0xffffu); } }
    for (int i = gt; i < 4 * 48 * 1024; i += NGT) {
        const int L = i / 49152, rem = i % 49152, n = rem >> 10, k = rem & 1023;
        const float w = n < 36 ? args.in[LBASE(L) + 4 + NMIX(L)][(size_t)k * 36 + n] : 0.f;
        const unsigned hi = pk2(w, 0.f) & 0xffffu; const float lo = w - bf1((unsigned short)hi);
        bf16* RH = (bf16*)(ws + WS_RTR + (size_t)L * 196608); RH[rem] = (bf16)hi; RH[49152 + rem] = (bf16)(pk2(lo, 0.f) & 0xffffu);
    }
}

__device__ __forceinline__ void norm_store_row(const f32x4 (&v)[4], const float* __restrict__ gain, const float* __restrict__ shift, const float* __restrict__ scale, bf16* __restrict__ hrow, int lane) {
    float ss = 0.f;
#pragma unroll
    for (int j = 0; j < 4; ++j) ss += (v[j][0] * v[j][0] + v[j][1] * v[j][1]) + (v[j][2] * v[j][2] + v[j][3] * v[j][3]);
    const float rstd = __builtin_amdgcn_rsqf(wave_sum(ss) * (1.0f / 1024.0f) + EPS);
#pragma unroll
    for (int j = 0; j < 4; ++j) { const int c = 4 * lane + 256 * j;
        const f32x4 g = *(const f32x4*)(gain + c), sc = *(const f32x4*)(scale + c), sh = *(const f32x4*)(shift + c);
        const f32x4 h = v[j] * rstd * (g * (1.0f + sc)) + sh;
        v2u w; w.x = pk2(h[0], h[1]); w.y = pk2(h[2], h[3]); *(v2u*)(hrow + c) = w; }
}
__device__ __forceinline__ void phase_norm0(const Args& args) {
    int tid_ = threadIdx.x; asm volatile("" : "+v"(tid_)); const int tid = tid_, lane = tid & 63, wave = __builtin_amdgcn_readfirstlane(tid >> 6), G = gridDim.x, bid = blockIdx.x; (void)tid; (void)lane; (void)wave;
    const float* X = args.in[0]; bf16* H = (bf16*)(args.ws + WS_ACT + A_H); const float* MOD = (const float*)(args.ws + WS_MOD);
    for (int t = bid * NWAVES + wave; t < T; t += G * NWAVES) { const int b = t / SEQ; f32x4 v[4];
#pragma unroll
        for (int j = 0; j < 4; ++j) v[j] = *(const f32x4*)(X + (size_t)t * 1024 + 4 * lane + 256 * j);
        const float* m = MOD + (size_t)b * 6144;
        norm_store_row(v, args.in[2], m, m + 1024, H + (size_t)t * 1024, lane); }
}

__device__ __forceinline__ void phase_gm_spatial(const Args& args, int L, LAS unsigned char* lds) {
    int tid_ = threadIdx.x; asm volatile("" : "+v"(tid_)); const int tid = tid_, lane = tid & 63, wave = __builtin_amdgcn_readfirstlane(tid >> 6), G = gridDim.x, bid = blockIdx.x; (void)tid; (void)lane; (void)wave;
    unsigned char* ws = uni_ptr(args.ws); const int ib = LBASE(L) + 4;
    const float* v_norm = args.in[ib + 1]; const float* w_s = args.in[ib + 2]; const float* b_s = args.in[ib + 3];
    const bf16* U = (const bf16*)(ws + WS_ACT + A_U); const bf16* V = (const bf16*)(ws + WS_ACT + A_V); bf16* GT = (bf16*)(ws + WS_ACT + A_GATED);
    const float* VSSP = (const float*)(ws + WS_VSSP);
    LAS bf16* WL = (LAS bf16*)lds; LAS bf16* VT = (LAS bf16*)(lds + 34816); LAS float* rs = (LAS float*)(lds + 69632);
    const int wr = wave >> 2, wc = wave & 3, fr = lane & 15, fq = lane >> 4;
    for (int u = bid; u < 2048; u += G) {
        const int c = u >> 3, g = u & 7; const size_t tok0 = (size_t)c * 128;
        if (tid < 128) { const float* p = VSSP + (tok0 + tid) * 16; float s = 0.f;
#pragma unroll
            for (int i = 0; i < 4; ++i) { const f32x4 q = *(const f32x4*)(p + 4 * i); s += (q[0] + q[1]) + (q[2] + q[3]); }
            rs[tid] = __builtin_amdgcn_rsqf(s * (1.0f / 1024.0f) + EPS); }
        { const int s = tid & 127, dq = tid >> 7; const bf16* vp = V + (tok0 + s) * 1024 + g * 128 + dq * 32;
#pragma unroll
          for (int i = 0; i < 4; ++i) { const v4u q = *(const v4u*)(vp + 8 * i); const unsigned w[4] = {q.x, q.y, q.z, q.w};
#pragma unroll
              for (int e = 0; e < 4; ++e) { VT[(dq * 32 + 8 * i + 2 * e) * 136 + s] = (bf16)(w[e] & 0xffffu); VT[(dq * 32 + 8 * i + 2 * e + 1) * 136 + s] = (bf16)(w[e] >> 16); } } }
        __syncthreads();
        { const int tr = tid >> 2, sq = (tid & 3) * 32; const float* wp = w_s + ((size_t)g * 128 + tr) * 128 + sq;
#pragma unroll
          for (int i = 0; i < 8; ++i) { const f32x4 q = *(const f32x4*)(wp + 4 * i); float o[4];
#pragma unroll
              for (int e = 0; e < 4; ++e) { const int s = sq + 4 * i + e; o[e] = (s <= tr) ? q[e] * rs[s] : 0.f; }
              v2u w; w.x = pk2(o[0], o[1]); w.y = pk2(o[2], o[3]); *(LAS v2u*)(WL + tr * 136 + sq + 4 * i) = w; } }
        __syncthreads();
        f32x4 acc[2][4];
#pragma unroll
        for (int n = 0; n < 2; ++n)
#pragma unroll
            for (int m = 0; m < 4; ++m) acc[n][m] = (f32x4){0.f, 0.f, 0.f, 0.f};
#pragma unroll
        for (int ks = 0; ks < 4; ++ks) { bf16x8 vf[2], wf[4];
#pragma unroll
            for (int n = 0; n < 2; ++n) vf[n] = *(const LAS bf16x8*)(VT + (32 * wc + 16 * n + fr) * 136 + 32 * ks + 8 * fq);
#pragma unroll
            for (int m = 0; m < 4; ++m) wf[m] = *(const LAS bf16x8*)(WL + (64 * wr + 16 * m + fr) * 136 + 32 * ks + 8 * fq);
#pragma unroll
            for (int n = 0; n < 2; ++n)
#pragma unroll
                for (int m = 0; m < 4; ++m) acc[n][m] = __builtin_amdgcn_mfma_f32_16x16x32_bf16(vf[n], wf[m], acc[n][m], 0, 0, 0); }
#pragma unroll
        for (int m = 0; m < 4; ++m) { const int t = 64 * wr + 16 * m + fr; const float bs = b_s[g * 128 + t];
#pragma unroll
            for (int n = 0; n < 2; ++n) { const int d0 = g * 128 + 32 * wc + 16 * n + 4 * fq; const size_t off = (tok0 + t) * 1024 + d0;
                const v2u uu = *(const v2u*)(U + off); const f32x4 vn = *(const f32x4*)(v_norm + d0);
                const float o0 = bflo(uu.x) * (acc[n][m][0] * vn[0] + bs), o1 = bfhi(uu.x) * (acc[n][m][1] * vn[1] + bs), o2 = bflo(uu.y) * (acc[n][m][2] * vn[2] + bs), o3 = bfhi(uu.y) * (acc[n][m][3] * vn[3] + bs);
                v2u w; w.x = pk2(o0, o1); w.y = pk2(o2, o3); *(v2u*)(GT + off) = w; } }
        __syncthreads();
    }
}

__device__ __forceinline__ void phase_swa_attn(const Args& args, LAS unsigned char* lds) {
    int tid_ = threadIdx.x; asm volatile("" : "+v"(tid_)); const int tid = tid_, lane = tid & 63, wave = __builtin_amdgcn_readfirstlane(tid >> 6), G = gridDim.x, bid = blockIdx.x; (void)tid; (void)lane; (void)wave;
    unsigned char* ws = uni_ptr(args.ws);
    const float* q_norm = args.in[34]; const float* k_norm = args.in[35]; const float* sinks = args.in[36];
    const bf16* QKV = (const bf16*)(ws + WS_ACT + A_QKV); bf16* O = (bf16*)(ws + WS_ACT + A_H);
    LAS bf16* KL = (LAS bf16*)lds; LAS bf16* VT = (LAS bf16*)(lds + 36864);
    const int fr = lane & 15, fq = lane >> 4;
    for (int u = bid; u < 1024; u += G) {
        const int n = u & 127, kvh = (u >> 7) & 3, b = u >> 9; const long tok0 = (long)b * SEQ + (long)n * 128;
        { const int key = tid >> 1, half = tid & 1; const long tk = tok0 - 128 + key; float x[32]; float ss = 0.f;
          const bool ok = (n > 0) || (key >= 128);
          const bf16* kp = QKV + (size_t)(ok ? tk : tok0) * 1536 + 1024 + kvh * 64 + half * 32;
#pragma unroll
          for (int i = 0; i < 4; ++i) { const v4u q = *(const v4u*)(kp + 8 * i); const unsigned w[4] = {q.x, q.y, q.z, q.w};
#pragma unroll
              for (int e = 0; e < 4; ++e) { x[8 * i + 2 * e] = bflo(w[e]); x[8 * i + 2 * e + 1] = bfhi(w[e]); } }
#pragma unroll
          for (int i = 0; i < 32; ++i) ss += x[i] * x[i];
          ss += __shfl_xor(ss, 1);
          const float rstd = ok ? __builtin_amdgcn_rsqf(ss * (1.0f / 64.0f) + EPS) : 0.f;
#pragma unroll
          for (int i = 0; i < 4; ++i) { float o[8];
#pragma unroll
              for (int e = 0; e < 8; ++e) o[e] = x[8 * i + e] * rstd * k_norm[half * 32 + 8 * i + e];
              v4u w; w.x = pk2(o[0], o[1]); w.y = pk2(o[2], o[3]); w.z = pk2(o[4], o[5]); w.w = pk2(o[6], o[7]);
              *(LAS v4u*)(KL + key * 72 + half * 32 + 8 * i) = w; } }
        { const int key = tid & 255, dh = tid >> 8; const long tk = tok0 - 128 + key; const bool ok = (n > 0) || (key >= 128);
          const bf16* vp = QKV + (size_t)(ok ? tk : tok0) * 1536 + 1280 + kvh * 64 + dh * 32;
#pragma unroll
          for (int i = 0; i < 4; ++i) { v4u q = *(const v4u*)(vp + 8 * i); if (!ok) q = (v4u){0u, 0u, 0u, 0u}; const unsigned w[4] = {q.x, q.y, q.z, q.w};
#pragma unroll
              for (int e = 0; e < 4; ++e) { VT[(dh * 32 + 8 * i + 2 * e) * 264 + key] = (bf16)(w[e] & 0xffffu); VT[(dh * 32 + 8 * i + 2 * e + 1) * 264 + key] = (bf16)(w[e] >> 16); } } }
        __syncthreads();
        const int g = wave >> 1, qh = wave & 1, hq = kvh * 4 + g; const float sink = sinks[hq];
#pragma unroll 1
        for (int mt = 0; mt < 4; ++mt) {
            asm volatile("" ::: "memory");
            const int qi = qh * 64 + mt * 16 + fr;
            bf16x8 qf[2];
            { float x[16]; float ss = 0.f; const bf16* qp = QKV + (size_t)(tok0 + qi) * 1536 + hq * 64 + 8 * fq;
#pragma unroll
              for (int ks = 0; ks < 2; ++ks) { const v4u q = *(const v4u*)(qp + 32 * ks); const unsigned w[4] = {q.x, q.y, q.z, q.w};
#pragma unroll
                  for (int e = 0; e < 4; ++e) { x[8 * ks + 2 * e] = bflo(w[e]); x[8 * ks + 2 * e + 1] = bfhi(w[e]); } }
#pragma unroll
              for (int i = 0; i < 16; ++i) ss += x[i] * x[i];
              ss += __shfl_xor(ss, 16); ss += __shfl_xor(ss, 32);
              const float rstd = __builtin_amdgcn_rsqf(ss * (1.0f / 64.0f) + EPS) * 0.125f;
#pragma unroll
              for (int ks = 0; ks < 2; ++ks) { float o[8];
#pragma unroll
                  for (int e = 0; e < 8; ++e) o[e] = x[8 * ks + e] * rstd * q_norm[32 * ks + 8 * fq + e];
                  v4u w; w.x = pk2(o[0], o[1]); w.y = pk2(o[2], o[3]); w.z = pk2(o[4], o[5]); w.w = pk2(o[6], o[7]); qf[ks] = __builtin_bit_cast(bf16x8, w); } }
            f32x4 s[16]; float mx = -INFINITY;
#pragma unroll
            for (int nt = 0; nt < 16; ++nt) { f32x4 a = {0.f, 0.f, 0.f, 0.f};
#pragma unroll
                for (int ks = 0; ks < 2; ++ks) { const bf16x8 kf = *(const LAS bf16x8*)(KL + (16 * nt + fr) * 72 + 32 * ks + 8 * fq); a = __builtin_amdgcn_mfma_f32_16x16x32_bf16(kf, qf[ks], a, 0, 0, 0); }
#pragma unroll
                for (int i = 0; i < 4; ++i) { const int kj = 16 * nt + 4 * fq + i; const bool valid = (kj > qi) && (kj <= qi + 128) && ((n > 0) || (kj >= 128)); a[i] = valid ? a[i] : -INFINITY; mx = fmaxf(mx, a[i]); }
                s[nt] = a; }
            mx = fmaxf(mx, __shfl_xor(mx, 16)); mx = fmaxf(mx, __shfl_xor(mx, 32)); mx = fmaxf(mx, sink);
            float l = 0.f;
#pragma unroll
            for (int nt = 0; nt < 16; ++nt)
#pragma unroll
                for (int i = 0; i < 4; ++i) { const float p = fast_exp(s[nt][i] - mx); s[nt][i] = p; l += p; }
            l += __shfl_xor(l, 16); l += __shfl_xor(l, 32); l += fast_exp(sink - mx);
            f32x4 o[4];
#pragma unroll
            for (int dt = 0; dt < 4; ++dt) o[dt] = (f32x4){0.f, 0.f, 0.f, 0.f};
#pragma unroll
            for (int st = 0; st < 8; ++st) {
                v4u pw; pw.x = pk2(s[2 * st][0], s[2 * st][1]); pw.y = pk2(s[2 * st][2], s[2 * st][3]); pw.z = pk2(s[2 * st + 1][0], s[2 * st + 1][1]); pw.w = pk2(s[2 * st + 1][2], s[2 * st + 1][3]);
                const bf16x8 pf = __builtin_bit_cast(bf16x8, pw);
#pragma unroll
                for (int dt = 0; dt < 4; ++dt) { const LAS bf16* vp = VT + (16 * dt + fr) * 264 + 32 * st + 4 * fq;
                    const v2u v0 = *(const LAS v2u*)vp, v1 = *(const LAS v2u*)(vp + 16); v4u vw; vw.x = v0.x; vw.y = v0.y; vw.z = v1.x; vw.w = v1.y;
                    o[dt] = __builtin_amdgcn_mfma_f32_16x16x32_bf16(__builtin_bit_cast(bf16x8, vw), pf, o[dt], 0, 0, 0); } }
            const float inv = 1.0f / l;
#pragma unroll
            for (int dt = 0; dt < 4; ++dt) { v2u w; w.x = pk2(o[dt][0] * inv, o[dt][1] * inv); w.y = pk2(o[dt][2] * inv, o[dt][3] * inv);
                *(v2u*)(O + (size_t)(tok0 + qi) * 1024 + hq * 64 + 16 * dt + 4 * fq) = w; }
        }
        __syncthreads();
    }
}

__device__ __forceinline__ void phase_dn_prep(const Args& args) {
    int tid_ = threadIdx.x; asm volatile("" : "+v"(tid_)); const int tid = tid_, lane = tid & 63, wave = __builtin_amdgcn_readfirstlane(tid >> 6), G = gridDim.x, bid = blockIdx.x; (void)tid; (void)lane; (void)wave;
    unsigned char* ws = uni_ptr(args.ws); const float* conv_w = args.in[20]; const float* a_log = args.in[21]; const float* dt_bias = args.in[22];
    const bf16* QKV = (const bf16*)(ws + WS_ACT + A_QKV); bf16* QN = (bf16*)(ws + WS_ACT + A_QN); bf16* KN = (bf16*)(ws + WS_ACT + A_KN); bf16* VV = (bf16*)(ws + WS_ACT + A_VV);
    const float* BA = (const float*)(ws + WS_BA); float* DNB = (float*)(ws + WS_DNB);
    for (int t = bid * NWAVES + wave; t < T; t += G * NWAVES) { const int pos = t % SEQ;
#pragma unroll
        for (int j = 0; j < 4; ++j) { const int ch = 8 * lane + 512 * j; float a[8];
#pragma unroll
            for (int e = 0; e < 8; ++e) a[e] = 0.f;
#pragma unroll
            for (int tap = 0; tap < 4; ++tap) { if (pos - 3 + tap >= 0) { const v4u q = *(const v4u*)(QKV + (size_t)(t - 3 + tap) * 2048 + ch); const f32x4 w0 = *(const f32x4*)(conv_w + tap * 2048 + ch), w1 = *(const f32x4*)(conv_w + tap * 2048 + ch + 4);
                a[0] += w0[0] * bflo(q.x); a[1] += w0[1] * bfhi(q.x); a[2] += w0[2] * bflo(q.y); a[3] += w0[3] * bfhi(q.y); a[4] += w1[0] * bflo(q.z); a[5] += w1[1] * bfhi(q.z); a[6] += w1[2] * bflo(q.w); a[7] += w1[3] * bfhi(q.w); } }
            float ss = 0.f;
#pragma unroll
            for (int e = 0; e < 8; ++e) { a[e] = siluf_(a[e]); ss += a[e] * a[e]; }
            if (j < 2) { ss += __shfl_xor(ss, 1); ss += __shfl_xor(ss, 2); ss += __shfl_xor(ss, 4); ss += __shfl_xor(ss, 8);
                const float r = __builtin_amdgcn_rsqf(ss + EPS); bf16* dst = (j == 0 ? QN : KN) + (size_t)t * 512 + 8 * lane;
                v4u w; w.x = pk2(a[0] * r, a[1] * r); w.y = pk2(a[2] * r, a[3] * r); w.z = pk2(a[4] * r, a[5] * r); w.w = pk2(a[6] * r, a[7] * r); *(v4u*)dst = w; }
            else { v4u w; w.x = pk2(a[0], a[1]); w.y = pk2(a[2], a[3]); w.z = pk2(a[4], a[5]); w.w = pk2(a[6], a[7]); *(v4u*)(VV + (size_t)t * 1024 + 8 * lane + 512 * (j - 2)) = w; } }
        if (lane < 8) { const float bi = BA[(size_t)t * 16 + lane], ai = BA[(size_t)t * 16 + 8 + lane] + dt_bias[lane];
            const float sp = fmaxf(ai, 0.f) + log1pf(expf(-fabsf(ai)));
            DNB[(size_t)t * 16 + lane] = 1.0f / (1.0f + expf(-bi)); DNB[(size_t)t * 16 + 8 + lane] = -expf(a_log[lane]) * sp; }
    }
}
constexpr int FA_STRIDE = 25600, FB_STRIDE = 32768, FU_STRIDE = 16384;
constexpr float DN_SCALE = 0.08838834764831845f;
__device__ __forceinline__ void phase_dn_chunk(const Args& args, LAS unsigned char* lds) {
    int tid_ = threadIdx.x; asm volatile("" : "+v"(tid_)); const int tid = tid_, lane = tid & 63, wave = __builtin_amdgcn_readfirstlane(tid >> 6), G = gridDim.x, bid = blockIdx.x;
    unsigned char* ws = uni_ptr(args.ws);
    const bf16* QN = (const bf16*)(ws + WS_ACT + A_QN); const bf16* KN = (const bf16*)(ws + WS_ACT + A_KN); const bf16* VV = (const bf16*)(ws + WS_ACT + A_VV);
    const float* DNB = (const float*)(ws + WS_DNB);
    unsigned char* FA = ws + WS_ACT + A_FA; unsigned char* FB = ws + WS_ACT + A_FB; unsigned char* FU = ws + WS_ACT + A_FU;
    LAS float* Al = (LAS float*)(lds + wave * 16384);
    LAS float* tb = (LAS float*)(lds + LDSCTL_OFF + 2048 + wave * 512);
    const int fr = lane & 15, fq = lane >> 4;
    for (int it = bid * NWAVES + wave; it < 4096; it += G * NWAVES) {
        const int b = it >> 11, hv = (it >> 8) & 7, n = it & 255, hq = hv >> 1; const size_t t0 = (size_t)b * SEQ + (size_t)n * 64; const int itq = (b * 4 + hq) * 256 + n;
        unsigned char* fa = FA + (size_t)it * FA_STRIDE; unsigned char* fb = FB + (size_t)itq * FB_STRIDE;
        const float bv = DNB[(t0 + lane) * 16 + hv]; float gcv = DNB[(t0 + lane) * 16 + 8 + hv];
#pragma unroll
        for (int o = 1; o < 64; o <<= 1) { const float t = __shfl_up(gcv, o); if (lane >= o) gcv += t; }
        const float gll = __shfl(gcv, 63);
        tb[lane] = gcv; tb[64 + lane] = bv;
        { float* fe = (float*)(fa + 24576); fe[lane] = DN_SCALE * expf(gcv); fe[64 + lane] = expf(gll - gcv); if (lane == 0) fe[128] = expf(gll); }
        asm volatile("" ::: "memory");
        bf16x8 kf[4][4];
#pragma unroll
        for (int t = 0; t < 4; ++t)
#pragma unroll
            for (int ks = 0; ks < 4; ++ks) kf[t][ks] = *(const bf16x8*)(KN + (t0 + 16 * t + fr) * 512 + hq * 128 + 32 * ks + 8 * fq);
#pragma unroll
        for (int m = 0; m < 4; ++m) { const int c = 16 * m + fr; const float bm = tb[64 + c], gm = tb[c];
            bf16x8 qf[4];
#pragma unroll
            for (int ks = 0; ks < 4; ++ks) qf[ks] = *(const bf16x8*)(QN + (t0 + c) * 512 + hq * 128 + 32 * ks + 8 * fq);
            f32x4 tl[4];
#pragma unroll
            for (int t = 0; t < 4; ++t) {
                if (t <= m) { f32x4 ak = {0.f, 0.f, 0.f, 0.f}, aq = {0.f, 0.f, 0.f, 0.f};
#pragma unroll
                    for (int ks = 0; ks < 4; ++ks) { ak = __builtin_amdgcn_mfma_f32_16x16x32_bf16(kf[t][ks], kf[m][ks], ak, 0, 0, 0); aq = __builtin_amdgcn_mfma_f32_16x16x32_bf16(kf[t][ks], qf[ks], aq, 0, 0, 0); }
                    const f32x4 gs4 = *(const LAS f32x4*)(tb + 16 * t + 4 * fq); f32x4 av;
#pragma unroll
                    for (int r = 0; r < 4; ++r) { const int s = 16 * t + 4 * fq + r; const float dec = expf(fminf(gm - gs4[r], 0.f)); av[r] = (s < c) ? bm * ak[r] * dec : 0.f; tl[t][r] = (s <= c) ? DN_SCALE * aq[r] * dec : 0.f; }
                    *(LAS f32x4*)(Al + c * 64 + 16 * t + 4 * fq) = av; }
                else tl[t] = (f32x4){0.f, 0.f, 0.f, 0.f}; }
#pragma unroll
            for (int k2 = 0; k2 < 2; ++k2) { v4u w; w.x = pk2(tl[2 * k2][0], tl[2 * k2][1]); w.y = pk2(tl[2 * k2][2], tl[2 * k2][3]); w.z = pk2(tl[2 * k2 + 1][0], tl[2 * k2 + 1][1]); w.w = pk2(tl[2 * k2 + 1][2], tl[2 * k2 + 1][3]);
                *(v4u*)(fa + 16384 + (m * 2 + k2) * 1024 + lane * 16) = w; } }
        asm volatile("s_waitcnt lgkmcnt(0)" ::: "memory");
        float Tc[64];
#pragma unroll
        for (int m = 0; m < 64; ++m) Tc[m] = (m == lane) ? 1.f : 0.f;
#pragma unroll
        for (int r = 1; r < 64; ++r) { float acc = 0.f;
#pragma unroll
            for (int m4 = 0; m4 < (r + 3) / 4; ++m4) { const f32x4 a4 = *(const LAS f32x4*)(Al + r * 64 + 4 * m4);
#pragma unroll
                for (int e = 0; e < 4; ++e) if (4 * m4 + e < r) acc += a4[e] * Tc[4 * m4 + e]; }
            Tc[r] -= acc; }
        asm volatile("s_waitcnt lgkmcnt(0)" ::: "memory");
        LAS bf16* T1l = (LAS bf16*)Al; LAS bf16* T2l = T1l + 4096;
        { const float c1 = bv, c2 = bv * expf(gcv);
#pragma unroll
          for (int i = 0; i < 64; ++i) { T1l[i * 64 + lane] = (bf16)(pk2(Tc[i] * c1, 0.f) & 0xffffu); T2l[i * 64 + lane] = (bf16)(pk2(Tc[i] * c2, 0.f) & 0xffffu); } }
        asm volatile("s_waitcnt lgkmcnt(0)" ::: "memory");
        { bf16x8 t1f[4][2];
#pragma unroll
          for (int m = 0; m < 4; ++m)
#pragma unroll
              for (int k2 = 0; k2 < 2; ++k2) t1f[m][k2] = *(const LAS bf16x8*)(T1l + (16 * m + fr) * 64 + 32 * k2 + 8 * fq);
#pragma unroll 1
          for (int j = 0; j < 8; ++j) { bf16x8 vf[2];
#pragma unroll
              for (int k2 = 0; k2 < 2; ++k2)
#pragma unroll
                  for (int i = 0; i < 8; ++i) vf[k2][i] = (short)VV[(t0 + 32 * k2 + 8 * fq + i) * 1024 + hv * 128 + 16 * j + fr];
#pragma unroll
              for (int m = 0; m < 4; ++m) { f32x4 a = {0.f, 0.f, 0.f, 0.f};
#pragma unroll
                  for (int k2 = 0; k2 < 2; ++k2) a = __builtin_amdgcn_mfma_f32_16x16x32_bf16(t1f[m][k2], vf[k2], a, 0, 0, 0);
                  v2u w; w.x = pk2(a[0], a[1]); w.y = pk2(a[2], a[3]); *(v2u*)(FU + (size_t)it * FU_STRIDE + ((j * 4 + m) * 64 + lane) * 8) = w; } } }
        { bf16x8 ktf[8][2];
#pragma unroll
          for (int dt = 0; dt < 8; ++dt)
#pragma unroll
              for (int k2 = 0; k2 < 2; ++k2)
#pragma unroll
                  for (int i = 0; i < 8; ++i) ktf[dt][k2][i] = (short)KN[(t0 + 32 * k2 + 16 * (i >> 2) + 4 * fq + (i & 3)) * 512 + hq * 128 + 16 * dt + fr];
          if ((hv & 1) == 0) {
#pragma unroll
              for (int dt = 0; dt < 8; ++dt)
#pragma unroll
                  for (int k2 = 0; k2 < 2; ++k2) *(bf16x8*)(fb + 16384 + (dt * 2 + k2) * 1024 + lane * 16) = ktf[dt][k2];
#pragma unroll
              for (int m = 0; m < 4; ++m)
#pragma unroll
                  for (int ks = 0; ks < 4; ++ks) { const bf16* qp = QN + (t0 + 16 * m + fr) * 512 + hq * 128 + 32 * ks + 4 * fq; const v2u lo = *(const v2u*)qp, hi = *(const v2u*)(qp + 16);
                      v4u w; w.x = lo.x; w.y = lo.y; w.z = hi.x; w.w = hi.y; *(v4u*)(fb + (m * 4 + ks) * 1024 + lane * 16) = w; } }
#pragma unroll
          for (int m = 0; m < 4; ++m) { bf16x8 t2f[2];
#pragma unroll
              for (int k2 = 0; k2 < 2; ++k2) { const LAS bf16* tp = T2l + (16 * m + fr) * 64 + 32 * k2 + 4 * fq; const v2u lo = *(const LAS v2u*)tp, hi = *(const LAS v2u*)(tp + 16); v4u w; w.x = lo.x; w.y = lo.y; w.z = hi.x; w.w = hi.y; t2f[k2] = __builtin_bit_cast(bf16x8, w); }
              f32x4 acc[8];
#pragma unroll
              for (int dt = 0; dt < 8; ++dt) { acc[dt] = (f32x4){0.f, 0.f, 0.f, 0.f};
#pragma unroll
                  for (int k2 = 0; k2 < 2; ++k2) acc[dt] = __builtin_amdgcn_mfma_f32_16x16x32_bf16(ktf[dt][k2], t2f[k2], acc[dt], 0, 0, 0); }
#pragma unroll
              for (int ks = 0; ks < 4; ++ks) { v4u w; w.x = pk2(-acc[2 * ks][0], -acc[2 * ks][1]); w.y = pk2(-acc[2 * ks][2], -acc[2 * ks][3]); w.z = pk2(-acc[2 * ks + 1][0], -acc[2 * ks + 1][1]); w.w = pk2(-acc[2 * ks + 1][2], -acc[2 * ks + 1][3]);
                  *(v4u*)(fa + (m * 4 + ks) * 1024 + lane * 16) = w; } } }
        asm volatile("s_waitcnt lgkmcnt(0)" ::: "memory");
    }
}
__device__ __forceinline__ void phase_dn_scan(const Args& args, LAS unsigned char* lds) {
    int tid_ = threadIdx.x; asm volatile("" : "+v"(tid_)); const int tid = tid_, lane = tid & 63, wave = __builtin_amdgcn_readfirstlane(tid >> 6), G = gridDim.x, bid = blockIdx.x;
    if (wave != 0) return;
    unsigned char* ws = uni_ptr(args.ws);
    const unsigned char* FA = ws + WS_ACT + A_FA; const unsigned char* FB = ws + WS_ACT + A_FB; const unsigned char* FU = ws + WS_ACT + A_FU; bf16* O = (bf16*)(ws + WS_ACT + A_O);
    const int fr = lane & 15, fq = lane >> 4;
    constexpr int SLOT = 57344;
    for (int sidx = bid; sidx < 128; sidx += G) {
        const int bh = (sidx & 7) * 2 + (sidx >> 6), j = (sidx >> 3) & 7, b = bh >> 3, hv = bh & 7, hq = hv >> 1;
        const int it0 = bh * 256, itq0 = (b * 4 + hq) * 256;
        f32x4 S[8];
#pragma unroll
        for (int dt = 0; dt < 8; ++dt) S[dt] = (f32x4){0.f, 0.f, 0.f, 0.f};
        f32x4 egc[4], ekd[4]; v2u uu[4]; float gl;
#define DN_ISSUE(nn, E, K, U, GL) do { const unsigned char* fa_ = FA + (size_t)(it0 + (nn)) * FA_STRIDE; const unsigned char* fb_ = FB + (size_t)(itq0 + (nn)) * FB_STRIDE; LAS unsigned char* sl_ = lds + ((nn) & 1) * SLOT; \
            _Pragma("unroll") for (int f = 0; f < 24; ++f) __builtin_amdgcn_global_load_lds((const unsigned*)(fa_ + f * 1024 + lane * 16), (LAS unsigned*)(sl_ + f * 1024), 16, 0, 0); \
            _Pragma("unroll") for (int f = 0; f < 32; ++f) __builtin_amdgcn_global_load_lds((const unsigned*)(fb_ + f * 1024 + lane * 16), (LAS unsigned*)(sl_ + 24576 + f * 1024), 16, 0, 0); \
            const float* fe_ = (const float*)(fa_ + 24576); \
            _Pragma("unroll") for (int m = 0; m < 4; ++m) { E[m] = *(const f32x4*)(fe_ + 16 * m + 4 * fq); K[m] = *(const f32x4*)(fe_ + 64 + 16 * m + 4 * fq); U[m] = *(const v2u*)(FU + (size_t)(it0 + (nn)) * FU_STRIDE + ((j * 4 + m) * 64 + lane) * 8); } \
            GL = fe_[128]; } while (0)
        DN_ISSUE(0, egc, ekd, uu, gl);
        for (int n = 0; n < 256; ++n) {
            if (n == 0) asm volatile("s_waitcnt vmcnt(0)" ::: "memory"); else asm volatile("s_waitcnt vmcnt(16)" ::: "memory");
            f32x4 egn[4], ekn[4]; v2u un[4]; float gln = 0.f;
#pragma unroll
            for (int m = 0; m < 4; ++m) { egn[m] = egc[m]; ekn[m] = ekd[m]; un[m] = uu[m]; }
            if (n + 1 < 256) { asm volatile("s_waitcnt lgkmcnt(0)" ::: "memory"); DN_ISSUE(n + 1, egn, ekn, un, gln); }
            const LAS unsigned char* base = lds + (n & 1) * SLOT + lane * 16;
            bf16x8 sf[4];
#pragma unroll
            for (int ks = 0; ks < 4; ++ks) { v4u w; w.x = pk2(S[2 * ks][0], S[2 * ks][1]); w.y = pk2(S[2 * ks][2], S[2 * ks][3]); w.z = pk2(S[2 * ks + 1][0], S[2 * ks + 1][1]); w.w = pk2(S[2 * ks + 1][2], S[2 * ks + 1][3]); sf[ks] = __builtin_bit_cast(bf16x8, w); }
            f32x4 av[4], ao[4];
#pragma unroll
            for (int m = 0; m < 4; ++m) { av[m] = (f32x4){bflo(uu[m].x), bfhi(uu[m].x), bflo(uu[m].y), bfhi(uu[m].y)}; ao[m] = (f32x4){0.f, 0.f, 0.f, 0.f};
#pragma unroll
                for (int ks = 0; ks < 4; ++ks) { av[m] = __builtin_amdgcn_mfma_f32_16x16x32_bf16(*(const LAS bf16x8*)(base + (m * 4 + ks) * 1024), sf[ks], av[m], 0, 0, 0);
                    ao[m] = __builtin_amdgcn_mfma_f32_16x16x32_bf16(*(const LAS bf16x8*)(base + 24576 + (m * 4 + ks) * 1024), sf[ks], ao[m], 0, 0, 0); }
                ao[m] = ao[m] * egc[m]; }
            bf16x8 vf[2], vpf[2];
#pragma unroll
            for (int k2 = 0; k2 < 2; ++k2) { v4u w; w.x = pk2(av[2 * k2][0], av[2 * k2][1]); w.y = pk2(av[2 * k2][2], av[2 * k2][3]); w.z = pk2(av[2 * k2 + 1][0], av[2 * k2 + 1][1]); w.w = pk2(av[2 * k2 + 1][2], av[2 * k2 + 1][3]); vf[k2] = __builtin_bit_cast(bf16x8, w);
                const f32x4 p0 = av[2 * k2] * ekd[2 * k2], p1 = av[2 * k2 + 1] * ekd[2 * k2 + 1];
                v4u x; x.x = pk2(p0[0], p0[1]); x.y = pk2(p0[2], p0[3]); x.z = pk2(p1[0], p1[1]); x.w = pk2(p1[2], p1[3]); vpf[k2] = __builtin_bit_cast(bf16x8, x); }
#pragma unroll
            for (int m = 0; m < 4; ++m)
#pragma unroll
                for (int k2 = 0; k2 < 2; ++k2) ao[m] = __builtin_amdgcn_mfma_f32_16x16x32_bf16(*(const LAS bf16x8*)(base + 16384 + (m * 2 + k2) * 1024), vf[k2], ao[m], 0, 0, 0);
#pragma unroll
            for (int dt = 0; dt < 8; ++dt) { S[dt] = S[dt] * gl;
#pragma unroll
                for (int k2 = 0; k2 < 2; ++k2) S[dt] = __builtin_amdgcn_mfma_f32_16x16x32_bf16(*(const LAS bf16x8*)(base + 40960 + (dt * 2 + k2) * 1024), vpf[k2], S[dt], 0, 0, 0); }
            asm volatile("s_waitcnt lgkmcnt(0)" ::: "memory");
            { bf16* op = O + ((size_t)b * SEQ + (size_t)n * 64 + 4 * fq) * 1024 + hv * 128 + 16 * j + fr;
#pragma unroll
              for (int m = 0; m < 4; ++m)
#pragma unroll
                  for (int r = 0; r < 4; ++r) op[(size_t)(16 * m + r) * 1024] = (bf16)(pk2(ao[m][r], 0.f) & 0xffffu); }
#pragma unroll
            for (int m = 0; m < 4; ++m) { egc[m] = egn[m]; ekd[m] = ekn[m]; uu[m] = un[m]; }
            gl = (n + 1 < 256) ? gln : gl;
        }
#undef DN_ISSUE
    }
}
__device__ __forceinline__ void phase_dn_ogate(const Args& args) {
    int tid_ = threadIdx.x; asm volatile("" : "+v"(tid_)); const int tid = tid_, lane = tid & 63, wave = __builtin_amdgcn_readfirstlane(tid >> 6), G = gridDim.x, bid = blockIdx.x; (void)tid; (void)lane; (void)wave;
    unsigned char* ws = uni_ptr(args.ws); const float* o_norm = args.in[23];
    const bf16* O = (const bf16*)(ws + WS_ACT + A_O); const bf16* Z = (const bf16*)(ws + WS_ACT + A_Z); bf16* GT = (bf16*)(ws + WS_ACT + A_H);
    for (int t = bid * NWAVES + wave; t < T; t += G * NWAVES) {
#pragma unroll
        for (int j = 0; j < 2; ++j) { const int ch = 8 * lane + 512 * j; const v4u q = *(const v4u*)(O + (size_t)t * 1024 + ch), z = *(const v4u*)(Z + (size_t)t * 1024 + ch);
            float o[8] = {bflo(q.x), bfhi(q.x), bflo(q.y), bfhi(q.y), bflo(q.z), bfhi(q.z), bflo(q.w), bfhi(q.w)}; const float zz[8] = {bflo(z.x), bfhi(z.x), bflo(z.y), bfhi(z.y), bflo(z.z), bfhi(z.z), bflo(z.w), bfhi(z.w)};
            float ss = 0.f;
#pragma unroll
            for (int e = 0; e < 8; ++e) ss += o[e] * o[e];
            ss += __shfl_xor(ss, 1); ss += __shfl_xor(ss, 2); ss += __shfl_xor(ss, 4); ss += __shfl_xor(ss, 8);
            const float r = __builtin_amdgcn_rsqf(ss * (1.0f / 128.0f) + EPS);
#pragma unroll
            for (int e = 0; e < 8; ++e) o[e] = o[e] * r * o_norm[(ch & 127) + e] * siluf_(zz[e]);
            v4u w; w.x = pk2(o[0], o[1]); w.y = pk2(o[2], o[3]); w.z = pk2(o[4], o[5]); w.w = pk2(o[6], o[7]); *(v4u*)(GT + (size_t)t * 1024 + ch) = w; }
    }
}

__device__ __forceinline__ void phase_moe_router(const Args& args, int L, LAS unsigned char* lds) {
    int tid_ = threadIdx.x; asm volatile("" : "+v"(tid_)); const int tid = tid_, lane = tid & 63, wave = __builtin_amdgcn_readfirstlane(tid >> 6), G = gridDim.x, bid = blockIdx.x; (void)tid; (void)lane; (void)wave;
    unsigned char* ws = uni_ptr(args.ws); const int ib = LBASE(L) + 4 + NMIX(L);
    const float* X = args.out; bf16* H = (bf16*)(ws + WS_ACT + A_H); const float* MOD = (const float*)(ws + WS_MOD) + (size_t)L * 2 * 6144;
    const float* nf = args.in[LBASE(L) + 1]; const float* rb = args.in[ib + 1];
    const bf16* RH = (const bf16*)(ws + WS_RTR + (size_t)L * 196608); const bf16* RLo = RH + 49152;
    int* EID = (int*)(ws + WS_EID); float* GATE = (float*)(ws + WS_GATE); int* CNT = (int*)(ws + WS_CNT);
    LAS float* gs = (LAS float*)lds; LAS float* sh = gs + 1024; LAS int* lcnt = (LAS int*)(lds + 8192); LAS float* scr = (LAS float*)(lds + 8448 + wave * 3072);
    const int r = lane & 15, q = lane >> 4;
    for (int item = bid; item < T / 128; item += G) {
        const int r0 = item * 128, b = r0 / SEQ; const float* m = MOD + (size_t)b * 6144;
        __syncthreads();
        for (int k = tid; k < 1024; k += NTHR) { gs[k] = nf[k] * (1.0f + m[4096 + k]); sh[k] = m[3072 + k]; }
        if (tid < 32) lcnt[tid] = 0;
        __syncthreads();
        const int row = r0 + 16 * wave + r; const float* xp = X + (size_t)row * 1024 + 8 * q;
        float ss = 0.f;
#pragma unroll 8
        for (int j = 0; j < 32; ++j) { const f32x4 v0 = *(const f32x4*)(xp + 32 * j), v1 = *(const f32x4*)(xp + 32 * j + 4); ss += (v0[0] * v0[0] + v0[1] * v0[1]) + (v0[2] * v0[2] + v0[3] * v0[3]) + (v1[0] * v1[0] + v1[1] * v1[1]) + (v1[2] * v1[2] + v1[3] * v1[3]); }
        ss += __shfl_xor(ss, 16); ss += __shfl_xor(ss, 32);
        const float rstd = __builtin_amdgcn_rsqf(ss * (1.0f / 1024.0f) + EPS);
        f32x4 acc[3];
#pragma unroll
        for (int nt = 0; nt < 3; ++nt) acc[nt] = (f32x4){0.f, 0.f, 0.f, 0.f};
#pragma unroll 2
        for (int j = 0; j < 32; ++j) { const int k0 = 32 * j + 8 * q; const f32x4 v0 = *(const f32x4*)(xp + 32 * j), v1 = *(const f32x4*)(xp + 32 * j + 4);
            const f32x4 g0 = *(const LAS f32x4*)(gs + k0), g1 = *(const LAS f32x4*)(gs + k0 + 4), s0 = *(const LAS f32x4*)(sh + k0), s1 = *(const LAS f32x4*)(sh + k0 + 4);
            const f32x4 h0 = v0 * rstd * g0 + s0, h1 = v1 * rstd * g1 + s1;
            v4u hi; hi.x = pk2(h0[0], h0[1]); hi.y = pk2(h0[2], h0[3]); hi.z = pk2(h1[0], h1[1]); hi.w = pk2(h1[2], h1[3]);
            v4u lo; lo.x = pk2(h0[0] - bflo(hi.x), h0[1] - bfhi(hi.x)); lo.y = pk2(h0[2] - bflo(hi.y), h0[3] - bfhi(hi.y)); lo.z = pk2(h1[0] - bflo(hi.z), h1[1] - bfhi(hi.z)); lo.w = pk2(h1[2] - bflo(hi.w), h1[3] - bfhi(hi.w));
            *(v4u*)(H + (size_t)row * 1024 + k0) = hi;
            const bf16x8 ahi = __builtin_bit_cast(bf16x8, hi), alo = __builtin_bit_cast(bf16x8, lo);
#pragma unroll
            for (int nt = 0; nt < 3; ++nt) { const bf16x8 bh = *(const bf16x8*)(RH + (size_t)(nt * 16 + r) * 1024 + k0), bl = *(const bf16x8*)(RLo + (size_t)(nt * 16 + r) * 1024 + k0);
                acc[nt] = __builtin_amdgcn_mfma_f32_16x16x32_bf16(bh, ahi, acc[nt], 0, 0, 0); acc[nt] = __builtin_amdgcn_mfma_f32_16x16x32_bf16(bl, ahi, acc[nt], 0, 0, 0); acc[nt] = __builtin_amdgcn_mfma_f32_16x16x32_bf16(bh, alo, acc[nt], 0, 0, 0); } }
#pragma unroll
        for (int nt = 0; nt < 3; ++nt) *(LAS f32x4*)(scr + r * 48 + 16 * nt + 4 * q) = acc[nt];
        LDS_WAIT(); asm volatile("" ::: "memory");
        if (lane < 16) { float lg[36];
#pragma unroll
            for (int i = 0; i < 9; ++i) { const f32x4 v = *(const LAS f32x4*)(scr + r * 48 + 4 * i); lg[4 * i] = v[0] + rb[4 * i]; lg[4 * i + 1] = v[1] + rb[4 * i + 1]; lg[4 * i + 2] = v[2] + rb[4 * i + 2]; lg[4 * i + 3] = v[3] + rb[4 * i + 3]; }
            int gsel = 0; float gm = lg[0];
#pragma unroll
            for (int i = 1; i < 4; ++i) if (lg[i] > gm) { gm = lg[i]; gsel = i; }
            float gsum = 0.f;
#pragma unroll
            for (int i = 0; i < 4; ++i) gsum += expf(lg[i] - gm);
            const float pg = 1.0f / gsum;
            float le[8];
#pragma unroll
            for (int i = 0; i < 8; ++i) le[i] = gsel == 0 ? lg[4 + i] : (gsel == 1 ? lg[12 + i] : (gsel == 2 ? lg[20 + i] : lg[28 + i]));
            int j1 = 0; float m1 = le[0];
#pragma unroll
            for (int i = 1; i < 8; ++i) if (le[i] > m1) { m1 = le[i]; j1 = i; }
            int j2 = -1; float m2 = -INFINITY;
#pragma unroll
            for (int i = 0; i < 8; ++i) if (i != j1 && le[i] > m2) { m2 = le[i]; j2 = i; }
            const float p2 = expf(m2 - m1), den = 1.0f / (1.0f + p2);
            const int e1 = gsel * 8 + j1, e2 = gsel * 8 + j2;
            EID[(size_t)row * 2] = e1; EID[(size_t)row * 2 + 1] = e2; GATE[(size_t)row * 2] = pg * den; GATE[(size_t)row * 2 + 1] = pg * p2 * den;
            __hip_atomic_fetch_add(lcnt + e1, 1, __ATOMIC_RELAXED, __HIP_MEMORY_SCOPE_WORKGROUP); __hip_atomic_fetch_add(lcnt + e2, 1, __ATOMIC_RELAXED, __HIP_MEMORY_SCOPE_WORKGROUP); }
        __syncthreads();
        if (tid < 32) CNT[item * 32 + tid] = lcnt[tid];
    }
}
__device__ __forceinline__ void phase_moe_scatter(const Args& args, LAS unsigned char* lds) {
    int tid_ = threadIdx.x; asm volatile("" : "+v"(tid_)); const int tid = tid_, lane = tid & 63, wave = __builtin_amdgcn_readfirstlane(tid >> 6), G = gridDim.x, bid = blockIdx.x; (void)tid; (void)lane; (void)wave;
    unsigned char* ws = uni_ptr(args.ws);
    const bf16* H = (const bf16*)(ws + WS_ACT + A_H); bf16* XG = (bf16*)(ws + WS_ACT + A_XG);
    const int* EID = (const int*)(ws + WS_EID); int* SLOT = (int*)(ws + WS_SLOT); const int* CNT = (const int*)(ws + WS_CNT); int* TILEE = (int*)(ws + WS_TILEE);
    LAS int* tot = (LAS int*)lds; LAS int* before = tot + 32; LAS int* pstart = tot + 64; LAS int* lcnt = tot + 96; LAS int* lslot = tot + 128;
    for (int item = bid; item < T / 128; item += G) {
        const int r0 = item * 128;
        __syncthreads();
        if (tid < 32) { int t_ = 0, b_ = 0;
            for (int w = 0; w < T / 128; ++w) { const int c = CNT[w * 32 + tid]; t_ += c; b_ += (w < item) ? c : 0; }
            tot[tid] = t_; before[tid] = b_; lcnt[tid] = 0; }
        __syncthreads();
        if (tid == 0) { int ps = 0; for (int e = 0; e < 32; ++e) { pstart[e] = ps; ps += (tot[e] + 255) & ~255; }
            if (item == 0) { TILEE[0] = ps >> 8; for (int e = 0; e < 32; ++e) { const int t0 = pstart[e] >> 8, nt = ((tot[e] + 255) >> 8); for (int i = 0; i < nt; ++i) TILEE[16 + t0 + i] = e; } } }
        __syncthreads();
        if (tid < 256) { const int e = EID[(size_t)r0 * 2 + tid]; const int rank = __hip_atomic_fetch_add(lcnt + e, 1, __ATOMIC_RELAXED, __HIP_MEMORY_SCOPE_WORKGROUP); const int slot = pstart[e] + before[e] + rank; SLOT[(size_t)r0 * 2 + tid] = slot; lslot[tid] = slot; }
        __syncthreads();
        for (int rr = 0; rr < 16; ++rr) { const int row = 16 * wave + rr; const bf16* src = H + (size_t)(r0 + row) * 1024;
            const v4u a = *(const v4u*)(src + 8 * lane), c = *(const v4u*)(src + 512 + 8 * lane); const int s0 = lslot[2 * row], s1 = lslot[2 * row + 1];
            bf16* d0 = XG + (size_t)s0 * 1024; bf16* d1 = XG + (size_t)s1 * 1024;
            *(v4u*)(d0 + 8 * lane) = a; *(v4u*)(d0 + 512 + 8 * lane) = c; *(v4u*)(d1 + 8 * lane) = a; *(v4u*)(d1 + 512 + 8 * lane) = c; }
        { const int e = item & 31, part = item >> 5; const int p0 = pstart[e] + tot[e], npad = ((tot[e] + 255) & ~255) - tot[e]; const v4u z = {0u, 0u, 0u, 0u};
          for (int pr = part * 8 + wave; pr < npad; pr += 64) { bf16* d = XG + (size_t)(p0 + pr) * 1024; *(v4u*)(d + 8 * lane) = z; *(v4u*)(d + 512 + 8 * lane) = z; } }
    }
}
__device__ __forceinline__ void phase_moe_combine(const Args& args, int L) {
    int tid_ = threadIdx.x; asm volatile("" : "+v"(tid_)); const int tid = tid_, lane = tid & 63, wave = __builtin_amdgcn_readfirstlane(tid >> 6), G = gridDim.x, bid = blockIdx.x; (void)tid; (void)lane; (void)wave;
    unsigned char* ws = uni_ptr(args.ws); float* X = args.out; const bf16* Y = (const bf16*)(ws + WS_ACT + A_Y); bf16* H = (bf16*)(ws + WS_ACT + A_H);
    const int* SLOT = (const int*)(ws + WS_SLOT); const float* GATE = (const float*)(ws + WS_GATE); const float* MOD = (const float*)(ws + WS_MOD);
    for (int t = bid * NWAVES + wave; t < T; t += G * NWAVES) { const int b = t / SEQ;
        const int s0 = SLOT[(size_t)t * 2], s1 = SLOT[(size_t)t * 2 + 1]; const float g0 = GATE[(size_t)t * 2], g1 = GATE[(size_t)t * 2 + 1];
        const float* gf = MOD + (size_t)(L * 2 + b) * 6144 + 5120; f32x4 v[4];
#pragma unroll
        for (int j = 0; j < 4; ++j) { const int c = 4 * lane + 256 * j; const f32x4 x = *(const f32x4*)(X + (size_t)t * 1024 + c), gg = *(const f32x4*)(gf + c);
            const v2u y0 = *(const v2u*)(Y + (size_t)s0 * 1024 + c), y1 = *(const v2u*)(Y + (size_t)s1 * 1024 + c);
            f32x4 mo; mo[0] = g0 * bflo(y0.x) + g1 * bflo(y1.x); mo[1] = g0 * bfhi(y0.x) + g1 * bfhi(y1.x); mo[2] = g0 * bflo(y0.y) + g1 * bflo(y1.y); mo[3] = g0 * bfhi(y0.y) + g1 * bfhi(y1.y);
            v[j] = x + gg * mo; *(f32x4*)(X + (size_t)t * 1024 + c) = v[j]; }
        if (L < 3) { const float* m = MOD + (size_t)((L + 1) * 2 + b) * 6144; norm_store_row(v, args.in[LBASE(L + 1)], m, m + 1024, H + (size_t)t * 1024, lane); }
    }
}

constexpr int N_PHASES = 37;

#define PHASE(k) if ((lo <= (k) && (k) < hi) && ((started ? (xcd_barrier(bar), 0) : 0), started = true, true))
template <int L> __device__ __forceinline__ void run_layer(const Args& args, LAS unsigned char* lds, const XcdBarrier& bar, bool& started, const int lo, const int hi) {
    const int G = gridDim.x, bid = blockIdx.x;
    unsigned char* ws = uni_ptr(args.ws);
    const float* MOD = (const float*)(ws + WS_MOD);
    bf16* Hb = (bf16*)(ws + WS_ACT + A_H);

        const int pb = (L == 0) ? 1 : (L == 1 ? 10 : (L == 2 ? 21 : 29));
        const float* xsrc = (L == 0) ? args.in[0] : (const float*)args.out;
        const float* gate_m = MOD + (size_t)L * 2 * 6144 + 2048;
        int mb;
        if constexpr (L == 0 || L == 3) {
            int g0 = pb;
            if (L == 0) { PHASE(pb) { phase_norm0(args); } g0 = pb + 1; }
            const bf16* Win = (const bf16*)(ws + WS_WMIX + (L == 0 ? WMIX_GM_IN0 : WMIX_GM_IN3)); const bf16* Wout = (const bf16*)(ws + WS_WMIX + (L == 0 ? WMIX_GM_OUT0 : WMIX_GM_OUT3));
            PHASE(g0) { pg8::Gemm g{Hb, Win, T, 2048, 1024}; pg8::StaticOrder S; S.init(T, 2048, G, bid);
                EpiGm1 E{(bf16*)(ws + WS_ACT + A_U), (bf16*)(ws + WS_ACT + A_V), (float*)(ws + WS_VSSP)};
                pg8::gemm_phase<EpiGm1, pg8::StaticOrder, true, true>(lds, g, S, E); }
            PHASE(g0 + 1) { phase_gm_spatial(args, L, lds); }
            PHASE(g0 + 2) { pg8::Gemm g{(const bf16*)(ws + WS_ACT + A_GATED), Wout, T, 1024, 1024}; pg8::StaticOrder S; S.init(T, 1024, G, bid);
                EpiRes E{xsrc, args.out, gate_m};
                pg8::gemm_phase<EpiRes, pg8::StaticOrder, true, true>(lds, g, S, E); }
            mb = g0 + 3;
        } else if constexpr (L == 1) {
            PHASE(pb) { pg8::Gemm g{Hb, (const bf16*)(ws + WS_WMIX + WMIX_DN_IN), T, 3328, 1024}; pg8::StaticOrder S; S.init(T, 3328, G, bid);
                EpiDn1 E{(bf16*)(ws + WS_ACT + A_QKV), (bf16*)(ws + WS_ACT + A_Z), (float*)(ws + WS_BA)};
                pg8::gemm_phase<EpiDn1, pg8::StaticOrder, true, true>(lds, g, S, E); }
            PHASE(pb + 1) { phase_dn_prep(args); }
            PHASE(pb + 2) { phase_dn_chunk(args, lds); }
            PHASE(pb + 3) { phase_dn_scan(args, lds); }
            PHASE(pb + 4) { phase_dn_ogate(args); }
            PHASE(pb + 5) { pg8::Gemm g{Hb, (const bf16*)(ws + WS_WMIX + WMIX_DN_OUT), T, 1024, 1024}; pg8::StaticOrder S; S.init(T, 1024, G, bid);
                EpiRes E{xsrc, args.out, gate_m};
                pg8::gemm_phase<EpiRes, pg8::StaticOrder, true, true>(lds, g, S, E); }
            mb = pb + 6;
        } else {
            PHASE(pb) { pg8::Gemm g{Hb, (const bf16*)(ws + WS_WMIX + WMIX_SWA_IN), T, 1536, 1024}; pg8::StaticOrder S; S.init(T, 1536, G, bid);
                EpiBf E{(bf16*)(ws + WS_ACT + A_QKV), 1536, 0xffff};
                pg8::gemm_phase<EpiBf, pg8::StaticOrder, true, true>(lds, g, S, E); }
            PHASE(pb + 1) { phase_swa_attn(args, lds); }
            PHASE(pb + 2) { pg8::Gemm g{Hb, (const bf16*)(ws + WS_WMIX + WMIX_SWA_OUT), T, 1024, 1024}; pg8::StaticOrder S; S.init(T, 1024, G, bid);
                EpiRes E{xsrc, args.out, gate_m};
                pg8::gemm_phase<EpiRes, pg8::StaticOrder, true, true>(lds, g, S, E); }
            mb = pb + 3;
        }
        PHASE(mb) { phase_moe_router(args, L, lds); }
        PHASE(mb + 1) { phase_moe_scatter(args, lds); }
        const int* TILEE = (const int*)(ws + WS_TILEE);
        PHASE(mb + 2) { const int ntiles = TILEE[0]; pg8::Gemm g{(const bf16*)(ws + WS_ACT + A_XG), (const bf16*)(ws + WS_W + (size_t)L * 96 * MiB), MAXROWS, 1024, 1024};
            MoeOrder S; S.init(TILEE + 16, ntiles, G, bid); EpiMoe1 E{(bf16*)(ws + WS_ACT + A_ACTV)};
            pg8::gemm_phase<EpiMoe1, MoeOrder, true, true>(lds, g, S, E); }
        PHASE(mb + 3) { const int ntiles = TILEE[0]; pg8::Gemm g{(const bf16*)(ws + WS_ACT + A_ACTV), (const bf16*)(ws + WS_W + (size_t)L * 96 * MiB + 64 * MiB), MAXROWS, 1024, 512};
            MoeOrder S; S.init(TILEE + 16, ntiles, G, bid); EpiBf E{(bf16*)(ws + WS_ACT + A_Y), 1024, 3};
            pg8::gemm_phase<EpiBf, MoeOrder, true, true>(lds, g, S, E); }
        PHASE(mb + 4) { phase_moe_combine(args, L); }

}
__global__ void __launch_bounds__(NTHR, 2) fwd_kernel(Args args) {
    extern __shared__ __attribute__((aligned(16))) unsigned char lds_raw[];
    LAS unsigned char* lds = (LAS unsigned char*)lds_raw;
    const int tid = threadIdx.x;
    unsigned char* ws = uni_ptr(args.ws);
    for (int u = tid; u < (LDS_BYTES - LDSCTL_OFF) / 4; u += NTHR) ((LAS unsigned*)(lds + LDSCTL_OFF))[u] = 0u;
    __syncthreads();
    volatile LAS unsigned* MISC = (volatile LAS unsigned*)(lds + MISC_OFF);
    XcdBarrier bar = xcd_barrier_post((unsigned*)(ws + WS_CTL) + 4096 + (size_t)args.li * XCD_BAR_WORDS, MISC + 8);
    const int lo = args.ph_lo, hi = args.ph_hi; bool started = false;
    const float* MOD = (const float*)(ws + WS_MOD);
    bf16* Hb = (bf16*)(ws + WS_ACT + A_H);

    PHASE(0) { phase_prologue(args, lds); }

    run_layer<0>(args, lds, bar, started, lo, hi);
    run_layer<1>(args, lds, bar, started, lo, hi);
    run_layer<2>(args, lds, bar, started, lo, hi);
    run_layer<3>(args, lds, bar, started, lo, hi);
#undef PHASE
}

extern "C" void kernel_launch(void* const* d_in, const int* in_sizes, int n_in, void* d_out, int out_size, void* d_ws, size_t ws_size, hipStream_t stream) {
    static int grid = 0;
    if (grid == 0) {
        if (n_in != N_IN || in_sizes[0] != T * D || out_size != T * D || ws_size < WS_END) { fprintf(stderr, "kernel_launch: unexpected shapes (n_in %d, in0 %d, out %d, ws %zu < %zu)\n", n_in, n_in > 0 ? in_sizes[0] : -1, out_size, ws_size, (size_t)WS_END); grid = -1; return; }
        int dev = 0, cus = 0, per_cu = 0;
        if (hipGetDevice(&dev) != hipSuccess || hipDeviceGetAttribute(&cus, hipDeviceAttributeMultiprocessorCount, dev) != hipSuccess) { grid = -1; return; }
        if (hipFuncSetAttribute((const void*)fwd_kernel, hipFuncAttributeMaxDynamicSharedMemorySize, LDS_BYTES) != hipSuccess) { fprintf(stderr, "kernel_launch: hipFuncSetAttribute failed\n"); grid = -1; return; }
        if (hipOccupancyMaxActiveBlocksPerMultiprocessor(&per_cu, (const void*)fwd_kernel, NTHR, LDS_BYTES) != hipSuccess || per_cu < 1) fprintf(stderr, "kernel_launch: occupancy query reports %d\n", per_cu);
        (void)hipGetLastError();
        grid = cus;
    }
    if (grid < 0) return;
    if (hipMemsetAsync((char*)d_ws + WS_CTL, 0, CTL_ZERO_BYTES, stream) != hipSuccess) return;
    Args a{};
    for (int i = 0; i < N_IN; ++i) a.in[i] = (const float*)d_in[i];
    a.out = (float*)d_out; a.ws = (unsigned char*)d_ws; a.pad = 0;
#if MK_LAUNCH_MODE == 1
    a.ph_lo = 0; a.ph_hi = N_PHASES; a.li = 0;
    hipLaunchKernelGGL(fwd_kernel, dim3(grid), dim3(NTHR), LDS_BYTES, stream, a);
#else
    for (int p = 0; p < N_PHASES; ++p) { a.ph_lo = p; a.ph_hi = p + 1; a.li = 0;
        hipLaunchKernelGGL(fwd_kernel, dim3(grid), dim3(NTHR), LDS_BYTES, stream, a); }
#endif
}
```

```cpp
#include <hip/hip_runtime.h>
#include <cstdio>
#include <cstdint>
#ifndef MK_LAUNCH_MODE
#define MK_LAUNCH_MODE 1
#endif
namespace pg8 {
#define PG8_LAS __attribute__((address_space(3)))
typedef unsigned short bf16_t;
typedef short bf16x8 __attribute__((ext_vector_type(8)));
typedef float f32x4 __attribute__((ext_vector_type(4)));
typedef unsigned u32x4 __attribute__((ext_vector_type(4)));
constexpr int BM = 256, BK = 64, HALF = 128, HTB = HALF * BK * 2  , STAGE_BYTES = 8 * HTB, NXCD = 8, WGM = 8;

__host__ __device__ __forceinline__ int lds_byte(int r, int c) { const int st = (r >> 4) * 2 + (c >> 5), rr = r & 15, cc = c & 31, ob = rr * 64 + cc * 2; return st * 1024 + (ob ^ (((ob >> 9) & 1) << 5)); }
__host__ __device__ __forceinline__ void stage_rc(int b, int& R, int& C) { const int st = b / 1024, sb = b % 1024, swz = sb ^ (((sb >> 9) & 1) << 5); R = (st >> 1) * 16 + swz / 64; C = (st & 1) * 32 + (swz % 64) / 2; }
__host__ __device__ __forceinline__ int perm32(int rho) { const int n = rho >> 4, i = rho & 15; return 8 * (i >> 2) + 4 * n + (i & 3); }

struct Unit { int pm, pn; };
struct Gemm { const bf16_t* A; const bf16_t* Bt; int M, N, K; };

struct StaticOrder {
    int nM, nN, nwg, G, c;
    __host__ __device__ void init(int M, int N, int G_, int c_) { nM = M / BM; nN = N / BM; nwg = nM * nN; G = G_; c = c_; }
    __host__ __device__ bool next(int i, Unit& u) const {
        const long L = (long)i * G + c; if (L >= nwg) return false;
        int wgid = (int)L; { const int q = nwg / NXCD, r = nwg % NXCD, xcd = wgid % NXCD, off = wgid / NXCD; wgid = (xcd < r ? xcd * (q + 1) : r * (q + 1) + (xcd - r) * q) + off; }
        const int nig = WGM * nN, gid = wgid / nig, fm = gid * WGM, gsz = (nM - fm) < WGM ? (nM - fm) : WGM;
        u.pm = fm + ((wgid % nig) % gsz); u.pn = (wgid % nig) / gsz; return true;
    }
    __device__ __forceinline__ void a_ready(const Unit&) const {}
    __device__ __forceinline__ void done(const Unit&) const {}
};
typedef float f32x2_ __attribute__((ext_vector_type(2))); typedef __bf16 bf16x2_ __attribute__((ext_vector_type(2)));
__device__ __forceinline__ unsigned cvt_pk_bf16(float lo, float hi) { const f32x2_ v = {lo, hi}; return __builtin_bit_cast(unsigned, __builtin_convertvector(v, bf16x2_)); }
typedef float f32x2 __attribute__((ext_vector_type(2)));
template <class Epi, class Sched, bool ALIGN_EPI = false, bool SP2 = false>
__device__ __forceinline__ void gemm_phase(PG8_LAS unsigned char* lds, const Gemm g, const Sched& S, const Epi& E) {
    const int tid = threadIdx.x, wid = __builtin_amdgcn_readfirstlane(tid >> 6), lane = tid & 63, wr = wid >> 2, wc = wid & 3, fr = lane & 15, fq = lane >> 4;
    const int K = g.K, nt = K / BK;
    unsigned voffA[2], voffB[2];
#pragma unroll
    for (int i = 0; i < 2; ++i) { int R, C; stage_rc(tid * 16 + i * 8192, R, C); const int Rb = Epi::PERM ? ((R & ~31) + perm32(R & 31)) : R;
        voffA[i] = (unsigned)(R * K + C) * 2u; voffB[i] = (unsigned)(Rb * K + C) * 2u; }
    const size_t kstep = (size_t)(BK * 2);
    const size_t hstep = (size_t)HALF * K * 2;
    const size_t tstep = 2 * hstep;
    const unsigned ldsw = (unsigned)wid * 1024u;
    const int aoff = lds_byte(wr * 64 + fr, fq * 8), boff = lds_byte(wc * 32 + fr, fq * 8);
#define PG8_SA(b, h) (((b) * 2 + (h)) * HTB)
#define PG8_SB(b, h) ((4 + (b) * 2 + (h)) * HTB)
#define PG8_STAGE(bufoff, gbase, voff) do { _Pragma("unroll") for (int _i = 0; _i < 2; ++_i) \
        __builtin_amdgcn_global_load_lds((const unsigned*)((const char*)(gbase) + (voff)[_i]), (PG8_LAS unsigned*)(lds + (bufoff) + ldsw + _i * 8192), 16, 0, 0); } while (0)
#define PG8_LDA(dst, b, h) do { _Pragma("unroll") for (int m = 0; m < 4; ++m) _Pragma("unroll") for (int k = 0; k < 2; ++k) dst[m][k] = *(const PG8_LAS bf16x8*)(lds + PG8_SA(b, h) + aoff + m * 2048 + k * 1024); } while (0)
#define PG8_LDB(dst, b, h) do { _Pragma("unroll") for (int n = 0; n < 2; ++n) _Pragma("unroll") for (int k = 0; k < 2; ++k) dst[n][k] = *(const PG8_LAS bf16x8*)(lds + PG8_SB(b, h) + boff + n * 2048 + k * 1024); } while (0)
#define PG8_MMA(ai, bj, At, Bt) do { __builtin_amdgcn_s_setprio(1); _Pragma("unroll") for (int m = 0; m < 4; ++m) _Pragma("unroll") for (int n = 0; n < 2; ++n) _Pragma("unroll") for (int k = 0; k < 2; ++k) \
        acc[ai][bj][m][n] = __builtin_amdgcn_mfma_f32_16x16x32_bf16(Bt[n][k], At[m][k], acc[ai][bj][m][n], 0, 0, 0); __builtin_amdgcn_s_setprio(0); } while (0)
#define PG8_WAIT_V(n) asm volatile("s_waitcnt vmcnt(" #n ")" ::: "memory")
#define PG8_WAIT_L(n) asm volatile("s_waitcnt lgkmcnt(" #n ")" ::: "memory")
#define PG8_BAR __builtin_amdgcn_s_barrier()
#define PG8_SCHED __builtin_amdgcn_sched_barrier(0)
    Unit cur, nxt; int ui = 0;
    if (!S.next(0, cur)) return;
    f32x4 acc[2][2][4][2];
#pragma unroll
    for (int a = 0; a < 2; ++a)
#pragma unroll
        for (int b = 0; b < 2; ++b)
#pragma unroll
            for (int m = 0; m < 4; ++m)
#pragma unroll
                for (int n = 0; n < 2; ++n) acc[a][b][m][n] = (f32x4){0.f, 0.f, 0.f, 0.f};
    bf16x8 At[4][2], B0[2][2], B1[2][2];
    const char* cA = (const char*)g.A + (size_t)cur.pm * tstep; const char* cB = (const char*)g.Bt + (size_t)cur.pn * tstep;
    S.a_ready(cur);
    if constexpr (SP2) {
        PG8_STAGE(PG8_SB(0, 0), cB, voffB); PG8_STAGE(PG8_SB(0, 1), cB + hstep, voffB); PG8_STAGE(PG8_SA(0, 0), cA, voffA); PG8_STAGE(PG8_SA(0, 1), cA + hstep, voffA);
        if (wr == 1) PG8_BAR;
        PG8_WAIT_V(2); PG8_BAR;
        PG8_STAGE(PG8_SB(1, 0), cB + kstep, voffB); PG8_STAGE(PG8_SA(1, 0), cA + kstep, voffA); PG8_STAGE(PG8_SB(1, 1), cB + hstep + kstep, voffB);
        PG8_WAIT_V(6); PG8_BAR;
    } else {
        PG8_STAGE(PG8_SB(0, 0), cB, voffB); PG8_STAGE(PG8_SA(0, 0), cA, voffA); PG8_STAGE(PG8_SB(0, 1), cB + hstep, voffB); PG8_STAGE(PG8_SA(0, 1), cA + hstep, voffA);
        if (wr == 1) PG8_BAR;
        PG8_WAIT_V(4); PG8_BAR;
        PG8_STAGE(PG8_SB(1, 0), cB + kstep, voffB); PG8_STAGE(PG8_SA(1, 0), cA + kstep, voffA); PG8_STAGE(PG8_SB(1, 1), cB + hstep + kstep, voffB);
        PG8_WAIT_V(6); PG8_BAR;
    }
    for (;;) {
        const bool has_next = S.next(ui + 1, nxt);
        const char* nA = has_next ? (const char*)g.A + (size_t)nxt.pm * tstep : cA; const char* nB = has_next ? (const char*)g.Bt + (size_t)nxt.pn * tstep : cB;
        for (int t = 0; t < nt; t += 2) {
            const bool last = (t == nt - 2);
            const char* a1 = cA + (size_t)(t + 1) * kstep;
            const char* a2 = last ? nA : cA + (size_t)(t + 2) * kstep; const char* b2 = last ? nB : cB + (size_t)(t + 2) * kstep;
            const char* a3 = a2 + kstep; const char* b3 = b2 + kstep;
            if (last && has_next) S.a_ready(nxt);
            if constexpr (SP2) {
            PG8_LDB(B0, 0, 0); PG8_LDB(B1, 0, 1); PG8_SCHED; PG8_LDA(At, 0, 0); PG8_STAGE(PG8_SA(1, 1), a1 + hstep, voffA);
            PG8_WAIT_V(8); PG8_WAIT_L(0); PG8_BAR; PG8_MMA(0, 0, At, B0); PG8_MMA(0, 1, At, B1); PG8_BAR; PG8_SCHED;
            PG8_LDA(At, 0, 1); PG8_STAGE(PG8_SB(0, 0), b2, voffB); PG8_STAGE(PG8_SB(0, 1), b2 + hstep, voffB); PG8_STAGE(PG8_SA(0, 0), a2, voffA);
            PG8_WAIT_V(8); PG8_WAIT_L(0); PG8_BAR; PG8_MMA(1, 0, At, B0); PG8_MMA(1, 1, At, B1); PG8_BAR; PG8_SCHED;
            PG8_LDB(B0, 1, 0); PG8_LDB(B1, 1, 1); PG8_SCHED; PG8_LDA(At, 1, 0); PG8_STAGE(PG8_SA(0, 1), a2 + hstep, voffA);
            PG8_WAIT_V(8); PG8_WAIT_L(0); PG8_BAR; PG8_MMA(0, 0, At, B0); PG8_MMA(0, 1, At, B1); PG8_BAR; PG8_SCHED;
            PG8_LDA(At, 1, 1); PG8_STAGE(PG8_SB(1, 0), b3, voffB); PG8_STAGE(PG8_SB(1, 1), b3 + hstep, voffB); PG8_STAGE(PG8_SA(1, 0), a3, voffA);
            PG8_WAIT_V(8); PG8_WAIT_L(0); PG8_BAR; PG8_MMA(1, 0, At, B0); PG8_MMA(1, 1, At, B1); PG8_BAR; PG8_SCHED;
            } else {
            PG8_LDB(B0, 0, 0); PG8_SCHED; PG8_LDA(At, 0, 0); PG8_STAGE(PG8_SA(1, 1), a1 + hstep, voffA);
            PG8_WAIT_L(8); PG8_BAR; PG8_WAIT_L(0); PG8_MMA(0, 0, At, B0); PG8_BAR; PG8_SCHED;
            PG8_LDB(B1, 0, 1); PG8_STAGE(PG8_SB(0, 0), b2, voffB);
            PG8_BAR; PG8_WAIT_L(0); PG8_MMA(0, 1, At, B1); PG8_BAR;
            PG8_LDA(At, 0, 1); PG8_STAGE(PG8_SA(0, 0), a2, voffA);
            PG8_BAR; PG8_WAIT_L(0); PG8_MMA(1, 0, At, B0); PG8_BAR; PG8_SCHED;
            PG8_STAGE(PG8_SB(0, 1), b2 + hstep, voffB);
            PG8_WAIT_V(6); PG8_BAR; PG8_MMA(1, 1, At, B1); PG8_BAR;
            PG8_LDB(B0, 1, 0); PG8_SCHED; PG8_LDA(At, 1, 0); PG8_STAGE(PG8_SA(0, 1), a2 + hstep, voffA);
            PG8_WAIT_L(8); PG8_BAR; PG8_WAIT_L(0); PG8_MMA(0, 0, At, B0); PG8_BAR; PG8_SCHED;
            PG8_LDB(B1, 1, 1); PG8_STAGE(PG8_SB(1, 0), b3, voffB);
            PG8_BAR; PG8_WAIT_L(0); PG8_MMA(0, 1, At, B1); PG8_BAR;
            PG8_LDA(At, 1, 1); PG8_STAGE(PG8_SA(1, 0), a3, voffA);
            PG8_BAR; PG8_WAIT_L(0); PG8_MMA(1, 0, At, B0); PG8_BAR; PG8_SCHED;
            PG8_STAGE(PG8_SB(1, 1), b3 + hstep, voffB);
            PG8_WAIT_V(6); PG8_BAR; PG8_MMA(1, 1, At, B1); PG8_BAR;
            }
        }
        if constexpr (ALIGN_EPI) { if (wr == 0) PG8_BAR; }
        if constexpr (!Epi::AFTER_DRAIN) { E(acc, cur, wr, wc, fr, fq); S.done(cur); }
        if (!has_next) break;
#pragma unroll
        for (int a = 0; a < 2; ++a)
#pragma unroll
            for (int b = 0; b < 2; ++b)
#pragma unroll
                for (int m = 0; m < 4; ++m)
#pragma unroll
                    for (int n = 0; n < 2; ++n) acc[a][b][m][n] = (f32x4){0.f, 0.f, 0.f, 0.f};
        cur = nxt; cA = nA; cB = nB; ++ui;
        if constexpr (ALIGN_EPI) { if (wr == 1) PG8_BAR; }
    }
    PG8_WAIT_V(0);
    if constexpr (!ALIGN_EPI) { if (wr == 0) PG8_BAR; }
    PG8_BAR;
    if constexpr (Epi::AFTER_DRAIN) { E.fused(acc, cur, wr, wc, fr, fq, lds, wid, lane); S.done(cur); }
#undef PG8_SA
#undef PG8_SB
#undef PG8_STAGE
#undef PG8_LDA
#undef PG8_LDB
#undef PG8_MMA
#undef PG8_WAIT_V
#undef PG8_WAIT_L
#undef PG8_BAR
#undef PG8_SCHED
}
}

constexpr int NB = 2, SEQ = 16384, T = NB * SEQ, D = 1024;
constexpr float EPS = 1e-6f;
constexpr int NWAVES = 8, NTHR = 512;
constexpr int N_IN = 55;
__host__ __device__ constexpr int LBASE(int L) { return L == 0 ? 2 : (L == 1 ? 15 : (L == 2 ? 29 : 42)); }
__host__ __device__ constexpr int NMIX(int L) { return L == 1 ? 6 : 5; }

constexpr size_t MiB = 1u << 20;
constexpr size_t WS_CTL = 0, CTL_ZERO_BYTES = 1 * MiB;
constexpr size_t WS_MOD = 1 * MiB;
constexpr size_t WS_CNT = WS_MOD + 256 * 1024;
constexpr size_t WS_TILEE = WS_CNT + 64 * 1024;
constexpr size_t WS_EID = 2 * MiB;
constexpr size_t WS_GATE = WS_EID + 256 * 1024;
constexpr size_t WS_SLOT = WS_GATE + 256 * 1024;
constexpr size_t WS_VSSP = 3 * MiB;
constexpr size_t WS_BA = 5 * MiB;
constexpr size_t WS_DNB = 7 * MiB;
constexpr size_t WS_RTR = 9 * MiB;
constexpr size_t WS_W = 16 * MiB;
constexpr size_t WS_WMIX = WS_W + 384 * MiB;
constexpr size_t WMIX_GM_IN0 = 0, WMIX_GM_OUT0 = 4 * MiB, WMIX_DN_IN = 6 * MiB, WMIX_DN_OUT = 13 * MiB, WMIX_SWA_IN = 15 * MiB, WMIX_SWA_OUT = 18 * MiB, WMIX_GM_IN3 = 20 * MiB, WMIX_GM_OUT3 = 24 * MiB;
constexpr size_t WS_ACT = 432 * MiB;
constexpr size_t A_H = 0;
constexpr size_t A_U = 64 * MiB, A_V = 128 * MiB, A_GATED = 192 * MiB;
constexpr size_t A_QKV = 64 * MiB, A_Z = 192 * MiB, A_QN = 256 * MiB, A_KN = 288 * MiB, A_VV = 320 * MiB, A_FA = 384 * MiB, A_FB = 484 * MiB, A_FU = 64 * MiB, A_O = 128 * MiB;
constexpr size_t A_XG = 64 * MiB, A_ACTV = 208 * MiB, A_Y = 280 * MiB;
constexpr size_t WS_END = WS_ACT + 548 * MiB;
constexpr int MAXROWS = 73728;

constexpr int RING_BYTES = 131072;
constexpr int LDSCTL_OFF = RING_BYTES, MISC_OFF = LDSCTL_OFF + 320;
constexpr int LDS_BYTES = 147456;

#define LAS __attribute__((address_space(3)))
typedef unsigned short bf16;
typedef unsigned v4u __attribute__((ext_vector_type(4)));
typedef unsigned v2u __attribute__((ext_vector_type(2)));
typedef float f32x4 __attribute__((ext_vector_type(4)));
typedef short bf16x8 __attribute__((ext_vector_type(8)));
typedef short bf16x4 __attribute__((ext_vector_type(4)));
#define LDS_WAIT() asm volatile("s_waitcnt lgkmcnt(0)" ::: "memory")
#define VM_WAIT() asm volatile("s_waitcnt vmcnt(0)" ::: "memory")
__device__ __forceinline__ unsigned pk2(float lo, float hi) { return pg8::cvt_pk_bf16(lo, hi); }
__device__ __forceinline__ float bflo(unsigned w) { return __uint_as_float(w << 16); }
__device__ __forceinline__ float bfhi(unsigned w) { return __uint_as_float(w & 0xffff0000u); }
__device__ __forceinline__ float bf1(unsigned short b) { return __uint_as_float(((unsigned)b) << 16); }
__device__ __forceinline__ float wave_sum(float v) {
#pragma unroll
    for (int o = 1; o < 64; o <<= 1) v += __shfl_xor(v, o);
    return v;
}
__device__ __forceinline__ float fast_exp(float x) { return __builtin_amdgcn_exp2f(x * 1.44269504089f); }
__device__ __forceinline__ float sigmoidf_(float x) { return __builtin_amdgcn_rcpf(1.0f + fast_exp(-x)); }
__device__ __forceinline__ float siluf_(float x) { return x * sigmoidf_(x); }
__device__ __forceinline__ float gelu_tanh(float x) { const float y = 1.5957691216057308f * (x + 0.044715f * x * x * x); return x * __builtin_amdgcn_rcpf(1.0f + fast_exp(-y)); }

#define RLX_AGENT __ATOMIC_RELAXED, __HIP_MEMORY_SCOPE_AGENT
__device__ __forceinline__ unsigned char* uni_ptr(unsigned char* p) { const unsigned long long w = (unsigned long long)p; const unsigned lo = __builtin_amdgcn_readfirstlane((unsigned)w), hi = __builtin_amdgcn_readfirstlane((unsigned)(w >> 32)); return (unsigned char*)(__attribute__((address_space(1))) unsigned char*)(((unsigned long long)hi << 32) | lo); }
#define XB_TMO      128
#define XB_XCNT(j)  (256  + 64 * (j))
#define XB_XSUB(j)  (1280 + 64 * (j))
#define XB_XGEN(j)  (2304 + 64 * (j))
#define XB_TOP      3328
#define XB_TOPGEN   3392
#define XCD_BAR_WORDS 3456
#define XB_SPIN_CAP (1u << 18)

__device__ __forceinline__ unsigned xb_ld(unsigned* p)              { return __hip_atomic_load(p, __ATOMIC_RELAXED, __HIP_MEMORY_SCOPE_AGENT); }
__device__ __forceinline__ unsigned xb_add(unsigned* p, unsigned v) { return __hip_atomic_fetch_add(p, v, __ATOMIC_RELAXED, __HIP_MEMORY_SCOPE_AGENT); }
__device__ __forceinline__ unsigned xb_xcc_id() { return (unsigned)__builtin_amdgcn_s_getreg((3 << 11) | 20) & 0xFu; }
#define XB_SPIN(cond, bar) do { unsigned _sp = 0; while (cond) { __builtin_amdgcn_s_sleep(1); \
    if ((++_sp & 255u) == 0u) { if (xb_ld(&(bar)[XB_TMO])) break; if (_sp > XB_SPIN_CAP) { atomicAdd(&(bar)[XB_TMO], 1u); break; } } } } while (0)

struct XcdBarrier {
    unsigned* bar; unsigned x;
    volatile LAS unsigned* st;
};

__device__ __forceinline__ XcdBarrier xcd_barrier_post(unsigned* bar, volatile LAS unsigned* st) {
    XcdBarrier b; b.bar = bar; b.x = xb_xcc_id(); b.st = st;
    if (threadIdx.x == 0) (void)xb_add(&bar[XB_XCNT(b.x)], 1u);
    return b;
}
__device__ __forceinline__ void xcd_barrier_complete(unsigned* bar, unsigned x, unsigned& nloc, unsigned& nx) {
    const unsigned G = gridDim.x * gridDim.y * gridDim.z;
    unsigned sum, cnt, mine, sp = 0u;
    for (;;) {
        sum = 0u; cnt = 0u; mine = 0u;
#pragma unroll
        for (unsigned j = 0; j < 16; ++j) { const unsigned c = xb_ld(&bar[XB_XCNT(j)]); sum += c; cnt += (c > 0u) ? 1u : 0u; mine = (j == x) ? c : mine; }
        if (sum == G) break;
        __builtin_amdgcn_s_sleep(1);
        if ((++sp & 255u) == 0u) { if (xb_ld(&bar[XB_TMO])) break; if (sp > XB_SPIN_CAP) { atomicAdd(&bar[XB_TMO], 1u); break; } }
    }
    nloc = mine > 0u ? mine : 1u; nx = cnt > 0u ? cnt : 1u;
}

__device__ __forceinline__ void xcd_barrier(const XcdBarrier& b) {
    asm volatile("s_waitcnt vmcnt(0)" ::: "memory");
    __syncthreads();
    if (threadIdx.x == 0) {
        unsigned* bar = b.bar;
        __builtin_amdgcn_s_waitcnt(0);
        unsigned nloc = b.st[0], nx = b.st[1];
        if (nloc == 0u) { xcd_barrier_complete(bar, b.x, nloc, nx); b.st[0] = nloc; b.st[1] = nx; }
        const unsigned old = xb_add(&bar[XB_XSUB(b.x)], 1u);
        const unsigned gen = old / nloc;
        if (old + 1u == (gen + 1u) * nloc) {
            __builtin_amdgcn_fence(__ATOMIC_RELEASE, "agent");
            asm volatile("s_waitcnt vmcnt(0)" ::: "memory");
            const unsigned og = xb_add(&bar[XB_TOP], 1u);
            const unsigned tg = og / nx;
            if (og + 1u == (tg + 1u) * nx) xb_add(&bar[XB_TOPGEN], 1u);
            else XB_SPIN(xb_ld(&bar[XB_TOPGEN]) == tg, bar);
            __builtin_amdgcn_fence(__ATOMIC_ACQUIRE, "agent");
            xb_add(&bar[XB_XGEN(b.x)], 1u);
            asm volatile("s_waitcnt vmcnt(0)" ::: "memory");
        } else {
            XB_SPIN(xb_ld(&bar[XB_XGEN(b.x)]) == gen, bar);
            __builtin_amdgcn_fence(__ATOMIC_ACQUIRE, "agent");
            asm volatile("s_waitcnt vmcnt(0)" ::: "memory");
        }
    }
    __syncthreads();
}

typedef const pg8::f32x4 (&AccRef)[2][2][4][2];

struct EpiGm1 {
    static constexpr bool PERM = true, AFTER_DRAIN = false;
    bf16* U; bf16* V; float* vssp;
    __device__ __forceinline__ void operator()(AccRef acc, const pg8::Unit& u, int wr, int wc, int fr, int fq) const {
        const int row0 = u.pm * 256 + wr * 64 + fr; const bool isV = u.pn >= 4; const int col0 = (u.pn & 3) * 256 + wc * 32 + 8 * fq;
        bf16* base = isV ? V : U;
#pragma unroll
        for (int ai = 0; ai < 2; ++ai)
#pragma unroll
            for (int m = 0; m < 4; ++m) { const int row = row0 + ai * 128 + m * 16; bf16* rowp = base + (size_t)row * 1024 + col0; float ss = 0.f;
#pragma unroll
                for (int bj = 0; bj < 2; ++bj) { f32x4 v0 = acc[ai][bj][m][0], v1 = acc[ai][bj][m][1];
#pragma unroll
                    for (int j = 0; j < 4; ++j) { v0[j] = gelu_tanh(v0[j]); v1[j] = gelu_tanh(v1[j]); ss += v0[j] * v0[j] + v1[j] * v1[j]; }
                    v4u w; w.x = pk2(v0[0], v0[1]); w.y = pk2(v0[2], v0[3]); w.z = pk2(v1[0], v1[1]); w.w = pk2(v1[2], v1[3]);
                    *(v4u*)(rowp + bj * 128) = w; }
                if (isV) { ss += __shfl_xor(ss, 16); ss += __shfl_xor(ss, 32); if (fq == 0) vssp[(size_t)row * 16 + (u.pn - 4) * 4 + wc] = ss; } }
    }
};
struct EpiRes {
    static constexpr bool PERM = false, AFTER_DRAIN = false;
    const float* src; float* dst; const float* gate;
    __device__ __forceinline__ void operator()(AccRef acc, const pg8::Unit& u, int wr, int wc, int fr, int fq) const {
        const int row0 = u.pm * 256 + wr * 64 + fr, col0 = u.pn * 256 + wc * 32 + 4 * fq; const int b = (u.pm * 256) / SEQ;
        f32x4 gv[2][2];
#pragma unroll
        for (int bj = 0; bj < 2; ++bj)
#pragma unroll
            for (int n = 0; n < 2; ++n) gv[bj][n] = *(const f32x4*)(gate + (size_t)b * 6144 + col0 + bj * 128 + n * 16);
#pragma unroll
        for (int ai = 0; ai < 2; ++ai)
#pragma unroll
            for (int m = 0; m < 4; ++m) { const size_t off = (size_t)(row0 + ai * 128 + m * 16) * 1024 + col0;
#pragma unroll
                for (int bj = 0; bj < 2; ++bj)
#pragma unroll
                    for (int n = 0; n < 2; ++n) { const f32x4 xs = *(const f32x4*)(src + off + bj * 128 + n * 16); *(f32x4*)(dst + off + bj * 128 + n * 16) = xs + gv[bj][n] * acc[ai][bj][m][n]; } }
    }
};
struct EpiBf {
    static constexpr bool PERM = true, AFTER_DRAIN = false;
    bf16* O; int ldc; int nmask;
    __device__ __forceinline__ void operator()(AccRef acc, const pg8::Unit& u, int wr, int wc, int fr, int fq) const {
        const int row0 = u.pm * 256 + wr * 64 + fr, col0 = (u.pn & nmask) * 256 + wc * 32 + 8 * fq;
#pragma unroll
        for (int ai = 0; ai < 2; ++ai)
#pragma unroll
            for (int m = 0; m < 4; ++m) { bf16* rowp = O + (size_t)(row0 + ai * 128 + m * 16) * ldc + col0;
#pragma unroll
                for (int bj = 0; bj < 2; ++bj) { const f32x4 v0 = acc[ai][bj][m][0], v1 = acc[ai][bj][m][1];
                    v4u w; w.x = pk2(v0[0], v0[1]); w.y = pk2(v0[2], v0[3]); w.z = pk2(v1[0], v1[1]); w.w = pk2(v1[2], v1[3]);
                    *(v4u*)(rowp + bj * 128) = w; } }
    }
};
struct EpiDn1 {
    static constexpr bool PERM = true, AFTER_DRAIN = false;
    bf16* QKV; bf16* Z; float* BA;
    __device__ __forceinline__ void operator()(AccRef acc, const pg8::Unit& u, int wr, int wc, int fr, int fq) const {
        const int row0 = u.pm * 256 + wr * 64 + fr;
        if (u.pn < 12) {
            bf16* base = u.pn < 8 ? QKV : Z; const int ldc = u.pn < 8 ? 2048 : 1024; const int col0 = (u.pn < 8 ? u.pn : u.pn - 8) * 256 + wc * 32 + 8 * fq;
#pragma unroll
            for (int ai = 0; ai < 2; ++ai)
#pragma unroll
                for (int m = 0; m < 4; ++m) { bf16* rowp = base + (size_t)(row0 + ai * 128 + m * 16) * ldc + col0;
#pragma unroll
                    for (int bj = 0; bj < 2; ++bj) { const f32x4 v0 = acc[ai][bj][m][0], v1 = acc[ai][bj][m][1];
                        v4u w; w.x = pk2(v0[0], v0[1]); w.y = pk2(v0[2], v0[3]); w.z = pk2(v1[0], v1[1]); w.w = pk2(v1[2], v1[3]);
                        *(v4u*)(rowp + bj * 128) = w; } }
        } else if (wc == 0 && fq < 2) {
#pragma unroll
            for (int ai = 0; ai < 2; ++ai)
#pragma unroll
                for (int m = 0; m < 4; ++m) { float* rowp = BA + (size_t)(row0 + ai * 128 + m * 16) * 16 + 8 * fq;
                    *(f32x4*)(rowp) = acc[ai][0][m][0]; *(f32x4*)(rowp + 4) = acc[ai][0][m][1]; }
        }
    }
};
struct EpiMoe1 {
    static constexpr bool PERM = true, AFTER_DRAIN = false;
    bf16* O;
    __device__ __forceinline__ void operator()(AccRef acc, const pg8::Unit& u, int wr, int wc, int fr, int fq) const {
        const int row0 = u.pm * 256 + wr * 64 + fr, col0 = (u.pn & 3) * 128 + wc * 32 + 8 * fq;
#pragma unroll
        for (int ai = 0; ai < 2; ++ai)
#pragma unroll
            for (int m = 0; m < 4; ++m) { bf16* rowp = O + (size_t)(row0 + ai * 128 + m * 16) * 512 + col0; float r[8];
#pragma unroll
                for (int n = 0; n < 2; ++n)
#pragma unroll
                    for (int j = 0; j < 4; ++j) { const float a = acc[ai][0][m][n][j], g = acc[ai][1][m][n][j]; r[4 * n + j] = siluf_(a) * g; }
                v4u w; w.x = pk2(r[0], r[1]); w.y = pk2(r[2], r[3]); w.z = pk2(r[4], r[5]); w.w = pk2(r[6], r[7]);
                *(v4u*)rowp = w; }
    }
};
struct MoeOrder {
    const int* tile_e; int total, G, c;
    __device__ __forceinline__ void init(const int* te, int ntiles, int G_, int c_) { tile_e = te; total = ntiles * 4; G = G_; c = c_; }
    __device__ __forceinline__ bool next(int i, pg8::Unit& u) const {
        const long Lx = (long)i * G + c; if (Lx >= total) return false;
        const int w0 = (int)Lx, q = total / 8, r = total % 8, xcd = w0 % 8, off = w0 / 8;
        const int wgid = (xcd < r ? xcd * (q + 1) : r * (q + 1) + (xcd - r) * q) + off;
        const int rt = wgid >> 2; u.pm = rt; u.pn = tile_e[rt] * 4 + (wgid & 3); return true;
    }
    __device__ __forceinline__ void a_ready(const pg8::Unit&) const {}
    __device__ __forceinline__ void done(const pg8::Unit&) const {}
};

struct Args { const float* in[N_IN]; float* out; unsigned char* ws; int ph_lo, ph_hi, li, pad; };

__device__ __forceinline__ void tr_item(const float* __restrict__ W, int ldn, int k0, int n0, bf16* __restrict__ WT, int Kd, int drow0, LAS float* scr, int lane) {
#pragma unroll 8
    for (int i = 0; i < 32; ++i) { const int kk = 2 * i + (lane >> 5); scr[kk * 33 + (lane & 31)] = W[(size_t)(k0 + kk) * ldn + n0 + (lane & 31)]; }
    LDS_WAIT(); asm volatile("" ::: "memory");
    const int c = lane & 7;
#pragma unroll
    for (int j = 0; j < 4; ++j) { const int n = (lane >> 3) + 8 * j; const LAS float* s = scr + (8 * c) * 33 + n;
        v4u o; o.x = pk2(s[0 * 33], s[1 * 33]); o.y = pk2(s[2 * 33], s[3 * 33]); o.z = pk2(s[4 * 33], s[5 * 33]); o.w = pk2(s[6 * 33], s[7 * 33]);
        *(v4u*)(WT + (size_t)(drow0 + n) * Kd + k0 + 8 * c) = o; }
    LDS_WAIT(); asm volatile("" ::: "memory");
}

__device__ __forceinline__ void phase_prologue(const Args& args, LAS unsigned char* lds) {
    int tid_ = threadIdx.x; asm volatile("" : "+v"(tid_)); const int tid = tid_, lane = tid & 63, wave = __builtin_amdgcn_readfirstlane(tid >> 6), G = gridDim.x, bid = blockIdx.x; (void)tid; (void)lane; (void)wave;
    unsigned char* ws = uni_ptr(args.ws);
    LAS float* cact = (LAS float*)(lds + 69632);
    LAS float* red = (LAS float*)(lds + 77824);
    for (int k = tid; k < 2048; k += NTHR) cact[k] = siluf_(args.in[1][k]);
    __syncthreads();
    float* MOD = (float*)(ws + WS_MOD);
    for (int item = bid; item < 384; item += G) {
        const int L = item / 96, cg = item % 96, c4 = tid & 15, ks = tid >> 4;
        const float* w = args.in[LBASE(L) + 2] + (size_t)(ks * 32) * 6144 + cg * 64 + c4 * 4;
        f32x4 a0 = {0.f, 0.f, 0.f, 0.f}, a1 = {0.f, 0.f, 0.f, 0.f};
#pragma unroll 8
        for (int kk = 0; kk < 32; ++kk) { const f32x4 wv = *(const f32x4*)(w + (size_t)kk * 6144); a0 += cact[ks * 32 + kk] * wv; a1 += cact[1024 + ks * 32 + kk] * wv; }
        *(LAS f32x4*)(red + (ks * 2 + 0) * 64 + c4 * 4) = a0; *(LAS f32x4*)(red + (ks * 2 + 1) * 64 + c4 * 4) = a1;
        __syncthreads();
        if (tid < 128) { const int b = tid >> 6, col = tid & 63; float s = 0.f;
#pragma unroll
            for (int k2 = 0; k2 < 32; ++k2) s += red[(k2 * 2 + b) * 64 + col];
            MOD[(size_t)(L * 2 + b) * 6144 + cg * 64 + col] = s + args.in[LBASE(L) + 3][cg * 64 + col]; }
        __syncthreads();
    }
    LAS float* scr = (LAS float*)(lds + wave * 8448);
    const int gw = bid * NWAVES + wave, NGW = G * NWAVES;
    constexpr int PER_L = 24576, N_EXP = 4 * PER_L, N_MIXI = 1536 + 2048 + 1280 + 1536;
    for (int it = gw; it < N_EXP + N_MIXI; it += NGW) {
        const float* src; bf16* dst; int ldn, k0, n0, Kd, drow0;
        if (it < N_EXP) {
            const int L = it / PER_L; int r = it % PER_L; const int ib = LBASE(L) + 4 + NMIX(L);
            if (r < 16384) { const int e = r >> 9, rr = r & 511; k0 = (rr >> 5) * 64; n0 = (rr & 31) * 32; ldn = 1024; Kd = 1024;
                src = args.in[ib + 2] + (size_t)e * 1048576; dst = (bf16*)(ws + WS_W + (size_t)L * 96 * MiB) + (size_t)e * 1048576;
                drow0 = (n0 < 512) ? ((n0 >> 7) * 256 + (n0 & 127)) : ((((n0 - 512) >> 7) * 256) + 128 + ((n0 - 512) & 127)); }
            else { r -= 16384; const int e = r >> 8, rr = r & 255; k0 = (rr >> 5) * 64; n0 = (rr & 31) * 32; ldn = 1024; Kd = 512;
                src = args.in[ib + 3] + (size_t)e * 524288; dst = (bf16*)(ws + WS_W + (size_t)L * 96 * MiB + 64 * MiB) + (size_t)e * 524288; drow0 = n0; }
        } else {
            int r = it - N_EXP; int idx, nblk; size_t woff;
            if (r < 1024) { idx = 6; ldn = 2048; nblk = 64; woff = WMIX_GM_IN0; }
            else if ((r -= 1024) < 512) { idx = 10; ldn = 1024; nblk = 32; woff = WMIX_GM_OUT0; }
            else if ((r -= 512) < 1536) { idx = 19; ldn = 3088; nblk = 96; woff = WMIX_DN_IN; }
            else if ((r -= 1536) < 512) { idx = 24; ldn = 1024; nblk = 32; woff = WMIX_DN_OUT; }
            else if ((r -= 512) < 768) { idx = 33; ldn = 1536; nblk = 48; woff = WMIX_SWA_IN; }
            else if ((r -= 768) < 512) { idx = 37; ldn = 1024; nblk = 32; woff = WMIX_SWA_OUT; }
            else if ((r -= 512) < 1024) { idx = 46; ldn = 2048; nblk = 64; woff = WMIX_GM_IN3; }
            else { r -= 1024; idx = 50; ldn = 1024; nblk = 32; woff = WMIX_GM_OUT3; }
            src = args.in[idx]; dst = (bf16*)(ws + WS_WMIX + woff); k0 = (r / nblk) * 64; n0 = (r % nblk) * 32; Kd = 1024; drow0 = n0;
        }
        tr_item(src, ldn, k0, n0, dst, Kd, drow0, scr, lane);
    }
    const int gt = bid * NTHR + tid, NGT = G * NTHR;
    { bf16* dst = (bf16*)(ws + WS_WMIX + WMIX_DN_IN) + (size_t)3072 * 1024; const float* w = args.in[19];
      for (int i = gt; i < 256 * 1024; i += NGT) { const int n = i >> 10, k = i & 1023; const float v = n < 16 ? w[(size_t)k * 3088 + 3072 + n] : 0.f; dst[i] = (bf16)(pk2(v, 0.f) & 0xffffu); } }
    for (int i = gt; i < 4 * 48 * 1024; i += NGT) {
        const int L = i / 49152, rem = i % 49152, n = rem >> 10, k = rem & 1023;
        const float w = n < 36 ? args.in[LBASE(L) + 4 + NMIX(L)][(size_t)k * 36 + n] : 0.f;
        const unsigned hi = pk2(w, 0.f) & 0xffffu; const float lo = w - bf1((unsigned short)hi);
        bf16* RH = (bf16*)(ws + WS_RTR + (size_t)L * 196608); RH[rem] = (bf16)hi; RH[49152 + rem] = (bf16)(pk2(lo, 0.f) & 0xffffu);
    }
}

__device__ __forceinline__ void norm_store_row(const f32x4 (&v)[4], const float* __restrict__ gain, const float* __restrict__ shift, const float* __restrict__ scale, bf16* __restrict__ hrow, int lane) {
    float ss = 0.f;
#pragma unroll
    for (int j = 0; j < 4; ++j) ss += (v[j][0] * v[j][0] + v[j][1] * v[j][1]) + (v[j][2] * v[j][2] + v[j][3] * v[j][3]);
    const float rstd = __builtin_amdgcn_rsqf(wave_sum(ss) * (1.0f / 1024.0f) + EPS);
#pragma unroll
    for (int j = 0; j < 4; ++j) { const int c = 4 * lane + 256 * j;
        const f32x4 g = *(const f32x4*)(gain + c), sc = *(const f32x4*)(scale + c), sh = *(const f32x4*)(shift + c);
        const f32x4 h = v[j] * rstd * (g * (1.0f + sc)) + sh;
        v2u w; w.x = pk2(h[0], h[1]); w.y = pk2(h[2], h[3]); *(v2u*)(hrow + c) = w; }
}
__device__ __forceinline__ void phase_norm0(const Args& args) {
    int tid_ = threadIdx.x; asm volatile("" : "+v"(tid_)); const int tid = tid_, lane = tid & 63, wave = __builtin_amdgcn_readfirstlane(tid >> 6), G = gridDim.x, bid = blockIdx.x; (void)tid; (void)lane; (void)wave;
    const float* X = args.in[0]; bf16* H = (bf16*)(args.ws + WS_ACT + A_H); const float* MOD = (const float*)(args.ws + WS_MOD);
    for (int t = bid * NWAVES + wave; t < T; t += G * NWAVES) { const int b = t / SEQ; f32x4 v[4];
#pragma unroll
        for (int j = 0; j < 4; ++j) v[j] = *(const f32x4*)(X + (size_t)t * 1024 + 4 * lane + 256 * j);
        const float* m = MOD + (size_t)b * 6144;
        norm_store_row(v, args.in[2], m, m + 1024, H + (size_t)t * 1024, lane); }
}

__device__ __forceinline__ void phase_gm_spatial(const Args& args, int L, LAS unsigned char* lds) {
    int tid_ = threadIdx.x; asm volatile("" : "+v"(tid_)); const int tid = tid_, lane = tid & 63, wave = __builtin_amdgcn_readfirstlane(tid >> 6), G = gridDim.x, bid = blockIdx.x; (void)tid; (void)lane; (void)wave;
    unsigned char* ws = uni_ptr(args.ws); const int ib = LBASE(L) + 4;
    const float* v_norm = args.in[ib + 1]; const float* w_s = args.in[ib + 2]; const float* b_s = args.in[ib + 3];
    const bf16* U = (const bf16*)(ws + WS_ACT + A_U); const bf16* V = (const bf16*)(ws + WS_ACT + A_V); bf16* GT = (bf16*)(ws + WS_ACT + A_GATED);
    const float* VSSP = (const float*)(ws + WS_VSSP);
    LAS bf16* WL = (LAS bf16*)lds; LAS bf16* VT = (LAS bf16*)(lds + 34816); LAS float* rs = (LAS float*)(lds + 69632);
    const int wr = wave >> 2, wc = wave & 3, fr = lane & 15, fq = lane >> 4;
    for (int u = bid; u < 2048; u += G) {
        const int c = u >> 3, g = u & 7; const size_t tok0 = (size_t)c * 128;
        if (tid < 128) { const float* p = VSSP + (tok0 + tid) * 16; float s = 0.f;
#pragma unroll
            for (int i = 0; i < 4; ++i) { const f32x4 q = *(const f32x4*)(p + 4 * i); s += (q[0] + q[1]) + (q[2] + q[3]); }
            rs[tid] = __builtin_amdgcn_rsqf(s * (1.0f / 1024.0f) + EPS); }
        { const int s = tid & 127, dq = tid >> 7; const bf16* vp = V + (tok0 + s) * 1024 + g * 128 + dq * 32;
#pragma unroll
          for (int i = 0; i < 4; ++i) { const v4u q = *(const v4u*)(vp + 8 * i); const unsigned w[4] = {q.x, q.y, q.z, q.w};
#pragma unroll
              for (int e = 0; e < 4; ++e) { VT[(dq * 32 + 8 * i + 2 * e) * 136 + s] = (bf16)(w[e] & 0xffffu); VT[(dq * 32 + 8 * i + 2 * e + 1) * 136 + s] = (bf16)(w[e] >> 16); } } }
        __syncthreads();
        { const int tr = tid >> 2, sq = (tid & 3) * 32; const float* wp = w_s + ((size_t)g * 128 + tr) * 128 + sq;
#pragma unroll
          for (int i = 0; i < 8; ++i) { const f32x4 q = *(const f32x4*)(wp + 4 * i); float o[4];
#pragma unroll
              for (int e = 0; e < 4; ++e) { const int s = sq + 4 * i + e; o[e] = (s <= tr) ? q[e] * rs[s] : 0.f; }
              v2u w; w.x = pk2(o[0], o[1]); w.y = pk2(o[2], o[3]); *(LAS v2u*)(WL + tr * 136 + sq + 4 * i) = w; } }
        __syncthreads();
        f32x4 acc[2][4];
#pragma unroll
        for (int n = 0; n < 2; ++n)
#pragma unroll
            for (int m = 0; m < 4; ++m) acc[n][m] = (f32x4){0.f, 0.f, 0.f, 0.f};
#pragma unroll
        for (int ks = 0; ks < 4; ++ks) { bf16x8 vf[2], wf[4];
#pragma unroll
            for (int n = 0; n < 2; ++n) vf[n] = *(const LAS bf16x8*)(VT + (32 * wc + 16 * n + fr) * 136 + 32 * ks + 8 * fq);
#pragma unroll
            for (int m = 0; m < 4; ++m) wf[m] = *(const LAS bf16x8*)(WL + (64 * wr + 16 * m + fr) * 136 + 32 * ks + 8 * fq);
#pragma unroll
            for (int n = 0; n < 2; ++n)
#pragma unroll
                for (int m = 0; m < 4; ++m) acc[n][m] = __builtin_amdgcn_mfma_f32_16x16x32_bf16(vf[n], wf[m], acc[n][m], 0, 0, 0); }
#pragma unroll
        for (int m = 0; m < 4; ++m) { const int t = 64 * wr + 16 * m + fr; const float bs = b_s[g * 128 + t];
#pragma unroll
            for (int n = 0; n < 2; ++n) { const int d0 = g * 128 + 32 * wc + 16 * n + 4 * fq; const size_t off = (tok0 + t) * 1024 + d0;
                const v2u uu = *(const v2u*)(U + off); const f32x4 vn = *(const f32x4*)(v_norm + d0);
                const float o0 = bflo(uu.x) * (acc[n][m][0] * vn[0] + bs), o1 = bfhi(uu.x) * (acc[n][m][1] * vn[1] + bs), o2 = bflo(uu.y) * (acc[n][m][2] * vn[2] + bs), o3 = bfhi(uu.y) * (acc[n][m][3] * vn[3] + bs);
                v2u w; w.x = pk2(o0, o1); w.y = pk2(o2, o3); *(v2u*)(GT + off) = w; } }
        __syncthreads();
    }
}

__device__ __forceinline__ void phase_swa_attn(const Args& args, LAS unsigned char* lds) {
    int tid_ = threadIdx.x; asm volatile("" : "+v"(tid_)); const int tid = tid_, lane = tid & 63, wave = __builtin_amdgcn_readfirstlane(tid >> 6), G = gridDim.x, bid = blockIdx.x; (void)tid; (void)lane; (void)wave;
    unsigned char* ws = uni_ptr(args.ws);
    const float* q_norm = args.in[34]; const float* k_norm = args.in[35]; const float* sinks = args.in[36];
    const bf16* QKV = (const bf16*)(ws + WS_ACT + A_QKV); bf16* O = (bf16*)(ws + WS_ACT + A_H);
    LAS bf16* KL = (LAS bf16*)lds; LAS bf16* VT = (LAS bf16*)(lds + 36864);
    const int fr = lane & 15, fq = lane >> 4;
    for (int u = bid; u < 1024; u += G) {
        const int n = u & 127, kvh = (u >> 7) & 3, b = u >> 9; const long tok0 = (long)b * SEQ + (long)n * 128;
        { const int key = tid >> 1, half = tid & 1; const long tk = tok0 - 128 + key; float x[32]; float ss = 0.f;
          const bool ok = (n > 0) || (key >= 128);
          const bf16* kp = QKV + (size_t)(ok ? tk : tok0) * 1536 + 1024 + kvh * 64 + half * 32;
#pragma unroll
          for (int i = 0; i < 4; ++i) { const v4u q = *(const v4u*)(kp + 8 * i); const unsigned w[4] = {q.x, q.y, q.z, q.w};
#pragma unroll
              for (int e = 0; e < 4; ++e) { x[8 * i + 2 * e] = bflo(w[e]); x[8 * i + 2 * e + 1] = bfhi(w[e]); } }
#pragma unroll
          for (int i = 0; i < 32; ++i) ss += x[i] * x[i];
          ss += __shfl_xor(ss, 1);
          const float rstd = ok ? __builtin_amdgcn_rsqf(ss * (1.0f / 64.0f) + EPS) : 0.f;
#pragma unroll
          for (int i = 0; i < 4; ++i) { float o[8];
#pragma unroll
              for (int e = 0; e < 8; ++e) o[e] = x[8 * i + e] * rstd * k_norm[half * 32 + 8 * i + e];
              v4u w; w.x = pk2(o[0], o[1]); w.y = pk2(o[2], o[3]); w.z = pk2(o[4], o[5]); w.w = pk2(o[6], o[7]);
              *(LAS v4u*)(KL + key * 72 + half * 32 + 8 * i) = w; } }
        { const int key = tid & 255, dh = tid >> 8; const long tk = tok0 - 128 + key; const bool ok = (n > 0) || (key >= 128);
          const bf16* vp = QKV + (size_t)(ok ? tk : tok0) * 1536 + 1280 + kvh * 64 + dh * 32;
#pragma unroll
          for (int i = 0; i < 4; ++i) { v4u q = *(const v4u*)(vp + 8 * i); if (!ok) q = (v4u){0u, 0u, 0u, 0u}; const unsigned w[4] = {q.x, q.y, q.z, q.w};
#pragma unroll
              for (int e = 0; e < 4; ++e) { VT[(dh * 32 + 8 * i + 2 * e) * 264 + key] = (bf16)(w[e] & 0xffffu); VT[(dh * 32 + 8 * i + 2 * e + 1) * 264 + key] = (bf16)(w[e] >> 16); } } }
        __syncthreads();
        const int g = wave >> 1, qh = wave & 1, hq = kvh * 4 + g; const float sink = sinks[hq];
#pragma unroll 1
        for (int mt = 0; mt < 4; ++mt) {
            asm volatile("" ::: "memory");
            const int qi = qh * 64 + mt * 16 + fr;
            bf16x8 qf[2];
            { float x[16]; float ss = 0.f; const bf16* qp = QKV + (size_t)(tok0 + qi) * 1536 + hq * 64 + 8 * fq;
#pragma unroll
              for (int ks = 0; ks < 2; ++ks) { const v4u q = *(const v4u*)(qp + 32 * ks); const unsigned w[4] = {q.x, q.y, q.z, q.w};
#pragma unroll
                  for (int e = 0; e < 4; ++e) { x[8 * ks + 2 * e] = bflo(w[e]); x[8 * ks + 2 * e + 1] = bfhi(w[e]); } }
#pragma unroll
              for (int i = 0; i < 16; ++i) ss += x[i] * x[i];
              ss += __shfl_xor(ss, 16); ss += __shfl_xor(ss, 32);
              const float rstd = __builtin_amdgcn_rsqf(ss * (1.0f / 64.0f) + EPS) * 0.125f;
#pragma unroll
              for (int ks = 0; ks < 2; ++ks) { float o[8];
#pragma unroll
                  for (int e = 0; e < 8; ++e) o[e] = x[8 * ks + e] * rstd * q_norm[32 * ks + 8 * fq + e];
                  v4u w; w.x = pk2(o[0], o[1]); w.y = pk2(o[2], o[3]); w.z = pk2(o[4], o[5]); w.w = pk2(o[6], o[7]); qf[ks] = __builtin_bit_cast(bf16x8, w); } }
            f32x4 s[16]; float mx = -INFINITY;
#pragma unroll
            for (int nt = 0; nt < 16; ++nt) { f32x4 a = {0.f, 0.f, 0.f, 0.f};
#pragma unroll
                for (int ks = 0; ks < 2; ++ks) { const bf16x8 kf = *(const LAS bf16x8*)(KL + (16 * nt + fr) * 72 + 32 * ks + 8 * fq); a = __builtin_amdgcn_mfma_f32_16x16x32_bf16(kf, qf[ks], a, 0, 0, 0); }
#pragma unroll
                for (int i = 0; i < 4; ++i) { const int kj = 16 * nt + 4 * fq + i; const bool valid = (kj > qi) && (kj <= qi + 128) && ((n > 0) || (kj >= 128)); a[i] = valid ? a[i] : -INFINITY; mx = fmaxf(mx, a[i]); }
                s[nt] = a; }
            mx = fmaxf(mx, __shfl_xor(mx, 16)); mx = fmaxf(mx, __shfl_xor(mx, 32)); mx = fmaxf(mx, sink);
            float l = 0.f;
#pragma unroll
            for (int nt = 0; nt < 16; ++nt)
#pragma unroll
                for (int i = 0; i < 4; ++i) { const float p = fast_exp(s[nt][i] - mx); s[nt][i] = p; l += p; }
            l += __shfl_xor(l, 16); l += __shfl_xor(l, 32); l += fast_exp(sink - mx);
            f32x4 o[4];
#pragma unroll
            for (int dt = 0; dt < 4; ++dt) o[dt] = (f32x4){0.f, 0.f, 0.f, 0.f};
#pragma unroll
            for (int st = 0; st < 8; ++st) {
                v4u pw; pw.x = pk2(s[2 * st][0], s[2 * st][1]); pw.y = pk2(s[2 * st][2], s[2 * st][3]); pw.z = pk2(s[2 * st + 1][0], s[2 * st + 1][1]); pw.w = pk2(s[2 * st + 1][2], s[2 * st + 1][3]);
                const bf16x8 pf = __builtin_bit_cast(bf16x8, pw);
#pragma unroll
                for (int dt = 0; dt < 4; ++dt) { const LAS bf16* vp = VT + (16 * dt + fr) * 264 + 32 * st + 4 * fq;
                    const v2u v0 = *(const LAS v2u*)vp, v1 = *(const LAS v2u*)(vp + 16); v4u vw; vw.x = v0.x; vw.y = v0.y; vw.z = v1.x; vw.w = v1.y;
                    o[dt] = __builtin_amdgcn_mfma_f32_16x16x32_bf16(__builtin_bit_cast(bf16x8, vw), pf, o[dt], 0, 0, 0); } }
            const float inv = 1.0f / l;
#pragma unroll
            for (int dt = 0; dt < 4; ++dt) { v2u w; w.x = pk2(o[dt][0] * inv, o[dt][1] * inv); w.y = pk2(o[dt][2] * inv, o[dt][3] * inv);
                *(v2u*)(O + (size_t)(tok0 + qi) * 1024 + hq * 64 + 16 * dt + 4 * fq) = w; }
        }
        __syncthreads();
    }
}

__device__ __forceinline__ void phase_dn_prep(const Args& args) {
    int tid_ = threadIdx.x; asm volatile("" : "+v"(tid_)); const int tid = tid_, lane = tid & 63, wave = __builtin_amdgcn_readfirstlane(tid >> 6), G = gridDim.x, bid = blockIdx.x; (void)tid; (void)lane; (void)wave;
    unsigned char* ws = uni_ptr(args.ws); const float* conv_w = args.in[20]; const float* a_log = args.in[21]; const float* dt_bias = args.in[22];
    const bf16* QKV = (const bf16*)(ws + WS_ACT + A_QKV); bf16* QN = (bf16*)(ws + WS_ACT + A_QN); bf16* KN = (bf16*)(ws + WS_ACT + A_KN); bf16* VV = (bf16*)(ws + WS_ACT + A_VV);
    const float* BA = (const float*)(ws + WS_BA); float* DNB = (float*)(ws + WS_DNB);
    for (int t = bid * NWAVES + wave; t < T; t += G * NWAVES) { const int pos = t % SEQ;
#pragma unroll
        for (int j = 0; j < 4; ++j) { const int ch = 8 * lane + 512 * j; float a[8];
#pragma unroll
            for (int e = 0; e < 8; ++e) a[e] = 0.f;
#pragma unroll
            for (int tap = 0; tap < 4; ++tap) { if (pos - 3 + tap >= 0) { const v4u q = *(const v4u*)(QKV + (size_t)(t - 3 + tap) * 2048 + ch); const f32x4 w0 = *(const f32x4*)(conv_w + tap * 2048 + ch), w1 = *(const f32x4*)(conv_w + tap * 2048 + ch + 4);
                a[0] += w0[0] * bflo(q.x); a[1] += w0[1] * bfhi(q.x); a[2] += w0[2] * bflo(q.y); a[3] += w0[3] * bfhi(q.y); a[4] += w1[0] * bflo(q.z); a[5] += w1[1] * bfhi(q.z); a[6] += w1[2] * bflo(q.w); a[7] += w1[3] * bfhi(q.w); } }
            float ss = 0.f;
#pragma unroll
            for (int e = 0; e < 8; ++e) { a[e] = siluf_(a[e]); ss += a[e] * a[e]; }
            if (j < 2) { ss += __shfl_xor(ss, 1); ss += __shfl_xor(ss, 2); ss += __shfl_xor(ss, 4); ss += __shfl_xor(ss, 8);
                const float r = __builtin_amdgcn_rsqf(ss + EPS); bf16* dst = (j == 0 ? QN : KN) + (size_t)t * 512 + 8 * lane;
                v4u w; w.x = pk2(a[0] * r, a[1] * r); w.y = pk2(a[2] * r, a[3] * r); w.z = pk2(a[4] * r, a[5] * r); w.w = pk2(a[6] * r, a[7] * r); *(v4u*)dst = w; }
            else { v4u w; w.x = pk2(a[0], a[1]); w.y = pk2(a[2], a[3]); w.z = pk2(a[4], a[5]); w.w = pk2(a[6], a[7]); *(v4u*)(VV + (size_t)t * 1024 + 8 * lane + 512 * (j - 2)) = w; } }
        if (lane < 8) { const float bi = BA[(size_t)t * 16 + lane], ai = BA[(size_t)t * 16 + 8 + lane] + dt_bias[lane];
            const float sp = fmaxf(ai, 0.f) + log1pf(expf(-fabsf(ai)));
            DNB[(size_t)t * 16 + lane] = 1.0f / (1.0f + expf(-bi)); DNB[(size_t)t * 16 + 8 + lane] = -expf(a_log[lane]) * sp; }
    }
}
constexpr int FA_STRIDE = 25600, FB_STRIDE = 32768, FU_STRIDE = 16384;
constexpr float DN_SCALE = 0.08838834764831845f;
__device__ __forceinline__ void phase_dn_chunk(const Args& args, LAS unsigned char* lds) {
    int tid_ = threadIdx.x; asm volatile("" : "+v"(tid_)); const int tid = tid_, lane = tid & 63, wave = __builtin_amdgcn_readfirstlane(tid >> 6), G = gridDim.x, bid = blockIdx.x;
    unsigned char* ws = uni_ptr(args.ws);
    const bf16* QN = (const bf16*)(ws + WS_ACT + A_QN); const bf16* KN = (const bf16*)(ws + WS_ACT + A_KN); const bf16* VV = (const bf16*)(ws + WS_ACT + A_VV);
    const float* DNB = (const float*)(ws + WS_DNB);
    unsigned char* FA = ws + WS_ACT + A_FA; unsigned char* FB = ws + WS_ACT + A_FB; unsigned char* FU = ws + WS_ACT + A_FU;
    LAS float* Al = (LAS float*)(lds + wave * 16384);
    LAS float* tb = (LAS float*)(lds + LDSCTL_OFF + 2048 + wave * 512);
    const int fr = lane & 15, fq = lane >> 4;
    for (int it = bid * NWAVES + wave; it < 4096; it += G * NWAVES) {
        const int b = it >> 11, hv = (it >> 8) & 7, n = it & 255, hq = hv >> 1; const size_t t0 = (size_t)b * SEQ + (size_t)n * 64; const int itq = (b * 4 + hq) * 256 + n;
        unsigned char* fa = FA + (size_t)it * FA_STRIDE; unsigned char* fb = FB + (size_t)itq * FB_STRIDE;
        const float bv = DNB[(t0 + lane) * 16 + hv]; float gcv = DNB[(t0 + lane) * 16 + 8 + hv];
#pragma unroll
        for (int o = 1; o < 64; o <<= 1) { const float t = __shfl_up(gcv, o); if (lane >= o) gcv += t; }
        const float gll = __shfl(gcv, 63);
        tb[lane] = gcv; tb[64 + lane] = bv;
        { float* fe = (float*)(fa + 24576); fe[lane] = DN_SCALE * expf(gcv); fe[64 + lane] = expf(gll - gcv); fe[128 + lane] = expf(gll); }
        asm volatile("" ::: "memory");
        bf16x8 kf[4][4];
#pragma unroll
        for (int t = 0; t < 4; ++t)
#pragma unroll
            for (int ks = 0; ks < 4; ++ks) kf[t][ks] = *(const bf16x8*)(KN + (t0 + 16 * t + fr) * 512 + hq * 128 + 32 * ks + 8 * fq);
#pragma unroll
        for (int m = 0; m < 4; ++m) { const int c = 16 * m + fr; const float bm = tb[64 + c], gm = tb[c];
            bf16x8 qf[4];
#pragma unroll
            for (int ks = 0; ks < 4; ++ks) qf[ks] = *(const bf16x8*)(QN + (t0 + c) * 512 + hq * 128 + 32 * ks + 8 * fq);
            f32x4 tl[4];
#pragma unroll
            for (int t = 0; t < 4; ++t) {
                if (t <= m) { f32x4 ak = {0.f, 0.f, 0.f, 0.f}, aq = {0.f, 0.f, 0.f, 0.f};
#pragma unroll
                    for (int ks = 0; ks < 4; ++ks) { ak = __builtin_amdgcn_mfma_f32_16x16x32_bf16(kf[t][ks], kf[m][ks], ak, 0, 0, 0); aq = __builtin_amdgcn_mfma_f32_16x16x32_bf16(kf[t][ks], qf[ks], aq, 0, 0, 0); }
                    const f32x4 gs4 = *(const LAS f32x4*)(tb + 16 * t + 4 * fq); f32x4 av;
#pragma unroll
                    for (int r = 0; r < 4; ++r) { const int s = 16 * t + 4 * fq + r; const float dec = expf(fminf(gm - gs4[r], 0.f)); av[r] = (s < c) ? bm * ak[r] * dec : 0.f; tl[t][r] = (s <= c) ? DN_SCALE * aq[r] * dec : 0.f; }
                    *(LAS f32x4*)(Al + c * 64 + 16 * t + 4 * fq) = av; }
                else tl[t] = (f32x4){0.f, 0.f, 0.f, 0.f}; }
#pragma unroll
            for (int k2 = 0; k2 < 2; ++k2) { v4u w; w.x = pk2(tl[2 * k2][0], tl[2 * k2][1]); w.y = pk2(tl[2 * k2][2], tl[2 * k2][3]); w.z = pk2(tl[2 * k2 + 1][0], tl[2 * k2 + 1][1]); w.w = pk2(tl[2 * k2 + 1][2], tl[2 * k2 + 1][3]);
                *(v4u*)(fa + 16384 + (m * 2 + k2) * 1024 + lane * 16) = w; } }
        asm volatile("s_waitcnt lgkmcnt(0)" ::: "memory");
        float Tc[64];
#pragma unroll
        for (int m = 0; m < 64; ++m) Tc[m] = (m == lane) ? 1.f : 0.f;
#pragma unroll
        for (int r = 1; r < 64; ++r) { float acc = 0.f;
#pragma unroll
            for (int m4 = 0; m4 < (r + 3) / 4; ++m4) { const f32x4 a4 = *(const LAS f32x4*)(Al + r * 64 + 4 * m4);
#pragma unroll
                for (int e = 0; e < 4; ++e) if (4 * m4 + e < r) acc += a4[e] * Tc[4 * m4 + e]; }
            Tc[r] -= acc; }
        asm volatile("s_waitcnt lgkmcnt(0)" ::: "memory");
        LAS bf16* T1l = (LAS bf16*)Al; LAS bf16* T2l = T1l + 4096;
        { const float c1 = bv, c2 = bv * expf(gcv);
#pragma unroll
          for (int i = 0; i < 64; ++i) { T1l[i * 64 + lane] = (bf16)(pk2(Tc[i] * c1, 0.f) & 0xffffu); T2l[i * 64 + lane] = (bf16)(pk2(Tc[i] * c2, 0.f) & 0xffffu); } }
        asm volatile("s_waitcnt lgkmcnt(0)" ::: "memory");
        { bf16x8 t1f[4][2];
#pragma unroll
          for (int m = 0; m < 4; ++m)
#pragma unroll
              for (int k2 = 0; k2 < 2; ++k2) t1f[m][k2] = *(const LAS bf16x8*)(T1l + (16 * m + fr) * 64 + 32 * k2 + 8 * fq);
#pragma unroll 1
          for (int j = 0; j < 8; ++j) { bf16x8 vf[2];
#pragma unroll
              for (int k2 = 0; k2 < 2; ++k2)
#pragma unroll
                  for (int i = 0; i < 8; ++i) vf[k2][i] = (short)VV[(t0 + 32 * k2 + 8 * fq + i) * 1024 + hv * 128 + 16 * j + fr];
#pragma unroll
              for (int m = 0; m < 4; ++m) { f32x4 a = {0.f, 0.f, 0.f, 0.f};
#pragma unroll
                  for (int k2 = 0; k2 < 2; ++k2) a = __builtin_amdgcn_mfma_f32_16x16x32_bf16(t1f[m][k2], vf[k2], a, 0, 0, 0);
                  v2u w; w.x = pk2(a[0], a[1]); w.y = pk2(a[2], a[3]); *(v2u*)(FU + (size_t)it * FU_STRIDE + ((j * 4 + m) * 64 + lane) * 8) = w; } } }
        { bf16x8 ktf[8][2];
#pragma unroll
          for (int dt = 0; dt < 8; ++dt)
#pragma unroll
              for (int k2 = 0; k2 < 2; ++k2)
#pragma unroll
                  for (int i = 0; i < 8; ++i) ktf[dt][k2][i] = (short)KN[(t0 + 32 * k2 + 16 * (i >> 2) + 4 * fq + (i & 3)) * 512 + hq * 128 + 16 * dt + fr];
          if ((hv & 1) == 0) {
#pragma unroll
              for (int dt = 0; dt < 8; ++dt)
#pragma unroll
                  for (int k2 = 0; k2 < 2; ++k2) *(bf16x8*)(fb + 16384 + (dt * 2 + k2) * 1024 + lane * 16) = ktf[dt][k2];
#pragma unroll
              for (int m = 0; m < 4; ++m)
#pragma unroll
                  for (int ks = 0; ks < 4; ++ks) { const bf16* qp = QN + (t0 + 16 * m + fr) * 512 + hq * 128 + 32 * ks + 4 * fq; const v2u lo = *(const v2u*)qp, hi = *(const v2u*)(qp + 16);
                      v4u w; w.x = lo.x; w.y = lo.y; w.z = hi.x; w.w = hi.y; *(v4u*)(fb + (m * 4 + ks) * 1024 + lane * 16) = w; } }
#pragma unroll
          for (int m = 0; m < 4; ++m) { bf16x8 t2f[2];
#pragma unroll
              for (int k2 = 0; k2 < 2; ++k2) { const LAS bf16* tp = T2l + (16 * m + fr) * 64 + 32 * k2 + 4 * fq; const v2u lo = *(const LAS v2u*)tp, hi = *(const LAS v2u*)(tp + 16); v4u w; w.x = lo.x; w.y = lo.y; w.z = hi.x; w.w = hi.y; t2f[k2] = __builtin_bit_cast(bf16x8, w); }
              f32x4 acc[8];
#pragma unroll
              for (int dt = 0; dt < 8; ++dt) { acc[dt] = (f32x4){0.f, 0.f, 0.f, 0.f};
#pragma unroll
                  for (int k2 = 0; k2 < 2; ++k2) acc[dt] = __builtin_amdgcn_mfma_f32_16x16x32_bf16(ktf[dt][k2], t2f[k2], acc[dt], 0, 0, 0); }
#pragma unroll
              for (int ks = 0; ks < 4; ++ks) { v4u w; w.x = pk2(-acc[2 * ks][0], -acc[2 * ks][1]); w.y = pk2(-acc[2 * ks][2], -acc[2 * ks][3]); w.z = pk2(-acc[2 * ks + 1][0], -acc[2 * ks + 1][1]); w.w = pk2(-acc[2 * ks + 1][2], -acc[2 * ks + 1][3]);
                  *(v4u*)(fa + (m * 4 + ks) * 1024 + lane * 16) = w; } } }
        asm volatile("s_waitcnt lgkmcnt(0)" ::: "memory");
    }
}
__device__ __forceinline__ void phase_dn_scan(const Args& args, LAS unsigned char* lds) {
    int tid_ = threadIdx.x; asm volatile("" : "+v"(tid_)); const int tid = tid_, lane = tid & 63, wave = __builtin_amdgcn_readfirstlane(tid >> 6), G = gridDim.x, bid = blockIdx.x;
    if (wave != 0) return;
    unsigned char* ws = uni_ptr(args.ws);
    const unsigned char* FA = ws + WS_ACT + A_FA; const unsigned char* FB = ws + WS_ACT + A_FB; const unsigned char* FU = ws + WS_ACT + A_FU; bf16* O = (bf16*)(ws + WS_ACT + A_O);
    const int fr = lane & 15, fq = lane >> 4;
    constexpr int SLOT = 60416, O_QK = 16384, O_TB = 24576, O_Q = 25600, O_KT = 41984, O_U = 58368;
#define SB() __builtin_amdgcn_sched_barrier(0)
#define DMA4(g, l) do { __builtin_amdgcn_global_load_lds((g), (l), 16, 0, 0); __builtin_amdgcn_global_load_lds((g), (l), 16, 1024, 0); __builtin_amdgcn_global_load_lds((g), (l), 16, 2048, 0); __builtin_amdgcn_global_load_lds((g), (l), 16, 3072, 0); } while (0)
    for (int sidx = bid; sidx < 128; sidx += G) {
        const int bh = (sidx & 7) * 2 + (sidx >> 6), j = (sidx >> 3) & 7, b = bh >> 3, hv = bh & 7, hq = hv >> 1;
        const int it0 = bh * 256, itq0 = (b * 4 + hq) * 256;
        f32x4 S[8];
#pragma unroll
        for (int dt = 0; dt < 8; ++dt) S[dt] = (f32x4){0.f, 0.f, 0.f, 0.f};
#define DN_ISSUE(nn) do { const unsigned char* fa_ = FA + (size_t)(it0 + (nn)) * FA_STRIDE + lane * 16; const unsigned char* fb_ = FB + (size_t)(itq0 + (nn)) * FB_STRIDE + lane * 16; \
            const unsigned char* fu_ = FU + (size_t)(it0 + (nn)) * FU_STRIDE + j * 2048 + lane * 16; LAS unsigned char* sl_ = lds + ((nn) & 1) * SLOT; \
            _Pragma("unroll") for (int f4 = 0; f4 < 6; ++f4) { DMA4((const unsigned*)(fa_ + f4 * 4096), (LAS unsigned*)(sl_ + f4 * 4096)); } \
            __builtin_amdgcn_global_load_lds((const unsigned*)(fa_ + 24576), (LAS unsigned*)(sl_ + O_TB), 16, 0, 0); \
            _Pragma("unroll") for (int f4 = 0; f4 < 8; ++f4) { DMA4((const unsigned*)(fb_ + f4 * 4096), (LAS unsigned*)(sl_ + O_Q + f4 * 4096)); } \
            __builtin_amdgcn_global_load_lds((const unsigned*)(fu_), (LAS unsigned*)(sl_ + O_U), 16, 0, 0); __builtin_amdgcn_global_load_lds((const unsigned*)(fu_), (LAS unsigned*)(sl_ + O_U), 16, 1024, 0); } while (0)
        DN_ISSUE(0);
        bf16x8 sf[4];
#pragma unroll
        for (int ks = 0; ks < 4; ++ks) sf[ks] = (bf16x8){0, 0, 0, 0, 0, 0, 0, 0};
#pragma unroll 1
        for (int n = 0; n < 256; ++n) {
            if (n == 0) asm volatile("s_waitcnt vmcnt(0)" ::: "memory"); else asm volatile("s_waitcnt vmcnt(16)" ::: "memory");
            if (n + 1 < 256) DN_ISSUE(n + 1);
            asm volatile("" ::: "memory");
            const LAS unsigned char* base = lds + (n & 1) * SLOT + lane * 16;
            const LAS float* tbl = (const LAS float*)(lds + (n & 1) * SLOT + O_TB);
            f32x4 egc[4], ekd[4], av[4], ao[4];
#pragma unroll
            for (int m = 0; m < 4; ++m) { egc[m] = *(const LAS f32x4*)(tbl + 16 * m + 4 * fq); ekd[m] = *(const LAS f32x4*)(tbl + 64 + 16 * m + 4 * fq);
                const v2u u2 = *(const LAS v2u*)(lds + (n & 1) * SLOT + O_U + (m * 64 + lane) * 8); av[m] = (f32x4){bflo(u2.x), bfhi(u2.x), bflo(u2.y), bfhi(u2.y)}; ao[m] = (f32x4){0.f, 0.f, 0.f, 0.f}; }
            const float gl = tbl[128 + lane];
            SB();
            bf16x8 Aw[16], Bq[16];
#pragma unroll
            for (int f = 0; f < 16; ++f) Aw[f] = *(const LAS bf16x8*)(base + f * 1024);
#pragma unroll
            for (int f = 0; f < 16; ++f) Bq[f] = *(const LAS bf16x8*)(base + O_Q + f * 1024);
            SB();
#pragma unroll
            for (int ks = 0; ks < 4; ++ks)
#pragma unroll
                for (int m = 0; m < 4; ++m) av[m] = __builtin_amdgcn_mfma_f32_16x16x32_bf16(Aw[m * 4 + ks], sf[ks], av[m], 0, 0, 0);
            SB();
            bf16x8 Ck[16];
#pragma unroll
            for (int f = 0; f < 8; ++f) Ck[f] = *(const LAS bf16x8*)(base + O_QK + f * 1024);
#pragma unroll
            for (int f = 0; f < 8; ++f) Ck[8 + f] = *(const LAS bf16x8*)(base + O_KT + f * 1024);
            SB();
#pragma unroll
            for (int ks = 0; ks < 4; ++ks)
#pragma unroll
                for (int m = 0; m < 4; ++m) ao[m] = __builtin_amdgcn_mfma_f32_16x16x32_bf16(Bq[m * 4 + ks], sf[ks], ao[m], 0, 0, 0);
#pragma unroll
            for (int dt = 0; dt < 8; ++dt) S[dt] = S[dt] * gl;
            SB();
            bf16x8 Dk[8];
#pragma unroll
            for (int f = 0; f < 8; ++f) Dk[f] = *(const LAS bf16x8*)(base + O_KT + 8192 + f * 1024);
            bf16x8 vf[2], vpf[2];
#pragma unroll
            for (int k2 = 0; k2 < 2; ++k2) { v4u w; w.x = pk2(av[2 * k2][0], av[2 * k2][1]); w.y = pk2(av[2 * k2][2], av[2 * k2][3]); w.z = pk2(av[2 * k2 + 1][0], av[2 * k2 + 1][1]); w.w = pk2(av[2 * k2 + 1][2], av[2 * k2 + 1][3]); vf[k2] = __builtin_bit_cast(bf16x8, w);
                const f32x4 p0 = av[2 * k2] * ekd[2 * k2], p1 = av[2 * k2 + 1] * ekd[2 * k2 + 1];
                v4u x; x.x = pk2(p0[0], p0[1]); x.y = pk2(p0[2], p0[3]); x.z = pk2(p1[0], p1[1]); x.w = pk2(p1[2], p1[3]); vpf[k2] = __builtin_bit_cast(bf16x8, x); }
#pragma unroll
            for (int m = 0; m < 4; ++m) ao[m] = ao[m] * egc[m];
            SB();
#pragma unroll
            for (int k2 = 0; k2 < 2; ++k2)
#pragma unroll
                for (int dt = 0; dt < 4; ++dt) S[dt] = __builtin_amdgcn_mfma_f32_16x16x32_bf16(Ck[8 + dt * 2 + k2], vpf[k2], S[dt], 0, 0, 0);
#pragma unroll
            for (int k2 = 0; k2 < 2; ++k2)
#pragma unroll
                for (int dt = 4; dt < 8; ++dt) S[dt] = __builtin_amdgcn_mfma_f32_16x16x32_bf16(Dk[(dt - 4) * 2 + k2], vpf[k2], S[dt], 0, 0, 0);
#pragma unroll
            for (int k2 = 0; k2 < 2; ++k2)
#pragma unroll
                for (int m = 0; m < 4; ++m) ao[m] = __builtin_amdgcn_mfma_f32_16x16x32_bf16(Ck[m * 2 + k2], vf[k2], ao[m], 0, 0, 0);
            SB();
#pragma unroll
            for (int ks = 0; ks < 4; ++ks) { v4u w; w.x = pk2(S[2 * ks][0], S[2 * ks][1]); w.y = pk2(S[2 * ks][2], S[2 * ks][3]); w.z = pk2(S[2 * ks + 1][0], S[2 * ks + 1][1]); w.w = pk2(S[2 * ks + 1][2], S[2 * ks + 1][3]); sf[ks] = __builtin_bit_cast(bf16x8, w); }
            asm volatile("s_waitcnt lgkmcnt(0)" ::: "memory");
            { bf16* op = O + ((size_t)b * SEQ + (size_t)n * 64 + 4 * fq) * 1024 + hv * 128 + 16 * j + fr;
#pragma unroll
              for (int m = 0; m < 4; ++m)
#pragma unroll
                  for (int r = 0; r < 4; ++r) op[(size_t)(16 * m + r) * 1024] = (bf16)(pk2(ao[m][r], 0.f) & 0xffffu); }
        }
#undef DN_ISSUE
    }
#undef SB
#undef DMA4
}
__device__ __forceinline__ void phase_dn_ogate(const Args& args) {
    int tid_ = threadIdx.x; asm volatile("" : "+v"(tid_)); const int tid = tid_, lane = tid & 63, wave = __builtin_amdgcn_readfirstlane(tid >> 6), G = gridDim.x, bid = blockIdx.x; (void)tid; (void)lane; (void)wave;
    unsigned char* ws = uni_ptr(args.ws); const float* o_norm = args.in[23];
    const bf16* O = (const bf16*)(ws + WS_ACT + A_O); const bf16* Z = (const bf16*)(ws + WS_ACT + A_Z); bf16* GT = (bf16*)(ws + WS_ACT + A_H);
    for (int t = bid * NWAVES + wave; t < T; t += G * NWAVES) {
#pragma unroll
        for (int j = 0; j < 2; ++j) { const int ch = 8 * lane + 512 * j; const v4u q = *(const v4u*)(O + (size_t)t * 1024 + ch), z = *(const v4u*)(Z + (size_t)t * 1024 + ch);
            float o[8] = {bflo(q.x), bfhi(q.x), bflo(q.y), bfhi(q.y), bflo(q.z), bfhi(q.z), bflo(q.w), bfhi(q.w)}; const float zz[8] = {bflo(z.x), bfhi(z.x), bflo(z.y), bfhi(z.y), bflo(z.z), bfhi(z.z), bflo(z.w), bfhi(z.w)};
            float ss = 0.f;
#pragma unroll
            for (int e = 0; e < 8; ++e) ss += o[e] * o[e];
            ss += __shfl_xor(ss, 1); ss += __shfl_xor(ss, 2); ss += __shfl_xor(ss, 4); ss += __shfl_xor(ss, 8);
            const float r = __builtin_amdgcn_rsqf(ss * (1.0f / 128.0f) + EPS);
#pragma unroll
            for (int e = 0; e < 8; ++e) o[e] = o[e] * r * o_norm[(ch & 127) + e] * siluf_(zz[e]);
            v4u w; w.x = pk2(o[0], o[1]); w.y = pk2(o[2], o[3]); w.z = pk2(o[4], o[5]); w.w = pk2(o[6], o[7]); *(v4u*)(GT + (size_t)t * 1024 + ch) = w; }
    }
}

__device__ __forceinline__ void phase_moe_router(const Args& args, int L, LAS unsigned char* lds) {
    int tid_ = threadIdx.x; asm volatile("" : "+v"(tid_)); const int tid = tid_, lane = tid & 63, wave = __builtin_amdgcn_readfirstlane(tid >> 6), G = gridDim.x, bid = blockIdx.x; (void)tid; (void)lane; (void)wave;
    unsigned char* ws = uni_ptr(args.ws); const int ib = LBASE(L) + 4 + NMIX(L);
    const float* X = args.out; bf16* H = (bf16*)(ws + WS_ACT + A_H); const float* MOD = (const float*)(ws + WS_MOD) + (size_t)L * 2 * 6144;
    const float* nf = args.in[LBASE(L) + 1]; const float* rb = args.in[ib + 1];
    const bf16* RH = (const bf16*)(ws + WS_RTR + (size_t)L * 196608); const bf16* RLo = RH + 49152;
    int* EID = (int*)(ws + WS_EID); float* GATE = (float*)(ws + WS_GATE); int* CNT = (int*)(ws + WS_CNT);
    LAS float* gs = (LAS float*)lds; LAS float* sh = gs + 1024; LAS int* lcnt = (LAS int*)(lds + 8192); LAS float* scr = (LAS float*)(lds + 8448 + wave * 3072);
    const int r = lane & 15, q = lane >> 4;
    for (int item = bid; item < T / 128; item += G) {
        const int r0 = item * 128, b = r0 / SEQ; const float* m = MOD + (size_t)b * 6144;
        __syncthreads();
        for (int k = tid; k < 1024; k += NTHR) { gs[k] = nf[k] * (1.0f + m[4096 + k]); sh[k] = m[3072 + k]; }
        if (tid < 32) lcnt[tid] = 0;
        __syncthreads();
        const int row = r0 + 16 * wave + r; const float* xp = X + (size_t)row * 1024 + 8 * q;
        float ss = 0.f;
#pragma unroll 8
        for (int j = 0; j < 32; ++j) { const f32x4 v0 = *(const f32x4*)(xp + 32 * j), v1 = *(const f32x4*)(xp + 32 * j + 4); ss += (v0[0] * v0[0] + v0[1] * v0[1]) + (v0[2] * v0[2] + v0[3] * v0[3]) + (v1[0] * v1[0] + v1[1] * v1[1]) + (v1[2] * v1[2] + v1[3] * v1[3]); }
        ss += __shfl_xor(ss, 16); ss += __shfl_xor(ss, 32);
        const float rstd = __builtin_amdgcn_rsqf(ss * (1.0f / 1024.0f) + EPS);
        f32x4 acc[3];
#pragma unroll
        for (int nt = 0; nt < 3; ++nt) acc[nt] = (f32x4){0.f, 0.f, 0.f, 0.f};
#pragma unroll 2
        for (int j = 0; j < 32; ++j) { const int k0 = 32 * j + 8 * q; const f32x4 v0 = *(const f32x4*)(xp + 32 * j), v1 = *(const f32x4*)(xp + 32 * j + 4);
            const f32x4 g0 = *(const LAS f32x4*)(gs + k0), g1 = *(const LAS f32x4*)(gs + k0 + 4), s0 = *(const LAS f32x4*)(sh + k0), s1 = *(const LAS f32x4*)(sh + k0 + 4);
            const f32x4 h0 = v0 * rstd * g0 + s0, h1 = v1 * rstd * g1 + s1;
            v4u hi; hi.x = pk2(h0[0], h0[1]); hi.y = pk2(h0[2], h0[3]); hi.z = pk2(h1[0], h1[1]); hi.w = pk2(h1[2], h1[3]);
            v4u lo; lo.x = pk2(h0[0] - bflo(hi.x), h0[1] - bfhi(hi.x)); lo.y = pk2(h0[2] - bflo(hi.y), h0[3] - bfhi(hi.y)); lo.z = pk2(h1[0] - bflo(hi.z), h1[1] - bfhi(hi.z)); lo.w = pk2(h1[2] - bflo(hi.w), h1[3] - bfhi(hi.w));
            *(v4u*)(H + (size_t)row * 1024 + k0) = hi;
            const bf16x8 ahi = __builtin_bit_cast(bf16x8, hi), alo = __builtin_bit_cast(bf16x8, lo);
#pragma unroll
            for (int nt = 0; nt < 3; ++nt) { const bf16x8 bh = *(const bf16x8*)(RH + (size_t)(nt * 16 + r) * 1024 + k0), bl = *(const bf16x8*)(RLo + (size_t)(nt * 16 + r) * 1024 + k0);
                acc[nt] = __builtin_amdgcn_mfma_f32_16x16x32_bf16(bh, ahi, acc[nt], 0, 0, 0); acc[nt] = __builtin_amdgcn_mfma_f32_16x16x32_bf16(bl, ahi, acc[nt], 0, 0, 0); acc[nt] = __builtin_amdgcn_mfma_f32_16x16x32_bf16(bh, alo, acc[nt], 0, 0, 0); } }
#pragma unroll
        for (int nt = 0; nt < 3; ++nt) *(LAS f32x4*)(scr + r * 48 + 16 * nt + 4 * q) = acc[nt];
        LDS_WAIT(); asm volatile("" ::: "memory");
        if (lane < 16) { float lg[36];
#pragma unroll
            for (int i = 0; i < 9; ++i) { const f32x4 v = *(const LAS f32x4*)(scr + r * 48 + 4 * i); lg[4 * i] = v[0] + rb[4 * i]; lg[4 * i + 1] = v[1] + rb[4 * i + 1]; lg[4 * i + 2] = v[2] + rb[4 * i + 2]; lg[4 * i + 3] = v[3] + rb[4 * i + 3]; }
            int gsel = 0; float gm = lg[0];
#pragma unroll
            for (int i = 1; i < 4; ++i) if (lg[i] > gm) { gm = lg[i]; gsel = i; }
            float gsum = 0.f;
#pragma unroll
            for (int i = 0; i < 4; ++i) gsum += expf(lg[i] - gm);
            const float pg = 1.0f / gsum;
            float le[8];
#pragma unroll
            for (int i = 0; i < 8; ++i) le[i] = gsel == 0 ? lg[4 + i] : (gsel == 1 ? lg[12 + i] : (gsel == 2 ? lg[20 + i] : lg[28 + i]));
            int j1 = 0; float m1 = le[0];
#pragma unroll
            for (int i = 1; i < 8; ++i) if (le[i] > m1) { m1 = le[i]; j1 = i; }
            int j2 = -1; float m2 = -INFINITY;
#pragma unroll
            for (int i = 0; i < 8; ++i) if (i != j1 && le[i] > m2) { m2 = le[i]; j2 = i; }
            const float p2 = expf(m2 - m1), den = 1.0f / (1.0f + p2);
            const int e1 = gsel * 8 + j1, e2 = gsel * 8 + j2;
            EID[(size_t)row * 2] = e1; EID[(size_t)row * 2 + 1] = e2; GATE[(size_t)row * 2] = pg * den; GATE[(size_t)row * 2 + 1] = pg * p2 * den;
            __hip_atomic_fetch_add(lcnt + e1, 1, __ATOMIC_RELAXED, __HIP_MEMORY_SCOPE_WORKGROUP); __hip_atomic_fetch_add(lcnt + e2, 1, __ATOMIC_RELAXED, __HIP_MEMORY_SCOPE_WORKGROUP); }
        __syncthreads();
        if (tid < 32) CNT[item * 32 + tid] = lcnt[tid];
    }
}
__device__ __forceinline__ void phase_moe_scatter(const Args& args, LAS unsigned char* lds) {
    int tid_ = threadIdx.x; asm volatile("" : "+v"(tid_)); const int tid = tid_, lane = tid & 63, wave = __builtin_amdgcn_readfirstlane(tid >> 6), G = gridDim.x, bid = blockIdx.x; (void)tid; (void)lane; (void)wave;
    unsigned char* ws = uni_ptr(args.ws);
    const bf16* H = (const bf16*)(ws + WS_ACT + A_H); bf16* XG = (bf16*)(ws + WS_ACT + A_XG);
    const int* EID = (const int*)(ws + WS_EID); int* SLOT = (int*)(ws + WS_SLOT); const int* CNT = (const int*)(ws + WS_CNT); int* TILEE = (int*)(ws + WS_TILEE);
    LAS int* tot = (LAS int*)lds; LAS int* before = tot + 32; LAS int* pstart = tot + 64; LAS int* lcnt = tot + 96; LAS int* lslot = tot + 128;
    for (int item = bid; item < T / 128; item += G) {
        const int r0 = item * 128;
        __syncthreads();
        if (tid < 32) { int t_ = 0, b_ = 0;
            for (int w = 0; w < T / 128; ++w) { const int c = CNT[w * 32 + tid]; t_ += c; b_ += (w < item) ? c : 0; }
            tot[tid] = t_; before[tid] = b_; lcnt[tid] = 0; }
        __syncthreads();
        if (tid == 0) { int ps = 0; for (int e = 0; e < 32; ++e) { pstart[e] = ps; ps += (tot[e] + 255) & ~255; }
            if (item == 0) { TILEE[0] = ps >> 8; for (int e = 0; e < 32; ++e) { const int t0 = pstart[e] >> 8, nt = ((tot[e] + 255) >> 8); for (int i = 0; i < nt; ++i) TILEE[16 + t0 + i] = e; } } }
        __syncthreads();
        if (tid < 256) { const int e = EID[(size_t)r0 * 2 + tid]; const int rank = __hip_atomic_fetch_add(lcnt + e, 1, __ATOMIC_RELAXED, __HIP_MEMORY_SCOPE_WORKGROUP); const int slot = pstart[e] + before[e] + rank; SLOT[(size_t)r0 * 2 + tid] = slot; lslot[tid] = slot; }
        __syncthreads();
        for (int rr = 0; rr < 16; ++rr) { const int row = 16 * wave + rr; const bf16* src = H + (size_t)(r0 + row) * 1024;
            const v4u a = *(const v4u*)(src + 8 * lane), c = *(const v4u*)(src + 512 + 8 * lane); const int s0 = lslot[2 * row], s1 = lslot[2 * row + 1];
            bf16* d0 = XG + (size_t)s0 * 1024; bf16* d1 = XG + (size_t)s1 * 1024;
            *(v4u*)(d0 + 8 * lane) = a; *(v4u*)(d0 + 512 + 8 * lane) = c; *(v4u*)(d1 + 8 * lane) = a; *(v4u*)(d1 + 512 + 8 * lane) = c; }
        { const int e = item & 31, part = item >> 5; const int p0 = pstart[e] + tot[e], npad = ((tot[e] + 255) & ~255) - tot[e]; const v4u z = {0u, 0u, 0u, 0u};
          for (int pr = part * 8 + wave; pr < npad; pr += 64) { bf16* d = XG + (size_t)(p0 + pr) * 1024; *(v4u*)(d + 8 * lane) = z; *(v4u*)(d + 512 + 8 * lane) = z; } }
    }
}
__device__ __forceinline__ void phase_moe_combine(const Args& args, int L) {
    int tid_ = threadIdx.x; asm volatile("" : "+v"(tid_)); const int tid = tid_, lane = tid & 63, wave = __builtin_amdgcn_readfirstlane(tid >> 6), G = gridDim.x, bid = blockIdx.x; (void)tid; (void)lane; (void)wave;
    unsigned char* ws = uni_ptr(args.ws); float* X = args.out; const bf16* Y = (const bf16*)(ws + WS_ACT + A_Y); bf16* H = (bf16*)(ws + WS_ACT + A_H);
    const int* SLOT = (const int*)(ws + WS_SLOT); const float* GATE = (const float*)(ws + WS_GATE); const float* MOD = (const float*)(ws + WS_MOD);
    for (int t = bid * NWAVES + wave; t < T; t += G * NWAVES) { const int b = t / SEQ;
        const int s0 = SLOT[(size_t)t * 2], s1 = SLOT[(size_t)t * 2 + 1]; const float g0 = GATE[(size_t)t * 2], g1 = GATE[(size_t)t * 2 + 1];
        const float* gf = MOD + (size_t)(L * 2 + b) * 6144 + 5120; f32x4 v[4];
#pragma unroll
        for (int j = 0; j < 4; ++j) { const int c = 4 * lane + 256 * j; const f32x4 x = *(const f32x4*)(X + (size_t)t * 1024 + c), gg = *(const f32x4*)(gf + c);
            const v2u y0 = *(const v2u*)(Y + (size_t)s0 * 1024 + c), y1 = *(const v2u*)(Y + (size_t)s1 * 1024 + c);
            f32x4 mo; mo[0] = g0 * bflo(y0.x) + g1 * bflo(y1.x); mo[1] = g0 * bfhi(y0.x) + g1 * bfhi(y1.x); mo[2] = g0 * bflo(y0.y) + g1 * bflo(y1.y); mo[3] = g0 * bfhi(y0.y) + g1 * bfhi(y1.y);
            v[j] = x + gg * mo; *(f32x4*)(X + (size_t)t * 1024 + c) = v[j]; }
        if (L < 3) { const float* m = MOD + (size_t)((L + 1) * 2 + b) * 6144; norm_store_row(v, args.in[LBASE(L + 1)], m, m + 1024, H + (size_t)t * 1024, lane); }
    }
}

constexpr int N_PHASES = 37;

#ifndef DUP_MASK
#define DUP_MASK 0
#endif
#define PHASE(k) if ((lo <= (k) && (k) < hi) && ((started ? (xcd_barrier(bar), 0) : 0), started = true, true))
#define NREP(g) (1 + ((DUP_MASK >> (g)) & 1))
#define PHASE_G(k, g) PHASE(k) for (int rep_ = 0; rep_ < NREP(g); ++rep_, ((rep_ < NREP(g)) ? (xcd_barrier(bar), 0) : 0))
template <int L> __device__ __forceinline__ void run_layer(const Args& args, LAS unsigned char* lds, const XcdBarrier& bar, bool& started, const int lo, const int hi) {
    const int G = gridDim.x, bid = blockIdx.x;
    unsigned char* ws = uni_ptr(args.ws);
    const float* MOD = (const float*)(ws + WS_MOD);
    bf16* Hb = (bf16*)(ws + WS_ACT + A_H);

        const int pb = (L == 0) ? 1 : (L == 1 ? 10 : (L == 2 ? 21 : 29));
        const float* xsrc = (L == 0) ? args.in[0] : (const float*)args.out;
        const float* gate_m = MOD + (size_t)L * 2 * 6144 + 2048;
        int mb;
        if constexpr (L == 0 || L == 3) {
            int g0 = pb;
            if (L == 0) { PHASE_G(pb, 8) { phase_norm0(args); } g0 = pb + 1; }
            const bf16* Win = (const bf16*)(ws + WS_WMIX + (L == 0 ? WMIX_GM_IN0 : WMIX_GM_IN3)); const bf16* Wout = (const bf16*)(ws + WS_WMIX + (L == 0 ? WMIX_GM_OUT0 : WMIX_GM_OUT3));
            PHASE_G(g0, 1) { pg8::Gemm g{Hb, Win, T, 2048, 1024}; pg8::StaticOrder S; S.init(T, 2048, G, bid);
                EpiGm1 E{(bf16*)(ws + WS_ACT + A_U), (bf16*)(ws + WS_ACT + A_V), (float*)(ws + WS_VSSP)};
                pg8::gemm_phase<EpiGm1, pg8::StaticOrder, true, true>(lds, g, S, E); }
            PHASE_G(g0 + 1, 2) { phase_gm_spatial(args, L, lds); }
            PHASE_G(g0 + 2, (L == 0 ? 1 : 31)) { pg8::Gemm g{(const bf16*)(ws + WS_ACT + A_GATED), Wout, T, 1024, 1024}; pg8::StaticOrder S; S.init(T, 1024, G, bid);
                EpiRes E{xsrc, args.out, gate_m};
                pg8::gemm_phase<EpiRes, pg8::StaticOrder, true, true>(lds, g, S, E); }
            mb = g0 + 3;
        } else if constexpr (L == 1) {
            PHASE_G(pb, 1) { pg8::Gemm g{Hb, (const bf16*)(ws + WS_WMIX + WMIX_DN_IN), T, 3328, 1024}; pg8::StaticOrder S; S.init(T, 3328, G, bid);
                EpiDn1 E{(bf16*)(ws + WS_ACT + A_QKV), (bf16*)(ws + WS_ACT + A_Z), (float*)(ws + WS_BA)};
                pg8::gemm_phase<EpiDn1, pg8::StaticOrder, true, true>(lds, g, S, E); }
            PHASE_G(pb + 1, 3) { phase_dn_prep(args); }
            PHASE_G(pb + 2, 4) { phase_dn_chunk(args, lds); }
            PHASE_G(pb + 3, 5) { phase_dn_scan(args, lds); }
            PHASE_G(pb + 4, 3) { phase_dn_ogate(args); }
            PHASE(pb + 5) { pg8::Gemm g{Hb, (const bf16*)(ws + WS_WMIX + WMIX_DN_OUT), T, 1024, 1024}; pg8::StaticOrder S; S.init(T, 1024, G, bid);
                EpiRes E{xsrc, args.out, gate_m};
                pg8::gemm_phase<EpiRes, pg8::StaticOrder, true, true>(lds, g, S, E); }
            mb = pb + 6;
        } else {
            PHASE_G(pb, 1) { pg8::Gemm g{Hb, (const bf16*)(ws + WS_WMIX + WMIX_SWA_IN), T, 1536, 1024}; pg8::StaticOrder S; S.init(T, 1536, G, bid);
                EpiBf E{(bf16*)(ws + WS_ACT + A_QKV), 1536, 0xffff};
                pg8::gemm_phase<EpiBf, pg8::StaticOrder, true, true>(lds, g, S, E); }
            PHASE_G(pb + 1, 2) { phase_swa_attn(args, lds); }
            PHASE(pb + 2) { pg8::Gemm g{Hb, (const bf16*)(ws + WS_WMIX + WMIX_SWA_OUT), T, 1024, 1024}; pg8::StaticOrder S; S.init(T, 1024, G, bid);
                EpiRes E{xsrc, args.out, gate_m};
                pg8::gemm_phase<EpiRes, pg8::StaticOrder, true, true>(lds, g, S, E); }
            mb = pb + 3;
        }
        PHASE_G(mb, 6) { phase_moe_router(args, L, lds); }
        PHASE_G(mb + 1, 6) { phase_moe_scatter(args, lds); }
        const int* TILEE = (const int*)(ws + WS_TILEE);
        PHASE_G(mb + 2, 7) { const int ntiles = TILEE[0]; pg8::Gemm g{(const bf16*)(ws + WS_ACT + A_XG), (const bf16*)(ws + WS_W + (size_t)L * 96 * MiB), MAXROWS, 1024, 1024};
            MoeOrder S; S.init(TILEE + 16, ntiles, G, bid); EpiMoe1 E{(bf16*)(ws + WS_ACT + A_ACTV)};
            pg8::gemm_phase<EpiMoe1, MoeOrder, true, true>(lds, g, S, E); }
        PHASE_G(mb + 3, 7) { const int ntiles = TILEE[0]; pg8::Gemm g{(const bf16*)(ws + WS_ACT + A_ACTV), (const bf16*)(ws + WS_W + (size_t)L * 96 * MiB + 64 * MiB), MAXROWS, 1024, 512};
            MoeOrder S; S.init(TILEE + 16, ntiles, G, bid); EpiBf E{(bf16*)(ws + WS_ACT + A_Y), 1024, 3};
            pg8::gemm_phase<EpiBf, MoeOrder, true, true>(lds, g, S, E); }
        PHASE(mb + 4) { phase_moe_combine(args, L); }

}
__global__ void __launch_bounds__(NTHR, 2) fwd_kernel(Args args) {
    extern __shared__ __attribute__((aligned(16))) unsigned char lds_raw[];
    LAS unsigned char* lds = (LAS unsigned char*)lds_raw;
    const int tid = threadIdx.x;
    unsigned char* ws = uni_ptr(args.ws);
    for (int u = tid; u < (LDS_BYTES - LDSCTL_OFF) / 4; u += NTHR) ((LAS unsigned*)(lds + LDSCTL_OFF))[u] = 0u;
    __syncthreads();
    volatile LAS unsigned* MISC = (volatile LAS unsigned*)(lds + MISC_OFF);
    XcdBarrier bar = xcd_barrier_post((unsigned*)(ws + WS_CTL) + 4096 + (size_t)args.li * XCD_BAR_WORDS, MISC + 8);
    const int lo = args.ph_lo, hi = args.ph_hi; bool started = false;
    const float* MOD = (const float*)(ws + WS_MOD);
    bf16* Hb = (bf16*)(ws + WS_ACT + A_H);

    PHASE_G(0, 0) { phase_prologue(args, lds); }

    run_layer<0>(args, lds, bar, started, lo, hi);
    run_layer<1>(args, lds, bar, started, lo, hi);
    run_layer<2>(args, lds, bar, started, lo, hi);
    run_layer<3>(args, lds, bar, started, lo, hi);
#undef PHASE
#undef PHASE_G
}

extern "C" void kernel_launch(void* const* d_in, const int* in_sizes, int n_in, void* d_out, int out_size, void* d_ws, size_t ws_size, hipStream_t stream) {
    static int grid = 0;
    if (grid == 0) {
        if (n_in != N_IN || in_sizes[0] != T * D || out_size != T * D || ws_size < WS_END) { fprintf(stderr, "kernel_launch: unexpected shapes (n_in %d, in0 %d, out %d, ws %zu < %zu)\n", n_in, n_in > 0 ? in_sizes[0] : -1, out_size, ws_size, (size_t)WS_END); grid = -1; return; }
        int dev = 0, cus = 0, per_cu = 0;
        if (hipGetDevice(&dev) != hipSuccess || hipDeviceGetAttribute(&cus, hipDeviceAttributeMultiprocessorCount, dev) != hipSuccess) { grid = -1; return; }
        if (hipFuncSetAttribute((const void*)fwd_kernel, hipFuncAttributeMaxDynamicSharedMemorySize, LDS_BYTES) != hipSuccess) { fprintf(stderr, "kernel_launch: hipFuncSetAttribute failed\n"); grid = -1; return; }
        if (hipOccupancyMaxActiveBlocksPerMultiprocessor(&per_cu, (const void*)fwd_kernel, NTHR, LDS_BYTES) != hipSuccess || per_cu < 1) fprintf(stderr, "kernel_launch: occupancy query reports %d\n", per_cu);
        (void)hipGetLastError();
        grid = cus;
    }
    if (grid < 0) return;
    if (hipMemsetAsync((char*)d_ws + WS_CTL, 0, CTL_ZERO_BYTES, stream) != hipSuccess) return;
    Args a{};
    for (int i = 0; i < N_IN; ++i) a.in[i] = (const float*)d_in[i];
    a.out = (float*)d_out; a.ws = (unsigned char*)d_ws; a.pad = 0;
#if MK_LAUNCH_MODE == 1
    a.ph_lo = 0; a.ph_hi = N_PHASES; a.li = 0;
    hipLaunchKernelGGL(fwd_kernel, dim3(grid), dim3(NTHR), LDS_BYTES, stream, a);
#else
    for (int p = 0; p < N_PHASES; ++p) { a.ph_lo = p; a.ph_hi = p + 1; a.li = 0;
        hipLaunchKernelGGL(fwd_kernel, dim3(grid), dim3(NTHR), LDS_BYTES, stream, a); }
#endif
}
```

```cpp
#include <hip/hip_runtime.h>
#include <cstdio>
#include <cstdint>
#ifndef MK_LAUNCH_MODE
#define MK_LAUNCH_MODE 1
#endif
namespace pg8 {
#define PG8_LAS __attribute__((address_space(3)))
typedef unsigned short bf16_t;
typedef short bf16x8 __attribute__((ext_vector_type(8)));
typedef float f32x4 __attribute__((ext_vector_type(4)));
typedef unsigned u32x4 __attribute__((ext_vector_type(4)));
constexpr int BM = 256, BK = 64, HALF = 128, HTB = HALF * BK * 2  , STAGE_BYTES = 8 * HTB, NXCD = 8, WGM = 8;

__host__ __device__ __forceinline__ int lds_byte(int r, int c) { const int st = (r >> 4) * 2 + (c >> 5), rr = r & 15, cc = c & 31, ob = rr * 64 + cc * 2; return st * 1024 + (ob ^ (((ob >> 9) & 1) << 5)); }
__host__ __device__ __forceinline__ void stage_rc(int b, int& R, int& C) { const int st = b / 1024, sb = b % 1024, swz = sb ^ (((sb >> 9) & 1) << 5); R = (st >> 1) * 16 + swz / 64; C = (st & 1) * 32 + (swz % 64) / 2; }
__host__ __device__ __forceinline__ int perm32(int rho) { const int n = rho >> 4, i = rho & 15; return 8 * (i >> 2) + 4 * n + (i & 3); }

struct Unit { int pm, pn; };
struct Gemm { const bf16_t* A; const bf16_t* Bt; int M, N, K; };

struct StaticOrder {
    int nM, nN, nwg, G, c;
    __host__ __device__ void init(int M, int N, int G_, int c_) { nM = M / BM; nN = N / BM; nwg = nM * nN; G = G_; c = c_; }
    __host__ __device__ bool next(int i, Unit& u) const {
        const long L = (long)i * G + c; if (L >= nwg) return false;
        int wgid = (int)L; { const int q = nwg / NXCD, r = nwg % NXCD, xcd = wgid % NXCD, off = wgid / NXCD; wgid = (xcd < r ? xcd * (q + 1) : r * (q + 1) + (xcd - r) * q) + off; }
        const int nig = WGM * nN, gid = wgid / nig, fm = gid * WGM, gsz = (nM - fm) < WGM ? (nM - fm) : WGM;
        u.pm = fm + ((wgid % nig) % gsz); u.pn = (wgid % nig) / gsz; return true;
    }
    __device__ __forceinline__ void a_ready(const Unit&) const {}
    __device__ __forceinline__ void done(const Unit&) const {}
};
typedef float f32x2_ __attribute__((ext_vector_type(2))); typedef __bf16 bf16x2_ __attribute__((ext_vector_type(2)));
__device__ __forceinline__ unsigned cvt_pk_bf16(float lo, float hi) { const f32x2_ v = {lo, hi}; return __builtin_bit_cast(unsigned, __builtin_convertvector(v, bf16x2_)); }
typedef float f32x2 __attribute__((ext_vector_type(2)));
template <class Epi, class Sched, bool ALIGN_EPI = false, bool SP2 = false>
__device__ __forceinline__ void gemm_phase(PG8_LAS unsigned char* lds, const Gemm g, const Sched& S, const Epi& E) {
    const int tid = threadIdx.x, wid = __builtin_amdgcn_readfirstlane(tid >> 6), lane = tid & 63, wr = wid >> 2, wc = wid & 3, fr = lane & 15, fq = lane >> 4;
    const int K = g.K, nt = K / BK;
    unsigned voffA[2], voffB[2];
#pragma unroll
    for (int i = 0; i < 2; ++i) { int R, C; stage_rc(tid * 16 + i * 8192, R, C); const int Rb = Epi::PERM ? ((R & ~31) + perm32(R & 31)) : R;
        voffA[i] = (unsigned)(R * K + C) * 2u; voffB[i] = (unsigned)(Rb * K + C) * 2u; }
    const size_t kstep = (size_t)(BK * 2);
    const size_t hstep = (size_t)HALF * K * 2;
    const size_t tstep = 2 * hstep;
    const unsigned ldsw = (unsigned)wid * 1024u;
    const int aoff = lds_byte(wr * 64 + fr, fq * 8), boff = lds_byte(wc * 32 + fr, fq * 8);
#define PG8_SA(b, h) (((b) * 2 + (h)) * HTB)
#define PG8_SB(b, h) ((4 + (b) * 2 + (h)) * HTB)
#define PG8_STAGE(bufoff, gbase, voff) do { _Pragma("unroll") for (int _i = 0; _i < 2; ++_i) \
        __builtin_amdgcn_global_load_lds((const unsigned*)((const char*)(gbase) + (voff)[_i]), (PG8_LAS unsigned*)(lds + (bufoff) + ldsw + _i * 8192), 16, 0, 0); } while (0)
#define PG8_LDA(dst, b, h) do { _Pragma("unroll") for (int m = 0; m < 4; ++m) _Pragma("unroll") for (int k = 0; k < 2; ++k) dst[m][k] = *(const PG8_LAS bf16x8*)(lds + PG8_SA(b, h) + aoff + m * 2048 + k * 1024); } while (0)
#define PG8_LDB(dst, b, h) do { _Pragma("unroll") for (int n = 0; n < 2; ++n) _Pragma("unroll") for (int k = 0; k < 2; ++k) dst[n][k] = *(const PG8_LAS bf16x8*)(lds + PG8_SB(b, h) + boff + n * 2048 + k * 1024); } while (0)
#define PG8_MMA(ai, bj, At, Bt) do { __builtin_amdgcn_s_setprio(1); _Pragma("unroll") for (int m = 0; m < 4; ++m) _Pragma("unroll") for (int n = 0; n < 2; ++n) _Pragma("unroll") for (int k = 0; k < 2; ++k) \
        acc[ai][bj][m][n] = __builtin_amdgcn_mfma_f32_16x16x32_bf16(Bt[n][k], At[m][k], acc[ai][bj][m][n], 0, 0, 0); __builtin_amdgcn_s_setprio(0); } while (0)
#define PG8_WAIT_V(n) asm volatile("s_waitcnt vmcnt(" #n ")" ::: "memory")
#define PG8_WAIT_L(n) asm volatile("s_waitcnt lgkmcnt(" #n ")" ::: "memory")
#define PG8_BAR __builtin_amdgcn_s_barrier()
#define PG8_SCHED __builtin_amdgcn_sched_barrier(0)
    Unit cur, nxt; int ui = 0;
    if (!S.next(0, cur)) return;
    f32x4 acc[2][2][4][2];
#pragma unroll
    for (int a = 0; a < 2; ++a)
#pragma unroll
        for (int b = 0; b < 2; ++b)
#pragma unroll
            for (int m = 0; m < 4; ++m)
#pragma unroll
                for (int n = 0; n < 2; ++n) acc[a][b][m][n] = (f32x4){0.f, 0.f, 0.f, 0.f};
    bf16x8 At[4][2], B0[2][2], B1[2][2];
    const char* cA = (const char*)g.A + (size_t)cur.pm * tstep; const char* cB = (const char*)g.Bt + (size_t)cur.pn * tstep;
    S.a_ready(cur);
    if constexpr (SP2) {
        PG8_STAGE(PG8_SB(0, 0), cB, voffB); PG8_STAGE(PG8_SB(0, 1), cB + hstep, voffB); PG8_STAGE(PG8_SA(0, 0), cA, voffA); PG8_STAGE(PG8_SA(0, 1), cA + hstep, voffA);
        if (wr == 1) PG8_BAR;
        PG8_WAIT_V(2); PG8_BAR;
        PG8_STAGE(PG8_SB(1, 0), cB + kstep, voffB); PG8_STAGE(PG8_SA(1, 0), cA + kstep, voffA); PG8_STAGE(PG8_SB(1, 1), cB + hstep + kstep, voffB);
        PG8_WAIT_V(6); PG8_BAR;
    } else {
        PG8_STAGE(PG8_SB(0, 0), cB, voffB); PG8_STAGE(PG8_SA(0, 0), cA, voffA); PG8_STAGE(PG8_SB(0, 1), cB + hstep, voffB); PG8_STAGE(PG8_SA(0, 1), cA + hstep, voffA);
        if (wr == 1) PG8_BAR;
        PG8_WAIT_V(4); PG8_BAR;
        PG8_STAGE(PG8_SB(1, 0), cB + kstep, voffB); PG8_STAGE(PG8_SA(1, 0), cA + kstep, voffA); PG8_STAGE(PG8_SB(1, 1), cB + hstep + kstep, voffB);
        PG8_WAIT_V(6); PG8_BAR;
    }
    for (;;) {
        const bool has_next = S.next(ui + 1, nxt);
        const char* nA = has_next ? (const char*)g.A + (size_t)nxt.pm * tstep : cA; const char* nB = has_next ? (const char*)g.Bt + (size_t)nxt.pn * tstep : cB;
        for (int t = 0; t < nt; t += 2) {
            const bool last = (t == nt - 2);
            const char* a1 = cA + (size_t)(t + 1) * kstep;
            const char* a2 = last ? nA : cA + (size_t)(t + 2) * kstep; const char* b2 = last ? nB : cB + (size_t)(t + 2) * kstep;
            const char* a3 = a2 + kstep; const char* b3 = b2 + kstep;
            if (last && has_next) S.a_ready(nxt);
            if constexpr (SP2) {
            PG8_LDB(B0, 0, 0); PG8_LDB(B1, 0, 1); PG8_SCHED; PG8_LDA(At, 0, 0); PG8_STAGE(PG8_SA(1, 1), a1 + hstep, voffA);
            PG8_WAIT_V(8); PG8_WAIT_L(0); PG8_BAR; PG8_MMA(0, 0, At, B0); PG8_MMA(0, 1, At, B1); PG8_BAR; PG8_SCHED;
            PG8_LDA(At, 0, 1); PG8_STAGE(PG8_SB(0, 0), b2, voffB); PG8_STAGE(PG8_SB(0, 1), b2 + hstep, voffB); PG8_STAGE(PG8_SA(0, 0), a2, voffA);
            PG8_WAIT_V(8); PG8_WAIT_L(0); PG8_BAR; PG8_MMA(1, 0, At, B0); PG8_MMA(1, 1, At, B1); PG8_BAR; PG8_SCHED;
            PG8_LDB(B0, 1, 0); PG8_LDB(B1, 1, 1); PG8_SCHED; PG8_LDA(At, 1, 0); PG8_STAGE(PG8_SA(0, 1), a2 + hstep, voffA);
            PG8_WAIT_V(8); PG8_WAIT_L(0); PG8_BAR; PG8_MMA(0, 0, At, B0); PG8_MMA(0, 1, At, B1); PG8_BAR; PG8_SCHED;
            PG8_LDA(At, 1, 1); PG8_STAGE(PG8_SB(1, 0), b3, voffB); PG8_STAGE(PG8_SB(1, 1), b3 + hstep, voffB); PG8_STAGE(PG8_SA(1, 0), a3, voffA);
            PG8_WAIT_V(8); PG8_WAIT_L(0); PG8_BAR; PG8_MMA(1, 0, At, B0); PG8_MMA(1, 1, At, B1); PG8_BAR; PG8_SCHED;
            } else {
            PG8_LDB(B0, 0, 0); PG8_SCHED; PG8_LDA(At, 0, 0); PG8_STAGE(PG8_SA(1, 1), a1 + hstep, voffA);
            PG8_WAIT_L(8); PG8_BAR; PG8_WAIT_L(0); PG8_MMA(0, 0, At, B0); PG8_BAR; PG8_SCHED;
            PG8_LDB(B1, 0, 1); PG8_STAGE(PG8_SB(0, 0), b2, voffB);
            PG8_BAR; PG8_WAIT_L(0); PG8_MMA(0, 1, At, B1); PG8_BAR;
            PG8_LDA(At, 0, 1); PG8_STAGE(PG8_SA(0, 0), a2, voffA);
            PG8_BAR; PG8_WAIT_L(0); PG8_MMA(1, 0, At, B0); PG8_BAR; PG8_SCHED;
            PG8_STAGE(PG8_SB(0, 1), b2 + hstep, voffB);
            PG8_WAIT_V(6); PG8_BAR; PG8_MMA(1, 1, At, B1); PG8_BAR;
            PG8_LDB(B0, 1, 0); PG8_SCHED; PG8_LDA(At, 1, 0); PG8_STAGE(PG8_SA(0, 1), a2 + hstep, voffA);
            PG8_WAIT_L(8); PG8_BAR; PG8_WAIT_L(0); PG8_MMA(0, 0, At, B0); PG8_BAR; PG8_SCHED;
            PG8_LDB(B1, 1, 1); PG8_STAGE(PG8_SB(1, 0), b3, voffB);
            PG8_BAR; PG8_WAIT_L(0); PG8_MMA(0, 1, At, B1); PG8_BAR;
            PG8_LDA(At, 1, 1); PG8_STAGE(PG8_SA(1, 0), a3, voffA);
            PG8_BAR; PG8_WAIT_L(0); PG8_MMA(1, 0, At, B0); PG8_BAR; PG8_SCHED;
            PG8_STAGE(PG8_SB(1, 1), b3 + hstep, voffB);
            PG8_WAIT_V(6); PG8_BAR; PG8_MMA(1, 1, At, B1); PG8_BAR;
            }
        }
        if constexpr (ALIGN_EPI) { if (wr == 0) PG8_BAR; }
        if constexpr (!Epi::AFTER_DRAIN) { E(acc, cur, wr, wc, fr, fq); S.done(cur); }
        if (!has_next) break;
#pragma unroll
        for (int a = 0; a < 2; ++a)
#pragma unroll
            for (int b = 0; b < 2; ++b)
#pragma unroll
                for (int m = 0; m < 4; ++m)
#pragma unroll
                    for (int n = 0; n < 2; ++n) acc[a][b][m][n] = (f32x4){0.f, 0.f, 0.f, 0.f};
        cur = nxt; cA = nA; cB = nB; ++ui;
        if constexpr (ALIGN_EPI) { if (wr == 1) PG8_BAR; }
    }
    PG8_WAIT_V(0);
    if constexpr (!ALIGN_EPI) { if (wr == 0) PG8_BAR; }
    PG8_BAR;
    if constexpr (Epi::AFTER_DRAIN) { E.fused(acc, cur, wr, wc, fr, fq, lds, wid, lane); S.done(cur); }
#undef PG8_SA
#undef PG8_SB
#undef PG8_STAGE
#undef PG8_LDA
#undef PG8_LDB
#undef PG8_MMA
#undef PG8_WAIT_V
#undef PG8_WAIT_L
#undef PG8_BAR
#undef PG8_SCHED
}
}

constexpr int NB = 2, SEQ = 16384, T = NB * SEQ, D = 1024;
constexpr float EPS = 1e-6f;
constexpr int NWAVES = 8, NTHR = 512;
constexpr int N_IN = 55;
__host__ __device__ constexpr int LBASE(int L) { return L == 0 ? 2 : (L == 1 ? 15 : (L == 2 ? 29 : 42)); }
__host__ __device__ constexpr int NMIX(int L) { return L == 1 ? 6 : 5; }

constexpr size_t MiB = 1u << 20;
constexpr size_t WS_CTL = 0, CTL_ZERO_BYTES = 1 * MiB;
constexpr size_t WS_MOD = 1 * MiB;
constexpr size_t WS_CNT = WS_MOD + 256 * 1024;
constexpr size_t WS_TILEE = WS_CNT + 64 * 1024;
constexpr size_t WS_EID = 2 * MiB;
constexpr size_t WS_GATE = WS_EID + 256 * 1024;
constexpr size_t WS_SLOT = WS_GATE + 256 * 1024;
constexpr size_t WS_VSSP = 3 * MiB;
constexpr size_t WS_BA = 5 * MiB;
constexpr size_t WS_DNB = 7 * MiB;
constexpr size_t WS_RTR = 9 * MiB;
constexpr size_t WS_W = 16 * MiB;
constexpr size_t WS_WMIX = WS_W + 384 * MiB;
constexpr size_t WMIX_GM_IN0 = 0, WMIX_GM_OUT0 = 4 * MiB, WMIX_DN_IN = 6 * MiB, WMIX_DN_OUT = 13 * MiB, WMIX_SWA_IN = 15 * MiB, WMIX_SWA_OUT = 18 * MiB, WMIX_GM_IN3 = 20 * MiB, WMIX_GM_OUT3 = 24 * MiB;
constexpr size_t WS_ACT = 432 * MiB;
constexpr size_t A_H = 0;
constexpr size_t A_U = 64 * MiB, A_V = 128 * MiB, A_GATED = 192 * MiB;
constexpr size_t A_QKV = 64 * MiB, A_Z = 192 * MiB, A_QN = 256 * MiB, A_KN = 288 * MiB, A_VV = 320 * MiB, A_FA = 384 * MiB, A_FB = 484 * MiB, A_FU = 64 * MiB, A_O = 128 * MiB;
constexpr size_t A_XG = 64 * MiB, A_ACTV = 208 * MiB, A_Y = 280 * MiB;
constexpr size_t WS_END = WS_ACT + 548 * MiB;
constexpr int MAXROWS = 73728;

constexpr int RING_BYTES = 131072;
constexpr int LDSCTL_OFF = RING_BYTES, MISC_OFF = LDSCTL_OFF + 320;
constexpr int LDS_BYTES = 147456;

#define LAS __attribute__((address_space(3)))
typedef unsigned short bf16;
typedef unsigned v4u __attribute__((ext_vector_type(4)));
typedef unsigned v2u __attribute__((ext_vector_type(2)));
typedef float f32x4 __attribute__((ext_vector_type(4)));
typedef short bf16x8 __attribute__((ext_vector_type(8)));
typedef short bf16x4 __attribute__((ext_vector_type(4)));
#define LDS_WAIT() asm volatile("s_waitcnt lgkmcnt(0)" ::: "memory")
#define VM_WAIT() asm volatile("s_waitcnt vmcnt(0)" ::: "memory")
__device__ __forceinline__ unsigned pk2(float lo, float hi) { return pg8::cvt_pk_bf16(lo, hi); }
__device__ __forceinline__ float bflo(unsigned w) { return __uint_as_float(w << 16); }
__device__ __forceinline__ float bfhi(unsigned w) { return __uint_as_float(w & 0xffff0000u); }
__device__ __forceinline__ float bf1(unsigned short b) { return __uint_as_float(((unsigned)b) << 16); }
__device__ __forceinline__ float wave_sum(float v) {
#pragma unroll
    for (int o = 1; o < 64; o <<= 1) v += __shfl_xor(v, o);
    return v;
}
__device__ __forceinline__ float fast_exp(float x) { return __builtin_amdgcn_exp2f(x * 1.44269504089f); }
__device__ __forceinline__ float sigmoidf_(float x) { return __builtin_amdgcn_rcpf(1.0f + fast_exp(-x)); }
__device__ __forceinline__ float siluf_(float x) { return x * sigmoidf_(x); }
__device__ __forceinline__ float gelu_tanh(float x) { const float y = 1.5957691216057308f * (x + 0.044715f * x * x * x); return x * __builtin_amdgcn_rcpf(1.0f + fast_exp(-y)); }

#define RLX_AGENT __ATOMIC_RELAXED, __HIP_MEMORY_SCOPE_AGENT
__device__ __forceinline__ unsigned char* uni_ptr(unsigned char* p) { const unsigned long long w = (unsigned long long)p; const unsigned lo = __builtin_amdgcn_readfirstlane((unsigned)w), hi = __builtin_amdgcn_readfirstlane((unsigned)(w >> 32)); return (unsigned char*)(__attribute__((address_space(1))) unsigned char*)(((unsigned long long)hi << 32) | lo); }
#define XB_TMO      128
#define XB_XCNT(j)  (256  + 64 * (j))
#define XB_XSUB(j)  (1280 + 64 * (j))
#define XB_XGEN(j)  (2304 + 64 * (j))
#define XB_TOP      3328
#define XB_TOPGEN   3392
#define XCD_BAR_WORDS 3456
#define XB_SPIN_CAP (1u << 18)

__device__ __forceinline__ unsigned xb_ld(unsigned* p)              { return __hip_atomic_load(p, __ATOMIC_RELAXED, __HIP_MEMORY_SCOPE_AGENT); }
__device__ __forceinline__ unsigned xb_add(unsigned* p, unsigned v) { return __hip_atomic_fetch_add(p, v, __ATOMIC_RELAXED, __HIP_MEMORY_SCOPE_AGENT); }
__device__ __forceinline__ unsigned xb_xcc_id() { return (unsigned)__builtin_amdgcn_s_getreg((3 << 11) | 20) & 0xFu; }
#define XB_SPIN(cond, bar) do { unsigned _sp = 0; while (cond) { __builtin_amdgcn_s_sleep(1); \
    if ((++_sp & 255u) == 0u) { if (xb_ld(&(bar)[XB_TMO])) break; if (_sp > XB_SPIN_CAP) { atomicAdd(&(bar)[XB_TMO], 1u); break; } } } } while (0)

struct XcdBarrier {
    unsigned* bar; unsigned x;
    volatile LAS unsigned* st;
};

__device__ __forceinline__ XcdBarrier xcd_barrier_post(unsigned* bar, volatile LAS unsigned* st) {
    XcdBarrier b; b.bar = bar; b.x = xb_xcc_id(); b.st = st;
    if (threadIdx.x == 0) (void)xb_add(&bar[XB_XCNT(b.x)], 1u);
    return b;
}
__device__ __forceinline__ void xcd_barrier_complete(unsigned* bar, unsigned x, unsigned& nloc, unsigned& nx) {
    const unsigned G = gridDim.x * gridDim.y * gridDim.z;
    unsigned sum, cnt, mine, sp = 0u;
    for (;;) {
        sum = 0u; cnt = 0u; mine = 0u;
#pragma unroll
        for (unsigned j = 0; j < 16; ++j) { const unsigned c = xb_ld(&bar[XB_XCNT(j)]); sum += c; cnt += (c > 0u) ? 1u : 0u; mine = (j == x) ? c : mine; }
        if (sum == G) break;
        __builtin_amdgcn_s_sleep(1);
        if ((++sp & 255u) == 0u) { if (xb_ld(&bar[XB_TMO])) break; if (sp > XB_SPIN_CAP) { atomicAdd(&bar[XB_TMO], 1u); break; } }
    }
    nloc = mine > 0u ? mine : 1u; nx = cnt > 0u ? cnt : 1u;
}

__device__ __forceinline__ void xcd_barrier(const XcdBarrier& b) {
    asm volatile("s_waitcnt vmcnt(0)" ::: "memory");
    __syncthreads();
    if (threadIdx.x == 0) {
        unsigned* bar = b.bar;
        __builtin_amdgcn_s_waitcnt(0);
        unsigned nloc = b.st[0], nx = b.st[1];
        if (nloc == 0u) { xcd_barrier_complete(bar, b.x, nloc, nx); b.st[0] = nloc; b.st[1] = nx; }
        const unsigned old = xb_add(&bar[XB_XSUB(b.x)], 1u);
        const unsigned gen = old / nloc;
        if (old + 1u == (gen + 1u) * nloc) {
            __builtin_amdgcn_fence(__ATOMIC_RELEASE, "agent");
            asm volatile("s_waitcnt vmcnt(0)" ::: "memory");
            const unsigned og = xb_add(&bar[XB_TOP], 1u);
            const unsigned tg = og / nx;
            if (og + 1u == (tg + 1u) * nx) xb_add(&bar[XB_TOPGEN], 1u);
            else XB_SPIN(xb_ld(&bar[XB_TOPGEN]) == tg, bar);
            __builtin_amdgcn_fence(__ATOMIC_ACQUIRE, "agent");
            xb_add(&bar[XB_XGEN(b.x)], 1u);
            asm volatile("s_waitcnt vmcnt(0)" ::: "memory");
        } else {
            XB_SPIN(xb_ld(&bar[XB_XGEN(b.x)]) == gen, bar);
            __builtin_amdgcn_fence(__ATOMIC_ACQUIRE, "agent");
            asm volatile("s_waitcnt vmcnt(0)" ::: "memory");
        }
    }
    __syncthreads();
}

typedef const pg8::f32x4 (&AccRef)[2][2][4][2];

struct EpiGm1 {
    static constexpr bool PERM = true, AFTER_DRAIN = false;
    bf16* U; bf16* V; float* vssp;
    __device__ __forceinline__ void operator()(AccRef acc, const pg8::Unit& u, int wr, int wc, int fr, int fq) const {
        const int row0 = u.pm * 256 + wr * 64 + fr; const bool isV = u.pn >= 4; const int col0 = (u.pn & 3) * 256 + wc * 32 + 8 * fq;
        bf16* base = isV ? V : U;
#pragma unroll
        for (int ai = 0; ai < 2; ++ai)
#pragma unroll
            for (int m = 0; m < 4; ++m) { const int row = row0 + ai * 128 + m * 16; bf16* rowp = base + (size_t)row * 1024 + col0; float ss = 0.f;
#pragma unroll
                for (int bj = 0; bj < 2; ++bj) { f32x4 v0 = acc[ai][bj][m][0], v1 = acc[ai][bj][m][1];
#pragma unroll
                    for (int j = 0; j < 4; ++j) { v0[j] = gelu_tanh(v0[j]); v1[j] = gelu_tanh(v1[j]); ss += v0[j] * v0[j] + v1[j] * v1[j]; }
                    v4u w; w.x = pk2(v0[0], v0[1]); w.y = pk2(v0[2], v0[3]); w.z = pk2(v1[0], v1[1]); w.w = pk2(v1[2], v1[3]);
                    *(v4u*)(rowp + bj * 128) = w; }
                if (isV) { ss += __shfl_xor(ss, 16); ss += __shfl_xor(ss, 32); if (fq == 0) vssp[(size_t)row * 16 + (u.pn - 4) * 4 + wc] = ss; } }
    }
};
struct EpiRes {
    static constexpr bool PERM = false, AFTER_DRAIN = false;
    const float* src; float* dst; const float* gate;
    __device__ __forceinline__ void operator()(AccRef acc, const pg8::Unit& u, int wr, int wc, int fr, int fq) const {
        const int row0 = u.pm * 256 + wr * 64 + fr, col0 = u.pn * 256 + wc * 32 + 4 * fq; const int b = (u.pm * 256) / SEQ;
        f32x4 gv[2][2];
#pragma unroll
        for (int bj = 0; bj < 2; ++bj)
#pragma unroll
            for (int n = 0; n < 2; ++n) gv[bj][n] = *(const f32x4*)(gate + (size_t)b * 6144 + col0 + bj * 128 + n * 16);
#pragma unroll
        for (int ai = 0; ai < 2; ++ai)
#pragma unroll
            for (int m = 0; m < 4; ++m) { const size_t off = (size_t)(row0 + ai * 128 + m * 16) * 1024 + col0;
#pragma unroll
                for (int bj = 0; bj < 2; ++bj)
#pragma unroll
                    for (int n = 0; n < 2; ++n) { const f32x4 xs = *(const f32x4*)(src + off + bj * 128 + n * 16); *(f32x4*)(dst + off + bj * 128 + n * 16) = xs + gv[bj][n] * acc[ai][bj][m][n]; } }
    }
};
struct EpiBf {
    static constexpr bool PERM = true, AFTER_DRAIN = false;
    bf16* O; int ldc; int nmask;
    __device__ __forceinline__ void operator()(AccRef acc, const pg8::Unit& u, int wr, int wc, int fr, int fq) const {
        const int row0 = u.pm * 256 + wr * 64 + fr, col0 = (u.pn & nmask) * 256 + wc * 32 + 8 * fq;
#pragma unroll
        for (int ai = 0; ai < 2; ++ai)
#pragma unroll
            for (int m = 0; m < 4; ++m) { bf16* rowp = O + (size_t)(row0 + ai * 128 + m * 16) * ldc + col0;
#pragma unroll
                for (int bj = 0; bj < 2; ++bj) { const f32x4 v0 = acc[ai][bj][m][0], v1 = acc[ai][bj][m][1];
                    v4u w; w.x = pk2(v0[0], v0[1]); w.y = pk2(v0[2], v0[3]); w.z = pk2(v1[0], v1[1]); w.w = pk2(v1[2], v1[3]);
                    *(v4u*)(rowp + bj * 128) = w; } }
    }
};
struct EpiDn1 {
    static constexpr bool PERM = true, AFTER_DRAIN = false;
    bf16* QKV; bf16* Z; float* BA;
    __device__ __forceinline__ void operator()(AccRef acc, const pg8::Unit& u, int wr, int wc, int fr, int fq) const {
        const int row0 = u.pm * 256 + wr * 64 + fr;
        if (u.pn < 12) {
            bf16* base = u.pn < 8 ? QKV : Z; const int ldc = u.pn < 8 ? 2048 : 1024; const int col0 = (u.pn < 8 ? u.pn : u.pn - 8) * 256 + wc * 32 + 8 * fq;
#pragma unroll
            for (int ai = 0; ai < 2; ++ai)
#pragma unroll
                for (int m = 0; m < 4; ++m) { bf16* rowp = base + (size_t)(row0 + ai * 128 + m * 16) * ldc + col0;
#pragma unroll
                    for (int bj = 0; bj < 2; ++bj) { const f32x4 v0 = acc[ai][bj][m][0], v1 = acc[ai][bj][m][1];
                        v4u w; w.x = pk2(v0[0], v0[1]); w.y = pk2(v0[2], v0[3]); w.z = pk2(v1[0], v1[1]); w.w = pk2(v1[2], v1[3]);
                        *(v4u*)(rowp + bj * 128) = w; } }
        } else if (wc == 0 && fq < 2) {
#pragma unroll
            for (int ai = 0; ai < 2; ++ai)
#pragma unroll
                for (int m = 0; m < 4; ++m) { float* rowp = BA + (size_t)(row0 + ai * 128 + m * 16) * 16 + 8 * fq;
                    *(f32x4*)(rowp) = acc[ai][0][m][0]; *(f32x4*)(rowp + 4) = acc[ai][0][m][1]; }
        }
    }
};
struct EpiMoe1 {
    static constexpr bool PERM = true, AFTER_DRAIN = false;
    bf16* O;
    __device__ __forceinline__ void operator()(AccRef acc, const pg8::Unit& u, int wr, int wc, int fr, int fq) const {
        const int row0 = u.pm * 256 + wr * 64 + fr, col0 = (u.pn & 3) * 128 + wc * 32 + 8 * fq;
#pragma unroll
        for (int ai = 0; ai < 2; ++ai)
#pragma unroll
            for (int m = 0; m < 4; ++m) { bf16* rowp = O + (size_t)(row0 + ai * 128 + m * 16) * 512 + col0; float r[8];
#pragma unroll
                for (int n = 0; n < 2; ++n)
#pragma unroll
                    for (int j = 0; j < 4; ++j) { const float a = acc[ai][0][m][n][j], g = acc[ai][1][m][n][j]; r[4 * n + j] = siluf_(a) * g; }
                v4u w; w.x = pk2(r[0], r[1]); w.y = pk2(r[2], r[3]); w.z = pk2(r[4], r[5]); w.w = pk2(r[6], r[7]);
                *(v4u*)rowp = w; }
    }
};
struct MoeOrder {
    const int* tile_e; int total, G, c;
    __device__ __forceinline__ void init(const int* te, int ntiles, int G_, int c_) { tile_e = te; total = ntiles * 4; G = G_; c = c_; }
    __device__ __forceinline__ bool next(int i, pg8::Unit& u) const {
        const long Lx = (long)i * G + c; if (Lx >= total) return false;
        const int w0 = (int)Lx, q = total / 8, r = total % 8, xcd = w0 % 8, off = w0 / 8;
        const int wgid = (xcd < r ? xcd * (q + 1) : r * (q + 1) + (xcd - r) * q) + off;
        const int rt = wgid >> 2; u.pm = rt; u.pn = tile_e[rt] * 4 + (wgid & 3); return true;
    }
    __device__ __forceinline__ void a_ready(const pg8::Unit&) const {}
    __device__ __forceinline__ void done(const pg8::Unit&) const {}
};

struct Args { const float* in[N_IN]; float* out; unsigned char* ws; int ph_lo, ph_hi, li, pad; };

__device__ __forceinline__ void tr_item(const float* __restrict__ W, int ldn, int k0, int n0, bf16* __restrict__ WT, int Kd, int drow0, LAS float* scr, int lane) {
#pragma unroll 8
    for (int i = 0; i < 32; ++i) { const int kk = 2 * i + (lane >> 5); scr[kk * 33 + (lane & 31)] = W[(size_t)(k0 + kk) * ldn + n0 + (lane & 31)]; }
    LDS_WAIT(); asm volatile("" ::: "memory");
    const int c = lane & 7;
#pragma unroll
    for (int j = 0; j < 4; ++j) { const int n = (lane >> 3) + 8 * j; const LAS float* s = scr + (8 * c) * 33 + n;
        v4u o; o.x = pk2(s[0 * 33], s[1 * 33]); o.y = pk2(s[2 * 33], s[3 * 33]); o.z = pk2(s[4 * 33], s[5 * 33]); o.w = pk2(s[6 * 33], s[7 * 33]);
        *(v4u*)(WT + (size_t)(drow0 + n) * Kd + k0 + 8 * c) = o; }
    LDS_WAIT(); asm volatile("" ::: "memory");
}

constexpr int CV_PER_L = 24576, CV_N_EXP = 4 * CV_PER_L, CV_MIX_L01 = 3584, CV_N_MIXI = 1536 + 2048 + 1280 + 1536;
struct CvItem { const float* src; bf16* dst; int ldn, Kd; };
__device__ __forceinline__ CvItem cv_decode(const Args& args, unsigned char* ws, int it) {
    CvItem c; const float* src; bf16* dst; int ldn, k0, n0, Kd, drow0;
    constexpr int PER_L = CV_PER_L, N_EXP = CV_N_EXP;
    if (it < N_EXP) {
        const int L = it / PER_L; int r = it % PER_L; const int ib = LBASE(L) + 4 + NMIX(L);
        if (r < 16384) { const int e = r >> 9, rr = r & 511; k0 = (rr >> 5) * 64; n0 = (rr & 31) * 32; ldn = 1024; Kd = 1024;
            src = args.in[ib + 2] + (size_t)e * 1048576; dst = (bf16*)(ws + WS_W + (size_t)L * 96 * MiB) + (size_t)e * 1048576;
            drow0 = (n0 < 512) ? ((n0 >> 7) * 256 + (n0 & 127)) : ((((n0 - 512) >> 7) * 256) + 128 + ((n0 - 512) & 127)); }
        else { r -= 16384; const int e = r >> 8, rr = r & 255; k0 = (rr >> 5) * 64; n0 = (rr & 31) * 32; ldn = 1024; Kd = 512;
            src = args.in[ib + 3] + (size_t)e * 524288; dst = (bf16*)(ws + WS_W + (size_t)L * 96 * MiB + 64 * MiB) + (size_t)e * 524288; drow0 = n0; }
    } else {
        int r = it - N_EXP; int idx, nblk; size_t woff;
        if (r < 1024) { idx = 6; ldn = 2048; nblk = 64; woff = WMIX_GM_IN0; }
        else if ((r -= 1024) < 512) { idx = 10; ldn = 1024; nblk = 32; woff = WMIX_GM_OUT0; }
        else if ((r -= 512) < 1536) { idx = 19; ldn = 3088; nblk = 96; woff = WMIX_DN_IN; }
        else if ((r -= 1536) < 512) { idx = 24; ldn = 1024; nblk = 32; woff = WMIX_DN_OUT; }
        else if ((r -= 512) < 768) { idx = 33; ldn = 1536; nblk = 48; woff = WMIX_SWA_IN; }
        else if ((r -= 768) < 512) { idx = 37; ldn = 1024; nblk = 32; woff = WMIX_SWA_OUT; }
        else if ((r -= 512) < 1024) { idx = 46; ldn = 2048; nblk = 64; woff = WMIX_GM_IN3; }
        else { r -= 1024; idx = 50; ldn = 1024; nblk = 32; woff = WMIX_GM_OUT3; }
        src = args.in[idx]; dst = (bf16*)(ws + WS_WMIX + woff); k0 = (r / nblk) * 64; n0 = (r % nblk) * 32; Kd = 1024; drow0 = n0;
    }
    c.src = src + (size_t)k0 * ldn + n0; c.dst = dst + (size_t)drow0 * Kd + k0; c.ldn = ldn; c.Kd = Kd; return c;
}
__device__ __forceinline__ void cv_load(const CvItem& c, f32x4 (&v)[8], int lane) {
    const float* p = c.src + (size_t)(lane >> 3) * c.ldn + 4 * (lane & 7);
#pragma unroll
    for (int i = 0; i < 8; ++i) v[i] = *(const f32x4*)(p + (size_t)(8 * i) * c.ldn);
}
__device__ __forceinline__ void cv_store(const CvItem& c, const f32x4 (&v)[8], LAS float* scr, int lane) {
    const int kr = lane >> 3, n4 = 4 * (lane & 7);
#pragma unroll
    for (int i = 0; i < 8; ++i) { LAS float* q = scr + (kr + 8 * i) * 33 + n4; q[0] = v[i][0]; q[1] = v[i][1]; q[2] = v[i][2]; q[3] = v[i][3]; }
    LDS_WAIT(); asm volatile("" ::: "memory");
    const int ck = lane & 7;
#pragma unroll
    for (int j = 0; j < 4; ++j) { const int n = (lane >> 3) + 8 * j; const LAS float* s = scr + (8 * ck) * 33 + n;
        v4u o; o.x = pk2(s[0 * 33], s[1 * 33]); o.y = pk2(s[2 * 33], s[3 * 33]); o.z = pk2(s[4 * 33], s[5 * 33]); o.w = pk2(s[6 * 33], s[7 * 33]);
        *(v4u*)(c.dst + (size_t)n * c.Kd + 8 * ck) = o; }
    LDS_WAIT(); asm volatile("" ::: "memory");
}
__device__ __forceinline__ void convert_weights(const Args& args, LAS unsigned char* lds, int it_lo, int it_hi, int gw, int NGW) {
    int tid_ = threadIdx.x; asm volatile("" : "+v"(tid_)); const int lane = tid_ & 63, wave = __builtin_amdgcn_readfirstlane(tid_ >> 6);
    unsigned char* ws = uni_ptr(args.ws);
    LAS float* scr = (LAS float*)(lds + wave * 8448);
    for (int it = it_lo + gw; it < it_hi; it += 2 * NGW) {
        const int it2 = it + NGW; const bool two = it2 < it_hi;
        const CvItem c0 = cv_decode(args, ws, it), c1 = cv_decode(args, ws, two ? it2 : it);
        f32x4 v0[8], v1[8];
        cv_load(c0, v0, lane); if (two) cv_load(c1, v1, lane);
        cv_store(c0, v0, scr, lane); if (two) cv_store(c1, v1, scr, lane);
    }
}
__device__ __forceinline__ void phase_prologue(const Args& args, LAS unsigned char* lds) {
    int tid_ = threadIdx.x; asm volatile("" : "+v"(tid_)); const int tid = tid_, lane = tid & 63, wave = __builtin_amdgcn_readfirstlane(tid >> 6), G = gridDim.x, bid = blockIdx.x; (void)tid; (void)lane; (void)wave;
    unsigned char* ws = uni_ptr(args.ws);
    LAS float* cact = (LAS float*)(lds + 69632);
    LAS float* red = (LAS float*)(lds + 77824);
    for (int k = tid; k < 2048; k += NTHR) cact[k] = siluf_(args.in[1][k]);
    __syncthreads();
    float* MOD = (float*)(ws + WS_MOD);
    for (int item = bid; item < 384; item += G) {
        const int L = item / 96, cg = item % 96, c4 = tid & 15, ks = tid >> 4;
        const float* w = args.in[LBASE(L) + 2] + (size_t)(ks * 32) * 6144 + cg * 64 + c4 * 4;
        f32x4 a0 = {0.f, 0.f, 0.f, 0.f}, a1 = {0.f, 0.f, 0.f, 0.f};
#pragma unroll 8
        for (int kk = 0; kk < 32; ++kk) { const f32x4 wv = *(const f32x4*)(w + (size_t)kk * 6144); a0 += cact[ks * 32 + kk] * wv; a1 += cact[1024 + ks * 32 + kk] * wv; }
        *(LAS f32x4*)(red + (ks * 2 + 0) * 64 + c4 * 4) = a0; *(LAS f32x4*)(red + (ks * 2 + 1) * 64 + c4 * 4) = a1;
        __syncthreads();
        if (tid < 128) { const int b = tid >> 6, col = tid & 63; float s = 0.f;
#pragma unroll
            for (int k2 = 0; k2 < 32; ++k2) s += red[(k2 * 2 + b) * 64 + col];
            MOD[(size_t)(L * 2 + b) * 6144 + cg * 64 + col] = s + args.in[LBASE(L) + 3][cg * 64 + col]; }
        __syncthreads();
    }
    { const int gw = bid * NWAVES + wave, NGW = G * NWAVES;
      if (G > 128) { convert_weights(args, lds, 0, CV_PER_L, gw, NGW); convert_weights(args, lds, CV_N_EXP, CV_N_EXP + CV_MIX_L01, gw, NGW); }
      else convert_weights(args, lds, 0, CV_N_EXP + CV_N_MIXI, gw, NGW); }
    const int gt = bid * NTHR + tid, NGT = G * NTHR;
    { bf16* dst = (bf16*)(ws + WS_WMIX + WMIX_DN_IN) + (size_t)3072 * 1024; const float* w = args.in[19];
      for (int i = gt; i < 256 * 1024; i += NGT) { const int n = i >> 10, k = i & 1023; const float v = n < 16 ? w[(size_t)k * 3088 + 3072 + n] : 0.f; dst[i] = (bf16)(pk2(v, 0.f) & 0xffffu); } }
    for (int i = gt; i < 4 * 48 * 1024; i += NGT) {
        const int L = i / 49152, rem = i % 49152, n = rem >> 10, k = rem & 1023;
        const float w = n < 36 ? args.in[LBASE(L) + 4 + NMIX(L)][(size_t)k * 36 + n] : 0.f;
        const unsigned hi = pk2(w, 0.f) & 0xffffu; const float lo = w - bf1((unsigned short)hi);
        bf16* RH = (bf16*)(ws + WS_RTR + (size_t)L * 196608); RH[rem] = (bf16)hi; RH[49152 + rem] = (bf16)(pk2(lo, 0.f) & 0xffffu);
    }
}

__device__ __forceinline__ void norm_store_row(const f32x4 (&v)[4], const float* __restrict__ gain, const float* __restrict__ shift, const float* __restrict__ scale, bf16* __restrict__ hrow, int lane) {
    float ss = 0.f;
#pragma unroll
    for (int j = 0; j < 4; ++j) ss += (v[j][0] * v[j][0] + v[j][1] * v[j][1]) + (v[j][2] * v[j][2] + v[j][3] * v[j][3]);
    const float rstd = __builtin_amdgcn_rsqf(wave_sum(ss) * (1.0f / 1024.0f) + EPS);
#pragma unroll
    for (int j = 0; j < 4; ++j) { const int c = 4 * lane + 256 * j;
        const f32x4 g = *(const f32x4*)(gain + c), sc = *(const f32x4*)(scale + c), sh = *(const f32x4*)(shift + c);
        const f32x4 h = v[j] * rstd * (g * (1.0f + sc)) + sh;
        v2u w; w.x = pk2(h[0], h[1]); w.y = pk2(h[2], h[3]); *(v2u*)(hrow + c) = w; }
}
__device__ __forceinline__ void phase_norm0(const Args& args) {
    int tid_ = threadIdx.x; asm volatile("" : "+v"(tid_)); const int tid = tid_, lane = tid & 63, wave = __builtin_amdgcn_readfirstlane(tid >> 6), G = gridDim.x, bid = blockIdx.x; (void)tid; (void)lane; (void)wave;
    const float* X = args.in[0]; bf16* H = (bf16*)(args.ws + WS_ACT + A_H); const float* MOD = (const float*)(args.ws + WS_MOD);
    for (int t = bid * NWAVES + wave; t < T; t += G * NWAVES) { const int b = t / SEQ; f32x4 v[4];
#pragma unroll
        for (int j = 0; j < 4; ++j) v[j] = *(const f32x4*)(X + (size_t)t * 1024 + 4 * lane + 256 * j);
        const float* m = MOD + (size_t)b * 6144;
        norm_store_row(v, args.in[2], m, m + 1024, H + (size_t)t * 1024, lane); }
}

__device__ __forceinline__ void phase_gm_spatial(const Args& args, int L, LAS unsigned char* lds) {
    int tid_ = threadIdx.x; asm volatile("" : "+v"(tid_)); const int tid = tid_, lane = tid & 63, wave = __builtin_amdgcn_readfirstlane(tid >> 6), G = gridDim.x, bid = blockIdx.x; (void)tid; (void)lane; (void)wave;
    unsigned char* ws = uni_ptr(args.ws); const int ib = LBASE(L) + 4;
    const float* v_norm = args.in[ib + 1]; const float* w_s = args.in[ib + 2]; const float* b_s = args.in[ib + 3];
    const bf16* U = (const bf16*)(ws + WS_ACT + A_U); const bf16* V = (const bf16*)(ws + WS_ACT + A_V); bf16* GT = (bf16*)(ws + WS_ACT + A_GATED);
    const float* VSSP = (const float*)(ws + WS_VSSP);
    LAS bf16* WL = (LAS bf16*)lds; LAS bf16* VT = (LAS bf16*)(lds + 34816); LAS float* rs = (LAS float*)(lds + 69632);
    const int wr = wave >> 2, wc = wave & 3, fr = lane & 15, fq = lane >> 4;
    for (int u = bid; u < 2048; u += G) {
        const int c = u >> 3, g = u & 7; const size_t tok0 = (size_t)c * 128;
        if (tid < 128) { const float* p = VSSP + (tok0 + tid) * 16; float s = 0.f;
#pragma unroll
            for (int i = 0; i < 4; ++i) { const f32x4 q = *(const f32x4*)(p + 4 * i); s += (q[0] + q[1]) + (q[2] + q[3]); }
            rs[tid] = __builtin_amdgcn_rsqf(s * (1.0f / 1024.0f) + EPS); }
        { const int s = tid & 127, dq = tid >> 7; const bf16* vp = V + (tok0 + s) * 1024 + g * 128 + dq * 32;
#pragma unroll
          for (int i = 0; i < 4; ++i) { const v4u q = *(const v4u*)(vp + 8 * i); const unsigned w[4] = {q.x, q.y, q.z, q.w};
#pragma unroll
              for (int e = 0; e < 4; ++e) { VT[(dq * 32 + 8 * i + 2 * e) * 136 + s] = (bf16)(w[e] & 0xffffu); VT[(dq * 32 + 8 * i + 2 * e + 1) * 136 + s] = (bf16)(w[e] >> 16); } } }
        __syncthreads();
        { const int tr = tid >> 2, sq = (tid & 3) * 32; const float* wp = w_s + ((size_t)g * 128 + tr) * 128 + sq;
#pragma unroll
          for (int i = 0; i < 8; ++i) { const f32x4 q = *(const f32x4*)(wp + 4 * i); float o[4];
#pragma unroll
              for (int e = 0; e < 4; ++e) { const int s = sq + 4 * i + e; o[e] = (s <= tr) ? q[e] * rs[s] : 0.f; }
              v2u w; w.x = pk2(o[0], o[1]); w.y = pk2(o[2], o[3]); *(LAS v2u*)(WL + tr * 136 + sq + 4 * i) = w; } }
        __syncthreads();
        f32x4 acc[2][4];
#pragma unroll
        for (int n = 0; n < 2; ++n)
#pragma unroll
            for (int m = 0; m < 4; ++m) acc[n][m] = (f32x4){0.f, 0.f, 0.f, 0.f};
#pragma unroll
        for (int ks = 0; ks < 4; ++ks) { bf16x8 vf[2], wf[4];
#pragma unroll
            for (int n = 0; n < 2; ++n) vf[n] = *(const LAS bf16x8*)(VT + (32 * wc + 16 * n + fr) * 136 + 32 * ks + 8 * fq);
#pragma unroll
            for (int m = 0; m < 4; ++m) wf[m] = *(const LAS bf16x8*)(WL + (64 * wr + 16 * m + fr) * 136 + 32 * ks + 8 * fq);
#pragma unroll
            for (int n = 0; n < 2; ++n)
#pragma unroll
                for (int m = 0; m < 4; ++m) acc[n][m] = __builtin_amdgcn_mfma_f32_16x16x32_bf16(vf[n], wf[m], acc[n][m], 0, 0, 0); }
#pragma unroll
        for (int m = 0; m < 4; ++m) { const int t = 64 * wr + 16 * m + fr; const float bs = b_s[g * 128 + t];
#pragma unroll
            for (int n = 0; n < 2; ++n) { const int d0 = g * 128 + 32 * wc + 16 * n + 4 * fq; const size_t off = (tok0 + t) * 1024 + d0;
                const v2u uu = *(const v2u*)(U + off); const f32x4 vn = *(const f32x4*)(v_norm + d0);
                const float o0 = bflo(uu.x) * (acc[n][m][0] * vn[0] + bs), o1 = bfhi(uu.x) * (acc[n][m][1] * vn[1] + bs), o2 = bflo(uu.y) * (acc[n][m][2] * vn[2] + bs), o3 = bfhi(uu.y) * (acc[n][m][3] * vn[3] + bs);
                v2u w; w.x = pk2(o0, o1); w.y = pk2(o2, o3); *(v2u*)(GT + off) = w; } }
        __syncthreads();
    }
}

__device__ __forceinline__ void phase_swa_attn(const Args& args, LAS unsigned char* lds) {
    int tid_ = threadIdx.x; asm volatile("" : "+v"(tid_)); const int tid = tid_, lane = tid & 63, wave = __builtin_amdgcn_readfirstlane(tid >> 6), G = gridDim.x, bid = blockIdx.x; (void)tid; (void)lane; (void)wave;
    unsigned char* ws = uni_ptr(args.ws);
    const float* q_norm = args.in[34]; const float* k_norm = args.in[35]; const float* sinks = args.in[36];
    const bf16* QKV = (const bf16*)(ws + WS_ACT + A_QKV); bf16* O = (bf16*)(ws + WS_ACT + A_H);
    LAS bf16* KL = (LAS bf16*)lds; LAS bf16* VT = (LAS bf16*)(lds + 36864);
    const int fr = lane & 15, fq = lane >> 4;
    for (int u = bid; u < 1024; u += G) {
        const int n = u & 127, kvh = (u >> 7) & 3, b = u >> 9; const long tok0 = (long)b * SEQ + (long)n * 128;
        { const int key = tid >> 1, half = tid & 1; const long tk = tok0 - 128 + key; float x[32]; float ss = 0.f;
          const bool ok = (n > 0) || (key >= 128);
          const bf16* kp = QKV + (size_t)(ok ? tk : tok0) * 1536 + 1024 + kvh * 64 + half * 32;
#pragma unroll
          for (int i = 0; i < 4; ++i) { const v4u q = *(const v4u*)(kp + 8 * i); const unsigned w[4] = {q.x, q.y, q.z, q.w};
#pragma unroll
              for (int e = 0; e < 4; ++e) { x[8 * i + 2 * e] = bflo(w[e]); x[8 * i + 2 * e + 1] = bfhi(w[e]); } }
#pragma unroll
          for (int i = 0; i < 32; ++i) ss += x[i] * x[i];
          ss += __shfl_xor(ss, 1);
          const float rstd = ok ? __builtin_amdgcn_rsqf(ss * (1.0f / 64.0f) + EPS) : 0.f;
#pragma unroll
          for (int i = 0; i < 4; ++i) { float o[8];
#pragma unroll
              for (int e = 0; e < 8; ++e) o[e] = x[8 * i + e] * rstd * k_norm[half * 32 + 8 * i + e];
              v4u w; w.x = pk2(o[0], o[1]); w.y = pk2(o[2], o[3]); w.z = pk2(o[4], o[5]); w.w = pk2(o[6], o[7]);
              *(LAS v4u*)(KL + key * 72 + half * 32 + 8 * i) = w; } }
        { const int key = tid & 255, dh = tid >> 8; const long tk = tok0 - 128 + key; const bool ok = (n > 0) || (key >= 128);
          const bf16* vp = QKV + (size_t)(ok ? tk : tok0) * 1536 + 1280 + kvh * 64 + dh * 32;
#pragma unroll
          for (int i = 0; i < 4; ++i) { v4u q = *(const v4u*)(vp + 8 * i); if (!ok) q = (v4u){0u, 0u, 0u, 0u}; const unsigned w[4] = {q.x, q.y, q.z, q.w};
#pragma unroll
              for (int e = 0; e < 4; ++e) { VT[(dh * 32 + 8 * i + 2 * e) * 264 + key] = (bf16)(w[e] & 0xffffu); VT[(dh * 32 + 8 * i + 2 * e + 1) * 264 + key] = (bf16)(w[e] >> 16); } } }
        __syncthreads();
        const int g = wave >> 1, qh = wave & 1, hq = kvh * 4 + g; const float sink = sinks[hq];
#pragma unroll 1
        for (int mt = 0; mt < 4; ++mt) {
            asm volatile("" ::: "memory");
            const int qi = qh * 64 + mt * 16 + fr;
            bf16x8 qf[2];
            { float x[16]; float ss = 0.f; const bf16* qp = QKV + (size_t)(tok0 + qi) * 1536 + hq * 64 + 8 * fq;
#pragma unroll
              for (int ks = 0; ks < 2; ++ks) { const v4u q = *(const v4u*)(qp + 32 * ks); const unsigned w[4] = {q.x, q.y, q.z, q.w};
#pragma unroll
                  for (int e = 0; e < 4; ++e) { x[8 * ks + 2 * e] = bflo(w[e]); x[8 * ks + 2 * e + 1] = bfhi(w[e]); } }
#pragma unroll
              for (int i = 0; i < 16; ++i) ss += x[i] * x[i];
              ss += __shfl_xor(ss, 16); ss += __shfl_xor(ss, 32);
              const float rstd = __builtin_amdgcn_rsqf(ss * (1.0f / 64.0f) + EPS) * 0.125f;
#pragma unroll
              for (int ks = 0; ks < 2; ++ks) { float o[8];
#pragma unroll
                  for (int e = 0; e < 8; ++e) o[e] = x[8 * ks + e] * rstd * q_norm[32 * ks + 8 * fq + e];
                  v4u w; w.x = pk2(o[0], o[1]); w.y = pk2(o[2], o[3]); w.z = pk2(o[4], o[5]); w.w = pk2(o[6], o[7]); qf[ks] = __builtin_bit_cast(bf16x8, w); } }
            f32x4 s[16]; float mx = -INFINITY;
#pragma unroll
            for (int nt = 0; nt < 16; ++nt) { f32x4 a = {0.f, 0.f, 0.f, 0.f};
#pragma unroll
                for (int ks = 0; ks < 2; ++ks) { const bf16x8 kf = *(const LAS bf16x8*)(KL + (16 * nt + fr) * 72 + 32 * ks + 8 * fq); a = __builtin_amdgcn_mfma_f32_16x16x32_bf16(kf, qf[ks], a, 0, 0, 0); }
#pragma unroll
                for (int i = 0; i < 4; ++i) { const int kj = 16 * nt + 4 * fq + i; const bool valid = (kj > qi) && (kj <= qi + 128) && ((n > 0) || (kj >= 128)); a[i] = valid ? a[i] : -INFINITY; mx = fmaxf(mx, a[i]); }
                s[nt] = a; }
            mx = fmaxf(mx, __shfl_xor(mx, 16)); mx = fmaxf(mx, __shfl_xor(mx, 32)); mx = fmaxf(mx, sink);
            float l = 0.f;
#pragma unroll
            for (int nt = 0; nt < 16; ++nt)
#pragma unroll
                for (int i = 0; i < 4; ++i) { const float p = fast_exp(s[nt][i] - mx); s[nt][i] = p; l += p; }
            l += __shfl_xor(l, 16); l += __shfl_xor(l, 32); l += fast_exp(sink - mx);
            f32x4 o[4];
#pragma unroll
            for (int dt = 0; dt < 4; ++dt) o[dt] = (f32x4){0.f, 0.f, 0.f, 0.f};
#pragma unroll
            for (int st = 0; st < 8; ++st) {
                v4u pw; pw.x = pk2(s[2 * st][0], s[2 * st][1]); pw.y = pk2(s[2 * st][2], s[2 * st][3]); pw.z = pk2(s[2 * st + 1][0], s[2 * st + 1][1]); pw.w = pk2(s[2 * st + 1][2], s[2 * st + 1][3]);
                const bf16x8 pf = __builtin_bit_cast(bf16x8, pw);
#pragma unroll
                for (int dt = 0; dt < 4; ++dt) { const LAS bf16* vp = VT + (16 * dt + fr) * 264 + 32 * st + 4 * fq;
                    const v2u v0 = *(const LAS v2u*)vp, v1 = *(const LAS v2u*)(vp + 16); v4u vw; vw.x = v0.x; vw.y = v0.y; vw.z = v1.x; vw.w = v1.y;
                    o[dt] = __builtin_amdgcn_mfma_f32_16x16x32_bf16(__builtin_bit_cast(bf16x8, vw), pf, o[dt], 0, 0, 0); } }
            const float inv = 1.0f / l;
#pragma unroll
            for (int dt = 0; dt < 4; ++dt) { v2u w; w.x = pk2(o[dt][0] * inv, o[dt][1] * inv); w.y = pk2(o[dt][2] * inv, o[dt][3] * inv);
                *(v2u*)(O + (size_t)(tok0 + qi) * 1024 + hq * 64 + 16 * dt + 4 * fq) = w; }
        }
        __syncthreads();
    }
}

__device__ __forceinline__ void phase_dn_prep(const Args& args) {
    int tid_ = threadIdx.x; asm volatile("" : "+v"(tid_)); const int tid = tid_, lane = tid & 63, wave = __builtin_amdgcn_readfirstlane(tid >> 6), G = gridDim.x, bid = blockIdx.x; (void)tid; (void)lane; (void)wave;
    unsigned char* ws = uni_ptr(args.ws); const float* conv_w = args.in[20]; const float* a_log = args.in[21]; const float* dt_bias = args.in[22];
    const bf16* QKV = (const bf16*)(ws + WS_ACT + A_QKV); bf16* QN = (bf16*)(ws + WS_ACT + A_QN); bf16* KN = (bf16*)(ws + WS_ACT + A_KN); bf16* VV = (bf16*)(ws + WS_ACT + A_VV);
    const float* BA = (const float*)(ws + WS_BA); float* DNB = (float*)(ws + WS_DNB);
    for (int t = bid * NWAVES + wave; t < T; t += G * NWAVES) { const int pos = t % SEQ;
#pragma unroll
        for (int j = 0; j < 4; ++j) { const int ch = 8 * lane + 512 * j; float a[8];
#pragma unroll
            for (int e = 0; e < 8; ++e) a[e] = 0.f;
#pragma unroll
            for (int tap = 0; tap < 4; ++tap) { if (pos - 3 + tap >= 0) { const v4u q = *(const v4u*)(QKV + (size_t)(t - 3 + tap) * 2048 + ch); const f32x4 w0 = *(const f32x4*)(conv_w + tap * 2048 + ch), w1 = *(const f32x4*)(conv_w + tap * 2048 + ch + 4);
                a[0] += w0[0] * bflo(q.x); a[1] += w0[1] * bfhi(q.x); a[2] += w0[2] * bflo(q.y); a[3] += w0[3] * bfhi(q.y); a[4] += w1[0] * bflo(q.z); a[5] += w1[1] * bfhi(q.z); a[6] += w1[2] * bflo(q.w); a[7] += w1[3] * bfhi(q.w); } }
            float ss = 0.f;
#pragma unroll
            for (int e = 0; e < 8; ++e) { a[e] = siluf_(a[e]); ss += a[e] * a[e]; }
            if (j < 2) { ss += __shfl_xor(ss, 1); ss += __shfl_xor(ss, 2); ss += __shfl_xor(ss, 4); ss += __shfl_xor(ss, 8);
                const float r = __builtin_amdgcn_rsqf(ss + EPS); bf16* dst = (j == 0 ? QN : KN) + (size_t)t * 512 + 8 * lane;
                v4u w; w.x = pk2(a[0] * r, a[1] * r); w.y = pk2(a[2] * r, a[3] * r); w.z = pk2(a[4] * r, a[5] * r); w.w = pk2(a[6] * r, a[7] * r); *(v4u*)dst = w; }
            else { v4u w; w.x = pk2(a[0], a[1]); w.y = pk2(a[2], a[3]); w.z = pk2(a[4], a[5]); w.w = pk2(a[6], a[7]); *(v4u*)(VV + (size_t)t * 1024 + 8 * lane + 512 * (j - 2)) = w; } }
        if (lane < 8) { const float bi = BA[(size_t)t * 16 + lane], ai = BA[(size_t)t * 16 + 8 + lane] + dt_bias[lane];
            const float sp = fmaxf(ai, 0.f) + log1pf(expf(-fabsf(ai)));
            DNB[(size_t)t * 16 + lane] = 1.0f / (1.0f + expf(-bi)); DNB[(size_t)t * 16 + 8 + lane] = -expf(a_log[lane]) * sp; }
    }
}
constexpr int FA_STRIDE = 25600, FB_STRIDE = 32768, FU_STRIDE = 16384;
constexpr float DN_SCALE = 0.08838834764831845f;
__device__ __forceinline__ void phase_dn_chunk(const Args& args, LAS unsigned char* lds) {
    int tid_ = threadIdx.x; asm volatile("" : "+v"(tid_)); const int tid = tid_, lane = tid & 63, wave = __builtin_amdgcn_readfirstlane(tid >> 6), G = gridDim.x, bid = blockIdx.x;
    unsigned char* ws = uni_ptr(args.ws);
    const bf16* QN = (const bf16*)(ws + WS_ACT + A_QN); const bf16* KN = (const bf16*)(ws + WS_ACT + A_KN); const bf16* VV = (const bf16*)(ws + WS_ACT + A_VV);
    const float* DNB = (const float*)(ws + WS_DNB);
    unsigned char* FA = ws + WS_ACT + A_FA; unsigned char* FB = ws + WS_ACT + A_FB; unsigned char* FU = ws + WS_ACT + A_FU;
    LAS float* Al = (LAS float*)(lds + wave * 16384);
    LAS float* tb = (LAS float*)(lds + LDSCTL_OFF + 2048 + wave * 512);
    const int fr = lane & 15, fq = lane >> 4;
    for (int it = bid * NWAVES + wave; it < 4096; it += G * NWAVES) {
        const int b = it >> 11, hv = (it >> 8) & 7, n = it & 255, hq = hv >> 1; const size_t t0 = (size_t)b * SEQ + (size_t)n * 64; const int itq = (b * 4 + hq) * 256 + n;
        unsigned char* fa = FA + (size_t)it * FA_STRIDE; unsigned char* fb = FB + (size_t)itq * FB_STRIDE;
        const float bv = DNB[(t0 + lane) * 16 + hv]; float gcv = DNB[(t0 + lane) * 16 + 8 + hv];
#pragma unroll
        for (int o = 1; o < 64; o <<= 1) { const float t = __shfl_up(gcv, o); if (lane >= o) gcv += t; }
        const float gll = __shfl(gcv, 63);
        tb[lane] = gcv; tb[64 + lane] = bv;
        { float* fe = (float*)(fa + 24576); fe[lane] = DN_SCALE * expf(gcv); fe[64 + lane] = expf(gll - gcv); fe[128 + lane] = expf(gll); }
        asm volatile("" ::: "memory");
        bf16x8 kf[4][4];
#pragma unroll
        for (int t = 0; t < 4; ++t)
#pragma unroll
            for (int ks = 0; ks < 4; ++ks) kf[t][ks] = *(const bf16x8*)(KN + (t0 + 16 * t + fr) * 512 + hq * 128 + 32 * ks + 8 * fq);
#pragma unroll
        for (int m = 0; m < 4; ++m) { const int c = 16 * m + fr; const float bm = tb[64 + c], gm = tb[c];
            bf16x8 qf[4];
#pragma unroll
            for (int ks = 0; ks < 4; ++ks) qf[ks] = *(const bf16x8*)(QN + (t0 + c) * 512 + hq * 128 + 32 * ks + 8 * fq);
            f32x4 tl[4];
#pragma unroll
            for (int t = 0; t < 4; ++t) {
                if (t <= m) { f32x4 ak = {0.f, 0.f, 0.f, 0.f}, aq = {0.f, 0.f, 0.f, 0.f};
#pragma unroll
                    for (int ks = 0; ks < 4; ++ks) { ak = __builtin_amdgcn_mfma_f32_16x16x32_bf16(kf[t][ks], kf[m][ks], ak, 0, 0, 0); aq = __builtin_amdgcn_mfma_f32_16x16x32_bf16(kf[t][ks], qf[ks], aq, 0, 0, 0); }
                    const f32x4 gs4 = *(const LAS f32x4*)(tb + 16 * t + 4 * fq); f32x4 av;
#pragma unroll
                    for (int r = 0; r < 4; ++r) { const int s = 16 * t + 4 * fq + r; const float dec = expf(fminf(gm - gs4[r], 0.f)); av[r] = (s < c) ? bm * ak[r] * dec : 0.f; tl[t][r] = (s <= c) ? DN_SCALE * aq[r] * dec : 0.f; }
                    *(LAS f32x4*)(Al + c * 64 + 16 * t + 4 * fq) = av; }
                else tl[t] = (f32x4){0.f, 0.f, 0.f, 0.f}; }
#pragma unroll
            for (int k2 = 0; k2 < 2; ++k2) { v4u w; w.x = pk2(tl[2 * k2][0], tl[2 * k2][1]); w.y = pk2(tl[2 * k2][2], tl[2 * k2][3]); w.z = pk2(tl[2 * k2 + 1][0], tl[2 * k2 + 1][1]); w.w = pk2(tl[2 * k2 + 1][2], tl[2 * k2 + 1][3]);
                *(v4u*)(fa + 16384 + (m * 2 + k2) * 1024 + lane * 16) = w; } }
        asm volatile("s_waitcnt lgkmcnt(0)" ::: "memory");
        float Tc[64];
#pragma unroll
        for (int m = 0; m < 64; ++m) Tc[m] = (m == lane) ? 1.f : 0.f;
#pragma unroll
        for (int r = 1; r < 64; ++r) { float acc = 0.f;
#pragma unroll
            for (int m4 = 0; m4 < (r + 3) / 4; ++m4) { const f32x4 a4 = *(const LAS f32x4*)(Al + r * 64 + 4 * m4);
#pragma unroll
                for (int e = 0; e < 4; ++e) if (4 * m4 + e < r) acc += a4[e] * Tc[4 * m4 + e]; }
            Tc[r] -= acc; }
        asm volatile("s_waitcnt lgkmcnt(0)" ::: "memory");
        LAS bf16* T1l = (LAS bf16*)Al; LAS bf16* T2l = T1l + 4096;
        { const float c1 = bv, c2 = bv * expf(gcv);
#pragma unroll
          for (int i = 0; i < 64; ++i) { T1l[i * 64 + lane] = (bf16)(pk2(Tc[i] * c1, 0.f) & 0xffffu); T2l[i * 64 + lane] = (bf16)(pk2(Tc[i] * c2, 0.f) & 0xffffu); } }
        asm volatile("s_waitcnt lgkmcnt(0)" ::: "memory");
        { bf16x8 t1f[4][2];
#pragma unroll
          for (int m = 0; m < 4; ++m)
#pragma unroll
              for (int k2 = 0; k2 < 2; ++k2) t1f[m][k2] = *(const LAS bf16x8*)(T1l + (16 * m + fr) * 64 + 32 * k2 + 8 * fq);
#pragma unroll 1
          for (int j = 0; j < 8; ++j) { bf16x8 vf[2];
#pragma unroll
              for (int k2 = 0; k2 < 2; ++k2)
#pragma unroll
                  for (int i = 0; i < 8; ++i) vf[k2][i] = (short)VV[(t0 + 32 * k2 + 8 * fq + i) * 1024 + hv * 128 + 16 * j + fr];
#pragma unroll
              for (int m = 0; m < 4; ++m) { f32x4 a = {0.f, 0.f, 0.f, 0.f};
#pragma unroll
                  for (int k2 = 0; k2 < 2; ++k2) a = __builtin_amdgcn_mfma_f32_16x16x32_bf16(t1f[m][k2], vf[k2], a, 0, 0, 0);
                  v2u w; w.x = pk2(a[0], a[1]); w.y = pk2(a[2], a[3]); *(v2u*)(FU + (size_t)it * FU_STRIDE + ((j * 4 + m) * 64 + lane) * 8) = w; } } }
        { bf16x8 ktf[8][2];
#pragma unroll
          for (int dt = 0; dt < 8; ++dt)
#pragma unroll
              for (int k2 = 0; k2 < 2; ++k2)
#pragma unroll
                  for (int i = 0; i < 8; ++i) ktf[dt][k2][i] = (short)KN[(t0 + 32 * k2 + 16 * (i >> 2) + 4 * fq + (i & 3)) * 512 + hq * 128 + 16 * dt + fr];
          if ((hv & 1) == 0) {
#pragma unroll
              for (int dt = 0; dt < 8; ++dt)
#pragma unroll
                  for (int k2 = 0; k2 < 2; ++k2) *(bf16x8*)(fb + 16384 + (dt * 2 + k2) * 1024 + lane * 16) = ktf[dt][k2];
#pragma unroll
              for (int m = 0; m < 4; ++m)
#pragma unroll
                  for (int ks = 0; ks < 4; ++ks) { const bf16* qp = QN + (t0 + 16 * m + fr) * 512 + hq * 128 + 32 * ks + 4 * fq; const v2u lo = *(const v2u*)qp, hi = *(const v2u*)(qp + 16);
                      v4u w; w.x = lo.x; w.y = lo.y; w.z = hi.x; w.w = hi.y; *(v4u*)(fb + (m * 4 + ks) * 1024 + lane * 16) = w; } }
#pragma unroll
          for (int m = 0; m < 4; ++m) { bf16x8 t2f[2];
#pragma unroll
              for (int k2 = 0; k2 < 2; ++k2) { const LAS bf16* tp = T2l + (16 * m + fr) * 64 + 32 * k2 + 4 * fq; const v2u lo = *(const LAS v2u*)tp, hi = *(const LAS v2u*)(tp + 16); v4u w; w.x = lo.x; w.y = lo.y; w.z = hi.x; w.w = hi.y; t2f[k2] = __builtin_bit_cast(bf16x8, w); }
              f32x4 acc[8];
#pragma unroll
              for (int dt = 0; dt < 8; ++dt) { acc[dt] = (f32x4){0.f, 0.f, 0.f, 0.f};
#pragma unroll
                  for (int k2 = 0; k2 < 2; ++k2) acc[dt] = __builtin_amdgcn_mfma_f32_16x16x32_bf16(ktf[dt][k2], t2f[k2], acc[dt], 0, 0, 0); }
#pragma unroll
              for (int ks = 0; ks < 4; ++ks) { v4u w; w.x = pk2(-acc[2 * ks][0], -acc[2 * ks][1]); w.y = pk2(-acc[2 * ks][2], -acc[2 * ks][3]); w.z = pk2(-acc[2 * ks + 1][0], -acc[2 * ks + 1][1]); w.w = pk2(-acc[2 * ks + 1][2], -acc[2 * ks + 1][3]);
                  *(v4u*)(fa + (m * 4 + ks) * 1024 + lane * 16) = w; } } }
        asm volatile("s_waitcnt lgkmcnt(0)" ::: "memory");
    }
}
__device__ __forceinline__ void phase_dn_scan(const Args& args, LAS unsigned char* lds) {
    int tid_ = threadIdx.x; asm volatile("" : "+v"(tid_)); const int tid = tid_, lane = tid & 63, wave = __builtin_amdgcn_readfirstlane(tid >> 6), G = gridDim.x, bid = blockIdx.x;
    if (bid >= 128) {
        const int gw = (bid - 128) * NWAVES + wave, NGW = (G - 128) * NWAVES;
        convert_weights(args, lds, CV_PER_L, CV_N_EXP, gw, NGW); convert_weights(args, lds, CV_N_EXP + CV_MIX_L01, CV_N_EXP + CV_N_MIXI, gw, NGW); return; }
    unsigned char* ws = uni_ptr(args.ws);
    const unsigned char* FA = ws + WS_ACT + A_FA; const unsigned char* FB = ws + WS_ACT + A_FB; const unsigned char* FU = ws + WS_ACT + A_FU; bf16* O = (bf16*)(ws + WS_ACT + A_O);
    const int fr = lane & 15, fq = lane >> 4;
    constexpr int SLOT = 60416, O_QK = 16384, O_TB = 24576, O_Q = 25600, O_KT = 41984, O_U = 58368;
#define SB() __builtin_amdgcn_sched_barrier(0)
#define WGBAR() do { asm volatile("" ::: "memory"); __builtin_amdgcn_s_barrier(); asm volatile("" ::: "memory"); } while (0)
#define DN_AUX 0
#define DMA4(g, l) do { __builtin_amdgcn_global_load_lds((g), (l), 16, 0, DN_AUX); __builtin_amdgcn_global_load_lds((g), (l), 16, 1024, DN_AUX); __builtin_amdgcn_global_load_lds((g), (l), 16, 2048, DN_AUX); __builtin_amdgcn_global_load_lds((g), (l), 16, 3072, DN_AUX); } while (0)
    for (int sidx = bid; sidx < 128; sidx += G) {
        const int bh = (sidx & 7) * 2 + (sidx >> 6), j = (sidx >> 3) & 7, b = bh >> 3, hv = bh & 7, hq = hv >> 1;
        const int it0 = bh * 256, itq0 = (b * 4 + hq) * 256;
        if (wave == 1 || wave == 4) {
#define DN_ISSUE_A(nn) do { LAS unsigned char* sl_ = lds + ((nn) & 1) * SLOT; \
                if (wave == 1) { const unsigned char* fa_ = FA + (size_t)(it0 + (nn)) * FA_STRIDE + lane * 16; \
                    _Pragma("unroll") for (int f4 = 0; f4 < 4; ++f4) { DMA4((const unsigned*)(fa_ + f4 * 4096), (LAS unsigned*)(sl_ + f4 * 4096)); } \
                    __builtin_amdgcn_global_load_lds((const unsigned*)(fa_ + 24576), (LAS unsigned*)(sl_ + O_TB), 16, 0, DN_AUX); } \
                else { const unsigned char* fb_ = FB + (size_t)(itq0 + (nn)) * FB_STRIDE + lane * 16; const unsigned char* fu_ = FU + (size_t)(it0 + (nn)) * FU_STRIDE + j * 2048 + lane * 16; \
                    _Pragma("unroll") for (int f4 = 0; f4 < 4; ++f4) { DMA4((const unsigned*)(fb_ + f4 * 4096), (LAS unsigned*)(sl_ + O_Q + f4 * 4096)); } \
                    __builtin_amdgcn_global_load_lds((const unsigned*)(fu_), (LAS unsigned*)(sl_ + O_U), 16, 0, DN_AUX); __builtin_amdgcn_global_load_lds((const unsigned*)(fu_), (LAS unsigned*)(sl_ + O_U), 16, 1024, DN_AUX); } } while (0)
#define DN_WAIT_A() do { if (wave == 1) asm volatile("s_waitcnt vmcnt(17)" ::: "memory"); else asm volatile("s_waitcnt vmcnt(18)" ::: "memory"); } while (0)
            DN_ISSUE_A(0); DN_ISSUE_A(1);
            DN_WAIT_A();
#pragma unroll 1
            for (int n = 0; n < 256; ++n) {
                WGBAR();
                WGBAR();
                if (n + 2 < 256) { DN_ISSUE_A(n + 2); DN_WAIT_A(); }
                else asm volatile("s_waitcnt vmcnt(0)" ::: "memory");
            }
#undef DN_ISSUE_A
#undef DN_WAIT_A
        } else if (wave == 2 || wave == 5) {
#define DN_ISSUE_B(nn) do { LAS unsigned char* sl_ = lds + ((nn) & 1) * SLOT; const unsigned char* fb_ = FB + (size_t)(itq0 + (nn)) * FB_STRIDE + 16384 + lane * 16; \
                if (wave == 2) { const unsigned char* fa_ = FA + (size_t)(it0 + (nn)) * FA_STRIDE + 16384 + lane * 16; \
                    _Pragma("unroll") for (int f4 = 0; f4 < 2; ++f4) { DMA4((const unsigned*)(fa_ + f4 * 4096), (LAS unsigned*)(sl_ + O_QK + f4 * 4096)); } \
                    DMA4((const unsigned*)(fb_), (LAS unsigned*)(sl_ + O_KT)); } \
                else { _Pragma("unroll") for (int f4 = 1; f4 < 4; ++f4) { DMA4((const unsigned*)(fb_ + f4 * 4096), (LAS unsigned*)(sl_ + O_KT + f4 * 4096)); } } } while (0)
            DN_ISSUE_B(0);
#pragma unroll 1
            for (int n = 0; n < 256; ++n) {
                WGBAR();
                if (n + 1 < 256) { DN_ISSUE_B(n + 1); asm volatile("s_waitcnt vmcnt(12)" ::: "memory"); }
                else asm volatile("s_waitcnt vmcnt(0)" ::: "memory");
                WGBAR();
            }
#undef DN_ISSUE_B
        } else if (wave == 3) {
            unsigned sink = 0u, pa = 0u, pb = 0u;
#pragma unroll 1
            for (int n = 0; n < 256; ++n) {
                WGBAR(); WGBAR();
                sink += pa + pb;
                const int p = n + 5;
                if (p < 256) { const int li = j * 57 + lane;
                    if (lane < 57 && li < 456) { const unsigned char* q = li < 200 ? FA + (size_t)(it0 + p) * FA_STRIDE + li * 128 : FB + (size_t)(itq0 + p) * FB_STRIDE + (li - 200) * 128; pa = *(const volatile unsigned*)q; }
                    if (lane < 16) pb = *(const volatile unsigned*)(FU + (size_t)(it0 + p) * FU_STRIDE + j * 2048 + lane * 128); }
            }
            sink += pa + pb;
            if (sink == 0x9e3779b9u) O[0] = 0;
        } else if (wave != 0) {
#pragma unroll 1
            for (int n = 0; n < 256; ++n) { WGBAR(); WGBAR(); }
        } else {
        f32x4 S[8];
#pragma unroll
        for (int dt = 0; dt < 8; ++dt) S[dt] = (f32x4){0.f, 0.f, 0.f, 0.f};
        bf16x8 sf[4];
#pragma unroll
        for (int ks = 0; ks < 4; ++ks) sf[ks] = (bf16x8){0, 0, 0, 0, 0, 0, 0, 0};
#pragma unroll 1
        for (int n = 0; n < 256; ++n) {
            WGBAR();
            const LAS unsigned char* base = lds + (n & 1) * SLOT + lane * 16;
            const LAS float* tbl = (const LAS float*)(lds + (n & 1) * SLOT + O_TB);
            f32x4 egc[4], ekd[4], av[4], ao[4];
#pragma unroll
            for (int m = 0; m < 4; ++m) { egc[m] = *(const LAS f32x4*)(tbl + 16 * m + 4 * fq); ekd[m] = *(const LAS f32x4*)(tbl + 64 + 16 * m + 4 * fq);
                const v2u u2 = *(const LAS v2u*)(lds + (n & 1) * SLOT + O_U + (m * 64 + lane) * 8); av[m] = (f32x4){bflo(u2.x), bfhi(u2.x), bflo(u2.y), bfhi(u2.y)}; ao[m] = (f32x4){0.f, 0.f, 0.f, 0.f}; }
            const float gl = tbl[128 + lane];
            SB();
            bf16x8 Aw[16], Bq[16];
#pragma unroll
            for (int f = 0; f < 16; ++f) Aw[f] = *(const LAS bf16x8*)(base + f * 1024);
            SB();
#pragma unroll
            for (int ks = 0; ks < 4; ++ks) {
#pragma unroll
                for (int m = 0; m < 4; ++m) Bq[m * 4 + ks] = *(const LAS bf16x8*)(base + O_Q + (m * 4 + ks) * 1024);
#pragma unroll
                for (int m = 0; m < 4; ++m) av[m] = __builtin_amdgcn_mfma_f32_16x16x32_bf16(Aw[m * 4 + ks], sf[ks], av[m], 0, 0, 0);
                SB(); }
            asm volatile("s_waitcnt lgkmcnt(0)" ::: "memory");
            WGBAR();
            bf16x8 Ck[16], Dk[8];
#pragma unroll
            for (int ks = 0; ks < 4; ++ks) {
#pragma unroll
                for (int f = 0; f < 2; ++f) { Ck[8 + ks * 2 + f] = *(const LAS bf16x8*)(base + O_KT + (ks * 2 + f) * 1024); Dk[ks * 2 + f] = *(const LAS bf16x8*)(base + O_KT + 8192 + (ks * 2 + f) * 1024); Ck[ks * 2 + f] = *(const LAS bf16x8*)(base + O_QK + (ks * 2 + f) * 1024); }
#pragma unroll
                for (int m = 0; m < 4; ++m) ao[m] = __builtin_amdgcn_mfma_f32_16x16x32_bf16(Bq[m * 4 + ks], sf[ks], ao[m], 0, 0, 0);
                SB(); }
#pragma unroll
            for (int dt = 0; dt < 8; ++dt) S[dt] = S[dt] * gl;
            bf16x8 vf[2], vpf[2];
#pragma unroll
            for (int k2 = 0; k2 < 2; ++k2) { v4u w; w.x = pk2(av[2 * k2][0], av[2 * k2][1]); w.y = pk2(av[2 * k2][2], av[2 * k2][3]); w.z = pk2(av[2 * k2 + 1][0], av[2 * k2 + 1][1]); w.w = pk2(av[2 * k2 + 1][2], av[2 * k2 + 1][3]); vf[k2] = __builtin_bit_cast(bf16x8, w);
                const f32x4 p0 = av[2 * k2] * ekd[2 * k2], p1 = av[2 * k2 + 1] * ekd[2 * k2 + 1];
                v4u x; x.x = pk2(p0[0], p0[1]); x.y = pk2(p0[2], p0[3]); x.z = pk2(p1[0], p1[1]); x.w = pk2(p1[2], p1[3]); vpf[k2] = __builtin_bit_cast(bf16x8, x); }
#pragma unroll
            for (int m = 0; m < 4; ++m) ao[m] = ao[m] * egc[m];
            SB();
#pragma unroll
            for (int k2 = 0; k2 < 2; ++k2)
#pragma unroll
                for (int dt = 0; dt < 4; ++dt) S[dt] = __builtin_amdgcn_mfma_f32_16x16x32_bf16(Ck[8 + dt * 2 + k2], vpf[k2], S[dt], 0, 0, 0);
#pragma unroll
            for (int k2 = 0; k2 < 2; ++k2)
#pragma unroll
                for (int dt = 4; dt < 8; ++dt) S[dt] = __builtin_amdgcn_mfma_f32_16x16x32_bf16(Dk[(dt - 4) * 2 + k2], vpf[k2], S[dt], 0, 0, 0);
#pragma unroll
            for (int k2 = 0; k2 < 2; ++k2)
#pragma unroll
                for (int m = 0; m < 4; ++m) ao[m] = __builtin_amdgcn_mfma_f32_16x16x32_bf16(Ck[m * 2 + k2], vf[k2], ao[m], 0, 0, 0);
            SB();
#pragma unroll
            for (int ks = 0; ks < 4; ++ks) { v4u w; w.x = pk2(S[2 * ks][0], S[2 * ks][1]); w.y = pk2(S[2 * ks][2], S[2 * ks][3]); w.z = pk2(S[2 * ks + 1][0], S[2 * ks + 1][1]); w.w = pk2(S[2 * ks + 1][2], S[2 * ks + 1][3]); sf[ks] = __builtin_bit_cast(bf16x8, w); }
            asm volatile("s_waitcnt lgkmcnt(0)" ::: "memory");
            { bf16* op = O + ((size_t)b * SEQ + (size_t)n * 64 + 4 * fq) * 1024 + hv * 128 + 16 * j + fr;
#pragma unroll
              for (int m = 0; m < 4; ++m)
#pragma unroll
                  for (int r = 0; r < 4; ++r) op[(size_t)(16 * m + r) * 1024] = (bf16)(pk2(ao[m][r], 0.f) & 0xffffu); }
        }
        }
        __syncthreads();
    }
#undef SB
#undef DMA4
#undef WGBAR
}
__device__ __forceinline__ void phase_dn_ogate(const Args& args) {
    int tid_ = threadIdx.x; asm volatile("" : "+v"(tid_)); const int tid = tid_, lane = tid & 63, wave = __builtin_amdgcn_readfirstlane(tid >> 6), G = gridDim.x, bid = blockIdx.x; (void)tid; (void)lane; (void)wave;
    unsigned char* ws = uni_ptr(args.ws); const float* o_norm = args.in[23];
    const bf16* O = (const bf16*)(ws + WS_ACT + A_O); const bf16* Z = (const bf16*)(ws + WS_ACT + A_Z); bf16* GT = (bf16*)(ws + WS_ACT + A_H);
    for (int t = bid * NWAVES + wave; t < T; t += G * NWAVES) {
#pragma unroll
        for (int j = 0; j < 2; ++j) { const int ch = 8 * lane + 512 * j; const v4u q = *(const v4u*)(O + (size_t)t * 1024 + ch), z = *(const v4u*)(Z + (size_t)t * 1024 + ch);
            float o[8] = {bflo(q.x), bfhi(q.x), bflo(q.y), bfhi(q.y), bflo(q.z), bfhi(q.z), bflo(q.w), bfhi(q.w)}; const float zz[8] = {bflo(z.x), bfhi(z.x), bflo(z.y), bfhi(z.y), bflo(z.z), bfhi(z.z), bflo(z.w), bfhi(z.w)};
            float ss = 0.f;
#pragma unroll
            for (int e = 0; e < 8; ++e) ss += o[e] * o[e];
            ss += __shfl_xor(ss, 1); ss += __shfl_xor(ss, 2); ss += __shfl_xor(ss, 4); ss += __shfl_xor(ss, 8);
            const float r = __builtin_amdgcn_rsqf(ss * (1.0f / 128.0f) + EPS);
#pragma unroll
            for (int e = 0; e < 8; ++e) o[e] = o[e] * r * o_norm[(ch & 127) + e] * siluf_(zz[e]);
            v4u w; w.x = pk2(o[0], o[1]); w.y = pk2(o[2], o[3]); w.z = pk2(o[4], o[5]); w.w = pk2(o[6], o[7]); *(v4u*)(GT + (size_t)t * 1024 + ch) = w; }
    }
}

__device__ __forceinline__ void phase_moe_router(const Args& args, int L, LAS unsigned char* lds) {
    int tid_ = threadIdx.x; asm volatile("" : "+v"(tid_)); const int tid = tid_, lane = tid & 63, wave = __builtin_amdgcn_readfirstlane(tid >> 6), G = gridDim.x, bid = blockIdx.x; (void)tid; (void)lane; (void)wave;
    unsigned char* ws = uni_ptr(args.ws); const int ib = LBASE(L) + 4 + NMIX(L);
    const float* X = args.out; bf16* H = (bf16*)(ws + WS_ACT + A_H); const float* MOD = (const float*)(ws + WS_MOD) + (size_t)L * 2 * 6144;
    const float* nf = args.in[LBASE(L) + 1]; const float* rb = args.in[ib + 1];
    const bf16* RH = (const bf16*)(ws + WS_RTR + (size_t)L * 196608); const bf16* RLo = RH + 49152;
    int* EID = (int*)(ws + WS_EID); float* GATE = (float*)(ws + WS_GATE); int* CNT = (int*)(ws + WS_CNT);
    LAS float* gs = (LAS float*)lds; LAS float* sh = gs + 1024; LAS int* lcnt = (LAS int*)(lds + 8192); LAS float* scr = (LAS float*)(lds + 8448 + wave * 3072);
    const int r = lane & 15, q = lane >> 4;
    for (int item = bid; item < T / 128; item += G) {
        const int r0 = item * 128, b = r0 / SEQ; const float* m = MOD + (size_t)b * 6144;
        __syncthreads();
        for (int k = tid; k < 1024; k += NTHR) { gs[k] = nf[k] * (1.0f + m[4096 + k]); sh[k] = m[3072 + k]; }
        if (tid < 32) lcnt[tid] = 0;
        __syncthreads();
        const int row = r0 + 16 * wave + r; const float* xp = X + (size_t)row * 1024 + 8 * q;
        float ss = 0.f;
#pragma unroll 8
        for (int j = 0; j < 32; ++j) { const f32x4 v0 = *(const f32x4*)(xp + 32 * j), v1 = *(const f32x4*)(xp + 32 * j + 4); ss += (v0[0] * v0[0] + v0[1] * v0[1]) + (v0[2] * v0[2] + v0[3] * v0[3]) + (v1[0] * v1[0] + v1[1] * v1[1]) + (v1[2] * v1[2] + v1[3] * v1[3]); }
        ss += __shfl_xor(ss, 16); ss += __shfl_xor(ss, 32);
        const float rstd = __builtin_amdgcn_rsqf(ss * (1.0f / 1024.0f) + EPS);
        f32x4 acc[3];
#pragma unroll
        for (int nt = 0; nt < 3; ++nt) acc[nt] = (f32x4){0.f, 0.f, 0.f, 0.f};
#pragma unroll 2
        for (int j = 0; j < 32; ++j) { const int k0 = 32 * j + 8 * q; const f32x4 v0 = *(const f32x4*)(xp + 32 * j), v1 = *(const f32x4*)(xp + 32 * j + 4);
            const f32x4 g0 = *(const LAS f32x4*)(gs + k0), g1 = *(const LAS f32x4*)(gs + k0 + 4), s0 = *(const LAS f32x4*)(sh + k0), s1 = *(const LAS f32x4*)(sh + k0 + 4);
            const f32x4 h0 = v0 * rstd * g0 + s0, h1 = v1 * rstd * g1 + s1;
            v4u hi; hi.x = pk2(h0[0], h0[1]); hi.y = pk2(h0[2], h0[3]); hi.z = pk2(h1[0], h1[1]); hi.w = pk2(h1[2], h1[3]);
            v4u lo; lo.x = pk2(h0[0] - bflo(hi.x), h0[1] - bfhi(hi.x)); lo.y = pk2(h0[2] - bflo(hi.y), h0[3] - bfhi(hi.y)); lo.z = pk2(h1[0] - bflo(hi.z), h1[1] - bfhi(hi.z)); lo.w = pk2(h1[2] - bflo(hi.w), h1[3] - bfhi(hi.w));
            *(v4u*)(H + (size_t)row * 1024 + k0) = hi;
            const bf16x8 ahi = __builtin_bit_cast(bf16x8, hi), alo = __builtin_bit_cast(bf16x8, lo);
#pragma unroll
            for (int nt = 0; nt < 3; ++nt) { const bf16x8 bh = *(const bf16x8*)(RH + (size_t)(nt * 16 + r) * 1024 + k0), bl = *(const bf16x8*)(RLo + (size_t)(nt * 16 + r) * 1024 + k0);
                acc[nt] = __builtin_amdgcn_mfma_f32_16x16x32_bf16(bh, ahi, acc[nt], 0, 0, 0); acc[nt] = __builtin_amdgcn_mfma_f32_16x16x32_bf16(bl, ahi, acc[nt], 0, 0, 0); acc[nt] = __builtin_amdgcn_mfma_f32_16x16x32_bf16(bh, alo, acc[nt], 0, 0, 0); } }
#pragma unroll
        for (int nt = 0; nt < 3; ++nt) *(LAS f32x4*)(scr + r * 48 + 16 * nt + 4 * q) = acc[nt];
        LDS_WAIT(); asm volatile("" ::: "memory");
        if (lane < 16) { float lg[36];
#pragma unroll
            for (int i = 0; i < 9; ++i) { const f32x4 v = *(const LAS f32x4*)(scr + r * 48 + 4 * i); lg[4 * i] = v[0] + rb[4 * i]; lg[4 * i + 1] = v[1] + rb[4 * i + 1]; lg[4 * i + 2] = v[2] + rb[4 * i + 2]; lg[4 * i + 3] = v[3] + rb[4 * i + 3]; }
            int gsel = 0; float gm = lg[0];
#pragma unroll
            for (int i = 1; i < 4; ++i) if (lg[i] > gm) { gm = lg[i]; gsel = i; }
            float gsum = 0.f;
#pragma unroll
            for (int i = 0; i < 4; ++i) gsum += expf(lg[i] - gm);
            const float pg = 1.0f / gsum;
            float le[8];
#pragma unroll
            for (int i = 0; i < 8; ++i) le[i] = gsel == 0 ? lg[4 + i] : (gsel == 1 ? lg[12 + i] : (gsel == 2 ? lg[20 + i] : lg[28 + i]));
            int j1 = 0; float m1 = le[0];
#pragma unroll
            for (int i = 1; i < 8; ++i) if (le[i] > m1) { m1 = le[i]; j1 = i; }
            int j2 = -1; float m2 = -INFINITY;
#pragma unroll
            for (int i = 0; i < 8; ++i) if (i != j1 && le[i] > m2) { m2 = le[i]; j2 = i; }
            const float p2 = expf(m2 - m1), den = 1.0f / (1.0f + p2);
            const int e1 = gsel * 8 + j1, e2 = gsel * 8 + j2;
            EID[(size_t)row * 2] = e1; EID[(size_t)row * 2 + 1] = e2; GATE[(size_t)row * 2] = pg * den; GATE[(size_t)row * 2 + 1] = pg * p2 * den;
            __hip_atomic_fetch_add(lcnt + e1, 1, __ATOMIC_RELAXED, __HIP_MEMORY_SCOPE_WORKGROUP); __hip_atomic_fetch_add(lcnt + e2, 1, __ATOMIC_RELAXED, __HIP_MEMORY_SCOPE_WORKGROUP); }
        __syncthreads();
        if (tid < 32) CNT[item * 32 + tid] = lcnt[tid];
    }
}
__device__ __forceinline__ void phase_moe_scatter(const Args& args, LAS unsigned char* lds) {
    int tid_ = threadIdx.x; asm volatile("" : "+v"(tid_)); const int tid = tid_, lane = tid & 63, wave = __builtin_amdgcn_readfirstlane(tid >> 6), G = gridDim.x, bid = blockIdx.x; (void)tid; (void)lane; (void)wave;
    unsigned char* ws = uni_ptr(args.ws);
    const bf16* H = (const bf16*)(ws + WS_ACT + A_H); bf16* XG = (bf16*)(ws + WS_ACT + A_XG);
    const int* EID = (const int*)(ws + WS_EID); int* SLOT = (int*)(ws + WS_SLOT); const int* CNT = (const int*)(ws + WS_CNT); int* TILEE = (int*)(ws + WS_TILEE);
    LAS int* tot = (LAS int*)lds; LAS int* before = tot + 32; LAS int* pstart = tot + 64; LAS int* lcnt = tot + 96; LAS int* lslot = tot + 128;
    for (int item = bid; item < T / 128; item += G) {
        const int r0 = item * 128;
        __syncthreads();
        if (tid < 32) { int t_ = 0, b_ = 0;
            for (int w = 0; w < T / 128; ++w) { const int c = CNT[w * 32 + tid]; t_ += c; b_ += (w < item) ? c : 0; }
            tot[tid] = t_; before[tid] = b_; lcnt[tid] = 0; }
        __syncthreads();
        if (tid == 0) { int ps = 0; for (int e = 0; e < 32; ++e) { pstart[e] = ps; ps += (tot[e] + 255) & ~255; }
            if (item == 0) { TILEE[0] = ps >> 8; for (int e = 0; e < 32; ++e) { const int t0 = pstart[e] >> 8, nt = ((tot[e] + 255) >> 8); for (int i = 0; i < nt; ++i) TILEE[16 + t0 + i] = e; } } }
        __syncthreads();
        if (tid < 256) { const int e = EID[(size_t)r0 * 2 + tid]; const int rank = __hip_atomic_fetch_add(lcnt + e, 1, __ATOMIC_RELAXED, __HIP_MEMORY_SCOPE_WORKGROUP); const int slot = pstart[e] + before[e] + rank; SLOT[(size_t)r0 * 2 + tid] = slot; lslot[tid] = slot; }
        __syncthreads();
        for (int rr = 0; rr < 16; ++rr) { const int row = 16 * wave + rr; const bf16* src = H + (size_t)(r0 + row) * 1024;
            const v4u a = *(const v4u*)(src + 8 * lane), c = *(const v4u*)(src + 512 + 8 * lane); const int s0 = lslot[2 * row], s1 = lslot[2 * row + 1];
            bf16* d0 = XG + (size_t)s0 * 1024; bf16* d1 = XG + (size_t)s1 * 1024;
            *(v4u*)(d0 + 8 * lane) = a; *(v4u*)(d0 + 512 + 8 * lane) = c; *(v4u*)(d1 + 8 * lane) = a; *(v4u*)(d1 + 512 + 8 * lane) = c; }
        { const int e = item & 31, part = item >> 5; const int p0 = pstart[e] + tot[e], npad = ((tot[e] + 255) & ~255) - tot[e]; const v4u z = {0u, 0u, 0u, 0u};
          for (int pr = part * 8 + wave; pr < npad; pr += 64) { bf16* d = XG + (size_t)(p0 + pr) * 1024; *(v4u*)(d + 8 * lane) = z; *(v4u*)(d + 512 + 8 * lane) = z; } }
    }
}
__device__ __forceinline__ void phase_moe_combine(const Args& args, int L) {
    int tid_ = threadIdx.x; asm volatile("" : "+v"(tid_)); const int tid = tid_, lane = tid & 63, wave = __builtin_amdgcn_readfirstlane(tid >> 6), G = gridDim.x, bid = blockIdx.x; (void)tid; (void)lane; (void)wave;
    unsigned char* ws = uni_ptr(args.ws); float* X = args.out; const bf16* Y = (const bf16*)(ws + WS_ACT + A_Y); bf16* H = (bf16*)(ws + WS_ACT + A_H);
    const int* SLOT = (const int*)(ws + WS_SLOT); const float* GATE = (const float*)(ws + WS_GATE); const float* MOD = (const float*)(ws + WS_MOD);
    for (int t = bid * NWAVES + wave; t < T; t += G * NWAVES) { const int b = t / SEQ;
        const int s0 = SLOT[(size_t)t * 2], s1 = SLOT[(size_t)t * 2 + 1]; const float g0 = GATE[(size_t)t * 2], g1 = GATE[(size_t)t * 2 + 1];
        const float* gf = MOD + (size_t)(L * 2 + b) * 6144 + 5120; f32x4 v[4];
#pragma unroll
        for (int j = 0; j < 4; ++j) { const int c = 4 * lane + 256 * j; const f32x4 x = *(const f32x4*)(X + (size_t)t * 1024 + c), gg = *(const f32x4*)(gf + c);
            const v2u y0 = *(const v2u*)(Y + (size_t)s0 * 1024 + c), y1 = *(const v2u*)(Y + (size_t)s1 * 1024 + c);
            f32x4 mo; mo[0] = g0 * bflo(y0.x) + g1 * bflo(y1.x); mo[1] = g0 * bfhi(y0.x) + g1 * bfhi(y1.x); mo[2] = g0 * bflo(y0.y) + g1 * bflo(y1.y); mo[3] = g0 * bfhi(y0.y) + g1 * bfhi(y1.y);
            v[j] = x + gg * mo; *(f32x4*)(X + (size_t)t * 1024 + c) = v[j]; }
        if (L < 3) { const float* m = MOD + (size_t)((L + 1) * 2 + b) * 6144; norm_store_row(v, args.in[LBASE(L + 1)], m, m + 1024, H + (size_t)t * 1024, lane); }
    }
}

constexpr int N_PHASES = 37;

#ifndef DUP_MASK
#define DUP_MASK 0
#endif
#define PHASE(k) if ((lo <= (k) && (k) < hi) && ((started ? (xcd_barrier(bar), 0) : 0), started = true, true))
#define NREP(g) (1 + ((DUP_MASK >> (g)) & 1))
#define PHASE_G(k, g) PHASE(k) for (int rep_ = 0; rep_ < NREP(g); ++rep_, ((rep_ < NREP(g)) ? (xcd_barrier(bar), 0) : 0))
template <int L> __device__ __forceinline__ void run_layer(const Args& args, LAS unsigned char* lds, const XcdBarrier& bar, bool& started, const int lo, const int hi) {
    const int G = gridDim.x, bid = blockIdx.x;
    unsigned char* ws = uni_ptr(args.ws);
    const float* MOD = (const float*)(ws + WS_MOD);
    bf16* Hb = (bf16*)(ws + WS_ACT + A_H);

        const int pb = (L == 0) ? 1 : (L == 1 ? 10 : (L == 2 ? 21 : 29));
        const float* xsrc = (L == 0) ? args.in[0] : (const float*)args.out;
        const float* gate_m = MOD + (size_t)L * 2 * 6144 + 2048;
        int mb;
        if constexpr (L == 0 || L == 3) {
            int g0 = pb;
            if (L == 0) { PHASE_G(pb, 8) { phase_norm0(args); } g0 = pb + 1; }
            const bf16* Win = (const bf16*)(ws + WS_WMIX + (L == 0 ? WMIX_GM_IN0 : WMIX_GM_IN3)); const bf16* Wout = (const bf16*)(ws + WS_WMIX + (L == 0 ? WMIX_GM_OUT0 : WMIX_GM_OUT3));
            PHASE_G(g0, 1) { pg8::Gemm g{Hb, Win, T, 2048, 1024}; pg8::StaticOrder S; S.init(T, 2048, G, bid);
                EpiGm1 E{(bf16*)(ws + WS_ACT + A_U), (bf16*)(ws + WS_ACT + A_V), (float*)(ws + WS_VSSP)};
                pg8::gemm_phase<EpiGm1, pg8::StaticOrder, true, true>(lds, g, S, E); }
            PHASE_G(g0 + 1, 2) { phase_gm_spatial(args, L, lds); }
            PHASE_G(g0 + 2, (L == 0 ? 1 : 31)) { pg8::Gemm g{(const bf16*)(ws + WS_ACT + A_GATED), Wout, T, 1024, 1024}; pg8::StaticOrder S; S.init(T, 1024, G, bid);
                EpiRes E{xsrc, args.out, gate_m};
                pg8::gemm_phase<EpiRes, pg8::StaticOrder, true, true>(lds, g, S, E); }
            mb = g0 + 3;
        } else if constexpr (L == 1) {
            PHASE_G(pb, 1) { pg8::Gemm g{Hb, (const bf16*)(ws + WS_WMIX + WMIX_DN_IN), T, 3328, 1024}; pg8::StaticOrder S; S.init(T, 3328, G, bid);
                EpiDn1 E{(bf16*)(ws + WS_ACT + A_QKV), (bf16*)(ws + WS_ACT + A_Z), (float*)(ws + WS_BA)};
                pg8::gemm_phase<EpiDn1, pg8::StaticOrder, true, true>(lds, g, S, E); }
            PHASE_G(pb + 1, 3) { phase_dn_prep(args); }
            PHASE_G(pb + 2, 4) { phase_dn_chunk(args, lds); }
            PHASE_G(pb + 3, 5) { phase_dn_scan(args, lds); }
            PHASE_G(pb + 4, 3) { phase_dn_ogate(args); }
            PHASE(pb + 5) { pg8::Gemm g{Hb, (const bf16*)(ws + WS_WMIX + WMIX_DN_OUT), T, 1024, 1024}; pg8::StaticOrder S; S.init(T, 1024, G, bid);
                EpiRes E{xsrc, args.out, gate_m};
                pg8::gemm_phase<EpiRes, pg8::StaticOrder, true, true>(lds, g, S, E); }
            mb = pb + 6;
        } else {
            PHASE_G(pb, 1) { pg8::Gemm g{Hb, (const bf16*)(ws + WS_WMIX + WMIX_SWA_IN), T, 1536, 1024}; pg8::StaticOrder S; S.init(T, 1536, G, bid);
                EpiBf E{(bf16*)(ws + WS_ACT + A_QKV), 1536, 0xffff};
                pg8::gemm_phase<EpiBf, pg8::StaticOrder, true, true>(lds, g, S, E); }
            PHASE_G(pb + 1, 2) { phase_swa_attn(args, lds); }
            PHASE(pb + 2) { pg8::Gemm g{Hb, (const bf16*)(ws + WS_WMIX + WMIX_SWA_OUT), T, 1024, 1024}; pg8::StaticOrder S; S.init(T, 1024, G, bid);
                EpiRes E{xsrc, args.out, gate_m};
                pg8::gemm_phase<EpiRes, pg8::StaticOrder, true, true>(lds, g, S, E); }
            mb = pb + 3;
        }
        PHASE_G(mb, 6) { phase_moe_router(args, L, lds); }
        PHASE_G(mb + 1, 6) { phase_moe_scatter(args, lds); }
        const int* TILEE = (const int*)(ws + WS_TILEE);
        PHASE_G(mb + 2, 7) { const int ntiles = TILEE[0]; pg8::Gemm g{(const bf16*)(ws + WS_ACT + A_XG), (const bf16*)(ws + WS_W + (size_t)L * 96 * MiB), MAXROWS, 1024, 1024};
            MoeOrder S; S.init(TILEE + 16, ntiles, G, bid); EpiMoe1 E{(bf16*)(ws + WS_ACT + A_ACTV)};
            pg8::gemm_phase<EpiMoe1, MoeOrder, true, true>(lds, g, S, E); }
        PHASE_G(mb + 3, 7) { const int ntiles = TILEE[0]; pg8::Gemm g{(const bf16*)(ws + WS_ACT + A_ACTV), (const bf16*)(ws + WS_W + (size_t)L * 96 * MiB + 64 * MiB), MAXROWS, 1024, 512};
            MoeOrder S; S.init(TILEE + 16, ntiles, G, bid); EpiBf E{(bf16*)(ws + WS_ACT + A_Y), 1024, 3};
            pg8::gemm_phase<EpiBf, MoeOrder, true, true>(lds, g, S, E); }
        PHASE(mb + 4) { phase_moe_combine(args, L); }

}
__global__ void __launch_bounds__(NTHR, 2) fwd_kernel(Args args) {
    extern __shared__ __attribute__((aligned(16))) unsigned char lds_raw[];
    LAS unsigned char* lds = (LAS unsigned char*)lds_raw;
    const int tid = threadIdx.x;
    unsigned char* ws = uni_ptr(args.ws);
    for (int u = tid; u < (LDS_BYTES - LDSCTL_OFF) / 4; u += NTHR) ((LAS unsigned*)(lds + LDSCTL_OFF))[u] = 0u;
    __syncthreads();
    volatile LAS unsigned* MISC = (volatile LAS unsigned*)(lds + MISC_OFF);
    XcdBarrier bar = xcd_barrier_post((unsigned*)(ws + WS_CTL) + 4096 + (size_t)args.li * XCD_BAR_WORDS, MISC + 8);
    const int lo = args.ph_lo, hi = args.ph_hi; bool started = false;
    const float* MOD = (const float*)(ws + WS_MOD);
    bf16* Hb = (bf16*)(ws + WS_ACT + A_H);

    PHASE_G(0, 0) { phase_prologue(args, lds); }

    run_layer<0>(args, lds, bar, started, lo, hi);
    run_layer<1>(args, lds, bar, started, lo, hi);
    run_layer<2>(args, lds, bar, started, lo, hi);
    run_layer<3>(args, lds, bar, started, lo, hi);
#undef PHASE
#undef PHASE_G
}

extern "C" void kernel_launch(void* const* d_in, const int* in_sizes, int n_in, void* d_out, int out_size, void* d_ws, size_t ws_size, hipStream_t stream) {
    static int grid = 0;
    if (grid == 0) {
        if (n_in != N_IN || in_sizes[0] != T * D || out_size != T * D || ws_size < WS_END) { fprintf(stderr, "kernel_launch: unexpected shapes (n_in %d, in0 %d, out %d, ws %zu < %zu)\n", n_in, n_in > 0 ? in_sizes[0] : -1, out_size, ws_size, (size_t)WS_END); grid = -1; return; }
        int dev = 0, cus = 0, per_cu = 0;
        if (hipGetDevice(&dev) != hipSuccess || hipDeviceGetAttribute(&cus, hipDeviceAttributeMultiprocessorCount, dev) != hipSuccess) { grid = -1; return; }
        if (hipFuncSetAttribute((const void*)fwd_kernel, hipFuncAttributeMaxDynamicSharedMemorySize, LDS_BYTES) != hipSuccess) { fprintf(stderr, "kernel_launch: hipFuncSetAttribute failed\n"); grid = -1; return; }
        if (hipOccupancyMaxActiveBlocksPerMultiprocessor(&per_cu, (const void*)fwd_kernel, NTHR, LDS_BYTES) != hipSuccess || per_cu < 1) fprintf(stderr, "kernel_launch: occupancy query reports %d\n", per_cu);
        (void)hipGetLastError();
        grid = cus;
    }
    if (grid < 0) return;
    if (hipMemsetAsync((char*)d_ws + WS_CTL, 0, CTL_ZERO_BYTES, stream) != hipSuccess) return;
    Args a{};
    for (int i = 0; i < N_IN; ++i) a.in[i] = (const float*)d_in[i];
    a.out = (float*)d_out; a.ws = (unsigned char*)d_ws; a.pad = 0;
#if MK_LAUNCH_MODE == 1
    a.ph_lo = 0; a.ph_hi = N_PHASES; a.li = 0;
    hipLaunchKernelGGL(fwd_kernel, dim3(grid), dim3(NTHR), LDS_BYTES, stream, a);
#else
    for (int p = 0; p < N_PHASES; ++p) { a.ph_lo = p; a.ph_hi = p + 1; a.li = 0;
        hipLaunchKernelGGL(fwd_kernel, dim3(grid), dim3(NTHR), LDS_BYTES, stream, a); }
#endif
}
```

```cpp
#include <hip/hip_runtime.h>
#include <cstdio>
#include <cstdint>
#ifndef MK_LAUNCH_MODE
#define MK_LAUNCH_MODE 1
#endif
namespace pg8 {
#define PG8_LAS __attribute__((address_space(3)))
typedef unsigned short bf16_t;
typedef short bf16x8 __attribute__((ext_vector_type(8)));
typedef float f32x4 __attribute__((ext_vector_type(4)));
typedef unsigned u32x4 __attribute__((ext_vector_type(4)));
constexpr int BM = 256, BK = 64, HALF = 128, HTB = HALF * BK * 2  , STAGE_BYTES = 8 * HTB, NXCD = 8, WGM = 8;

__host__ __device__ __forceinline__ int lds_byte(int r, int c) { const int st = (r >> 4) * 2 + (c >> 5), rr = r & 15, cc = c & 31, ob = rr * 64 + cc * 2; return st * 1024 + (ob ^ (((ob >> 9) & 1) << 5)); }
__host__ __device__ __forceinline__ void stage_rc(int b, int& R, int& C) { const int st = b / 1024, sb = b % 1024, swz = sb ^ (((sb >> 9) & 1) << 5); R = (st >> 1) * 16 + swz / 64; C = (st & 1) * 32 + (swz % 64) / 2; }
__host__ __device__ __forceinline__ int perm32(int rho) { const int n = rho >> 4, i = rho & 15; return 8 * (i >> 2) + 4 * n + (i & 3); }

struct Unit { int pm, pn; };
struct Gemm { const bf16_t* A; const bf16_t* Bt; int M, N, K; };

struct StaticOrder {
    int nM, nN, nwg, G, c;
    __host__ __device__ void init(int M, int N, int G_, int c_) { nM = M / BM; nN = N / BM; nwg = nM * nN; G = G_; c = c_; }
    __host__ __device__ bool next(int i, Unit& u) const {
        const long L = (long)i * G + c; if (L >= nwg) return false;
        int wgid = (int)L; { const int q = nwg / NXCD, r = nwg % NXCD, xcd = wgid % NXCD, off = wgid / NXCD; wgid = (xcd < r ? xcd * (q + 1) : r * (q + 1) + (xcd - r) * q) + off; }
        const int nig = WGM * nN, gid = wgid / nig, fm = gid * WGM, gsz = (nM - fm) < WGM ? (nM - fm) : WGM;
        u.pm = fm + ((wgid % nig) % gsz); u.pn = (wgid % nig) / gsz; return true;
    }
    __device__ __forceinline__ void a_ready(const Unit&) const {}
    __device__ __forceinline__ void done(const Unit&) const {}
};
typedef float f32x2_ __attribute__((ext_vector_type(2))); typedef __bf16 bf16x2_ __attribute__((ext_vector_type(2)));
__device__ __forceinline__ unsigned cvt_pk_bf16(float lo, float hi) { const f32x2_ v = {lo, hi}; return __builtin_bit_cast(unsigned, __builtin_convertvector(v, bf16x2_)); }
typedef float f32x2 __attribute__((ext_vector_type(2)));
template <class Epi, class Sched, bool ALIGN_EPI = false, bool SP2 = false>
__device__ __forceinline__ void gemm_phase(PG8_LAS unsigned char* lds, const Gemm g, const Sched& S, const Epi& E) {
    const int tid = threadIdx.x, wid = __builtin_amdgcn_readfirstlane(tid >> 6), lane = tid & 63, wr = wid >> 2, wc = wid & 3, fr = lane & 15, fq = lane >> 4;
    const int K = g.K, nt = K / BK;
    unsigned voffA[2], voffB[2];
#pragma unroll
    for (int i = 0; i < 2; ++i) { int R, C; stage_rc(tid * 16 + i * 8192, R, C); const int Rb = Epi::PERM ? ((R & ~31) + perm32(R & 31)) : R;
        voffA[i] = (unsigned)(R * K + C) * 2u; voffB[i] = (unsigned)(Rb * K + C) * 2u; }
    const size_t kstep = (size_t)(BK * 2);
    const size_t hstep = (size_t)HALF * K * 2;
    const size_t tstep = 2 * hstep;
    const unsigned ldsw = (unsigned)wid * 1024u;
    const int aoff = lds_byte(wr * 64 + fr, fq * 8), boff = lds_byte(wc * 32 + fr, fq * 8);
#define PG8_SA(b, h) (((b) * 2 + (h)) * HTB)
#define PG8_SB(b, h) ((4 + (b) * 2 + (h)) * HTB)
#define PG8_STAGE(bufoff, gbase, voff) do { _Pragma("unroll") for (int _i = 0; _i < 2; ++_i) \
        __builtin_amdgcn_global_load_lds((const unsigned*)((const char*)(gbase) + (voff)[_i]), (PG8_LAS unsigned*)(lds + (bufoff) + ldsw + _i * 8192), 16, 0, 0); } while (0)
#define PG8_LDA(dst, b, h) do { _Pragma("unroll") for (int m = 0; m < 4; ++m) _Pragma("unroll") for (int k = 0; k < 2; ++k) dst[m][k] = *(const PG8_LAS bf16x8*)(lds + PG8_SA(b, h) + aoff + m * 2048 + k * 1024); } while (0)
#define PG8_LDB(dst, b, h) do { _Pragma("unroll") for (int n = 0; n < 2; ++n) _Pragma("unroll") for (int k = 0; k < 2; ++k) dst[n][k] = *(const PG8_LAS bf16x8*)(lds + PG8_SB(b, h) + boff + n * 2048 + k * 1024); } while (0)
#define PG8_MMA(ai, bj, At, Bt) do { __builtin_amdgcn_s_setprio(1); _Pragma("unroll") for (int m = 0; m < 4; ++m) _Pragma("unroll") for (int n = 0; n < 2; ++n) _Pragma("unroll") for (int k = 0; k < 2; ++k) \
        acc[ai][bj][m][n] = __builtin_amdgcn_mfma_f32_16x16x32_bf16(Bt[n][k], At[m][k], acc[ai][bj][m][n], 0, 0, 0); __builtin_amdgcn_s_setprio(0); } while (0)
#define PG8_WAIT_V(n) asm volatile("s_waitcnt vmcnt(" #n ")" ::: "memory")
#define PG8_WAIT_L(n) asm volatile("s_waitcnt lgkmcnt(" #n ")" ::: "memory")
#define PG8_BAR __builtin_amdgcn_s_barrier()
#define PG8_SCHED __builtin_amdgcn_sched_barrier(0)
    Unit cur, nxt; int ui = 0;
    if (!S.next(0, cur)) return;
    f32x4 acc[2][2][4][2];
#pragma unroll
    for (int a = 0; a < 2; ++a)
#pragma unroll
        for (int b = 0; b < 2; ++b)
#pragma unroll
            for (int m = 0; m < 4; ++m)
#pragma unroll
                for (int n = 0; n < 2; ++n) acc[a][b][m][n] = (f32x4){0.f, 0.f, 0.f, 0.f};
    bf16x8 At[4][2], B0[2][2], B1[2][2];
    const char* cA = (const char*)g.A + (size_t)cur.pm * tstep; const char* cB = (const char*)g.Bt + (size_t)cur.pn * tstep;
    S.a_ready(cur);
    if constexpr (SP2) {
        PG8_STAGE(PG8_SB(0, 0), cB, voffB); PG8_STAGE(PG8_SB(0, 1), cB + hstep, voffB); PG8_STAGE(PG8_SA(0, 0), cA, voffA); PG8_STAGE(PG8_SA(0, 1), cA + hstep, voffA);
        if (wr == 1) PG8_BAR;
        PG8_WAIT_V(2); PG8_BAR;
        PG8_STAGE(PG8_SB(1, 0), cB + kstep, voffB); PG8_STAGE(PG8_SA(1, 0), cA + kstep, voffA); PG8_STAGE(PG8_SB(1, 1), cB + hstep + kstep, voffB);
        PG8_WAIT_V(6); PG8_BAR;
    } else {
        PG8_STAGE(PG8_SB(0, 0), cB, voffB); PG8_STAGE(PG8_SA(0, 0), cA, voffA); PG8_STAGE(PG8_SB(0, 1), cB + hstep, voffB); PG8_STAGE(PG8_SA(0, 1), cA + hstep, voffA);
        if (wr == 1) PG8_BAR;
        PG8_WAIT_V(4); PG8_BAR;
        PG8_STAGE(PG8_SB(1, 0), cB + kstep, voffB); PG8_STAGE(PG8_SA(1, 0), cA + kstep, voffA); PG8_STAGE(PG8_SB(1, 1), cB + hstep + kstep, voffB);
        PG8_WAIT_V(6); PG8_BAR;
    }
    for (;;) {
        const bool has_next = S.next(ui + 1, nxt);
        const char* nA = has_next ? (const char*)g.A + (size_t)nxt.pm * tstep : cA; const char* nB = has_next ? (const char*)g.Bt + (size_t)nxt.pn * tstep : cB;
        for (int t = 0; t < nt; t += 2) {
            const bool last = (t == nt - 2);
            const char* a1 = cA + (size_t)(t + 1) * kstep;
            const char* a2 = last ? nA : cA + (size_t)(t + 2) * kstep; const char* b2 = last ? nB : cB + (size_t)(t + 2) * kstep;
            const char* a3 = a2 + kstep; const char* b3 = b2 + kstep;
            if (last && has_next) S.a_ready(nxt);
            if constexpr (SP2) {
            PG8_LDB(B0, 0, 0); PG8_LDB(B1, 0, 1); PG8_SCHED; PG8_LDA(At, 0, 0); PG8_STAGE(PG8_SA(1, 1), a1 + hstep, voffA);
            PG8_WAIT_V(8); PG8_WAIT_L(0); PG8_BAR; PG8_MMA(0, 0, At, B0); PG8_MMA(0, 1, At, B1); PG8_BAR; PG8_SCHED;
            PG8_LDA(At, 0, 1); PG8_STAGE(PG8_SB(0, 0), b2, voffB); PG8_STAGE(PG8_SB(0, 1), b2 + hstep, voffB); PG8_STAGE(PG8_SA(0, 0), a2, voffA);
            PG8_WAIT_V(8); PG8_WAIT_L(0); PG8_BAR; PG8_MMA(1, 0, At, B0); PG8_MMA(1, 1, At, B1); PG8_BAR; PG8_SCHED;
            PG8_LDB(B0, 1, 0); PG8_LDB(B1, 1, 1); PG8_SCHED; PG8_LDA(At, 1, 0); PG8_STAGE(PG8_SA(0, 1), a2 + hstep, voffA);
            PG8_WAIT_V(8); PG8_WAIT_L(0); PG8_BAR; PG8_MMA(0, 0, At, B0); PG8_MMA(0, 1, At, B1); PG8_BAR; PG8_SCHED;
            PG8_LDA(At, 1, 1); PG8_STAGE(PG8_SB(1, 0), b3, voffB); PG8_STAGE(PG8_SB(1, 1), b3 + hstep, voffB); PG8_STAGE(PG8_SA(1, 0), a3, voffA);
            PG8_WAIT_V(8); PG8_WAIT_L(0); PG8_BAR; PG8_MMA(1, 0, At, B0); PG8_MMA(1, 1, At, B1); PG8_BAR; PG8_SCHED;
            } else {
            PG8_LDB(B0, 0, 0); PG8_SCHED; PG8_LDA(At, 0, 0); PG8_STAGE(PG8_SA(1, 1), a1 + hstep, voffA);
            PG8_WAIT_L(8); PG8_BAR; PG8_WAIT_L(0); PG8_MMA(0, 0, At, B0); PG8_BAR; PG8_SCHED;
            PG8_LDB(B1, 0, 1); PG8_STAGE(PG8_SB(0, 0), b2, voffB);
            PG8_BAR; PG8_WAIT_L(0); PG8_MMA(0, 1, At, B1); PG8_BAR;
            PG8_LDA(At, 0, 1); PG8_STAGE(PG8_SA(0, 0), a2, voffA);
            PG8_BAR; PG8_WAIT_L(0); PG8_MMA(1, 0, At, B0); PG8_BAR; PG8_SCHED;
            PG8_STAGE(PG8_SB(0, 1), b2 + hstep, voffB);
            PG8_WAIT_V(6); PG8_BAR; PG8_MMA(1, 1, At, B1); PG8_BAR;
            PG8_LDB(B0, 1, 0); PG8_SCHED; PG8_LDA(At, 1, 0); PG8_STAGE(PG8_SA(0, 1), a2 + hstep, voffA);
            PG8_WAIT_L(8); PG8_BAR; PG8_WAIT_L(0); PG8_MMA(0, 0, At, B0); PG8_BAR; PG8_SCHED;
            PG8_LDB(B1, 1, 1); PG8_STAGE(PG8_SB(1, 0), b3, voffB);
            PG8_BAR; PG8_WAIT_L(0); PG8_MMA(0, 1, At, B1); PG8_BAR;
            PG8_LDA(At, 1, 1); PG8_STAGE(PG8_SA(1, 0), a3, voffA);
            PG8_BAR; PG8_WAIT_L(0); PG8_MMA(1, 0, At, B0); PG8_BAR; PG8_SCHED;
            PG8_STAGE(PG8_SB(1, 1), b3 + hstep, voffB);
            PG8_WAIT_V(6); PG8_BAR; PG8_MMA(1, 1, At, B1); PG8_BAR;
            }
        }
        if constexpr (ALIGN_EPI) { if (wr == 0) PG8_BAR; }
        if constexpr (!Epi::AFTER_DRAIN) { E(acc, cur, wr, wc, fr, fq); S.done(cur); }
        if (!has_next) break;
#pragma unroll
        for (int a = 0; a < 2; ++a)
#pragma unroll
            for (int b = 0; b < 2; ++b)
#pragma unroll
                for (int m = 0; m < 4; ++m)
#pragma unroll
                    for (int n = 0; n < 2; ++n) acc[a][b][m][n] = (f32x4){0.f, 0.f, 0.f, 0.f};
        cur = nxt; cA = nA; cB = nB; ++ui;
        if constexpr (ALIGN_EPI) { if (wr == 1) PG8_BAR; }
    }
    PG8_WAIT_V(0);
    if constexpr (!ALIGN_EPI) { if (wr == 0) PG8_BAR; }
    PG8_BAR;
    if constexpr (Epi::AFTER_DRAIN) { E.fused(acc, cur, wr, wc, fr, fq, lds, wid, lane); S.done(cur); }
#undef PG8_SA
#undef PG8_SB
#undef PG8_STAGE
#undef PG8_LDA
#undef PG8_LDB
#undef PG8_MMA
#undef PG8_WAIT_V
#undef PG8_WAIT_L
#undef PG8_BAR
#undef PG8_SCHED
}

template <class Epi, class Sched, bool ALIGN_EPI = true, bool SP2 = true>
__device__ __forceinline__ void gemm_phase_gather(PG8_LAS unsigned char* lds, const Gemm g, const Sched& S, const Epi& E, const PG8_LAS int* lidx) {
    static_assert(SP2 && ALIGN_EPI, "gather variant: SP2 + ALIGN_EPI only");
    const int tid = threadIdx.x, wid = __builtin_amdgcn_readfirstlane(tid >> 6), lane = tid & 63, wr = wid >> 2, wc = wid & 3, fr = lane & 15, fq = lane >> 4;
    const int K = g.K, nt = K / BK;
    unsigned voffB[2]; int RA[2]; unsigned CA[2];
#pragma unroll
    for (int i = 0; i < 2; ++i) { int R, C; stage_rc(tid * 16 + i * 8192, R, C); const int Rb = Epi::PERM ? ((R & ~31) + perm32(R & 31)) : R;
        RA[i] = R; CA[i] = (unsigned)C * 2u; voffB[i] = (unsigned)(Rb * K + C) * 2u; }
    unsigned ca[2][2], na[2][2];
#define PG8_ROWOFF(dst, ui_) do { _Pragma("unroll") for (int h_ = 0; h_ < 2; ++h_) _Pragma("unroll") for (int i_ = 0; i_ < 2; ++i_) dst[h_][i_] = (unsigned)lidx[(ui_) * 256 + h_ * 128 + RA[i_]] * (unsigned)(K * 2) + CA[i_]; } while (0)
#define PG8_STAGEA(bufoff, kb, vo) do { _Pragma("unroll") for (int _i = 0; _i < 2; ++_i) \
        __builtin_amdgcn_global_load_lds((const unsigned*)((const char*)g.A + (size_t)(kb) + (vo)[_i]), (PG8_LAS unsigned*)(lds + (bufoff) + ldsw + _i * 8192), 16, 0, 0); } while (0)
    const size_t kstep = (size_t)(BK * 2);
    const size_t hstep = (size_t)HALF * K * 2;
    const size_t tstep = 2 * hstep;
    const unsigned ldsw = (unsigned)wid * 1024u;
    const int aoff = lds_byte(wr * 64 + fr, fq * 8), boff = lds_byte(wc * 32 + fr, fq * 8);
#define PG8_SA(b, h) (((b) * 2 + (h)) * HTB)
#define PG8_SB(b, h) ((4 + (b) * 2 + (h)) * HTB)
#define PG8_STAGE(bufoff, gbase, voff) do { _Pragma("unroll") for (int _i = 0; _i < 2; ++_i) \
        __builtin_amdgcn_global_load_lds((const unsigned*)((const char*)(gbase) + (voff)[_i]), (PG8_LAS unsigned*)(lds + (bufoff) + ldsw + _i * 8192), 16, 0, 0); } while (0)
#define PG8_LDA(dst, b, h) do { _Pragma("unroll") for (int m = 0; m < 4; ++m) _Pragma("unroll") for (int k = 0; k < 2; ++k) dst[m][k] = *(const PG8_LAS bf16x8*)(lds + PG8_SA(b, h) + aoff + m * 2048 + k * 1024); } while (0)
#define PG8_LDB(dst, b, h) do { _Pragma("unroll") for (int n = 0; n < 2; ++n) _Pragma("unroll") for (int k = 0; k < 2; ++k) dst[n][k] = *(const PG8_LAS bf16x8*)(lds + PG8_SB(b, h) + boff + n * 2048 + k * 1024); } while (0)
#define PG8_MMA(ai, bj, At, Bt) do { __builtin_amdgcn_s_setprio(1); _Pragma("unroll") for (int m = 0; m < 4; ++m) _Pragma("unroll") for (int n = 0; n < 2; ++n) _Pragma("unroll") for (int k = 0; k < 2; ++k) \
        acc[ai][bj][m][n] = __builtin_amdgcn_mfma_f32_16x16x32_bf16(Bt[n][k], At[m][k], acc[ai][bj][m][n], 0, 0, 0); __builtin_amdgcn_s_setprio(0); } while (0)
#define PG8_WAIT_V(n) asm volatile("s_waitcnt vmcnt(" #n ")" ::: "memory")
#define PG8_WAIT_L(n) asm volatile("s_waitcnt lgkmcnt(" #n ")" ::: "memory")
#define PG8_BAR __builtin_amdgcn_s_barrier()
#define PG8_SCHED __builtin_amdgcn_sched_barrier(0)
    Unit cur, nxt; int ui = 0;
    if (!S.next(0, cur)) return;
    f32x4 acc[2][2][4][2];
#pragma unroll
    for (int a = 0; a < 2; ++a)
#pragma unroll
        for (int b = 0; b < 2; ++b)
#pragma unroll
            for (int m = 0; m < 4; ++m)
#pragma unroll
                for (int n = 0; n < 2; ++n) acc[a][b][m][n] = (f32x4){0.f, 0.f, 0.f, 0.f};
    bf16x8 At[4][2], B0[2][2], B1[2][2];
    const char* cB = (const char*)g.Bt + (size_t)cur.pn * tstep; PG8_ROWOFF(ca, 0);
    S.a_ready(cur);
    if constexpr (SP2) {
        PG8_STAGE(PG8_SB(0, 0), cB, voffB); PG8_STAGE(PG8_SB(0, 1), cB + hstep, voffB); PG8_STAGEA(PG8_SA(0, 0), 0, ca[0]); PG8_STAGEA(PG8_SA(0, 1), 0, ca[1]);
        if (wr == 1) PG8_BAR;
        PG8_WAIT_V(2); PG8_BAR;
        PG8_STAGE(PG8_SB(1, 0), cB + kstep, voffB); PG8_STAGEA(PG8_SA(1, 0), kstep, ca[0]); PG8_STAGE(PG8_SB(1, 1), cB + hstep + kstep, voffB);
        PG8_WAIT_V(6); PG8_BAR;
    }
    for (;;) {
        const bool has_next = S.next(ui + 1, nxt);
        const char* nB = has_next ? (const char*)g.Bt + (size_t)nxt.pn * tstep : cB;
        if (has_next) PG8_ROWOFF(na, ui + 1); else { _Pragma("unroll") for (int h_ = 0; h_ < 2; ++h_) _Pragma("unroll") for (int i_ = 0; i_ < 2; ++i_) na[h_][i_] = ca[h_][i_]; }
        for (int t = 0; t < nt; t += 2) {
            const bool last = (t == nt - 2);
            const size_t k1 = (size_t)(t + 1) * kstep, k2 = last ? (size_t)0 : (size_t)(t + 2) * kstep, k3 = k2 + kstep;
            unsigned o2[2][2];
#pragma unroll
            for (int h_ = 0; h_ < 2; ++h_)
#pragma unroll
                for (int i_ = 0; i_ < 2; ++i_) o2[h_][i_] = last ? na[h_][i_] : ca[h_][i_];
            const char* b2 = last ? nB : cB + (size_t)(t + 2) * kstep; const char* b3 = b2 + kstep;
            if (last && has_next) S.a_ready(nxt);
            if constexpr (SP2) {
            PG8_LDB(B0, 0, 0); PG8_LDB(B1, 0, 1); PG8_SCHED; PG8_LDA(At, 0, 0); PG8_STAGEA(PG8_SA(1, 1), k1, ca[1]);
            PG8_WAIT_V(8); PG8_WAIT_L(0); PG8_BAR; PG8_MMA(0, 0, At, B0); PG8_MMA(0, 1, At, B1); PG8_BAR; PG8_SCHED;
            PG8_LDA(At, 0, 1); PG8_STAGE(PG8_SB(0, 0), b2, voffB); PG8_STAGE(PG8_SB(0, 1), b2 + hstep, voffB); PG8_STAGEA(PG8_SA(0, 0), k2, o2[0]);
            PG8_WAIT_V(8); PG8_WAIT_L(0); PG8_BAR; PG8_MMA(1, 0, At, B0); PG8_MMA(1, 1, At, B1); PG8_BAR; PG8_SCHED;
            PG8_LDB(B0, 1, 0); PG8_LDB(B1, 1, 1); PG8_SCHED; PG8_LDA(At, 1, 0); PG8_STAGEA(PG8_SA(0, 1), k2, o2[1]);
            PG8_WAIT_V(8); PG8_WAIT_L(0); PG8_BAR; PG8_MMA(0, 0, At, B0); PG8_MMA(0, 1, At, B1); PG8_BAR; PG8_SCHED;
            PG8_LDA(At, 1, 1); PG8_STAGE(PG8_SB(1, 0), b3, voffB); PG8_STAGE(PG8_SB(1, 1), b3 + hstep, voffB); PG8_STAGEA(PG8_SA(1, 0), k3, o2[0]);
            PG8_WAIT_V(8); PG8_WAIT_L(0); PG8_BAR; PG8_MMA(1, 0, At, B0); PG8_MMA(1, 1, At, B1); PG8_BAR; PG8_SCHED;
            }
        }
        if constexpr (ALIGN_EPI) { if (wr == 0) PG8_BAR; }
        if constexpr (!Epi::AFTER_DRAIN) { E(acc, cur, wr, wc, fr, fq); S.done(cur); }
        if (!has_next) break;
#pragma unroll
        for (int a = 0; a < 2; ++a)
#pragma unroll
            for (int b = 0; b < 2; ++b)
#pragma unroll
                for (int m = 0; m < 4; ++m)
#pragma unroll
                    for (int n = 0; n < 2; ++n) acc[a][b][m][n] = (f32x4){0.f, 0.f, 0.f, 0.f};
        cur = nxt; cB = nB; ++ui;
        { _Pragma("unroll") for (int h_ = 0; h_ < 2; ++h_) _Pragma("unroll") for (int i_ = 0; i_ < 2; ++i_) ca[h_][i_] = na[h_][i_]; }
        if constexpr (ALIGN_EPI) { if (wr == 1) PG8_BAR; }
    }
    PG8_WAIT_V(0);
    if constexpr (!ALIGN_EPI) { if (wr == 0) PG8_BAR; }
    PG8_BAR;
    if constexpr (Epi::AFTER_DRAIN) { E.fused(acc, cur, wr, wc, fr, fq, lds, wid, lane); S.done(cur); }
#undef PG8_SA
#undef PG8_ROWOFF
#undef PG8_STAGEA
#undef PG8_SB
#undef PG8_STAGE
#undef PG8_LDA
#undef PG8_LDB
#undef PG8_MMA
#undef PG8_WAIT_V
#undef PG8_WAIT_L
#undef PG8_BAR
#undef PG8_SCHED
}
}

constexpr int NB = 2, SEQ = 16384, T = NB * SEQ, D = 1024;
constexpr float EPS = 1e-6f;
constexpr int NWAVES = 8, NTHR = 512;
constexpr int N_IN = 55;
__host__ __device__ constexpr int LBASE(int L) { return L == 0 ? 2 : (L == 1 ? 15 : (L == 2 ? 29 : 42)); }
__host__ __device__ constexpr int NMIX(int L) { return L == 1 ? 6 : 5; }

constexpr size_t MiB = 1u << 20;
constexpr size_t WS_CTL = 0, CTL_ZERO_BYTES = 1 * MiB;
constexpr size_t WS_MOD = 1 * MiB;
constexpr size_t WS_CNT = WS_MOD + 256 * 1024;
constexpr size_t WS_TILEE = WS_CNT + 64 * 1024;
constexpr size_t WS_EID = 2 * MiB;
constexpr size_t WS_GATE = WS_EID + 256 * 1024;
constexpr size_t WS_SLOT = WS_GATE + 256 * 1024;
constexpr size_t WS_VSSP = 3 * MiB;
constexpr size_t WS_BA = 5 * MiB;
constexpr size_t WS_DNB = 7 * MiB;
constexpr size_t WS_RTR = 9 * MiB;
constexpr size_t WS_TOK = 12 * MiB;
constexpr size_t WS_W = 16 * MiB;
constexpr size_t WS_WMIX = WS_W + 384 * MiB;
constexpr size_t WMIX_GM_IN0 = 0, WMIX_GM_OUT0 = 4 * MiB, WMIX_DN_IN = 6 * MiB, WMIX_DN_OUT = 13 * MiB, WMIX_SWA_IN = 15 * MiB, WMIX_SWA_OUT = 18 * MiB, WMIX_GM_IN3 = 20 * MiB, WMIX_GM_OUT3 = 24 * MiB;
constexpr size_t WS_ACT = 432 * MiB;
constexpr size_t A_H = 0;
constexpr size_t A_U = 64 * MiB, A_V = 128 * MiB, A_GATED = 192 * MiB;
constexpr size_t A_QKV = 64 * MiB, A_Z = 192 * MiB, A_QN = 256 * MiB, A_KN = 288 * MiB, A_VV = 320 * MiB, A_FA = 384 * MiB, A_FB = 484 * MiB, A_FU = 64 * MiB, A_O = 128 * MiB;
constexpr size_t A_XG = 64 * MiB, A_ACTV = 208 * MiB, A_Y = 280 * MiB;
constexpr size_t WS_END = WS_ACT + 548 * MiB;
constexpr int MAXROWS = 73728;

constexpr int RING_BYTES = 131072;
constexpr int LDSCTL_OFF = RING_BYTES, MISC_OFF = LDSCTL_OFF + 320;
constexpr int LDS_BYTES = 147456;

#define LAS __attribute__((address_space(3)))
typedef unsigned short bf16;
typedef unsigned v4u __attribute__((ext_vector_type(4)));
typedef unsigned v2u __attribute__((ext_vector_type(2)));
typedef float f32x4 __attribute__((ext_vector_type(4)));
typedef short bf16x8 __attribute__((ext_vector_type(8)));
typedef short bf16x4 __attribute__((ext_vector_type(4)));
#define LDS_WAIT() asm volatile("s_waitcnt lgkmcnt(0)" ::: "memory")
#define VM_WAIT() asm volatile("s_waitcnt vmcnt(0)" ::: "memory")
__device__ __forceinline__ unsigned pk2(float lo, float hi) { return pg8::cvt_pk_bf16(lo, hi); }
__device__ __forceinline__ float bflo(unsigned w) { return __uint_as_float(w << 16); }
__device__ __forceinline__ float bfhi(unsigned w) { return __uint_as_float(w & 0xffff0000u); }
__device__ __forceinline__ float bf1(unsigned short b) { return __uint_as_float(((unsigned)b) << 16); }
__device__ __forceinline__ float wave_sum(float v) {
#pragma unroll
    for (int o = 1; o < 64; o <<= 1) v += __shfl_xor(v, o);
    return v;
}
__device__ __forceinline__ float fast_exp(float x) { return __builtin_amdgcn_exp2f(x * 1.44269504089f); }
__device__ __forceinline__ float sigmoidf_(float x) { return __builtin_amdgcn_rcpf(1.0f + fast_exp(-x)); }
__device__ __forceinline__ float siluf_(float x) { return x * sigmoidf_(x); }
__device__ __forceinline__ float gelu_tanh(float x) { const float y = 1.5957691216057308f * (x + 0.044715f * x * x * x); return x * __builtin_amdgcn_rcpf(1.0f + fast_exp(-y)); }

#define RLX_AGENT __ATOMIC_RELAXED, __HIP_MEMORY_SCOPE_AGENT
__device__ __forceinline__ unsigned char* uni_ptr(unsigned char* p) { const unsigned long long w = (unsigned long long)p; const unsigned lo = __builtin_amdgcn_readfirstlane((unsigned)w), hi = __builtin_amdgcn_readfirstlane((unsigned)(w >> 32)); return (unsigned char*)(__attribute__((address_space(1))) unsigned char*)(((unsigned long long)hi << 32) | lo); }
#define XB_TMO      128
#define XB_XCNT(j)  (256  + 64 * (j))
#define XB_XSUB(j)  (1280 + 64 * (j))
#define XB_XGEN(j)  (2304 + 64 * (j))
#define XB_TOP      3328
#define XB_TOPGEN   3392
#define XCD_BAR_WORDS 3456
#define XB_SPIN_CAP (1u << 18)

__device__ __forceinline__ unsigned xb_ld(unsigned* p)              { return __hip_atomic_load(p, __ATOMIC_RELAXED, __HIP_MEMORY_SCOPE_AGENT); }
__device__ __forceinline__ unsigned xb_add(unsigned* p, unsigned v) { return __hip_atomic_fetch_add(p, v, __ATOMIC_RELAXED, __HIP_MEMORY_SCOPE_AGENT); }
__device__ __forceinline__ unsigned xb_xcc_id() { return (unsigned)__builtin_amdgcn_s_getreg((3 << 11) | 20) & 0xFu; }
#define XB_SPIN(cond, bar) do { unsigned _sp = 0; while (cond) { __builtin_amdgcn_s_sleep(1); \
    if ((++_sp & 255u) == 0u) { if (xb_ld(&(bar)[XB_TMO])) break; if (_sp > XB_SPIN_CAP) { atomicAdd(&(bar)[XB_TMO], 1u); break; } } } } while (0)

struct XcdBarrier {
    unsigned* bar; unsigned x;
    volatile LAS unsigned* st;
};

__device__ __forceinline__ XcdBarrier xcd_barrier_post(unsigned* bar, volatile LAS unsigned* st) {
    XcdBarrier b; b.bar = bar; b.x = xb_xcc_id(); b.st = st;
    if (threadIdx.x == 0) (void)xb_add(&bar[XB_XCNT(b.x)], 1u);
    return b;
}
__device__ __forceinline__ void xcd_barrier_complete(unsigned* bar, unsigned x, unsigned& nloc, unsigned& nx) {
    const unsigned G = gridDim.x * gridDim.y * gridDim.z;
    unsigned sum, cnt, mine, sp = 0u;
    for (;;) {
        sum = 0u; cnt = 0u; mine = 0u;
#pragma unroll
        for (unsigned j = 0; j < 16; ++j) { const unsigned c = xb_ld(&bar[XB_XCNT(j)]); sum += c; cnt += (c > 0u) ? 1u : 0u; mine = (j == x) ? c : mine; }
        if (sum == G) break;
        __builtin_amdgcn_s_sleep(1);
        if ((++sp & 255u) == 0u) { if (xb_ld(&bar[XB_TMO])) break; if (sp > XB_SPIN_CAP) { atomicAdd(&bar[XB_TMO], 1u); break; } }
    }
    nloc = mine > 0u ? mine : 1u; nx = cnt > 0u ? cnt : 1u;
}

__device__ __forceinline__ void xcd_barrier(const XcdBarrier& b) {
    asm volatile("s_waitcnt vmcnt(0)" ::: "memory");
    __syncthreads();
    if (threadIdx.x == 0) {
        unsigned* bar = b.bar;
        __builtin_amdgcn_s_waitcnt(0);
        unsigned nloc = b.st[0], nx = b.st[1];
        if (nloc == 0u) { xcd_barrier_complete(bar, b.x, nloc, nx); b.st[0] = nloc; b.st[1] = nx; }
        const unsigned old = xb_add(&bar[XB_XSUB(b.x)], 1u);
        const unsigned gen = old / nloc;
        if (old + 1u == (gen + 1u) * nloc) {
            __builtin_amdgcn_fence(__ATOMIC_RELEASE, "agent");
            asm volatile("s_waitcnt vmcnt(0)" ::: "memory");
            const unsigned og = xb_add(&bar[XB_TOP], 1u);
            const unsigned tg = og / nx;
            if (og + 1u == (tg + 1u) * nx) xb_add(&bar[XB_TOPGEN], 1u);
            else XB_SPIN(xb_ld(&bar[XB_TOPGEN]) == tg, bar);
            __builtin_amdgcn_fence(__ATOMIC_ACQUIRE, "agent");
            xb_add(&bar[XB_XGEN(b.x)], 1u);
            asm volatile("s_waitcnt vmcnt(0)" ::: "memory");
        } else {
            XB_SPIN(xb_ld(&bar[XB_XGEN(b.x)]) == gen, bar);
            __builtin_amdgcn_fence(__ATOMIC_ACQUIRE, "agent");
            asm volatile("s_waitcnt vmcnt(0)" ::: "memory");
        }
    }
    __syncthreads();
}

typedef const pg8::f32x4 (&AccRef)[2][2][4][2];

struct EpiGm1 {
    static constexpr bool PERM = true, AFTER_DRAIN = false;
    bf16* U; bf16* V; float* vssp;
    __device__ __forceinline__ void operator()(AccRef acc, const pg8::Unit& u, int wr, int wc, int fr, int fq) const {
        const int row0 = u.pm * 256 + wr * 64 + fr; const bool isV = u.pn >= 4; const int col0 = (u.pn & 3) * 256 + wc * 32 + 8 * fq;
        bf16* base = isV ? V : U;
#pragma unroll
        for (int ai = 0; ai < 2; ++ai)
#pragma unroll
            for (int m = 0; m < 4; ++m) { const int row = row0 + ai * 128 + m * 16; bf16* rowp = base + (size_t)row * 1024 + col0; float ss = 0.f;
#pragma unroll
                for (int bj = 0; bj < 2; ++bj) { f32x4 v0 = acc[ai][bj][m][0], v1 = acc[ai][bj][m][1];
#pragma unroll
                    for (int j = 0; j < 4; ++j) { v0[j] = gelu_tanh(v0[j]); v1[j] = gelu_tanh(v1[j]); ss += v0[j] * v0[j] + v1[j] * v1[j]; }
                    v4u w; w.x = pk2(v0[0], v0[1]); w.y = pk2(v0[2], v0[3]); w.z = pk2(v1[0], v1[1]); w.w = pk2(v1[2], v1[3]);
                    *(v4u*)(rowp + bj * 128) = w; }
                if (isV) { ss += __shfl_xor(ss, 16); ss += __shfl_xor(ss, 32); if (fq == 0) vssp[(size_t)row * 16 + (u.pn - 4) * 4 + wc] = ss; } }
    }
};
struct EpiRes {
    static constexpr bool PERM = false, AFTER_DRAIN = false;
    const float* src; float* dst; const float* gate;
    __device__ __forceinline__ void operator()(AccRef acc, const pg8::Unit& u, int wr, int wc, int fr, int fq) const {
        const int row0 = u.pm * 256 + wr * 64 + fr, col0 = u.pn * 256 + wc * 32 + 4 * fq; const int b = (u.pm * 256) / SEQ;
        f32x4 gv[2][2];
#pragma unroll
        for (int bj = 0; bj < 2; ++bj)
#pragma unroll
            for (int n = 0; n < 2; ++n) gv[bj][n] = *(const f32x4*)(gate + (size_t)b * 6144 + col0 + bj * 128 + n * 16);
#pragma unroll
        for (int ai = 0; ai < 2; ++ai)
#pragma unroll
            for (int m = 0; m < 4; ++m) { const size_t off = (size_t)(row0 + ai * 128 + m * 16) * 1024 + col0;
#pragma unroll
                for (int bj = 0; bj < 2; ++bj)
#pragma unroll
                    for (int n = 0; n < 2; ++n) { const f32x4 xs = *(const f32x4*)(src + off + bj * 128 + n * 16); *(f32x4*)(dst + off + bj * 128 + n * 16) = xs + gv[bj][n] * acc[ai][bj][m][n]; } }
    }
};
struct EpiBf {
    static constexpr bool PERM = true, AFTER_DRAIN = false;
    bf16* O; int ldc; int nmask;
    __device__ __forceinline__ void operator()(AccRef acc, const pg8::Unit& u, int wr, int wc, int fr, int fq) const {
        const int row0 = u.pm * 256 + wr * 64 + fr, col0 = (u.pn & nmask) * 256 + wc * 32 + 8 * fq;
#pragma unroll
        for (int ai = 0; ai < 2; ++ai)
#pragma unroll
            for (int m = 0; m < 4; ++m) { bf16* rowp = O + (size_t)(row0 + ai * 128 + m * 16) * ldc + col0;
#pragma unroll
                for (int bj = 0; bj < 2; ++bj) { const f32x4 v0 = acc[ai][bj][m][0], v1 = acc[ai][bj][m][1];
                    v4u w; w.x = pk2(v0[0], v0[1]); w.y = pk2(v0[2], v0[3]); w.z = pk2(v1[0], v1[1]); w.w = pk2(v1[2], v1[3]);
                    *(v4u*)(rowp + bj * 128) = w; } }
    }
};
struct EpiDn1 {
    static constexpr bool PERM = true, AFTER_DRAIN = false;
    bf16* QKV; bf16* Z; float* BA;
    __device__ __forceinline__ void operator()(AccRef acc, const pg8::Unit& u, int wr, int wc, int fr, int fq) const {
        const int row0 = u.pm * 256 + wr * 64 + fr;
        if (u.pn < 12) {
            bf16* base = u.pn < 8 ? QKV : Z; const int ldc = u.pn < 8 ? 2048 : 1024; const int col0 = (u.pn < 8 ? u.pn : u.pn - 8) * 256 + wc * 32 + 8 * fq;
#pragma unroll
            for (int ai = 0; ai < 2; ++ai)
#pragma unroll
                for (int m = 0; m < 4; ++m) { bf16* rowp = base + (size_t)(row0 + ai * 128 + m * 16) * ldc + col0;
#pragma unroll
                    for (int bj = 0; bj < 2; ++bj) { const f32x4 v0 = acc[ai][bj][m][0], v1 = acc[ai][bj][m][1];
                        v4u w; w.x = pk2(v0[0], v0[1]); w.y = pk2(v0[2], v0[3]); w.z = pk2(v1[0], v1[1]); w.w = pk2(v1[2], v1[3]);
                        *(v4u*)(rowp + bj * 128) = w; } }
        } else if (wc == 0 && fq < 2) {
#pragma unroll
            for (int ai = 0; ai < 2; ++ai)
#pragma unroll
                for (int m = 0; m < 4; ++m) { float* rowp = BA + (size_t)(row0 + ai * 128 + m * 16) * 16 + 8 * fq;
                    *(f32x4*)(rowp) = acc[ai][0][m][0]; *(f32x4*)(rowp + 4) = acc[ai][0][m][1]; }
        }
    }
};
struct EpiMoe1 {
    static constexpr bool PERM = true, AFTER_DRAIN = false;
    bf16* O;
    __device__ __forceinline__ void operator()(AccRef acc, const pg8::Unit& u, int wr, int wc, int fr, int fq) const {
        const int row0 = u.pm * 256 + wr * 64 + fr, col0 = (u.pn & 3) * 128 + wc * 32 + 8 * fq;
#pragma unroll
        for (int ai = 0; ai < 2; ++ai)
#pragma unroll
            for (int m = 0; m < 4; ++m) { bf16* rowp = O + (size_t)(row0 + ai * 128 + m * 16) * 512 + col0; float r[8];
#pragma unroll
                for (int n = 0; n < 2; ++n)
#pragma unroll
                    for (int j = 0; j < 4; ++j) { const float a = acc[ai][0][m][n][j], g = acc[ai][1][m][n][j]; r[4 * n + j] = siluf_(a) * g; }
                v4u w; w.x = pk2(r[0], r[1]); w.y = pk2(r[2], r[3]); w.z = pk2(r[4], r[5]); w.w = pk2(r[6], r[7]);
                *(v4u*)rowp = w; }
    }
};
struct MoeOrder {
    const int* tile_e; int total, G, c;
    __device__ __forceinline__ void init(const int* te, int ntiles, int G_, int c_) { tile_e = te; total = ntiles * 4; G = G_; c = c_; }
    __device__ __forceinline__ bool next(int i, pg8::Unit& u) const {
        const long Lx = (long)i * G + c; if (Lx >= total) return false;
        const int w0 = (int)Lx, q = total / 8, r = total % 8, xcd = w0 % 8, off = w0 / 8;
        const int wgid = (xcd < r ? xcd * (q + 1) : r * (q + 1) + (xcd - r) * q) + off;
        const int rt = wgid >> 2; u.pm = rt; u.pn = tile_e[rt] * 4 + (wgid & 3); return true;
    }
    __device__ __forceinline__ void a_ready(const pg8::Unit&) const {}
    __device__ __forceinline__ void done(const pg8::Unit&) const {}
};

struct Args { const float* in[N_IN]; float* out; unsigned char* ws; int ph_lo, ph_hi, li, pad; };

__device__ __forceinline__ void tr_item(const float* __restrict__ W, int ldn, int k0, int n0, bf16* __restrict__ WT, int Kd, int drow0, LAS float* scr, int lane) {
#pragma unroll 8
    for (int i = 0; i < 32; ++i) { const int kk = 2 * i + (lane >> 5); scr[kk * 33 + (lane & 31)] = W[(size_t)(k0 + kk) * ldn + n0 + (lane & 31)]; }
    LDS_WAIT(); asm volatile("" ::: "memory");
    const int c = lane & 7;
#pragma unroll
    for (int j = 0; j < 4; ++j) { const int n = (lane >> 3) + 8 * j; const LAS float* s = scr + (8 * c) * 33 + n;
        v4u o; o.x = pk2(s[0 * 33], s[1 * 33]); o.y = pk2(s[2 * 33], s[3 * 33]); o.z = pk2(s[4 * 33], s[5 * 33]); o.w = pk2(s[6 * 33], s[7 * 33]);
        *(v4u*)(WT + (size_t)(drow0 + n) * Kd + k0 + 8 * c) = o; }
    LDS_WAIT(); asm volatile("" ::: "memory");
}

constexpr int CV_PER_L = 24576, CV_N_EXP = 4 * CV_PER_L, CV_MIX_L01 = 3584, CV_N_MIXI = 1536 + 2048 + 1280 + 1536;
struct CvItem { const float* src; bf16* dst; int ldn, Kd; };
__device__ __forceinline__ CvItem cv_decode(const Args& args, unsigned char* ws, int it) {
    CvItem c; const float* src; bf16* dst; int ldn, k0, n0, Kd, drow0;
    constexpr int PER_L = CV_PER_L, N_EXP = CV_N_EXP;
    if (it < N_EXP) {
        const int L = it / PER_L; int r = it % PER_L; const int ib = LBASE(L) + 4 + NMIX(L);
        if (r < 16384) { const int e = r >> 9, rr = r & 511; k0 = (rr >> 5) * 64; n0 = (rr & 31) * 32; ldn = 1024; Kd = 1024;
            src = args.in[ib + 2] + (size_t)e * 1048576; dst = (bf16*)(ws + WS_W + (size_t)L * 96 * MiB) + (size_t)e * 1048576;
            drow0 = (n0 < 512) ? ((n0 >> 7) * 256 + (n0 & 127)) : ((((n0 - 512) >> 7) * 256) + 128 + ((n0 - 512) & 127)); }
        else { r -= 16384; const int e = r >> 8, rr = r & 255; k0 = (rr >> 5) * 64; n0 = (rr & 31) * 32; ldn = 1024; Kd = 512;
            src = args.in[ib + 3] + (size_t)e * 524288; dst = (bf16*)(ws + WS_W + (size_t)L * 96 * MiB + 64 * MiB) + (size_t)e * 524288; drow0 = n0; }
    } else {
        int r = it - N_EXP; int idx, nblk; size_t woff;
        if (r < 1024) { idx = 6; ldn = 2048; nblk = 64; woff = WMIX_GM_IN0; }
        else if ((r -= 1024) < 512) { idx = 10; ldn = 1024; nblk = 32; woff = WMIX_GM_OUT0; }
        else if ((r -= 512) < 1536) { idx = 19; ldn = 3088; nblk = 96; woff = WMIX_DN_IN; }
        else if ((r -= 1536) < 512) { idx = 24; ldn = 1024; nblk = 32; woff = WMIX_DN_OUT; }
        else if ((r -= 512) < 768) { idx = 33; ldn = 1536; nblk = 48; woff = WMIX_SWA_IN; }
        else if ((r -= 768) < 512) { idx = 37; ldn = 1024; nblk = 32; woff = WMIX_SWA_OUT; }
        else if ((r -= 512) < 1024) { idx = 46; ldn = 2048; nblk = 64; woff = WMIX_GM_IN3; }
        else { r -= 1024; idx = 50; ldn = 1024; nblk = 32; woff = WMIX_GM_OUT3; }
        src = args.in[idx]; dst = (bf16*)(ws + WS_WMIX + woff); k0 = (r / nblk) * 64; n0 = (r % nblk) * 32; Kd = 1024; drow0 = n0;
    }
    c.src = src + (size_t)k0 * ldn + n0; c.dst = dst + (size_t)drow0 * Kd + k0; c.ldn = ldn; c.Kd = Kd; return c;
}
__device__ __forceinline__ void cv_load(const CvItem& c, f32x4 (&v)[8], int lane) {
    const float* p = c.src + (size_t)(lane >> 3) * c.ldn + 4 * (lane & 7);
#pragma unroll
    for (int i = 0; i < 8; ++i) v[i] = *(const f32x4*)(p + (size_t)(8 * i) * c.ldn);
}
__device__ __forceinline__ void cv_store(const CvItem& c, const f32x4 (&v)[8], LAS float* scr, int lane) {
    const int kr = lane >> 3, n4 = 4 * (lane & 7);
#pragma unroll
    for (int i = 0; i < 8; ++i) { LAS float* q = scr + (kr + 8 * i) * 33 + n4; q[0] = v[i][0]; q[1] = v[i][1]; q[2] = v[i][2]; q[3] = v[i][3]; }
    LDS_WAIT(); asm volatile("" ::: "memory");
    const int ck = lane & 7;
#pragma unroll
    for (int j = 0; j < 4; ++j) { const int n = (lane >> 3) + 8 * j; const LAS float* s = scr + (8 * ck) * 33 + n;
        v4u o; o.x = pk2(s[0 * 33], s[1 * 33]); o.y = pk2(s[2 * 33], s[3 * 33]); o.z = pk2(s[4 * 33], s[5 * 33]); o.w = pk2(s[6 * 33], s[7 * 33]);
        *(v4u*)(c.dst + (size_t)n * c.Kd + 8 * ck) = o; }
    LDS_WAIT(); asm volatile("" ::: "memory");
}
__device__ __forceinline__ void convert_weights(const Args& args, LAS unsigned char* lds, int it_lo, int it_hi, int gw, int NGW) {
    int tid_ = threadIdx.x; asm volatile("" : "+v"(tid_)); const int lane = tid_ & 63, wave = __builtin_amdgcn_readfirstlane(tid_ >> 6);
    unsigned char* ws = uni_ptr(args.ws);
    LAS float* scr = (LAS float*)(lds + wave * 8448);
    for (int it = it_lo + gw; it < it_hi; it += 2 * NGW) {
        const int it2 = it + NGW; const bool two = it2 < it_hi;
        const CvItem c0 = cv_decode(args, ws, it), c1 = cv_decode(args, ws, two ? it2 : it);
        f32x4 v0[8], v1[8];
        cv_load(c0, v0, lane); if (two) cv_load(c1, v1, lane);
        cv_store(c0, v0, scr, lane); if (two) cv_store(c1, v1, scr, lane);
    }
}
__device__ __forceinline__ void phase_prologue(const Args& args, LAS unsigned char* lds) {
    int tid_ = threadIdx.x; asm volatile("" : "+v"(tid_)); const int tid = tid_, lane = tid & 63, wave = __builtin_amdgcn_readfirstlane(tid >> 6), G = gridDim.x, bid = blockIdx.x; (void)tid; (void)lane; (void)wave;
    unsigned char* ws = uni_ptr(args.ws);
    LAS float* cact = (LAS float*)(lds + 69632);
    LAS float* red = (LAS float*)(lds + 77824);
    for (int k = tid; k < 2048; k += NTHR) cact[k] = siluf_(args.in[1][k]);
    __syncthreads();
    float* MOD = (float*)(ws + WS_MOD);
    for (int item = bid; item < 384; item += G) {
        const int L = item / 96, cg = item % 96, c4 = tid & 15, ks = tid >> 4;
        const float* w = args.in[LBASE(L) + 2] + (size_t)(ks * 32) * 6144 + cg * 64 + c4 * 4;
        f32x4 a0 = {0.f, 0.f, 0.f, 0.f}, a1 = {0.f, 0.f, 0.f, 0.f};
#pragma unroll 8
        for (int kk = 0; kk < 32; ++kk) { const f32x4 wv = *(const f32x4*)(w + (size_t)kk * 6144); a0 += cact[ks * 32 + kk] * wv; a1 += cact[1024 + ks * 32 + kk] * wv; }
        *(LAS f32x4*)(red + (ks * 2 + 0) * 64 + c4 * 4) = a0; *(LAS f32x4*)(red + (ks * 2 + 1) * 64 + c4 * 4) = a1;
        __syncthreads();
        if (tid < 128) { const int b = tid >> 6, col = tid & 63; float s = 0.f;
#pragma unroll
            for (int k2 = 0; k2 < 32; ++k2) s += red[(k2 * 2 + b) * 64 + col];
            MOD[(size_t)(L * 2 + b) * 6144 + cg * 64 + col] = s + args.in[LBASE(L) + 3][cg * 64 + col]; }
        __syncthreads();
    }
    { const int gw = bid * NWAVES + wave, NGW = G * NWAVES;
      if (G > 128) { convert_weights(args, lds, 0, CV_PER_L, gw, NGW); convert_weights(args, lds, CV_N_EXP, CV_N_EXP + CV_MIX_L01, gw, NGW); }
      else convert_weights(args, lds, 0, CV_N_EXP + CV_N_MIXI, gw, NGW); }
    const int gt = bid * NTHR + tid, NGT = G * NTHR;
    { bf16* dst = (bf16*)(ws + WS_WMIX + WMIX_DN_IN) + (size_t)3072 * 1024; const float* w = args.in[19];
      for (int i = gt; i < 256 * 1024; i += NGT) { const int n = i >> 10, k = i & 1023; const float v = n < 16 ? w[(size_t)k * 3088 + 3072 + n] : 0.f; dst[i] = (bf16)(pk2(v, 0.f) & 0xffffu); } }
    for (int i = gt; i < 4 * 48 * 1024; i += NGT) {
        const int L = i / 49152, rem = i % 49152, n = rem >> 10, k = rem & 1023;
        const float w = n < 36 ? args.in[LBASE(L) + 4 + NMIX(L)][(size_t)k * 36 + n] : 0.f;
        const unsigned hi = pk2(w, 0.f) & 0xffffu; const float lo = w - bf1((unsigned short)hi);
        bf16* RH = (bf16*)(ws + WS_RTR + (size_t)L * 196608); RH[rem] = (bf16)hi; RH[49152 + rem] = (bf16)(pk2(lo, 0.f) & 0xffffu);
    }
}

__device__ __forceinline__ void norm_store_row(const f32x4 (&v)[4], const float* __restrict__ gain, const float* __restrict__ shift, const float* __restrict__ scale, bf16* __restrict__ hrow, int lane) {
    float ss = 0.f;
#pragma unroll
    for (int j = 0; j < 4; ++j) ss += (v[j][0] * v[j][0] + v[j][1] * v[j][1]) + (v[j][2] * v[j][2] + v[j][3] * v[j][3]);
    const float rstd = __builtin_amdgcn_rsqf(wave_sum(ss) * (1.0f / 1024.0f) + EPS);
#pragma unroll
    for (int j = 0; j < 4; ++j) { const int c = 4 * lane + 256 * j;
        const f32x4 g = *(const f32x4*)(gain + c), sc = *(const f32x4*)(scale + c), sh = *(const f32x4*)(shift + c);
        const f32x4 h = v[j] * rstd * (g * (1.0f + sc)) + sh;
        v2u w; w.x = pk2(h[0], h[1]); w.y = pk2(h[2], h[3]); *(v2u*)(hrow + c) = w; }
}
__device__ __forceinline__ void phase_norm0(const Args& args) {
    int tid_ = threadIdx.x; asm volatile("" : "+v"(tid_)); const int tid = tid_, lane = tid & 63, wave = __builtin_amdgcn_readfirstlane(tid >> 6), G = gridDim.x, bid = blockIdx.x; (void)tid; (void)lane; (void)wave;
    const float* X = args.in[0]; bf16* H = (bf16*)(args.ws + WS_ACT + A_H); const float* MOD = (const float*)(args.ws + WS_MOD);
    for (int t = bid * NWAVES + wave; t < T; t += G * NWAVES) { const int b = t / SEQ; f32x4 v[4];
#pragma unroll
        for (int j = 0; j < 4; ++j) v[j] = *(const f32x4*)(X + (size_t)t * 1024 + 4 * lane + 256 * j);
        const float* m = MOD + (size_t)b * 6144;
        norm_store_row(v, args.in[2], m, m + 1024, H + (size_t)t * 1024, lane); }
}

__device__ __forceinline__ void phase_gm_spatial(const Args& args, int L, LAS unsigned char* lds) {
    int tid_ = threadIdx.x; asm volatile("" : "+v"(tid_)); const int tid = tid_, lane = tid & 63, wave = __builtin_amdgcn_readfirstlane(tid >> 6), G = gridDim.x, bid = blockIdx.x; (void)tid; (void)lane; (void)wave;
    unsigned char* ws = uni_ptr(args.ws); const int ib = LBASE(L) + 4;
    const float* v_norm = args.in[ib + 1]; const float* w_s = args.in[ib + 2]; const float* b_s = args.in[ib + 3];
    const bf16* U = (const bf16*)(ws + WS_ACT + A_U); const bf16* V = (const bf16*)(ws + WS_ACT + A_V); bf16* GT = (bf16*)(ws + WS_ACT + A_GATED);
    const float* VSSP = (const float*)(ws + WS_VSSP);
    LAS bf16* WL = (LAS bf16*)lds; LAS bf16* VT = (LAS bf16*)(lds + 34816); LAS float* rs = (LAS float*)(lds + 69632);
    const int wr = wave >> 2, wc = wave & 3, fr = lane & 15, fq = lane >> 4;
    for (int u = bid; u < 2048; u += G) {
        const int c = u >> 3, g = u & 7; const size_t tok0 = (size_t)c * 128;
        if (tid < 128) { const float* p = VSSP + (tok0 + tid) * 16; float s = 0.f;
#pragma unroll
            for (int i = 0; i < 4; ++i) { const f32x4 q = *(const f32x4*)(p + 4 * i); s += (q[0] + q[1]) + (q[2] + q[3]); }
            rs[tid] = __builtin_amdgcn_rsqf(s * (1.0f / 1024.0f) + EPS); }
        { const int s = tid & 127, dq = tid >> 7; const bf16* vp = V + (tok0 + s) * 1024 + g * 128 + dq * 32;
#pragma unroll
          for (int i = 0; i < 4; ++i) { const v4u q = *(const v4u*)(vp + 8 * i); const unsigned w[4] = {q.x, q.y, q.z, q.w};
#pragma unroll
              for (int e = 0; e < 4; ++e) { VT[(dq * 32 + 8 * i + 2 * e) * 136 + s] = (bf16)(w[e] & 0xffffu); VT[(dq * 32 + 8 * i + 2 * e + 1) * 136 + s] = (bf16)(w[e] >> 16); } } }
        __syncthreads();
        { const int tr = tid >> 2, sq = (tid & 3) * 32; const float* wp = w_s + ((size_t)g * 128 + tr) * 128 + sq;
#pragma unroll
          for (int i = 0; i < 8; ++i) { const f32x4 q = *(const f32x4*)(wp + 4 * i); float o[4];
#pragma unroll
              for (int e = 0; e < 4; ++e) { const int s = sq + 4 * i + e; o[e] = (s <= tr) ? q[e] * rs[s] : 0.f; }
              v2u w; w.x = pk2(o[0], o[1]); w.y = pk2(o[2], o[3]); *(LAS v2u*)(WL + tr * 136 + sq + 4 * i) = w; } }
        __syncthreads();
        f32x4 acc[2][4];
#pragma unroll
        for (int n = 0; n < 2; ++n)
#pragma unroll
            for (int m = 0; m < 4; ++m) acc[n][m] = (f32x4){0.f, 0.f, 0.f, 0.f};
#pragma unroll
        for (int ks = 0; ks < 4; ++ks) { bf16x8 vf[2], wf[4];
#pragma unroll
            for (int n = 0; n < 2; ++n) vf[n] = *(const LAS bf16x8*)(VT + (32 * wc + 16 * n + fr) * 136 + 32 * ks + 8 * fq);
#pragma unroll
            for (int m = 0; m < 4; ++m) wf[m] = *(const LAS bf16x8*)(WL + (64 * wr + 16 * m + fr) * 136 + 32 * ks + 8 * fq);
#pragma unroll
            for (int n = 0; n < 2; ++n)
#pragma unroll
                for (int m = 0; m < 4; ++m) acc[n][m] = __builtin_amdgcn_mfma_f32_16x16x32_bf16(vf[n], wf[m], acc[n][m], 0, 0, 0); }
#pragma unroll
        for (int m = 0; m < 4; ++m) { const int t = 64 * wr + 16 * m + fr; const float bs = b_s[g * 128 + t];
#pragma unroll
            for (int n = 0; n < 2; ++n) { const int d0 = g * 128 + 32 * wc + 16 * n + 4 * fq; const size_t off = (tok0 + t) * 1024 + d0;
                const v2u uu = *(const v2u*)(U + off); const f32x4 vn = *(const f32x4*)(v_norm + d0);
                const float o0 = bflo(uu.x) * (acc[n][m][0] * vn[0] + bs), o1 = bfhi(uu.x) * (acc[n][m][1] * vn[1] + bs), o2 = bflo(uu.y) * (acc[n][m][2] * vn[2] + bs), o3 = bfhi(uu.y) * (acc[n][m][3] * vn[3] + bs);
                v2u w; w.x = pk2(o0, o1); w.y = pk2(o2, o3); *(v2u*)(GT + off) = w; } }
        __syncthreads();
    }
}

__device__ __forceinline__ void phase_swa_attn(const Args& args, LAS unsigned char* lds) {
    int tid_ = threadIdx.x; asm volatile("" : "+v"(tid_)); const int tid = tid_, lane = tid & 63, wave = __builtin_amdgcn_readfirstlane(tid >> 6), G = gridDim.x, bid = blockIdx.x; (void)tid; (void)lane; (void)wave;
    unsigned char* ws = uni_ptr(args.ws);
    const float* q_norm = args.in[34]; const float* k_norm = args.in[35]; const float* sinks = args.in[36];
    const bf16* QKV = (const bf16*)(ws + WS_ACT + A_QKV); bf16* O = (bf16*)(ws + WS_ACT + A_H);
    LAS bf16* KL = (LAS bf16*)lds; LAS bf16* VT = (LAS bf16*)(lds + 36864);
    const int fr = lane & 15, fq = lane >> 4;
    for (int u = bid; u < 1024; u += G) {
        const int n = u & 127, kvh = (u >> 7) & 3, b = u >> 9; const long tok0 = (long)b * SEQ + (long)n * 128;
        { const int key = tid >> 1, half = tid & 1; const long tk = tok0 - 128 + key; float x[32]; float ss = 0.f;
          const bool ok = (n > 0) || (key >= 128);
          const bf16* kp = QKV + (size_t)(ok ? tk : tok0) * 1536 + 1024 + kvh * 64 + half * 32;
#pragma unroll
          for (int i = 0; i < 4; ++i) { const v4u q = *(const v4u*)(kp + 8 * i); const unsigned w[4] = {q.x, q.y, q.z, q.w};
#pragma unroll
              for (int e = 0; e < 4; ++e) { x[8 * i + 2 * e] = bflo(w[e]); x[8 * i + 2 * e + 1] = bfhi(w[e]); } }
#pragma unroll
          for (int i = 0; i < 32; ++i) ss += x[i] * x[i];
          ss += __shfl_xor(ss, 1);
          const float rstd = ok ? __builtin_amdgcn_rsqf(ss * (1.0f / 64.0f) + EPS) : 0.f;
#pragma unroll
          for (int i = 0; i < 4; ++i) { float o[8];
#pragma unroll
              for (int e = 0; e < 8; ++e) o[e] = x[8 * i + e] * rstd * k_norm[half * 32 + 8 * i + e];
              v4u w; w.x = pk2(o[0], o[1]); w.y = pk2(o[2], o[3]); w.z = pk2(o[4], o[5]); w.w = pk2(o[6], o[7]);
              *(LAS v4u*)(KL + key * 72 + half * 32 + 8 * i) = w; } }
        { const int key = tid & 255, dh = tid >> 8; const long tk = tok0 - 128 + key; const bool ok = (n > 0) || (key >= 128);
          const bf16* vp = QKV + (size_t)(ok ? tk : tok0) * 1536 + 1280 + kvh * 64 + dh * 32;
#pragma unroll
          for (int i = 0; i < 4; ++i) { v4u q = *(const v4u*)(vp + 8 * i); if (!ok) q = (v4u){0u, 0u, 0u, 0u}; const unsigned w[4] = {q.x, q.y, q.z, q.w};
#pragma unroll
              for (int e = 0; e < 4; ++e) { VT[(dh * 32 + 8 * i + 2 * e) * 264 + key] = (bf16)(w[e] & 0xffffu); VT[(dh * 32 + 8 * i + 2 * e + 1) * 264 + key] = (bf16)(w[e] >> 16); } } }
        __syncthreads();
        const int g = wave >> 1, qh = wave & 1, hq = kvh * 4 + g; const float sink = sinks[hq];
#pragma unroll 1
        for (int mt = 0; mt < 4; ++mt) {
            asm volatile("" ::: "memory");
            const int qi = qh * 64 + mt * 16 + fr;
            bf16x8 qf[2];
            { float x[16]; float ss = 0.f; const bf16* qp = QKV + (size_t)(tok0 + qi) * 1536 + hq * 64 + 8 * fq;
#pragma unroll
              for (int ks = 0; ks < 2; ++ks) { const v4u q = *(const v4u*)(qp + 32 * ks); const unsigned w[4] = {q.x, q.y, q.z, q.w};
#pragma unroll
                  for (int e = 0; e < 4; ++e) { x[8 * ks + 2 * e] = bflo(w[e]); x[8 * ks + 2 * e + 1] = bfhi(w[e]); } }
#pragma unroll
              for (int i = 0; i < 16; ++i) ss += x[i] * x[i];
              ss += __shfl_xor(ss, 16); ss += __shfl_xor(ss, 32);
              const float rstd = __builtin_amdgcn_rsqf(ss * (1.0f / 64.0f) + EPS) * 0.125f;
#pragma unroll
              for (int ks = 0; ks < 2; ++ks) { float o[8];
#pragma unroll
                  for (int e = 0; e < 8; ++e) o[e] = x[8 * ks + e] * rstd * q_norm[32 * ks + 8 * fq + e];
                  v4u w; w.x = pk2(o[0], o[1]); w.y = pk2(o[2], o[3]); w.z = pk2(o[4], o[5]); w.w = pk2(o[6], o[7]); qf[ks] = __builtin_bit_cast(bf16x8, w); } }
            f32x4 s[16]; float mx = -INFINITY;
#pragma unroll
            for (int nt = 0; nt < 16; ++nt) { f32x4 a = {0.f, 0.f, 0.f, 0.f};
#pragma unroll
                for (int ks = 0; ks < 2; ++ks) { const bf16x8 kf = *(const LAS bf16x8*)(KL + (16 * nt + fr) * 72 + 32 * ks + 8 * fq); a = __builtin_amdgcn_mfma_f32_16x16x32_bf16(kf, qf[ks], a, 0, 0, 0); }
#pragma unroll
                for (int i = 0; i < 4; ++i) { const int kj = 16 * nt + 4 * fq + i; const bool valid = (kj > qi) && (kj <= qi + 128) && ((n > 0) || (kj >= 128)); a[i] = valid ? a[i] : -INFINITY; mx = fmaxf(mx, a[i]); }
                s[nt] = a; }
            mx = fmaxf(mx, __shfl_xor(mx, 16)); mx = fmaxf(mx, __shfl_xor(mx, 32)); mx = fmaxf(mx, sink);
            float l = 0.f;
#pragma unroll
            for (int nt = 0; nt < 16; ++nt)
#pragma unroll
                for (int i = 0; i < 4; ++i) { const float p = fast_exp(s[nt][i] - mx); s[nt][i] = p; l += p; }
            l += __shfl_xor(l, 16); l += __shfl_xor(l, 32); l += fast_exp(sink - mx);
            f32x4 o[4];
#pragma unroll
            for (int dt = 0; dt < 4; ++dt) o[dt] = (f32x4){0.f, 0.f, 0.f, 0.f};
#pragma unroll
            for (int st = 0; st < 8; ++st) {
                v4u pw; pw.x = pk2(s[2 * st][0], s[2 * st][1]); pw.y = pk2(s[2 * st][2], s[2 * st][3]); pw.z = pk2(s[2 * st + 1][0], s[2 * st + 1][1]); pw.w = pk2(s[2 * st + 1][2], s[2 * st + 1][3]);
                const bf16x8 pf = __builtin_bit_cast(bf16x8, pw);
#pragma unroll
                for (int dt = 0; dt < 4; ++dt) { const LAS bf16* vp = VT + (16 * dt + fr) * 264 + 32 * st + 4 * fq;
                    const v2u v0 = *(const LAS v2u*)vp, v1 = *(const LAS v2u*)(vp + 16); v4u vw; vw.x = v0.x; vw.y = v0.y; vw.z = v1.x; vw.w = v1.y;
                    o[dt] = __builtin_amdgcn_mfma_f32_16x16x32_bf16(__builtin_bit_cast(bf16x8, vw), pf, o[dt], 0, 0, 0); } }
            const float inv = 1.0f / l;
#pragma unroll
            for (int dt = 0; dt < 4; ++dt) { v2u w; w.x = pk2(o[dt][0] * inv, o[dt][1] * inv); w.y = pk2(o[dt][2] * inv, o[dt][3] * inv);
                *(v2u*)(O + (size_t)(tok0 + qi) * 1024 + hq * 64 + 16 * dt + 4 * fq) = w; }
        }
        __syncthreads();
    }
}

__device__ __forceinline__ void phase_dn_prep(const Args& args) {
    int tid_ = threadIdx.x; asm volatile("" : "+v"(tid_)); const int tid = tid_, lane = tid & 63, wave = __builtin_amdgcn_readfirstlane(tid >> 6), G = gridDim.x, bid = blockIdx.x; (void)tid; (void)lane; (void)wave;
    unsigned char* ws = uni_ptr(args.ws); const float* conv_w = args.in[20]; const float* a_log = args.in[21]; const float* dt_bias = args.in[22];
    const bf16* QKV = (const bf16*)(ws + WS_ACT + A_QKV); bf16* QN = (bf16*)(ws + WS_ACT + A_QN); bf16* KN = (bf16*)(ws + WS_ACT + A_KN); bf16* VV = (bf16*)(ws + WS_ACT + A_VV);
    const float* BA = (const float*)(ws + WS_BA); float* DNB = (float*)(ws + WS_DNB);
    for (int t = bid * NWAVES + wave; t < T; t += G * NWAVES) { const int pos = t % SEQ;
#pragma unroll
        for (int j = 0; j < 4; ++j) { const int ch = 8 * lane + 512 * j; float a[8];
#pragma unroll
            for (int e = 0; e < 8; ++e) a[e] = 0.f;
#pragma unroll
            for (int tap = 0; tap < 4; ++tap) { if (pos - 3 + tap >= 0) { const v4u q = *(const v4u*)(QKV + (size_t)(t - 3 + tap) * 2048 + ch); const f32x4 w0 = *(const f32x4*)(conv_w + tap * 2048 + ch), w1 = *(const f32x4*)(conv_w + tap * 2048 + ch + 4);
                a[0] += w0[0] * bflo(q.x); a[1] += w0[1] * bfhi(q.x); a[2] += w0[2] * bflo(q.y); a[3] += w0[3] * bfhi(q.y); a[4] += w1[0] * bflo(q.z); a[5] += w1[1] * bfhi(q.z); a[6] += w1[2] * bflo(q.w); a[7] += w1[3] * bfhi(q.w); } }
            float ss = 0.f;
#pragma unroll
            for (int e = 0; e < 8; ++e) { a[e] = siluf_(a[e]); ss += a[e] * a[e]; }
            if (j < 2) { ss += __shfl_xor(ss, 1); ss += __shfl_xor(ss, 2); ss += __shfl_xor(ss, 4); ss += __shfl_xor(ss, 8);
                const float r = __builtin_amdgcn_rsqf(ss + EPS); bf16* dst = (j == 0 ? QN : KN) + (size_t)t * 512 + 8 * lane;
                v4u w; w.x = pk2(a[0] * r, a[1] * r); w.y = pk2(a[2] * r, a[3] * r); w.z = pk2(a[4] * r, a[5] * r); w.w = pk2(a[6] * r, a[7] * r); *(v4u*)dst = w; }
            else { v4u w; w.x = pk2(a[0], a[1]); w.y = pk2(a[2], a[3]); w.z = pk2(a[4], a[5]); w.w = pk2(a[6], a[7]); *(v4u*)(VV + (size_t)t * 1024 + 8 * lane + 512 * (j - 2)) = w; } }
        if (lane < 8) { const float bi = BA[(size_t)t * 16 + lane], ai = BA[(size_t)t * 16 + 8 + lane] + dt_bias[lane];
            const float sp = fmaxf(ai, 0.f) + log1pf(expf(-fabsf(ai)));
            DNB[(size_t)t * 16 + lane] = 1.0f / (1.0f + expf(-bi)); DNB[(size_t)t * 16 + 8 + lane] = -expf(a_log[lane]) * sp; }
    }
}
constexpr int FA_STRIDE = 25600, FB_STRIDE = 32768, FU_STRIDE = 16384;
constexpr float DN_SCALE = 0.08838834764831845f;
__device__ __forceinline__ void phase_dn_chunk(const Args& args, LAS unsigned char* lds) {
    int tid_ = threadIdx.x; asm volatile("" : "+v"(tid_)); const int tid = tid_, lane = tid & 63, wave = __builtin_amdgcn_readfirstlane(tid >> 6), G = gridDim.x, bid = blockIdx.x;
    unsigned char* ws = uni_ptr(args.ws);
    const bf16* QN = (const bf16*)(ws + WS_ACT + A_QN); const bf16* KN = (const bf16*)(ws + WS_ACT + A_KN); const bf16* VV = (const bf16*)(ws + WS_ACT + A_VV);
    const float* DNB = (const float*)(ws + WS_DNB);
    unsigned char* FA = ws + WS_ACT + A_FA; unsigned char* FB = ws + WS_ACT + A_FB; unsigned char* FU = ws + WS_ACT + A_FU;
    LAS float* Al = (LAS float*)(lds + wave * 16384);
    LAS float* tb = (LAS float*)(lds + LDSCTL_OFF + 2048 + wave * 512);
    const int fr = lane & 15, fq = lane >> 4;
    for (int it = bid * NWAVES + wave; it < 4096; it += G * NWAVES) {
        const int b = it >> 11, hv = (it >> 8) & 7, n = it & 255, hq = hv >> 1; const size_t t0 = (size_t)b * SEQ + (size_t)n * 64; const int itq = (b * 4 + hq) * 256 + n;
        unsigned char* fa = FA + (size_t)it * FA_STRIDE; unsigned char* fb = FB + (size_t)itq * FB_STRIDE;
        const float bv = DNB[(t0 + lane) * 16 + hv]; float gcv = DNB[(t0 + lane) * 16 + 8 + hv];
#pragma unroll
        for (int o = 1; o < 64; o <<= 1) { const float t = __shfl_up(gcv, o); if (lane >= o) gcv += t; }
        const float gll = __shfl(gcv, 63);
        tb[lane] = gcv; tb[64 + lane] = bv;
        { float* fe = (float*)(fa + 24576); fe[lane] = DN_SCALE * expf(gcv); fe[64 + lane] = expf(gll - gcv); fe[128 + lane] = expf(gll); }
        asm volatile("" ::: "memory");
        bf16x8 kf[4][4];
#pragma unroll
        for (int t = 0; t < 4; ++t)
#pragma unroll
            for (int ks = 0; ks < 4; ++ks) kf[t][ks] = *(const bf16x8*)(KN + (t0 + 16 * t + fr) * 512 + hq * 128 + 32 * ks + 8 * fq);
#pragma unroll
        for (int m = 0; m < 4; ++m) { const int c = 16 * m + fr; const float bm = tb[64 + c], gm = tb[c];
            bf16x8 qf[4];
#pragma unroll
            for (int ks = 0; ks < 4; ++ks) qf[ks] = *(const bf16x8*)(QN + (t0 + c) * 512 + hq * 128 + 32 * ks + 8 * fq);
            f32x4 tl[4];
#pragma unroll
            for (int t = 0; t < 4; ++t) {
                if (t <= m) { f32x4 ak = {0.f, 0.f, 0.f, 0.f}, aq = {0.f, 0.f, 0.f, 0.f};
#pragma unroll
                    for (int ks = 0; ks < 4; ++ks) { ak = __builtin_amdgcn_mfma_f32_16x16x32_bf16(kf[t][ks], kf[m][ks], ak, 0, 0, 0); aq = __builtin_amdgcn_mfma_f32_16x16x32_bf16(kf[t][ks], qf[ks], aq, 0, 0, 0); }
                    const f32x4 gs4 = *(const LAS f32x4*)(tb + 16 * t + 4 * fq); f32x4 av;
#pragma unroll
                    for (int r = 0; r < 4; ++r) { const int s = 16 * t + 4 * fq + r; const float dec = expf(fminf(gm - gs4[r], 0.f)); av[r] = (s < c) ? bm * ak[r] * dec : 0.f; tl[t][r] = (s <= c) ? DN_SCALE * aq[r] * dec : 0.f; }
                    *(LAS f32x4*)(Al + c * 64 + 16 * t + 4 * fq) = av; }
                else tl[t] = (f32x4){0.f, 0.f, 0.f, 0.f}; }
#pragma unroll
            for (int k2 = 0; k2 < 2; ++k2) { v4u w; w.x = pk2(tl[2 * k2][0], tl[2 * k2][1]); w.y = pk2(tl[2 * k2][2], tl[2 * k2][3]); w.z = pk2(tl[2 * k2 + 1][0], tl[2 * k2 + 1][1]); w.w = pk2(tl[2 * k2 + 1][2], tl[2 * k2 + 1][3]);
                *(v4u*)(fa + 16384 + (m * 2 + k2) * 1024 + lane * 16) = w; } }
        asm volatile("s_waitcnt lgkmcnt(0)" ::: "memory");
        float Tc[64];
#pragma unroll
        for (int m = 0; m < 64; ++m) Tc[m] = (m == lane) ? 1.f : 0.f;
#pragma unroll
        for (int r = 1; r < 64; ++r) { float acc = 0.f;
#pragma unroll
            for (int m4 = 0; m4 < (r + 3) / 4; ++m4) { const f32x4 a4 = *(const LAS f32x4*)(Al + r * 64 + 4 * m4);
#pragma unroll
                for (int e = 0; e < 4; ++e) if (4 * m4 + e < r) acc += a4[e] * Tc[4 * m4 + e]; }
            Tc[r] -= acc; }
        asm volatile("s_waitcnt lgkmcnt(0)" ::: "memory");
        LAS bf16* T1l = (LAS bf16*)Al; LAS bf16* T2l = T1l + 4096;
        { const float c1 = bv, c2 = bv * expf(gcv);
#pragma unroll
          for (int i = 0; i < 64; ++i) { T1l[i * 64 + lane] = (bf16)(pk2(Tc[i] * c1, 0.f) & 0xffffu); T2l[i * 64 + lane] = (bf16)(pk2(Tc[i] * c2, 0.f) & 0xffffu); } }
        asm volatile("s_waitcnt lgkmcnt(0)" ::: "memory");
        { bf16x8 t1f[4][2];
#pragma unroll
          for (int m = 0; m < 4; ++m)
#pragma unroll
              for (int k2 = 0; k2 < 2; ++k2) t1f[m][k2] = *(const LAS bf16x8*)(T1l + (16 * m + fr) * 64 + 32 * k2 + 8 * fq);
#pragma unroll 1
          for (int j = 0; j < 8; ++j) { bf16x8 vf[2];
#pragma unroll
              for (int k2 = 0; k2 < 2; ++k2)
#pragma unroll
                  for (int i = 0; i < 8; ++i) vf[k2][i] = (short)VV[(t0 + 32 * k2 + 8 * fq + i) * 1024 + hv * 128 + 16 * j + fr];
#pragma unroll
              for (int m = 0; m < 4; ++m) { f32x4 a = {0.f, 0.f, 0.f, 0.f};
#pragma unroll
                  for (int k2 = 0; k2 < 2; ++k2) a = __builtin_amdgcn_mfma_f32_16x16x32_bf16(t1f[m][k2], vf[k2], a, 0, 0, 0);
                  v2u w; w.x = pk2(a[0], a[1]); w.y = pk2(a[2], a[3]); *(v2u*)(FU + (size_t)it * FU_STRIDE + ((j * 4 + m) * 64 + lane) * 8) = w; } } }
        { bf16x8 ktf[8][2];
#pragma unroll
          for (int dt = 0; dt < 8; ++dt)
#pragma unroll
              for (int k2 = 0; k2 < 2; ++k2)
#pragma unroll
                  for (int i = 0; i < 8; ++i) ktf[dt][k2][i] = (short)KN[(t0 + 32 * k2 + 16 * (i >> 2) + 4 * fq + (i & 3)) * 512 + hq * 128 + 16 * dt + fr];
          if ((hv & 1) == 0) {
#pragma unroll
              for (int dt = 0; dt < 8; ++dt)
#pragma unroll
                  for (int k2 = 0; k2 < 2; ++k2) *(bf16x8*)(fb + 16384 + (dt * 2 + k2) * 1024 + lane * 16) = ktf[dt][k2];
#pragma unroll
              for (int m = 0; m < 4; ++m)
#pragma unroll
                  for (int ks = 0; ks < 4; ++ks) { const bf16* qp = QN + (t0 + 16 * m + fr) * 512 + hq * 128 + 32 * ks + 4 * fq; const v2u lo = *(const v2u*)qp, hi = *(const v2u*)(qp + 16);
                      v4u w; w.x = lo.x; w.y = lo.y; w.z = hi.x; w.w = hi.y; *(v4u*)(fb + (m * 4 + ks) * 1024 + lane * 16) = w; } }
#pragma unroll
          for (int m = 0; m < 4; ++m) { bf16x8 t2f[2];
#pragma unroll
              for (int k2 = 0; k2 < 2; ++k2) { const LAS bf16* tp = T2l + (16 * m + fr) * 64 + 32 * k2 + 4 * fq; const v2u lo = *(const LAS v2u*)tp, hi = *(const LAS v2u*)(tp + 16); v4u w; w.x = lo.x; w.y = lo.y; w.z = hi.x; w.w = hi.y; t2f[k2] = __builtin_bit_cast(bf16x8, w); }
              f32x4 acc[8];
#pragma unroll
              for (int dt = 0; dt < 8; ++dt) { acc[dt] = (f32x4){0.f, 0.f, 0.f, 0.f};
#pragma unroll
                  for (int k2 = 0; k2 < 2; ++k2) acc[dt] = __builtin_amdgcn_mfma_f32_16x16x32_bf16(ktf[dt][k2], t2f[k2], acc[dt], 0, 0, 0); }
#pragma unroll
              for (int ks = 0; ks < 4; ++ks) { v4u w; w.x = pk2(-acc[2 * ks][0], -acc[2 * ks][1]); w.y = pk2(-acc[2 * ks][2], -acc[2 * ks][3]); w.z = pk2(-acc[2 * ks + 1][0], -acc[2 * ks + 1][1]); w.w = pk2(-acc[2 * ks + 1][2], -acc[2 * ks + 1][3]);
                  *(v4u*)(fa + (m * 4 + ks) * 1024 + lane * 16) = w; } } }
        asm volatile("s_waitcnt lgkmcnt(0)" ::: "memory");
    }
}
__device__ __forceinline__ void phase_dn_scan(const Args& args, LAS unsigned char* lds) {
    int tid_ = threadIdx.x; asm volatile("" : "+v"(tid_)); const int tid = tid_, lane = tid & 63, wave = __builtin_amdgcn_readfirstlane(tid >> 6), G = gridDim.x, bid = blockIdx.x;
    if (bid >= 128) {
        const int gw = (bid - 128) * NWAVES + wave, NGW = (G - 128) * NWAVES;
        convert_weights(args, lds, CV_PER_L, CV_N_EXP, gw, NGW); convert_weights(args, lds, CV_N_EXP + CV_MIX_L01, CV_N_EXP + CV_N_MIXI, gw, NGW); return; }
    unsigned char* ws = uni_ptr(args.ws);
    const unsigned char* FA = ws + WS_ACT + A_FA; const unsigned char* FB = ws + WS_ACT + A_FB; const unsigned char* FU = ws + WS_ACT + A_FU; bf16* O = (bf16*)(ws + WS_ACT + A_O);
    const int fr = lane & 15, fq = lane >> 4;
    constexpr int SLOT = 60416, O_QK = 16384, O_TB = 24576, O_Q = 25600, O_KT = 41984, O_U = 58368;
#define SB() __builtin_amdgcn_sched_barrier(0)
#define WGBAR() do { asm volatile("" ::: "memory"); __builtin_amdgcn_s_barrier(); asm volatile("" ::: "memory"); } while (0)
#define DN_AUX 0
#define DMA4(g, l) do { __builtin_amdgcn_global_load_lds((g), (l), 16, 0, DN_AUX); __builtin_amdgcn_global_load_lds((g), (l), 16, 1024, DN_AUX); __builtin_amdgcn_global_load_lds((g), (l), 16, 2048, DN_AUX); __builtin_amdgcn_global_load_lds((g), (l), 16, 3072, DN_AUX); } while (0)
    for (int sidx = bid; sidx < 128; sidx += G) {
        const int bh = (sidx & 7) * 2 + (sidx >> 6), j = (sidx >> 3) & 7, b = bh >> 3, hv = bh & 7, hq = hv >> 1;
        const int it0 = bh * 256, itq0 = (b * 4 + hq) * 256;
        if (wave == 1 || wave == 4) {
#define DN_ISSUE_A(nn) do { LAS unsigned char* sl_ = lds + ((nn) & 1) * SLOT; \
                if (wave == 1) { const unsigned char* fa_ = FA + (size_t)(it0 + (nn)) * FA_STRIDE + lane * 16; \
                    _Pragma("unroll") for (int f4 = 0; f4 < 4; ++f4) { DMA4((const unsigned*)(fa_ + f4 * 4096), (LAS unsigned*)(sl_ + f4 * 4096)); } \
                    __builtin_amdgcn_global_load_lds((const unsigned*)(fa_ + 24576), (LAS unsigned*)(sl_ + O_TB), 16, 0, DN_AUX); } \
                else { const unsigned char* fb_ = FB + (size_t)(itq0 + (nn)) * FB_STRIDE + lane * 16; const unsigned char* fu_ = FU + (size_t)(it0 + (nn)) * FU_STRIDE + j * 2048 + lane * 16; \
                    _Pragma("unroll") for (int f4 = 0; f4 < 4; ++f4) { DMA4((const unsigned*)(fb_ + f4 * 4096), (LAS unsigned*)(sl_ + O_Q + f4 * 4096)); } \
                    __builtin_amdgcn_global_load_lds((const unsigned*)(fu_), (LAS unsigned*)(sl_ + O_U), 16, 0, DN_AUX); __builtin_amdgcn_global_load_lds((const unsigned*)(fu_), (LAS unsigned*)(sl_ + O_U), 16, 1024, DN_AUX); } } while (0)
#define DN_WAIT_A() do { if (wave == 1) asm volatile("s_waitcnt vmcnt(17)" ::: "memory"); else asm volatile("s_waitcnt vmcnt(18)" ::: "memory"); } while (0)
            DN_ISSUE_A(0); DN_ISSUE_A(1);
            DN_WAIT_A();
#pragma unroll 1
            for (int n = 0; n < 256; ++n) {
                WGBAR();
                WGBAR();
                if (n + 2 < 256) { DN_ISSUE_A(n + 2); DN_WAIT_A(); }
                else asm volatile("s_waitcnt vmcnt(0)" ::: "memory");
            }
#undef DN_ISSUE_A
#undef DN_WAIT_A
        } else if (wave == 2 || wave == 5) {
#define DN_ISSUE_B(nn) do { LAS unsigned char* sl_ = lds + ((nn) & 1) * SLOT; const unsigned char* fb_ = FB + (size_t)(itq0 + (nn)) * FB_STRIDE + 16384 + lane * 16; \
                if (wave == 2) { const unsigned char* fa_ = FA + (size_t)(it0 + (nn)) * FA_STRIDE + 16384 + lane * 16; \
                    _Pragma("unroll") for (int f4 = 0; f4 < 2; ++f4) { DMA4((const unsigned*)(fa_ + f4 * 4096), (LAS unsigned*)(sl_ + O_QK + f4 * 4096)); } \
                    DMA4((const unsigned*)(fb_), (LAS unsigned*)(sl_ + O_KT)); } \
                else { _Pragma("unroll") for (int f4 = 1; f4 < 4; ++f4) { DMA4((const unsigned*)(fb_ + f4 * 4096), (LAS unsigned*)(sl_ + O_KT + f4 * 4096)); } } } while (0)
            DN_ISSUE_B(0);
#pragma unroll 1
            for (int n = 0; n < 256; ++n) {
                WGBAR();
                if (n + 1 < 256) { DN_ISSUE_B(n + 1); asm volatile("s_waitcnt vmcnt(12)" ::: "memory"); }
                else asm volatile("s_waitcnt vmcnt(0)" ::: "memory");
                WGBAR();
            }
#undef DN_ISSUE_B
        } else if (wave == 3) {
            unsigned sink = 0u, pa = 0u, pb = 0u;
#pragma unroll 1
            for (int n = 0; n < 256; ++n) {
                WGBAR(); WGBAR();
                sink += pa + pb;
                const int p = n + 5;
                if (p < 256) { const int li = j * 57 + lane;
                    if (lane < 57 && li < 456) { const unsigned char* q = li < 200 ? FA + (size_t)(it0 + p) * FA_STRIDE + li * 128 : FB + (size_t)(itq0 + p) * FB_STRIDE + (li - 200) * 128; pa = *(const volatile unsigned*)q; }
                    if (lane < 16) pb = *(const volatile unsigned*)(FU + (size_t)(it0 + p) * FU_STRIDE + j * 2048 + lane * 128); }
            }
            sink += pa + pb;
            if (sink == 0x9e3779b9u) O[0] = 0;
        } else if (wave != 0) {
#pragma unroll 1
            for (int n = 0; n < 256; ++n) { WGBAR(); WGBAR(); }
        } else {
        f32x4 S[8];
#pragma unroll
        for (int dt = 0; dt < 8; ++dt) S[dt] = (f32x4){0.f, 0.f, 0.f, 0.f};
        bf16x8 sf[4];
#pragma unroll
        for (int ks = 0; ks < 4; ++ks) sf[ks] = (bf16x8){0, 0, 0, 0, 0, 0, 0, 0};
#pragma unroll 1
        for (int n = 0; n < 256; ++n) {
            WGBAR();
            const LAS unsigned char* base = lds + (n & 1) * SLOT + lane * 16;
            const LAS float* tbl = (const LAS float*)(lds + (n & 1) * SLOT + O_TB);
            f32x4 egc[4], ekd[4], av[4], ao[4];
#pragma unroll
            for (int m = 0; m < 4; ++m) { egc[m] = *(const LAS f32x4*)(tbl + 16 * m + 4 * fq); ekd[m] = *(const LAS f32x4*)(tbl + 64 + 16 * m + 4 * fq);
                const v2u u2 = *(const LAS v2u*)(lds + (n & 1) * SLOT + O_U + (m * 64 + lane) * 8); av[m] = (f32x4){bflo(u2.x), bfhi(u2.x), bflo(u2.y), bfhi(u2.y)}; ao[m] = (f32x4){0.f, 0.f, 0.f, 0.f}; }
            const float gl = tbl[128 + lane];
            SB();
            bf16x8 Aw[16], Bq[16];
#pragma unroll
            for (int f = 0; f < 16; ++f) Aw[f] = *(const LAS bf16x8*)(base + f * 1024);
            SB();
#pragma unroll
            for (int ks = 0; ks < 4; ++ks) {
#pragma unroll
                for (int m = 0; m < 4; ++m) Bq[m * 4 + ks] = *(const LAS bf16x8*)(base + O_Q + (m * 4 + ks) * 1024);
#pragma unroll
                for (int m = 0; m < 4; ++m) av[m] = __builtin_amdgcn_mfma_f32_16x16x32_bf16(Aw[m * 4 + ks], sf[ks], av[m], 0, 0, 0);
                SB(); }
            asm volatile("s_waitcnt lgkmcnt(0)" ::: "memory");
            WGBAR();
            bf16x8 Ck[16], Dk[8];
#pragma unroll
            for (int ks = 0; ks < 4; ++ks) {
#pragma unroll
                for (int f = 0; f < 2; ++f) { Ck[8 + ks * 2 + f] = *(const LAS bf16x8*)(base + O_KT + (ks * 2 + f) * 1024); Dk[ks * 2 + f] = *(const LAS bf16x8*)(base + O_KT + 8192 + (ks * 2 + f) * 1024); Ck[ks * 2 + f] = *(const LAS bf16x8*)(base + O_QK + (ks * 2 + f) * 1024); }
#pragma unroll
                for (int m = 0; m < 4; ++m) ao[m] = __builtin_amdgcn_mfma_f32_16x16x32_bf16(Bq[m * 4 + ks], sf[ks], ao[m], 0, 0, 0);
                SB(); }
#pragma unroll
            for (int dt = 0; dt < 8; ++dt) S[dt] = S[dt] * gl;
            bf16x8 vf[2], vpf[2];
#pragma unroll
            for (int k2 = 0; k2 < 2; ++k2) { v4u w; w.x = pk2(av[2 * k2][0], av[2 * k2][1]); w.y = pk2(av[2 * k2][2], av[2 * k2][3]); w.z = pk2(av[2 * k2 + 1][0], av[2 * k2 + 1][1]); w.w = pk2(av[2 * k2 + 1][2], av[2 * k2 + 1][3]); vf[k2] = __builtin_bit_cast(bf16x8, w);
                const f32x4 p0 = av[2 * k2] * ekd[2 * k2], p1 = av[2 * k2 + 1] * ekd[2 * k2 + 1];
                v4u x; x.x = pk2(p0[0], p0[1]); x.y = pk2(p0[2], p0[3]); x.z = pk2(p1[0], p1[1]); x.w = pk2(p1[2], p1[3]); vpf[k2] = __builtin_bit_cast(bf16x8, x); }
#pragma unroll
            for (int m = 0; m < 4; ++m) ao[m] = ao[m] * egc[m];
            SB();
#pragma unroll
            for (int k2 = 0; k2 < 2; ++k2)
#pragma unroll
                for (int dt = 0; dt < 4; ++dt) S[dt] = __builtin_amdgcn_mfma_f32_16x16x32_bf16(Ck[8 + dt * 2 + k2], vpf[k2], S[dt], 0, 0, 0);
#pragma unroll
            for (int k2 = 0; k2 < 2; ++k2)
#pragma unroll
                for (int dt = 4; dt < 8; ++dt) S[dt] = __builtin_amdgcn_mfma_f32_16x16x32_bf16(Dk[(dt - 4) * 2 + k2], vpf[k2], S[dt], 0, 0, 0);
#pragma unroll
            for (int k2 = 0; k2 < 2; ++k2)
#pragma unroll
                for (int m = 0; m < 4; ++m) ao[m] = __builtin_amdgcn_mfma_f32_16x16x32_bf16(Ck[m * 2 + k2], vf[k2], ao[m], 0, 0, 0);
            SB();
#pragma unroll
            for (int ks = 0; ks < 4; ++ks) { v4u w; w.x = pk2(S[2 * ks][0], S[2 * ks][1]); w.y = pk2(S[2 * ks][2], S[2 * ks][3]); w.z = pk2(S[2 * ks + 1][0], S[2 * ks + 1][1]); w.w = pk2(S[2 * ks + 1][2], S[2 * ks + 1][3]); sf[ks] = __builtin_bit_cast(bf16x8, w); }
            asm volatile("s_waitcnt lgkmcnt(0)" ::: "memory");
            { bf16* op = O + ((size_t)b * SEQ + (size_t)n * 64 + 4 * fq) * 1024 + hv * 128 + 16 * j + fr;
#pragma unroll
              for (int m = 0; m < 4; ++m)
#pragma unroll
                  for (int r = 0; r < 4; ++r) op[(size_t)(16 * m + r) * 1024] = (bf16)(pk2(ao[m][r], 0.f) & 0xffffu); }
        }
        }
        __syncthreads();
    }
#undef SB
#undef DMA4
#undef WGBAR
}
__device__ __forceinline__ void phase_dn_ogate(const Args& args) {
    int tid_ = threadIdx.x; asm volatile("" : "+v"(tid_)); const int tid = tid_, lane = tid & 63, wave = __builtin_amdgcn_readfirstlane(tid >> 6), G = gridDim.x, bid = blockIdx.x; (void)tid; (void)lane; (void)wave;
    unsigned char* ws = uni_ptr(args.ws); const float* o_norm = args.in[23];
    const bf16* O = (const bf16*)(ws + WS_ACT + A_O); const bf16* Z = (const bf16*)(ws + WS_ACT + A_Z); bf16* GT = (bf16*)(ws + WS_ACT + A_H);
    for (int t = bid * NWAVES + wave; t < T; t += G * NWAVES) {
#pragma unroll
        for (int j = 0; j < 2; ++j) { const int ch = 8 * lane + 512 * j; const v4u q = *(const v4u*)(O + (size_t)t * 1024 + ch), z = *(const v4u*)(Z + (size_t)t * 1024 + ch);
            float o[8] = {bflo(q.x), bfhi(q.x), bflo(q.y), bfhi(q.y), bflo(q.z), bfhi(q.z), bflo(q.w), bfhi(q.w)}; const float zz[8] = {bflo(z.x), bfhi(z.x), bflo(z.y), bfhi(z.y), bflo(z.z), bfhi(z.z), bflo(z.w), bfhi(z.w)};
            float ss = 0.f;
#pragma unroll
            for (int e = 0; e < 8; ++e) ss += o[e] * o[e];
            ss += __shfl_xor(ss, 1); ss += __shfl_xor(ss, 2); ss += __shfl_xor(ss, 4); ss += __shfl_xor(ss, 8);
            const float r = __builtin_amdgcn_rsqf(ss * (1.0f / 128.0f) + EPS);
#pragma unroll
            for (int e = 0; e < 8; ++e) o[e] = o[e] * r * o_norm[(ch & 127) + e] * siluf_(zz[e]);
            v4u w; w.x = pk2(o[0], o[1]); w.y = pk2(o[2], o[3]); w.z = pk2(o[4], o[5]); w.w = pk2(o[6], o[7]); *(v4u*)(GT + (size_t)t * 1024 + ch) = w; }
    }
}

__device__ __forceinline__ void phase_moe_router(const Args& args, int L, LAS unsigned char* lds) {
    int tid_ = threadIdx.x; asm volatile("" : "+v"(tid_)); const int tid = tid_, lane = tid & 63, wave = __builtin_amdgcn_readfirstlane(tid >> 6), G = gridDim.x, bid = blockIdx.x;
    unsigned char* ws = uni_ptr(args.ws); const int ib = LBASE(L) + 4 + NMIX(L);
    const float* X = args.out; bf16* H = (bf16*)(ws + WS_ACT + A_H); const float* MOD = (const float*)(ws + WS_MOD) + (size_t)L * 2 * 6144;
    const float* nf = args.in[LBASE(L) + 1]; const float* rb = args.in[ib + 1];
    const bf16* RH = (const bf16*)(ws + WS_RTR + (size_t)L * 196608); const bf16* RLo = RH + 49152;
    int* EID = (int*)(ws + WS_EID); float* GATE = (float*)(ws + WS_GATE); int* CNT = (int*)(ws + WS_CNT);
    LAS float* gs = (LAS float*)lds; LAS float* sh = gs + 1024; LAS int* lcnt = (LAS int*)(lds + 8192);
    LAS float* ssp = (LAS float*)(lds + 8448);
    LAS float* part = (LAS float*)(lds + 9472);
    LAS float* logit = (LAS float*)(lds + 58624);
    const int r = lane & 15, q = lane >> 4, kw = 128 * wave;
    bf16x8 bh[4][3], bl[4][3];
#pragma unroll
    for (int ks = 0; ks < 4; ++ks)
#pragma unroll
        for (int nt = 0; nt < 3; ++nt) { bh[ks][nt] = *(const bf16x8*)(RH + (size_t)(nt * 16 + r) * 1024 + kw + 32 * ks + 8 * q); bl[ks][nt] = *(const bf16x8*)(RLo + (size_t)(nt * 16 + r) * 1024 + kw + 32 * ks + 8 * q); }
    for (int item = bid; item < T / 128; item += G) {
        const int r0 = item * 128, b = r0 / SEQ; const float* m = MOD + (size_t)b * 6144;
        __syncthreads();
        for (int k = tid; k < 1024; k += NTHR) { gs[k] = nf[k] * (1.0f + m[4096 + k]); sh[k] = m[3072 + k]; }
        if (tid < 32) lcnt[tid] = 0;
        f32x4 xv[8];
        { const float* xp = X + (size_t)(r0 + r) * 1024 + kw + 8 * q;
#pragma unroll
          for (int ks = 0; ks < 4; ++ks) { xv[2 * ks] = *(const f32x4*)(xp + 32 * ks); xv[2 * ks + 1] = *(const f32x4*)(xp + 32 * ks + 4); } }
        __syncthreads();
#pragma unroll 1
        for (int g = 0; g < 8; ++g) {
            const int row = r0 + 16 * g + r, pb = g & 1;
            f32x4 xn[8];
            if (g < 7) { const float* xp = X + (size_t)(row + 16) * 1024 + kw + 8 * q;
#pragma unroll
                for (int ks = 0; ks < 4; ++ks) { xn[2 * ks] = *(const f32x4*)(xp + 32 * ks); xn[2 * ks + 1] = *(const f32x4*)(xp + 32 * ks + 4); } }
            else {
#pragma unroll
                for (int i = 0; i < 8; ++i) xn[i] = xv[i]; }
            float ss = 0.f;
#pragma unroll
            for (int i = 0; i < 8; ++i) ss += (xv[i][0] * xv[i][0] + xv[i][1] * xv[i][1]) + (xv[i][2] * xv[i][2] + xv[i][3] * xv[i][3]);
            ss += __shfl_xor(ss, 16); ss += __shfl_xor(ss, 32);
            if (q == 0) ssp[(pb * 8 + wave) * 16 + r] = ss;
            __syncthreads();
            float tot = 0.f;
#pragma unroll
            for (int w = 0; w < 8; ++w) tot += ssp[(pb * 8 + w) * 16 + r];
            const float rstd = __builtin_amdgcn_rsqf(tot * (1.0f / 1024.0f) + EPS);
            f32x4 acc[3];
#pragma unroll
            for (int nt = 0; nt < 3; ++nt) acc[nt] = (f32x4){0.f, 0.f, 0.f, 0.f};
#pragma unroll
            for (int ks = 0; ks < 4; ++ks) { const int k0 = kw + 32 * ks + 8 * q;
                const f32x4 g0 = *(const LAS f32x4*)(gs + k0), g1 = *(const LAS f32x4*)(gs + k0 + 4), s0 = *(const LAS f32x4*)(sh + k0), s1 = *(const LAS f32x4*)(sh + k0 + 4);
                const f32x4 h0 = xv[2 * ks] * rstd * g0 + s0, h1 = xv[2 * ks + 1] * rstd * g1 + s1;
                v4u hi; hi.x = pk2(h0[0], h0[1]); hi.y = pk2(h0[2], h0[3]); hi.z = pk2(h1[0], h1[1]); hi.w = pk2(h1[2], h1[3]);
                v4u lo; lo.x = pk2(h0[0] - bflo(hi.x), h0[1] - bfhi(hi.x)); lo.y = pk2(h0[2] - bflo(hi.y), h0[3] - bfhi(hi.y)); lo.z = pk2(h1[0] - bflo(hi.z), h1[1] - bfhi(hi.z)); lo.w = pk2(h1[2] - bflo(hi.w), h1[3] - bfhi(hi.w));
                *(v4u*)(H + (size_t)row * 1024 + k0) = hi;
                const bf16x8 ahi = __builtin_bit_cast(bf16x8, hi), alo = __builtin_bit_cast(bf16x8, lo);
#pragma unroll
                for (int nt = 0; nt < 3; ++nt) { acc[nt] = __builtin_amdgcn_mfma_f32_16x16x32_bf16(bh[ks][nt], ahi, acc[nt], 0, 0, 0); acc[nt] = __builtin_amdgcn_mfma_f32_16x16x32_bf16(bl[ks][nt], ahi, acc[nt], 0, 0, 0); acc[nt] = __builtin_amdgcn_mfma_f32_16x16x32_bf16(bh[ks][nt], alo, acc[nt], 0, 0, 0); } }
#pragma unroll
            for (int nt = 0; nt < 3; ++nt) *(LAS f32x4*)(part + ((pb * 8 + wave) * 16 + r) * 48 + 16 * nt + 4 * q) = acc[nt];
            __syncthreads();
            for (int o = tid; o < 768; o += NTHR) { float sacc = 0.f;
#pragma unroll
                for (int w = 0; w < 8; ++w) sacc += part[(pb * 8 + w) * 768 + o];
                const int n = o % 48; logit[pb * 768 + o] = sacc + (n < 36 ? rb[n] : 0.f); }
            __syncthreads();
            if (wave == g && lane < 16) { float lg[36]; const int trow = r0 + 16 * g + lane;
#pragma unroll
                for (int i = 0; i < 9; ++i) { const f32x4 v = *(const LAS f32x4*)(logit + pb * 768 + lane * 48 + 4 * i); lg[4 * i] = v[0]; lg[4 * i + 1] = v[1]; lg[4 * i + 2] = v[2]; lg[4 * i + 3] = v[3]; }
                int gsel = 0; float gm = lg[0];
#pragma unroll
                for (int i = 1; i < 4; ++i) if (lg[i] > gm) { gm = lg[i]; gsel = i; }
                float gsum = 0.f;
#pragma unroll
                for (int i = 0; i < 4; ++i) gsum += expf(lg[i] - gm);
                const float pg = 1.0f / gsum;
                float le[8];
#pragma unroll
                for (int i = 0; i < 8; ++i) le[i] = gsel == 0 ? lg[4 + i] : (gsel == 1 ? lg[12 + i] : (gsel == 2 ? lg[20 + i] : lg[28 + i]));
                int j1 = 0; float m1 = le[0];
#pragma unroll
                for (int i = 1; i < 8; ++i) if (le[i] > m1) { m1 = le[i]; j1 = i; }
                int j2 = -1; float m2 = -INFINITY;
#pragma unroll
                for (int i = 0; i < 8; ++i) if (i != j1 && le[i] > m2) { m2 = le[i]; j2 = i; }
                const float p2 = expf(m2 - m1), den = 1.0f / (1.0f + p2);
                const int e1 = gsel * 8 + j1, e2 = gsel * 8 + j2;
                EID[(size_t)trow * 2] = e1; EID[(size_t)trow * 2 + 1] = e2; GATE[(size_t)trow * 2] = pg * den; GATE[(size_t)trow * 2 + 1] = pg * p2 * den;
                __hip_atomic_fetch_add(lcnt + e1, 1, __ATOMIC_RELAXED, __HIP_MEMORY_SCOPE_WORKGROUP); __hip_atomic_fetch_add(lcnt + e2, 1, __ATOMIC_RELAXED, __HIP_MEMORY_SCOPE_WORKGROUP); }
#pragma unroll
            for (int i = 0; i < 8; ++i) xv[i] = xn[i];
        }
        __syncthreads();
        if (tid < 32) CNT[item * 32 + tid] = lcnt[tid];
        if (item == 0 && tid < 128) *(v4u*)(H + (size_t)T * 1024 + 8 * tid) = (v4u){0u, 0u, 0u, 0u};
    }
}
__device__ __forceinline__ void phase_moe_scatter(const Args& args, LAS unsigned char* lds) {
    int tid_ = threadIdx.x; asm volatile("" : "+v"(tid_)); const int tid = tid_, lane = tid & 63, wave = __builtin_amdgcn_readfirstlane(tid >> 6), G = gridDim.x, bid = blockIdx.x; (void)tid; (void)lane; (void)wave;
    unsigned char* ws = uni_ptr(args.ws);
    const int* EID = (const int*)(ws + WS_EID); int* SLOT = (int*)(ws + WS_SLOT); const int* CNT = (const int*)(ws + WS_CNT); int* TILEE = (int*)(ws + WS_TILEE); int* TOK = (int*)(ws + WS_TOK);
    LAS int* tot = (LAS int*)lds; LAS int* before = tot + 32; LAS int* pstart = tot + 64; LAS int* lcnt = tot + 96; LAS int* lslot = tot + 128; LAS int* psum = tot + 384; LAS int* pbef = tot + 896;
    for (int item = bid; item < T / 128; item += G) {
        const int r0 = item * 128;
        __syncthreads();
        { const int e = tid & 31, part = tid >> 5; int s_ = 0, b_ = 0; int cv[16];
#pragma unroll
          for (int i = 0; i < 16; ++i) cv[i] = CNT[(part * 16 + i) * 32 + e];
#pragma unroll
          for (int i = 0; i < 16; ++i) { s_ += cv[i]; b_ += (part * 16 + i < item) ? cv[i] : 0; }
          psum[part * 32 + e] = s_; pbef[part * 32 + e] = b_; }
        __syncthreads();
        if (tid < 32) { int t_ = 0, b_ = 0;
#pragma unroll
            for (int p = 0; p < 16; ++p) { t_ += psum[p * 32 + tid]; b_ += pbef[p * 32 + tid]; }
            tot[tid] = t_; before[tid] = b_; lcnt[tid] = 0; }
        __syncthreads();
        if (tid == 0) { int ps = 0; for (int e = 0; e < 32; ++e) { pstart[e] = ps; ps += (tot[e] + 255) & ~255; }
            if (item == 0) { TILEE[0] = ps >> 8; for (int e = 0; e < 32; ++e) { const int t0 = pstart[e] >> 8, nt = ((tot[e] + 255) >> 8); for (int i = 0; i < nt; ++i) TILEE[16 + t0 + i] = e; } } }
        __syncthreads();
        if (tid < 256) { const int e = EID[(size_t)r0 * 2 + tid]; const int rank = __hip_atomic_fetch_add(lcnt + e, 1, __ATOMIC_RELAXED, __HIP_MEMORY_SCOPE_WORKGROUP); const int slot = pstart[e] + before[e] + rank; SLOT[(size_t)r0 * 2 + tid] = slot; lslot[tid] = slot; }
        __syncthreads();
        if (tid < 256) TOK[lslot[tid]] = r0 + (tid >> 1);
        { const int e = item & 31, part = item >> 5; const int p0 = pstart[e] + tot[e], npad = ((tot[e] + 255) & ~255) - tot[e];
          if (tid < 32 && part * 32 + tid < npad) TOK[p0 + part * 32 + tid] = T; }
    }
}
__device__ __forceinline__ void phase_moe_combine(const Args& args, int L) {
    int tid_ = threadIdx.x; asm volatile("" : "+v"(tid_)); const int tid = tid_, lane = tid & 63, wave = __builtin_amdgcn_readfirstlane(tid >> 6), G = gridDim.x, bid = blockIdx.x; (void)tid; (void)lane; (void)wave;
    unsigned char* ws = uni_ptr(args.ws); float* X = args.out; const bf16* Y = (const bf16*)(ws + WS_ACT + A_Y); bf16* H = (bf16*)(ws + WS_ACT + A_H);
    const int* SLOT = (const int*)(ws + WS_SLOT); const float* GATE = (const float*)(ws + WS_GATE); const float* MOD = (const float*)(ws + WS_MOD);
    for (int t = bid * NWAVES + wave; t < T; t += G * NWAVES) { const int b = t / SEQ;
        const int s0 = SLOT[(size_t)t * 2], s1 = SLOT[(size_t)t * 2 + 1]; const float g0 = GATE[(size_t)t * 2], g1 = GATE[(size_t)t * 2 + 1];
        const float* gf = MOD + (size_t)(L * 2 + b) * 6144 + 5120; f32x4 v[4];
#pragma unroll
        for (int j = 0; j < 4; ++j) { const int c = 4 * lane + 256 * j; const f32x4 x = *(const f32x4*)(X + (size_t)t * 1024 + c), gg = *(const f32x4*)(gf + c);
            const v2u y0 = *(const v2u*)(Y + (size_t)s0 * 1024 + c), y1 = *(const v2u*)(Y + (size_t)s1 * 1024 + c);
            f32x4 mo; mo[0] = g0 * bflo(y0.x) + g1 * bflo(y1.x); mo[1] = g0 * bfhi(y0.x) + g1 * bfhi(y1.x); mo[2] = g0 * bflo(y0.y) + g1 * bflo(y1.y); mo[3] = g0 * bfhi(y0.y) + g1 * bfhi(y1.y);
            v[j] = x + gg * mo; *(f32x4*)(X + (size_t)t * 1024 + c) = v[j]; }
        if (L < 3) { const float* m = MOD + (size_t)((L + 1) * 2 + b) * 6144; norm_store_row(v, args.in[LBASE(L + 1)], m, m + 1024, H + (size_t)t * 1024, lane); }
    }
}

constexpr int N_PHASES = 37;

#ifndef DUP_MASK
#define DUP_MASK 0
#endif
#define PHASE(k) if ((lo <= (k) && (k) < hi) && ((started ? (xcd_barrier(bar), 0) : 0), started = true, true))
#define NREP(g) (1 + ((DUP_MASK >> (g)) & 1))
#define PHASE_G(k, g) PHASE(k) for (int rep_ = 0; rep_ < NREP(g); ++rep_, ((rep_ < NREP(g)) ? (xcd_barrier(bar), 0) : 0))
template <int L> __device__ __forceinline__ void run_layer(const Args& args, LAS unsigned char* lds, const XcdBarrier& bar, bool& started, const int lo, const int hi) {
    const int G = gridDim.x, bid = blockIdx.x;
    unsigned char* ws = uni_ptr(args.ws);
    const float* MOD = (const float*)(ws + WS_MOD);
    bf16* Hb = (bf16*)(ws + WS_ACT + A_H);

        const int pb = (L == 0) ? 1 : (L == 1 ? 10 : (L == 2 ? 21 : 29));
        const float* xsrc = (L == 0) ? args.in[0] : (const float*)args.out;
        const float* gate_m = MOD + (size_t)L * 2 * 6144 + 2048;
        int mb;
        if constexpr (L == 0 || L == 3) {
            int g0 = pb;
            if (L == 0) { PHASE_G(pb, 8) { phase_norm0(args); } g0 = pb + 1; }
            const bf16* Win = (const bf16*)(ws + WS_WMIX + (L == 0 ? WMIX_GM_IN0 : WMIX_GM_IN3)); const bf16* Wout = (const bf16*)(ws + WS_WMIX + (L == 0 ? WMIX_GM_OUT0 : WMIX_GM_OUT3));
            PHASE_G(g0, 1) { pg8::Gemm g{Hb, Win, T, 2048, 1024}; pg8::StaticOrder S; S.init(T, 2048, G, bid);
                EpiGm1 E{(bf16*)(ws + WS_ACT + A_U), (bf16*)(ws + WS_ACT + A_V), (float*)(ws + WS_VSSP)};
                pg8::gemm_phase<EpiGm1, pg8::StaticOrder, true, true>(lds, g, S, E); }
            PHASE_G(g0 + 1, 2) { phase_gm_spatial(args, L, lds); }
            PHASE_G(g0 + 2, (L == 0 ? 1 : 31)) { pg8::Gemm g{(const bf16*)(ws + WS_ACT + A_GATED), Wout, T, 1024, 1024}; pg8::StaticOrder S; S.init(T, 1024, G, bid);
                EpiRes E{xsrc, args.out, gate_m};
                pg8::gemm_phase<EpiRes, pg8::StaticOrder, true, true>(lds, g, S, E); }
            mb = g0 + 3;
        } else if constexpr (L == 1) {
            PHASE_G(pb, 1) { pg8::Gemm g{Hb, (const bf16*)(ws + WS_WMIX + WMIX_DN_IN), T, 3328, 1024}; pg8::StaticOrder S; S.init(T, 3328, G, bid);
                EpiDn1 E{(bf16*)(ws + WS_ACT + A_QKV), (bf16*)(ws + WS_ACT + A_Z), (float*)(ws + WS_BA)};
                pg8::gemm_phase<EpiDn1, pg8::StaticOrder, true, true>(lds, g, S, E); }
            PHASE_G(pb + 1, 3) { phase_dn_prep(args); }
            PHASE_G(pb + 2, 4) { phase_dn_chunk(args, lds); }
            PHASE_G(pb + 3, 5) { phase_dn_scan(args, lds); }
            PHASE_G(pb + 4, 3) { phase_dn_ogate(args); }
            PHASE(pb + 5) { pg8::Gemm g{Hb, (const bf16*)(ws + WS_WMIX + WMIX_DN_OUT), T, 1024, 1024}; pg8::StaticOrder S; S.init(T, 1024, G, bid);
                EpiRes E{xsrc, args.out, gate_m};
                pg8::gemm_phase<EpiRes, pg8::StaticOrder, true, true>(lds, g, S, E); }
            mb = pb + 6;
        } else {
            PHASE_G(pb, 1) { pg8::Gemm g{Hb, (const bf16*)(ws + WS_WMIX + WMIX_SWA_IN), T, 1536, 1024}; pg8::StaticOrder S; S.init(T, 1536, G, bid);
                EpiBf E{(bf16*)(ws + WS_ACT + A_QKV), 1536, 0xffff};
                pg8::gemm_phase<EpiBf, pg8::StaticOrder, true, true>(lds, g, S, E); }
            PHASE_G(pb + 1, 2) { phase_swa_attn(args, lds); }
            PHASE(pb + 2) { pg8::Gemm g{Hb, (const bf16*)(ws + WS_WMIX + WMIX_SWA_OUT), T, 1024, 1024}; pg8::StaticOrder S; S.init(T, 1024, G, bid);
                EpiRes E{xsrc, args.out, gate_m};
                pg8::gemm_phase<EpiRes, pg8::StaticOrder, true, true>(lds, g, S, E); }
            mb = pb + 3;
        }
        PHASE_G(mb, 6) { phase_moe_router(args, L, lds); }
        PHASE_G(mb + 1, 9) { phase_moe_scatter(args, lds); }
        const int* TILEE = (const int*)(ws + WS_TILEE);
        PHASE_G(mb + 2, 7) { const int ntiles = TILEE[0]; pg8::Gemm g{Hb, (const bf16*)(ws + WS_W + (size_t)L * 96 * MiB), MAXROWS, 1024, 1024};
            MoeOrder S; S.init(TILEE + 16, ntiles, G, bid); EpiMoe1 E{(bf16*)(ws + WS_ACT + A_ACTV)};
            LAS int* lidx = (LAS int*)(lds + LDSCTL_OFF + 2048); const int* TOK = (const int*)(ws + WS_TOK);
            __syncthreads();
            for (int ui = 0; ui < 5; ++ui) { pg8::Unit u; if (S.next(ui, u) && threadIdx.x < 256) lidx[ui * 256 + threadIdx.x] = TOK[u.pm * 256 + threadIdx.x]; }
            __syncthreads();
            pg8::gemm_phase_gather<EpiMoe1, MoeOrder, true, true>(lds, g, S, E, lidx); }
        PHASE_G(mb + 3, 7) { const int ntiles = TILEE[0]; pg8::Gemm g{(const bf16*)(ws + WS_ACT + A_ACTV), (const bf16*)(ws + WS_W + (size_t)L * 96 * MiB + 64 * MiB), MAXROWS, 1024, 512};
            MoeOrder S; S.init(TILEE + 16, ntiles, G, bid); EpiBf E{(bf16*)(ws + WS_ACT + A_Y), 1024, 3};
            pg8::gemm_phase<EpiBf, MoeOrder, true, true>(lds, g, S, E); }
        PHASE(mb + 4) { phase_moe_combine(args, L); }

}
__global__ void __launch_bounds__(NTHR, 2) fwd_kernel(Args args) {
    extern __shared__ __attribute__((aligned(16))) unsigned char lds_raw[];
    LAS unsigned char* lds = (LAS unsigned char*)lds_raw;
    const int tid = threadIdx.x;
    unsigned char* ws = uni_ptr(args.ws);
    for (int u = tid; u < (LDS_BYTES - LDSCTL_OFF) / 4; u += NTHR) ((LAS unsigned*)(lds + LDSCTL_OFF))[u] = 0u;
    __syncthreads();
    volatile LAS unsigned* MISC = (volatile LAS unsigned*)(lds + MISC_OFF);
    XcdBarrier bar = xcd_barrier_post((unsigned*)(ws + WS_CTL) + 4096 + (size_t)args.li * XCD_BAR_WORDS, MISC + 8);
    const int lo = args.ph_lo, hi = args.ph_hi; bool started = false;
    const float* MOD = (const float*)(ws + WS_MOD);
    bf16* Hb = (bf16*)(ws + WS_ACT + A_H);

    PHASE_G(0, 0) { phase_prologue(args, lds); }

    run_layer<0>(args, lds, bar, started, lo, hi);
    run_layer<1>(args, lds, bar, started, lo, hi);
    run_layer<2>(args, lds, bar, started, lo, hi);
    run_layer<3>(args, lds, bar, started, lo, hi);
#undef PHASE
#undef PHASE_G
}

extern "C" void kernel_launch(void* const* d_in, const int* in_sizes, int n_in, void* d_out, int out_size, void* d_ws, size_t ws_size, hipStream_t stream) {
    static int grid = 0;
    if (grid == 0) {
        if (n_in != N_IN || in_sizes[0] != T * D || out_size != T * D || ws_size < WS_END) { fprintf(stderr, "kernel_launch: unexpected shapes (n_in %d, in0 %d, out %d, ws %zu < %zu)\n", n_in, n_in > 0 ? in_sizes[0] : -1, out_size, ws_size, (size_t)WS_END); grid = -1; return; }
        int dev = 0, cus = 0, per_cu = 0;
        if (hipGetDevice(&dev) != hipSuccess || hipDeviceGetAttribute(&cus, hipDeviceAttributeMultiprocessorCount, dev) != hipSuccess) { grid = -1; return; }
        if (hipFuncSetAttribute((const void*)fwd_kernel, hipFuncAttributeMaxDynamicSharedMemorySize, LDS_BYTES) != hipSuccess) { fprintf(stderr, "kernel_launch: hipFuncSetAttribute failed\n"); grid = -1; return; }
        if (hipOccupancyMaxActiveBlocksPerMultiprocessor(&per_cu, (const void*)fwd_kernel, NTHR, LDS_BYTES) != hipSuccess || per_cu < 1) fprintf(stderr, "kernel_launch: occupancy query reports %d\n", per_cu);
        (void)hipGetLastError();
        grid = cus;
    }
    if (grid < 0) return;
    if (hipMemsetAsync((char*)d_ws + WS_CTL, 0, CTL_ZERO_BYTES, stream) != hipSuccess) return;
    Args a{};
    for (int i = 0; i < N_IN; ++i) a.in[i] = (const float*)d_in[i];
    a.out = (float*)d_out; a.ws = (unsigned char*)d_ws; a.pad = 0;
#if MK_LAUNCH_MODE == 1
    a.ph_lo = 0; a.ph_hi = N_PHASES; a.li = 0;
    hipLaunchKernelGGL(fwd_kernel, dim3(grid), dim3(NTHR), LDS_BYTES, stream, a);
#else
    for (int p = 0; p < N_PHASES; ++p) { a.ph_lo = p; a.ph_hi = p + 1; a.li = 0;
        hipLaunchKernelGGL(fwd_kernel, dim3(grid), dim3(NTHR), LDS_BYTES, stream, a); }
#endif
}
```

```cpp
#include <hip/hip_runtime.h>
#include <cstdio>
#include <cstdint>
#ifndef MK_LAUNCH_MODE
#define MK_LAUNCH_MODE 1
#endif
namespace pg8 {
#define PG8_LAS __attribute__((address_space(3)))
typedef unsigned short bf16_t;
typedef short bf16x8 __attribute__((ext_vector_type(8)));
typedef float f32x4 __attribute__((ext_vector_type(4)));
typedef unsigned u32x4 __attribute__((ext_vector_type(4)));
constexpr int BM = 256, BK = 64, HALF = 128, HTB = HALF * BK * 2  , STAGE_BYTES = 8 * HTB, NXCD = 8, WGM = 8;

__host__ __device__ __forceinline__ int lds_byte(int r, int c) { const int st = (r >> 4) * 2 + (c >> 5), rr = r & 15, cc = c & 31, ob = rr * 64 + cc * 2; return st * 1024 + (ob ^ (((ob >> 9) & 1) << 5)); }
__host__ __device__ __forceinline__ void stage_rc(int b, int& R, int& C) { const int st = b / 1024, sb = b % 1024, swz = sb ^ (((sb >> 9) & 1) << 5); R = (st >> 1) * 16 + swz / 64; C = (st & 1) * 32 + (swz % 64) / 2; }
__host__ __device__ __forceinline__ int perm32(int rho) { const int n = rho >> 4, i = rho & 15; return 8 * (i >> 2) + 4 * n + (i & 3); }

struct Unit { int pm, pn; };
struct Gemm { const bf16_t* A; const bf16_t* Bt; int M, N, K; };

struct StaticOrder {
    int nM, nN, nwg, G, c;
    __host__ __device__ void init(int M, int N, int G_, int c_) { nM = M / BM; nN = N / BM; nwg = nM * nN; G = G_; c = c_; }
    __host__ __device__ bool next(int i, Unit& u) const {
        const long L = (long)i * G + c; if (L >= nwg) return false;
        int wgid = (int)L; { const int q = nwg / NXCD, r = nwg % NXCD, xcd = wgid % NXCD, off = wgid / NXCD; wgid = (xcd < r ? xcd * (q + 1) : r * (q + 1) + (xcd - r) * q) + off; }
        const int nig = WGM * nN, gid = wgid / nig, fm = gid * WGM, gsz = (nM - fm) < WGM ? (nM - fm) : WGM;
        u.pm = fm + ((wgid % nig) % gsz); u.pn = (wgid % nig) / gsz; return true;
    }
    __device__ __forceinline__ void a_ready(const Unit&) const {}
    __device__ __forceinline__ void done(const Unit&) const {}
};
typedef float f32x2_ __attribute__((ext_vector_type(2))); typedef __bf16 bf16x2_ __attribute__((ext_vector_type(2)));
__device__ __forceinline__ unsigned cvt_pk_bf16(float lo, float hi) { const f32x2_ v = {lo, hi}; return __builtin_bit_cast(unsigned, __builtin_convertvector(v, bf16x2_)); }
typedef float f32x2 __attribute__((ext_vector_type(2)));
template <class Epi, class Sched, bool ALIGN_EPI = false, bool SP2 = false>
__device__ __forceinline__ void gemm_phase(PG8_LAS unsigned char* lds, const Gemm g, const Sched& S, const Epi& E) {
    const int tid = threadIdx.x, wid = __builtin_amdgcn_readfirstlane(tid >> 6), lane = tid & 63, wr = wid >> 2, wc = wid & 3, fr = lane & 15, fq = lane >> 4;
    const int K = g.K, nt = K / BK;
    unsigned voffA[2], voffB[2];
#pragma unroll
    for (int i = 0; i < 2; ++i) { int R, C; stage_rc(tid * 16 + i * 8192, R, C); const int Rb = Epi::PERM ? ((R & ~31) + perm32(R & 31)) : R;
        voffA[i] = (unsigned)(R * K + C) * 2u; voffB[i] = (unsigned)(Rb * K + C) * 2u; }
    const size_t kstep = (size_t)(BK * 2);
    const size_t hstep = (size_t)HALF * K * 2;
    const size_t tstep = 2 * hstep;
    const unsigned ldsw = (unsigned)wid * 1024u;
    const int aoff = lds_byte(wr * 64 + fr, fq * 8), boff = lds_byte(wc * 32 + fr, fq * 8);
#define PG8_SA(b, h) (((b) * 2 + (h)) * HTB)
#define PG8_SB(b, h) ((4 + (b) * 2 + (h)) * HTB)
#define PG8_STAGE(bufoff, gbase, voff) do { _Pragma("unroll") for (int _i = 0; _i < 2; ++_i) \
        __builtin_amdgcn_global_load_lds((const unsigned*)((const char*)(gbase) + (voff)[_i]), (PG8_LAS unsigned*)(lds + (bufoff) + ldsw + _i * 8192), 16, 0, 0); } while (0)
#define PG8_LDA(dst, b, h) do { _Pragma("unroll") for (int m = 0; m < 4; ++m) _Pragma("unroll") for (int k = 0; k < 2; ++k) dst[m][k] = *(const PG8_LAS bf16x8*)(lds + PG8_SA(b, h) + aoff + m * 2048 + k * 1024); } while (0)
#define PG8_LDB(dst, b, h) do { _Pragma("unroll") for (int n = 0; n < 2; ++n) _Pragma("unroll") for (int k = 0; k < 2; ++k) dst[n][k] = *(const PG8_LAS bf16x8*)(lds + PG8_SB(b, h) + boff + n * 2048 + k * 1024); } while (0)
#define PG8_MMA(ai, bj, At, Bt) do { __builtin_amdgcn_s_setprio(1); _Pragma("unroll") for (int m = 0; m < 4; ++m) _Pragma("unroll") for (int n = 0; n < 2; ++n) _Pragma("unroll") for (int k = 0; k < 2; ++k) \
        acc[ai][bj][m][n] = __builtin_amdgcn_mfma_f32_16x16x32_bf16(Bt[n][k], At[m][k], acc[ai][bj][m][n], 0, 0, 0); __builtin_amdgcn_s_setprio(0); } while (0)
#define PG8_WAIT_V(n) asm volatile("s_waitcnt vmcnt(" #n ")" ::: "memory")
#define PG8_WAIT_L(n) asm volatile("s_waitcnt lgkmcnt(" #n ")" ::: "memory")
#define PG8_BAR __builtin_amdgcn_s_barrier()
#define PG8_SCHED __builtin_amdgcn_sched_barrier(0)
    Unit cur, nxt; int ui = 0;
    if (!S.next(0, cur)) return;
    f32x4 acc[2][2][4][2];
#pragma unroll
    for (int a = 0; a < 2; ++a)
#pragma unroll
        for (int b = 0; b < 2; ++b)
#pragma unroll
            for (int m = 0; m < 4; ++m)
#pragma unroll
                for (int n = 0; n < 2; ++n) acc[a][b][m][n] = (f32x4){0.f, 0.f, 0.f, 0.f};
    bf16x8 At[4][2], B0[2][2], B1[2][2];
    const char* cA = (const char*)g.A + (size_t)cur.pm * tstep; const char* cB = (const char*)g.Bt + (size_t)cur.pn * tstep;
    S.a_ready(cur);
    if constexpr (SP2) {
        PG8_STAGE(PG8_SB(0, 0), cB, voffB); PG8_STAGE(PG8_SB(0, 1), cB + hstep, voffB); PG8_STAGE(PG8_SA(0, 0), cA, voffA); PG8_STAGE(PG8_SA(0, 1), cA + hstep, voffA);
        if (wr == 1) PG8_BAR;
        PG8_WAIT_V(2); PG8_BAR;
        PG8_STAGE(PG8_SB(1, 0), cB + kstep, voffB); PG8_STAGE(PG8_SA(1, 0), cA + kstep, voffA); PG8_STAGE(PG8_SB(1, 1), cB + hstep + kstep, voffB);
        PG8_WAIT_V(6); PG8_BAR;
    } else {
        PG8_STAGE(PG8_SB(0, 0), cB, voffB); PG8_STAGE(PG8_SA(0, 0), cA, voffA); PG8_STAGE(PG8_SB(0, 1), cB + hstep, voffB); PG8_STAGE(PG8_SA(0, 1), cA + hstep, voffA);
        if (wr == 1) PG8_BAR;
        PG8_WAIT_V(4); PG8_BAR;
        PG8_STAGE(PG8_SB(1, 0), cB + kstep, voffB); PG8_STAGE(PG8_SA(1, 0), cA + kstep, voffA); PG8_STAGE(PG8_SB(1, 1), cB + hstep + kstep, voffB);
        PG8_WAIT_V(6); PG8_BAR;
    }
    for (;;) {
        const bool has_next = S.next(ui + 1, nxt);
        const char* nA = has_next ? (const char*)g.A + (size_t)nxt.pm * tstep : cA; const char* nB = has_next ? (const char*)g.Bt + (size_t)nxt.pn * tstep : cB;
        for (int t = 0; t < nt; t += 2) {
            const bool last = (t == nt - 2);
            const char* a1 = cA + (size_t)(t + 1) * kstep;
            const char* a2 = last ? nA : cA + (size_t)(t + 2) * kstep; const char* b2 = last ? nB : cB + (size_t)(t + 2) * kstep;
            const char* a3 = a2 + kstep; const char* b3 = b2 + kstep;
            if (last && has_next) S.a_ready(nxt);
            if constexpr (SP2) {
            PG8_LDB(B0, 0, 0); PG8_LDB(B1, 0, 1); PG8_SCHED; PG8_LDA(At, 0, 0); PG8_STAGE(PG8_SA(1, 1), a1 + hstep, voffA);
            PG8_WAIT_V(8); PG8_WAIT_L(0); PG8_BAR; PG8_MMA(0, 0, At, B0); PG8_MMA(0, 1, At, B1); PG8_BAR; PG8_SCHED;
            PG8_LDA(At, 0, 1); PG8_STAGE(PG8_SB(0, 0), b2, voffB); PG8_STAGE(PG8_SB(0, 1), b2 + hstep, voffB); PG8_STAGE(PG8_SA(0, 0), a2, voffA);
            PG8_WAIT_V(8); PG8_WAIT_L(0); PG8_BAR; PG8_MMA(1, 0, At, B0); PG8_MMA(1, 1, At, B1); PG8_BAR; PG8_SCHED;
            PG8_LDB(B0, 1, 0); PG8_LDB(B1, 1, 1); PG8_SCHED; PG8_LDA(At, 1, 0); PG8_STAGE(PG8_SA(0, 1), a2 + hstep, voffA);
            PG8_WAIT_V(8); PG8_WAIT_L(0); PG8_BAR; PG8_MMA(0, 0, At, B0); PG8_MMA(0, 1, At, B1); PG8_BAR; PG8_SCHED;
            PG8_LDA(At, 1, 1); PG8_STAGE(PG8_SB(1, 0), b3, voffB); PG8_STAGE(PG8_SB(1, 1), b3 + hstep, voffB); PG8_STAGE(PG8_SA(1, 0), a3, voffA);
            PG8_WAIT_V(8); PG8_WAIT_L(0); PG8_BAR; PG8_MMA(1, 0, At, B0); PG8_MMA(1, 1, At, B1); PG8_BAR; PG8_SCHED;
            } else {
            PG8_LDB(B0, 0, 0); PG8_SCHED; PG8_LDA(At, 0, 0); PG8_STAGE(PG8_SA(1, 1), a1 + hstep, voffA);
            PG8_WAIT_L(8); PG8_BAR; PG8_WAIT_L(0); PG8_MMA(0, 0, At, B0); PG8_BAR; PG8_SCHED;
            PG8_LDB(B1, 0, 1); PG8_STAGE(PG8_SB(0, 0), b2, voffB);
            PG8_BAR; PG8_WAIT_L(0); PG8_MMA(0, 1, At, B1); PG8_BAR;
            PG8_LDA(At, 0, 1); PG8_STAGE(PG8_SA(0, 0), a2, voffA);
            PG8_BAR; PG8_WAIT_L(0); PG8_MMA(1, 0, At, B0); PG8_BAR; PG8_SCHED;
            PG8_STAGE(PG8_SB(0, 1), b2 + hstep, voffB);
            PG8_WAIT_V(6); PG8_BAR; PG8_MMA(1, 1, At, B1); PG8_BAR;
            PG8_LDB(B0, 1, 0); PG8_SCHED; PG8_LDA(At, 1, 0); PG8_STAGE(PG8_SA(0, 1), a2 + hstep, voffA);
            PG8_WAIT_L(8); PG8_BAR; PG8_WAIT_L(0); PG8_MMA(0, 0, At, B0); PG8_BAR; PG8_SCHED;
            PG8_LDB(B1, 1, 1); PG8_STAGE(PG8_SB(1, 0), b3, voffB);
            PG8_BAR; PG8_WAIT_L(0); PG8_MMA(0, 1, At, B1); PG8_BAR;
            PG8_LDA(At, 1, 1); PG8_STAGE(PG8_SA(1, 0), a3, voffA);
            PG8_BAR; PG8_WAIT_L(0); PG8_MMA(1, 0, At, B0); PG8_BAR; PG8_SCHED;
            PG8_STAGE(PG8_SB(1, 1), b3 + hstep, voffB);
            PG8_WAIT_V(6); PG8_BAR; PG8_MMA(1, 1, At, B1); PG8_BAR;
            }
        }
        if constexpr (ALIGN_EPI) { if (wr == 0) PG8_BAR; }
        if constexpr (!Epi::AFTER_DRAIN) { E(acc, cur, wr, wc, fr, fq); S.done(cur); }
        if (!has_next) break;
#pragma unroll
        for (int a = 0; a < 2; ++a)
#pragma unroll
            for (int b = 0; b < 2; ++b)
#pragma unroll
                for (int m = 0; m < 4; ++m)
#pragma unroll
                    for (int n = 0; n < 2; ++n) acc[a][b][m][n] = (f32x4){0.f, 0.f, 0.f, 0.f};
        cur = nxt; cA = nA; cB = nB; ++ui;
        if constexpr (ALIGN_EPI) { if (wr == 1) PG8_BAR; }
    }
    PG8_WAIT_V(0);
    if constexpr (!ALIGN_EPI) { if (wr == 0) PG8_BAR; }
    PG8_BAR;
    if constexpr (Epi::AFTER_DRAIN) { E.fused(acc, cur, wr, wc, fr, fq, lds, wid, lane); S.done(cur); }
#undef PG8_SA
#undef PG8_SB
#undef PG8_STAGE
#undef PG8_LDA
#undef PG8_LDB
#undef PG8_MMA
#undef PG8_WAIT_V
#undef PG8_WAIT_L
#undef PG8_BAR
#undef PG8_SCHED
}

template <class Epi, class Sched, bool ALIGN_EPI = true, bool SP2 = true>
__device__ __forceinline__ void gemm_phase_gather(PG8_LAS unsigned char* lds, const Gemm g, const Sched& S, const Epi& E, const PG8_LAS int* lidx) {
    static_assert(SP2 && ALIGN_EPI, "gather variant: SP2 + ALIGN_EPI only");
    const int tid = threadIdx.x, wid = __builtin_amdgcn_readfirstlane(tid >> 6), lane = tid & 63, wr = wid >> 2, wc = wid & 3, fr = lane & 15, fq = lane >> 4;
    const int K = g.K, nt = K / BK;
    unsigned voffB[2]; int RA[2]; unsigned CA[2];
#pragma unroll
    for (int i = 0; i < 2; ++i) { int R, C; stage_rc(tid * 16 + i * 8192, R, C); const int Rb = Epi::PERM ? ((R & ~31) + perm32(R & 31)) : R;
        RA[i] = R; CA[i] = (unsigned)C * 2u; voffB[i] = (unsigned)(Rb * K + C) * 2u; }
    unsigned ca[2][2], na[2][2];
#define PG8_ROWOFF(dst, ui_) do { _Pragma("unroll") for (int h_ = 0; h_ < 2; ++h_) _Pragma("unroll") for (int i_ = 0; i_ < 2; ++i_) dst[h_][i_] = (unsigned)lidx[(ui_) * 256 + h_ * 128 + RA[i_]] * (unsigned)(K * 2) + CA[i_]; } while (0)
#define PG8_STAGEA(bufoff, kb, vo) do { _Pragma("unroll") for (int _i = 0; _i < 2; ++_i) \
        __builtin_amdgcn_global_load_lds((const unsigned*)((const char*)g.A + (size_t)(kb) + (vo)[_i]), (PG8_LAS unsigned*)(lds + (bufoff) + ldsw + _i * 8192), 16, 0, 0); } while (0)
    const size_t kstep = (size_t)(BK * 2);
    const size_t hstep = (size_t)HALF * K * 2;
    const size_t tstep = 2 * hstep;
    const unsigned ldsw = (unsigned)wid * 1024u;
    const int aoff = lds_byte(wr * 64 + fr, fq * 8), boff = lds_byte(wc * 32 + fr, fq * 8);
#define PG8_SA(b, h) (((b) * 2 + (h)) * HTB)
#define PG8_SB(b, h) ((4 + (b) * 2 + (h)) * HTB)
#define PG8_STAGE(bufoff, gbase, voff) do { _Pragma("unroll") for (int _i = 0; _i < 2; ++_i) \
        __builtin_amdgcn_global_load_lds((const unsigned*)((const char*)(gbase) + (voff)[_i]), (PG8_LAS unsigned*)(lds + (bufoff) + ldsw + _i * 8192), 16, 0, 0); } while (0)
#define PG8_LDA(dst, b, h) do { _Pragma("unroll") for (int m = 0; m < 4; ++m) _Pragma("unroll") for (int k = 0; k < 2; ++k) dst[m][k] = *(const PG8_LAS bf16x8*)(lds + PG8_SA(b, h) + aoff + m * 2048 + k * 1024); } while (0)
#define PG8_LDB(dst, b, h) do { _Pragma("unroll") for (int n = 0; n < 2; ++n) _Pragma("unroll") for (int k = 0; k < 2; ++k) dst[n][k] = *(const PG8_LAS bf16x8*)(lds + PG8_SB(b, h) + boff + n * 2048 + k * 1024); } while (0)
#define PG8_MMA(ai, bj, At, Bt) do { __builtin_amdgcn_s_setprio(1); _Pragma("unroll") for (int m = 0; m < 4; ++m) _Pragma("unroll") for (int n = 0; n < 2; ++n) _Pragma("unroll") for (int k = 0; k < 2; ++k) \
        acc[ai][bj][m][n] = __builtin_amdgcn_mfma_f32_16x16x32_bf16(Bt[n][k], At[m][k], acc[ai][bj][m][n], 0, 0, 0); __builtin_amdgcn_s_setprio(0); } while (0)
#define PG8_WAIT_V(n) asm volatile("s_waitcnt vmcnt(" #n ")" ::: "memory")
#define PG8_WAIT_L(n) asm volatile("s_waitcnt lgkmcnt(" #n ")" ::: "memory")
#define PG8_BAR __builtin_amdgcn_s_barrier()
#define PG8_SCHED __builtin_amdgcn_sched_barrier(0)
    Unit cur, nxt; int ui = 0;
    if (!S.next(0, cur)) return;
    f32x4 acc[2][2][4][2];
#pragma unroll
    for (int a = 0; a < 2; ++a)
#pragma unroll
        for (int b = 0; b < 2; ++b)
#pragma unroll
            for (int m = 0; m < 4; ++m)
#pragma unroll
                for (int n = 0; n < 2; ++n) acc[a][b][m][n] = (f32x4){0.f, 0.f, 0.f, 0.f};
    bf16x8 At[4][2], B0[2][2], B1[2][2];
    const char* cB = (const char*)g.Bt + (size_t)cur.pn * tstep; PG8_ROWOFF(ca, 0);
    S.a_ready(cur);
    if constexpr (SP2) {
        PG8_STAGE(PG8_SB(0, 0), cB, voffB); PG8_STAGE(PG8_SB(0, 1), cB + hstep, voffB); PG8_STAGEA(PG8_SA(0, 0), 0, ca[0]); PG8_STAGEA(PG8_SA(0, 1), 0, ca[1]);
        if (wr == 1) PG8_BAR;
        PG8_WAIT_V(2); PG8_BAR;
        PG8_STAGE(PG8_SB(1, 0), cB + kstep, voffB); PG8_STAGEA(PG8_SA(1, 0), kstep, ca[0]); PG8_STAGE(PG8_SB(1, 1), cB + hstep + kstep, voffB);
        PG8_WAIT_V(6); PG8_BAR;
    }
    for (;;) {
        const bool has_next = S.next(ui + 1, nxt);
        const char* nB = has_next ? (const char*)g.Bt + (size_t)nxt.pn * tstep : cB;
        if (has_next) PG8_ROWOFF(na, ui + 1); else { _Pragma("unroll") for (int h_ = 0; h_ < 2; ++h_) _Pragma("unroll") for (int i_ = 0; i_ < 2; ++i_) na[h_][i_] = ca[h_][i_]; }
        for (int t = 0; t < nt; t += 2) {
            const bool last = (t == nt - 2);
            const size_t k1 = (size_t)(t + 1) * kstep, k2 = last ? (size_t)0 : (size_t)(t + 2) * kstep, k3 = k2 + kstep;
            unsigned o2[2][2];
#pragma unroll
            for (int h_ = 0; h_ < 2; ++h_)
#pragma unroll
                for (int i_ = 0; i_ < 2; ++i_) o2[h_][i_] = last ? na[h_][i_] : ca[h_][i_];
            const char* b2 = last ? nB : cB + (size_t)(t + 2) * kstep; const char* b3 = b2 + kstep;
            if (last && has_next) S.a_ready(nxt);
            if constexpr (SP2) {
            PG8_LDB(B0, 0, 0); PG8_LDB(B1, 0, 1); PG8_SCHED; PG8_LDA(At, 0, 0); PG8_STAGEA(PG8_SA(1, 1), k1, ca[1]);
            PG8_WAIT_V(8); PG8_WAIT_L(0); PG8_BAR; PG8_MMA(0, 0, At, B0); PG8_MMA(0, 1, At, B1); PG8_BAR; PG8_SCHED;
            PG8_LDA(At, 0, 1); PG8_STAGE(PG8_SB(0, 0), b2, voffB); PG8_STAGE(PG8_SB(0, 1), b2 + hstep, voffB); PG8_STAGEA(PG8_SA(0, 0), k2, o2[0]);
            PG8_WAIT_V(8); PG8_WAIT_L(0); PG8_BAR; PG8_MMA(1, 0, At, B0); PG8_MMA(1, 1, At, B1); PG8_BAR; PG8_SCHED;
            PG8_LDB(B0, 1, 0); PG8_LDB(B1, 1, 1); PG8_SCHED; PG8_LDA(At, 1, 0); PG8_STAGEA(PG8_SA(0, 1), k2, o2[1]);
            PG8_WAIT_V(8); PG8_WAIT_L(0); PG8_BAR; PG8_MMA(0, 0, At, B0); PG8_MMA(0, 1, At, B1); PG8_BAR; PG8_SCHED;
            PG8_LDA(At, 1, 1); PG8_STAGE(PG8_SB(1, 0), b3, voffB); PG8_STAGE(PG8_SB(1, 1), b3 + hstep, voffB); PG8_STAGEA(PG8_SA(1, 0), k3, o2[0]);
            PG8_WAIT_V(8); PG8_WAIT_L(0); PG8_BAR; PG8_MMA(1, 0, At, B0); PG8_MMA(1, 1, At, B1); PG8_BAR; PG8_SCHED;
            }
        }
        if constexpr (ALIGN_EPI) { if (wr == 0) PG8_BAR; }
        if constexpr (!Epi::AFTER_DRAIN) { E(acc, cur, wr, wc, fr, fq); S.done(cur); }
        if (!has_next) break;
#pragma unroll
        for (int a = 0; a < 2; ++a)
#pragma unroll
            for (int b = 0; b < 2; ++b)
#pragma unroll
                for (int m = 0; m < 4; ++m)
#pragma unroll
                    for (int n = 0; n < 2; ++n) acc[a][b][m][n] = (f32x4){0.f, 0.f, 0.f, 0.f};
        cur = nxt; cB = nB; ++ui;
        { _Pragma("unroll") for (int h_ = 0; h_ < 2; ++h_) _Pragma("unroll") for (int i_ = 0; i_ < 2; ++i_) ca[h_][i_] = na[h_][i_]; }
        if constexpr (ALIGN_EPI) { if (wr == 1) PG8_BAR; }
    }
    PG8_WAIT_V(0);
    if constexpr (!ALIGN_EPI) { if (wr == 0) PG8_BAR; }
    PG8_BAR;
    if constexpr (Epi::AFTER_DRAIN) { E.fused(acc, cur, wr, wc, fr, fq, lds, wid, lane); S.done(cur); }
#undef PG8_SA
#undef PG8_ROWOFF
#undef PG8_STAGEA
#undef PG8_SB
#undef PG8_STAGE
#undef PG8_LDA
#undef PG8_LDB
#undef PG8_MMA
#undef PG8_WAIT_V
#undef PG8_WAIT_L
#undef PG8_BAR
#undef PG8_SCHED
}
}

constexpr int NB = 2, SEQ = 16384, T = NB * SEQ, D = 1024;
constexpr float EPS = 1e-6f;
constexpr int NWAVES = 8, NTHR = 512;
constexpr int N_IN = 55;
__host__ __device__ constexpr int LBASE(int L) { return L == 0 ? 2 : (L == 1 ? 15 : (L == 2 ? 29 : 42)); }
__host__ __device__ constexpr int NMIX(int L) { return L == 1 ? 6 : 5; }

constexpr size_t MiB = 1u << 20;
constexpr size_t WS_CTL = 0, CTL_ZERO_BYTES = 1 * MiB;
constexpr size_t WS_MOD = 1 * MiB;
constexpr size_t WS_CNT = WS_MOD + 256 * 1024;
constexpr size_t WS_TILEE = WS_CNT + 64 * 1024;
constexpr size_t WS_EID = 2 * MiB;
constexpr size_t WS_GATE = WS_EID + 256 * 1024;
constexpr size_t WS_SLOT = WS_GATE + 256 * 1024;
constexpr size_t WS_VSSP = 3 * MiB;
constexpr size_t WS_BA = 5 * MiB;
constexpr size_t WS_DNB = 7 * MiB;
constexpr size_t WS_RTR = 9 * MiB;
constexpr size_t WS_TOK = 12 * MiB;
constexpr size_t WS_W = 16 * MiB;
constexpr size_t WS_WMIX = WS_W + 384 * MiB;
constexpr size_t WMIX_GM_IN0 = 0, WMIX_GM_OUT0 = 4 * MiB, WMIX_DN_IN = 6 * MiB, WMIX_DN_OUT = 13 * MiB, WMIX_SWA_IN = 15 * MiB, WMIX_SWA_OUT = 18 * MiB, WMIX_GM_IN3 = 20 * MiB, WMIX_GM_OUT3 = 24 * MiB;
constexpr size_t WS_ACT = 432 * MiB;
constexpr size_t A_H = 0;
constexpr size_t A_U = 64 * MiB, A_V = 128 * MiB, A_GATED = 192 * MiB;
constexpr size_t A_QKV = 64 * MiB, A_Z = 192 * MiB, A_QN = 256 * MiB, A_KN = 288 * MiB, A_VV = 320 * MiB, A_FA = 384 * MiB, A_FB = 484 * MiB, A_FU = 64 * MiB, A_O = 128 * MiB;
constexpr size_t A_XG = 64 * MiB, A_ACTV = 208 * MiB, A_Y = 280 * MiB;
constexpr size_t WS_END = WS_ACT + 548 * MiB;
constexpr int MAXROWS = 73728;

constexpr int RING_BYTES = 131072;
constexpr int LDSCTL_OFF = RING_BYTES, MISC_OFF = LDSCTL_OFF + 320;
constexpr int LDS_BYTES = 147456;

#define LAS __attribute__((address_space(3)))
typedef unsigned short bf16;
typedef unsigned v4u __attribute__((ext_vector_type(4)));
typedef unsigned v2u __attribute__((ext_vector_type(2)));
typedef float f32x4 __attribute__((ext_vector_type(4)));
typedef short bf16x8 __attribute__((ext_vector_type(8)));
typedef short bf16x4 __attribute__((ext_vector_type(4)));
#define LDS_WAIT() asm volatile("s_waitcnt lgkmcnt(0)" ::: "memory")
#define VM_WAIT() asm volatile("s_waitcnt vmcnt(0)" ::: "memory")
__device__ __forceinline__ unsigned pk2(float lo, float hi) { return pg8::cvt_pk_bf16(lo, hi); }
__device__ __forceinline__ float bflo(unsigned w) { return __uint_as_float(w << 16); }
__device__ __forceinline__ float bfhi(unsigned w) { return __uint_as_float(w & 0xffff0000u); }
__device__ __forceinline__ float bf1(unsigned short b) { return __uint_as_float(((unsigned)b) << 16); }
__device__ __forceinline__ float wave_sum(float v) {
#pragma unroll
    for (int o = 1; o < 64; o <<= 1) v += __shfl_xor(v, o);
    return v;
}
__device__ __forceinline__ float fast_exp(float x) { return __builtin_amdgcn_exp2f(x * 1.44269504089f); }
__device__ __forceinline__ float sigmoidf_(float x) { return __builtin_amdgcn_rcpf(1.0f + fast_exp(-x)); }
__device__ __forceinline__ float siluf_(float x) { return x * sigmoidf_(x); }
__device__ __forceinline__ float gelu_tanh(float x) { const float y = 1.5957691216057308f * (x + 0.044715f * x * x * x); return x * __builtin_amdgcn_rcpf(1.0f + fast_exp(-y)); }

#define RLX_AGENT __ATOMIC_RELAXED, __HIP_MEMORY_SCOPE_AGENT
__device__ __forceinline__ unsigned char* uni_ptr(unsigned char* p) { const unsigned long long w = (unsigned long long)p; const unsigned lo = __builtin_amdgcn_readfirstlane((unsigned)w), hi = __builtin_amdgcn_readfirstlane((unsigned)(w >> 32)); return (unsigned char*)(__attribute__((address_space(1))) unsigned char*)(((unsigned long long)hi << 32) | lo); }
#define XB_TMO      128
#define XB_XCNT(j)  (256  + 64 * (j))
#define XB_XSUB(j)  (1280 + 64 * (j))
#define XB_XGEN(j)  (2304 + 64 * (j))
#define XB_TOP      3328
#define XB_TOPGEN   3392
#define XCD_BAR_WORDS 3456
#define XB_SPIN_CAP (1u << 18)

__device__ __forceinline__ unsigned xb_ld(unsigned* p)              { return __hip_atomic_load(p, __ATOMIC_RELAXED, __HIP_MEMORY_SCOPE_AGENT); }
__device__ __forceinline__ unsigned xb_add(unsigned* p, unsigned v) { return __hip_atomic_fetch_add(p, v, __ATOMIC_RELAXED, __HIP_MEMORY_SCOPE_AGENT); }
__device__ __forceinline__ unsigned xb_xcc_id() { return (unsigned)__builtin_amdgcn_s_getreg((3 << 11) | 20) & 0xFu; }
#define XB_SPIN(cond, bar) do { unsigned _sp = 0; while (cond) { __builtin_amdgcn_s_sleep(1); \
    if ((++_sp & 255u) == 0u) { if (xb_ld(&(bar)[XB_TMO])) break; if (_sp > XB_SPIN_CAP) { atomicAdd(&(bar)[XB_TMO], 1u); break; } } } } while (0)

struct XcdBarrier {
    unsigned* bar; unsigned x;
    volatile LAS unsigned* st;
};

__device__ __forceinline__ XcdBarrier xcd_barrier_post(unsigned* bar, volatile LAS unsigned* st) {
    XcdBarrier b; b.bar = bar; b.x = xb_xcc_id(); b.st = st;
    if (threadIdx.x == 0) (void)xb_add(&bar[XB_XCNT(b.x)], 1u);
    return b;
}
__device__ __forceinline__ void xcd_barrier_complete(unsigned* bar, unsigned x, unsigned& nloc, unsigned& nx) {
    const unsigned G = gridDim.x * gridDim.y * gridDim.z;
    unsigned sum, cnt, mine, sp = 0u;
    for (;;) {
        sum = 0u; cnt = 0u; mine = 0u;
#pragma unroll
        for (unsigned j = 0; j < 16; ++j) { const unsigned c = xb_ld(&bar[XB_XCNT(j)]); sum += c; cnt += (c > 0u) ? 1u : 0u; mine = (j == x) ? c : mine; }
        if (sum == G) break;
        __builtin_amdgcn_s_sleep(1);
        if ((++sp & 255u) == 0u) { if (xb_ld(&bar[XB_TMO])) break; if (sp > XB_SPIN_CAP) { atomicAdd(&bar[XB_TMO], 1u); break; } }
    }
    nloc = mine > 0u ? mine : 1u; nx = cnt > 0u ? cnt : 1u;
}

__device__ __forceinline__ void xcd_barrier(const XcdBarrier& b) {
    asm volatile("s_waitcnt vmcnt(0)" ::: "memory");
    __syncthreads();
    if (threadIdx.x == 0) {
        unsigned* bar = b.bar;
        __builtin_amdgcn_s_waitcnt(0);
        unsigned nloc = b.st[0], nx = b.st[1];
        if (nloc == 0u) { xcd_barrier_complete(bar, b.x, nloc, nx); b.st[0] = nloc; b.st[1] = nx; }
        const unsigned old = xb_add(&bar[XB_XSUB(b.x)], 1u);
        const unsigned gen = old / nloc;
        if (old + 1u == (gen + 1u) * nloc) {
            __builtin_amdgcn_fence(__ATOMIC_RELEASE, "agent");
            asm volatile("s_waitcnt vmcnt(0)" ::: "memory");
            const unsigned og = xb_add(&bar[XB_TOP], 1u);
            const unsigned tg = og / nx;
            if (og + 1u == (tg + 1u) * nx) xb_add(&bar[XB_TOPGEN], 1u);
            else XB_SPIN(xb_ld(&bar[XB_TOPGEN]) == tg, bar);
            __builtin_amdgcn_fence(__ATOMIC_ACQUIRE, "agent");
            xb_add(&bar[XB_XGEN(b.x)], 1u);
            asm volatile("s_waitcnt vmcnt(0)" ::: "memory");
        } else {
            XB_SPIN(xb_ld(&bar[XB_XGEN(b.x)]) == gen, bar);
            __builtin_amdgcn_fence(__ATOMIC_ACQUIRE, "agent");
            asm volatile("s_waitcnt vmcnt(0)" ::: "memory");
        }
    }
    __syncthreads();
}

typedef const pg8::f32x4 (&AccRef)[2][2][4][2];

struct EpiGm1 {
    static constexpr bool PERM = true, AFTER_DRAIN = false;
    bf16* U; bf16* V; float* vssp;
    __device__ __forceinline__ void operator()(AccRef acc, const pg8::Unit& u, int wr, int wc, int fr, int fq) const {
        const int row0 = u.pm * 256 + wr * 64 + fr; const bool isV = u.pn >= 4; const int col0 = (u.pn & 3) * 256 + wc * 32 + 8 * fq;
        bf16* base = isV ? V : U;
#pragma unroll
        for (int ai = 0; ai < 2; ++ai)
#pragma unroll
            for (int m = 0; m < 4; ++m) { const int row = row0 + ai * 128 + m * 16; bf16* rowp = base + (size_t)row * 1024 + col0; float ss = 0.f;
#pragma unroll
                for (int bj = 0; bj < 2; ++bj) { f32x4 v0 = acc[ai][bj][m][0], v1 = acc[ai][bj][m][1];
#pragma unroll
                    for (int j = 0; j < 4; ++j) { v0[j] = gelu_tanh(v0[j]); v1[j] = gelu_tanh(v1[j]); ss += v0[j] * v0[j] + v1[j] * v1[j]; }
                    v4u w; w.x = pk2(v0[0], v0[1]); w.y = pk2(v0[2], v0[3]); w.z = pk2(v1[0], v1[1]); w.w = pk2(v1[2], v1[3]);
                    *(v4u*)(rowp + bj * 128) = w; }
                if (isV) { ss += __shfl_xor(ss, 16); ss += __shfl_xor(ss, 32); if (fq == 0) vssp[(size_t)row * 16 + (u.pn - 4) * 4 + wc] = ss; } }
    }
};
struct EpiRes {
    static constexpr bool PERM = false, AFTER_DRAIN = false;
    const float* src; float* dst; const float* gate;
    __device__ __forceinline__ void operator()(AccRef acc, const pg8::Unit& u, int wr, int wc, int fr, int fq) const {
        const int row0 = u.pm * 256 + wr * 64 + fr, col0 = u.pn * 256 + wc * 32 + 4 * fq; const int b = (u.pm * 256) / SEQ;
        f32x4 gv[2][2];
#pragma unroll
        for (int bj = 0; bj < 2; ++bj)
#pragma unroll
            for (int n = 0; n < 2; ++n) gv[bj][n] = *(const f32x4*)(gate + (size_t)b * 6144 + col0 + bj * 128 + n * 16);
#pragma unroll
        for (int ai = 0; ai < 2; ++ai)
#pragma unroll
            for (int m = 0; m < 4; ++m) { const size_t off = (size_t)(row0 + ai * 128 + m * 16) * 1024 + col0;
#pragma unroll
                for (int bj = 0; bj < 2; ++bj)
#pragma unroll
                    for (int n = 0; n < 2; ++n) { const f32x4 xs = *(const f32x4*)(src + off + bj * 128 + n * 16); *(f32x4*)(dst + off + bj * 128 + n * 16) = xs + gv[bj][n] * acc[ai][bj][m][n]; } }
    }
};
struct EpiBf {
    static constexpr bool PERM = true, AFTER_DRAIN = false;
    bf16* O; int ldc; int nmask;
    __device__ __forceinline__ void operator()(AccRef acc, const pg8::Unit& u, int wr, int wc, int fr, int fq) const {
        const int row0 = u.pm * 256 + wr * 64 + fr, col0 = (u.pn & nmask) * 256 + wc * 32 + 8 * fq;
#pragma unroll
        for (int ai = 0; ai < 2; ++ai)
#pragma unroll
            for (int m = 0; m < 4; ++m) { bf16* rowp = O + (size_t)(row0 + ai * 128 + m * 16) * ldc + col0;
#pragma unroll
                for (int bj = 0; bj < 2; ++bj) { const f32x4 v0 = acc[ai][bj][m][0], v1 = acc[ai][bj][m][1];
                    v4u w; w.x = pk2(v0[0], v0[1]); w.y = pk2(v0[2], v0[3]); w.z = pk2(v1[0], v1[1]); w.w = pk2(v1[2], v1[3]);
                    *(v4u*)(rowp + bj * 128) = w; } }
    }
};
struct EpiDn1 {
    static constexpr bool PERM = true, AFTER_DRAIN = false;
    bf16* QKV; bf16* Z; float* BA;
    __device__ __forceinline__ void operator()(AccRef acc, const pg8::Unit& u, int wr, int wc, int fr, int fq) const {
        const int row0 = u.pm * 256 + wr * 64 + fr;
        if (u.pn < 12) {
            bf16* base = u.pn < 8 ? QKV : Z; const int ldc = u.pn < 8 ? 2048 : 1024; const int col0 = (u.pn < 8 ? u.pn : u.pn - 8) * 256 + wc * 32 + 8 * fq;
#pragma unroll
            for (int ai = 0; ai < 2; ++ai)
#pragma unroll
                for (int m = 0; m < 4; ++m) { bf16* rowp = base + (size_t)(row0 + ai * 128 + m * 16) * ldc + col0;
#pragma unroll
                    for (int bj = 0; bj < 2; ++bj) { const f32x4 v0 = acc[ai][bj][m][0], v1 = acc[ai][bj][m][1];
                        v4u w; w.x = pk2(v0[0], v0[1]); w.y = pk2(v0[2], v0[3]); w.z = pk2(v1[0], v1[1]); w.w = pk2(v1[2], v1[3]);
                        *(v4u*)(rowp + bj * 128) = w; } }
        } else if (wc == 0 && fq < 2) {
#pragma unroll
            for (int ai = 0; ai < 2; ++ai)
#pragma unroll
                for (int m = 0; m < 4; ++m) { float* rowp = BA + (size_t)(row0 + ai * 128 + m * 16) * 16 + 8 * fq;
                    *(f32x4*)(rowp) = acc[ai][0][m][0]; *(f32x4*)(rowp + 4) = acc[ai][0][m][1]; }
        }
    }
};
struct EpiMoe1 {
    static constexpr bool PERM = true, AFTER_DRAIN = false;
    bf16* O;
    __device__ __forceinline__ void operator()(AccRef acc, const pg8::Unit& u, int wr, int wc, int fr, int fq) const {
        const int row0 = u.pm * 256 + wr * 64 + fr, col0 = (u.pn & 3) * 128 + wc * 32 + 8 * fq;
#pragma unroll
        for (int ai = 0; ai < 2; ++ai)
#pragma unroll
            for (int m = 0; m < 4; ++m) { bf16* rowp = O + (size_t)(row0 + ai * 128 + m * 16) * 512 + col0; float r[8];
#pragma unroll
                for (int n = 0; n < 2; ++n)
#pragma unroll
                    for (int j = 0; j < 4; ++j) { const float a = acc[ai][0][m][n][j], g = acc[ai][1][m][n][j]; r[4 * n + j] = siluf_(a) * g; }
                v4u w; w.x = pk2(r[0], r[1]); w.y = pk2(r[2], r[3]); w.z = pk2(r[4], r[5]); w.w = pk2(r[6], r[7]);
                *(v4u*)rowp = w; }
    }
};
struct MoeOrder {
    const int* tile_e; int total, G, c;
    __device__ __forceinline__ void init(const int* te, int ntiles, int G_, int c_) { tile_e = te; total = ntiles * 4; G = G_; c = c_; }
    __device__ __forceinline__ bool next(int i, pg8::Unit& u) const {
        const long Lx = (long)i * G + c; if (Lx >= total) return false;
        const int w0 = (int)Lx, q = total / 8, r = total % 8, xcd = w0 % 8, off = w0 / 8;
        const int wgid = (xcd < r ? xcd * (q + 1) : r * (q + 1) + (xcd - r) * q) + off;
        const int rt = wgid >> 2; u.pm = rt; u.pn = tile_e[rt] * 4 + (wgid & 3); return true;
    }
    __device__ __forceinline__ void a_ready(const pg8::Unit&) const {}
    __device__ __forceinline__ void done(const pg8::Unit&) const {}
};

struct Args { const float* in[N_IN]; float* out; unsigned char* ws; int ph_lo, ph_hi, li, pad; };

__device__ __forceinline__ void tr_item(const float* __restrict__ W, int ldn, int k0, int n0, bf16* __restrict__ WT, int Kd, int drow0, LAS float* scr, int lane) {
#pragma unroll 8
    for (int i = 0; i < 32; ++i) { const int kk = 2 * i + (lane >> 5); scr[kk * 33 + (lane & 31)] = W[(size_t)(k0 + kk) * ldn + n0 + (lane & 31)]; }
    LDS_WAIT(); asm volatile("" ::: "memory");
    const int c = lane & 7;
#pragma unroll
    for (int j = 0; j < 4; ++j) { const int n = (lane >> 3) + 8 * j; const LAS float* s = scr + (8 * c) * 33 + n;
        v4u o; o.x = pk2(s[0 * 33], s[1 * 33]); o.y = pk2(s[2 * 33], s[3 * 33]); o.z = pk2(s[4 * 33], s[5 * 33]); o.w = pk2(s[6 * 33], s[7 * 33]);
        *(v4u*)(WT + (size_t)(drow0 + n) * Kd + k0 + 8 * c) = o; }
    LDS_WAIT(); asm volatile("" ::: "memory");
}

constexpr int CV_PER_L = 24576, CV_N_EXP = 4 * CV_PER_L, CV_MIX_L01 = 3584, CV_N_MIXI = 1536 + 2048 + 1280 + 1536;
struct CvItem { const float* src; bf16* dst; int ldn, Kd; };
__device__ __forceinline__ CvItem cv_decode(const Args& args, unsigned char* ws, int it) {
    CvItem c; const float* src; bf16* dst; int ldn, k0, n0, Kd, drow0;
    constexpr int PER_L = CV_PER_L, N_EXP = CV_N_EXP;
    if (it < N_EXP) {
        const int L = it / PER_L; int r = it % PER_L; const int ib = LBASE(L) + 4 + NMIX(L);
        if (r < 16384) { const int e = r >> 9, rr = r & 511; k0 = (rr >> 5) * 64; n0 = (rr & 31) * 32; ldn = 1024; Kd = 1024;
            src = args.in[ib + 2] + (size_t)e * 1048576; dst = (bf16*)(ws + WS_W + (size_t)L * 96 * MiB) + (size_t)e * 1048576;
            drow0 = (n0 < 512) ? ((n0 >> 7) * 256 + (n0 & 127)) : ((((n0 - 512) >> 7) * 256) + 128 + ((n0 - 512) & 127)); }
        else { r -= 16384; const int e = r >> 8, rr = r & 255; k0 = (rr >> 5) * 64; n0 = (rr & 31) * 32; ldn = 1024; Kd = 512;
            src = args.in[ib + 3] + (size_t)e * 524288; dst = (bf16*)(ws + WS_W + (size_t)L * 96 * MiB + 64 * MiB) + (size_t)e * 524288; drow0 = n0; }
    } else {
        int r = it - N_EXP; int idx, nblk; size_t woff;
        if (r < 1024) { idx = 6; ldn = 2048; nblk = 64; woff = WMIX_GM_IN0; }
        else if ((r -= 1024) < 512) { idx = 10; ldn = 1024; nblk = 32; woff = WMIX_GM_OUT0; }
        else if ((r -= 512) < 1536) { idx = 19; ldn = 3088; nblk = 96; woff = WMIX_DN_IN; }
        else if ((r -= 1536) < 512) { idx = 24; ldn = 1024; nblk = 32; woff = WMIX_DN_OUT; }
        else if ((r -= 512) < 768) { idx = 33; ldn = 1536; nblk = 48; woff = WMIX_SWA_IN; }
        else if ((r -= 768) < 512) { idx = 37; ldn = 1024; nblk = 32; woff = WMIX_SWA_OUT; }
        else if ((r -= 512) < 1024) { idx = 46; ldn = 2048; nblk = 64; woff = WMIX_GM_IN3; }
        else { r -= 1024; idx = 50; ldn = 1024; nblk = 32; woff = WMIX_GM_OUT3; }
        src = args.in[idx]; dst = (bf16*)(ws + WS_WMIX + woff); k0 = (r / nblk) * 64; n0 = (r % nblk) * 32; Kd = 1024; drow0 = n0;
    }
    c.src = src + (size_t)k0 * ldn + n0; c.dst = dst + (size_t)drow0 * Kd + k0; c.ldn = ldn; c.Kd = Kd; return c;
}
__device__ __forceinline__ void cv_load(const CvItem& c, f32x4 (&v)[8], int lane) {
    const float* p = c.src + (size_t)(2 * (lane >> 3)) * c.ldn + 4 * (lane & 7);
#pragma unroll
    for (int i = 0; i < 4; ++i) { v[2 * i] = *(const f32x4*)(p + (size_t)(16 * i) * c.ldn); v[2 * i + 1] = *(const f32x4*)(p + (size_t)(16 * i + 1) * c.ldn); }
}
__device__ __forceinline__ void cv_store(const CvItem& c, const f32x4 (&v)[8], LAS float* scr, int lane) {
    LAS unsigned* su = (LAS unsigned*)scr; const int kp = lane >> 3, n4 = 4 * (lane & 7);
#pragma unroll
    for (int i = 0; i < 4; ++i) { LAS unsigned* q = su + (kp + 8 * i) * 33 + n4;
#pragma unroll
        for (int e = 0; e < 4; ++e) q[e] = pk2(v[2 * i][e], v[2 * i + 1][e]); }
    LDS_WAIT(); asm volatile("" ::: "memory");
    const int ck = lane & 7;
#pragma unroll
    for (int j = 0; j < 4; ++j) { const int n = (lane >> 3) + 8 * j; const LAS unsigned* s = su + (4 * ck) * 33 + n;
        v4u o; o.x = s[0]; o.y = s[33]; o.z = s[66]; o.w = s[99];
        *(v4u*)(c.dst + (size_t)n * c.Kd + 8 * ck) = o; }
    LDS_WAIT(); asm volatile("" ::: "memory");
}
__device__ __forceinline__ void convert_weights(const Args& args, LAS unsigned char* lds, int it_lo, int it_hi, int gw, int NGW) {
    int tid_ = threadIdx.x; asm volatile("" : "+v"(tid_)); const int lane = tid_ & 63, wave = __builtin_amdgcn_readfirstlane(tid_ >> 6);
    unsigned char* ws = uni_ptr(args.ws);
    LAS float* scr = (LAS float*)(lds + wave * 8448);
    for (int it = it_lo + gw; it < it_hi; it += 2 * NGW) {
        const int it2 = it + NGW; const bool two = it2 < it_hi;
        const CvItem c0 = cv_decode(args, ws, it), c1 = cv_decode(args, ws, two ? it2 : it);
        f32x4 v0[8], v1[8];
        cv_load(c0, v0, lane); if (two) cv_load(c1, v1, lane);
        cv_store(c0, v0, scr, lane); if (two) cv_store(c1, v1, scr, lane);
    }
}
__device__ __forceinline__ void phase_prologue(const Args& args, LAS unsigned char* lds) {
    int tid_ = threadIdx.x; asm volatile("" : "+v"(tid_)); const int tid = tid_, lane = tid & 63, wave = __builtin_amdgcn_readfirstlane(tid >> 6), G = gridDim.x, bid = blockIdx.x; (void)tid; (void)lane; (void)wave;
    unsigned char* ws = uni_ptr(args.ws);
    LAS float* cact = (LAS float*)(lds + 69632);
    LAS float* red = (LAS float*)(lds + 77824);
    for (int k = tid; k < 2048; k += NTHR) cact[k] = siluf_(args.in[1][k]);
    __syncthreads();
    float* MOD = (float*)(ws + WS_MOD);
    for (int item = bid; item < 384; item += G) {
        const int L = item / 96, cg = item % 96, c4 = tid & 15, ks = tid >> 4;
        const float* w = args.in[LBASE(L) + 2] + (size_t)(ks * 32) * 6144 + cg * 64 + c4 * 4;
        f32x4 a0 = {0.f, 0.f, 0.f, 0.f}, a1 = {0.f, 0.f, 0.f, 0.f};
#pragma unroll 8
        for (int kk = 0; kk < 32; ++kk) { const f32x4 wv = *(const f32x4*)(w + (size_t)kk * 6144); a0 += cact[ks * 32 + kk] * wv; a1 += cact[1024 + ks * 32 + kk] * wv; }
        *(LAS f32x4*)(red + (ks * 2 + 0) * 64 + c4 * 4) = a0; *(LAS f32x4*)(red + (ks * 2 + 1) * 64 + c4 * 4) = a1;
        __syncthreads();
        if (tid < 128) { const int b = tid >> 6, col = tid & 63; float s = 0.f;
#pragma unroll
            for (int k2 = 0; k2 < 32; ++k2) s += red[(k2 * 2 + b) * 64 + col];
            MOD[(size_t)(L * 2 + b) * 6144 + cg * 64 + col] = s + args.in[LBASE(L) + 3][cg * 64 + col]; }
        __syncthreads();
    }
    { const int gw = bid * NWAVES + wave, NGW = G * NWAVES;
      if (G > 128) { convert_weights(args, lds, 0, CV_PER_L, gw, NGW); convert_weights(args, lds, CV_N_EXP, CV_N_EXP + CV_MIX_L01, gw, NGW); }
      else convert_weights(args, lds, 0, CV_N_EXP + CV_N_MIXI, gw, NGW); }
    const int gt = bid * NTHR + tid, NGT = G * NTHR;
    { bf16* dst = (bf16*)(ws + WS_WMIX + WMIX_DN_IN) + (size_t)3072 * 1024; const float* w = args.in[19];
      for (int i = gt; i < 256 * 1024; i += NGT) { const int n = i >> 10, k = i & 1023; const float v = n < 16 ? w[(size_t)k * 3088 + 3072 + n] : 0.f; dst[i] = (bf16)(pk2(v, 0.f) & 0xffffu); } }
    for (int i = gt; i < 4 * 48 * 1024; i += NGT) {
        const int L = i / 49152, rem = i % 49152, n = rem >> 10, k = rem & 1023;
        const float w = n < 36 ? args.in[LBASE(L) + 4 + NMIX(L)][(size_t)k * 36 + n] : 0.f;
        const unsigned hi = pk2(w, 0.f) & 0xffffu; const float lo = w - bf1((unsigned short)hi);
        bf16* RH = (bf16*)(ws + WS_RTR + (size_t)L * 196608); RH[rem] = (bf16)hi; RH[49152 + rem] = (bf16)(pk2(lo, 0.f) & 0xffffu);
    }
}

__device__ __forceinline__ void norm_store_row(const f32x4 (&v)[4], const float* __restrict__ gain, const float* __restrict__ shift, const float* __restrict__ scale, bf16* __restrict__ hrow, int lane) {
    float ss = 0.f;
#pragma unroll
    for (int j = 0; j < 4; ++j) ss += (v[j][0] * v[j][0] + v[j][1] * v[j][1]) + (v[j][2] * v[j][2] + v[j][3] * v[j][3]);
    const float rstd = __builtin_amdgcn_rsqf(wave_sum(ss) * (1.0f / 1024.0f) + EPS);
#pragma unroll
    for (int j = 0; j < 4; ++j) { const int c = 4 * lane + 256 * j;
        const f32x4 g = *(const f32x4*)(gain + c), sc = *(const f32x4*)(scale + c), sh = *(const f32x4*)(shift + c);
        const f32x4 h = v[j] * rstd * (g * (1.0f + sc)) + sh;
        v2u w; w.x = pk2(h[0], h[1]); w.y = pk2(h[2], h[3]); *(v2u*)(hrow + c) = w; }
}
__device__ __forceinline__ void phase_norm0(const Args& args) {
    int tid_ = threadIdx.x; asm volatile("" : "+v"(tid_)); const int tid = tid_, lane = tid & 63, wave = __builtin_amdgcn_readfirstlane(tid >> 6), G = gridDim.x, bid = blockIdx.x; (void)tid; (void)lane; (void)wave;
    const float* X = args.in[0]; bf16* H = (bf16*)(args.ws + WS_ACT + A_H); const float* MOD = (const float*)(args.ws + WS_MOD);
    for (int t = bid * NWAVES + wave; t < T; t += G * NWAVES) { const int b = t / SEQ; f32x4 v[4];
#pragma unroll
        for (int j = 0; j < 4; ++j) v[j] = *(const f32x4*)(X + (size_t)t * 1024 + 4 * lane + 256 * j);
        const float* m = MOD + (size_t)b * 6144;
        norm_store_row(v, args.in[2], m, m + 1024, H + (size_t)t * 1024, lane); }
}

__device__ __forceinline__ void phase_gm_spatial(const Args& args, int L, LAS unsigned char* lds) {
    int tid_ = threadIdx.x; asm volatile("" : "+v"(tid_)); const int tid = tid_, lane = tid & 63, wave = __builtin_amdgcn_readfirstlane(tid >> 6), G = gridDim.x, bid = blockIdx.x; (void)tid; (void)lane; (void)wave;
    unsigned char* ws = uni_ptr(args.ws); const int ib = LBASE(L) + 4;
    const float* v_norm = args.in[ib + 1]; const float* w_s = args.in[ib + 2]; const float* b_s = args.in[ib + 3];
    const bf16* U = (const bf16*)(ws + WS_ACT + A_U); const bf16* V = (const bf16*)(ws + WS_ACT + A_V); bf16* GT = (bf16*)(ws + WS_ACT + A_GATED);
    const float* VSSP = (const float*)(ws + WS_VSSP);
    LAS bf16* WL = (LAS bf16*)lds; LAS bf16* VT = (LAS bf16*)(lds + 34816); LAS float* rs = (LAS float*)(lds + 69632);
    const int wr = wave >> 2, wc = wave & 3, fr = lane & 15, fq = lane >> 4;
    for (int u = bid; u < 2048; u += G) {
        const int c = u >> 3, g = u & 7; const size_t tok0 = (size_t)c * 128;
        if (tid < 128) { const float* p = VSSP + (tok0 + tid) * 16; float s = 0.f;
#pragma unroll
            for (int i = 0; i < 4; ++i) { const f32x4 q = *(const f32x4*)(p + 4 * i); s += (q[0] + q[1]) + (q[2] + q[3]); }
            rs[tid] = __builtin_amdgcn_rsqf(s * (1.0f / 1024.0f) + EPS); }
        { const int s = tid & 127, dq = tid >> 7; const bf16* vp = V + (tok0 + s) * 1024 + g * 128 + dq * 32;
#pragma unroll
          for (int i = 0; i < 4; ++i) { const v4u q = *(const v4u*)(vp + 8 * i); const unsigned w[4] = {q.x, q.y, q.z, q.w};
#pragma unroll
              for (int e = 0; e < 4; ++e) { VT[(dq * 32 + 8 * i + 2 * e) * 136 + s] = (bf16)(w[e] & 0xffffu); VT[(dq * 32 + 8 * i + 2 * e + 1) * 136 + s] = (bf16)(w[e] >> 16); } } }
        __syncthreads();
        { const int tr = tid >> 2, sq = (tid & 3) * 32; const float* wp = w_s + ((size_t)g * 128 + tr) * 128 + sq;
#pragma unroll
          for (int i = 0; i < 8; ++i) { const f32x4 q = *(const f32x4*)(wp + 4 * i); float o[4];
#pragma unroll
              for (int e = 0; e < 4; ++e) { const int s = sq + 4 * i + e; o[e] = (s <= tr) ? q[e] * rs[s] : 0.f; }
              v2u w; w.x = pk2(o[0], o[1]); w.y = pk2(o[2], o[3]); *(LAS v2u*)(WL + tr * 136 + sq + 4 * i) = w; } }
        __syncthreads();
        f32x4 acc[2][4];
#pragma unroll
        for (int n = 0; n < 2; ++n)
#pragma unroll
            for (int m = 0; m < 4; ++m) acc[n][m] = (f32x4){0.f, 0.f, 0.f, 0.f};
#pragma unroll
        for (int ks = 0; ks < 4; ++ks) { bf16x8 vf[2], wf[4];
#pragma unroll
            for (int n = 0; n < 2; ++n) vf[n] = *(const LAS bf16x8*)(VT + (32 * wc + 16 * n + fr) * 136 + 32 * ks + 8 * fq);
#pragma unroll
            for (int m = 0; m < 4; ++m) wf[m] = *(const LAS bf16x8*)(WL + (64 * wr + 16 * m + fr) * 136 + 32 * ks + 8 * fq);
#pragma unroll
            for (int n = 0; n < 2; ++n)
#pragma unroll
                for (int m = 0; m < 4; ++m) acc[n][m] = __builtin_amdgcn_mfma_f32_16x16x32_bf16(vf[n], wf[m], acc[n][m], 0, 0, 0); }
#pragma unroll
        for (int m = 0; m < 4; ++m) { const int t = 64 * wr + 16 * m + fr; const float bs = b_s[g * 128 + t];
#pragma unroll
            for (int n = 0; n < 2; ++n) { const int d0 = g * 128 + 32 * wc + 16 * n + 4 * fq; const size_t off = (tok0 + t) * 1024 + d0;
                const v2u uu = *(const v2u*)(U + off); const f32x4 vn = *(const f32x4*)(v_norm + d0);
                const float o0 = bflo(uu.x) * (acc[n][m][0] * vn[0] + bs), o1 = bfhi(uu.x) * (acc[n][m][1] * vn[1] + bs), o2 = bflo(uu.y) * (acc[n][m][2] * vn[2] + bs), o3 = bfhi(uu.y) * (acc[n][m][3] * vn[3] + bs);
                v2u w; w.x = pk2(o0, o1); w.y = pk2(o2, o3); *(v2u*)(GT + off) = w; } }
        __syncthreads();
    }
}

__device__ __forceinline__ void phase_swa_attn(const Args& args, LAS unsigned char* lds) {
    int tid_ = threadIdx.x; asm volatile("" : "+v"(tid_)); const int tid = tid_, lane = tid & 63, wave = __builtin_amdgcn_readfirstlane(tid >> 6), G = gridDim.x, bid = blockIdx.x; (void)tid; (void)lane; (void)wave;
    unsigned char* ws = uni_ptr(args.ws);
    const float* q_norm = args.in[34]; const float* k_norm = args.in[35]; const float* sinks = args.in[36];
    const bf16* QKV = (const bf16*)(ws + WS_ACT + A_QKV); bf16* O = (bf16*)(ws + WS_ACT + A_H);
    LAS bf16* KL = (LAS bf16*)lds; LAS bf16* VT = (LAS bf16*)(lds + 36864);
    const int fr = lane & 15, fq = lane >> 4;
    for (int u = bid; u < 1024; u += G) {
        const int n = u & 127, kvh = (u >> 7) & 3, b = u >> 9; const long tok0 = (long)b * SEQ + (long)n * 128;
        { const int key = tid >> 1, half = tid & 1; const long tk = tok0 - 128 + key; float x[32]; float ss = 0.f;
          const bool ok = (n > 0) || (key >= 128);
          const bf16* kp = QKV + (size_t)(ok ? tk : tok0) * 1536 + 1024 + kvh * 64 + half * 32;
#pragma unroll
          for (int i = 0; i < 4; ++i) { const v4u q = *(const v4u*)(kp + 8 * i); const unsigned w[4] = {q.x, q.y, q.z, q.w};
#pragma unroll
              for (int e = 0; e < 4; ++e) { x[8 * i + 2 * e] = bflo(w[e]); x[8 * i + 2 * e + 1] = bfhi(w[e]); } }
#pragma unroll
          for (int i = 0; i < 32; ++i) ss += x[i] * x[i];
          ss += __shfl_xor(ss, 1);
          const float rstd = ok ? __builtin_amdgcn_rsqf(ss * (1.0f / 64.0f) + EPS) : 0.f;
#pragma unroll
          for (int i = 0; i < 4; ++i) { float o[8];
#pragma unroll
              for (int e = 0; e < 8; ++e) o[e] = x[8 * i + e] * rstd * k_norm[half * 32 + 8 * i + e];
              v4u w; w.x = pk2(o[0], o[1]); w.y = pk2(o[2], o[3]); w.z = pk2(o[4], o[5]); w.w = pk2(o[6], o[7]);
              *(LAS v4u*)(KL + key * 72 + half * 32 + 8 * i) = w; } }
        { const int key = tid & 255, dh = tid >> 8; const long tk = tok0 - 128 + key; const bool ok = (n > 0) || (key >= 128);
          const bf16* vp = QKV + (size_t)(ok ? tk : tok0) * 1536 + 1280 + kvh * 64 + dh * 32;
#pragma unroll
          for (int i = 0; i < 4; ++i) { v4u q = *(const v4u*)(vp + 8 * i); if (!ok) q = (v4u){0u, 0u, 0u, 0u}; const unsigned w[4] = {q.x, q.y, q.z, q.w};
#pragma unroll
              for (int e = 0; e < 4; ++e) { VT[(dh * 32 + 8 * i + 2 * e) * 264 + key] = (bf16)(w[e] & 0xffffu); VT[(dh * 32 + 8 * i + 2 * e + 1) * 264 + key] = (bf16)(w[e] >> 16); } } }
        __syncthreads();
        const int g = wave >> 1, qh = wave & 1, hq = kvh * 4 + g; const float sink = sinks[hq];
#pragma unroll 1
        for (int mt = 0; mt < 4; ++mt) {
            asm volatile("" ::: "memory");
            const int qi = qh * 64 + mt * 16 + fr;
            bf16x8 qf[2];
            { float x[16]; float ss = 0.f; const bf16* qp = QKV + (size_t)(tok0 + qi) * 1536 + hq * 64 + 8 * fq;
#pragma unroll
              for (int ks = 0; ks < 2; ++ks) { const v4u q = *(const v4u*)(qp + 32 * ks); const unsigned w[4] = {q.x, q.y, q.z, q.w};
#pragma unroll
                  for (int e = 0; e < 4; ++e) { x[8 * ks + 2 * e] = bflo(w[e]); x[8 * ks + 2 * e + 1] = bfhi(w[e]); } }
#pragma unroll
              for (int i = 0; i < 16; ++i) ss += x[i] * x[i];
              ss += __shfl_xor(ss, 16); ss += __shfl_xor(ss, 32);
              const float rstd = __builtin_amdgcn_rsqf(ss * (1.0f / 64.0f) + EPS) * 0.125f;
#pragma unroll
              for (int ks = 0; ks < 2; ++ks) { float o[8];
#pragma unroll
                  for (int e = 0; e < 8; ++e) o[e] = x[8 * ks + e] * rstd * q_norm[32 * ks + 8 * fq + e];
                  v4u w; w.x = pk2(o[0], o[1]); w.y = pk2(o[2], o[3]); w.z = pk2(o[4], o[5]); w.w = pk2(o[6], o[7]); qf[ks] = __builtin_bit_cast(bf16x8, w); } }
            f32x4 s[16]; float mx = -INFINITY;
#pragma unroll
            for (int nt = 0; nt < 16; ++nt) { f32x4 a = {0.f, 0.f, 0.f, 0.f};
#pragma unroll
                for (int ks = 0; ks < 2; ++ks) { const bf16x8 kf = *(const LAS bf16x8*)(KL + (16 * nt + fr) * 72 + 32 * ks + 8 * fq); a = __builtin_amdgcn_mfma_f32_16x16x32_bf16(kf, qf[ks], a, 0, 0, 0); }
#pragma unroll
                for (int i = 0; i < 4; ++i) { const int kj = 16 * nt + 4 * fq + i; const bool valid = (kj > qi) && (kj <= qi + 128) && ((n > 0) || (kj >= 128)); a[i] = valid ? a[i] : -INFINITY; mx = fmaxf(mx, a[i]); }
                s[nt] = a; }
            mx = fmaxf(mx, __shfl_xor(mx, 16)); mx = fmaxf(mx, __shfl_xor(mx, 32)); mx = fmaxf(mx, sink);
            float l = 0.f;
#pragma unroll
            for (int nt = 0; nt < 16; ++nt)
#pragma unroll
                for (int i = 0; i < 4; ++i) { const float p = fast_exp(s[nt][i] - mx); s[nt][i] = p; l += p; }
            l += __shfl_xor(l, 16); l += __shfl_xor(l, 32); l += fast_exp(sink - mx);
            f32x4 o[4];
#pragma unroll
            for (int dt = 0; dt < 4; ++dt) o[dt] = (f32x4){0.f, 0.f, 0.f, 0.f};
#pragma unroll
            for (int st = 0; st < 8; ++st) {
                v4u pw; pw.x = pk2(s[2 * st][0], s[2 * st][1]); pw.y = pk2(s[2 * st][2], s[2 * st][3]); pw.z = pk2(s[2 * st + 1][0], s[2 * st + 1][1]); pw.w = pk2(s[2 * st + 1][2], s[2 * st + 1][3]);
                const bf16x8 pf = __builtin_bit_cast(bf16x8, pw);
#pragma unroll
                for (int dt = 0; dt < 4; ++dt) { const LAS bf16* vp = VT + (16 * dt + fr) * 264 + 32 * st + 4 * fq;
                    const v2u v0 = *(const LAS v2u*)vp, v1 = *(const LAS v2u*)(vp + 16); v4u vw; vw.x = v0.x; vw.y = v0.y; vw.z = v1.x; vw.w = v1.y;
                    o[dt] = __builtin_amdgcn_mfma_f32_16x16x32_bf16(__builtin_bit_cast(bf16x8, vw), pf, o[dt], 0, 0, 0); } }
            const float inv = 1.0f / l;
#pragma unroll
            for (int dt = 0; dt < 4; ++dt) { v2u w; w.x = pk2(o[dt][0] * inv, o[dt][1] * inv); w.y = pk2(o[dt][2] * inv, o[dt][3] * inv);
                *(v2u*)(O + (size_t)(tok0 + qi) * 1024 + hq * 64 + 16 * dt + 4 * fq) = w; }
        }
        __syncthreads();
    }
}

__device__ __forceinline__ void phase_dn_prep(const Args& args, LAS unsigned char* lds) {
    int tid_ = threadIdx.x; asm volatile("" : "+v"(tid_)); const int tid = tid_, lane = tid & 63, wave = __builtin_amdgcn_readfirstlane(tid >> 6), G = gridDim.x, bid = blockIdx.x;
    unsigned char* ws = uni_ptr(args.ws); const float* conv_w = args.in[20]; const float* a_log = args.in[21]; const float* dt_bias = args.in[22];
    const bf16* QKV = (const bf16*)(ws + WS_ACT + A_QKV); bf16* QN = (bf16*)(ws + WS_ACT + A_QN); bf16* KN = (bf16*)(ws + WS_ACT + A_KN); bf16* VV = (bf16*)(ws + WS_ACT + A_VV);
    const float* BA = (const float*)(ws + WS_BA); float* DNB = (float*)(ws + WS_DNB);
    constexpr int RUN = 16;
    LAS float* cwl = (LAS float*)lds;
    for (int i = tid; i < 2048; i += NTHR) *(LAS f32x4*)(cwl + 4 * i) = *(const f32x4*)(conv_w + 4 * i);
    __syncthreads();
    const float alg = lane < 8 ? -expf(a_log[lane]) : 0.f, dtb = lane < 8 ? dt_bias[lane] : 0.f;
    for (int run = bid * NWAVES + wave; run < T / RUN; run += G * NWAVES) {
        const int tbeg = run * RUN, pos0 = tbeg % SEQ;
        v4u rows[3][4];
#pragma unroll
        for (int d = 0; d < 3; ++d)
#pragma unroll
            for (int j = 0; j < 4; ++j) rows[d][j] = (pos0 - 3 + d >= 0) ? *(const v4u*)(QKV + (size_t)(tbeg - 3 + d) * 2048 + 8 * lane + 512 * j) : (v4u){0u, 0u, 0u, 0u};
#pragma unroll 1
        for (int i = 0; i < RUN; ++i) { const int t = tbeg + i;
            v4u cur[4];
#pragma unroll
            for (int j = 0; j < 4; ++j) cur[j] = *(const v4u*)(QKV + (size_t)t * 2048 + 8 * lane + 512 * j);
            float bi = 0.f, ai = 0.f; if (lane < 8) { bi = BA[(size_t)t * 16 + lane]; ai = BA[(size_t)t * 16 + 8 + lane] + dtb; }
#pragma unroll
            for (int j = 0; j < 4; ++j) { float a[8];
#pragma unroll
                for (int e = 0; e < 8; ++e) a[e] = 0.f;
#pragma unroll
                for (int tap = 0; tap < 4; ++tap) { const v4u q = tap < 3 ? rows[tap][j] : cur[j]; const f32x4 w0 = *(const LAS f32x4*)(cwl + tap * 2048 + 8 * lane + 512 * j), w1 = *(const LAS f32x4*)(cwl + tap * 2048 + 8 * lane + 512 * j + 4);
                    a[0] += w0[0] * bflo(q.x); a[1] += w0[1] * bfhi(q.x); a[2] += w0[2] * bflo(q.y); a[3] += w0[3] * bfhi(q.y); a[4] += w1[0] * bflo(q.z); a[5] += w1[1] * bfhi(q.z); a[6] += w1[2] * bflo(q.w); a[7] += w1[3] * bfhi(q.w); }
                float ss = 0.f;
#pragma unroll
                for (int e = 0; e < 8; ++e) { a[e] = siluf_(a[e]); ss += a[e] * a[e]; }
                if (j < 2) { ss += __shfl_xor(ss, 1); ss += __shfl_xor(ss, 2); ss += __shfl_xor(ss, 4); ss += __shfl_xor(ss, 8);
                    const float r = __builtin_amdgcn_rsqf(ss + EPS); bf16* dst = (j == 0 ? QN : KN) + (size_t)t * 512 + 8 * lane;
                    v4u w; w.x = pk2(a[0] * r, a[1] * r); w.y = pk2(a[2] * r, a[3] * r); w.z = pk2(a[4] * r, a[5] * r); w.w = pk2(a[6] * r, a[7] * r); *(v4u*)dst = w; }
                else { v4u w; w.x = pk2(a[0], a[1]); w.y = pk2(a[2], a[3]); w.z = pk2(a[4], a[5]); w.w = pk2(a[6], a[7]); *(v4u*)(VV + (size_t)t * 1024 + 8 * lane + 512 * (j - 2)) = w; } }
            if (lane < 8) { const float sp = fmaxf(ai, 0.f) + log1pf(expf(-fabsf(ai)));
                DNB[(size_t)t * 16 + lane] = 1.0f / (1.0f + expf(-bi)); DNB[(size_t)t * 16 + 8 + lane] = alg * sp; }
#pragma unroll
            for (int j = 0; j < 4; ++j) { rows[0][j] = rows[1][j]; rows[1][j] = rows[2][j]; rows[2][j] = cur[j]; }
        }
    }
}
constexpr int FA_STRIDE = 25600, FB_STRIDE = 32768, FU_STRIDE = 16384;
constexpr float DN_SCALE = 0.08838834764831845f;
__device__ __forceinline__ void phase_dn_chunk(const Args& args, LAS unsigned char* lds) {
    int tid_ = threadIdx.x; asm volatile("" : "+v"(tid_)); const int tid = tid_, lane = tid & 63, wave = __builtin_amdgcn_readfirstlane(tid >> 6), G = gridDim.x, bid = blockIdx.x;
    unsigned char* ws = uni_ptr(args.ws);
    const bf16* QN = (const bf16*)(ws + WS_ACT + A_QN); const bf16* KN = (const bf16*)(ws + WS_ACT + A_KN); const bf16* VV = (const bf16*)(ws + WS_ACT + A_VV);
    const float* DNB = (const float*)(ws + WS_DNB);
    unsigned char* FA = ws + WS_ACT + A_FA; unsigned char* FB = ws + WS_ACT + A_FB; unsigned char* FU = ws + WS_ACT + A_FU;
    LAS float* Al = (LAS float*)(lds + wave * 16384);
    LAS float* tb = (LAS float*)(lds + LDSCTL_OFF + 2048 + wave * 512);
    const int fr = lane & 15, fq = lane >> 4;
    for (int it = bid * NWAVES + wave; it < 4096; it += G * NWAVES) {
        const int b = it >> 11, hv = (it >> 8) & 7, n = it & 255, hq = hv >> 1; const unsigned t0 = (unsigned)b * SEQ + (unsigned)n * 64; const int itq = (b * 4 + hq) * 256 + n;
        unsigned char* fa = FA + (size_t)it * FA_STRIDE; unsigned char* fb = FB + (size_t)itq * FB_STRIDE;
        const float bv = DNB[(t0 + lane) * 16 + hv]; float gcv = DNB[(t0 + lane) * 16 + 8 + hv];
#pragma unroll
        for (int o = 1; o < 64; o <<= 1) { const float t = __shfl_up(gcv, o); if (lane >= o) gcv += t; }
        const float gll = __shfl(gcv, 63);
        tb[lane] = gcv; tb[64 + lane] = bv;
        { float* fe = (float*)(fa + 24576); fe[lane] = DN_SCALE * expf(gcv); fe[64 + lane] = expf(gll - gcv); fe[128 + lane] = expf(gll); }
        asm volatile("" ::: "memory");
        bf16x8 kf[4][4];
#pragma unroll
        for (int t = 0; t < 4; ++t)
#pragma unroll
            for (int ks = 0; ks < 4; ++ks) kf[t][ks] = *(const bf16x8*)(KN + (t0 + 16 * t + fr) * 512 + hq * 128 + 32 * ks + 8 * fq);
#pragma unroll
        for (int m = 0; m < 4; ++m) { const int c = 16 * m + fr; const float bm = tb[64 + c], gm = tb[c];
            bf16x8 qf[4];
#pragma unroll
            for (int ks = 0; ks < 4; ++ks) qf[ks] = *(const bf16x8*)(QN + (t0 + c) * 512 + hq * 128 + 32 * ks + 8 * fq);
            f32x4 tl[4];
#pragma unroll
            for (int t = 0; t < 4; ++t) {
                if (t <= m) { f32x4 ak = {0.f, 0.f, 0.f, 0.f}, aq = {0.f, 0.f, 0.f, 0.f};
#pragma unroll
                    for (int ks = 0; ks < 4; ++ks) { ak = __builtin_amdgcn_mfma_f32_16x16x32_bf16(kf[t][ks], kf[m][ks], ak, 0, 0, 0); aq = __builtin_amdgcn_mfma_f32_16x16x32_bf16(kf[t][ks], qf[ks], aq, 0, 0, 0); }
                    const f32x4 gs4 = *(const LAS f32x4*)(tb + 16 * t + 4 * fq); f32x4 av;
#pragma unroll
                    for (int r = 0; r < 4; ++r) { const int s = 16 * t + 4 * fq + r; const float dec = expf(fminf(gm - gs4[r], 0.f)); av[r] = (s < c) ? bm * ak[r] * dec : 0.f; tl[t][r] = (s <= c) ? DN_SCALE * aq[r] * dec : 0.f; }
                    *(LAS f32x4*)(Al + c * 64 + 16 * t + 4 * fq) = av; }
                else tl[t] = (f32x4){0.f, 0.f, 0.f, 0.f}; }
#pragma unroll
            for (int k2 = 0; k2 < 2; ++k2) { v4u w; w.x = pk2(tl[2 * k2][0], tl[2 * k2][1]); w.y = pk2(tl[2 * k2][2], tl[2 * k2][3]); w.z = pk2(tl[2 * k2 + 1][0], tl[2 * k2 + 1][1]); w.w = pk2(tl[2 * k2 + 1][2], tl[2 * k2 + 1][3]);
                *(v4u*)(fa + 16384 + (m * 2 + k2) * 1024 + lane * 16) = w; } }
        asm volatile("s_waitcnt lgkmcnt(0)" ::: "memory");
        float Tc[64];
#pragma unroll
        for (int m = 0; m < 64; ++m) Tc[m] = (m == lane) ? 1.f : 0.f;
#pragma unroll
        for (int r = 1; r < 64; ++r) { float acc = 0.f;
#pragma unroll
            for (int m4 = 0; m4 < (r + 3) / 4; ++m4) { const f32x4 a4 = *(const LAS f32x4*)(Al + r * 64 + 4 * m4);
#pragma unroll
                for (int e = 0; e < 4; ++e) if (4 * m4 + e < r) acc += a4[e] * Tc[4 * m4 + e]; }
            Tc[r] -= acc; if ((r & 3) == 3) __builtin_amdgcn_sched_barrier(0); }
        asm volatile("s_waitcnt lgkmcnt(0)" ::: "memory");
        LAS bf16* T1l = (LAS bf16*)Al; LAS bf16* T2l = T1l + 4096;
        { const float c1 = bv, c2 = bv * expf(gcv);
#pragma unroll
          for (int i = 0; i < 64; ++i) { T1l[i * 64 + lane] = (bf16)(pk2(Tc[i] * c1, 0.f) & 0xffffu); T2l[i * 64 + lane] = (bf16)(pk2(Tc[i] * c2, 0.f) & 0xffffu); } }
        asm volatile("s_waitcnt lgkmcnt(0)" ::: "memory");
        bf16x8 t1f[4][2], t2f[4][2];
#pragma unroll
        for (int m = 0; m < 4; ++m)
#pragma unroll
            for (int k2 = 0; k2 < 2; ++k2) { const int o = (16 * m + fr) * 64 + 32 * k2 + 4 * fq;
                { const v2u lo = *(const LAS v2u*)(T1l + o), hi = *(const LAS v2u*)(T1l + o + 16); v4u w; w.x = lo.x; w.y = lo.y; w.z = hi.x; w.w = hi.y; t1f[m][k2] = __builtin_bit_cast(bf16x8, w); }
                { const v2u lo = *(const LAS v2u*)(T2l + o), hi = *(const LAS v2u*)(T2l + o + 16); v4u w; w.x = lo.x; w.y = lo.y; w.z = hi.x; w.w = hi.y; t2f[m][k2] = __builtin_bit_cast(bf16x8, w); } }
        asm volatile("s_waitcnt lgkmcnt(0)" ::: "memory");
        LAS unsigned char* tile = (LAS unsigned char*)Al;
        typedef short s16x4 __attribute__((ext_vector_type(4)));
#define DN_STAGE_TILE(src, pitch, coff) do { _Pragma("unroll") for (int hb_ = 0; hb_ < 2; ++hb_) { v4u pv[8]; _Pragma("unroll") for (int it_ = 0; it_ < 8; ++it_) { const int p_ = lane + 64 * (it_ + 8 * hb_), row_ = p_ >> 4, c16_ = p_ & 15; pv[it_] = *(const v4u*)((src) + (t0 + row_) * (pitch) + (coff) + c16_ * 8); } \
            _Pragma("unroll") for (int it_ = 0; it_ < 8; ++it_) { const int p_ = lane + 64 * (it_ + 8 * hb_), row_ = p_ >> 4, c16_ = p_ & 15; *(LAS v4u*)(tile + row_ * 256 + (((c16_ >> 1) ^ (row_ & 7)) << 5) + ((c16_ & 1) << 4)) = pv[it_]; } } } while (0)
#define DN_TR_FRAG(dst, ct, k2) do { const int r0_ = 32 * (k2) + 4 * fq + (fr >> 2), r1_ = r0_ + 16; \
            const s16x4 lo_ = __builtin_amdgcn_ds_read_tr16_b64_v4i16((LAS s16x4*)(tile + r0_ * 256 + ((((ct)) ^ (r0_ & 7)) << 5) + ((fr & 3) << 3))); \
            const s16x4 hi_ = __builtin_amdgcn_ds_read_tr16_b64_v4i16((LAS s16x4*)(tile + r1_ * 256 + ((((ct)) ^ (r1_ & 7)) << 5) + ((fr & 3) << 3))); \
            dst = (bf16x8){lo_[0], lo_[1], lo_[2], lo_[3], hi_[0], hi_[1], hi_[2], hi_[3]}; } while (0)
        DN_STAGE_TILE(VV, 1024, hv * 128);
        asm volatile("s_waitcnt lgkmcnt(0)" ::: "memory");
#pragma unroll 1
        for (int j = 0; j < 8; ++j) { bf16x8 vf[2];
            DN_TR_FRAG(vf[0], j, 0); DN_TR_FRAG(vf[1], j, 1);
#pragma unroll
            for (int m = 0; m < 4; ++m) { f32x4 a = {0.f, 0.f, 0.f, 0.f};
#pragma unroll
                for (int k2 = 0; k2 < 2; ++k2) a = __builtin_amdgcn_mfma_f32_16x16x32_bf16(t1f[m][k2], vf[k2], a, 0, 0, 0);
                v2u w; w.x = pk2(a[0], a[1]); w.y = pk2(a[2], a[3]); *(v2u*)(FU + (size_t)it * FU_STRIDE + ((j * 4 + m) * 64 + lane) * 8) = w; } }
        asm volatile("s_waitcnt lgkmcnt(0)" ::: "memory");
        DN_STAGE_TILE(KN, 512, hq * 128);
        asm volatile("s_waitcnt lgkmcnt(0)" ::: "memory");
        if ((hv & 1) == 0) { int fr2 = fr, fq2 = fq; asm volatile("" : "+v"(fr2), "+v"(fq2));
#pragma unroll
            for (int m = 0; m < 4; ++m)
#pragma unroll
                for (int ks = 0; ks < 4; ++ks) { const bf16* qp = QN + (t0 + 16 * m + fr2) * 512 + hq * 128 + 32 * ks + 4 * fq2; const v2u lo = *(const v2u*)qp, hi = *(const v2u*)(qp + 16);
                    v4u w; w.x = lo.x; w.y = lo.y; w.z = hi.x; w.w = hi.y; *(v4u*)(fb + (m * 4 + ks) * 1024 + lane * 16) = w; } }
#pragma unroll 1
        for (int dh = 0; dh < 2; ++dh) { bf16x8 ktf[4][2];
#pragma unroll
            for (int d4 = 0; d4 < 4; ++d4) { DN_TR_FRAG(ktf[d4][0], 4 * dh + d4, 0); DN_TR_FRAG(ktf[d4][1], 4 * dh + d4, 1); }
            if ((hv & 1) == 0) {
#pragma unroll
                for (int d4 = 0; d4 < 4; ++d4)
#pragma unroll
                    for (int k2 = 0; k2 < 2; ++k2) *(bf16x8*)(fb + 16384 + ((4 * dh + d4) * 2 + k2) * 1024 + lane * 16) = ktf[d4][k2]; }
#pragma unroll
            for (int m = 0; m < 4; ++m) { f32x4 acc[4];
#pragma unroll
                for (int d4 = 0; d4 < 4; ++d4) { acc[d4] = (f32x4){0.f, 0.f, 0.f, 0.f};
#pragma unroll
                    for (int k2 = 0; k2 < 2; ++k2) acc[d4] = __builtin_amdgcn_mfma_f32_16x16x32_bf16(ktf[d4][k2], t2f[m][k2], acc[d4], 0, 0, 0); }
#pragma unroll
                for (int kk = 0; kk < 2; ++kk) { v4u w; w.x = pk2(-acc[2 * kk][0], -acc[2 * kk][1]); w.y = pk2(-acc[2 * kk][2], -acc[2 * kk][3]); w.z = pk2(-acc[2 * kk + 1][0], -acc[2 * kk + 1][1]); w.w = pk2(-acc[2 * kk + 1][2], -acc[2 * kk + 1][3]);
                    *(v4u*)(fa + (m * 4 + 2 * dh + kk) * 1024 + lane * 16) = w; } } }
        asm volatile("s_waitcnt lgkmcnt(0)" ::: "memory");
#undef DN_STAGE_TILE
#undef DN_TR_FRAG
    }
}
__device__ __forceinline__ void phase_dn_scan(const Args& args, LAS unsigned char* lds) {
    int tid_ = threadIdx.x; asm volatile("" : "+v"(tid_)); const int tid = tid_, lane = tid & 63, wave = __builtin_amdgcn_readfirstlane(tid >> 6), G = gridDim.x, bid = blockIdx.x;
    if (bid >= 128) {
        const int gw = (bid - 128) * NWAVES + wave, NGW = (G - 128) * NWAVES;
        convert_weights(args, lds, CV_PER_L, CV_N_EXP, gw, NGW); convert_weights(args, lds, CV_N_EXP + CV_MIX_L01, CV_N_EXP + CV_N_MIXI, gw, NGW); return; }
    unsigned char* ws = uni_ptr(args.ws);
    const unsigned char* FA = ws + WS_ACT + A_FA; const unsigned char* FB = ws + WS_ACT + A_FB; const unsigned char* FU = ws + WS_ACT + A_FU; bf16* O = (bf16*)(ws + WS_ACT + A_O);
    const int fr = lane & 15, fq = lane >> 4;
    constexpr int SLOT = 60416, O_QK = 16384, O_TB = 24576, O_Q = 25600, O_KT = 41984, O_U = 58368;
#define SB() __builtin_amdgcn_sched_barrier(0)
#define WGBAR() do { asm volatile("" ::: "memory"); __builtin_amdgcn_s_barrier(); asm volatile("" ::: "memory"); } while (0)
#define DN_AUX 0
#define DMA4(g, l) do { __builtin_amdgcn_global_load_lds((g), (l), 16, 0, DN_AUX); __builtin_amdgcn_global_load_lds((g), (l), 16, 1024, DN_AUX); __builtin_amdgcn_global_load_lds((g), (l), 16, 2048, DN_AUX); __builtin_amdgcn_global_load_lds((g), (l), 16, 3072, DN_AUX); } while (0)
    for (int sidx = bid; sidx < 128; sidx += G) {
        const int bh = (sidx & 7) * 2 + (sidx >> 6), j = (sidx >> 3) & 7, b = bh >> 3, hv = bh & 7, hq = hv >> 1;
        const int it0 = bh * 256, itq0 = (b * 4 + hq) * 256;
        if (wave == 1 || wave == 4) {
#define DN_ISSUE_A(nn) do { LAS unsigned char* sl_ = lds + ((nn) & 1) * SLOT; \
                if (wave == 1) { const unsigned char* fa_ = FA + (size_t)(it0 + (nn)) * FA_STRIDE + lane * 16; \
                    _Pragma("unroll") for (int f4 = 0; f4 < 4; ++f4) { DMA4((const unsigned*)(fa_ + f4 * 4096), (LAS unsigned*)(sl_ + f4 * 4096)); } \
                    __builtin_amdgcn_global_load_lds((const unsigned*)(fa_ + 24576), (LAS unsigned*)(sl_ + O_TB), 16, 0, DN_AUX); } \
                else { const unsigned char* fb_ = FB + (size_t)(itq0 + (nn)) * FB_STRIDE + lane * 16; const unsigned char* fu_ = FU + (size_t)(it0 + (nn)) * FU_STRIDE + j * 2048 + lane * 16; \
                    _Pragma("unroll") for (int f4 = 0; f4 < 4; ++f4) { DMA4((const unsigned*)(fb_ + f4 * 4096), (LAS unsigned*)(sl_ + O_Q + f4 * 4096)); } \
                    __builtin_amdgcn_global_load_lds((const unsigned*)(fu_), (LAS unsigned*)(sl_ + O_U), 16, 0, DN_AUX); __builtin_amdgcn_global_load_lds((const unsigned*)(fu_), (LAS unsigned*)(sl_ + O_U), 16, 1024, DN_AUX); } } while (0)
#define DN_WAIT_A() do { if (wave == 1) asm volatile("s_waitcnt vmcnt(17)" ::: "memory"); else asm volatile("s_waitcnt vmcnt(18)" ::: "memory"); } while (0)
            DN_ISSUE_A(0); DN_ISSUE_A(1);
            DN_WAIT_A();
#pragma unroll 1
            for (int n = 0; n < 256; ++n) {
                WGBAR();
                WGBAR();
                if (n + 2 < 256) { DN_ISSUE_A(n + 2); DN_WAIT_A(); }
                else asm volatile("s_waitcnt vmcnt(0)" ::: "memory");
            }
#undef DN_ISSUE_A
#undef DN_WAIT_A
        } else if (wave == 2 || wave == 5) {
#define DN_ISSUE_B(nn) do { LAS unsigned char* sl_ = lds + ((nn) & 1) * SLOT; const unsigned char* fb_ = FB + (size_t)(itq0 + (nn)) * FB_STRIDE + 16384 + lane * 16; \
                if (wave == 2) { const unsigned char* fa_ = FA + (size_t)(it0 + (nn)) * FA_STRIDE + 16384 + lane * 16; \
                    _Pragma("unroll") for (int f4 = 0; f4 < 2; ++f4) { DMA4((const unsigned*)(fa_ + f4 * 4096), (LAS unsigned*)(sl_ + O_QK + f4 * 4096)); } \
                    DMA4((const unsigned*)(fb_), (LAS unsigned*)(sl_ + O_KT)); } \
                else { _Pragma("unroll") for (int f4 = 1; f4 < 4; ++f4) { DMA4((const unsigned*)(fb_ + f4 * 4096), (LAS unsigned*)(sl_ + O_KT + f4 * 4096)); } } } while (0)
            DN_ISSUE_B(0);
#pragma unroll 1
            for (int n = 0; n < 256; ++n) {
                WGBAR();
                if (n + 1 < 256) { DN_ISSUE_B(n + 1); asm volatile("s_waitcnt vmcnt(12)" ::: "memory"); }
                else asm volatile("s_waitcnt vmcnt(0)" ::: "memory");
                WGBAR();
            }
#undef DN_ISSUE_B
        } else if (wave == 3) {
            unsigned sink = 0u, pa = 0u, pb = 0u;
#pragma unroll 1
            for (int n = 0; n < 256; ++n) {
                WGBAR(); WGBAR();
                sink += pa + pb;
                const int p = n + 5;
                if (p < 256) { const int li = j * 57 + lane;
                    if (lane < 57 && li < 456) { const unsigned char* q = li < 200 ? FA + (size_t)(it0 + p) * FA_STRIDE + li * 128 : FB + (size_t)(itq0 + p) * FB_STRIDE + (li - 200) * 128; pa = *(const volatile unsigned*)q; }
                    if (lane < 16) pb = *(const volatile unsigned*)(FU + (size_t)(it0 + p) * FU_STRIDE + j * 2048 + lane * 128); }
            }
            sink += pa + pb;
            if (sink == 0x9e3779b9u) O[0] = 0;
        } else if (wave != 0) {
#pragma unroll 1
            for (int n = 0; n < 256; ++n) { WGBAR(); WGBAR(); }
        } else {
        f32x4 S[8];
#pragma unroll
        for (int dt = 0; dt < 8; ++dt) S[dt] = (f32x4){0.f, 0.f, 0.f, 0.f};
        bf16x8 sf[4];
#pragma unroll
        for (int ks = 0; ks < 4; ++ks) sf[ks] = (bf16x8){0, 0, 0, 0, 0, 0, 0, 0};
#pragma unroll 1
        for (int n = 0; n < 256; ++n) {
            WGBAR();
            const LAS unsigned char* base = lds + (n & 1) * SLOT + lane * 16;
            const LAS float* tbl = (const LAS float*)(lds + (n & 1) * SLOT + O_TB);
            f32x4 egc[4], ekd[4], av[4], ao[4];
#pragma unroll
            for (int m = 0; m < 4; ++m) { egc[m] = *(const LAS f32x4*)(tbl + 16 * m + 4 * fq); ekd[m] = *(const LAS f32x4*)(tbl + 64 + 16 * m + 4 * fq);
                const v2u u2 = *(const LAS v2u*)(lds + (n & 1) * SLOT + O_U + (m * 64 + lane) * 8); av[m] = (f32x4){bflo(u2.x), bfhi(u2.x), bflo(u2.y), bfhi(u2.y)}; ao[m] = (f32x4){0.f, 0.f, 0.f, 0.f}; }
            const float gl = tbl[128 + lane];
            SB();
            bf16x8 Aw[16], Bq[16];
#pragma unroll
            for (int f = 0; f < 16; ++f) Aw[f] = *(const LAS bf16x8*)(base + f * 1024);
            SB();
#pragma unroll
            for (int ks = 0; ks < 4; ++ks) {
#pragma unroll
                for (int m = 0; m < 4; ++m) Bq[m * 4 + ks] = *(const LAS bf16x8*)(base + O_Q + (m * 4 + ks) * 1024);
#pragma unroll
                for (int m = 0; m < 4; ++m) av[m] = __builtin_amdgcn_mfma_f32_16x16x32_bf16(Aw[m * 4 + ks], sf[ks], av[m], 0, 0, 0);
                SB(); }
            asm volatile("s_waitcnt lgkmcnt(0)" ::: "memory");
            WGBAR();
            bf16x8 Ck[16], Dk[8];
#pragma unroll
            for (int ks = 0; ks < 4; ++ks) {
#pragma unroll
                for (int f = 0; f < 2; ++f) { Ck[8 + ks * 2 + f] = *(const LAS bf16x8*)(base + O_KT + (ks * 2 + f) * 1024); Dk[ks * 2 + f] = *(const LAS bf16x8*)(base + O_KT + 8192 + (ks * 2 + f) * 1024); Ck[ks * 2 + f] = *(const LAS bf16x8*)(base + O_QK + (ks * 2 + f) * 1024); }
#pragma unroll
                for (int m = 0; m < 4; ++m) ao[m] = __builtin_amdgcn_mfma_f32_16x16x32_bf16(Bq[m * 4 + ks], sf[ks], ao[m], 0, 0, 0);
                SB(); }
#pragma unroll
            for (int dt = 0; dt < 8; ++dt) S[dt] = S[dt] * gl;
            bf16x8 vf[2], vpf[2];
#pragma unroll
            for (int k2 = 0; k2 < 2; ++k2) { v4u w; w.x = pk2(av[2 * k2][0], av[2 * k2][1]); w.y = pk2(av[2 * k2][2], av[2 * k2][3]); w.z = pk2(av[2 * k2 + 1][0], av[2 * k2 + 1][1]); w.w = pk2(av[2 * k2 + 1][2], av[2 * k2 + 1][3]); vf[k2] = __builtin_bit_cast(bf16x8, w);
                const f32x4 p0 = av[2 * k2] * ekd[2 * k2], p1 = av[2 * k2 + 1] * ekd[2 * k2 + 1];
                v4u x; x.x = pk2(p0[0], p0[1]); x.y = pk2(p0[2], p0[3]); x.z = pk2(p1[0], p1[1]); x.w = pk2(p1[2], p1[3]); vpf[k2] = __builtin_bit_cast(bf16x8, x); }
#pragma unroll
            for (int m = 0; m < 4; ++m) ao[m] = ao[m] * egc[m];
            SB();
#pragma unroll
            for (int k2 = 0; k2 < 2; ++k2)
#pragma unroll
                for (int dt = 0; dt < 4; ++dt) S[dt] = __builtin_amdgcn_mfma_f32_16x16x32_bf16(Ck[8 + dt * 2 + k2], vpf[k2], S[dt], 0, 0, 0);
#pragma unroll
            for (int k2 = 0; k2 < 2; ++k2)
#pragma unroll
                for (int dt = 4; dt < 8; ++dt) S[dt] = __builtin_amdgcn_mfma_f32_16x16x32_bf16(Dk[(dt - 4) * 2 + k2], vpf[k2], S[dt], 0, 0, 0);
#pragma unroll
            for (int k2 = 0; k2 < 2; ++k2)
#pragma unroll
                for (int m = 0; m < 4; ++m) ao[m] = __builtin_amdgcn_mfma_f32_16x16x32_bf16(Ck[m * 2 + k2], vf[k2], ao[m], 0, 0, 0);
            SB();
#pragma unroll
            for (int ks = 0; ks < 4; ++ks) { v4u w; w.x = pk2(S[2 * ks][0], S[2 * ks][1]); w.y = pk2(S[2 * ks][2], S[2 * ks][3]); w.z = pk2(S[2 * ks + 1][0], S[2 * ks + 1][1]); w.w = pk2(S[2 * ks + 1][2], S[2 * ks + 1][3]); sf[ks] = __builtin_bit_cast(bf16x8, w); }
            asm volatile("s_waitcnt lgkmcnt(0)" ::: "memory");
            { bf16* op = O + ((size_t)b * SEQ + (size_t)n * 64 + 4 * fq) * 1024 + hv * 128 + 16 * j + fr;
#pragma unroll
              for (int m = 0; m < 4; ++m)
#pragma unroll
                  for (int r = 0; r < 4; ++r) op[(size_t)(16 * m + r) * 1024] = (bf16)(pk2(ao[m][r], 0.f) & 0xffffu); }
        }
        }
        __syncthreads();
    }
#undef SB
#undef DMA4
#undef WGBAR
}
__device__ __forceinline__ void phase_dn_ogate(const Args& args) {
    int tid_ = threadIdx.x; asm volatile("" : "+v"(tid_)); const int tid = tid_, lane = tid & 63, wave = __builtin_amdgcn_readfirstlane(tid >> 6), G = gridDim.x, bid = blockIdx.x; (void)tid; (void)lane; (void)wave;
    unsigned char* ws = uni_ptr(args.ws); const float* o_norm = args.in[23];
    const bf16* O = (const bf16*)(ws + WS_ACT + A_O); const bf16* Z = (const bf16*)(ws + WS_ACT + A_Z); bf16* GT = (bf16*)(ws + WS_ACT + A_H);
    for (int t = bid * NWAVES + wave; t < T; t += G * NWAVES) {
#pragma unroll
        for (int j = 0; j < 2; ++j) { const int ch = 8 * lane + 512 * j; const v4u q = *(const v4u*)(O + (size_t)t * 1024 + ch), z = *(const v4u*)(Z + (size_t)t * 1024 + ch);
            float o[8] = {bflo(q.x), bfhi(q.x), bflo(q.y), bfhi(q.y), bflo(q.z), bfhi(q.z), bflo(q.w), bfhi(q.w)}; const float zz[8] = {bflo(z.x), bfhi(z.x), bflo(z.y), bfhi(z.y), bflo(z.z), bfhi(z.z), bflo(z.w), bfhi(z.w)};
            float ss = 0.f;
#pragma unroll
            for (int e = 0; e < 8; ++e) ss += o[e] * o[e];
            ss += __shfl_xor(ss, 1); ss += __shfl_xor(ss, 2); ss += __shfl_xor(ss, 4); ss += __shfl_xor(ss, 8);
            const float r = __builtin_amdgcn_rsqf(ss * (1.0f / 128.0f) + EPS);
#pragma unroll
            for (int e = 0; e < 8; ++e) o[e] = o[e] * r * o_norm[(ch & 127) + e] * siluf_(zz[e]);
            v4u w; w.x = pk2(o[0], o[1]); w.y = pk2(o[2], o[3]); w.z = pk2(o[4], o[5]); w.w = pk2(o[6], o[7]); *(v4u*)(GT + (size_t)t * 1024 + ch) = w; }
    }
}

__device__ __forceinline__ void phase_moe_router(const Args& args, int L, LAS unsigned char* lds) {
    int tid_ = threadIdx.x; asm volatile("" : "+v"(tid_)); const int tid = tid_, lane = tid & 63, wave = __builtin_amdgcn_readfirstlane(tid >> 6), G = gridDim.x, bid = blockIdx.x;
    unsigned char* ws = uni_ptr(args.ws); const int ib = LBASE(L) + 4 + NMIX(L);
    const float* X = args.out; bf16* H = (bf16*)(ws + WS_ACT + A_H); const float* MOD = (const float*)(ws + WS_MOD) + (size_t)L * 2 * 6144;
    const float* nf = args.in[LBASE(L) + 1]; const float* rb = args.in[ib + 1];
    const bf16* RH = (const bf16*)(ws + WS_RTR + (size_t)L * 196608); const bf16* RLo = RH + 49152;
    int* EID = (int*)(ws + WS_EID); float* GATE = (float*)(ws + WS_GATE); int* CNT = (int*)(ws + WS_CNT);
    LAS float* gs = (LAS float*)lds; LAS float* sh = gs + 1024; LAS int* lcnt = (LAS int*)(lds + 8192);
    LAS float* ssp = (LAS float*)(lds + 8448);
    LAS float* part = (LAS float*)(lds + 9472);
    LAS float* logit = (LAS float*)(lds + 58624);
    const int r = lane & 15, q = lane >> 4, kw = 128 * wave;
    bf16x8 bh[4][3], bl[4][3];
#pragma unroll
    for (int ks = 0; ks < 4; ++ks)
#pragma unroll
        for (int nt = 0; nt < 3; ++nt) { bh[ks][nt] = *(const bf16x8*)(RH + (size_t)(nt * 16 + r) * 1024 + kw + 32 * ks + 8 * q); bl[ks][nt] = *(const bf16x8*)(RLo + (size_t)(nt * 16 + r) * 1024 + kw + 32 * ks + 8 * q); }
    for (int item = bid; item < T / 128; item += G) {
        const int r0 = item * 128, b = r0 / SEQ; const float* m = MOD + (size_t)b * 6144;
        __syncthreads();
        for (int k = tid; k < 1024; k += NTHR) { gs[k] = nf[k] * (1.0f + m[4096 + k]); sh[k] = m[3072 + k]; }
        if (tid < 32) lcnt[tid] = 0;
        f32x4 xv[8];
        { const float* xp = X + (size_t)(r0 + r) * 1024 + kw + 8 * q;
#pragma unroll
          for (int ks = 0; ks < 4; ++ks) { xv[2 * ks] = *(const f32x4*)(xp + 32 * ks); xv[2 * ks + 1] = *(const f32x4*)(xp + 32 * ks + 4); } }
        __syncthreads();
#pragma unroll 1
        for (int g = 0; g < 8; ++g) {
            const int row = r0 + 16 * g + r, pb = g & 1;
            f32x4 xn[8];
            if (g < 7) { const float* xp = X + (size_t)(row + 16) * 1024 + kw + 8 * q;
#pragma unroll
                for (int ks = 0; ks < 4; ++ks) { xn[2 * ks] = *(const f32x4*)(xp + 32 * ks); xn[2 * ks + 1] = *(const f32x4*)(xp + 32 * ks + 4); } }
            else {
#pragma unroll
                for (int i = 0; i < 8; ++i) xn[i] = xv[i]; }
            float ss = 0.f;
#pragma unroll
            for (int i = 0; i < 8; ++i) ss += (xv[i][0] * xv[i][0] + xv[i][1] * xv[i][1]) + (xv[i][2] * xv[i][2] + xv[i][3] * xv[i][3]);
            ss += __shfl_xor(ss, 16); ss += __shfl_xor(ss, 32);
            if (q == 0) ssp[(pb * 8 + wave) * 16 + r] = ss;
            __syncthreads();
            float tot = 0.f;
#pragma unroll
            for (int w = 0; w < 8; ++w) tot += ssp[(pb * 8 + w) * 16 + r];
            const float rstd = __builtin_amdgcn_rsqf(tot * (1.0f / 1024.0f) + EPS);
            f32x4 acc[3];
#pragma unroll
            for (int nt = 0; nt < 3; ++nt) acc[nt] = (f32x4){0.f, 0.f, 0.f, 0.f};
#pragma unroll
            for (int ks = 0; ks < 4; ++ks) { const int k0 = kw + 32 * ks + 8 * q;
                const f32x4 g0 = *(const LAS f32x4*)(gs + k0), g1 = *(const LAS f32x4*)(gs + k0 + 4), s0 = *(const LAS f32x4*)(sh + k0), s1 = *(const LAS f32x4*)(sh + k0 + 4);
                const f32x4 h0 = xv[2 * ks] * rstd * g0 + s0, h1 = xv[2 * ks + 1] * rstd * g1 + s1;
                v4u hi; hi.x = pk2(h0[0], h0[1]); hi.y = pk2(h0[2], h0[3]); hi.z = pk2(h1[0], h1[1]); hi.w = pk2(h1[2], h1[3]);
                v4u lo; lo.x = pk2(h0[0] - bflo(hi.x), h0[1] - bfhi(hi.x)); lo.y = pk2(h0[2] - bflo(hi.y), h0[3] - bfhi(hi.y)); lo.z = pk2(h1[0] - bflo(hi.z), h1[1] - bfhi(hi.z)); lo.w = pk2(h1[2] - bflo(hi.w), h1[3] - bfhi(hi.w));
                *(v4u*)(H + (size_t)row * 1024 + k0) = hi;
                const bf16x8 ahi = __builtin_bit_cast(bf16x8, hi), alo = __builtin_bit_cast(bf16x8, lo);
#pragma unroll
                for (int nt = 0; nt < 3; ++nt) { acc[nt] = __builtin_amdgcn_mfma_f32_16x16x32_bf16(bh[ks][nt], ahi, acc[nt], 0, 0, 0); acc[nt] = __builtin_amdgcn_mfma_f32_16x16x32_bf16(bl[ks][nt], ahi, acc[nt], 0, 0, 0); acc[nt] = __builtin_amdgcn_mfma_f32_16x16x32_bf16(bh[ks][nt], alo, acc[nt], 0, 0, 0); } }
#pragma unroll
            for (int nt = 0; nt < 3; ++nt) *(LAS f32x4*)(part + ((pb * 8 + wave) * 16 + r) * 48 + 16 * nt + 4 * q) = acc[nt];
            __syncthreads();
            for (int o = tid; o < 768; o += NTHR) { float sacc = 0.f;
#pragma unroll
                for (int w = 0; w < 8; ++w) sacc += part[(pb * 8 + w) * 768 + o];
                const int n = o % 48; logit[pb * 768 + o] = sacc + (n < 36 ? rb[n] : 0.f); }
            __syncthreads();
            if (wave == g && lane < 16) { float lg[36]; const int trow = r0 + 16 * g + lane;
#pragma unroll
                for (int i = 0; i < 9; ++i) { const f32x4 v = *(const LAS f32x4*)(logit + pb * 768 + lane * 48 + 4 * i); lg[4 * i] = v[0]; lg[4 * i + 1] = v[1]; lg[4 * i + 2] = v[2]; lg[4 * i + 3] = v[3]; }
                int gsel = 0; float gm = lg[0];
#pragma unroll
                for (int i = 1; i < 4; ++i) if (lg[i] > gm) { gm = lg[i]; gsel = i; }
                float gsum = 0.f;
#pragma unroll
                for (int i = 0; i < 4; ++i) gsum += expf(lg[i] - gm);
                const float pg = 1.0f / gsum;
                float le[8];
#pragma unroll
                for (int i = 0; i < 8; ++i) le[i] = gsel == 0 ? lg[4 + i] : (gsel == 1 ? lg[12 + i] : (gsel == 2 ? lg[20 + i] : lg[28 + i]));
                int j1 = 0; float m1 = le[0];
#pragma unroll
                for (int i = 1; i < 8; ++i) if (le[i] > m1) { m1 = le[i]; j1 = i; }
                int j2 = -1; float m2 = -INFINITY;
#pragma unroll
                for (int i = 0; i < 8; ++i) if (i != j1 && le[i] > m2) { m2 = le[i]; j2 = i; }
                const float p2 = expf(m2 - m1), den = 1.0f / (1.0f + p2);
                const int e1 = gsel * 8 + j1, e2 = gsel * 8 + j2;
                EID[(size_t)trow * 2] = e1; EID[(size_t)trow * 2 + 1] = e2; GATE[(size_t)trow * 2] = pg * den; GATE[(size_t)trow * 2 + 1] = pg * p2 * den;
                __hip_atomic_fetch_add(lcnt + e1, 1, __ATOMIC_RELAXED, __HIP_MEMORY_SCOPE_WORKGROUP); __hip_atomic_fetch_add(lcnt + e2, 1, __ATOMIC_RELAXED, __HIP_MEMORY_SCOPE_WORKGROUP); }
#pragma unroll
            for (int i = 0; i < 8; ++i) xv[i] = xn[i];
        }
        __syncthreads();
        if (tid < 32) CNT[item * 32 + tid] = lcnt[tid];
        if (item == 0 && tid < 128) *(v4u*)(H + (size_t)T * 1024 + 8 * tid) = (v4u){0u, 0u, 0u, 0u};
    }
}
__device__ __forceinline__ void phase_moe_scatter(const Args& args, LAS unsigned char* lds) {
    int tid_ = threadIdx.x; asm volatile("" : "+v"(tid_)); const int tid = tid_, lane = tid & 63, wave = __builtin_amdgcn_readfirstlane(tid >> 6), G = gridDim.x, bid = blockIdx.x; (void)tid; (void)lane; (void)wave;
    unsigned char* ws = uni_ptr(args.ws);
    const int* EID = (const int*)(ws + WS_EID); int* SLOT = (int*)(ws + WS_SLOT); const int* CNT = (const int*)(ws + WS_CNT); int* TILEE = (int*)(ws + WS_TILEE); int* TOK = (int*)(ws + WS_TOK);
    LAS int* tot = (LAS int*)lds; LAS int* before = tot + 32; LAS int* pstart = tot + 64; LAS int* lcnt = tot + 96; LAS int* lslot = tot + 128; LAS int* psum = tot + 384; LAS int* pbef = tot + 896;
    for (int item = bid; item < T / 128; item += G) {
        const int r0 = item * 128;
        __syncthreads();
        { const int e = tid & 31, part = tid >> 5; int s_ = 0, b_ = 0; int cv[16];
#pragma unroll
          for (int i = 0; i < 16; ++i) cv[i] = CNT[(part * 16 + i) * 32 + e];
#pragma unroll
          for (int i = 0; i < 16; ++i) { s_ += cv[i]; b_ += (part * 16 + i < item) ? cv[i] : 0; }
          psum[part * 32 + e] = s_; pbef[part * 32 + e] = b_; }
        __syncthreads();
        if (tid < 32) { int t_ = 0, b_ = 0;
#pragma unroll
            for (int p = 0; p < 16; ++p) { t_ += psum[p * 32 + tid]; b_ += pbef[p * 32 + tid]; }
            tot[tid] = t_; before[tid] = b_; lcnt[tid] = 0; }
        __syncthreads();
        if (tid == 0) { int ps = 0; for (int e = 0; e < 32; ++e) { pstart[e] = ps; ps += (tot[e] + 255) & ~255; }
            if (item == 0) { TILEE[0] = ps >> 8; for (int e = 0; e < 32; ++e) { const int t0 = pstart[e] >> 8, nt = ((tot[e] + 255) >> 8); for (int i = 0; i < nt; ++i) TILEE[16 + t0 + i] = e; } } }
        __syncthreads();
        if (tid < 256) { const int e = EID[(size_t)r0 * 2 + tid]; const int rank = __hip_atomic_fetch_add(lcnt + e, 1, __ATOMIC_RELAXED, __HIP_MEMORY_SCOPE_WORKGROUP); const int slot = pstart[e] + before[e] + rank; SLOT[(size_t)r0 * 2 + tid] = slot; lslot[tid] = slot; }
        __syncthreads();
        if (tid < 256) TOK[lslot[tid]] = r0 + (tid >> 1);
        { const int e = item & 31, part = item >> 5; const int p0 = pstart[e] + tot[e], npad = ((tot[e] + 255) & ~255) - tot[e];
          if (tid < 32 && part * 32 + tid < npad) TOK[p0 + part * 32 + tid] = T; }
    }
}
__device__ __forceinline__ void phase_moe_combine(const Args& args, int L) {
    int tid_ = threadIdx.x; asm volatile("" : "+v"(tid_)); const int tid = tid_, lane = tid & 63, wave = __builtin_amdgcn_readfirstlane(tid >> 6), G = gridDim.x, bid = blockIdx.x; (void)tid;
    unsigned char* ws = uni_ptr(args.ws); float* X = args.out; const bf16* Y = (const bf16*)(ws + WS_ACT + A_Y); bf16* H = (bf16*)(ws + WS_ACT + A_H);
    const int* SLOT = (const int*)(ws + WS_SLOT); const float* GATE = (const float*)(ws + WS_GATE); const float* MOD = (const float*)(ws + WS_MOD);
    const int NW = G * NWAVES;
    for (int t = bid * NWAVES + wave; t < T; t += 2 * NW) {
        const int tb = t + NW; const bool two = tb < T; const int t1 = two ? tb : t;
        const int ta[2] = {t, t1};
        f32x4 xv[2][4], gg[2][4]; v2u y0[2][4], y1[2][4]; float g0[2], g1[2];
#pragma unroll
        for (int k = 0; k < 2; ++k) { const int tt = ta[k]; const int b = tt / SEQ;
            const int s0 = SLOT[(size_t)tt * 2], s1 = SLOT[(size_t)tt * 2 + 1]; g0[k] = GATE[(size_t)tt * 2]; g1[k] = GATE[(size_t)tt * 2 + 1];
            const float* gf = MOD + (size_t)(L * 2 + b) * 6144 + 5120;
#pragma unroll
            for (int j = 0; j < 4; ++j) { const int c = 4 * lane + 256 * j; xv[k][j] = *(const f32x4*)(X + (size_t)tt * 1024 + c); gg[k][j] = *(const f32x4*)(gf + c);
                y0[k][j] = *(const v2u*)(Y + (size_t)s0 * 1024 + c); y1[k][j] = *(const v2u*)(Y + (size_t)s1 * 1024 + c); } }
#pragma unroll
        for (int k = 0; k < 2; ++k) { if (k == 1 && !two) break; const int tt = ta[k]; const int b = tt / SEQ; f32x4 v[4];
#pragma unroll
            for (int j = 0; j < 4; ++j) { const int c = 4 * lane + 256 * j; f32x4 mo;
                mo[0] = g0[k] * bflo(y0[k][j].x) + g1[k] * bflo(y1[k][j].x); mo[1] = g0[k] * bfhi(y0[k][j].x) + g1[k] * bfhi(y1[k][j].x); mo[2] = g0[k] * bflo(y0[k][j].y) + g1[k] * bflo(y1[k][j].y); mo[3] = g0[k] * bfhi(y0[k][j].y) + g1[k] * bfhi(y1[k][j].y);
                v[j] = xv[k][j] + gg[k][j] * mo; *(f32x4*)(X + (size_t)tt * 1024 + c) = v[j]; }
            if (L < 3) { const float* m = MOD + (size_t)((L + 1) * 2 + b) * 6144; norm_store_row(v, args.in[LBASE(L + 1)], m, m + 1024, H + (size_t)tt * 1024, lane); } }
    }
}

constexpr int N_PHASES = 37;

#ifndef DUP_MASK
#define DUP_MASK 0
#endif
#define PHASE(k) if ((lo <= (k) && (k) < hi) && ((started ? (xcd_barrier(bar), 0) : 0), started = true, true))
#define NREP(g) (1 + ((DUP_MASK >> (g)) & 1))
#define PHASE_G(k, g) PHASE(k) for (int rep_ = 0; rep_ < NREP(g); ++rep_, ((rep_ < NREP(g)) ? (xcd_barrier(bar), 0) : 0))
template <int L> __device__ __forceinline__ void run_layer(const Args& args, LAS unsigned char* lds, const XcdBarrier& bar, bool& started, const int lo, const int hi) {
    const int G = gridDim.x, bid = blockIdx.x;
    unsigned char* ws = uni_ptr(args.ws);
    const float* MOD = (const float*)(ws + WS_MOD);
    bf16* Hb = (bf16*)(ws + WS_ACT + A_H);

        const int pb = (L == 0) ? 1 : (L == 1 ? 10 : (L == 2 ? 21 : 29));
        const float* xsrc = (L == 0) ? args.in[0] : (const float*)args.out;
        const float* gate_m = MOD + (size_t)L * 2 * 6144 + 2048;
        int mb;
        if constexpr (L == 0 || L == 3) {
            int g0 = pb;
            if (L == 0) { PHASE_G(pb, 8) { phase_norm0(args); } g0 = pb + 1; }
            const bf16* Win = (const bf16*)(ws + WS_WMIX + (L == 0 ? WMIX_GM_IN0 : WMIX_GM_IN3)); const bf16* Wout = (const bf16*)(ws + WS_WMIX + (L == 0 ? WMIX_GM_OUT0 : WMIX_GM_OUT3));
            PHASE_G(g0, 1) { pg8::Gemm g{Hb, Win, T, 2048, 1024}; pg8::StaticOrder S; S.init(T, 2048, G, bid);
                EpiGm1 E{(bf16*)(ws + WS_ACT + A_U), (bf16*)(ws + WS_ACT + A_V), (float*)(ws + WS_VSSP)};
                pg8::gemm_phase<EpiGm1, pg8::StaticOrder, true, true>(lds, g, S, E); }
            PHASE_G(g0 + 1, 2) { phase_gm_spatial(args, L, lds); }
            PHASE_G(g0 + 2, (L == 0 ? 1 : 31)) { pg8::Gemm g{(const bf16*)(ws + WS_ACT + A_GATED), Wout, T, 1024, 1024}; pg8::StaticOrder S; S.init(T, 1024, G, bid);
                EpiRes E{xsrc, args.out, gate_m};
                pg8::gemm_phase<EpiRes, pg8::StaticOrder, true, true>(lds, g, S, E); }
            mb = g0 + 3;
        } else if constexpr (L == 1) {
            PHASE_G(pb, 1) { pg8::Gemm g{Hb, (const bf16*)(ws + WS_WMIX + WMIX_DN_IN), T, 3328, 1024}; pg8::StaticOrder S; S.init(T, 3328, G, bid);
                EpiDn1 E{(bf16*)(ws + WS_ACT + A_QKV), (bf16*)(ws + WS_ACT + A_Z), (float*)(ws + WS_BA)};
                pg8::gemm_phase<EpiDn1, pg8::StaticOrder, true, true>(lds, g, S, E); }
            PHASE_G(pb + 1, 3) { phase_dn_prep(args, lds); }
            PHASE_G(pb + 2, 4) { phase_dn_chunk(args, lds); }
            PHASE_G(pb + 3, 5) { phase_dn_scan(args, lds); }
            PHASE_G(pb + 4, 3) { phase_dn_ogate(args); }
            PHASE(pb + 5) { pg8::Gemm g{Hb, (const bf16*)(ws + WS_WMIX + WMIX_DN_OUT), T, 1024, 1024}; pg8::StaticOrder S; S.init(T, 1024, G, bid);
                EpiRes E{xsrc, args.out, gate_m};
                pg8::gemm_phase<EpiRes, pg8::StaticOrder, true, true>(lds, g, S, E); }
            mb = pb + 6;
        } else {
            PHASE_G(pb, 1) { pg8::Gemm g{Hb, (const bf16*)(ws + WS_WMIX + WMIX_SWA_IN), T, 1536, 1024}; pg8::StaticOrder S; S.init(T, 1536, G, bid);
                EpiBf E{(bf16*)(ws + WS_ACT + A_QKV), 1536, 0xffff};
                pg8::gemm_phase<EpiBf, pg8::StaticOrder, true, true>(lds, g, S, E); }
            PHASE_G(pb + 1, 2) { phase_swa_attn(args, lds); }
            PHASE(pb + 2) { pg8::Gemm g{Hb, (const bf16*)(ws + WS_WMIX + WMIX_SWA_OUT), T, 1024, 1024}; pg8::StaticOrder S; S.init(T, 1024, G, bid);
                EpiRes E{xsrc, args.out, gate_m};
                pg8::gemm_phase<EpiRes, pg8::StaticOrder, true, true>(lds, g, S, E); }
            mb = pb + 3;
        }
        PHASE_G(mb, 6) { phase_moe_router(args, L, lds); }
        PHASE_G(mb + 1, 9) { phase_moe_scatter(args, lds); }
        const int* TILEE = (const int*)(ws + WS_TILEE);
        PHASE_G(mb + 2, 7) { const int ntiles = TILEE[0]; pg8::Gemm g{Hb, (const bf16*)(ws + WS_W + (size_t)L * 96 * MiB), MAXROWS, 1024, 1024};
            MoeOrder S; S.init(TILEE + 16, ntiles, G, bid); EpiMoe1 E{(bf16*)(ws + WS_ACT + A_ACTV)};
            LAS int* lidx = (LAS int*)(lds + LDSCTL_OFF + 2048); const int* TOK = (const int*)(ws + WS_TOK);
            __syncthreads();
            for (int ui = 0; ui < 5; ++ui) { pg8::Unit u; if (S.next(ui, u) && threadIdx.x < 256) lidx[ui * 256 + threadIdx.x] = TOK[u.pm * 256 + threadIdx.x]; }
            __syncthreads();
            pg8::gemm_phase_gather<EpiMoe1, MoeOrder, true, true>(lds, g, S, E, lidx); }
        PHASE_G(mb + 3, 7) { const int ntiles = TILEE[0]; pg8::Gemm g{(const bf16*)(ws + WS_ACT + A_ACTV), (const bf16*)(ws + WS_W + (size_t)L * 96 * MiB + 64 * MiB), MAXROWS, 1024, 512};
            MoeOrder S; S.init(TILEE + 16, ntiles, G, bid); EpiBf E{(bf16*)(ws + WS_ACT + A_Y), 1024, 3};
            pg8::gemm_phase<EpiBf, MoeOrder, true, true>(lds, g, S, E); }
        PHASE(mb + 4) { phase_moe_combine(args, L); }

}
__global__ void __launch_bounds__(NTHR, 2) fwd_kernel(Args args) {
    extern __shared__ __attribute__((aligned(16))) unsigned char lds_raw[];
    LAS unsigned char* lds = (LAS unsigned char*)lds_raw;
    const int tid = threadIdx.x;
    unsigned char* ws = uni_ptr(args.ws);
    for (int u = tid; u < (LDS_BYTES - LDSCTL_OFF) / 4; u += NTHR) ((LAS unsigned*)(lds + LDSCTL_OFF))[u] = 0u;
    __syncthreads();
    volatile LAS unsigned* MISC = (volatile LAS unsigned*)(lds + MISC_OFF);
    XcdBarrier bar = xcd_barrier_post((unsigned*)(ws + WS_CTL) + 4096 + (size_t)args.li * XCD_BAR_WORDS, MISC + 8);
    const int lo = args.ph_lo, hi = args.ph_hi; bool started = false;
    const float* MOD = (const float*)(ws + WS_MOD);
    bf16* Hb = (bf16*)(ws + WS_ACT + A_H);

    PHASE_G(0, 0) { phase_prologue(args, lds); }

    run_layer<0>(args, lds, bar, started, lo, hi);
    run_layer<1>(args, lds, bar, started, lo, hi);
    run_layer<2>(args, lds, bar, started, lo, hi);
    run_layer<3>(args, lds, bar, started, lo, hi);
#undef PHASE
#undef PHASE_G
}

extern "C" void kernel_launch(void* const* d_in, const int* in_sizes, int n_in, void* d_out, int out_size, void* d_ws, size_t ws_size, hipStream_t stream) {
    static int grid = 0;
    if (grid == 0) {
        if (n_in != N_IN || in_sizes[0] != T * D || out_size != T * D || ws_size < WS_END) { fprintf(stderr, "kernel_launch: unexpected shapes (n_in %d, in0 %d, out %d, ws %zu < %zu)\n", n_in, n_in > 0 ? in_sizes[0] : -1, out_size, ws_size, (size_t)WS_END); grid = -1; return; }
        int dev = 0, cus = 0, per_cu = 0;
        if (hipGetDevice(&dev) != hipSuccess || hipDeviceGetAttribute(&cus, hipDeviceAttributeMultiprocessorCount, dev) != hipSuccess) { grid = -1; return; }
        if (hipFuncSetAttribute((const void*)fwd_kernel, hipFuncAttributeMaxDynamicSharedMemorySize, LDS_BYTES) != hipSuccess) { fprintf(stderr, "kernel_launch: hipFuncSetAttribute failed\n"); grid = -1; return; }
        if (hipOccupancyMaxActiveBlocksPerMultiprocessor(&per_cu, (const void*)fwd_kernel, NTHR, LDS_BYTES) != hipSuccess || per_cu < 1) fprintf(stderr, "kernel_launch: occupancy query reports %d\n", per_cu);
        (void)hipGetLastError();
        grid = cus;
    }
    if (grid < 0) return;
    if (hipMemsetAsync((char*)d_ws + WS_CTL, 0, CTL_ZERO_BYTES, stream) != hipSuccess) return;
    Args a{};
    for (int i = 0; i < N_IN; ++i) a.in[i] = (const float*)d_in[i];
    a.out = (float*)d_out; a.ws = (unsigned char*)d_ws; a.pad = 0;
#if MK_LAUNCH_MODE == 1
    a.ph_lo = 0; a.ph_hi = N_PHASES; a.li = 0;
    hipLaunchKernelGGL(fwd_kernel, dim3(grid), dim3(NTHR), LDS_BYTES, stream, a);
#else
#ifndef PROBE_PHASE
#define PROBE_PHASE -1
#endif
    for (int p = 0; p < N_PHASES; ++p) { a.ph_lo = p; a.ph_hi = p + 1; a.li = 0;
        for (int rep = 0; rep < (p == PROBE_PHASE ? 2 : 1); ++rep) hipLaunchKernelGGL(fwd_kernel, dim3(grid), dim3(NTHR), LDS_BYTES, stream, a); }
#endif
}
```

```cpp
#include <hip/hip_runtime.h>
#include <cstdio>
#include <cstdint>
#ifndef MK_LAUNCH_MODE
#define MK_LAUNCH_MODE 1
#endif
namespace pg8 {
#define PG8_LAS __attribute__((address_space(3)))
typedef unsigned short bf16_t;
typedef short bf16x8 __attribute__((ext_vector_type(8)));
typedef float f32x4 __attribute__((ext_vector_type(4)));
typedef unsigned u32x4 __attribute__((ext_vector_type(4)));
constexpr int BM = 256, BK = 64, HALF = 128, HTB = HALF * BK * 2  , STAGE_BYTES = 8 * HTB, NXCD = 8, WGM = 8;

__host__ __device__ __forceinline__ int lds_byte(int r, int c) { const int st = (r >> 4) * 2 + (c >> 5), rr = r & 15, cc = c & 31, ob = rr * 64 + cc * 2; return st * 1024 + (ob ^ (((ob >> 9) & 1) << 5)); }
__host__ __device__ __forceinline__ void stage_rc(int b, int& R, int& C) { const int st = b / 1024, sb = b % 1024, swz = sb ^ (((sb >> 9) & 1) << 5); R = (st >> 1) * 16 + swz / 64; C = (st & 1) * 32 + (swz % 64) / 2; }
__host__ __device__ __forceinline__ int perm32(int rho) { const int n = rho >> 4, i = rho & 15; return 8 * (i >> 2) + 4 * n + (i & 3); }

struct Unit { int pm, pn; };
struct Gemm { const bf16_t* A; const bf16_t* Bt; int M, N, K; };

struct StaticOrder {
    int nM, nN, nwg, G, c;
    __host__ __device__ void init(int M, int N, int G_, int c_) { nM = M / BM; nN = N / BM; nwg = nM * nN; G = G_; c = c_; }
    __host__ __device__ bool next(int i, Unit& u) const {
        const long L = (long)i * G + c; if (L >= nwg) return false;
        int wgid = (int)L; { const int q = nwg / NXCD, r = nwg % NXCD, xcd = wgid % NXCD, off = wgid / NXCD; wgid = (xcd < r ? xcd * (q + 1) : r * (q + 1) + (xcd - r) * q) + off; }
        const int nig = WGM * nN, gid = wgid / nig, fm = gid * WGM, gsz = (nM - fm) < WGM ? (nM - fm) : WGM;
        u.pm = fm + ((wgid % nig) % gsz); u.pn = (wgid % nig) / gsz; return true;
    }
    __device__ __forceinline__ void a_ready(const Unit&) const {}
    __device__ __forceinline__ void done(const Unit&) const {}
};
typedef float f32x2_ __attribute__((ext_vector_type(2))); typedef __bf16 bf16x2_ __attribute__((ext_vector_type(2)));
__device__ __forceinline__ unsigned cvt_pk_bf16(float lo, float hi) { const f32x2_ v = {lo, hi}; return __builtin_bit_cast(unsigned, __builtin_convertvector(v, bf16x2_)); }
typedef float f32x2 __attribute__((ext_vector_type(2)));
template <class Epi, class Sched, bool ALIGN_EPI = false, bool SP2 = false>
__device__ __forceinline__ void gemm_phase(PG8_LAS unsigned char* lds, const Gemm g, const Sched& S, const Epi& E) {
    const int tid = threadIdx.x, wid = __builtin_amdgcn_readfirstlane(tid >> 6), lane = tid & 63, wr = wid >> 2, wc = wid & 3, fr = lane & 15, fq = lane >> 4;
    const int K = g.K, nt = K / BK;
    unsigned voffA[2], voffB[2];
#pragma unroll
    for (int i = 0; i < 2; ++i) { int R, C; stage_rc(tid * 16 + i * 8192, R, C); const int Rb = Epi::PERM ? ((R & ~31) + perm32(R & 31)) : R;
        voffA[i] = (unsigned)(R * K + C) * 2u; voffB[i] = (unsigned)(Rb * K + C) * 2u; }
    const size_t kstep = (size_t)(BK * 2);
    const size_t hstep = (size_t)HALF * K * 2;
    const size_t tstep = 2 * hstep;
    const unsigned ldsw = (unsigned)wid * 1024u;
    const int aoff = lds_byte(wr * 64 + fr, fq * 8), boff = lds_byte(wc * 32 + fr, fq * 8);
#define PG8_SA(b, h) (((b) * 2 + (h)) * HTB)
#define PG8_SB(b, h) ((4 + (b) * 2 + (h)) * HTB)
#define PG8_STAGE(bufoff, gbase, voff) do { _Pragma("unroll") for (int _i = 0; _i < 2; ++_i) \
        __builtin_amdgcn_global_load_lds((const unsigned*)((const char*)(gbase) + (voff)[_i]), (PG8_LAS unsigned*)(lds + (bufoff) + ldsw + _i * 8192), 16, 0, 0); } while (0)
#define PG8_LDA(dst, b, h) do { _Pragma("unroll") for (int m = 0; m < 4; ++m) _Pragma("unroll") for (int k = 0; k < 2; ++k) dst[m][k] = *(const PG8_LAS bf16x8*)(lds + PG8_SA(b, h) + aoff + m * 2048 + k * 1024); } while (0)
#define PG8_LDB(dst, b, h) do { _Pragma("unroll") for (int n = 0; n < 2; ++n) _Pragma("unroll") for (int k = 0; k < 2; ++k) dst[n][k] = *(const PG8_LAS bf16x8*)(lds + PG8_SB(b, h) + boff + n * 2048 + k * 1024); } while (0)
#define PG8_MMA(ai, bj, At, Bt) do { __builtin_amdgcn_s_setprio(1); _Pragma("unroll") for (int m = 0; m < 4; ++m) _Pragma("unroll") for (int n = 0; n < 2; ++n) _Pragma("unroll") for (int k = 0; k < 2; ++k) \
        acc[ai][bj][m][n] = __builtin_amdgcn_mfma_f32_16x16x32_bf16(Bt[n][k], At[m][k], acc[ai][bj][m][n], 0, 0, 0); __builtin_amdgcn_s_setprio(0); } while (0)
#define PG8_WAIT_V(n) asm volatile("s_waitcnt vmcnt(" #n ")" ::: "memory")
#define PG8_WAIT_L(n) asm volatile("s_waitcnt lgkmcnt(" #n ")" ::: "memory")
#define PG8_BAR __builtin_amdgcn_s_barrier()
#define PG8_SCHED __builtin_amdgcn_sched_barrier(0)
    Unit cur, nxt; int ui = 0;
    if (!S.next(0, cur)) return;
    f32x4 acc[2][2][4][2];
#pragma unroll
    for (int a = 0; a < 2; ++a)
#pragma unroll
        for (int b = 0; b < 2; ++b)
#pragma unroll
            for (int m = 0; m < 4; ++m)
#pragma unroll
                for (int n = 0; n < 2; ++n) acc[a][b][m][n] = (f32x4){0.f, 0.f, 0.f, 0.f};
    bf16x8 At[4][2], B0[2][2], B1[2][2];
    const char* cA = (const char*)g.A + (size_t)cur.pm * tstep; const char* cB = (const char*)g.Bt + (size_t)cur.pn * tstep;
    S.a_ready(cur);
    if constexpr (SP2) {
        PG8_STAGE(PG8_SB(0, 0), cB, voffB); PG8_STAGE(PG8_SB(0, 1), cB + hstep, voffB); PG8_STAGE(PG8_SA(0, 0), cA, voffA); PG8_STAGE(PG8_SA(0, 1), cA + hstep, voffA);
        if (wr == 1) PG8_BAR;
        PG8_WAIT_V(2); PG8_BAR;
        PG8_STAGE(PG8_SB(1, 0), cB + kstep, voffB); PG8_STAGE(PG8_SA(1, 0), cA + kstep, voffA); PG8_STAGE(PG8_SB(1, 1), cB + hstep + kstep, voffB);
        PG8_WAIT_V(6); PG8_BAR;
    } else {
        PG8_STAGE(PG8_SB(0, 0), cB, voffB); PG8_STAGE(PG8_SA(0, 0), cA, voffA); PG8_STAGE(PG8_SB(0, 1), cB + hstep, voffB); PG8_STAGE(PG8_SA(0, 1), cA + hstep, voffA);
        if (wr == 1) PG8_BAR;
        PG8_WAIT_V(4); PG8_BAR;
        PG8_STAGE(PG8_SB(1, 0), cB + kstep, voffB); PG8_STAGE(PG8_SA(1, 0), cA + kstep, voffA); PG8_STAGE(PG8_SB(1, 1), cB + hstep + kstep, voffB);
        PG8_WAIT_V(6); PG8_BAR;
    }
    for (;;) {
        const bool has_next = S.next(ui + 1, nxt);
        const char* nA = has_next ? (const char*)g.A + (size_t)nxt.pm * tstep : cA; const char* nB = has_next ? (const char*)g.Bt + (size_t)nxt.pn * tstep : cB;
        for (int t = 0; t < nt; t += 2) {
            const bool last = (t == nt - 2);
            const char* a1 = cA + (size_t)(t + 1) * kstep;
            const char* a2 = last ? nA : cA + (size_t)(t + 2) * kstep; const char* b2 = last ? nB : cB + (size_t)(t + 2) * kstep;
            const char* a3 = a2 + kstep; const char* b3 = b2 + kstep;
            if (last && has_next) S.a_ready(nxt);
            if constexpr (SP2) {
            PG8_LDB(B0, 0, 0); PG8_LDB(B1, 0, 1); PG8_SCHED; PG8_LDA(At, 0, 0); PG8_STAGE(PG8_SA(1, 1), a1 + hstep, voffA);
            PG8_WAIT_V(8); PG8_WAIT_L(0); PG8_BAR; PG8_MMA(0, 0, At, B0); PG8_MMA(0, 1, At, B1); PG8_BAR; PG8_SCHED;
            PG8_LDA(At, 0, 1); PG8_STAGE(PG8_SB(0, 0), b2, voffB); PG8_STAGE(PG8_SB(0, 1), b2 + hstep, voffB); PG8_STAGE(PG8_SA(0, 0), a2, voffA);
            PG8_WAIT_V(8); PG8_WAIT_L(0); PG8_BAR; PG8_MMA(1, 0, At, B0); PG8_MMA(1, 1, At, B1); PG8_BAR; PG8_SCHED;
            PG8_LDB(B0, 1, 0); PG8_LDB(B1, 1, 1); PG8_SCHED; PG8_LDA(At, 1, 0); PG8_STAGE(PG8_SA(0, 1), a2 + hstep, voffA);
            PG8_WAIT_V(8); PG8_WAIT_L(0); PG8_BAR; PG8_MMA(0, 0, At, B0); PG8_MMA(0, 1, At, B1); PG8_BAR; PG8_SCHED;
            PG8_LDA(At, 1, 1); PG8_STAGE(PG8_SB(1, 0), b3, voffB); PG8_STAGE(PG8_SB(1, 1), b3 + hstep, voffB); PG8_STAGE(PG8_SA(1, 0), a3, voffA);
            PG8_WAIT_V(8); PG8_WAIT_L(0); PG8_BAR; PG8_MMA(1, 0, At, B0); PG8_MMA(1, 1, At, B1); PG8_BAR; PG8_SCHED;
            } else {
            PG8_LDB(B0, 0, 0); PG8_SCHED; PG8_LDA(At, 0, 0); PG8_STAGE(PG8_SA(1, 1), a1 + hstep, voffA);
            PG8_WAIT_L(8); PG8_BAR; PG8_WAIT_L(0); PG8_MMA(0, 0, At, B0); PG8_BAR; PG8_SCHED;
            PG8_LDB(B1, 0, 1); PG8_STAGE(PG8_SB(0, 0), b2, voffB);
            PG8_BAR; PG8_WAIT_L(0); PG8_MMA(0, 1, At, B1); PG8_BAR;
            PG8_LDA(At, 0, 1); PG8_STAGE(PG8_SA(0, 0), a2, voffA);
            PG8_BAR; PG8_WAIT_L(0); PG8_MMA(1, 0, At, B0); PG8_BAR; PG8_SCHED;
            PG8_STAGE(PG8_SB(0, 1), b2 + hstep, voffB);
            PG8_WAIT_V(6); PG8_BAR; PG8_MMA(1, 1, At, B1); PG8_BAR;
            PG8_LDB(B0, 1, 0); PG8_SCHED; PG8_LDA(At, 1, 0); PG8_STAGE(PG8_SA(0, 1), a2 + hstep, voffA);
            PG8_WAIT_L(8); PG8_BAR; PG8_WAIT_L(0); PG8_MMA(0, 0, At, B0); PG8_BAR; PG8_SCHED;
            PG8_LDB(B1, 1, 1); PG8_STAGE(PG8_SB(1, 0), b3, voffB);
            PG8_BAR; PG8_WAIT_L(0); PG8_MMA(0, 1, At, B1); PG8_BAR;
            PG8_LDA(At, 1, 1); PG8_STAGE(PG8_SA(1, 0), a3, voffA);
            PG8_BAR; PG8_WAIT_L(0); PG8_MMA(1, 0, At, B0); PG8_BAR; PG8_SCHED;
            PG8_STAGE(PG8_SB(1, 1), b3 + hstep, voffB);
            PG8_WAIT_V(6); PG8_BAR; PG8_MMA(1, 1, At, B1); PG8_BAR;
            }
        }
        if constexpr (ALIGN_EPI) { if (wr == 0) PG8_BAR; }
        if constexpr (!Epi::AFTER_DRAIN) { E(acc, cur, wr, wc, fr, fq); S.done(cur); }
        if (!has_next) break;
#pragma unroll
        for (int a = 0; a < 2; ++a)
#pragma unroll
            for (int b = 0; b < 2; ++b)
#pragma unroll
                for (int m = 0; m < 4; ++m)
#pragma unroll
                    for (int n = 0; n < 2; ++n) acc[a][b][m][n] = (f32x4){0.f, 0.f, 0.f, 0.f};
        cur = nxt; cA = nA; cB = nB; ++ui;
        if constexpr (ALIGN_EPI) { if (wr == 1) PG8_BAR; }
    }
    PG8_WAIT_V(0);
    if constexpr (!ALIGN_EPI) { if (wr == 0) PG8_BAR; }
    PG8_BAR;
    if constexpr (Epi::AFTER_DRAIN) { E.fused(acc, cur, wr, wc, fr, fq, lds, wid, lane); S.done(cur); }
#undef PG8_SA
#undef PG8_SB
#undef PG8_STAGE
#undef PG8_LDA
#undef PG8_LDB
#undef PG8_MMA
#undef PG8_WAIT_V
#undef PG8_WAIT_L
#undef PG8_BAR
#undef PG8_SCHED
}

template <class Epi, class Sched, bool ALIGN_EPI = true, bool SP2 = true>
__device__ __forceinline__ void gemm_phase_gather(PG8_LAS unsigned char* lds, const Gemm g, const Sched& S, const Epi& E, const PG8_LAS int* lidx) {
    static_assert(SP2 && ALIGN_EPI, "gather variant: SP2 + ALIGN_EPI only");
    const int tid = threadIdx.x, wid = __builtin_amdgcn_readfirstlane(tid >> 6), lane = tid & 63, wr = wid >> 2, wc = wid & 3, fr = lane & 15, fq = lane >> 4;
    const int K = g.K, nt = K / BK;
    unsigned voffB[2]; int RA[2]; unsigned CA[2];
#pragma unroll
    for (int i = 0; i < 2; ++i) { int R, C; stage_rc(tid * 16 + i * 8192, R, C); const int Rb = Epi::PERM ? ((R & ~31) + perm32(R & 31)) : R;
        RA[i] = R; CA[i] = (unsigned)C * 2u; voffB[i] = (unsigned)(Rb * K + C) * 2u; }
    unsigned ca[2][2], na[2][2];
#define PG8_ROWOFF(dst, ui_) do { _Pragma("unroll") for (int h_ = 0; h_ < 2; ++h_) _Pragma("unroll") for (int i_ = 0; i_ < 2; ++i_) dst[h_][i_] = (unsigned)lidx[(ui_) * 256 + h_ * 128 + RA[i_]] * (unsigned)(K * 2) + CA[i_]; } while (0)
#define PG8_STAGEA(bufoff, kb, vo) do { _Pragma("unroll") for (int _i = 0; _i < 2; ++_i) \
        __builtin_amdgcn_global_load_lds((const unsigned*)((const char*)g.A + (size_t)(kb) + (vo)[_i]), (PG8_LAS unsigned*)(lds + (bufoff) + ldsw + _i * 8192), 16, 0, 0); } while (0)
    const size_t kstep = (size_t)(BK * 2);
    const size_t hstep = (size_t)HALF * K * 2;
    const size_t tstep = 2 * hstep;
    const unsigned ldsw = (unsigned)wid * 1024u;
    const int aoff = lds_byte(wr * 64 + fr, fq * 8), boff = lds_byte(wc * 32 + fr, fq * 8);
#define PG8_SA(b, h) (((b) * 2 + (h)) * HTB)
#define PG8_SB(b, h) ((4 + (b) * 2 + (h)) * HTB)
#define PG8_STAGE(bufoff, gbase, voff) do { _Pragma("unroll") for (int _i = 0; _i < 2; ++_i) \
        __builtin_amdgcn_global_load_lds((const unsigned*)((const char*)(gbase) + (voff)[_i]), (PG8_LAS unsigned*)(lds + (bufoff) + ldsw + _i * 8192), 16, 0, 0); } while (0)
#define PG8_LDA(dst, b, h) do { _Pragma("unroll") for (int m = 0; m < 4; ++m) _Pragma("unroll") for (int k = 0; k < 2; ++k) dst[m][k] = *(const PG8_LAS bf16x8*)(lds + PG8_SA(b, h) + aoff + m * 2048 + k * 1024); } while (0)
#define PG8_LDB(dst, b, h) do { _Pragma("unroll") for (int n = 0; n < 2; ++n) _Pragma("unroll") for (int k = 0; k < 2; ++k) dst[n][k] = *(const PG8_LAS bf16x8*)(lds + PG8_SB(b, h) + boff + n * 2048 + k * 1024); } while (0)
#define PG8_MMA(ai, bj, At, Bt) do { __builtin_amdgcn_s_setprio(1); _Pragma("unroll") for (int m = 0; m < 4; ++m) _Pragma("unroll") for (int n = 0; n < 2; ++n) _Pragma("unroll") for (int k = 0; k < 2; ++k) \
        acc[ai][bj][m][n] = __builtin_amdgcn_mfma_f32_16x16x32_bf16(Bt[n][k], At[m][k], acc[ai][bj][m][n], 0, 0, 0); __builtin_amdgcn_s_setprio(0); } while (0)
#define PG8_WAIT_V(n) asm volatile("s_waitcnt vmcnt(" #n ")" ::: "memory")
#define PG8_WAIT_L(n) asm volatile("s_waitcnt lgkmcnt(" #n ")" ::: "memory")
#define PG8_BAR __builtin_amdgcn_s_barrier()
#define PG8_SCHED __builtin_amdgcn_sched_barrier(0)
    Unit cur, nxt; int ui = 0;
    if (!S.next(0, cur)) return;
    f32x4 acc[2][2][4][2];
#pragma unroll
    for (int a = 0; a < 2; ++a)
#pragma unroll
        for (int b = 0; b < 2; ++b)
#pragma unroll
            for (int m = 0; m < 4; ++m)
#pragma unroll
                for (int n = 0; n < 2; ++n) acc[a][b][m][n] = (f32x4){0.f, 0.f, 0.f, 0.f};
    bf16x8 At[4][2], B0[2][2], B1[2][2];
    const char* cB = (const char*)g.Bt + (size_t)cur.pn * tstep; PG8_ROWOFF(ca, 0);
    S.a_ready(cur);
    if constexpr (SP2) {
        PG8_STAGE(PG8_SB(0, 0), cB, voffB); PG8_STAGE(PG8_SB(0, 1), cB + hstep, voffB); PG8_STAGEA(PG8_SA(0, 0), 0, ca[0]); PG8_STAGEA(PG8_SA(0, 1), 0, ca[1]);
        if (wr == 1) PG8_BAR;
        PG8_WAIT_V(2); PG8_BAR;
        PG8_STAGE(PG8_SB(1, 0), cB + kstep, voffB); PG8_STAGEA(PG8_SA(1, 0), kstep, ca[0]); PG8_STAGE(PG8_SB(1, 1), cB + hstep + kstep, voffB);
        PG8_WAIT_V(6); PG8_BAR;
    }
    for (;;) {
        const bool has_next = S.next(ui + 1, nxt);
        const char* nB = has_next ? (const char*)g.Bt + (size_t)nxt.pn * tstep : cB;
        if (has_next) PG8_ROWOFF(na, ui + 1); else { _Pragma("unroll") for (int h_ = 0; h_ < 2; ++h_) _Pragma("unroll") for (int i_ = 0; i_ < 2; ++i_) na[h_][i_] = ca[h_][i_]; }
        for (int t = 0; t < nt; t += 2) {
            const bool last = (t == nt - 2);
            const size_t k1 = (size_t)(t + 1) * kstep, k2 = last ? (size_t)0 : (size_t)(t + 2) * kstep, k3 = k2 + kstep;
            unsigned o2[2][2];
#pragma unroll
            for (int h_ = 0; h_ < 2; ++h_)
#pragma unroll
                for (int i_ = 0; i_ < 2; ++i_) o2[h_][i_] = last ? na[h_][i_] : ca[h_][i_];
            const char* b2 = last ? nB : cB + (size_t)(t + 2) * kstep; const char* b3 = b2 + kstep;
            if (last && has_next) S.a_ready(nxt);
            if constexpr (SP2) {
            PG8_LDB(B0, 0, 0); PG8_LDB(B1, 0, 1); PG8_SCHED; PG8_LDA(At, 0, 0); PG8_STAGEA(PG8_SA(1, 1), k1, ca[1]);
            PG8_WAIT_V(8); PG8_WAIT_L(0); PG8_BAR; PG8_MMA(0, 0, At, B0); PG8_MMA(0, 1, At, B1); PG8_BAR; PG8_SCHED;
            PG8_LDA(At, 0, 1); PG8_STAGE(PG8_SB(0, 0), b2, voffB); PG8_STAGE(PG8_SB(0, 1), b2 + hstep, voffB); PG8_STAGEA(PG8_SA(0, 0), k2, o2[0]);
            PG8_WAIT_V(8); PG8_WAIT_L(0); PG8_BAR; PG8_MMA(1, 0, At, B0); PG8_MMA(1, 1, At, B1); PG8_BAR; PG8_SCHED;
            PG8_LDB(B0, 1, 0); PG8_LDB(B1, 1, 1); PG8_SCHED; PG8_LDA(At, 1, 0); PG8_STAGEA(PG8_SA(0, 1), k2, o2[1]);
            PG8_WAIT_V(8); PG8_WAIT_L(0); PG8_BAR; PG8_MMA(0, 0, At, B0); PG8_MMA(0, 1, At, B1); PG8_BAR; PG8_SCHED;
            PG8_LDA(At, 1, 1); PG8_STAGE(PG8_SB(1, 0), b3, voffB); PG8_STAGE(PG8_SB(1, 1), b3 + hstep, voffB); PG8_STAGEA(PG8_SA(1, 0), k3, o2[0]);
            PG8_WAIT_V(8); PG8_WAIT_L(0); PG8_BAR; PG8_MMA(1, 0, At, B0); PG8_MMA(1, 1, At, B1); PG8_BAR; PG8_SCHED;
            }
        }
        if constexpr (ALIGN_EPI) { if (wr == 0) PG8_BAR; }
        if constexpr (!Epi::AFTER_DRAIN) { E(acc, cur, wr, wc, fr, fq); S.done(cur); }
        if (!has_next) break;
#pragma unroll
        for (int a = 0; a < 2; ++a)
#pragma unroll
            for (int b = 0; b < 2; ++b)
#pragma unroll
                for (int m = 0; m < 4; ++m)
#pragma unroll
                    for (int n = 0; n < 2; ++n) acc[a][b][m][n] = (f32x4){0.f, 0.f, 0.f, 0.f};
        cur = nxt; cB = nB; ++ui;
        { _Pragma("unroll") for (int h_ = 0; h_ < 2; ++h_) _Pragma("unroll") for (int i_ = 0; i_ < 2; ++i_) ca[h_][i_] = na[h_][i_]; }
        if constexpr (ALIGN_EPI) { if (wr == 1) PG8_BAR; }
    }
    PG8_WAIT_V(0);
    if constexpr (!ALIGN_EPI) { if (wr == 0) PG8_BAR; }
    PG8_BAR;
    if constexpr (Epi::AFTER_DRAIN) { E.fused(acc, cur, wr, wc, fr, fq, lds, wid, lane); S.done(cur); }
#undef PG8_SA
#undef PG8_ROWOFF
#undef PG8_STAGEA
#undef PG8_SB
#undef PG8_STAGE
#undef PG8_LDA
#undef PG8_LDB
#undef PG8_MMA
#undef PG8_WAIT_V
#undef PG8_WAIT_L
#undef PG8_BAR
#undef PG8_SCHED
}
}

constexpr int NB = 2, SEQ = 16384, T = NB * SEQ, D = 1024;
constexpr float EPS = 1e-6f;
constexpr int NWAVES = 8, NTHR = 512;
constexpr int N_IN = 55;
__host__ __device__ constexpr int LBASE(int L) { return L == 0 ? 2 : (L == 1 ? 15 : (L == 2 ? 29 : 42)); }
__host__ __device__ constexpr int NMIX(int L) { return L == 1 ? 6 : 5; }

constexpr size_t MiB = 1u << 20;
constexpr size_t WS_CTL = 0, CTL_ZERO_BYTES = 1 * MiB;
constexpr size_t WS_MOD = 1 * MiB;
constexpr size_t WS_CNT = WS_MOD + 256 * 1024;
constexpr size_t WS_TILEE = WS_CNT + 64 * 1024;
constexpr size_t WS_EID = 2 * MiB;
constexpr size_t WS_GATE = WS_EID + 256 * 1024;
constexpr size_t WS_SLOT = WS_GATE + 256 * 1024;
constexpr size_t WS_VSSP = 3 * MiB;
constexpr size_t WS_BA = 5 * MiB;
constexpr size_t WS_DNB = 7 * MiB;
constexpr size_t WS_RTR = 9 * MiB;
constexpr size_t WS_TOK = 12 * MiB;
constexpr size_t WS_W = 16 * MiB;
constexpr size_t WS_WMIX = WS_W + 384 * MiB;
constexpr size_t WMIX_GM_IN0 = 0, WMIX_GM_OUT0 = 4 * MiB, WMIX_DN_IN = 6 * MiB, WMIX_DN_OUT = 13 * MiB, WMIX_SWA_IN = 15 * MiB, WMIX_SWA_OUT = 18 * MiB, WMIX_GM_IN3 = 20 * MiB, WMIX_GM_OUT3 = 24 * MiB;
constexpr size_t WS_ACT = 432 * MiB;
constexpr size_t A_H = 0;
constexpr size_t A_U = 64 * MiB, A_V = 128 * MiB, A_GATED = 192 * MiB;
constexpr size_t A_QKV = 64 * MiB, A_Z = 192 * MiB, A_QN = 256 * MiB, A_KN = 288 * MiB, A_VV = 320 * MiB, A_FA = 384 * MiB, A_FB = 484 * MiB, A_FU = 64 * MiB, A_O = 128 * MiB;
constexpr size_t A_XG = 64 * MiB, A_ACTV = 208 * MiB, A_Y = 280 * MiB;
constexpr size_t WS_END = WS_ACT + 548 * MiB;
constexpr int MAXROWS = 73728;

constexpr int RING_BYTES = 131072;
constexpr int LDSCTL_OFF = RING_BYTES, MISC_OFF = LDSCTL_OFF + 320;
constexpr int LDS_BYTES = 147456;

#define LAS __attribute__((address_space(3)))
typedef unsigned short bf16;
typedef unsigned v4u __attribute__((ext_vector_type(4)));
typedef unsigned v2u __attribute__((ext_vector_type(2)));
typedef float f32x4 __attribute__((ext_vector_type(4)));
typedef short bf16x8 __attribute__((ext_vector_type(8)));
typedef short bf16x4 __attribute__((ext_vector_type(4)));
#define LDS_WAIT() asm volatile("s_waitcnt lgkmcnt(0)" ::: "memory")
#define VM_WAIT() asm volatile("s_waitcnt vmcnt(0)" ::: "memory")
__device__ __forceinline__ unsigned pk2(float lo, float hi) { return pg8::cvt_pk_bf16(lo, hi); }
__device__ __forceinline__ float bflo(unsigned w) { return __uint_as_float(w << 16); }
__device__ __forceinline__ float bfhi(unsigned w) { return __uint_as_float(w & 0xffff0000u); }
__device__ __forceinline__ float bf1(unsigned short b) { return __uint_as_float(((unsigned)b) << 16); }
__device__ __forceinline__ float wave_sum(float v) {
#pragma unroll
    for (int o = 1; o < 64; o <<= 1) v += __shfl_xor(v, o);
    return v;
}
__device__ __forceinline__ float fast_exp(float x) { return __builtin_amdgcn_exp2f(x * 1.44269504089f); }
__device__ __forceinline__ float sigmoidf_(float x) { return __builtin_amdgcn_rcpf(1.0f + fast_exp(-x)); }
__device__ __forceinline__ float siluf_(float x) { return x * sigmoidf_(x); }
__device__ __forceinline__ float gelu_tanh(float x) { const float y = 1.5957691216057308f * (x + 0.044715f * x * x * x); return x * __builtin_amdgcn_rcpf(1.0f + fast_exp(-y)); }

#define RLX_AGENT __ATOMIC_RELAXED, __HIP_MEMORY_SCOPE_AGENT
__device__ __forceinline__ unsigned char* uni_ptr(unsigned char* p) { const unsigned long long w = (unsigned long long)p; const unsigned lo = __builtin_amdgcn_readfirstlane((unsigned)w), hi = __builtin_amdgcn_readfirstlane((unsigned)(w >> 32)); return (unsigned char*)(__attribute__((address_space(1))) unsigned char*)(((unsigned long long)hi << 32) | lo); }
#define XB_TMO      128
#define XB_XCNT(j)  (256  + 64 * (j))
#define XB_XSUB(j)  (1280 + 64 * (j))
#define XB_XGEN(j)  (2304 + 64 * (j))
#define XB_TOP      3328
#define XB_TOPGEN   3392
#define XCD_BAR_WORDS 3456
#define XB_SPIN_CAP (1u << 18)

__device__ __forceinline__ unsigned xb_ld(unsigned* p)              { return __hip_atomic_load(p, __ATOMIC_RELAXED, __HIP_MEMORY_SCOPE_AGENT); }
__device__ __forceinline__ unsigned xb_add(unsigned* p, unsigned v) { return __hip_atomic_fetch_add(p, v, __ATOMIC_RELAXED, __HIP_MEMORY_SCOPE_AGENT); }
__device__ __forceinline__ unsigned xb_xcc_id() { return (unsigned)__builtin_amdgcn_s_getreg((3 << 11) | 20) & 0xFu; }
#define XB_SPIN(cond, bar) do { unsigned _sp = 0; while (cond) { __builtin_amdgcn_s_sleep(1); \
    if ((++_sp & 255u) == 0u) { if (xb_ld(&(bar)[XB_TMO])) break; if (_sp > XB_SPIN_CAP) { atomicAdd(&(bar)[XB_TMO], 1u); break; } } } } while (0)

struct XcdBarrier {
    unsigned* bar; unsigned x;
    volatile LAS unsigned* st;
};

__device__ __forceinline__ XcdBarrier xcd_barrier_post(unsigned* bar, volatile LAS unsigned* st) {
    XcdBarrier b; b.bar = bar; b.x = xb_xcc_id(); b.st = st;
    if (threadIdx.x == 0) (void)xb_add(&bar[XB_XCNT(b.x)], 1u);
    return b;
}
__device__ __forceinline__ void xcd_barrier_complete(unsigned* bar, unsigned x, unsigned& nloc, unsigned& nx) {
    const unsigned G = gridDim.x * gridDim.y * gridDim.z;
    unsigned sum, cnt, mine, sp = 0u;
    for (;;) {
        sum = 0u; cnt = 0u; mine = 0u;
#pragma unroll
        for (unsigned j = 0; j < 16; ++j) { const unsigned c = xb_ld(&bar[XB_XCNT(j)]); sum += c; cnt += (c > 0u) ? 1u : 0u; mine = (j == x) ? c : mine; }
        if (sum == G) break;
        __builtin_amdgcn_s_sleep(1);
        if ((++sp & 255u) == 0u) { if (xb_ld(&bar[XB_TMO])) break; if (sp > XB_SPIN_CAP) { atomicAdd(&bar[XB_TMO], 1u); break; } }
    }
    nloc = mine > 0u ? mine : 1u; nx = cnt > 0u ? cnt : 1u;
}

__device__ __forceinline__ void xcd_barrier(const XcdBarrier& b) {
    asm volatile("s_waitcnt vmcnt(0)" ::: "memory");
    __syncthreads();
    if (threadIdx.x == 0) {
        unsigned* bar = b.bar;
        __builtin_amdgcn_s_waitcnt(0);
        unsigned nloc = b.st[0], nx = b.st[1];
        if (nloc == 0u) { xcd_barrier_complete(bar, b.x, nloc, nx); b.st[0] = nloc; b.st[1] = nx; }
        const unsigned old = xb_add(&bar[XB_XSUB(b.x)], 1u);
        const unsigned gen = old / nloc;
        if (old + 1u == (gen + 1u) * nloc) {
            __builtin_amdgcn_fence(__ATOMIC_RELEASE, "agent");
            asm volatile("s_waitcnt vmcnt(0)" ::: "memory");
            const unsigned og = xb_add(&bar[XB_TOP], 1u);
            const unsigned tg = og / nx;
            if (og + 1u == (tg + 1u) * nx) xb_add(&bar[XB_TOPGEN], 1u);
            else XB_SPIN(xb_ld(&bar[XB_TOPGEN]) == tg, bar);
            __builtin_amdgcn_fence(__ATOMIC_ACQUIRE, "agent");
            xb_add(&bar[XB_XGEN(b.x)], 1u);
            asm volatile("s_waitcnt vmcnt(0)" ::: "memory");
        } else {
            XB_SPIN(xb_ld(&bar[XB_XGEN(b.x)]) == gen, bar);
            __builtin_amdgcn_fence(__ATOMIC_ACQUIRE, "agent");
            asm volatile("s_waitcnt vmcnt(0)" ::: "memory");
        }
    }
    __syncthreads();
}

typedef const pg8::f32x4 (&AccRef)[2][2][4][2];

struct EpiGm1 {
    static constexpr bool PERM = true, AFTER_DRAIN = false;
    bf16* U; bf16* V; float* vssp;
    __device__ __forceinline__ void operator()(AccRef acc, const pg8::Unit& u, int wr, int wc, int fr, int fq) const {
        const int row0 = u.pm * 256 + wr * 64 + fr; const bool isV = u.pn >= 4; const int col0 = (u.pn & 3) * 256 + wc * 32 + 8 * fq;
        bf16* base = isV ? V : U;
#pragma unroll
        for (int ai = 0; ai < 2; ++ai)
#pragma unroll
            for (int m = 0; m < 4; ++m) { const int row = row0 + ai * 128 + m * 16; bf16* rowp = base + (size_t)row * 1024 + col0; float ss = 0.f;
#pragma unroll
                for (int bj = 0; bj < 2; ++bj) { f32x4 v0 = acc[ai][bj][m][0], v1 = acc[ai][bj][m][1];
#pragma unroll
                    for (int j = 0; j < 4; ++j) { v0[j] = gelu_tanh(v0[j]); v1[j] = gelu_tanh(v1[j]); ss += v0[j] * v0[j] + v1[j] * v1[j]; }
                    v4u w; w.x = pk2(v0[0], v0[1]); w.y = pk2(v0[2], v0[3]); w.z = pk2(v1[0], v1[1]); w.w = pk2(v1[2], v1[3]);
                    *(v4u*)(rowp + bj * 128) = w; }
                if (isV) { ss += __shfl_xor(ss, 16); ss += __shfl_xor(ss, 32); if (fq == 0) vssp[(size_t)row * 16 + (u.pn - 4) * 4 + wc] = ss; } }
    }
};
struct EpiRes {
    static constexpr bool PERM = false, AFTER_DRAIN = false;
    const float* src; float* dst; const float* gate;
    __device__ __forceinline__ void operator()(AccRef acc, const pg8::Unit& u, int wr, int wc, int fr, int fq) const {
        const int row0 = u.pm * 256 + wr * 64 + fr, col0 = u.pn * 256 + wc * 32 + 4 * fq; const int b = (u.pm * 256) / SEQ;
        f32x4 gv[2][2];
#pragma unroll
        for (int bj = 0; bj < 2; ++bj)
#pragma unroll
            for (int n = 0; n < 2; ++n) gv[bj][n] = *(const f32x4*)(gate + (size_t)b * 6144 + col0 + bj * 128 + n * 16);
#pragma unroll
        for (int ai = 0; ai < 2; ++ai)
#pragma unroll
            for (int m = 0; m < 4; ++m) { const size_t off = (size_t)(row0 + ai * 128 + m * 16) * 1024 + col0;
#pragma unroll
                for (int bj = 0; bj < 2; ++bj)
#pragma unroll
                    for (int n = 0; n < 2; ++n) { const f32x4 xs = *(const f32x4*)(src + off + bj * 128 + n * 16); *(f32x4*)(dst + off + bj * 128 + n * 16) = xs + gv[bj][n] * acc[ai][bj][m][n]; } }
    }
};
struct EpiBf {
    static constexpr bool PERM = true, AFTER_DRAIN = false;
    bf16* O; int ldc; int nmask;
    __device__ __forceinline__ void operator()(AccRef acc, const pg8::Unit& u, int wr, int wc, int fr, int fq) const {
        const int row0 = u.pm * 256 + wr * 64 + fr, col0 = (u.pn & nmask) * 256 + wc * 32 + 8 * fq;
#pragma unroll
        for (int ai = 0; ai < 2; ++ai)
#pragma unroll
            for (int m = 0; m < 4; ++m) { bf16* rowp = O + (size_t)(row0 + ai * 128 + m * 16) * ldc + col0;
#pragma unroll
                for (int bj = 0; bj < 2; ++bj) { const f32x4 v0 = acc[ai][bj][m][0], v1 = acc[ai][bj][m][1];
                    v4u w; w.x = pk2(v0[0], v0[1]); w.y = pk2(v0[2], v0[3]); w.z = pk2(v1[0], v1[1]); w.w = pk2(v1[2], v1[3]);
                    *(v4u*)(rowp + bj * 128) = w; } }
    }
};
struct EpiDn1 {
    static constexpr bool PERM = true, AFTER_DRAIN = false;
    bf16* QKV; bf16* Z; float* BA;
    __device__ __forceinline__ void operator()(AccRef acc, const pg8::Unit& u, int wr, int wc, int fr, int fq) const {
        const int row0 = u.pm * 256 + wr * 64 + fr;
        if (u.pn < 12) {
            bf16* base = u.pn < 8 ? QKV : Z; const int ldc = u.pn < 8 ? 2048 : 1024; const int col0 = (u.pn < 8 ? u.pn : u.pn - 8) * 256 + wc * 32 + 8 * fq;
#pragma unroll
            for (int ai = 0; ai < 2; ++ai)
#pragma unroll
                for (int m = 0; m < 4; ++m) { bf16* rowp = base + (size_t)(row0 + ai * 128 + m * 16) * ldc + col0;
#pragma unroll
                    for (int bj = 0; bj < 2; ++bj) { const f32x4 v0 = acc[ai][bj][m][0], v1 = acc[ai][bj][m][1];
                        v4u w; w.x = pk2(v0[0], v0[1]); w.y = pk2(v0[2], v0[3]); w.z = pk2(v1[0], v1[1]); w.w = pk2(v1[2], v1[3]);
                        *(v4u*)(rowp + bj * 128) = w; } }
        } else if (wc == 0 && fq < 2) {
#pragma unroll
            for (int ai = 0; ai < 2; ++ai)
#pragma unroll
                for (int m = 0; m < 4; ++m) { float* rowp = BA + (size_t)(row0 + ai * 128 + m * 16) * 16 + 8 * fq;
                    *(f32x4*)(rowp) = acc[ai][0][m][0]; *(f32x4*)(rowp + 4) = acc[ai][0][m][1]; }
        }
    }
};
struct EpiMoe1 {
    static constexpr bool PERM = true, AFTER_DRAIN = false;
    bf16* O;
    __device__ __forceinline__ void operator()(AccRef acc, const pg8::Unit& u, int wr, int wc, int fr, int fq) const {
        const int row0 = u.pm * 256 + wr * 64 + fr, col0 = (u.pn & 3) * 128 + wc * 32 + 8 * fq;
#pragma unroll
        for (int ai = 0; ai < 2; ++ai)
#pragma unroll
            for (int m = 0; m < 4; ++m) { bf16* rowp = O + (size_t)(row0 + ai * 128 + m * 16) * 512 + col0; float r[8];
#pragma unroll
                for (int n = 0; n < 2; ++n)
#pragma unroll
                    for (int j = 0; j < 4; ++j) { const float a = acc[ai][0][m][n][j], g = acc[ai][1][m][n][j]; r[4 * n + j] = siluf_(a) * g; }
                v4u w; w.x = pk2(r[0], r[1]); w.y = pk2(r[2], r[3]); w.z = pk2(r[4], r[5]); w.w = pk2(r[6], r[7]);
                *(v4u*)rowp = w; }
    }
};
struct MoeOrder {
    const int* tile_e; int total, G, c;
    __device__ __forceinline__ void init(const int* te, int ntiles, int G_, int c_) { tile_e = te; total = ntiles * 4; G = G_; c = c_; }
    __device__ __forceinline__ bool next(int i, pg8::Unit& u) const {
        const long Lx = (long)i * G + c; if (Lx >= total) return false;
        const int w0 = (int)Lx, q = total / 8, r = total % 8, xcd = w0 % 8, off = w0 / 8;
        const int wgid = (xcd < r ? xcd * (q + 1) : r * (q + 1) + (xcd - r) * q) + off;
        const int rt = wgid >> 2; u.pm = rt; u.pn = tile_e[rt] * 4 + (wgid & 3); return true;
    }
    __device__ __forceinline__ void a_ready(const pg8::Unit&) const {}
    __device__ __forceinline__ void done(const pg8::Unit&) const {}
};

struct Args { const float* in[N_IN]; float* out; unsigned char* ws; int ph_lo, ph_hi, li, pad; };

__device__ __forceinline__ void tr_item(const float* __restrict__ W, int ldn, int k0, int n0, bf16* __restrict__ WT, int Kd, int drow0, LAS float* scr, int lane) {
#pragma unroll 8
    for (int i = 0; i < 32; ++i) { const int kk = 2 * i + (lane >> 5); scr[kk * 33 + (lane & 31)] = W[(size_t)(k0 + kk) * ldn + n0 + (lane & 31)]; }
    LDS_WAIT(); asm volatile("" ::: "memory");
    const int c = lane & 7;
#pragma unroll
    for (int j = 0; j < 4; ++j) { const int n = (lane >> 3) + 8 * j; const LAS float* s = scr + (8 * c) * 33 + n;
        v4u o; o.x = pk2(s[0 * 33], s[1 * 33]); o.y = pk2(s[2 * 33], s[3 * 33]); o.z = pk2(s[4 * 33], s[5 * 33]); o.w = pk2(s[6 * 33], s[7 * 33]);
        *(v4u*)(WT + (size_t)(drow0 + n) * Kd + k0 + 8 * c) = o; }
    LDS_WAIT(); asm volatile("" ::: "memory");
}

constexpr int CV_PER_L = 24576, CV_N_EXP = 4 * CV_PER_L, CV_MIX_L01 = 3584, CV_N_MIXI = 1536 + 2048 + 1280 + 1536;
struct CvItem { const float* src; bf16* dst; int ldn, Kd; };
__device__ __forceinline__ CvItem cv_decode(const Args& args, unsigned char* ws, int it) {
    CvItem c; const float* src; bf16* dst; int ldn, k0, n0, Kd, drow0;
    constexpr int PER_L = CV_PER_L, N_EXP = CV_N_EXP;
    if (it < N_EXP) {
        const int L = it / PER_L; int r = it % PER_L; const int ib = LBASE(L) + 4 + NMIX(L);
        if (r < 16384) { const int e = r >> 9, rr = r & 511; k0 = (rr >> 5) * 64; n0 = (rr & 31) * 32; ldn = 1024; Kd = 1024;
            src = args.in[ib + 2] + (size_t)e * 1048576; dst = (bf16*)(ws + WS_W + (size_t)L * 96 * MiB) + (size_t)e * 1048576;
            drow0 = (n0 < 512) ? ((n0 >> 7) * 256 + (n0 & 127)) : ((((n0 - 512) >> 7) * 256) + 128 + ((n0 - 512) & 127)); }
        else { r -= 16384; const int e = r >> 8, rr = r & 255; k0 = (rr >> 5) * 64; n0 = (rr & 31) * 32; ldn = 1024; Kd = 512;
            src = args.in[ib + 3] + (size_t)e * 524288; dst = (bf16*)(ws + WS_W + (size_t)L * 96 * MiB + 64 * MiB) + (size_t)e * 524288; drow0 = n0; }
    } else {
        int r = it - N_EXP; int idx, nblk; size_t woff;
        if (r < 1024) { idx = 6; ldn = 2048; nblk = 64; woff = WMIX_GM_IN0; }
        else if ((r -= 1024) < 512) { idx = 10; ldn = 1024; nblk = 32; woff = WMIX_GM_OUT0; }
        else if ((r -= 512) < 1536) { idx = 19; ldn = 3088; nblk = 96; woff = WMIX_DN_IN; }
        else if ((r -= 1536) < 512) { idx = 24; ldn = 1024; nblk = 32; woff = WMIX_DN_OUT; }
        else if ((r -= 512) < 768) { idx = 33; ldn = 1536; nblk = 48; woff = WMIX_SWA_IN; }
        else if ((r -= 768) < 512) { idx = 37; ldn = 1024; nblk = 32; woff = WMIX_SWA_OUT; }
        else if ((r -= 512) < 1024) { idx = 46; ldn = 2048; nblk = 64; woff = WMIX_GM_IN3; }
        else { r -= 1024; idx = 50; ldn = 1024; nblk = 32; woff = WMIX_GM_OUT3; }
        src = args.in[idx]; dst = (bf16*)(ws + WS_WMIX + woff); k0 = (r / nblk) * 64; n0 = (r % nblk) * 32; Kd = 1024; drow0 = n0;
    }
    c.src = src + (size_t)k0 * ldn + n0; c.dst = dst + (size_t)drow0 * Kd + k0; c.ldn = ldn; c.Kd = Kd; return c;
}
__device__ __forceinline__ void cv_load(const CvItem& c, f32x4 (&v)[8], int lane) {
    const float* p = c.src + (size_t)(2 * (lane >> 3)) * c.ldn + 4 * (lane & 7);
#pragma unroll
    for (int i = 0; i < 4; ++i) { v[2 * i] = *(const f32x4*)(p + (size_t)(16 * i) * c.ldn); v[2 * i + 1] = *(const f32x4*)(p + (size_t)(16 * i + 1) * c.ldn); }
}
__device__ __forceinline__ void cv_store(const CvItem& c, const f32x4 (&v)[8], LAS float* scr, int lane) {
    LAS unsigned* su = (LAS unsigned*)scr; const int kp = lane >> 3, n4 = 4 * (lane & 7);
#pragma unroll
    for (int i = 0; i < 4; ++i) { LAS unsigned* q = su + (kp + 8 * i) * 33 + n4;
#pragma unroll
        for (int e = 0; e < 4; ++e) q[e] = pk2(v[2 * i][e], v[2 * i + 1][e]); }
    LDS_WAIT(); asm volatile("" ::: "memory");
    const int ck = lane & 7;
#pragma unroll
    for (int j = 0; j < 4; ++j) { const int n = (lane >> 3) + 8 * j; const LAS unsigned* s = su + (4 * ck) * 33 + n;
        v4u o; o.x = s[0]; o.y = s[33]; o.z = s[66]; o.w = s[99];
        *(v4u*)(c.dst + (size_t)n * c.Kd + 8 * ck) = o; }
    LDS_WAIT(); asm volatile("" ::: "memory");
}
__device__ __forceinline__ void convert_weights(const Args& args, LAS unsigned char* lds, int it_lo, int it_hi, int gw, int NGW) {
    int tid_ = threadIdx.x; asm volatile("" : "+v"(tid_)); const int lane = tid_ & 63, wave = __builtin_amdgcn_readfirstlane(tid_ >> 6);
    unsigned char* ws = uni_ptr(args.ws);
    LAS float* scr = (LAS float*)(lds + wave * 8448);
    for (int it = it_lo + gw; it < it_hi; it += 2 * NGW) {
        const int it2 = it + NGW; const bool two = it2 < it_hi;
        const CvItem c0 = cv_decode(args, ws, it), c1 = cv_decode(args, ws, two ? it2 : it);
        f32x4 v0[8], v1[8];
        cv_load(c0, v0, lane); if (two) cv_load(c1, v1, lane);
        cv_store(c0, v0, scr, lane); if (two) cv_store(c1, v1, scr, lane);
    }
}
__device__ __forceinline__ void phase_prologue(const Args& args, LAS unsigned char* lds) {
    int tid_ = threadIdx.x; asm volatile("" : "+v"(tid_)); const int tid = tid_, lane = tid & 63, wave = __builtin_amdgcn_readfirstlane(tid >> 6), G = gridDim.x, bid = blockIdx.x; (void)tid; (void)lane; (void)wave;
    unsigned char* ws = uni_ptr(args.ws);
    LAS float* cact = (LAS float*)(lds + 69632);
    LAS float* red = (LAS float*)(lds + 77824);
    for (int k = tid; k < 2048; k += NTHR) cact[k] = siluf_(args.in[1][k]);
    __syncthreads();
    float* MOD = (float*)(ws + WS_MOD);
    for (int item = bid; item < 384; item += G) {
        const int L = item / 96, cg = item % 96, c4 = tid & 15, ks = tid >> 4;
        const float* w = args.in[LBASE(L) + 2] + (size_t)(ks * 32) * 6144 + cg * 64 + c4 * 4;
        f32x4 a0 = {0.f, 0.f, 0.f, 0.f}, a1 = {0.f, 0.f, 0.f, 0.f};
#pragma unroll 8
        for (int kk = 0; kk < 32; ++kk) { const f32x4 wv = *(const f32x4*)(w + (size_t)kk * 6144); a0 += cact[ks * 32 + kk] * wv; a1 += cact[1024 + ks * 32 + kk] * wv; }
        *(LAS f32x4*)(red + (ks * 2 + 0) * 64 + c4 * 4) = a0; *(LAS f32x4*)(red + (ks * 2 + 1) * 64 + c4 * 4) = a1;
        __syncthreads();
        if (tid < 128) { const int b = tid >> 6, col = tid & 63; float s = 0.f;
#pragma unroll
            for (int k2 = 0; k2 < 32; ++k2) s += red[(k2 * 2 + b) * 64 + col];
            MOD[(size_t)(L * 2 + b) * 6144 + cg * 64 + col] = s + args.in[LBASE(L) + 3][cg * 64 + col]; }
        __syncthreads();
    }
    { const int gw = bid * NWAVES + wave, NGW = G * NWAVES;
      if (G > 128) { convert_weights(args, lds, 0, CV_PER_L, gw, NGW); convert_weights(args, lds, CV_N_EXP, CV_N_EXP + CV_MIX_L01, gw, NGW); }
      else convert_weights(args, lds, 0, CV_N_EXP + CV_N_MIXI, gw, NGW); }
    const int gt = bid * NTHR + tid, NGT = G * NTHR;
    { bf16* dst = (bf16*)(ws + WS_WMIX + WMIX_DN_IN) + (size_t)3072 * 1024; const float* w = args.in[19];
      for (int i = gt; i < 256 * 1024; i += NGT) { const int n = i >> 10, k = i & 1023; const float v = n < 16 ? w[(size_t)k * 3088 + 3072 + n] : 0.f; dst[i] = (bf16)(pk2(v, 0.f) & 0xffffu); } }
    for (int i = gt; i < 4 * 48 * 1024; i += NGT) {
        const int L = i / 49152, rem = i % 49152, n = rem >> 10, k = rem & 1023;
        const float w = n < 36 ? args.in[LBASE(L) + 4 + NMIX(L)][(size_t)k * 36 + n] : 0.f;
        const unsigned hi = pk2(w, 0.f) & 0xffffu; const float lo = w - bf1((unsigned short)hi);
        bf16* RH = (bf16*)(ws + WS_RTR + (size_t)L * 196608); RH[rem] = (bf16)hi; RH[49152 + rem] = (bf16)(pk2(lo, 0.f) & 0xffffu);
    }
}

__device__ __forceinline__ void norm_store_row(const f32x4 (&v)[4], const float* __restrict__ gain, const float* __restrict__ shift, const float* __restrict__ scale, bf16* __restrict__ hrow, int lane) {
    float ss = 0.f;
#pragma unroll
    for (int j = 0; j < 4; ++j) ss += (v[j][0] * v[j][0] + v[j][1] * v[j][1]) + (v[j][2] * v[j][2] + v[j][3] * v[j][3]);
    const float rstd = __builtin_amdgcn_rsqf(wave_sum(ss) * (1.0f / 1024.0f) + EPS);
#pragma unroll
    for (int j = 0; j < 4; ++j) { const int c = 4 * lane + 256 * j;
        const f32x4 g = *(const f32x4*)(gain + c), sc = *(const f32x4*)(scale + c), sh = *(const f32x4*)(shift + c);
        const f32x4 h = v[j] * rstd * (g * (1.0f + sc)) + sh;
        v2u w; w.x = pk2(h[0], h[1]); w.y = pk2(h[2], h[3]); *(v2u*)(hrow + c) = w; }
}
__device__ __forceinline__ void phase_norm0(const Args& args) {
    int tid_ = threadIdx.x; asm volatile("" : "+v"(tid_)); const int tid = tid_, lane = tid & 63, wave = __builtin_amdgcn_readfirstlane(tid >> 6), G = gridDim.x, bid = blockIdx.x; (void)tid; (void)lane; (void)wave;
    const float* X = args.in[0]; bf16* H = (bf16*)(args.ws + WS_ACT + A_H); const float* MOD = (const float*)(args.ws + WS_MOD);
    for (int t = bid * NWAVES + wave; t < T; t += G * NWAVES) { const int b = t / SEQ; f32x4 v[4];
#pragma unroll
        for (int j = 0; j < 4; ++j) v[j] = *(const f32x4*)(X + (size_t)t * 1024 + 4 * lane + 256 * j);
        const float* m = MOD + (size_t)b * 6144;
        norm_store_row(v, args.in[2], m, m + 1024, H + (size_t)t * 1024, lane); }
}

__device__ __forceinline__ void phase_gm_spatial(const Args& args, int L, LAS unsigned char* lds) {
    int tid_ = threadIdx.x; asm volatile("" : "+v"(tid_)); const int tid = tid_, lane = tid & 63, wave = __builtin_amdgcn_readfirstlane(tid >> 6), G = gridDim.x, bid = blockIdx.x;
    unsigned char* ws = uni_ptr(args.ws); const int ib = LBASE(L) + 4;
    const float* v_norm = args.in[ib + 1]; const float* w_s = args.in[ib + 2]; const float* b_s = args.in[ib + 3];
    const bf16* U = (const bf16*)(ws + WS_ACT + A_U); const bf16* V = (const bf16*)(ws + WS_ACT + A_V); bf16* GT = (bf16*)(ws + WS_ACT + A_GATED);
    const float* VSSP = (const float*)(ws + WS_VSSP);
    LAS bf16* WL = (LAS bf16*)lds;
    LAS unsigned char* VT = lds + 34816;
    LAS float* rs = (LAS float*)(lds + 67584);
    typedef short s16x4 __attribute__((ext_vector_type(4)));
    const int wr = wave >> 2, wc = wave & 3, fr = lane & 15, fq = lane >> 4;
    const int trw = tid >> 2, sq = (tid & 3) * 32;
    v4u vq[4]; f32x4 wq[8]; float ssq = 0.f;
#define GS_LOAD(u_) do { const int c_ = (u_) >> 3, g_ = (u_) & 7; const unsigned tok0_ = (unsigned)c_ * 128u; \
        _Pragma("unroll") for (int i_ = 0; i_ < 4; ++i_) { const int p_ = tid + 512 * i_, row_ = p_ >> 4, c16_ = p_ & 15; vq[i_] = *(const v4u*)(V + (size_t)(tok0_ + row_) * 1024 + g_ * 128 + c16_ * 8); } \
        const float* wp_ = w_s + ((size_t)g_ * 128 + trw) * 128 + sq; _Pragma("unroll") for (int i_ = 0; i_ < 8; ++i_) wq[i_] = *(const f32x4*)(wp_ + 4 * i_); \
        if (tid < 128) { const float* p_ = VSSP + (size_t)(tok0_ + tid) * 16; float s_ = 0.f; _Pragma("unroll") for (int i_ = 0; i_ < 4; ++i_) { const f32x4 q_ = *(const f32x4*)(p_ + 4 * i_); s_ += (q_[0] + q_[1]) + (q_[2] + q_[3]); } ssq = s_; } } while (0)
    if (bid < 2048) GS_LOAD(bid);
    for (int u = bid; u < 2048; u += G) {
        const int c = u >> 3, g = u & 7; const size_t tok0 = (size_t)c * 128;
        __syncthreads();
        if (tid < 128) rs[tid] = __builtin_amdgcn_rsqf(ssq * (1.0f / 1024.0f) + EPS);
#pragma unroll
        for (int i = 0; i < 4; ++i) { const int p = tid + 512 * i, row = p >> 4, c16 = p & 15; *(LAS v4u*)(VT + row * 256 + (((c16 >> 1) ^ (row & 7)) << 5) + ((c16 & 1) << 4)) = vq[i]; }
        __syncthreads();
#pragma unroll
        for (int i = 0; i < 8; ++i) { float o[4];
#pragma unroll
            for (int e = 0; e < 4; ++e) { const int s = sq + 4 * i + e; o[e] = (s <= trw) ? wq[i][e] * rs[s] : 0.f; }
            v2u w; w.x = pk2(o[0], o[1]); w.y = pk2(o[2], o[3]); *(LAS v2u*)(WL + trw * 136 + sq + 4 * i) = w; }
        __syncthreads();
        if (u + G < 2048) GS_LOAD(u + G);
        f32x4 acc[2][4];
#pragma unroll
        for (int n = 0; n < 2; ++n)
#pragma unroll
            for (int m = 0; m < 4; ++m) acc[n][m] = (f32x4){0.f, 0.f, 0.f, 0.f};
#pragma unroll
        for (int ks = 0; ks < 4; ++ks) {
            if (32 * ks <= 64 * wr + 63) {
                bf16x8 vf[2], wf[4];
#pragma unroll
                for (int n = 0; n < 2; ++n) { const int ct = 2 * wc + n, r0 = 32 * ks + 4 * fq + (fr >> 2), r1 = r0 + 16;
                    const s16x4 lo = __builtin_amdgcn_ds_read_tr16_b64_v4i16((LAS s16x4*)(VT + r0 * 256 + ((ct ^ (r0 & 7)) << 5) + ((fr & 3) << 3)));
                    const s16x4 hi = __builtin_amdgcn_ds_read_tr16_b64_v4i16((LAS s16x4*)(VT + r1 * 256 + ((ct ^ (r1 & 7)) << 5) + ((fr & 3) << 3)));
                    vf[n] = (bf16x8){lo[0], lo[1], lo[2], lo[3], hi[0], hi[1], hi[2], hi[3]}; }
#pragma unroll
                for (int m = 0; m < 4; ++m) { const LAS bf16* wp = WL + (64 * wr + 16 * m + fr) * 136 + 32 * ks + 4 * fq; const v2u lo = *(const LAS v2u*)wp, hi = *(const LAS v2u*)(wp + 16);
                    v4u w; w.x = lo.x; w.y = lo.y; w.z = hi.x; w.w = hi.y; wf[m] = __builtin_bit_cast(bf16x8, w); }
#pragma unroll
                for (int n = 0; n < 2; ++n)
#pragma unroll
                    for (int m = 0; m < 4; ++m) if (32 * ks <= 64 * wr + 16 * m + 15) acc[n][m] = __builtin_amdgcn_mfma_f32_16x16x32_bf16(vf[n], wf[m], acc[n][m], 0, 0, 0);
            } }
#pragma unroll
        for (int m = 0; m < 4; ++m) { const int t = 64 * wr + 16 * m + fr; const float bs = b_s[g * 128 + t];
#pragma unroll
            for (int n = 0; n < 2; ++n) { const int d0 = g * 128 + 32 * wc + 16 * n + 4 * fq; const size_t off = (tok0 + t) * 1024 + d0;
                const v2u uu = *(const v2u*)(U + off); const f32x4 vn = *(const f32x4*)(v_norm + d0);
                const float o0 = bflo(uu.x) * (acc[n][m][0] * vn[0] + bs), o1 = bfhi(uu.x) * (acc[n][m][1] * vn[1] + bs), o2 = bflo(uu.y) * (acc[n][m][2] * vn[2] + bs), o3 = bfhi(uu.y) * (acc[n][m][3] * vn[3] + bs);
                v2u w; w.x = pk2(o0, o1); w.y = pk2(o2, o3); *(v2u*)(GT + off) = w; } }
    }
#undef GS_LOAD
}

__device__ __forceinline__ void phase_swa_attn(const Args& args, LAS unsigned char* lds) {
    int tid_ = threadIdx.x; asm volatile("" : "+v"(tid_)); const int tid = tid_, lane = tid & 63, wave = __builtin_amdgcn_readfirstlane(tid >> 6), G = gridDim.x, bid = blockIdx.x;
    unsigned char* ws = uni_ptr(args.ws);
    const float* q_norm = args.in[34]; const float* k_norm = args.in[35]; const float* sinks = args.in[36];
    const bf16* QKV = (const bf16*)(ws + WS_ACT + A_QKV); bf16* O = (bf16*)(ws + WS_ACT + A_H);
    LAS bf16* KL = (LAS bf16*)lds; LAS unsigned char* VL = lds + 36864; LAS float* nrm = (LAS float*)(lds + 69632);
    if (tid < 64) { nrm[tid] = q_norm[tid]; nrm[64 + tid] = k_norm[tid]; }
    typedef short s16x4 __attribute__((ext_vector_type(4)));
    const int fr = lane & 15, fq = lane >> 4, g = wave >> 1, qh = wave & 1;
    const int kkey = tid >> 1, khalf = tid & 1;
    v4u kq[4], qq[4][2];
#define SW_LOAD(u_) do { const int n_ = (u_) & 127, kvh_ = ((u_) >> 7) & 3, b_ = (u_) >> 9; const unsigned tok0_ = (unsigned)b_ * SEQ + (unsigned)n_ * 128u; \
        { const bool ok_ = (n_ > 0) || (kkey >= 128); const bf16* kp_ = QKV + ((ok_ ? tok0_ - 128u + (unsigned)kkey : tok0_) * 1536u + 1024u + (unsigned)(kvh_ * 64 + khalf * 32)); _Pragma("unroll") for (int i_ = 0; i_ < 4; ++i_) kq[i_] = *(const v4u*)(kp_ + 8 * i_); } \
        } while (0)
#define SW_LOADQ(u_, mt_) do { const int n_ = (u_) & 127, kvh_ = ((u_) >> 7) & 3, b_ = (u_) >> 9; const unsigned tok0_ = (unsigned)b_ * SEQ + (unsigned)n_ * 128u; \
        const bf16* qp_ = QKV + ((tok0_ + (unsigned)(qh * 64 + (mt_) * 16 + fr)) * 1536u + (unsigned)((kvh_ * 4 + g) * 64 + 8 * fq)); qq[mt_][0] = *(const v4u*)qp_; qq[mt_][1] = *(const v4u*)(qp_ + 32); } while (0)
    if (bid < 1024) { SW_LOAD(bid); SW_LOADQ(bid, 0); SW_LOADQ(bid, 1); SW_LOADQ(bid, 2); SW_LOADQ(bid, 3); }
    for (int u = bid; u < 1024; u += G) {
        const int n = u & 127, kvh = (u >> 7) & 3, b = u >> 9; const unsigned tok0 = (unsigned)b * SEQ + (unsigned)n * 128u;
        __syncthreads(); asm volatile("" ::: "memory");
        { float x[32]; float ss = 0.f; const bool ok = (n > 0) || (kkey >= 128);
#pragma unroll
          for (int i = 0; i < 4; ++i) { const unsigned w[4] = {kq[i].x, kq[i].y, kq[i].z, kq[i].w};
#pragma unroll
              for (int e = 0; e < 4; ++e) { x[8 * i + 2 * e] = bflo(w[e]); x[8 * i + 2 * e + 1] = bfhi(w[e]); } }
#pragma unroll
          for (int i = 0; i < 32; ++i) ss += x[i] * x[i];
          ss += __shfl_xor(ss, 1);
          const float rstd = ok ? __builtin_amdgcn_rsqf(ss * (1.0f / 64.0f) + EPS) : 0.f;
#pragma unroll
          for (int i = 0; i < 4; ++i) { float o[8];
#pragma unroll
              for (int e = 0; e < 8; ++e) o[e] = x[8 * i + e] * rstd * nrm[64 + khalf * 32 + 8 * i + e];
              v4u w; w.x = pk2(o[0], o[1]); w.y = pk2(o[2], o[3]); w.z = pk2(o[4], o[5]); w.w = pk2(o[6], o[7]);
              *(LAS v4u*)(KL + kkey * 72 + khalf * 32 + 8 * i) = w; } }
        { v4u vq[4];
#pragma unroll
          for (int i = 0; i < 4; ++i) { const int p = tid + 512 * i, key = p >> 3, c16 = p & 7; const bool ok = (n > 0) || (key >= 128);
              vq[i] = *(const v4u*)(QKV + ((ok ? tok0 - 128u + (unsigned)key : tok0) * 1536u + 1280u + (unsigned)(kvh * 64 + c16 * 8))); if (!ok) vq[i] = (v4u){0u, 0u, 0u, 0u}; }
#pragma unroll
          for (int i = 0; i < 4; ++i) { const int p = tid + 512 * i, key = p >> 3, c16 = p & 7; *(LAS v4u*)(VL + key * 128 + (((c16 >> 1) ^ ((key >> 1) & 3)) << 5) + ((c16 & 1) << 4)) = vq[i]; } }
        __syncthreads();
        if (u + G < 1024) SW_LOAD(u + G);
        const int hq = kvh * 4 + g; const float sink = sinks[hq];
#pragma unroll
        for (int mt = 0; mt < 4; ++mt) {
            asm volatile("" ::: "memory"); __builtin_amdgcn_sched_barrier(0);
            const int qi = qh * 64 + mt * 16 + fr, nb = qh * 4 + mt;
            bf16x8 qf[2];
            { float x[16]; float ss = 0.f;
#pragma unroll
              for (int ks = 0; ks < 2; ++ks) { const unsigned w[4] = {qq[mt][ks].x, qq[mt][ks].y, qq[mt][ks].z, qq[mt][ks].w};
#pragma unroll
                  for (int e = 0; e < 4; ++e) { x[8 * ks + 2 * e] = bflo(w[e]); x[8 * ks + 2 * e + 1] = bfhi(w[e]); } }
#pragma unroll
              for (int i = 0; i < 16; ++i) ss += x[i] * x[i];
              ss += __shfl_xor(ss, 16); ss += __shfl_xor(ss, 32);
              const float rstd = __builtin_amdgcn_rsqf(ss * (1.0f / 64.0f) + EPS) * 0.125f;
#pragma unroll
              for (int ks = 0; ks < 2; ++ks) { float o[8];
#pragma unroll
                  for (int e = 0; e < 8; ++e) o[e] = x[8 * ks + e] * rstd * nrm[32 * ks + 8 * fq + e];
                  v4u w; w.x = pk2(o[0], o[1]); w.y = pk2(o[2], o[3]); w.z = pk2(o[4], o[5]); w.w = pk2(o[6], o[7]); qf[ks] = __builtin_bit_cast(bf16x8, w); } }
            if (u + G < 1024) SW_LOADQ(u + G, mt);
            f32x4 s[10]; float mx = -INFINITY;
#pragma unroll
            for (int i = 0; i < 9; ++i) { const int nt = nb + i; f32x4 a = {0.f, 0.f, 0.f, 0.f};
#pragma unroll
                for (int ks = 0; ks < 2; ++ks) { const bf16x8 kf = *(const LAS bf16x8*)(KL + (16 * nt + fr) * 72 + 32 * ks + 8 * fq); a = __builtin_amdgcn_mfma_f32_16x16x32_bf16(kf, qf[ks], a, 0, 0, 0); }
#pragma unroll
                for (int r = 0; r < 4; ++r) { const int kj = 16 * nt + 4 * fq + r; const bool valid = (kj > qi) && (kj <= qi + 128) && ((n > 0) || (kj >= 128)); a[r] = valid ? a[r] : -INFINITY; mx = fmaxf(mx, a[r]); }
                s[i] = a; }
            mx = fmaxf(mx, __shfl_xor(mx, 16)); mx = fmaxf(mx, __shfl_xor(mx, 32)); mx = fmaxf(mx, sink);
            float l = 0.f;
#pragma unroll
            for (int i = 0; i < 9; ++i)
#pragma unroll
                for (int r = 0; r < 4; ++r) { const float p = fast_exp(s[i][r] - mx); s[i][r] = p; l += p; }
            s[9] = (f32x4){0.f, 0.f, 0.f, 0.f};
            l += __shfl_xor(l, 16); l += __shfl_xor(l, 32); l += fast_exp(sink - mx);
            f32x4 o[4];
#pragma unroll
            for (int dt = 0; dt < 4; ++dt) o[dt] = (f32x4){0.f, 0.f, 0.f, 0.f};
#pragma unroll
            for (int st = 0; st < 5; ++st) {
                v4u pw; pw.x = pk2(s[2 * st][0], s[2 * st][1]); pw.y = pk2(s[2 * st][2], s[2 * st][3]); pw.z = pk2(s[2 * st + 1][0], s[2 * st + 1][1]); pw.w = pk2(s[2 * st + 1][2], s[2 * st + 1][3]);
                const bf16x8 pf = __builtin_bit_cast(bf16x8, pw);
                const int k0 = 16 * (nb + 2 * st) + 4 * fq + (fr >> 2); const int k1r = k0 + 16, k1 = k1r > 255 ? 255 : k1r;
#pragma unroll
                for (int dt = 0; dt < 4; ++dt) {
                    const s16x4 lo = __builtin_amdgcn_ds_read_tr16_b64_v4i16((LAS s16x4*)(VL + k0 * 128 + ((dt ^ ((k0 >> 1) & 3)) << 5) + ((fr & 3) << 3)));
                    const s16x4 hi = __builtin_amdgcn_ds_read_tr16_b64_v4i16((LAS s16x4*)(VL + k1 * 128 + ((dt ^ ((k1 >> 1) & 3)) << 5) + ((fr & 3) << 3)));
                    const bf16x8 vf = (bf16x8){lo[0], lo[1], lo[2], lo[3], hi[0], hi[1], hi[2], hi[3]};
                    o[dt] = __builtin_amdgcn_mfma_f32_16x16x32_bf16(vf, pf, o[dt], 0, 0, 0); } }
            const float inv = 1.0f / l;
#pragma unroll
            for (int dt = 0; dt < 4; ++dt) { v2u w; w.x = pk2(o[dt][0] * inv, o[dt][1] * inv); w.y = pk2(o[dt][2] * inv, o[dt][3] * inv);
                *(v2u*)(O + ((tok0 + (unsigned)qi) * 1024u + (unsigned)(hq * 64 + 16 * dt + 4 * fq))) = w; }
            __builtin_amdgcn_sched_barrier(0);
        }
    }
#undef SW_LOAD
#undef SW_LOADQ
}

__device__ __forceinline__ void phase_dn_prep(const Args& args, LAS unsigned char* lds) {
    int tid_ = threadIdx.x; asm volatile("" : "+v"(tid_)); const int tid = tid_, lane = tid & 63, wave = __builtin_amdgcn_readfirstlane(tid >> 6), G = gridDim.x, bid = blockIdx.x;
    unsigned char* ws = uni_ptr(args.ws); const float* conv_w = args.in[20]; const float* a_log = args.in[21]; const float* dt_bias = args.in[22];
    const bf16* QKV = (const bf16*)(ws + WS_ACT + A_QKV); bf16* QN = (bf16*)(ws + WS_ACT + A_QN); bf16* KN = (bf16*)(ws + WS_ACT + A_KN); bf16* VV = (bf16*)(ws + WS_ACT + A_VV);
    const float* BA = (const float*)(ws + WS_BA); float* DNB = (float*)(ws + WS_DNB);
    constexpr int RUN = 16;
    LAS float* cwl = (LAS float*)lds;
    for (int i = tid; i < 2048; i += NTHR) *(LAS f32x4*)(cwl + 4 * i) = *(const f32x4*)(conv_w + 4 * i);
    __syncthreads();
    const float alg = lane < 8 ? -expf(a_log[lane]) : 0.f, dtb = lane < 8 ? dt_bias[lane] : 0.f;
    for (int run = bid * NWAVES + wave; run < T / RUN; run += G * NWAVES) {
        const int tbeg = run * RUN, pos0 = tbeg % SEQ;
        v4u rows[3][4];
#pragma unroll
        for (int d = 0; d < 3; ++d)
#pragma unroll
            for (int j = 0; j < 4; ++j) rows[d][j] = (pos0 - 3 + d >= 0) ? *(const v4u*)(QKV + (size_t)(tbeg - 3 + d) * 2048 + 8 * lane + 512 * j) : (v4u){0u, 0u, 0u, 0u};
#pragma unroll 1
        for (int i = 0; i < RUN; ++i) { const int t = tbeg + i;
            v4u cur[4];
#pragma unroll
            for (int j = 0; j < 4; ++j) cur[j] = *(const v4u*)(QKV + (size_t)t * 2048 + 8 * lane + 512 * j);
            float bi = 0.f, ai = 0.f; if (lane < 8) { bi = BA[(size_t)t * 16 + lane]; ai = BA[(size_t)t * 16 + 8 + lane] + dtb; }
#pragma unroll
            for (int j = 0; j < 4; ++j) { float a[8];
#pragma unroll
                for (int e = 0; e < 8; ++e) a[e] = 0.f;
#pragma unroll
                for (int tap = 0; tap < 4; ++tap) { const v4u q = tap < 3 ? rows[tap][j] : cur[j]; const f32x4 w0 = *(const LAS f32x4*)(cwl + tap * 2048 + 8 * lane + 512 * j), w1 = *(const LAS f32x4*)(cwl + tap * 2048 + 8 * lane + 512 * j + 4);
                    a[0] += w0[0] * bflo(q.x); a[1] += w0[1] * bfhi(q.x); a[2] += w0[2] * bflo(q.y); a[3] += w0[3] * bfhi(q.y); a[4] += w1[0] * bflo(q.z); a[5] += w1[1] * bfhi(q.z); a[6] += w1[2] * bflo(q.w); a[7] += w1[3] * bfhi(q.w); }
                float ss = 0.f;
#pragma unroll
                for (int e = 0; e < 8; ++e) { a[e] = siluf_(a[e]); ss += a[e] * a[e]; }
                if (j < 2) { ss += __shfl_xor(ss, 1); ss += __shfl_xor(ss, 2); ss += __shfl_xor(ss, 4); ss += __shfl_xor(ss, 8);
                    const float r = __builtin_amdgcn_rsqf(ss + EPS); bf16* dst = (j == 0 ? QN : KN) + (size_t)t * 512 + 8 * lane;
                    v4u w; w.x = pk2(a[0] * r, a[1] * r); w.y = pk2(a[2] * r, a[3] * r); w.z = pk2(a[4] * r, a[5] * r); w.w = pk2(a[6] * r, a[7] * r); *(v4u*)dst = w; }
                else { v4u w; w.x = pk2(a[0], a[1]); w.y = pk2(a[2], a[3]); w.z = pk2(a[4], a[5]); w.w = pk2(a[6], a[7]); *(v4u*)(VV + (size_t)t * 1024 + 8 * lane + 512 * (j - 2)) = w; } }
            if (lane < 8) { const float sp = fmaxf(ai, 0.f) + log1pf(expf(-fabsf(ai)));
                DNB[(size_t)t * 16 + lane] = 1.0f / (1.0f + expf(-bi)); DNB[(size_t)t * 16 + 8 + lane] = alg * sp; }
#pragma unroll
            for (int j = 0; j < 4; ++j) { rows[0][j] = rows[1][j]; rows[1][j] = rows[2][j]; rows[2][j] = cur[j]; }
        }
    }
}
constexpr int FA_STRIDE = 25600, FB_STRIDE = 32768, FU_STRIDE = 16384;
constexpr float DN_SCALE = 0.08838834764831845f;
__device__ __forceinline__ void phase_dn_chunk(const Args& args, LAS unsigned char* lds) {
    int tid_ = threadIdx.x; asm volatile("" : "+v"(tid_)); const int tid = tid_, lane = tid & 63, wave = __builtin_amdgcn_readfirstlane(tid >> 6), G = gridDim.x, bid = blockIdx.x;
    unsigned char* ws = uni_ptr(args.ws);
    const bf16* QN = (const bf16*)(ws + WS_ACT + A_QN); const bf16* KN = (const bf16*)(ws + WS_ACT + A_KN); const bf16* VV = (const bf16*)(ws + WS_ACT + A_VV);
    const float* DNB = (const float*)(ws + WS_DNB);
    unsigned char* FA = ws + WS_ACT + A_FA; unsigned char* FB = ws + WS_ACT + A_FB; unsigned char* FU = ws + WS_ACT + A_FU;
    LAS float* Al = (LAS float*)(lds + wave * 16384);
    LAS float* tb = (LAS float*)(lds + LDSCTL_OFF + 2048 + wave * 512);
    const int fr = lane & 15, fq = lane >> 4;
    for (int it = bid * NWAVES + wave; it < 4096; it += G * NWAVES) {
        const int b = it >> 11, hv = (it >> 8) & 7, n = it & 255, hq = hv >> 1; const unsigned t0 = (unsigned)b * SEQ + (unsigned)n * 64; const int itq = (b * 4 + hq) * 256 + n;
        unsigned char* fa = FA + (size_t)it * FA_STRIDE; unsigned char* fb = FB + (size_t)itq * FB_STRIDE;
        const float bv = DNB[(t0 + lane) * 16 + hv]; float gcv = DNB[(t0 + lane) * 16 + 8 + hv];
#pragma unroll
        for (int o = 1; o < 64; o <<= 1) { const float t = __shfl_up(gcv, o); if (lane >= o) gcv += t; }
        const float gll = __shfl(gcv, 63);
        tb[lane] = gcv; tb[64 + lane] = bv;
        { float* fe = (float*)(fa + 24576); fe[lane] = DN_SCALE * expf(gcv); fe[64 + lane] = expf(gll - gcv); fe[128 + lane] = expf(gll); }
        asm volatile("" ::: "memory");
        bf16x8 kf[4][4];
#pragma unroll
        for (int t = 0; t < 4; ++t)
#pragma unroll
            for (int ks = 0; ks < 4; ++ks) kf[t][ks] = *(const bf16x8*)(KN + (t0 + 16 * t + fr) * 512 + hq * 128 + 32 * ks + 8 * fq);
#pragma unroll
        for (int m = 0; m < 4; ++m) { const int c = 16 * m + fr; const float bm = tb[64 + c], gm = tb[c];
            bf16x8 qf[4];
#pragma unroll
            for (int ks = 0; ks < 4; ++ks) qf[ks] = *(const bf16x8*)(QN + (t0 + c) * 512 + hq * 128 + 32 * ks + 8 * fq);
            f32x4 tl[4];
#pragma unroll
            for (int t = 0; t < 4; ++t) {
                if (t <= m) { f32x4 ak = {0.f, 0.f, 0.f, 0.f}, aq = {0.f, 0.f, 0.f, 0.f};
#pragma unroll
                    for (int ks = 0; ks < 4; ++ks) { ak = __builtin_amdgcn_mfma_f32_16x16x32_bf16(kf[t][ks], kf[m][ks], ak, 0, 0, 0); aq = __builtin_amdgcn_mfma_f32_16x16x32_bf16(kf[t][ks], qf[ks], aq, 0, 0, 0); }
                    const f32x4 gs4 = *(const LAS f32x4*)(tb + 16 * t + 4 * fq); f32x4 av;
#pragma unroll
                    for (int r = 0; r < 4; ++r) { const int s = 16 * t + 4 * fq + r; const float dec = expf(fminf(gm - gs4[r], 0.f)); av[r] = (s < c) ? bm * ak[r] * dec : 0.f; tl[t][r] = (s <= c) ? DN_SCALE * aq[r] * dec : 0.f; }
                    *(LAS f32x4*)(Al + c * 64 + 16 * t + 4 * fq) = av; }
                else tl[t] = (f32x4){0.f, 0.f, 0.f, 0.f}; }
#pragma unroll
            for (int k2 = 0; k2 < 2; ++k2) { v4u w; w.x = pk2(tl[2 * k2][0], tl[2 * k2][1]); w.y = pk2(tl[2 * k2][2], tl[2 * k2][3]); w.z = pk2(tl[2 * k2 + 1][0], tl[2 * k2 + 1][1]); w.w = pk2(tl[2 * k2 + 1][2], tl[2 * k2 + 1][3]);
                *(v4u*)(fa + 16384 + (m * 2 + k2) * 1024 + lane * 16) = w; } }
        asm volatile("s_waitcnt lgkmcnt(0)" ::: "memory");
        float Tc[64];
#pragma unroll
        for (int m = 0; m < 64; ++m) Tc[m] = (m == lane) ? 1.f : 0.f;
#pragma unroll
        for (int r = 1; r < 64; ++r) { float acc = 0.f;
#pragma unroll
            for (int m4 = 0; m4 < (r + 3) / 4; ++m4) { const f32x4 a4 = *(const LAS f32x4*)(Al + r * 64 + 4 * m4);
#pragma unroll
                for (int e = 0; e < 4; ++e) if (4 * m4 + e < r) acc += a4[e] * Tc[4 * m4 + e]; }
            Tc[r] -= acc; if ((r & 3) == 3) __builtin_amdgcn_sched_barrier(0); }
        asm volatile("s_waitcnt lgkmcnt(0)" ::: "memory");
        LAS bf16* T1l = (LAS bf16*)Al; LAS bf16* T2l = T1l + 4096;
        { const float c1 = bv, c2 = bv * expf(gcv);
#pragma unroll
          for (int i = 0; i < 64; ++i) { T1l[i * 64 + lane] = (bf16)(pk2(Tc[i] * c1, 0.f) & 0xffffu); T2l[i * 64 + lane] = (bf16)(pk2(Tc[i] * c2, 0.f) & 0xffffu); } }
        asm volatile("s_waitcnt lgkmcnt(0)" ::: "memory");
        bf16x8 t1f[4][2], t2f[4][2];
#pragma unroll
        for (int m = 0; m < 4; ++m)
#pragma unroll
            for (int k2 = 0; k2 < 2; ++k2) { const int o = (16 * m + fr) * 64 + 32 * k2 + 4 * fq;
                { const v2u lo = *(const LAS v2u*)(T1l + o), hi = *(const LAS v2u*)(T1l + o + 16); v4u w; w.x = lo.x; w.y = lo.y; w.z = hi.x; w.w = hi.y; t1f[m][k2] = __builtin_bit_cast(bf16x8, w); }
                { const v2u lo = *(const LAS v2u*)(T2l + o), hi = *(const LAS v2u*)(T2l + o + 16); v4u w; w.x = lo.x; w.y = lo.y; w.z = hi.x; w.w = hi.y; t2f[m][k2] = __builtin_bit_cast(bf16x8, w); } }
        asm volatile("s_waitcnt lgkmcnt(0)" ::: "memory");
        LAS unsigned char* tile = (LAS unsigned char*)Al;
        typedef short s16x4 __attribute__((ext_vector_type(4)));
#define DN_STAGE_TILE(src, pitch, coff) do { _Pragma("unroll") for (int hb_ = 0; hb_ < 2; ++hb_) { v4u pv[8]; _Pragma("unroll") for (int it_ = 0; it_ < 8; ++it_) { const int p_ = lane + 64 * (it_ + 8 * hb_), row_ = p_ >> 4, c16_ = p_ & 15; pv[it_] = *(const v4u*)((src) + (t0 + row_) * (pitch) + (coff) + c16_ * 8); } \
            _Pragma("unroll") for (int it_ = 0; it_ < 8; ++it_) { const int p_ = lane + 64 * (it_ + 8 * hb_), row_ = p_ >> 4, c16_ = p_ & 15; *(LAS v4u*)(tile + row_ * 256 + (((c16_ >> 1) ^ (row_ & 7)) << 5) + ((c16_ & 1) << 4)) = pv[it_]; } } } while (0)
#define DN_TR_FRAG(dst, ct, k2) do { const int r0_ = 32 * (k2) + 4 * fq + (fr >> 2), r1_ = r0_ + 16; \
            const s16x4 lo_ = __builtin_amdgcn_ds_read_tr16_b64_v4i16((LAS s16x4*)(tile + r0_ * 256 + ((((ct)) ^ (r0_ & 7)) << 5) + ((fr & 3) << 3))); \
            const s16x4 hi_ = __builtin_amdgcn_ds_read_tr16_b64_v4i16((LAS s16x4*)(tile + r1_ * 256 + ((((ct)) ^ (r1_ & 7)) << 5) + ((fr & 3) << 3))); \
            dst = (bf16x8){lo_[0], lo_[1], lo_[2], lo_[3], hi_[0], hi_[1], hi_[2], hi_[3]}; } while (0)
        DN_STAGE_TILE(VV, 1024, hv * 128);
        asm volatile("s_waitcnt lgkmcnt(0)" ::: "memory");
#pragma unroll 1
        for (int j = 0; j < 8; ++j) { bf16x8 vf[2];
            DN_TR_FRAG(vf[0], j, 0); DN_TR_FRAG(vf[1], j, 1);
#pragma unroll
            for (int m = 0; m < 4; ++m) { f32x4 a = {0.f, 0.f, 0.f, 0.f};
#pragma unroll
                for (int k2 = 0; k2 < 2; ++k2) a = __builtin_amdgcn_mfma_f32_16x16x32_bf16(t1f[m][k2], vf[k2], a, 0, 0, 0);
                v2u w; w.x = pk2(a[0], a[1]); w.y = pk2(a[2], a[3]); *(v2u*)(FU + (size_t)it * FU_STRIDE + ((j * 4 + m) * 64 + lane) * 8) = w; } }
        asm volatile("s_waitcnt lgkmcnt(0)" ::: "memory");
        DN_STAGE_TILE(KN, 512, hq * 128);
        asm volatile("s_waitcnt lgkmcnt(0)" ::: "memory");
        if ((hv & 1) == 0) { int fr2 = fr, fq2 = fq; asm volatile("" : "+v"(fr2), "+v"(fq2));
#pragma unroll
            for (int m = 0; m < 4; ++m)
#pragma unroll
                for (int ks = 0; ks < 4; ++ks) { const bf16* qp = QN + (t0 + 16 * m + fr2) * 512 + hq * 128 + 32 * ks + 4 * fq2; const v2u lo = *(const v2u*)qp, hi = *(const v2u*)(qp + 16);
                    v4u w; w.x = lo.x; w.y = lo.y; w.z = hi.x; w.w = hi.y; *(v4u*)(fb + (m * 4 + ks) * 1024 + lane * 16) = w; } }
#pragma unroll 1
        for (int dh = 0; dh < 2; ++dh) { bf16x8 ktf[4][2];
#pragma unroll
            for (int d4 = 0; d4 < 4; ++d4) { DN_TR_FRAG(ktf[d4][0], 4 * dh + d4, 0); DN_TR_FRAG(ktf[d4][1], 4 * dh + d4, 1); }
            if ((hv & 1) == 0) {
#pragma unroll
                for (int d4 = 0; d4 < 4; ++d4)
#pragma unroll
                    for (int k2 = 0; k2 < 2; ++k2) *(bf16x8*)(fb + 16384 + ((4 * dh + d4) * 2 + k2) * 1024 + lane * 16) = ktf[d4][k2]; }
#pragma unroll
            for (int m = 0; m < 4; ++m) { f32x4 acc[4];
#pragma unroll
                for (int d4 = 0; d4 < 4; ++d4) { acc[d4] = (f32x4){0.f, 0.f, 0.f, 0.f};
#pragma unroll
                    for (int k2 = 0; k2 < 2; ++k2) acc[d4] = __builtin_amdgcn_mfma_f32_16x16x32_bf16(ktf[d4][k2], t2f[m][k2], acc[d4], 0, 0, 0); }
#pragma unroll
                for (int kk = 0; kk < 2; ++kk) { v4u w; w.x = pk2(-acc[2 * kk][0], -acc[2 * kk][1]); w.y = pk2(-acc[2 * kk][2], -acc[2 * kk][3]); w.z = pk2(-acc[2 * kk + 1][0], -acc[2 * kk + 1][1]); w.w = pk2(-acc[2 * kk + 1][2], -acc[2 * kk + 1][3]);
                    *(v4u*)(fa + (m * 4 + 2 * dh + kk) * 1024 + lane * 16) = w; } } }
        asm volatile("s_waitcnt lgkmcnt(0)" ::: "memory");
#undef DN_STAGE_TILE
#undef DN_TR_FRAG
    }
}
__device__ __forceinline__ void phase_dn_scan(const Args& args, LAS unsigned char* lds) {
    int tid_ = threadIdx.x; asm volatile("" : "+v"(tid_)); const int tid = tid_, lane = tid & 63, wave = __builtin_amdgcn_readfirstlane(tid >> 6), G = gridDim.x, bid = blockIdx.x;
    if (bid >= 128) {
        const int gw = (bid - 128) * NWAVES + wave, NGW = (G - 128) * NWAVES;
        convert_weights(args, lds, CV_PER_L, CV_N_EXP, gw, NGW); convert_weights(args, lds, CV_N_EXP + CV_MIX_L01, CV_N_EXP + CV_N_MIXI, gw, NGW); return; }
    unsigned char* ws = uni_ptr(args.ws);
    const unsigned char* FA = ws + WS_ACT + A_FA; const unsigned char* FB = ws + WS_ACT + A_FB; const unsigned char* FU = ws + WS_ACT + A_FU; bf16* O = (bf16*)(ws + WS_ACT + A_O);
    const int fr = lane & 15, fq = lane >> 4;
    constexpr int SLOT = 60416, O_QK = 16384, O_TB = 24576, O_Q = 25600, O_KT = 41984, O_U = 58368;
#define SB() __builtin_amdgcn_sched_barrier(0)
#define WGBAR() do { asm volatile("" ::: "memory"); __builtin_amdgcn_s_barrier(); asm volatile("" ::: "memory"); } while (0)
#define DN_AUX 0
#define DMA4(g, l) do { __builtin_amdgcn_global_load_lds((g), (l), 16, 0, DN_AUX); __builtin_amdgcn_global_load_lds((g), (l), 16, 1024, DN_AUX); __builtin_amdgcn_global_load_lds((g), (l), 16, 2048, DN_AUX); __builtin_amdgcn_global_load_lds((g), (l), 16, 3072, DN_AUX); } while (0)
    for (int sidx = bid; sidx < 128; sidx += G) {
        const int bh = (sidx & 7) * 2 + (sidx >> 6), j = (sidx >> 3) & 7, b = bh >> 3, hv = bh & 7, hq = hv >> 1;
        const int it0 = bh * 256, itq0 = (b * 4 + hq) * 256;
        if (wave == 1 || wave == 4) {
#define DN_ISSUE_A(nn) do { LAS unsigned char* sl_ = lds + ((nn) & 1) * SLOT; \
                if (wave == 1) { const unsigned char* fa_ = FA + (size_t)(it0 + (nn)) * FA_STRIDE + lane * 16; \
                    _Pragma("unroll") for (int f4 = 0; f4 < 4; ++f4) { DMA4((const unsigned*)(fa_ + f4 * 4096), (LAS unsigned*)(sl_ + f4 * 4096)); } \
                    __builtin_amdgcn_global_load_lds((const unsigned*)(fa_ + 24576), (LAS unsigned*)(sl_ + O_TB), 16, 0, DN_AUX); } \
                else { const unsigned char* fb_ = FB + (size_t)(itq0 + (nn)) * FB_STRIDE + lane * 16; const unsigned char* fu_ = FU + (size_t)(it0 + (nn)) * FU_STRIDE + j * 2048 + lane * 16; \
                    _Pragma("unroll") for (int f4 = 0; f4 < 4; ++f4) { DMA4((const unsigned*)(fb_ + f4 * 4096), (LAS unsigned*)(sl_ + O_Q + f4 * 4096)); } \
                    __builtin_amdgcn_global_load_lds((const unsigned*)(fu_), (LAS unsigned*)(sl_ + O_U), 16, 0, DN_AUX); __builtin_amdgcn_global_load_lds((const unsigned*)(fu_), (LAS unsigned*)(sl_ + O_U), 16, 1024, DN_AUX); } } while (0)
#define DN_WAIT_A() do { if (wave == 1) asm volatile("s_waitcnt vmcnt(17)" ::: "memory"); else asm volatile("s_waitcnt vmcnt(18)" ::: "memory"); } while (0)
            DN_ISSUE_A(0); DN_ISSUE_A(1);
            DN_WAIT_A();
#pragma unroll 1
            for (int n = 0; n < 256; ++n) {
                WGBAR();
                WGBAR();
                if (n + 2 < 256) { DN_ISSUE_A(n + 2); DN_WAIT_A(); }
                else asm volatile("s_waitcnt vmcnt(0)" ::: "memory");
            }
#undef DN_ISSUE_A
#undef DN_WAIT_A
        } else if (wave == 2 || wave == 5) {
#define DN_ISSUE_B(nn) do { LAS unsigned char* sl_ = lds + ((nn) & 1) * SLOT; const unsigned char* fb_ = FB + (size_t)(itq0 + (nn)) * FB_STRIDE + 16384 + lane * 16; \
                if (wave == 2) { const unsigned char* fa_ = FA + (size_t)(it0 + (nn)) * FA_STRIDE + 16384 + lane * 16; \
                    _Pragma("unroll") for (int f4 = 0; f4 < 2; ++f4) { DMA4((const unsigned*)(fa_ + f4 * 4096), (LAS unsigned*)(sl_ + O_QK + f4 * 4096)); } \
                    DMA4((const unsigned*)(fb_), (LAS unsigned*)(sl_ + O_KT)); } \
                else { _Pragma("unroll") for (int f4 = 1; f4 < 4; ++f4) { DMA4((const unsigned*)(fb_ + f4 * 4096), (LAS unsigned*)(sl_ + O_KT + f4 * 4096)); } } } while (0)
            DN_ISSUE_B(0);
#pragma unroll 1
            for (int n = 0; n < 256; ++n) {
                WGBAR();
                if (n + 1 < 256) { DN_ISSUE_B(n + 1); asm volatile("s_waitcnt vmcnt(12)" ::: "memory"); }
                else asm volatile("s_waitcnt vmcnt(0)" ::: "memory");
                WGBAR();
            }
#undef DN_ISSUE_B
        } else if (wave == 3) {
            unsigned sink = 0u, pa = 0u, pb = 0u;
#pragma unroll 1
            for (int n = 0; n < 256; ++n) {
                WGBAR(); WGBAR();
                sink += pa + pb;
                const int p = n + 5;
                if (p < 256) { const int li = j * 57 + lane;
                    if (lane < 57 && li < 456) { const unsigned char* q = li < 200 ? FA + (size_t)(it0 + p) * FA_STRIDE + li * 128 : FB + (size_t)(itq0 + p) * FB_STRIDE + (li - 200) * 128; pa = *(const volatile unsigned*)q; }
                    if (lane < 16) pb = *(const volatile unsigned*)(FU + (size_t)(it0 + p) * FU_STRIDE + j * 2048 + lane * 128); }
            }
            sink += pa + pb;
            if (sink == 0x9e3779b9u) O[0] = 0;
        } else if (wave != 0) {
#pragma unroll 1
            for (int n = 0; n < 256; ++n) { WGBAR(); WGBAR(); }
        } else {
        f32x4 S[8];
#pragma unroll
        for (int dt = 0; dt < 8; ++dt) S[dt] = (f32x4){0.f, 0.f, 0.f, 0.f};
        bf16x8 sf[4];
#pragma unroll
        for (int ks = 0; ks < 4; ++ks) sf[ks] = (bf16x8){0, 0, 0, 0, 0, 0, 0, 0};
#pragma unroll 1
        for (int n = 0; n < 256; ++n) {
            WGBAR();
            const LAS unsigned char* base = lds + (n & 1) * SLOT + lane * 16;
            const LAS float* tbl = (const LAS float*)(lds + (n & 1) * SLOT + O_TB);
            f32x4 egc[4], ekd[4], av[4], ao[4];
#pragma unroll
            for (int m = 0; m < 4; ++m) { egc[m] = *(const LAS f32x4*)(tbl + 16 * m + 4 * fq); ekd[m] = *(const LAS f32x4*)(tbl + 64 + 16 * m + 4 * fq);
                const v2u u2 = *(const LAS v2u*)(lds + (n & 1) * SLOT + O_U + (m * 64 + lane) * 8); av[m] = (f32x4){bflo(u2.x), bfhi(u2.x), bflo(u2.y), bfhi(u2.y)}; ao[m] = (f32x4){0.f, 0.f, 0.f, 0.f}; }
            const float gl = tbl[128 + lane];
            SB();
            bf16x8 Aw[16], Bq[16];
#pragma unroll
            for (int f = 0; f < 16; ++f) Aw[f] = *(const LAS bf16x8*)(base + f * 1024);
            SB();
#pragma unroll
            for (int ks = 0; ks < 4; ++ks) {
#pragma unroll
                for (int m = 0; m < 4; ++m) Bq[m * 4 + ks] = *(const LAS bf16x8*)(base + O_Q + (m * 4 + ks) * 1024);
#pragma unroll
                for (int m = 0; m < 4; ++m) av[m] = __builtin_amdgcn_mfma_f32_16x16x32_bf16(Aw[m * 4 + ks], sf[ks], av[m], 0, 0, 0);
                SB(); }
            asm volatile("s_waitcnt lgkmcnt(0)" ::: "memory");
            WGBAR();
            bf16x8 Ck[16], Dk[8];
#pragma unroll
            for (int ks = 0; ks < 4; ++ks) {
#pragma unroll
                for (int f = 0; f < 2; ++f) { Ck[8 + ks * 2 + f] = *(const LAS bf16x8*)(base + O_KT + (ks * 2 + f) * 1024); Dk[ks * 2 + f] = *(const LAS bf16x8*)(base + O_KT + 8192 + (ks * 2 + f) * 1024); Ck[ks * 2 + f] = *(const LAS bf16x8*)(base + O_QK + (ks * 2 + f) * 1024); }
#pragma unroll
                for (int m = 0; m < 4; ++m) ao[m] = __builtin_amdgcn_mfma_f32_16x16x32_bf16(Bq[m * 4 + ks], sf[ks], ao[m], 0, 0, 0);
                SB(); }
#pragma unroll
            for (int dt = 0; dt < 8; ++dt) S[dt] = S[dt] * gl;
            bf16x8 vf[2], vpf[2];
#pragma unroll
            for (int k2 = 0; k2 < 2; ++k2) { v4u w; w.x = pk2(av[2 * k2][0], av[2 * k2][1]); w.y = pk2(av[2 * k2][2], av[2 * k2][3]); w.z = pk2(av[2 * k2 + 1][0], av[2 * k2 + 1][1]); w.w = pk2(av[2 * k2 + 1][2], av[2 * k2 + 1][3]); vf[k2] = __builtin_bit_cast(bf16x8, w);
                const f32x4 p0 = av[2 * k2] * ekd[2 * k2], p1 = av[2 * k2 + 1] * ekd[2 * k2 + 1];
                v4u x; x.x = pk2(p0[0], p0[1]); x.y = pk2(p0[2], p0[3]); x.z = pk2(p1[0], p1[1]); x.w = pk2(p1[2], p1[3]); vpf[k2] = __builtin_bit_cast(bf16x8, x); }
#pragma unroll
            for (int m = 0; m < 4; ++m) ao[m] = ao[m] * egc[m];
            SB();
#pragma unroll
            for (int k2 = 0; k2 < 2; ++k2)
#pragma unroll
                for (int dt = 0; dt < 4; ++dt) S[dt] = __builtin_amdgcn_mfma_f32_16x16x32_bf16(Ck[8 + dt * 2 + k2], vpf[k2], S[dt], 0, 0, 0);
#pragma unroll
            for (int k2 = 0; k2 < 2; ++k2)
#pragma unroll
                for (int dt = 4; dt < 8; ++dt) S[dt] = __builtin_amdgcn_mfma_f32_16x16x32_bf16(Dk[(dt - 4) * 2 + k2], vpf[k2], S[dt], 0, 0, 0);
#pragma unroll
            for (int k2 = 0; k2 < 2; ++k2)
#pragma unroll
                for (int m = 0; m < 4; ++m) ao[m] = __builtin_amdgcn_mfma_f32_16x16x32_bf16(Ck[m * 2 + k2], vf[k2], ao[m], 0, 0, 0);
            SB();
#pragma unroll
            for (int ks = 0; ks < 4; ++ks) { v4u w; w.x = pk2(S[2 * ks][0], S[2 * ks][1]); w.y = pk2(S[2 * ks][2], S[2 * ks][3]); w.z = pk2(S[2 * ks + 1][0], S[2 * ks + 1][1]); w.w = pk2(S[2 * ks + 1][2], S[2 * ks + 1][3]); sf[ks] = __builtin_bit_cast(bf16x8, w); }
            asm volatile("s_waitcnt lgkmcnt(0)" ::: "memory");
            { bf16* op = O + ((size_t)b * SEQ + (size_t)n * 64 + 4 * fq) * 1024 + hv * 128 + 16 * j + fr;
#pragma unroll
              for (int m = 0; m < 4; ++m)
#pragma unroll
                  for (int r = 0; r < 4; ++r) op[(size_t)(16 * m + r) * 1024] = (bf16)(pk2(ao[m][r], 0.f) & 0xffffu); }
        }
        }
        __syncthreads();
    }
#undef SB
#undef DMA4
#undef WGBAR
}
__device__ __forceinline__ void phase_dn_ogate(const Args& args) {
    int tid_ = threadIdx.x; asm volatile("" : "+v"(tid_)); const int tid = tid_, lane = tid & 63, wave = __builtin_amdgcn_readfirstlane(tid >> 6), G = gridDim.x, bid = blockIdx.x; (void)tid; (void)lane; (void)wave;
    unsigned char* ws = uni_ptr(args.ws); const float* o_norm = args.in[23];
    const bf16* O = (const bf16*)(ws + WS_ACT + A_O); const bf16* Z = (const bf16*)(ws + WS_ACT + A_Z); bf16* GT = (bf16*)(ws + WS_ACT + A_H);
    for (int t = bid * NWAVES + wave; t < T; t += G * NWAVES) {
#pragma unroll
        for (int j = 0; j < 2; ++j) { const int ch = 8 * lane + 512 * j; const v4u q = *(const v4u*)(O + (size_t)t * 1024 + ch), z = *(const v4u*)(Z + (size_t)t * 1024 + ch);
            float o[8] = {bflo(q.x), bfhi(q.x), bflo(q.y), bfhi(q.y), bflo(q.z), bfhi(q.z), bflo(q.w), bfhi(q.w)}; const float zz[8] = {bflo(z.x), bfhi(z.x), bflo(z.y), bfhi(z.y), bflo(z.z), bfhi(z.z), bflo(z.w), bfhi(z.w)};
            float ss = 0.f;
#pragma unroll
            for (int e = 0; e < 8; ++e) ss += o[e] * o[e];
            ss += __shfl_xor(ss, 1); ss += __shfl_xor(ss, 2); ss += __shfl_xor(ss, 4); ss += __shfl_xor(ss, 8);
            const float r = __builtin_amdgcn_rsqf(ss * (1.0f / 128.0f) + EPS);
#pragma unroll
            for (int e = 0; e < 8; ++e) o[e] = o[e] * r * o_norm[(ch & 127) + e] * siluf_(zz[e]);
            v4u w; w.x = pk2(o[0], o[1]); w.y = pk2(o[2], o[3]); w.z = pk2(o[4], o[5]); w.w = pk2(o[6], o[7]); *(v4u*)(GT + (size_t)t * 1024 + ch) = w; }
    }
}

__device__ __forceinline__ void phase_moe_router(const Args& args, int L, LAS unsigned char* lds) {
    int tid_ = threadIdx.x; asm volatile("" : "+v"(tid_)); const int tid = tid_, lane = tid & 63, wave = __builtin_amdgcn_readfirstlane(tid >> 6), G = gridDim.x, bid = blockIdx.x;
    unsigned char* ws = uni_ptr(args.ws); const int ib = LBASE(L) + 4 + NMIX(L);
    const float* X = args.out; bf16* H = (bf16*)(ws + WS_ACT + A_H); const float* MOD = (const float*)(ws + WS_MOD) + (size_t)L * 2 * 6144;
    const float* nf = args.in[LBASE(L) + 1]; const float* rb = args.in[ib + 1];
    const bf16* RH = (const bf16*)(ws + WS_RTR + (size_t)L * 196608); const bf16* RLo = RH + 49152;
    int* EID = (int*)(ws + WS_EID); float* GATE = (float*)(ws + WS_GATE); int* CNT = (int*)(ws + WS_CNT);
    LAS float* gs = (LAS float*)lds; LAS float* sh = gs + 1024; LAS int* lcnt = (LAS int*)(lds + 8192);
    LAS float* ssp = (LAS float*)(lds + 8448);
    LAS float* part = (LAS float*)(lds + 9472);
    LAS float* logit = (LAS float*)(lds + 58624);
    const int r = lane & 15, q = lane >> 4, kw = 128 * wave;
    bf16x8 bh[4][3], bl[4][3];
#pragma unroll
    for (int ks = 0; ks < 4; ++ks)
#pragma unroll
        for (int nt = 0; nt < 3; ++nt) { bh[ks][nt] = *(const bf16x8*)(RH + (size_t)(nt * 16 + r) * 1024 + kw + 32 * ks + 8 * q); bl[ks][nt] = *(const bf16x8*)(RLo + (size_t)(nt * 16 + r) * 1024 + kw + 32 * ks + 8 * q); }
    for (int item = bid; item < T / 128; item += G) {
        const int r0 = item * 128, b = r0 / SEQ; const float* m = MOD + (size_t)b * 6144;
        __syncthreads();
        for (int k = tid; k < 1024; k += NTHR) { gs[k] = nf[k] * (1.0f + m[4096 + k]); sh[k] = m[3072 + k]; }
        if (tid < 32) lcnt[tid] = 0;
        f32x4 xv[8];
        { const float* xp = X + (size_t)(r0 + r) * 1024 + kw + 8 * q;
#pragma unroll
          for (int ks = 0; ks < 4; ++ks) { xv[2 * ks] = *(const f32x4*)(xp + 32 * ks); xv[2 * ks + 1] = *(const f32x4*)(xp + 32 * ks + 4); } }
        __syncthreads();
#pragma unroll 1
        for (int g = 0; g < 8; ++g) {
            const int row = r0 + 16 * g + r, pb = g & 1;
            f32x4 xn[8];
            if (g < 7) { const float* xp = X + (size_t)(row + 16) * 1024 + kw + 8 * q;
#pragma unroll
                for (int ks = 0; ks < 4; ++ks) { xn[2 * ks] = *(const f32x4*)(xp + 32 * ks); xn[2 * ks + 1] = *(const f32x4*)(xp + 32 * ks + 4); } }
            else {
#pragma unroll
                for (int i = 0; i < 8; ++i) xn[i] = xv[i]; }
            float ss = 0.f;
#pragma unroll
            for (int i = 0; i < 8; ++i) ss += (xv[i][0] * xv[i][0] + xv[i][1] * xv[i][1]) + (xv[i][2] * xv[i][2] + xv[i][3] * xv[i][3]);
            ss += __shfl_xor(ss, 16); ss += __shfl_xor(ss, 32);
            if (q == 0) ssp[(pb * 8 + wave) * 16 + r] = ss;
            __syncthreads();
            float tot = 0.f;
#pragma unroll
            for (int w = 0; w < 8; ++w) tot += ssp[(pb * 8 + w) * 16 + r];
            const float rstd = __builtin_amdgcn_rsqf(tot * (1.0f / 1024.0f) + EPS);
            f32x4 acc[3];
#pragma unroll
            for (int nt = 0; nt < 3; ++nt) acc[nt] = (f32x4){0.f, 0.f, 0.f, 0.f};
#pragma unroll
            for (int ks = 0; ks < 4; ++ks) { const int k0 = kw + 32 * ks + 8 * q;
                const f32x4 g0 = *(const LAS f32x4*)(gs + k0), g1 = *(const LAS f32x4*)(gs + k0 + 4), s0 = *(const LAS f32x4*)(sh + k0), s1 = *(const LAS f32x4*)(sh + k0 + 4);
                const f32x4 h0 = xv[2 * ks] * rstd * g0 + s0, h1 = xv[2 * ks + 1] * rstd * g1 + s1;
                v4u hi; hi.x = pk2(h0[0], h0[1]); hi.y = pk2(h0[2], h0[3]); hi.z = pk2(h1[0], h1[1]); hi.w = pk2(h1[2], h1[3]);
                v4u lo; lo.x = pk2(h0[0] - bflo(hi.x), h0[1] - bfhi(hi.x)); lo.y = pk2(h0[2] - bflo(hi.y), h0[3] - bfhi(hi.y)); lo.z = pk2(h1[0] - bflo(hi.z), h1[1] - bfhi(hi.z)); lo.w = pk2(h1[2] - bflo(hi.w), h1[3] - bfhi(hi.w));
                *(v4u*)(H + (size_t)row * 1024 + k0) = hi;
                const bf16x8 ahi = __builtin_bit_cast(bf16x8, hi), alo = __builtin_bit_cast(bf16x8, lo);
#pragma unroll
                for (int nt = 0; nt < 3; ++nt) { acc[nt] = __builtin_amdgcn_mfma_f32_16x16x32_bf16(bh[ks][nt], ahi, acc[nt], 0, 0, 0); acc[nt] = __builtin_amdgcn_mfma_f32_16x16x32_bf16(bl[ks][nt], ahi, acc[nt], 0, 0, 0); acc[nt] = __builtin_amdgcn_mfma_f32_16x16x32_bf16(bh[ks][nt], alo, acc[nt], 0, 0, 0); } }
#pragma unroll
            for (int nt = 0; nt < 3; ++nt) *(LAS f32x4*)(part + ((pb * 8 + wave) * 16 + r) * 48 + 16 * nt + 4 * q) = acc[nt];
            __syncthreads();
            for (int o = tid; o < 768; o += NTHR) { float sacc = 0.f;
#pragma unroll
                for (int w = 0; w < 8; ++w) sacc += part[(pb * 8 + w) * 768 + o];
                const int n = o % 48; logit[pb * 768 + o] = sacc + (n < 36 ? rb[n] : 0.f); }
            __syncthreads();
            if (wave == g && lane < 16) { float lg[36]; const int trow = r0 + 16 * g + lane;
#pragma unroll
                for (int i = 0; i < 9; ++i) { const f32x4 v = *(const LAS f32x4*)(logit + pb * 768 + lane * 48 + 4 * i); lg[4 * i] = v[0]; lg[4 * i + 1] = v[1]; lg[4 * i + 2] = v[2]; lg[4 * i + 3] = v[3]; }
                int gsel = 0; float gm = lg[0];
#pragma unroll
                for (int i = 1; i < 4; ++i) if (lg[i] > gm) { gm = lg[i]; gsel = i; }
                float gsum = 0.f;
#pragma unroll
                for (int i = 0; i < 4; ++i) gsum += expf(lg[i] - gm);
                const float pg = 1.0f / gsum;
                float le[8];
#pragma unroll
                for (int i = 0; i < 8; ++i) le[i] = gsel == 0 ? lg[4 + i] : (gsel == 1 ? lg[12 + i] : (gsel == 2 ? lg[20 + i] : lg[28 + i]));
                int j1 = 0; float m1 = le[0];
#pragma unroll
                for (int i = 1; i < 8; ++i) if (le[i] > m1) { m1 = le[i]; j1 = i; }
                int j2 = -1; float m2 = -INFINITY;
#pragma unroll
                for (int i = 0; i < 8; ++i) if (i != j1 && le[i] > m2) { m2 = le[i]; j2 = i; }
                const float p2 = expf(m2 - m1), den = 1.0f / (1.0f + p2);
                const int e1 = gsel * 8 + j1, e2 = gsel * 8 + j2;
                EID[(size_t)trow * 2] = e1; EID[(size_t)trow * 2 + 1] = e2; GATE[(size_t)trow * 2] = pg * den; GATE[(size_t)trow * 2 + 1] = pg * p2 * den;
                __hip_atomic_fetch_add(lcnt + e1, 1, __ATOMIC_RELAXED, __HIP_MEMORY_SCOPE_WORKGROUP); __hip_atomic_fetch_add(lcnt + e2, 1, __ATOMIC_RELAXED, __HIP_MEMORY_SCOPE_WORKGROUP); }
#pragma unroll
            for (int i = 0; i < 8; ++i) xv[i] = xn[i];
        }
        __syncthreads();
        if (tid < 32) CNT[item * 32 + tid] = lcnt[tid];
        if (item == 0 && tid < 128) *(v4u*)(H + (size_t)T * 1024 + 8 * tid) = (v4u){0u, 0u, 0u, 0u};
    }
}
__device__ __forceinline__ void phase_moe_scatter(const Args& args, LAS unsigned char* lds) {
    int tid_ = threadIdx.x; asm volatile("" : "+v"(tid_)); const int tid = tid_, lane = tid & 63, wave = __builtin_amdgcn_readfirstlane(tid >> 6), G = gridDim.x, bid = blockIdx.x; (void)tid; (void)lane; (void)wave;
    unsigned char* ws = uni_ptr(args.ws);
    const int* EID = (const int*)(ws + WS_EID); int* SLOT = (int*)(ws + WS_SLOT); const int* CNT = (const int*)(ws + WS_CNT); int* TILEE = (int*)(ws + WS_TILEE); int* TOK = (int*)(ws + WS_TOK);
    LAS int* tot = (LAS int*)lds; LAS int* before = tot + 32; LAS int* pstart = tot + 64; LAS int* lcnt = tot + 96; LAS int* lslot = tot + 128; LAS int* psum = tot + 384; LAS int* pbef = tot + 896;
    for (int item = bid; item < T / 128; item += G) {
        const int r0 = item * 128;
        __syncthreads();
        { const int e = tid & 31, part = tid >> 5; int s_ = 0, b_ = 0; int cv[16];
#pragma unroll
          for (int i = 0; i < 16; ++i) cv[i] = CNT[(part * 16 + i) * 32 + e];
#pragma unroll
          for (int i = 0; i < 16; ++i) { s_ += cv[i]; b_ += (part * 16 + i < item) ? cv[i] : 0; }
          psum[part * 32 + e] = s_; pbef[part * 32 + e] = b_; }
        __syncthreads();
        if (tid < 32) { int t_ = 0, b_ = 0;
#pragma unroll
            for (int p = 0; p < 16; ++p) { t_ += psum[p * 32 + tid]; b_ += pbef[p * 32 + tid]; }
            tot[tid] = t_; before[tid] = b_; lcnt[tid] = 0; }
        __syncthreads();
        if (tid == 0) { int ps = 0; for (int e = 0; e < 32; ++e) { pstart[e] = ps; ps += (tot[e] + 255) & ~255; }
            if (item == 0) { TILEE[0] = ps >> 8; for (int e = 0; e < 32; ++e) { const int t0 = pstart[e] >> 8, nt = ((tot[e] + 255) >> 8); for (int i = 0; i < nt; ++i) TILEE[16 + t0 + i] = e; } } }
        __syncthreads();
        if (tid < 256) { const int e = EID[(size_t)r0 * 2 + tid]; const int rank = __hip_atomic_fetch_add(lcnt + e, 1, __ATOMIC_RELAXED, __HIP_MEMORY_SCOPE_WORKGROUP); const int slot = pstart[e] + before[e] + rank; SLOT[(size_t)r0 * 2 + tid] = slot; lslot[tid] = slot; }
        __syncthreads();
        if (tid < 256) TOK[lslot[tid]] = r0 + (tid >> 1);
        { const int e = item & 31, part = item >> 5; const int p0 = pstart[e] + tot[e], npad = ((tot[e] + 255) & ~255) - tot[e];
          if (tid < 32 && part * 32 + tid < npad) TOK[p0 + part * 32 + tid] = T; }
    }
}
__device__ __forceinline__ void phase_moe_combine(const Args& args, int L) {
    int tid_ = threadIdx.x; asm volatile("" : "+v"(tid_)); const int tid = tid_, lane = tid & 63, wave = __builtin_amdgcn_readfirstlane(tid >> 6), G = gridDim.x, bid = blockIdx.x; (void)tid;
    unsigned char* ws = uni_ptr(args.ws); float* X = args.out; const bf16* Y = (const bf16*)(ws + WS_ACT + A_Y); bf16* H = (bf16*)(ws + WS_ACT + A_H);
    const int* SLOT = (const int*)(ws + WS_SLOT); const float* GATE = (const float*)(ws + WS_GATE); const float* MOD = (const float*)(ws + WS_MOD);
    const int NW = G * NWAVES;
    for (int t = bid * NWAVES + wave; t < T; t += 2 * NW) {
        const int tb = t + NW; const bool two = tb < T; const int t1 = two ? tb : t;
        const int ta[2] = {t, t1};
        f32x4 xv[2][4], gg[2][4]; v2u y0[2][4], y1[2][4]; float g0[2], g1[2];
#pragma unroll
        for (int k = 0; k < 2; ++k) { const int tt = ta[k]; const int b = tt / SEQ;
            const int s0 = SLOT[(size_t)tt * 2], s1 = SLOT[(size_t)tt * 2 + 1]; g0[k] = GATE[(size_t)tt * 2]; g1[k] = GATE[(size_t)tt * 2 + 1];
            const float* gf = MOD + (size_t)(L * 2 + b) * 6144 + 5120;
#pragma unroll
            for (int j = 0; j < 4; ++j) { const int c = 4 * lane + 256 * j; xv[k][j] = *(const f32x4*)(X + (size_t)tt * 1024 + c); gg[k][j] = *(const f32x4*)(gf + c);
                y0[k][j] = *(const v2u*)(Y + (size_t)s0 * 1024 + c); y1[k][j] = *(const v2u*)(Y + (size_t)s1 * 1024 + c); } }
#pragma unroll
        for (int k = 0; k < 2; ++k) { if (k == 1 && !two) break; const int tt = ta[k]; const int b = tt / SEQ; f32x4 v[4];
#pragma unroll
            for (int j = 0; j < 4; ++j) { const int c = 4 * lane + 256 * j; f32x4 mo;
                mo[0] = g0[k] * bflo(y0[k][j].x) + g1[k] * bflo(y1[k][j].x); mo[1] = g0[k] * bfhi(y0[k][j].x) + g1[k] * bfhi(y1[k][j].x); mo[2] = g0[k] * bflo(y0[k][j].y) + g1[k] * bflo(y1[k][j].y); mo[3] = g0[k] * bfhi(y0[k][j].y) + g1[k] * bfhi(y1[k][j].y);
                v[j] = xv[k][j] + gg[k][j] * mo; *(f32x4*)(X + (size_t)tt * 1024 + c) = v[j]; }
            if (L < 3) { const float* m = MOD + (size_t)((L + 1) * 2 + b) * 6144; norm_store_row(v, args.in[LBASE(L + 1)], m, m + 1024, H + (size_t)tt * 1024, lane); } }
    }
}

constexpr int N_PHASES = 37;

#ifndef DUP_MASK
#define DUP_MASK 0
#endif
#define PHASE(k) if ((lo <= (k) && (k) < hi) && ((started ? (xcd_barrier(bar), 0) : 0), started = true, true))
#define NREP(g) (1 + ((DUP_MASK >> (g)) & 1))
#define PHASE_G(k, g) PHASE(k) for (int rep_ = 0; rep_ < NREP(g); ++rep_, ((rep_ < NREP(g)) ? (xcd_barrier(bar), 0) : 0))
template <int L> __device__ __forceinline__ void run_layer(const Args& args, LAS unsigned char* lds, const XcdBarrier& bar, bool& started, const int lo, const int hi) {
    const int G = gridDim.x, bid = blockIdx.x;
    unsigned char* ws = uni_ptr(args.ws);
    const float* MOD = (const float*)(ws + WS_MOD);
    bf16* Hb = (bf16*)(ws + WS_ACT + A_H);

        const int pb = (L == 0) ? 1 : (L == 1 ? 10 : (L == 2 ? 21 : 29));
        const float* xsrc = (L == 0) ? args.in[0] : (const float*)args.out;
        const float* gate_m = MOD + (size_t)L * 2 * 6144 + 2048;
        int mb;
        if constexpr (L == 0 || L == 3) {
            int g0 = pb;
            if (L == 0) { PHASE_G(pb, 8) { phase_norm0(args); } g0 = pb + 1; }
            const bf16* Win = (const bf16*)(ws + WS_WMIX + (L == 0 ? WMIX_GM_IN0 : WMIX_GM_IN3)); const bf16* Wout = (const bf16*)(ws + WS_WMIX + (L == 0 ? WMIX_GM_OUT0 : WMIX_GM_OUT3));
            PHASE_G(g0, 1) { pg8::Gemm g{Hb, Win, T, 2048, 1024}; pg8::StaticOrder S; S.init(T, 2048, G, bid);
                EpiGm1 E{(bf16*)(ws + WS_ACT + A_U), (bf16*)(ws + WS_ACT + A_V), (float*)(ws + WS_VSSP)};
                pg8::gemm_phase<EpiGm1, pg8::StaticOrder, true, true>(lds, g, S, E); }
            PHASE_G(g0 + 1, 2) { phase_gm_spatial(args, L, lds); }
            PHASE_G(g0 + 2, (L == 0 ? 1 : 31)) { pg8::Gemm g{(const bf16*)(ws + WS_ACT + A_GATED), Wout, T, 1024, 1024}; pg8::StaticOrder S; S.init(T, 1024, G, bid);
                EpiRes E{xsrc, args.out, gate_m};
                pg8::gemm_phase<EpiRes, pg8::StaticOrder, true, true>(lds, g, S, E); }
            mb = g0 + 3;
        } else if constexpr (L == 1) {
            PHASE_G(pb, 1) { pg8::Gemm g{Hb, (const bf16*)(ws + WS_WMIX + WMIX_DN_IN), T, 3328, 1024}; pg8::StaticOrder S; S.init(T, 3328, G, bid);
                EpiDn1 E{(bf16*)(ws + WS_ACT + A_QKV), (bf16*)(ws + WS_ACT + A_Z), (float*)(ws + WS_BA)};
                pg8::gemm_phase<EpiDn1, pg8::StaticOrder, true, true>(lds, g, S, E); }
            PHASE_G(pb + 1, 3) { phase_dn_prep(args, lds); }
            PHASE_G(pb + 2, 4) { phase_dn_chunk(args, lds); }
            PHASE_G(pb + 3, 5) { phase_dn_scan(args, lds); }
            PHASE_G(pb + 4, 3) { phase_dn_ogate(args); }
            PHASE(pb + 5) { pg8::Gemm g{Hb, (const bf16*)(ws + WS_WMIX + WMIX_DN_OUT), T, 1024, 1024}; pg8::StaticOrder S; S.init(T, 1024, G, bid);
                EpiRes E{xsrc, args.out, gate_m};
                pg8::gemm_phase<EpiRes, pg8::StaticOrder, true, true>(lds, g, S, E); }
            mb = pb + 6;
        } else {
            PHASE_G(pb, 1) { pg8::Gemm g{Hb, (const bf16*)(ws + WS_WMIX + WMIX_SWA_IN), T, 1536, 1024}; pg8::StaticOrder S; S.init(T, 1536, G, bid);
                EpiBf E{(bf16*)(ws + WS_ACT + A_QKV), 1536, 0xffff};
                pg8::gemm_phase<EpiBf, pg8::StaticOrder, true, true>(lds, g, S, E); }
            PHASE_G(pb + 1, 2) { phase_swa_attn(args, lds); }
            PHASE(pb + 2) { pg8::Gemm g{Hb, (const bf16*)(ws + WS_WMIX + WMIX_SWA_OUT), T, 1024, 1024}; pg8::StaticOrder S; S.init(T, 1024, G, bid);
                EpiRes E{xsrc, args.out, gate_m};
                pg8::gemm_phase<EpiRes, pg8::StaticOrder, true, true>(lds, g, S, E); }
            mb = pb + 3;
        }
        PHASE_G(mb, 6) { phase_moe_router(args, L, lds); }
        PHASE_G(mb + 1, 9) { phase_moe_scatter(args, lds); }
        const int* TILEE = (const int*)(ws + WS_TILEE);
        PHASE_G(mb + 2, 7) { const int ntiles = TILEE[0]; pg8::Gemm g{Hb, (const bf16*)(ws + WS_W + (size_t)L * 96 * MiB), MAXROWS, 1024, 1024};
            MoeOrder S; S.init(TILEE + 16, ntiles, G, bid); EpiMoe1 E{(bf16*)(ws + WS_ACT + A_ACTV)};
            LAS int* lidx = (LAS int*)(lds + LDSCTL_OFF + 2048); const int* TOK = (const int*)(ws + WS_TOK);
            __syncthreads();
            for (int ui = 0; ui < 5; ++ui) { pg8::Unit u; if (S.next(ui, u) && threadIdx.x < 256) lidx[ui * 256 + threadIdx.x] = TOK[u.pm * 256 + threadIdx.x]; }
            __syncthreads();
            pg8::gemm_phase_gather<EpiMoe1, MoeOrder, true, true>(lds, g, S, E, lidx); }
        PHASE_G(mb + 3, 7) { const int ntiles = TILEE[0]; pg8::Gemm g{(const bf16*)(ws + WS_ACT + A_ACTV), (const bf16*)(ws + WS_W + (size_t)L * 96 * MiB + 64 * MiB), MAXROWS, 1024, 512};
            MoeOrder S; S.init(TILEE + 16, ntiles, G, bid); EpiBf E{(bf16*)(ws + WS_ACT + A_Y), 1024, 3};
            pg8::gemm_phase<EpiBf, MoeOrder, true, true>(lds, g, S, E); }
        PHASE(mb + 4) { phase_moe_combine(args, L); }

}
__global__ void __launch_bounds__(NTHR, 2) fwd_kernel(Args args) {
    extern __shared__ __attribute__((aligned(16))) unsigned char lds_raw[];
    LAS unsigned char* lds = (LAS unsigned char*)lds_raw;
    const int tid = threadIdx.x;
    unsigned char* ws = uni_ptr(args.ws);
    for (int u = tid; u < (LDS_BYTES - LDSCTL_OFF) / 4; u += NTHR) ((LAS unsigned*)(lds + LDSCTL_OFF))[u] = 0u;
    __syncthreads();
    volatile LAS unsigned* MISC = (volatile LAS unsigned*)(lds + MISC_OFF);
    XcdBarrier bar = xcd_barrier_post((unsigned*)(ws + WS_CTL) + 4096 + (size_t)args.li * XCD_BAR_WORDS, MISC + 8);
    const int lo = args.ph_lo, hi = args.ph_hi; bool started = false;
    const float* MOD = (const float*)(ws + WS_MOD);
    bf16* Hb = (bf16*)(ws + WS_ACT + A_H);

    PHASE_G(0, 0) { phase_prologue(args, lds); }

    run_layer<0>(args, lds, bar, started, lo, hi);
    run_layer<1>(args, lds, bar, started, lo, hi);
    run_layer<2>(args, lds, bar, started, lo, hi);
    run_layer<3>(args, lds, bar, started, lo, hi);
#undef PHASE
#undef PHASE_G
}

extern "C" void kernel_launch(void* const* d_in, const int* in_sizes, int n_in, void* d_out, int out_size, void* d_ws, size_t ws_size, hipStream_t stream) {
    static int grid = 0;
    if (grid == 0) {
        if (n_in != N_IN || in_sizes[0] != T * D || out_size != T * D || ws_size < WS_END) { fprintf(stderr, "kernel_launch: unexpected shapes (n_in %d, in0 %d, out %d, ws %zu < %zu)\n", n_in, n_in > 0 ? in_sizes[0] : -1, out_size, ws_size, (size_t)WS_END); grid = -1; return; }
        int dev = 0, cus = 0, per_cu = 0;
        if (hipGetDevice(&dev) != hipSuccess || hipDeviceGetAttribute(&cus, hipDeviceAttributeMultiprocessorCount, dev) != hipSuccess) { grid = -1; return; }
        if (hipFuncSetAttribute((const void*)fwd_kernel, hipFuncAttributeMaxDynamicSharedMemorySize, LDS_BYTES) != hipSuccess) { fprintf(stderr, "kernel_launch: hipFuncSetAttribute failed\n"); grid = -1; return; }
        if (hipOccupancyMaxActiveBlocksPerMultiprocessor(&per_cu, (const void*)fwd_kernel, NTHR, LDS_BYTES) != hipSuccess || per_cu < 1) fprintf(stderr, "kernel_launch: occupancy query reports %d\n", per_cu);
        (void)hipGetLastError();
        grid = cus;
    }
    if (grid < 0) return;
    if (hipMemsetAsync((char*)d_ws + WS_CTL, 0, CTL_ZERO_BYTES, stream) != hipSuccess) return;
    Args a{};
    for (int i = 0; i < N_IN; ++i) a.in[i] = (const float*)d_in[i];
    a.out = (float*)d_out; a.ws = (unsigned char*)d_ws; a.pad = 0;
#if MK_LAUNCH_MODE == 1
    a.ph_lo = 0; a.ph_hi = N_PHASES; a.li = 0;
    hipLaunchKernelGGL(fwd_kernel, dim3(grid), dim3(NTHR), LDS_BYTES, stream, a);
#else
#ifndef PROBE_PHASE
#define PROBE_PHASE -1
#endif
    for (int p = 0; p < N_PHASES; ++p) { a.ph_lo = p; a.ph_hi = p + 1; a.li = 0;
        for (int rep = 0; rep < (p == PROBE_PHASE ? 2 : 1); ++rep) hipLaunchKernelGGL(fwd_kernel, dim3(grid), dim3(NTHR), LDS_BYTES, stream, a); }
#endif
}
```

```cpp
#include <hip/hip_runtime.h>
#include <cstdio>
#include <cstdint>
#ifndef MK_LAUNCH_MODE
#define MK_LAUNCH_MODE 1
#endif
namespace pg8 {
#define PG8_LAS __attribute__((address_space(3)))
typedef unsigned short bf16_t;
typedef short bf16x8 __attribute__((ext_vector_type(8)));
typedef float f32x4 __attribute__((ext_vector_type(4)));
typedef unsigned u32x4 __attribute__((ext_vector_type(4)));
constexpr int BM = 256, BK = 64, HALF = 128, HTB = HALF * BK * 2  , STAGE_BYTES = 8 * HTB, NXCD = 8, WGM = 8;

__host__ __device__ __forceinline__ int lds_byte(int r, int c) { const int st = (r >> 4) * 2 + (c >> 5), rr = r & 15, cc = c & 31, ob = rr * 64 + cc * 2; return st * 1024 + (ob ^ (((ob >> 9) & 1) << 5)); }
__host__ __device__ __forceinline__ void stage_rc(int b, int& R, int& C) { const int st = b / 1024, sb = b % 1024, swz = sb ^ (((sb >> 9) & 1) << 5); R = (st >> 1) * 16 + swz / 64; C = (st & 1) * 32 + (swz % 64) / 2; }
__host__ __device__ __forceinline__ int perm32(int rho) { const int n = rho >> 4, i = rho & 15; return 8 * (i >> 2) + 4 * n + (i & 3); }

struct Unit { int pm, pn; };
struct Gemm { const bf16_t* A; const bf16_t* Bt; int M, N, K; };

struct StaticOrder {
    int nM, nN, nwg, G, c;
    __host__ __device__ void init(int M, int N, int G_, int c_) { nM = M / BM; nN = N / BM; nwg = nM * nN; G = G_; c = c_; }
    __host__ __device__ bool next(int i, Unit& u) const {
        const long L = (long)i * G + c; if (L >= nwg) return false;
        int wgid = (int)L; { const int q = nwg / NXCD, r = nwg % NXCD, xcd = wgid % NXCD, off = wgid / NXCD; wgid = (xcd < r ? xcd * (q + 1) : r * (q + 1) + (xcd - r) * q) + off; }
        const int nig = WGM * nN, gid = wgid / nig, fm = gid * WGM, gsz = (nM - fm) < WGM ? (nM - fm) : WGM;
        u.pm = fm + ((wgid % nig) % gsz); u.pn = (wgid % nig) / gsz; return true;
    }
    __device__ __forceinline__ void a_ready(const Unit&) const {}
    __device__ __forceinline__ void done(const Unit&) const {}
};
typedef float f32x2_ __attribute__((ext_vector_type(2))); typedef __bf16 bf16x2_ __attribute__((ext_vector_type(2)));
__device__ __forceinline__ unsigned cvt_pk_bf16(float lo, float hi) { const f32x2_ v = {lo, hi}; return __builtin_bit_cast(unsigned, __builtin_convertvector(v, bf16x2_)); }
typedef float f32x2 __attribute__((ext_vector_type(2)));
typedef int pg8_v8i __attribute__((ext_vector_type(8))); typedef int pg8_v4i __attribute__((ext_vector_type(4)));
struct pg8_FragA { bf16x8 v[4][2]; pg8_v8i w[4]; }; struct pg8_FragB { bf16x8 v[2][2]; pg8_v8i w[2]; };
__device__ __forceinline__ pg8_v8i pg8_cat(bf16x8 lo, bf16x8 hi) { const pg8_v4i a = __builtin_bit_cast(pg8_v4i, lo), c = __builtin_bit_cast(pg8_v4i, hi); return (pg8_v8i){a[0], a[1], a[2], a[3], c[0], c[1], c[2], c[3]}; }
__device__ __forceinline__ unsigned pg8_touch_lines(const char* base, int nlines) {
    unsigned a = 0; for (int l = threadIdx.x; l < nlines; l += 512) a += *(const unsigned*)(base + (size_t)l * 128); return a;
}
__device__ __forceinline__ unsigned pg8_touch_rows(const char* base, const PG8_LAS int* idx, int rowbytes) {
    const int lpr = rowbytes >> 7; unsigned a = 0; for (int l = threadIdx.x; l < 256 * lpr; l += 512) a += *(const unsigned*)(base + (size_t)idx[l / lpr] * rowbytes + (size_t)(l % lpr) * 128); return a;
}
template <class Epi, class Sched, bool ALIGN_EPI = false, bool SP2 = false, bool FP8 = false, bool TOUCH = false, bool BT = false, bool AT = false>
__device__ __forceinline__ void gemm_phase(PG8_LAS unsigned char* lds, const Gemm g, const Sched& S, const Epi& E) {
    const int tid = threadIdx.x, wid = __builtin_amdgcn_readfirstlane(tid >> 6), lane = tid & 63, wr = wid >> 2, wc = wid & 3, fr = lane & 15, fq = lane >> 4;
    const int K = g.K, nt = K / BK;
    unsigned voffA[2], voffB[2];
#pragma unroll
    for (int i = 0; i < 2; ++i) { int R, C; stage_rc(tid * 16 + i * 8192, R, C); const int Rb = Epi::PERM ? ((R & ~31) + perm32(R & 31)) : R;
        voffA[i] = (unsigned)(R * (AT ? 64 : K) + C) * 2u; voffB[i] = (unsigned)(Rb * (BT ? 64 : K) + C) * 2u; }
    const size_t kstep = (size_t)(BK * 2);
    const size_t hstep = (size_t)HALF * K * 2;
    const size_t tstep = 2 * hstep;
    const size_t kstepB = BT ? (size_t)32768 : kstep, hstepB = BT ? (size_t)16384 : hstep;
    const size_t kstepA = AT ? (size_t)32768 : kstep, hstepA = AT ? (size_t)16384 : hstep;
    const unsigned ldsw = (unsigned)wid * 1024u;
    const int aoff = lds_byte(wr * 64 + fr, fq * 8), boff = lds_byte(wc * 32 + fr, fq * 8);
#define PG8_SA(b, h) (((b) * 2 + (h)) * HTB)
#define PG8_SB(b, h) ((4 + (b) * 2 + (h)) * HTB)
#define PG8_STAGE(bufoff, gbase, voff) do { _Pragma("unroll") for (int _i = 0; _i < 2; ++_i) \
        __builtin_amdgcn_global_load_lds((const unsigned*)((const char*)(gbase) + (voff)[_i]), (PG8_LAS unsigned*)(lds + (bufoff) + ldsw + _i * 8192), 16, 0, 0); } while (0)
#define PG8_LDA(dst, b, h) do { _Pragma("unroll") for (int m = 0; m < 4; ++m) { if constexpr (FP8) dst.w[m] = pg8_cat(*(const PG8_LAS bf16x8*)(lds + PG8_SA(b, h) + aoff + m * 2048), *(const PG8_LAS bf16x8*)(lds + PG8_SA(b, h) + aoff + m * 2048 + 1024)); \
        else { _Pragma("unroll") for (int k = 0; k < 2; ++k) dst.v[m][k] = *(const PG8_LAS bf16x8*)(lds + PG8_SA(b, h) + aoff + m * 2048 + k * 1024); } } } while (0)
#define PG8_LDB(dst, b, h) do { _Pragma("unroll") for (int n = 0; n < 2; ++n) { if constexpr (FP8) dst.w[n] = pg8_cat(*(const PG8_LAS bf16x8*)(lds + PG8_SB(b, h) + boff + n * 2048), *(const PG8_LAS bf16x8*)(lds + PG8_SB(b, h) + boff + n * 2048 + 1024)); \
        else { _Pragma("unroll") for (int k = 0; k < 2; ++k) dst.v[n][k] = *(const PG8_LAS bf16x8*)(lds + PG8_SB(b, h) + boff + n * 2048 + k * 1024); } } } while (0)
#define PG8_MMA(ai, bj, At, Bt) do { __builtin_amdgcn_s_setprio(1); if constexpr (FP8) { _Pragma("unroll") for (int m = 0; m < 4; ++m) _Pragma("unroll") for (int n = 0; n < 2; ++n) \
        asm volatile("v_mfma_f32_16x16x128_f8f6f4 %0, %1, %2, %0" : "+v"(acc[ai][bj][m][n]) : "v"(Bt.w[n]), "v"(At.w[m])); } \
        else { _Pragma("unroll") for (int m = 0; m < 4; ++m) _Pragma("unroll") for (int n = 0; n < 2; ++n) _Pragma("unroll") for (int k = 0; k < 2; ++k) \
        acc[ai][bj][m][n] = __builtin_amdgcn_mfma_f32_16x16x32_bf16(Bt.v[n][k], At.v[m][k], acc[ai][bj][m][n], 0, 0, 0); } __builtin_amdgcn_s_setprio(0); } while (0)
#define PG8_WAIT_V(n) asm volatile("s_waitcnt vmcnt(" #n ")" ::: "memory")
#define PG8_WAIT_L(n) asm volatile("s_waitcnt lgkmcnt(" #n ")" ::: "memory")
#define PG8_BAR __builtin_amdgcn_s_barrier()
#define PG8_SCHED __builtin_amdgcn_sched_barrier(0)
    Unit cur, nxt; int ui = 0;
    if (!S.next(0, cur)) return;
    if constexpr (TOUCH) { unsigned a_ = pg8_touch_lines((const char*)g.A + (size_t)cur.pm * (512 * (size_t)g.K), 4 * g.K) + pg8_touch_lines((const char*)g.Bt + (size_t)cur.pn * (512 * (size_t)g.K), 4 * g.K);
        Unit u1_; if (S.next(1, u1_)) a_ += pg8_touch_lines((const char*)g.A + (size_t)u1_.pm * (512 * (size_t)g.K), 4 * g.K) + pg8_touch_lines((const char*)g.Bt + (size_t)u1_.pn * (512 * (size_t)g.K), 4 * g.K);
        asm volatile("" :: "v"(a_)); }
    f32x4 acc[2][2][4][2];
#pragma unroll
    for (int a = 0; a < 2; ++a)
#pragma unroll
        for (int b = 0; b < 2; ++b)
#pragma unroll
            for (int m = 0; m < 4; ++m)
#pragma unroll
                for (int n = 0; n < 2; ++n) acc[a][b][m][n] = (f32x4){0.f, 0.f, 0.f, 0.f};
    pg8_FragA At; pg8_FragB B0, B1;
    const char* cA = (const char*)g.A + (size_t)cur.pm * tstep; const char* cB = (const char*)g.Bt + (size_t)cur.pn * tstep;
    S.a_ready(cur);
    if constexpr (SP2) {
        PG8_STAGE(PG8_SB(0, 0), cB, voffB); PG8_STAGE(PG8_SB(0, 1), cB + hstepB, voffB); PG8_STAGE(PG8_SA(0, 0), cA, voffA); PG8_STAGE(PG8_SA(0, 1), cA + hstepA, voffA);
        if (wr == 1) PG8_BAR;
        PG8_WAIT_V(2); PG8_BAR;
        PG8_STAGE(PG8_SB(1, 0), cB + kstepB, voffB); PG8_STAGE(PG8_SA(1, 0), cA + kstepA, voffA); PG8_STAGE(PG8_SB(1, 1), cB + hstepB + kstepB, voffB);
        PG8_WAIT_V(6); PG8_BAR;
    } else {
        PG8_STAGE(PG8_SB(0, 0), cB, voffB); PG8_STAGE(PG8_SA(0, 0), cA, voffA); PG8_STAGE(PG8_SB(0, 1), cB + hstepB, voffB); PG8_STAGE(PG8_SA(0, 1), cA + hstepA, voffA);
        if (wr == 1) PG8_BAR;
        PG8_WAIT_V(4); PG8_BAR;
        PG8_STAGE(PG8_SB(1, 0), cB + kstepB, voffB); PG8_STAGE(PG8_SA(1, 0), cA + kstepA, voffA); PG8_STAGE(PG8_SB(1, 1), cB + hstepB + kstepB, voffB);
        PG8_WAIT_V(6); PG8_BAR;
    }
    for (;;) {
        const bool has_next = S.next(ui + 1, nxt);
        const char* nA = has_next ? (const char*)g.A + (size_t)nxt.pm * tstep : cA; const char* nB = has_next ? (const char*)g.Bt + (size_t)nxt.pn * tstep : cB;
#pragma unroll 1
        for (int t = 0; t < nt; t += 2) {
            const bool last = (t == nt - 2);
            const char* a1 = cA + (size_t)(t + 1) * kstepA;
            const char* a2 = last ? nA : cA + (size_t)(t + 2) * kstepA; const char* b2 = last ? nB : cB + (size_t)(t + 2) * kstepB;
            const char* a3 = a2 + kstepA; const char* b3 = b2 + kstepB;
            if (last && has_next) S.a_ready(nxt);
            if constexpr (SP2) {
            PG8_LDB(B0, 0, 0); PG8_LDB(B1, 0, 1); PG8_SCHED; PG8_LDA(At, 0, 0); PG8_STAGE(PG8_SA(1, 1), a1 + hstepA, voffA);
            PG8_WAIT_V(8); PG8_WAIT_L(0); PG8_BAR; PG8_MMA(0, 0, At, B0); PG8_MMA(0, 1, At, B1); PG8_BAR; PG8_SCHED;
            PG8_LDA(At, 0, 1); PG8_STAGE(PG8_SB(0, 0), b2, voffB); PG8_STAGE(PG8_SB(0, 1), b2 + hstepB, voffB); PG8_STAGE(PG8_SA(0, 0), a2, voffA);
            PG8_WAIT_V(8); PG8_WAIT_L(0); PG8_BAR; PG8_MMA(1, 0, At, B0); PG8_MMA(1, 1, At, B1); PG8_BAR; PG8_SCHED;
            PG8_LDB(B0, 1, 0); PG8_LDB(B1, 1, 1); PG8_SCHED; PG8_LDA(At, 1, 0); PG8_STAGE(PG8_SA(0, 1), a2 + hstepA, voffA);
            PG8_WAIT_V(8); PG8_WAIT_L(0); PG8_BAR; PG8_MMA(0, 0, At, B0); PG8_MMA(0, 1, At, B1); PG8_BAR; PG8_SCHED;
            PG8_LDA(At, 1, 1); PG8_STAGE(PG8_SB(1, 0), b3, voffB); PG8_STAGE(PG8_SB(1, 1), b3 + hstepB, voffB); PG8_STAGE(PG8_SA(1, 0), a3, voffA);
            PG8_WAIT_V(8); PG8_WAIT_L(0); PG8_BAR; PG8_MMA(1, 0, At, B0); PG8_MMA(1, 1, At, B1); PG8_BAR; PG8_SCHED;
            } else {
            PG8_LDB(B0, 0, 0); PG8_SCHED; PG8_LDA(At, 0, 0); PG8_STAGE(PG8_SA(1, 1), a1 + hstepA, voffA);
            PG8_WAIT_L(8); PG8_BAR; PG8_WAIT_L(0); PG8_MMA(0, 0, At, B0); PG8_BAR; PG8_SCHED;
            PG8_LDB(B1, 0, 1); PG8_STAGE(PG8_SB(0, 0), b2, voffB);
            PG8_BAR; PG8_WAIT_L(0); PG8_MMA(0, 1, At, B1); PG8_BAR;
            PG8_LDA(At, 0, 1); PG8_STAGE(PG8_SA(0, 0), a2, voffA);
            PG8_BAR; PG8_WAIT_L(0); PG8_MMA(1, 0, At, B0); PG8_BAR; PG8_SCHED;
            PG8_STAGE(PG8_SB(0, 1), b2 + hstepB, voffB);
            PG8_WAIT_V(6); PG8_BAR; PG8_MMA(1, 1, At, B1); PG8_BAR;
            PG8_LDB(B0, 1, 0); PG8_SCHED; PG8_LDA(At, 1, 0); PG8_STAGE(PG8_SA(0, 1), a2 + hstepA, voffA);
            PG8_WAIT_L(8); PG8_BAR; PG8_WAIT_L(0); PG8_MMA(0, 0, At, B0); PG8_BAR; PG8_SCHED;
            PG8_LDB(B1, 1, 1); PG8_STAGE(PG8_SB(1, 0), b3, voffB);
            PG8_BAR; PG8_WAIT_L(0); PG8_MMA(0, 1, At, B1); PG8_BAR;
            PG8_LDA(At, 1, 1); PG8_STAGE(PG8_SA(1, 0), a3, voffA);
            PG8_BAR; PG8_WAIT_L(0); PG8_MMA(1, 0, At, B0); PG8_BAR; PG8_SCHED;
            PG8_STAGE(PG8_SB(1, 1), b3 + hstepB, voffB);
            PG8_WAIT_V(6); PG8_BAR; PG8_MMA(1, 1, At, B1); PG8_BAR;
            }
        }
        if constexpr (ALIGN_EPI) { if (wr == 0) PG8_BAR; }
        if constexpr (FP8) asm volatile("s_nop 15\n\ts_nop 15" ::: "memory");
        if constexpr (!Epi::AFTER_DRAIN) { const int ln_ = (int)__builtin_amdgcn_mbcnt_hi(~0u, __builtin_amdgcn_mbcnt_lo(~0u, 0u)); int fr_ = ln_ & 15, fq_ = ln_ >> 4; asm volatile("" : "+v"(fr_), "+v"(fq_)); E(acc, cur, wr, wc, fr_, fq_); S.done(cur);
            if constexpr (TOUCH) { Unit u2_; if (S.next(ui + 2, u2_)) { const unsigned a_ = pg8_touch_lines((const char*)g.A + (size_t)u2_.pm * (512 * (size_t)g.K), 4 * g.K) + pg8_touch_lines((const char*)g.Bt + (size_t)u2_.pn * (512 * (size_t)g.K), 4 * g.K); asm volatile("" :: "v"(a_)); } } }
        if (!has_next) break;
#pragma unroll
        for (int a = 0; a < 2; ++a)
#pragma unroll
            for (int b = 0; b < 2; ++b)
#pragma unroll
                for (int m = 0; m < 4; ++m)
#pragma unroll
                    for (int n = 0; n < 2; ++n) acc[a][b][m][n] = (f32x4){0.f, 0.f, 0.f, 0.f};
        cur = nxt; cA = nA; cB = nB; ++ui;
        if constexpr (ALIGN_EPI) { if (wr == 1) PG8_BAR; }
    }
    PG8_WAIT_V(0);
    if constexpr (!ALIGN_EPI) { if (wr == 0) PG8_BAR; }
    PG8_BAR;
    if constexpr (Epi::AFTER_DRAIN) { E.fused(acc, cur, wr, wc, fr, fq, lds, wid, lane); S.done(cur); }
#undef PG8_SA
#undef PG8_SB
#undef PG8_STAGE
#undef PG8_LDA
#undef PG8_LDB
#undef PG8_MMA
#undef PG8_WAIT_V
#undef PG8_WAIT_L
#undef PG8_BAR
#undef PG8_SCHED
}

template <class Epi, class Sched, bool ALIGN_EPI = true, bool SP2 = true, bool FP8 = false, bool TOUCH = false, bool BT = false>
__device__ __forceinline__ void gemm_phase_gather(PG8_LAS unsigned char* lds, const Gemm g, const Sched& S, const Epi& E, const PG8_LAS int* lidx) {
    static_assert(SP2 && ALIGN_EPI, "gather variant: SP2 + ALIGN_EPI only");
    const int tid = threadIdx.x, wid = __builtin_amdgcn_readfirstlane(tid >> 6), lane = tid & 63, wr = wid >> 2, wc = wid & 3, fr = lane & 15, fq = lane >> 4;
    const int K = g.K, nt = K / BK;
    unsigned voffB[2]; int RA[2]; unsigned CA[2];
#pragma unroll
    for (int i = 0; i < 2; ++i) { int R, C; stage_rc(tid * 16 + i * 8192, R, C); const int Rb = Epi::PERM ? ((R & ~31) + perm32(R & 31)) : R;
        RA[i] = R; CA[i] = (unsigned)C * 2u; voffB[i] = (unsigned)(Rb * (BT ? 64 : K) + C) * 2u; }
    unsigned ca[2][2], na[2][2];
#define PG8_ROWOFF(dst, ui_) do { _Pragma("unroll") for (int h_ = 0; h_ < 2; ++h_) _Pragma("unroll") for (int i_ = 0; i_ < 2; ++i_) dst[h_][i_] = (unsigned)lidx[(ui_) * 256 + h_ * 128 + RA[i_]] * (unsigned)(K * 2) + CA[i_]; } while (0)
#define PG8_STAGEA(bufoff, kb, vo) do { _Pragma("unroll") for (int _i = 0; _i < 2; ++_i) \
        __builtin_amdgcn_global_load_lds((const unsigned*)((const char*)g.A + (size_t)(kb) + (vo)[_i]), (PG8_LAS unsigned*)(lds + (bufoff) + ldsw + _i * 8192), 16, 0, 0); } while (0)
    const size_t kstep = (size_t)(BK * 2);
    const size_t hstep = (size_t)HALF * K * 2;
    const size_t tstep = 2 * hstep;
    const size_t kstepB = BT ? (size_t)32768 : kstep, hstepB = BT ? (size_t)16384 : hstep;
    const unsigned ldsw = (unsigned)wid * 1024u;
    const int aoff = lds_byte(wr * 64 + fr, fq * 8), boff = lds_byte(wc * 32 + fr, fq * 8);
#define PG8_SA(b, h) (((b) * 2 + (h)) * HTB)
#define PG8_SB(b, h) ((4 + (b) * 2 + (h)) * HTB)
#define PG8_STAGE(bufoff, gbase, voff) do { _Pragma("unroll") for (int _i = 0; _i < 2; ++_i) \
        __builtin_amdgcn_global_load_lds((const unsigned*)((const char*)(gbase) + (voff)[_i]), (PG8_LAS unsigned*)(lds + (bufoff) + ldsw + _i * 8192), 16, 0, 0); } while (0)
#define PG8_LDA(dst, b, h) do { _Pragma("unroll") for (int m = 0; m < 4; ++m) { if constexpr (FP8) dst.w[m] = pg8_cat(*(const PG8_LAS bf16x8*)(lds + PG8_SA(b, h) + aoff + m * 2048), *(const PG8_LAS bf16x8*)(lds + PG8_SA(b, h) + aoff + m * 2048 + 1024)); \
        else { _Pragma("unroll") for (int k = 0; k < 2; ++k) dst.v[m][k] = *(const PG8_LAS bf16x8*)(lds + PG8_SA(b, h) + aoff + m * 2048 + k * 1024); } } } while (0)
#define PG8_LDB(dst, b, h) do { _Pragma("unroll") for (int n = 0; n < 2; ++n) { if constexpr (FP8) dst.w[n] = pg8_cat(*(const PG8_LAS bf16x8*)(lds + PG8_SB(b, h) + boff + n * 2048), *(const PG8_LAS bf16x8*)(lds + PG8_SB(b, h) + boff + n * 2048 + 1024)); \
        else { _Pragma("unroll") for (int k = 0; k < 2; ++k) dst.v[n][k] = *(const PG8_LAS bf16x8*)(lds + PG8_SB(b, h) + boff + n * 2048 + k * 1024); } } } while (0)
#define PG8_MMA(ai, bj, At, Bt) do { __builtin_amdgcn_s_setprio(1); if constexpr (FP8) { _Pragma("unroll") for (int m = 0; m < 4; ++m) _Pragma("unroll") for (int n = 0; n < 2; ++n) \
        asm volatile("v_mfma_f32_16x16x128_f8f6f4 %0, %1, %2, %0" : "+v"(acc[ai][bj][m][n]) : "v"(Bt.w[n]), "v"(At.w[m])); } \
        else { _Pragma("unroll") for (int m = 0; m < 4; ++m) _Pragma("unroll") for (int n = 0; n < 2; ++n) _Pragma("unroll") for (int k = 0; k < 2; ++k) \
        acc[ai][bj][m][n] = __builtin_amdgcn_mfma_f32_16x16x32_bf16(Bt.v[n][k], At.v[m][k], acc[ai][bj][m][n], 0, 0, 0); } __builtin_amdgcn_s_setprio(0); } while (0)
#define PG8_WAIT_V(n) asm volatile("s_waitcnt vmcnt(" #n ")" ::: "memory")
#define PG8_WAIT_L(n) asm volatile("s_waitcnt lgkmcnt(" #n ")" ::: "memory")
#define PG8_BAR __builtin_amdgcn_s_barrier()
#define PG8_SCHED __builtin_amdgcn_sched_barrier(0)
    Unit cur, nxt; int ui = 0;
    if (!S.next(0, cur)) return;
    if constexpr (TOUCH) { unsigned a_ = pg8_touch_rows((const char*)g.A, lidx, 2 * g.K) + pg8_touch_lines((const char*)g.Bt + (size_t)cur.pn * (512 * (size_t)g.K), 4 * g.K);
        Unit u1_; if (S.next(1, u1_)) a_ += pg8_touch_rows((const char*)g.A, lidx + 256, 2 * g.K) + pg8_touch_lines((const char*)g.Bt + (size_t)u1_.pn * (512 * (size_t)g.K), 4 * g.K);
        asm volatile("" :: "v"(a_)); }
    f32x4 acc[2][2][4][2];
#pragma unroll
    for (int a = 0; a < 2; ++a)
#pragma unroll
        for (int b = 0; b < 2; ++b)
#pragma unroll
            for (int m = 0; m < 4; ++m)
#pragma unroll
                for (int n = 0; n < 2; ++n) acc[a][b][m][n] = (f32x4){0.f, 0.f, 0.f, 0.f};
    pg8_FragA At; pg8_FragB B0, B1;
    const char* cB = (const char*)g.Bt + (size_t)cur.pn * tstep; PG8_ROWOFF(ca, 0);
    S.a_ready(cur);
    if constexpr (SP2) {
        PG8_STAGE(PG8_SB(0, 0), cB, voffB); PG8_STAGE(PG8_SB(0, 1), cB + hstepB, voffB); PG8_STAGEA(PG8_SA(0, 0), 0, ca[0]); PG8_STAGEA(PG8_SA(0, 1), 0, ca[1]);
        if (wr == 1) PG8_BAR;
        PG8_WAIT_V(2); PG8_BAR;
        PG8_STAGE(PG8_SB(1, 0), cB + kstepB, voffB); PG8_STAGEA(PG8_SA(1, 0), kstep, ca[0]); PG8_STAGE(PG8_SB(1, 1), cB + hstepB + kstepB, voffB);
        PG8_WAIT_V(6); PG8_BAR;
    }
    for (;;) {
        const bool has_next = S.next(ui + 1, nxt);
        const char* nB = has_next ? (const char*)g.Bt + (size_t)nxt.pn * tstep : cB;
        if (has_next) PG8_ROWOFF(na, ui + 1); else { _Pragma("unroll") for (int h_ = 0; h_ < 2; ++h_) _Pragma("unroll") for (int i_ = 0; i_ < 2; ++i_) na[h_][i_] = ca[h_][i_]; }
#pragma unroll 1
        for (int t = 0; t < nt; t += 2) {
            const bool last = (t == nt - 2);
            const size_t k1 = (size_t)(t + 1) * kstep, k2 = last ? (size_t)0 : (size_t)(t + 2) * kstep, k3 = k2 + kstep;
            unsigned o2[2][2];
#pragma unroll
            for (int h_ = 0; h_ < 2; ++h_)
#pragma unroll
                for (int i_ = 0; i_ < 2; ++i_) o2[h_][i_] = last ? na[h_][i_] : ca[h_][i_];
            const char* b2 = last ? nB : cB + (size_t)(t + 2) * kstepB; const char* b3 = b2 + kstepB;
            if (last && has_next) S.a_ready(nxt);
            if constexpr (SP2) {
            PG8_LDB(B0, 0, 0); PG8_LDB(B1, 0, 1); PG8_SCHED; PG8_LDA(At, 0, 0); PG8_STAGEA(PG8_SA(1, 1), k1, ca[1]);
            PG8_WAIT_V(8); PG8_WAIT_L(0); PG8_BAR; PG8_MMA(0, 0, At, B0); PG8_MMA(0, 1, At, B1); PG8_BAR; PG8_SCHED;
            PG8_LDA(At, 0, 1); PG8_STAGE(PG8_SB(0, 0), b2, voffB); PG8_STAGE(PG8_SB(0, 1), b2 + hstepB, voffB); PG8_STAGEA(PG8_SA(0, 0), k2, o2[0]);
            PG8_WAIT_V(8); PG8_WAIT_L(0); PG8_BAR; PG8_MMA(1, 0, At, B0); PG8_MMA(1, 1, At, B1); PG8_BAR; PG8_SCHED;
            PG8_LDB(B0, 1, 0); PG8_LDB(B1, 1, 1); PG8_SCHED; PG8_LDA(At, 1, 0); PG8_STAGEA(PG8_SA(0, 1), k2, o2[1]);
            PG8_WAIT_V(8); PG8_WAIT_L(0); PG8_BAR; PG8_MMA(0, 0, At, B0); PG8_MMA(0, 1, At, B1); PG8_BAR; PG8_SCHED;
            PG8_LDA(At, 1, 1); PG8_STAGE(PG8_SB(1, 0), b3, voffB); PG8_STAGE(PG8_SB(1, 1), b3 + hstepB, voffB); PG8_STAGEA(PG8_SA(1, 0), k3, o2[0]);
            PG8_WAIT_V(8); PG8_WAIT_L(0); PG8_BAR; PG8_MMA(1, 0, At, B0); PG8_MMA(1, 1, At, B1); PG8_BAR; PG8_SCHED;
            }
        }
        if constexpr (ALIGN_EPI) { if (wr == 0) PG8_BAR; }
        if constexpr (FP8) asm volatile("s_nop 15\n\ts_nop 15" ::: "memory");
        if constexpr (!Epi::AFTER_DRAIN) { const int ln_ = (int)__builtin_amdgcn_mbcnt_hi(~0u, __builtin_amdgcn_mbcnt_lo(~0u, 0u)); int fr_ = ln_ & 15, fq_ = ln_ >> 4; asm volatile("" : "+v"(fr_), "+v"(fq_)); E(acc, cur, wr, wc, fr_, fq_); S.done(cur);
            if constexpr (TOUCH) { Unit u2_; if (S.next(ui + 2, u2_)) { const unsigned a_ = pg8_touch_rows((const char*)g.A, lidx + (ui + 2) * 256, 2 * g.K) + pg8_touch_lines((const char*)g.Bt + (size_t)u2_.pn * (512 * (size_t)g.K), 4 * g.K); asm volatile("" :: "v"(a_)); } } }
        if (!has_next) break;
#pragma unroll
        for (int a = 0; a < 2; ++a)
#pragma unroll
            for (int b = 0; b < 2; ++b)
#pragma unroll
                for (int m = 0; m < 4; ++m)
#pragma unroll
                    for (int n = 0; n < 2; ++n) acc[a][b][m][n] = (f32x4){0.f, 0.f, 0.f, 0.f};
        cur = nxt; cB = nB; ++ui;
        { _Pragma("unroll") for (int h_ = 0; h_ < 2; ++h_) _Pragma("unroll") for (int i_ = 0; i_ < 2; ++i_) ca[h_][i_] = na[h_][i_]; }
        if constexpr (ALIGN_EPI) { if (wr == 1) PG8_BAR; }
    }
    PG8_WAIT_V(0);
    if constexpr (!ALIGN_EPI) { if (wr == 0) PG8_BAR; }
    PG8_BAR;
    if constexpr (Epi::AFTER_DRAIN) { E.fused(acc, cur, wr, wc, fr, fq, lds, wid, lane); S.done(cur); }
#undef PG8_SA
#undef PG8_ROWOFF
#undef PG8_STAGEA
#undef PG8_SB
#undef PG8_STAGE
#undef PG8_LDA
#undef PG8_LDB
#undef PG8_MMA
#undef PG8_WAIT_V
#undef PG8_WAIT_L
#undef PG8_BAR
#undef PG8_SCHED
}
}

constexpr int NB = 2, SEQ = 16384, T = NB * SEQ, D = 1024;
constexpr float EPS = 1e-6f;
constexpr int NWAVES = 8, NTHR = 512;
constexpr int N_IN = 55;
__host__ __device__ constexpr int LBASE(int L) { return L == 0 ? 2 : (L == 1 ? 15 : (L == 2 ? 29 : 42)); }
__host__ __device__ constexpr int NMIX(int L) { return L == 1 ? 6 : 5; }

constexpr size_t MiB = 1u << 20;
constexpr size_t WS_CTL = 0, CTL_ZERO_BYTES = 1 * MiB;
constexpr size_t WS_MOD = 1 * MiB;
constexpr size_t WS_CNT = WS_MOD + 256 * 1024;
constexpr size_t WS_TILEE = WS_CNT + 64 * 1024;
constexpr size_t WS_EID = 2 * MiB;
constexpr size_t WS_GATE = WS_EID + 256 * 1024;
constexpr size_t WS_SLOT = WS_GATE + 256 * 1024;
constexpr size_t WS_VSSP = 3 * MiB;
constexpr size_t WS_BA = 5 * MiB;
constexpr size_t WS_DNB = 7 * MiB;
constexpr size_t WS_RTR = 9 * MiB;
constexpr size_t WS_WBA = 11 * MiB;
constexpr size_t WS_TOK = 12 * MiB;
constexpr size_t WS_W = 16 * MiB;
constexpr size_t WL_STRIDE = 48 * MiB, WL_OUT = 32 * MiB;
constexpr size_t WS_WMIX = WS_W + 4 * WL_STRIDE;
constexpr size_t WMIX_GM_IN0 = 0, WMIX_GM_OUT0 = 4 * MiB, WMIX_DN_IN = 6 * MiB, WMIX_DN_OUT = 13 * MiB, WMIX_SWA_IN = 15 * MiB, WMIX_SWA_OUT = 18 * MiB, WMIX_GM_IN3 = 20 * MiB, WMIX_GM_OUT3 = 24 * MiB;
constexpr size_t WS_ACT = 240 * MiB;
constexpr size_t A_H = 0;
constexpr size_t A_U = 64 * MiB, A_V = 128 * MiB, A_GATED = 192 * MiB;
constexpr size_t A_QKV = 64 * MiB, A_Z = 192 * MiB, A_QN = 256 * MiB, A_KN = 288 * MiB, A_VV = 320 * MiB, A_FA = 384 * MiB, A_FB = 484 * MiB, A_FU = 64 * MiB, A_O = 128 * MiB, A_SFR = 548 * MiB, A_VFR = 676 * MiB;
constexpr size_t A_XG = 64 * MiB, A_ACTV = 208 * MiB, A_Y = 280 * MiB;
constexpr size_t WS_X16B = WS_ACT + 548 * MiB;
constexpr size_t WS_END = WS_ACT + 740 * MiB;
constexpr int MAXROWS = 73728;

constexpr int RING_BYTES = 131072;
constexpr int LDSCTL_OFF = RING_BYTES, MISC_OFF = LDSCTL_OFF + 320;
constexpr int LDS_BYTES = 147456;

#define LAS __attribute__((address_space(3)))
typedef unsigned short bf16;
typedef unsigned v4u __attribute__((ext_vector_type(4)));
typedef unsigned v2u __attribute__((ext_vector_type(2)));
typedef float f32x4 __attribute__((ext_vector_type(4)));
typedef short bf16x8 __attribute__((ext_vector_type(8)));
typedef short bf16x4 __attribute__((ext_vector_type(4)));
#define LDS_WAIT() asm volatile("s_waitcnt lgkmcnt(0)" ::: "memory")
#define VM_WAIT() asm volatile("s_waitcnt vmcnt(0)" ::: "memory")
__device__ __forceinline__ unsigned pk2(float lo, float hi) { return pg8::cvt_pk_bf16(lo, hi); }
__device__ __forceinline__ float bflo(unsigned w) { return __uint_as_float(w << 16); }
__device__ __forceinline__ float bfhi(unsigned w) { return __uint_as_float(w & 0xffff0000u); }
__device__ __forceinline__ float bf1(unsigned short b) { return __uint_as_float(((unsigned)b) << 16); }
__device__ __forceinline__ float wave_sum(float v) {
#pragma unroll
    for (int o = 1; o < 64; o <<= 1) v += __shfl_xor(v, o);
    return v;
}
__device__ __forceinline__ float fast_exp(float x) { return __builtin_amdgcn_exp2f(x * 1.44269504089f); }
__device__ __forceinline__ float sigmoidf_(float x) { return __builtin_amdgcn_rcpf(1.0f + fast_exp(-x)); }
__device__ __forceinline__ float siluf_(float x) { return x * sigmoidf_(x); }
__device__ __forceinline__ float gelu_tanh(float x) { const float y = 1.5957691216057308f * (x + 0.044715f * x * x * x); return x * __builtin_amdgcn_rcpf(1.0f + fast_exp(-y)); }

__device__ __forceinline__ f32x4 gelu_tanh4(const f32x4 x) { const f32x4 t = x * x; const f32x4 p = t * -0.10294324f + -2.30220819f; const f32x4 ea = p * x; f32x4 e;
#pragma unroll
    for (int j = 0; j < 4; ++j) e[j] = __builtin_amdgcn_exp2f(ea[j]);
    const f32x4 d = e + 1.0f; f32x4 rc;
#pragma unroll
    for (int j = 0; j < 4; ++j) rc[j] = __builtin_amdgcn_rcpf(d[j]);
    return x * rc; }
#define RLX_AGENT __ATOMIC_RELAXED, __HIP_MEMORY_SCOPE_AGENT
__device__ __forceinline__ unsigned char* uni_ptr(unsigned char* p) { const unsigned long long w = (unsigned long long)p; const unsigned lo = __builtin_amdgcn_readfirstlane((unsigned)w), hi = __builtin_amdgcn_readfirstlane((unsigned)(w >> 32)); return (unsigned char*)(__attribute__((address_space(1))) unsigned char*)(((unsigned long long)hi << 32) | lo); }
__device__ __forceinline__ unsigned pk4_fp8(float a, float b, float c, float d) { int w = __builtin_amdgcn_cvt_pk_fp8_f32(a, b, 0, false); w = __builtin_amdgcn_cvt_pk_fp8_f32(c, d, w, true); return (unsigned)w; }
#define XB_TMO      128
#define XB_XCNT(j)  (256  + 64 * (j))
#define XB_XSUB(j)  (1280 + 64 * (j))
#define XB_XGEN(j)  (2304 + 64 * (j))
#define XB_TOP      3328
#define XB_TOPGEN   3392
#define XCD_BAR_WORDS 3456
#define XB_SPIN_CAP (1u << 18)

__device__ __forceinline__ unsigned xb_ld(unsigned* p)              { return __hip_atomic_load(p, __ATOMIC_RELAXED, __HIP_MEMORY_SCOPE_AGENT); }
__device__ __forceinline__ unsigned xb_add(unsigned* p, unsigned v) { return __hip_atomic_fetch_add(p, v, __ATOMIC_RELAXED, __HIP_MEMORY_SCOPE_AGENT); }
__device__ __forceinline__ unsigned xb_xcc_id() { return (unsigned)__builtin_amdgcn_s_getreg((3 << 11) | 20) & 0xFu; }
#define XB_SPIN(cond, bar) do { unsigned _sp = 0; while (cond) { __builtin_amdgcn_s_sleep(1); \
    if ((++_sp & 255u) == 0u) { if (xb_ld(&(bar)[XB_TMO])) break; if (_sp > XB_SPIN_CAP) { atomicAdd(&(bar)[XB_TMO], 1u); break; } } } } while (0)

struct XcdBarrier {
    unsigned* bar; unsigned x;
    volatile LAS unsigned* st;
};

__device__ __forceinline__ XcdBarrier xcd_barrier_post(unsigned* bar, volatile LAS unsigned* st) {
    XcdBarrier b; b.bar = bar; b.x = xb_xcc_id(); b.st = st;
    if (threadIdx.x == 0) (void)xb_add(&bar[XB_XCNT(b.x)], 1u);
    return b;
}
__device__ __forceinline__ void xcd_barrier_complete(unsigned* bar, unsigned x, unsigned& nloc, unsigned& nx) {
    const unsigned G = gridDim.x * gridDim.y * gridDim.z;
    unsigned sum, cnt, mine, sp = 0u;
    for (;;) {
        sum = 0u; cnt = 0u; mine = 0u;
#pragma unroll
        for (unsigned j = 0; j < 16; ++j) { const unsigned c = xb_ld(&bar[XB_XCNT(j)]); sum += c; cnt += (c > 0u) ? 1u : 0u; mine = (j == x) ? c : mine; }
        if (sum == G) break;
        __builtin_amdgcn_s_sleep(1);
        if ((++sp & 255u) == 0u) { if (xb_ld(&bar[XB_TMO])) break; if (sp > XB_SPIN_CAP) { atomicAdd(&bar[XB_TMO], 1u); break; } }
    }
    nloc = mine > 0u ? mine : 1u; nx = cnt > 0u ? cnt : 1u;
}

__device__ __forceinline__ void xcd_barrier(const XcdBarrier& b) {
    asm volatile("s_waitcnt vmcnt(0)" ::: "memory");
    __syncthreads();
    if (threadIdx.x == 0) {
        unsigned* bar = b.bar;
        __builtin_amdgcn_s_waitcnt(0);
        unsigned nloc = b.st[0], nx = b.st[1];
        if (nloc == 0u) { xcd_barrier_complete(bar, b.x, nloc, nx); b.st[0] = nloc; b.st[1] = nx; }
        const unsigned old = xb_add(&bar[XB_XSUB(b.x)], 1u);
        const unsigned gen = old / nloc;
        if (old + 1u == (gen + 1u) * nloc) {
            __builtin_amdgcn_fence(__ATOMIC_RELEASE, "agent");
            asm volatile("s_waitcnt vmcnt(0)" ::: "memory");
            const unsigned og = xb_add(&bar[XB_TOP], 1u);
            const unsigned tg = og / nx;
            if (og + 1u == (tg + 1u) * nx) xb_add(&bar[XB_TOPGEN], 1u);
            else XB_SPIN(xb_ld(&bar[XB_TOPGEN]) == tg, bar);
            __builtin_amdgcn_fence(__ATOMIC_ACQUIRE, "agent");
            xb_add(&bar[XB_XGEN(b.x)], 1u);
            asm volatile("s_waitcnt vmcnt(0)" ::: "memory");
        } else {
            XB_SPIN(xb_ld(&bar[XB_XGEN(b.x)]) == gen, bar);
            __builtin_amdgcn_fence(__ATOMIC_ACQUIRE, "agent");
            asm volatile("s_waitcnt vmcnt(0)" ::: "memory");
        }
    }
    __syncthreads();
}

typedef const pg8::f32x4 (&AccRef)[2][2][4][2];

struct EpiGm1 {
    static constexpr bool PERM = true, AFTER_DRAIN = false;
    bf16* U; bf16* V; float* vssp;
    __device__ __forceinline__ void operator()(AccRef acc, const pg8::Unit& u, int wr, int wc, int fr, int fq) const {
        const int row0 = u.pm * 256 + wr * 64 + fr; const bool isV = u.pn >= 4; const int col0 = (u.pn & 3) * 256 + wc * 32 + 8 * fq;
        bf16* base = isV ? V : U;
#pragma unroll
        for (int ai = 0; ai < 2; ++ai)
#pragma unroll
            for (int m = 0; m < 4; ++m) { const int row = row0 + ai * 128 + m * 16; bf16* rowp = base + (size_t)row * 1024 + col0; float ss = 0.f;
#pragma unroll
                for (int bj = 0; bj < 2; ++bj) { const f32x4 v0 = gelu_tanh4(acc[ai][bj][m][0]), v1 = gelu_tanh4(acc[ai][bj][m][1]);
                    { const f32x4 s4 = v0 * v0 + v1 * v1; ss += (s4[0] + s4[1]) + (s4[2] + s4[3]); }
                    v4u w; w.x = pk2(v0[0], v0[1]); w.y = pk2(v0[2], v0[3]); w.z = pk2(v1[0], v1[1]); w.w = pk2(v1[2], v1[3]);
                    *(v4u*)(rowp + bj * 128) = w; }
                if (isV) { ss += __shfl_xor(ss, 16); ss += __shfl_xor(ss, 32); if (fq == 0) vssp[(size_t)row * 16 + (u.pn - 4) * 4 + wc] = ss; } }
    }
};
template <bool SRC16>
struct EpiRes {
    static constexpr bool PERM = true, AFTER_DRAIN = false;
    const void* src; bf16* dst; const float* gate;
    __device__ __forceinline__ void operator()(AccRef acc, const pg8::Unit& u, int wr, int wc, int fr, int fq) const {
        const int row0 = u.pm * 256 + wr * 64 + fr, col0 = u.pn * 256 + wc * 32 + 8 * fq; const int b = (u.pm * 256) / SEQ;
        f32x4 gv[2][2];
#pragma unroll
        for (int bj = 0; bj < 2; ++bj)
#pragma unroll
            for (int n = 0; n < 2; ++n) gv[bj][n] = *(const f32x4*)(gate + (size_t)b * 6144 + col0 + bj * 128 + n * 4);
#pragma unroll
        for (int ai = 0; ai < 2; ++ai)
#pragma unroll
            for (int m = 0; m < 4; ++m) { const size_t off = (size_t)(row0 + ai * 128 + m * 16) * 1024 + col0;
#pragma unroll
                for (int bj = 0; bj < 2; ++bj) { f32x4 x0, x1;
                    if constexpr (SRC16) { const v4u w = *(const v4u*)((const bf16*)src + off + bj * 128); x0 = (f32x4){bflo(w.x), bfhi(w.x), bflo(w.y), bfhi(w.y)}; x1 = (f32x4){bflo(w.z), bfhi(w.z), bflo(w.w), bfhi(w.w)}; }
                    else { x0 = *(const f32x4*)((const float*)src + off + bj * 128); x1 = *(const f32x4*)((const float*)src + off + bj * 128 + 4); }
                    const f32x4 v0 = x0 + gv[bj][0] * acc[ai][bj][m][0], v1 = x1 + gv[bj][1] * acc[ai][bj][m][1];
                    v4u o; o.x = pk2(v0[0], v0[1]); o.y = pk2(v0[2], v0[3]); o.z = pk2(v1[0], v1[1]); o.w = pk2(v1[2], v1[3]);
                    *(v4u*)(dst + off + bj * 128) = o; } }
    }
};
struct EpiBf {
    static constexpr bool PERM = true, AFTER_DRAIN = false;
    bf16* O; int ldc; int nmask; float scale;
    __device__ __forceinline__ void operator()(AccRef acc, const pg8::Unit& u, int wr, int wc, int fr, int fq) const {
        const int row0 = u.pm * 256 + wr * 64 + fr, col0 = (u.pn & nmask) * 256 + wc * 32 + 8 * fq;
#pragma unroll
        for (int ai = 0; ai < 2; ++ai)
#pragma unroll
            for (int m = 0; m < 4; ++m) { bf16* rowp = O + (size_t)(row0 + ai * 128 + m * 16) * ldc + col0;
#pragma unroll
                for (int bj = 0; bj < 2; ++bj) { const f32x4 v0 = acc[ai][bj][m][0] * scale, v1 = acc[ai][bj][m][1] * scale;
                    v4u w; w.x = pk2(v0[0], v0[1]); w.y = pk2(v0[2], v0[3]); w.z = pk2(v1[0], v1[1]); w.w = pk2(v1[2], v1[3]);
                    *(v4u*)(rowp + bj * 128) = w; } }
    }
};
struct EpiF8 {
    static constexpr bool PERM = true, AFTER_DRAIN = false;
    unsigned char* O; int ldc; int nmask; float scale;
    __device__ __forceinline__ void operator()(AccRef acc, const pg8::Unit& u, int wr, int wc, int fr, int fq) const {
        const int row0 = u.pm * 256 + wr * 64 + fr, col0 = (u.pn & nmask) * 256 + wc * 32 + 8 * fq;
#pragma unroll
        for (int ai = 0; ai < 2; ++ai)
#pragma unroll
            for (int m = 0; m < 4; ++m) { unsigned char* rowp = O + (size_t)(row0 + ai * 128 + m * 16) * ldc + col0;
#pragma unroll
                for (int bj = 0; bj < 2; ++bj) { const f32x4 v0 = acc[ai][bj][m][0] * scale, v1 = acc[ai][bj][m][1] * scale;
                    v2u w; w.x = pk4_fp8(v0[0], v0[1], v0[2], v0[3]); w.y = pk4_fp8(v1[0], v1[1], v1[2], v1[3]);
                    *(v2u*)(rowp + bj * 128) = w; } }
    }
};
struct EpiDn1 {
    static constexpr bool PERM = true, AFTER_DRAIN = false;
    bf16* QKV; bf16* Z; float* BA;
    __device__ __forceinline__ void operator()(AccRef acc, const pg8::Unit& u, int wr, int wc, int fr, int fq) const {
        const int row0 = u.pm * 256 + wr * 64 + fr;
        if (u.pn < 12) {
            bf16* base = u.pn < 8 ? QKV : Z; const int ldc = u.pn < 8 ? 2048 : 1024; const int col0 = (u.pn < 8 ? u.pn : u.pn - 8) * 256 + wc * 32 + 8 * fq;
#pragma unroll
            for (int ai = 0; ai < 2; ++ai)
#pragma unroll
                for (int m = 0; m < 4; ++m) { bf16* rowp = base + (size_t)(row0 + ai * 128 + m * 16) * ldc + col0;
#pragma unroll
                    for (int bj = 0; bj < 2; ++bj) { const f32x4 v0 = acc[ai][bj][m][0], v1 = acc[ai][bj][m][1];
                        v4u w; w.x = pk2(v0[0], v0[1]); w.y = pk2(v0[2], v0[3]); w.z = pk2(v1[0], v1[1]); w.w = pk2(v1[2], v1[3]);
                        *(v4u*)(rowp + bj * 128) = w; } }
        } else if (wc == 0 && fq < 2) {
#pragma unroll
            for (int ai = 0; ai < 2; ++ai)
#pragma unroll
                for (int m = 0; m < 4; ++m) { float* rowp = BA + (size_t)(row0 + ai * 128 + m * 16) * 16 + 8 * fq;
                    *(f32x4*)(rowp) = acc[ai][0][m][0]; *(f32x4*)(rowp + 4) = acc[ai][0][m][1]; }
        }
    }
};
struct EpiMoe1 {
    static constexpr bool PERM = true, AFTER_DRAIN = false;
    unsigned char* O;
    __device__ __forceinline__ void operator()(AccRef acc, const pg8::Unit& u, int wr, int wc, int fr, int fq) const {
        const int row0 = u.pm * 256 + wr * 64 + fr, col0 = (u.pn & 3) * 128 + wc * 32 + 8 * fq;
#pragma unroll
        for (int ai = 0; ai < 2; ++ai)
#pragma unroll
            for (int m = 0; m < 4; ++m) { unsigned char* rowp = O + (size_t)(row0 + ai * 128 + m * 16) * 512 + col0; float r[8];
#pragma unroll
                for (int n = 0; n < 2; ++n) {
                    const f32x4 A = acc[ai][0][m][n], Gv = acc[ai][1][m][n]; const f32x4 ea = A * (-1.44269504089f * 0.03125f); f32x4 e;
#pragma unroll
                    for (int j = 0; j < 4; ++j) e[j] = __builtin_amdgcn_exp2f(ea[j]);
                    const f32x4 d = e * 1024.0f + 1024.0f; f32x4 rc;
#pragma unroll
                    for (int j = 0; j < 4; ++j) rc[j] = __builtin_amdgcn_rcpf(d[j]);
                    const f32x4 o = (A * Gv) * rc;
#pragma unroll
                    for (int j = 0; j < 4; ++j) r[4 * n + j] = o[j]; }
                v2u w; w.x = pk4_fp8(r[0], r[1], r[2], r[3]); w.y = pk4_fp8(r[4], r[5], r[6], r[7]);
                *(v2u*)rowp = w; }
    }
};
struct MoeOrder {
    const LAS int* tile_e; int total, G, c;
    __device__ __forceinline__ void init(const LAS int* te, int ntiles, int G_, int c_) { tile_e = te; total = ntiles * 4; G = G_; c = c_; }
    __device__ __forceinline__ bool next(int i, pg8::Unit& u) const {
        const long Lx = (long)i * G + c; if (Lx >= total) return false;
        const int w0 = (int)Lx, q = total / 8, r = total % 8, xcd = w0 % 8, off = w0 / 8;
        const int wgid = (xcd < r ? xcd * (q + 1) : r * (q + 1) + (xcd - r) * q) + off;
        const int rt = wgid >> 2; u.pm = rt; u.pn = tile_e[rt] * 4 + (wgid & 3); return true;
    }
    __device__ __forceinline__ void a_ready(const pg8::Unit&) const {}
    __device__ __forceinline__ void done(const pg8::Unit&) const {}
};

struct EpiMoe1P {
    static constexpr bool PERM = true, AFTER_DRAIN = false;
    bf16* O;
    __device__ __forceinline__ void operator()(AccRef acc, const pg8::Unit& u, int wr, int wc, int fr, int fq) const {
        const int row0 = u.pm * 256 + wr * 64 + fr, col0 = (u.pn & 3) * 128 + wc * 32 + 8 * fq;
#pragma unroll
        for (int ai = 0; ai < 2; ++ai)
#pragma unroll
            for (int m = 0; m < 4; ++m) { unsigned long long* rowp = (unsigned long long*)(O + (size_t)(row0 + ai * 128 + m * 16) * 512 + col0); float r[8];
#pragma unroll
                for (int n = 0; n < 2; ++n)
#pragma unroll
                    for (int j = 0; j < 4; ++j) { const float a = acc[ai][0][m][n][j], g = acc[ai][1][m][n][j]; r[4 * n + j] = siluf_(a) * g; }
                const unsigned long long w0 = (unsigned long long)pk2(r[0], r[1]) | ((unsigned long long)pk2(r[2], r[3]) << 32), w1 = (unsigned long long)pk2(r[4], r[5]) | ((unsigned long long)pk2(r[6], r[7]) << 32);
                __hip_atomic_store(rowp, w0, __ATOMIC_RELAXED, __HIP_MEMORY_SCOPE_AGENT); __hip_atomic_store(rowp + 1, w1, __ATOMIC_RELAXED, __HIP_MEMORY_SCOPE_AGENT); }
    }
};
struct MoeOrderPub : MoeOrder {
    unsigned* cnt;
    __device__ __forceinline__ void done(const pg8::Unit& u) const {
        asm volatile("s_waitcnt vmcnt(0)" ::: "memory");
        if ((threadIdx.x & 63) == 0) __hip_atomic_fetch_add(cnt + 64 * u.pm, 1u, __ATOMIC_RELAXED, __HIP_MEMORY_SCOPE_AGENT);
    }
};
struct MoeOrderWait : MoeOrder {
    const unsigned* cnt; unsigned* tmo;
    __device__ __forceinline__ void a_ready(const pg8::Unit& u) const {
        if (threadIdx.x < 64) {
            const unsigned long long t0 = __builtin_amdgcn_s_memrealtime(); unsigned polls = 0;
            while ((unsigned)__builtin_amdgcn_readfirstlane(__hip_atomic_load(cnt + 64 * u.pm, __ATOMIC_RELAXED, __HIP_MEMORY_SCOPE_AGENT)) < 32u) {
                if ((++polls & 255u) == 0u && __builtin_amdgcn_readfirstlane(__hip_atomic_load(tmo, __ATOMIC_RELAXED, __HIP_MEMORY_SCOPE_AGENT)) != 0u) break;
                if (__builtin_amdgcn_s_memrealtime() - t0 > 2000000ull) { if (threadIdx.x == 0) __hip_atomic_store(tmo, 1u, __ATOMIC_RELAXED, __HIP_MEMORY_SCOPE_AGENT); break; }
                __builtin_amdgcn_s_sleep(2); }
            __builtin_amdgcn_fence(__ATOMIC_ACQUIRE, "agent");
            asm volatile("s_waitcnt vmcnt(0)" ::: "memory");
        }
        asm volatile("" ::: "memory"); __builtin_amdgcn_s_barrier(); asm volatile("" ::: "memory");
    }
};

struct Args { const float* in[N_IN]; float* out; unsigned char* ws; int ph_lo, ph_hi, li, pad; };

__device__ __forceinline__ void tr_item(const float* __restrict__ W, int ldn, int k0, int n0, bf16* __restrict__ WT, int Kd, int drow0, LAS float* scr, int lane) {
#pragma unroll 8
    for (int i = 0; i < 32; ++i) { const int kk = 2 * i + (lane >> 5); scr[kk * 33 + (lane & 31)] = W[(size_t)(k0 + kk) * ldn + n0 + (lane & 31)]; }
    LDS_WAIT(); asm volatile("" ::: "memory");
    const int c = lane & 7;
#pragma unroll
    for (int j = 0; j < 4; ++j) { const int n = (lane >> 3) + 8 * j; const LAS float* s = scr + (8 * c) * 33 + n;
        v4u o; o.x = pk2(s[0 * 33], s[1 * 33]); o.y = pk2(s[2 * 33], s[3 * 33]); o.z = pk2(s[4 * 33], s[5 * 33]); o.w = pk2(s[6 * 33], s[7 * 33]);
        *(v4u*)(WT + (size_t)(drow0 + n) * Kd + k0 + 8 * c) = o; }
    LDS_WAIT(); asm volatile("" ::: "memory");
}

constexpr int CV_PER_L = 24576, CV_N_EXP = 4 * CV_PER_L, CV_MIX_L01 = 3584, CV_N_MIXI = 1536 + 2048 + 1280 + 1536;
#ifndef CV_SPLIT
#define CV_SPLIT CV_PER_L
#endif
struct CvItem { const float* src; bf16* dst; int ldn, Kd; float qs; };
__device__ __forceinline__ CvItem cv_decode(const Args& args, unsigned char* ws, int it) {
    CvItem c; const float* src; bf16* dst; int ldn, k0, n0, Kd, drow0;
    constexpr int PER_L = CV_PER_L, N_EXP = CV_N_EXP;
    if (it < N_EXP) {
        const int L = it / PER_L; int r = it % PER_L; const int ib = LBASE(L) + 4 + NMIX(L);
        if (r < 16384) { const int e = r >> 9, rr = r & 511; k0 = (rr >> 5) * 64; n0 = (rr & 31) * 32; ldn = 1024; Kd = 1024;
            src = args.in[ib + 2] + (size_t)e * 1048576; dst = (bf16*)(ws + WS_W + (size_t)L * WL_STRIDE + (size_t)e * 1048576);
            drow0 = (n0 < 512) ? ((n0 >> 7) * 256 + (n0 & 127)) : ((((n0 - 512) >> 7) * 256) + 128 + ((n0 - 512) & 127)); }
        else { r -= 16384; const int e = r >> 8, rr = r & 255; k0 = (rr >> 5) * 64; n0 = (rr & 31) * 32; ldn = 1024; Kd = 512;
            src = args.in[ib + 3] + (size_t)e * 524288; dst = (bf16*)(ws + WS_W + (size_t)L * WL_STRIDE + WL_OUT + (size_t)e * 524288); drow0 = n0; }
    } else {
        int r = it - N_EXP; int idx, nblk; size_t woff;
        if (r < 1024) { idx = 6; ldn = 2048; nblk = 64; woff = WMIX_GM_IN0; }
        else if ((r -= 1024) < 512) { idx = 10; ldn = 1024; nblk = 32; woff = WMIX_GM_OUT0; }
        else if ((r -= 512) < 1536) { idx = 19; ldn = 3088; nblk = 96; woff = WMIX_DN_IN; }
        else if ((r -= 1536) < 512) { idx = 24; ldn = 1024; nblk = 32; woff = WMIX_DN_OUT; }
        else if ((r -= 512) < 768) { idx = 33; ldn = 1536; nblk = 48; woff = WMIX_SWA_IN; }
        else if ((r -= 768) < 512) { idx = 37; ldn = 1024; nblk = 32; woff = WMIX_SWA_OUT; }
        else if ((r -= 512) < 1024) { idx = 46; ldn = 2048; nblk = 64; woff = WMIX_GM_IN3; }
        else { r -= 1024; idx = 50; ldn = 1024; nblk = 32; woff = WMIX_GM_OUT3; }
        src = args.in[idx]; dst = (bf16*)(ws + WS_WMIX + woff); k0 = (r / nblk) * 64; n0 = (r % nblk) * 32; Kd = 1024; drow0 = n0;
    }
    c.src = src + (size_t)k0 * ldn + n0; c.ldn = ldn; c.Kd = Kd;
    if (it < N_EXP) { c.qs = ((it % PER_L) < 16384) ? 32.f : 16.f;
        c.dst = (bf16*)((unsigned char*)dst + (size_t)(drow0 >> 8) * (256 * (size_t)Kd) + (size_t)(k0 >> 7) * 32768 + (size_t)(drow0 & 255) * 128 + (k0 & 127)); }
    else { c.qs = 0.f; c.dst = (bf16*)((unsigned char*)dst + (size_t)(drow0 >> 8) * (512 * (size_t)Kd) + (size_t)(k0 >> 6) * 32768 + (size_t)(drow0 & 255) * 128 + (size_t)(k0 & 63) * 2); }
    return c;
}
__device__ __forceinline__ void cv_load(const CvItem& c, f32x4 (&v)[8], int lane) {
    if (c.qs > 0.f) { const float* p = c.src + (size_t)(4 * (lane >> 3)) * c.ldn + 4 * (lane & 7);
#pragma unroll
        for (int i = 0; i < 2; ++i)
#pragma unroll
            for (int r = 0; r < 4; ++r) v[4 * i + r] = __builtin_nontemporal_load((const f32x4*)(p + (size_t)(32 * i + r) * c.ldn)); }
    else { const float* p = c.src + (size_t)(2 * (lane >> 3)) * c.ldn + 4 * (lane & 7);
#pragma unroll
        for (int i = 0; i < 4; ++i) { v[2 * i] = __builtin_nontemporal_load((const f32x4*)(p + (size_t)(16 * i) * c.ldn)); v[2 * i + 1] = __builtin_nontemporal_load((const f32x4*)(p + (size_t)(16 * i + 1) * c.ldn)); } }
}
__device__ __forceinline__ void cv_store(const CvItem& c, const f32x4 (&v)[8], LAS float* scr, int lane) {
    LAS unsigned* su = (LAS unsigned*)scr; const int kp = lane >> 3, n4 = 4 * (lane & 7);
    if (c.qs > 0.f) {
#pragma unroll
        for (int i = 0; i < 2; ++i) { LAS unsigned* q = su + (kp + 8 * i) * 33 + n4;
#pragma unroll
            for (int e = 0; e < 4; ++e) q[e] = pk4_fp8(v[4 * i][e] * c.qs, v[4 * i + 1][e] * c.qs, v[4 * i + 2][e] * c.qs, v[4 * i + 3][e] * c.qs); }
        LDS_WAIT(); asm volatile("" ::: "memory");
        const int n = lane >> 1, hf = lane & 1; const LAS unsigned* s = su + (8 * hf) * 33 + n;
        v4u o0, o1; o0.x = s[0]; o0.y = s[33]; o0.z = s[66]; o0.w = s[99]; o1.x = s[132]; o1.y = s[165]; o1.z = s[198]; o1.w = s[231];
        unsigned char* d = (unsigned char*)c.dst + (size_t)n * 128 + 32 * hf; *(v4u*)d = o0; *(v4u*)(d + 16) = o1;
        LDS_WAIT(); asm volatile("" ::: "memory");
        return; }
#pragma unroll
    for (int i = 0; i < 4; ++i) { LAS unsigned* q = su + (kp + 8 * i) * 33 + n4;
#pragma unroll
        for (int e = 0; e < 4; ++e) q[e] = pk2(v[2 * i][e], v[2 * i + 1][e]); }
    LDS_WAIT(); asm volatile("" ::: "memory");
    const int ck = lane & 7;
#pragma unroll
    for (int j = 0; j < 4; ++j) { const int n = (lane >> 3) + 8 * j; const LAS unsigned* s = su + (4 * ck) * 33 + n;
        v4u o; o.x = s[0]; o.y = s[33]; o.z = s[66]; o.w = s[99];
        *(v4u*)((unsigned char*)c.dst + (size_t)n * 128 + 16 * ck) = o; }
    LDS_WAIT(); asm volatile("" ::: "memory");
}
__device__ __forceinline__ void convert_weights(const Args& args, LAS unsigned char* lds, int it_lo, int it_hi, int gw, int NGW) {
    int tid_ = threadIdx.x; asm volatile("" : "+v"(tid_)); const int lane = tid_ & 63, wave = __builtin_amdgcn_readfirstlane(tid_ >> 6);
    unsigned char* ws = uni_ptr(args.ws);
    LAS float* scr = (LAS float*)(lds + wave * 8448);
    for (int it = it_lo + 4 * gw; it < it_hi; it += 4 * NGW) {
        const CvItem c0 = cv_decode(args, ws, it);
        const size_t dstep = (size_t)32 * 128;
        f32x4 v[4][8];
#pragma unroll
        for (int j = 0; j < 4; ++j) { CvItem c = c0; c.src = c0.src + 32 * j; cv_load(c, v[j], lane); }
#pragma unroll
        for (int j = 0; j < 4; ++j) { CvItem c = c0; c.dst = (bf16*)((unsigned char*)c0.dst + j * dstep); cv_store(c, v[j], scr, lane); }
    }
}
__device__ __forceinline__ void phase_prologue(const Args& args, LAS unsigned char* lds) {
    int tid_ = threadIdx.x; asm volatile("" : "+v"(tid_)); const int tid = tid_, lane = tid & 63, wave = __builtin_amdgcn_readfirstlane(tid >> 6), G = gridDim.x, bid = blockIdx.x; (void)tid; (void)lane; (void)wave;
    unsigned char* ws = uni_ptr(args.ws);
    LAS float* cact = (LAS float*)(lds + 69632);
    LAS float* red = (LAS float*)(lds + 77824);
    for (int k = tid; k < 2048; k += NTHR) cact[k] = siluf_(args.in[1][k]);
    __syncthreads();
    float* MOD = (float*)(ws + WS_MOD);
    for (int item = bid; item < 384; item += G) {
        const int L = item / 96, cg = item % 96, c4 = tid & 15, ks = tid >> 4;
        const float* w = args.in[LBASE(L) + 2] + (size_t)(ks * 32) * 6144 + cg * 64 + c4 * 4;
        f32x4 a0 = {0.f, 0.f, 0.f, 0.f}, a1 = {0.f, 0.f, 0.f, 0.f};
#pragma unroll 8
        for (int kk = 0; kk < 32; ++kk) { const f32x4 wv = *(const f32x4*)(w + (size_t)kk * 6144); a0 += cact[ks * 32 + kk] * wv; a1 += cact[1024 + ks * 32 + kk] * wv; }
        *(LAS f32x4*)(red + (ks * 2 + 0) * 64 + c4 * 4) = a0; *(LAS f32x4*)(red + (ks * 2 + 1) * 64 + c4 * 4) = a1;
        __syncthreads();
        if (tid < 128) { const int b = tid >> 6, col = tid & 63; float s = 0.f;
#pragma unroll
            for (int k2 = 0; k2 < 32; ++k2) s += red[(k2 * 2 + b) * 64 + col];
            MOD[(size_t)(L * 2 + b) * 6144 + cg * 64 + col] = s + args.in[LBASE(L) + 3][cg * 64 + col]; }
        __syncthreads();
    }
    { const int gw = bid * NWAVES + wave, NGW = G * NWAVES;
      if (G > 128) { convert_weights(args, lds, 0, CV_SPLIT, gw, NGW); convert_weights(args, lds, CV_N_EXP, CV_N_EXP + CV_MIX_L01, gw, NGW); }
      else convert_weights(args, lds, 0, CV_N_EXP + CV_N_MIXI, gw, NGW); }
    const int gt = bid * NTHR + tid, NGT = G * NTHR;
    { bf16* dst = (bf16*)(ws + WS_WBA); const float* w = args.in[19];
      for (int i = gt; i < 16 * 1024; i += NGT) { const int n = i >> 10, k = i & 1023; dst[i] = (bf16)(pk2(w[(size_t)k * 3088 + 3072 + n], 0.f) & 0xffffu); } }
    for (int i = gt; i < 4 * 48 * 1024; i += NGT) {
        const int L = i / 49152, rem = i % 49152, n = rem >> 10, k = rem & 1023;
        const float w = n < 36 ? args.in[LBASE(L) + 4 + NMIX(L)][(size_t)k * 36 + n] : 0.f;
        const unsigned hi = pk2(w, 0.f) & 0xffffu; const float lo = w - bf1((unsigned short)hi);
        bf16* RH = (bf16*)(ws + WS_RTR + (size_t)L * 196608); RH[rem] = (bf16)hi; RH[49152 + rem] = (bf16)(pk2(lo, 0.f) & 0xffffu);
    }
}

__device__ __forceinline__ void dn_ba_tail(const Args& args, LAS unsigned char* lds) {
    int tid_ = threadIdx.x; asm volatile("" : "+v"(tid_)); const int tid = tid_, lane = tid & 63, wave = __builtin_amdgcn_readfirstlane(tid >> 6), G = gridDim.x, bid = blockIdx.x;
    unsigned char* ws = uni_ptr(args.ws); const bf16* H = (const bf16*)(ws + WS_ACT + A_H); const bf16* W = (const bf16*)(ws + WS_WBA); float* BA = (float*)(ws + WS_BA);
    const int r = lane & 15, q = lane >> 4;
    bool staged = false;
    for (int g0 = bid * NWAVES; g0 < T / 16; g0 += G * NWAVES) {
        const int grp = g0 + wave; const bool act = grp < T / 16;
        const bf16* hp = H + (size_t)((act ? grp : 0) * 16 + r) * 1024 + 8 * q;
        bf16x8 hf[32];
#pragma unroll
        for (int s = 0; s < 32; ++s) hf[s] = *(const bf16x8*)(hp + 32 * s);
        if (!staged) { staged = true;
#pragma unroll
            for (int i = 0; i < 4; ++i) { const int idx = tid * 4 + i, n = idx >> 7, c = idx & 127; *(LAS v4u*)(lds + n * 2064 + c * 16) = *(const v4u*)(W + (size_t)n * 1024 + c * 8); }
            __syncthreads(); }
        f32x4 acc = {0.f, 0.f, 0.f, 0.f};
#pragma unroll
        for (int s = 0; s < 32; ++s) acc = __builtin_amdgcn_mfma_f32_16x16x32_bf16(*(const LAS bf16x8*)(lds + r * 2064 + 64 * s + 16 * q), hf[s], acc, 0, 0, 0);
        if (act) *(f32x4*)(BA + (size_t)(grp * 16 + r) * 16 + 4 * q) = acc;
    }
    __syncthreads();
}
__device__ __forceinline__ void norm_store_row(const f32x4 (&v)[4], const float* __restrict__ gain, const float* __restrict__ shift, const float* __restrict__ scale, bf16* __restrict__ hrow, int lane) {
    float ss = 0.f;
#pragma unroll
    for (int j = 0; j < 4; ++j) ss += (v[j][0] * v[j][0] + v[j][1] * v[j][1]) + (v[j][2] * v[j][2] + v[j][3] * v[j][3]);
    const float rstd = __builtin_amdgcn_rsqf(wave_sum(ss) * (1.0f / 1024.0f) + EPS);
#pragma unroll
    for (int j = 0; j < 4; ++j) { const int c = 4 * lane + 256 * j;
        const f32x4 g = *(const f32x4*)(gain + c), sc = *(const f32x4*)(scale + c), sh = *(const f32x4*)(shift + c);
        const f32x4 h = v[j] * rstd * (g * (1.0f + sc)) + sh;
        v2u w; w.x = pk2(h[0], h[1]); w.y = pk2(h[2], h[3]); *(v2u*)(hrow + c) = w; }
}
__device__ __forceinline__ void phase_norm0(const Args& args, LAS unsigned char* lds) {
    int tid_ = threadIdx.x; asm volatile("" : "+v"(tid_)); const int tid = tid_, lane = tid & 63, wave = __builtin_amdgcn_readfirstlane(tid >> 6), G = gridDim.x, bid = blockIdx.x;
    unsigned char* ws = uni_ptr(args.ws);
    const float* X = args.in[0]; bf16* H = (bf16*)(ws + WS_ACT + A_H); const float* MOD = (const float*)(ws + WS_MOD);
    LAS float* vgs = (LAS float*)lds; LAS float* vsh = vgs + 2048;
    for (int i = tid; i < 2048; i += NTHR) { const int b = i >> 10, k = i & 1023; const float* m = MOD + (size_t)b * 6144; vgs[i] = args.in[2][k] * (1.0f + m[1024 + k]); vsh[i] = m[k]; }
    __syncthreads();
    for (int t = bid * NWAVES + wave; t < T; t += G * NWAVES) { const int b = t / SEQ; f32x4 v[4]; float ss = 0.f;
#pragma unroll
        for (int j = 0; j < 4; ++j) { v[j] = *(const f32x4*)(X + (size_t)t * 1024 + 4 * lane + 256 * j); ss += (v[j][0] * v[j][0] + v[j][1] * v[j][1]) + (v[j][2] * v[j][2] + v[j][3] * v[j][3]); }
        const float rstd = __builtin_amdgcn_rsqf(wave_sum(ss) * (1.0f / 1024.0f) + EPS);
#pragma unroll
        for (int j = 0; j < 4; ++j) { const int c = 4 * lane + 256 * j; const f32x4 gsv = *(const LAS f32x4*)(vgs + b * 1024 + c), shv = *(const LAS f32x4*)(vsh + b * 1024 + c);
            const f32x4 h = v[j] * rstd * gsv + shv; v2u w; w.x = pk2(h[0], h[1]); w.y = pk2(h[2], h[3]); *(v2u*)(H + (size_t)t * 1024 + c) = w; } }
}

__device__ __forceinline__ void phase_gm_spatial(const Args& args, int L, LAS unsigned char* lds) {
    int tid_ = threadIdx.x; asm volatile("" : "+v"(tid_)); const int tid = tid_, lane = tid & 63, wave = __builtin_amdgcn_readfirstlane(tid >> 6), G = gridDim.x, bid = blockIdx.x;
    unsigned char* ws = uni_ptr(args.ws); const int ib = LBASE(L) + 4;
    const float* v_norm = args.in[ib + 1]; const float* w_s = args.in[ib + 2]; const float* b_s = args.in[ib + 3];
    const bf16* U = (const bf16*)(ws + WS_ACT + A_U); const bf16* V = (const bf16*)(ws + WS_ACT + A_V); bf16* GT = (bf16*)(ws + WS_ACT + A_GATED);
    const float* VSSP = (const float*)(ws + WS_VSSP);
    LAS bf16* WL = (LAS bf16*)lds;
    LAS unsigned char* VT = lds + 34816;
    LAS float* rs = (LAS float*)(lds + 67584);
    typedef short s16x4 __attribute__((ext_vector_type(4)));
    const int wr = wave >> 2, wc = wave & 3, fr = lane & 15, fq = lane >> 4;
    const int trw = tid >> 2, sq = (tid & 3) * 32;
    v4u vq[4]; f32x4 wq[8]; float ssq = 0.f;
#define GS_LOAD(u_) do { const int c_ = (u_) >> 3, g_ = (u_) & 7; const unsigned tok0_ = (unsigned)c_ * 128u; \
        _Pragma("unroll") for (int i_ = 0; i_ < 4; ++i_) { const int p_ = tid + 512 * i_, row_ = p_ >> 4, c16_ = p_ & 15; vq[i_] = *(const v4u*)(V + (size_t)(tok0_ + row_) * 1024 + g_ * 128 + c16_ * 8); } \
        const float* wp_ = w_s + ((size_t)g_ * 128 + trw) * 128 + sq; _Pragma("unroll") for (int i_ = 0; i_ < 8; ++i_) wq[i_] = *(const f32x4*)(wp_ + 4 * i_); \
        if (tid < 128) { const float* p_ = VSSP + (size_t)(tok0_ + tid) * 16; float s_ = 0.f; _Pragma("unroll") for (int i_ = 0; i_ < 4; ++i_) { const f32x4 q_ = *(const f32x4*)(p_ + 4 * i_); s_ += (q_[0] + q_[1]) + (q_[2] + q_[3]); } ssq = s_; } } while (0)
    if (bid < 2048) GS_LOAD(bid);
    for (int u = bid; u < 2048; u += G) {
        const int c = u >> 3, g = u & 7; const size_t tok0 = (size_t)c * 128;
        __syncthreads();
        if (tid < 128) rs[tid] = __builtin_amdgcn_rsqf(ssq * (1.0f / 1024.0f) + EPS);
#pragma unroll
        for (int i = 0; i < 4; ++i) { const int p = tid + 512 * i, row = p >> 4, c16 = p & 15; *(LAS v4u*)(VT + row * 256 + (((c16 >> 1) ^ (row & 7)) << 5) + ((c16 & 1) << 4)) = vq[i]; }
        __syncthreads();
#pragma unroll
        for (int i = 0; i < 8; ++i) { float o[4];
#pragma unroll
            for (int e = 0; e < 4; ++e) { const int s = sq + 4 * i + e; o[e] = (s <= trw) ? wq[i][e] * rs[s] : 0.f; }
            v2u w; w.x = pk2(o[0], o[1]); w.y = pk2(o[2], o[3]); *(LAS v2u*)(WL + trw * 136 + sq + 4 * i) = w; }
        __syncthreads();
        if (u + G < 2048) GS_LOAD(u + G);
        f32x4 acc[2][4];
#pragma unroll
        for (int n = 0; n < 2; ++n)
#pragma unroll
            for (int m = 0; m < 4; ++m) acc[n][m] = (f32x4){0.f, 0.f, 0.f, 0.f};
#pragma unroll
        for (int ks = 0; ks < 4; ++ks) {
            if (32 * ks <= 64 * wr + 63) {
                bf16x8 vf[2], wf[4];
#pragma unroll
                for (int n = 0; n < 2; ++n) { const int ct = 2 * wc + n, r0 = 32 * ks + 4 * fq + (fr >> 2), r1 = r0 + 16;
                    const s16x4 lo = __builtin_amdgcn_ds_read_tr16_b64_v4i16((LAS s16x4*)(VT + r0 * 256 + ((ct ^ (r0 & 7)) << 5) + ((fr & 3) << 3)));
                    const s16x4 hi = __builtin_amdgcn_ds_read_tr16_b64_v4i16((LAS s16x4*)(VT + r1 * 256 + ((ct ^ (r1 & 7)) << 5) + ((fr & 3) << 3)));
                    vf[n] = (bf16x8){lo[0], lo[1], lo[2], lo[3], hi[0], hi[1], hi[2], hi[3]}; }
#pragma unroll
                for (int m = 0; m < 4; ++m) { const LAS bf16* wp = WL + (64 * wr + 16 * m + fr) * 136 + 32 * ks + 4 * fq; const v2u lo = *(const LAS v2u*)wp, hi = *(const LAS v2u*)(wp + 16);
                    v4u w; w.x = lo.x; w.y = lo.y; w.z = hi.x; w.w = hi.y; wf[m] = __builtin_bit_cast(bf16x8, w); }
#pragma unroll
                for (int n = 0; n < 2; ++n)
#pragma unroll
                    for (int m = 0; m < 4; ++m) if (32 * ks <= 64 * wr + 16 * m + 15) acc[n][m] = __builtin_amdgcn_mfma_f32_16x16x32_bf16(vf[n], wf[m], acc[n][m], 0, 0, 0);
            } }
#pragma unroll
        for (int m = 0; m < 4; ++m) { const int t = 64 * wr + 16 * m + fr; const float bs = b_s[g * 128 + t];
#pragma unroll
            for (int n = 0; n < 2; ++n) { const int d0 = g * 128 + 32 * wc + 16 * n + 4 * fq; const size_t off = (tok0 + t) * 1024 + d0;
                const v2u uu = *(const v2u*)(U + off); const f32x4 vn = *(const f32x4*)(v_norm + d0);
                const float o0 = bflo(uu.x) * (acc[n][m][0] * vn[0] + bs), o1 = bfhi(uu.x) * (acc[n][m][1] * vn[1] + bs), o2 = bflo(uu.y) * (acc[n][m][2] * vn[2] + bs), o3 = bfhi(uu.y) * (acc[n][m][3] * vn[3] + bs);
                v2u w; w.x = pk2(o0, o1); w.y = pk2(o2, o3); *(v2u*)(GT + off) = w; } }
    }
#undef GS_LOAD
}

__device__ __forceinline__ void phase_swa_attn(const Args& args, LAS unsigned char* lds) {
    int tid_ = threadIdx.x; asm volatile("" : "+v"(tid_)); const int tid = tid_, lane = tid & 63, wave = __builtin_amdgcn_readfirstlane(tid >> 6), G = gridDim.x, bid = blockIdx.x;
    unsigned char* ws = uni_ptr(args.ws);
    const float* q_norm = args.in[34]; const float* k_norm = args.in[35]; const float* sinks = args.in[36];
    const bf16* QKV = (const bf16*)(ws + WS_ACT + A_QKV); bf16* O = (bf16*)(ws + WS_ACT + A_H);
    LAS bf16* KL = (LAS bf16*)lds; LAS unsigned char* VL = lds + 36864; LAS float* nrm = (LAS float*)(lds + 69632);
    if (tid < 64) { nrm[tid] = q_norm[tid]; nrm[64 + tid] = k_norm[tid]; }
    typedef short s16x4 __attribute__((ext_vector_type(4)));
    const int fr = lane & 15, fq = lane >> 4, g = wave >> 1, qh = wave & 1;
    const int kkey = tid >> 1, khalf = tid & 1;
    v4u kq[4], qq[4][2];
#define SW_LOAD(u_) do { const int n_ = (u_) & 127, kvh_ = ((u_) >> 7) & 3, b_ = (u_) >> 9; const unsigned tok0_ = (unsigned)b_ * SEQ + (unsigned)n_ * 128u; \
        { const bool ok_ = (n_ > 0) || (kkey >= 128); const bf16* kp_ = QKV + ((ok_ ? tok0_ - 128u + (unsigned)kkey : tok0_) * 1536u + 1024u + (unsigned)(kvh_ * 64 + khalf * 32)); _Pragma("unroll") for (int i_ = 0; i_ < 4; ++i_) kq[i_] = *(const v4u*)(kp_ + 8 * i_); } \
        } while (0)
#define SW_LOADQ(u_, mt_) do { const int n_ = (u_) & 127, kvh_ = ((u_) >> 7) & 3, b_ = (u_) >> 9; const unsigned tok0_ = (unsigned)b_ * SEQ + (unsigned)n_ * 128u; \
        const bf16* qp_ = QKV + ((tok0_ + (unsigned)(qh * 64 + (mt_) * 16 + fr)) * 1536u + (unsigned)((kvh_ * 4 + g) * 64 + 8 * fq)); qq[mt_][0] = *(const v4u*)qp_; qq[mt_][1] = *(const v4u*)(qp_ + 32); } while (0)
    if (bid < 1024) { SW_LOAD(bid); SW_LOADQ(bid, 0); SW_LOADQ(bid, 1); SW_LOADQ(bid, 2); SW_LOADQ(bid, 3); }
    for (int u = bid; u < 1024; u += G) {
        const int n = u & 127, kvh = (u >> 7) & 3, b = u >> 9; const unsigned tok0 = (unsigned)b * SEQ + (unsigned)n * 128u;
        __syncthreads(); asm volatile("" ::: "memory");
        { float x[32]; float ss = 0.f; const bool ok = (n > 0) || (kkey >= 128);
#pragma unroll
          for (int i = 0; i < 4; ++i) { const unsigned w[4] = {kq[i].x, kq[i].y, kq[i].z, kq[i].w};
#pragma unroll
              for (int e = 0; e < 4; ++e) { x[8 * i + 2 * e] = bflo(w[e]); x[8 * i + 2 * e + 1] = bfhi(w[e]); } }
#pragma unroll
          for (int i = 0; i < 32; ++i) ss += x[i] * x[i];
          ss += __shfl_xor(ss, 1);
          const float rstd = ok ? __builtin_amdgcn_rsqf(ss * (1.0f / 64.0f) + EPS) : 0.f;
#pragma unroll
          for (int i = 0; i < 4; ++i) { float o[8];
#pragma unroll
              for (int e = 0; e < 8; ++e) o[e] = x[8 * i + e] * rstd * nrm[64 + khalf * 32 + 8 * i + e];
              v4u w; w.x = pk2(o[0], o[1]); w.y = pk2(o[2], o[3]); w.z = pk2(o[4], o[5]); w.w = pk2(o[6], o[7]);
              *(LAS v4u*)(KL + kkey * 72 + khalf * 32 + 8 * i) = w; } }
        { v4u vq[4];
#pragma unroll
          for (int i = 0; i < 4; ++i) { const int p = tid + 512 * i, key = p >> 3, c16 = p & 7; const bool ok = (n > 0) || (key >= 128);
              vq[i] = *(const v4u*)(QKV + ((ok ? tok0 - 128u + (unsigned)key : tok0) * 1536u + 1280u + (unsigned)(kvh * 64 + c16 * 8))); if (!ok) vq[i] = (v4u){0u, 0u, 0u, 0u}; }
#pragma unroll
          for (int i = 0; i < 4; ++i) { const int p = tid + 512 * i, key = p >> 3, c16 = p & 7; *(LAS v4u*)(VL + key * 128 + (((c16 >> 1) ^ ((key >> 1) & 3)) << 5) + ((c16 & 1) << 4)) = vq[i]; } }
        __syncthreads();
        if (u + G < 1024) SW_LOAD(u + G);
        const int hq = kvh * 4 + g; const float sink = sinks[hq];
#pragma unroll
        for (int mt = 0; mt < 4; ++mt) {
            asm volatile("" ::: "memory"); __builtin_amdgcn_sched_barrier(0);
            const int qi = qh * 64 + mt * 16 + fr, nb = qh * 4 + mt;
            bf16x8 qf[2];
            { float x[16]; float ss = 0.f;
#pragma unroll
              for (int ks = 0; ks < 2; ++ks) { const unsigned w[4] = {qq[mt][ks].x, qq[mt][ks].y, qq[mt][ks].z, qq[mt][ks].w};
#pragma unroll
                  for (int e = 0; e < 4; ++e) { x[8 * ks + 2 * e] = bflo(w[e]); x[8 * ks + 2 * e + 1] = bfhi(w[e]); } }
#pragma unroll
              for (int i = 0; i < 16; ++i) ss += x[i] * x[i];
              ss += __shfl_xor(ss, 16); ss += __shfl_xor(ss, 32);
              const float rstd = __builtin_amdgcn_rsqf(ss * (1.0f / 64.0f) + EPS) * 0.125f;
#pragma unroll
              for (int ks = 0; ks < 2; ++ks) { float o[8];
#pragma unroll
                  for (int e = 0; e < 8; ++e) o[e] = x[8 * ks + e] * rstd * nrm[32 * ks + 8 * fq + e];
                  v4u w; w.x = pk2(o[0], o[1]); w.y = pk2(o[2], o[3]); w.z = pk2(o[4], o[5]); w.w = pk2(o[6], o[7]); qf[ks] = __builtin_bit_cast(bf16x8, w); } }
            if (u + G < 1024) SW_LOADQ(u + G, mt);
            f32x4 s[10]; float mx = -INFINITY;
#pragma unroll
            for (int i = 0; i < 9; ++i) { const int nt = nb + i; f32x4 a = {0.f, 0.f, 0.f, 0.f};
#pragma unroll
                for (int ks = 0; ks < 2; ++ks) { const bf16x8 kf = *(const LAS bf16x8*)(KL + (16 * nt + fr) * 72 + 32 * ks + 8 * fq); a = __builtin_amdgcn_mfma_f32_16x16x32_bf16(kf, qf[ks], a, 0, 0, 0); }
#pragma unroll
                for (int r = 0; r < 4; ++r) { const int kj = 16 * nt + 4 * fq + r; const bool valid = (kj > qi) && (kj <= qi + 128) && ((n > 0) || (kj >= 128)); a[r] = valid ? a[r] : -INFINITY; mx = fmaxf(mx, a[r]); }
                s[i] = a; }
            mx = fmaxf(mx, __shfl_xor(mx, 16)); mx = fmaxf(mx, __shfl_xor(mx, 32)); mx = fmaxf(mx, sink);
            float l = 0.f;
#pragma unroll
            for (int i = 0; i < 9; ++i)
#pragma unroll
                for (int r = 0; r < 4; ++r) { const float p = fast_exp(s[i][r] - mx); s[i][r] = p; l += p; }
            s[9] = (f32x4){0.f, 0.f, 0.f, 0.f};
            l += __shfl_xor(l, 16); l += __shfl_xor(l, 32); l += fast_exp(sink - mx);
            f32x4 o[4];
#pragma unroll
            for (int dt = 0; dt < 4; ++dt) o[dt] = (f32x4){0.f, 0.f, 0.f, 0.f};
#pragma unroll
            for (int st = 0; st < 5; ++st) {
                v4u pw; pw.x = pk2(s[2 * st][0], s[2 * st][1]); pw.y = pk2(s[2 * st][2], s[2 * st][3]); pw.z = pk2(s[2 * st + 1][0], s[2 * st + 1][1]); pw.w = pk2(s[2 * st + 1][2], s[2 * st + 1][3]);
                const bf16x8 pf = __builtin_bit_cast(bf16x8, pw);
                const int k0 = 16 * (nb + 2 * st) + 4 * fq + (fr >> 2); const int k1r = k0 + 16, k1 = k1r > 255 ? 255 : k1r;
#pragma unroll
                for (int dt = 0; dt < 4; ++dt) {
                    const s16x4 lo = __builtin_amdgcn_ds_read_tr16_b64_v4i16((LAS s16x4*)(VL + k0 * 128 + ((dt ^ ((k0 >> 1) & 3)) << 5) + ((fr & 3) << 3)));
                    const s16x4 hi = __builtin_amdgcn_ds_read_tr16_b64_v4i16((LAS s16x4*)(VL + k1 * 128 + ((dt ^ ((k1 >> 1) & 3)) << 5) + ((fr & 3) << 3)));
                    const bf16x8 vf = (bf16x8){lo[0], lo[1], lo[2], lo[3], hi[0], hi[1], hi[2], hi[3]};
                    o[dt] = __builtin_amdgcn_mfma_f32_16x16x32_bf16(vf, pf, o[dt], 0, 0, 0); } }
            const float inv = 1.0f / l;
#pragma unroll
            for (int dt = 0; dt < 4; ++dt) { v2u w; w.x = pk2(o[dt][0] * inv, o[dt][1] * inv); w.y = pk2(o[dt][2] * inv, o[dt][3] * inv);
                *(v2u*)(O + ((tok0 + (unsigned)qi) * 1024u + (unsigned)(hq * 64 + 16 * dt + 4 * fq))) = w; }
            __builtin_amdgcn_sched_barrier(0);
        }
    }
#undef SW_LOAD
#undef SW_LOADQ
}

__device__ __forceinline__ void phase_dn_prep(const Args& args, LAS unsigned char* lds) {
    int tid_ = threadIdx.x; asm volatile("" : "+v"(tid_)); const int tid = tid_, lane = tid & 63, wave = __builtin_amdgcn_readfirstlane(tid >> 6), G = gridDim.x, bid = blockIdx.x;
    unsigned char* ws = uni_ptr(args.ws); const float* conv_w = args.in[20]; const float* a_log = args.in[21]; const float* dt_bias = args.in[22];
    const bf16* QKV = (const bf16*)(ws + WS_ACT + A_QKV); bf16* QN = (bf16*)(ws + WS_ACT + A_QN); bf16* KN = (bf16*)(ws + WS_ACT + A_KN); bf16* VV = (bf16*)(ws + WS_ACT + A_VV);
    const float* BA = (const float*)(ws + WS_BA); float* DNB = (float*)(ws + WS_DNB);
    constexpr int RUN = 16;
    LAS float* cwl = (LAS float*)lds;
    for (int i = tid; i < 2048; i += NTHR) *(LAS f32x4*)(cwl + 4 * i) = *(const f32x4*)(conv_w + 4 * i);
    __syncthreads();
    const float alg = lane < 8 ? -expf(a_log[lane]) : 0.f, dtb = lane < 8 ? dt_bias[lane] : 0.f;
    for (int run = bid * NWAVES + wave; run < T / RUN; run += G * NWAVES) {
        const int tbeg = run * RUN, pos0 = tbeg % SEQ;
        v4u rows[3][4];
#pragma unroll
        for (int d = 0; d < 3; ++d)
#pragma unroll
            for (int j = 0; j < 4; ++j) rows[d][j] = (pos0 - 3 + d >= 0) ? *(const v4u*)(QKV + (size_t)(tbeg - 3 + d) * 2048 + 8 * lane + 512 * j) : (v4u){0u, 0u, 0u, 0u};
#pragma unroll 1
        for (int i = 0; i < RUN; ++i) { const int t = tbeg + i;
            v4u cur[4];
#pragma unroll
            for (int j = 0; j < 4; ++j) cur[j] = *(const v4u*)(QKV + (size_t)t * 2048 + 8 * lane + 512 * j);
            float bi = 0.f, ai = 0.f; if (lane < 8) { bi = BA[(size_t)t * 16 + lane]; ai = BA[(size_t)t * 16 + 8 + lane] + dtb; }
#pragma unroll
            for (int j = 0; j < 4; ++j) { float a[8];
#pragma unroll
                for (int e = 0; e < 8; ++e) a[e] = 0.f;
#pragma unroll
                for (int tap = 0; tap < 4; ++tap) { const v4u q = tap < 3 ? rows[tap][j] : cur[j]; const f32x4 w0 = *(const LAS f32x4*)(cwl + tap * 2048 + 8 * lane + 512 * j), w1 = *(const LAS f32x4*)(cwl + tap * 2048 + 8 * lane + 512 * j + 4);
                    a[0] += w0[0] * bflo(q.x); a[1] += w0[1] * bfhi(q.x); a[2] += w0[2] * bflo(q.y); a[3] += w0[3] * bfhi(q.y); a[4] += w1[0] * bflo(q.z); a[5] += w1[1] * bfhi(q.z); a[6] += w1[2] * bflo(q.w); a[7] += w1[3] * bfhi(q.w); }
                float ss = 0.f;
#pragma unroll
                for (int e = 0; e < 8; ++e) { a[e] = siluf_(a[e]); ss += a[e] * a[e]; }
                if (j < 2) { ss += __shfl_xor(ss, 1); ss += __shfl_xor(ss, 2); ss += __shfl_xor(ss, 4); ss += __shfl_xor(ss, 8);
                    const float r = __builtin_amdgcn_rsqf(ss + EPS); bf16* dst = (j == 0 ? QN : KN) + (size_t)t * 512 + 8 * lane;
                    v4u w; w.x = pk2(a[0] * r, a[1] * r); w.y = pk2(a[2] * r, a[3] * r); w.z = pk2(a[4] * r, a[5] * r); w.w = pk2(a[6] * r, a[7] * r); *(v4u*)dst = w; }
                else { v4u w; w.x = pk2(a[0], a[1]); w.y = pk2(a[2], a[3]); w.z = pk2(a[4], a[5]); w.w = pk2(a[6], a[7]); *(v4u*)(VV + (size_t)t * 1024 + 8 * lane + 512 * (j - 2)) = w; } }
            if (lane < 8) { const float sp = fmaxf(ai, 0.f) + log1pf(expf(-fabsf(ai)));
                DNB[(size_t)t * 16 + lane] = 1.0f / (1.0f + expf(-bi)); DNB[(size_t)t * 16 + 8 + lane] = alg * sp; }
#pragma unroll
            for (int j = 0; j < 4; ++j) { rows[0][j] = rows[1][j]; rows[1][j] = rows[2][j]; rows[2][j] = cur[j]; }
        }
    }
}
constexpr int FA_STRIDE = 25600, FB_STRIDE = 32768, FU_STRIDE = 16384;
constexpr float DN_SCALE = 0.08838834764831845f;
__device__ __forceinline__ void phase_dn_chunk(const Args& args, LAS unsigned char* lds) {
    int tid_ = threadIdx.x; asm volatile("" : "+v"(tid_)); const int tid = tid_, lane = tid & 63, wave = __builtin_amdgcn_readfirstlane(tid >> 6), G = gridDim.x, bid = blockIdx.x;
    unsigned char* ws = uni_ptr(args.ws);
    const bf16* QN = (const bf16*)(ws + WS_ACT + A_QN); const bf16* KN = (const bf16*)(ws + WS_ACT + A_KN); const bf16* VV = (const bf16*)(ws + WS_ACT + A_VV);
    const float* DNB = (const float*)(ws + WS_DNB);
    unsigned char* FA = ws + WS_ACT + A_FA; unsigned char* FB = ws + WS_ACT + A_FB; unsigned char* FU = ws + WS_ACT + A_FU;
    LAS float* Al = (LAS float*)(lds + wave * 16384);
    LAS float* tb = (LAS float*)(lds + LDSCTL_OFF + 2048 + wave * 512);
    const int fr = lane & 15, fq = lane >> 4;
    for (int it = bid * NWAVES + wave; it < 4096; it += G * NWAVES) {
        const int b = it >> 11, hv = (it >> 8) & 7, n = it & 255, hq = hv >> 1; const unsigned t0 = (unsigned)b * SEQ + (unsigned)n * 64; const int itq = (b * 4 + hq) * 256 + n;
        unsigned char* fa = FA + (size_t)it * FA_STRIDE; unsigned char* fb = FB + (size_t)itq * FB_STRIDE;
        const float bv = DNB[(t0 + lane) * 16 + hv]; float gcv = DNB[(t0 + lane) * 16 + 8 + hv];
#pragma unroll
        for (int o = 1; o < 64; o <<= 1) { const float t = __shfl_up(gcv, o); if (lane >= o) gcv += t; }
        const float gll = __shfl(gcv, 63);
        tb[lane] = gcv; tb[64 + lane] = bv;
        { float* fe = (float*)(fa + 24576); fe[lane] = DN_SCALE * expf(gcv); fe[64 + lane] = expf(gll - gcv); fe[128 + lane] = expf(gll); }
        asm volatile("" ::: "memory");
        bf16x8 kf[4][4];
#pragma unroll
        for (int t = 0; t < 4; ++t)
#pragma unroll
            for (int ks = 0; ks < 4; ++ks) kf[t][ks] = *(const bf16x8*)(KN + (t0 + 16 * t + fr) * 512 + hq * 128 + 32 * ks + 8 * fq);
#pragma unroll
        for (int m = 0; m < 4; ++m) { const int c = 16 * m + fr; const float bm = tb[64 + c], gm = tb[c];
            bf16x8 qf[4];
#pragma unroll
            for (int ks = 0; ks < 4; ++ks) qf[ks] = *(const bf16x8*)(QN + (t0 + c) * 512 + hq * 128 + 32 * ks + 8 * fq);
            f32x4 tl[4];
#pragma unroll
            for (int t = 0; t < 4; ++t) {
                if (t <= m) { f32x4 ak = {0.f, 0.f, 0.f, 0.f}, aq = {0.f, 0.f, 0.f, 0.f};
#pragma unroll
                    for (int ks = 0; ks < 4; ++ks) { ak = __builtin_amdgcn_mfma_f32_16x16x32_bf16(kf[t][ks], kf[m][ks], ak, 0, 0, 0); aq = __builtin_amdgcn_mfma_f32_16x16x32_bf16(kf[t][ks], qf[ks], aq, 0, 0, 0); }
                    const f32x4 gs4 = *(const LAS f32x4*)(tb + 16 * t + 4 * fq); f32x4 av;
#pragma unroll
                    for (int r = 0; r < 4; ++r) { const int s = 16 * t + 4 * fq + r; const float dec = fast_exp(fminf(gm - gs4[r], 0.f)); av[r] = (s < c) ? bm * ak[r] * dec : 0.f; tl[t][r] = (s <= c) ? DN_SCALE * aq[r] * dec : 0.f; }
                    *(LAS f32x4*)(Al + c * 64 + 16 * t + 4 * fq) = av; }
                else tl[t] = (f32x4){0.f, 0.f, 0.f, 0.f}; }
#pragma unroll
            for (int k2 = 0; k2 < 2; ++k2) { v4u w; w.x = pk2(tl[2 * k2][0], tl[2 * k2][1]); w.y = pk2(tl[2 * k2][2], tl[2 * k2][3]); w.z = pk2(tl[2 * k2 + 1][0], tl[2 * k2 + 1][1]); w.w = pk2(tl[2 * k2 + 1][2], tl[2 * k2 + 1][3]);
                *(v4u*)(fa + 16384 + (m * 2 + k2) * 1024 + lane * 16) = w; } }
        asm volatile("s_waitcnt lgkmcnt(0)" ::: "memory");
        float Tc[64];
#pragma unroll
        for (int m = 0; m < 64; ++m) Tc[m] = (m == lane) ? 1.f : 0.f;
#pragma unroll
        for (int r = 1; r < 64; ++r) { float acc = 0.f;
#pragma unroll
            for (int m4 = 0; m4 < (r + 3) / 4; ++m4) { const f32x4 a4 = *(const LAS f32x4*)(Al + r * 64 + 4 * m4);
#pragma unroll
                for (int e = 0; e < 4; ++e) if (4 * m4 + e < r) acc += a4[e] * Tc[4 * m4 + e]; }
            Tc[r] -= acc; if ((r & 3) == 3) __builtin_amdgcn_sched_barrier(0); }
        asm volatile("s_waitcnt lgkmcnt(0)" ::: "memory");
        LAS bf16* T1l = (LAS bf16*)Al; LAS bf16* T2l = T1l + 4096;
        { const float c1 = bv, c2 = bv * expf(gcv);
#pragma unroll
          for (int i = 0; i < 64; ++i) { T1l[i * 64 + lane] = (bf16)(pk2(Tc[i] * c1, 0.f) & 0xffffu); T2l[i * 64 + lane] = (bf16)(pk2(Tc[i] * c2, 0.f) & 0xffffu); } }
        asm volatile("s_waitcnt lgkmcnt(0)" ::: "memory");
        bf16x8 t1f[4][2], t2f[4][2];
#pragma unroll
        for (int m = 0; m < 4; ++m)
#pragma unroll
            for (int k2 = 0; k2 < 2; ++k2) { const int o = (16 * m + fr) * 64 + 32 * k2 + 4 * fq;
                { const v2u lo = *(const LAS v2u*)(T1l + o), hi = *(const LAS v2u*)(T1l + o + 16); v4u w; w.x = lo.x; w.y = lo.y; w.z = hi.x; w.w = hi.y; t1f[m][k2] = __builtin_bit_cast(bf16x8, w); }
                { const v2u lo = *(const LAS v2u*)(T2l + o), hi = *(const LAS v2u*)(T2l + o + 16); v4u w; w.x = lo.x; w.y = lo.y; w.z = hi.x; w.w = hi.y; t2f[m][k2] = __builtin_bit_cast(bf16x8, w); } }
        asm volatile("s_waitcnt lgkmcnt(0)" ::: "memory");
        LAS unsigned char* tile = (LAS unsigned char*)Al;
        typedef short s16x4 __attribute__((ext_vector_type(4)));
#define DN_STAGE_TILE(src, pitch, coff) do { _Pragma("unroll") for (int hb_ = 0; hb_ < 2; ++hb_) { v4u pv[8]; _Pragma("unroll") for (int it_ = 0; it_ < 8; ++it_) { const int p_ = lane + 64 * (it_ + 8 * hb_), row_ = p_ >> 4, c16_ = p_ & 15; pv[it_] = *(const v4u*)((src) + (t0 + row_) * (pitch) + (coff) + c16_ * 8); } \
            _Pragma("unroll") for (int it_ = 0; it_ < 8; ++it_) { const int p_ = lane + 64 * (it_ + 8 * hb_), row_ = p_ >> 4, c16_ = p_ & 15; *(LAS v4u*)(tile + row_ * 256 + (((c16_ >> 1) ^ (row_ & 7)) << 5) + ((c16_ & 1) << 4)) = pv[it_]; } } } while (0)
#define DN_TR_FRAG(dst, ct, k2) do { const int r0_ = 32 * (k2) + 4 * fq + (fr >> 2), r1_ = r0_ + 16; \
            const s16x4 lo_ = __builtin_amdgcn_ds_read_tr16_b64_v4i16((LAS s16x4*)(tile + r0_ * 256 + ((((ct)) ^ (r0_ & 7)) << 5) + ((fr & 3) << 3))); \
            const s16x4 hi_ = __builtin_amdgcn_ds_read_tr16_b64_v4i16((LAS s16x4*)(tile + r1_ * 256 + ((((ct)) ^ (r1_ & 7)) << 5) + ((fr & 3) << 3))); \
            dst = (bf16x8){lo_[0], lo_[1], lo_[2], lo_[3], hi_[0], hi_[1], hi_[2], hi_[3]}; } while (0)
        DN_STAGE_TILE(VV, 1024, hv * 128);
        asm volatile("s_waitcnt lgkmcnt(0)" ::: "memory");
#pragma unroll 1
        for (int j = 0; j < 8; ++j) { bf16x8 vf[2];
            DN_TR_FRAG(vf[0], j, 0); DN_TR_FRAG(vf[1], j, 1);
#pragma unroll
            for (int m = 0; m < 4; ++m) { f32x4 a = {0.f, 0.f, 0.f, 0.f};
#pragma unroll
                for (int k2 = 0; k2 < 2; ++k2) a = __builtin_amdgcn_mfma_f32_16x16x32_bf16(t1f[m][k2], vf[k2], a, 0, 0, 0);
                v2u w; w.x = pk2(a[0], a[1]); w.y = pk2(a[2], a[3]); *(v2u*)(FU + (size_t)it * FU_STRIDE + ((j * 4 + m) * 64 + lane) * 8) = w; } }
        asm volatile("s_waitcnt lgkmcnt(0)" ::: "memory");
        DN_STAGE_TILE(KN, 512, hq * 128);
        asm volatile("s_waitcnt lgkmcnt(0)" ::: "memory");
        if ((hv & 1) == 0) { int fr2 = fr, fq2 = fq; asm volatile("" : "+v"(fr2), "+v"(fq2));
#pragma unroll
            for (int m = 0; m < 4; ++m)
#pragma unroll
                for (int ks = 0; ks < 4; ++ks) { const bf16* qp = QN + (t0 + 16 * m + fr2) * 512 + hq * 128 + 32 * ks + 4 * fq2; const v2u lo = *(const v2u*)qp, hi = *(const v2u*)(qp + 16);
                    v4u w; w.x = lo.x; w.y = lo.y; w.z = hi.x; w.w = hi.y; *(v4u*)(fb + (m * 4 + ks) * 1024 + lane * 16) = w; } }
#pragma unroll 1
        for (int dh = 0; dh < 2; ++dh) { bf16x8 ktf[4][2];
#pragma unroll
            for (int d4 = 0; d4 < 4; ++d4) { DN_TR_FRAG(ktf[d4][0], 4 * dh + d4, 0); DN_TR_FRAG(ktf[d4][1], 4 * dh + d4, 1); }
            if ((hv & 1) == 0) {
#pragma unroll
                for (int d4 = 0; d4 < 4; ++d4)
#pragma unroll
                    for (int k2 = 0; k2 < 2; ++k2) *(bf16x8*)(fb + 16384 + ((4 * dh + d4) * 2 + k2) * 1024 + lane * 16) = ktf[d4][k2]; }
#pragma unroll
            for (int m = 0; m < 4; ++m) { f32x4 acc[4];
#pragma unroll
                for (int d4 = 0; d4 < 4; ++d4) { acc[d4] = (f32x4){0.f, 0.f, 0.f, 0.f};
#pragma unroll
                    for (int k2 = 0; k2 < 2; ++k2) acc[d4] = __builtin_amdgcn_mfma_f32_16x16x32_bf16(ktf[d4][k2], t2f[m][k2], acc[d4], 0, 0, 0); }
#pragma unroll
                for (int kk = 0; kk < 2; ++kk) { v4u w; w.x = pk2(-acc[2 * kk][0], -acc[2 * kk][1]); w.y = pk2(-acc[2 * kk][2], -acc[2 * kk][3]); w.z = pk2(-acc[2 * kk + 1][0], -acc[2 * kk + 1][1]); w.w = pk2(-acc[2 * kk + 1][2], -acc[2 * kk + 1][3]);
                    *(v4u*)(fa + (m * 4 + 2 * dh + kk) * 1024 + lane * 16) = w; } } }
        asm volatile("s_waitcnt lgkmcnt(0)" ::: "memory");
#undef DN_STAGE_TILE
#undef DN_TR_FRAG
    }
}
__device__ __forceinline__ void phase_dn_scan(const Args& args, LAS unsigned char* lds) {
    int tid_ = threadIdx.x; asm volatile("" : "+v"(tid_)); const int tid = tid_, lane = tid & 63, wave = __builtin_amdgcn_readfirstlane(tid >> 6), G = gridDim.x, bid = blockIdx.x;
    if (bid >= 128) {
        const int gw = (bid - 128) * NWAVES + wave, NGW = (G - 128) * NWAVES;
        convert_weights(args, lds, CV_SPLIT, CV_N_EXP, gw, NGW); convert_weights(args, lds, CV_N_EXP + CV_MIX_L01, CV_N_EXP + CV_N_MIXI, gw, NGW); return; }
    unsigned char* ws = uni_ptr(args.ws);
    const unsigned char* FA = ws + WS_ACT + A_FA; const unsigned char* FB = ws + WS_ACT + A_FB; const unsigned char* FU = ws + WS_ACT + A_FU;
    unsigned char* SFR = ws + WS_ACT + A_SFR; unsigned char* VFR = ws + WS_ACT + A_VFR;
    const int fq = lane >> 4;
    constexpr int SLOT = 35840, O_TB = 16384, O_KT = 17408, O_U = 33792, STG_S = 107520, STG_V = 115712;
#define SB() __builtin_amdgcn_sched_barrier(0)
#define WGBAR() do { asm volatile("" ::: "memory"); __builtin_amdgcn_s_barrier(); asm volatile("" ::: "memory"); } while (0)
#define DN_AUX 0
#define DMA4(g, l) do { __builtin_amdgcn_global_load_lds((g), (l), 16, 0, DN_AUX); __builtin_amdgcn_global_load_lds((g), (l), 16, 1024, DN_AUX); __builtin_amdgcn_global_load_lds((g), (l), 16, 2048, DN_AUX); __builtin_amdgcn_global_load_lds((g), (l), 16, 3072, DN_AUX); } while (0)
    for (int sidx = bid; sidx < 128; sidx += G) {
        const int bh = (sidx & 7) * 2 + (sidx >> 6), j = (sidx >> 3) & 7, b = bh >> 3, hv = bh & 7, hq = hv >> 1;
        const int it0 = bh * 256, itq0 = (b * 4 + hq) * 256;
#define VMW(n_) asm volatile("s_waitcnt vmcnt(" #n_ ")" ::: "memory")
        if (wave == 1 || wave == 4 || wave == 6 || wave == 7) {
            const int qa = wave == 1 ? 0 : (wave == 4 ? 1 : (wave == 6 ? 2 : 3));
#define DN_ISSUE_A(nn) do { LAS unsigned char* sl_ = lds + ((nn) % 3) * SLOT; const unsigned char* fa_ = FA + (size_t)(it0 + (nn)) * FA_STRIDE + lane * 16; \
                DMA4((const unsigned*)(fa_ + qa * 4096), (LAS unsigned*)(sl_ + qa * 4096)); \
                if (wave == 1) __builtin_amdgcn_global_load_lds((const unsigned*)(fa_ + 24576), (LAS unsigned*)(sl_ + O_TB), 16, 0, DN_AUX); \
                if (wave == 4) { const unsigned char* fu_ = FU + (size_t)(it0 + (nn)) * FU_STRIDE + j * 2048 + lane * 16; \
                    __builtin_amdgcn_global_load_lds((const unsigned*)(fu_), (LAS unsigned*)(sl_ + O_U), 16, 0, DN_AUX); __builtin_amdgcn_global_load_lds((const unsigned*)(fu_), (LAS unsigned*)(sl_ + O_U), 16, 1024, DN_AUX); } } while (0)
#define DN_WAIT_A(k) do { if ((k) == 0) VMW(0); else if (wave == 1) { if ((k) == 2) VMW(10); else VMW(5); } else if (wave == 4) { if ((k) == 2) VMW(12); else VMW(6); } else { if ((k) == 2) VMW(8); else VMW(4); } } while (0)
            DN_ISSUE_A(0); DN_ISSUE_A(1); DN_ISSUE_A(2);
            DN_WAIT_A(2);
            if (wave == 7) {
#pragma unroll 1
                for (int n = 0; n < 256; ++n) {
                    WGBAR();
                    WGBAR();
                    { unsigned char* sfo = SFR + ((size_t)(it0 + n) * 8 + j) * 4096 + lane * 16; const LAS unsigned char* ss_ = lds + STG_S + (n & 1) * 4096 + lane * 16;
#pragma unroll
                      for (int ks = 0; ks < 4; ++ks) *(bf16x8*)(sfo + ks * 1024) = *(const LAS bf16x8*)(ss_ + ks * 1024);
                      if (n > 0) { unsigned char* vfo = VFR + ((size_t)(it0 + n - 1) * 8 + j) * 2048 + lane * 16; const LAS unsigned char* sv_ = lds + STG_V + ((n - 1) & 1) * 2048 + lane * 16;
#pragma unroll
                          for (int k2 = 0; k2 < 2; ++k2) *(bf16x8*)(vfo + k2 * 1024) = *(const LAS bf16x8*)(sv_ + k2 * 1024); } }
                    asm volatile("" ::: "memory");
                    if (n + 3 < 256) { DN_ISSUE_A(n + 3); if (n == 0) VMW(12); else VMW(18); }
                    else if (n + 2 < 256) VMW(16);
                    else if (n + 1 < 256) VMW(12);
                }
            } else {
#pragma unroll 1
            for (int n = 0; n < 256; ++n) {
                WGBAR();
                WGBAR();
                if (n + 3 < 256) { DN_ISSUE_A(n + 3); DN_WAIT_A(2); }
                else if (n + 2 < 256) DN_WAIT_A(1);
                else DN_WAIT_A(0);
            }
            }
#undef DN_ISSUE_A
#undef DN_WAIT_A
        } else if (wave == 2 || wave == 3 || wave == 5) {
            const int p0 = wave == 2 ? 0 : (wave == 3 ? 6 : 11);
#define DN_ISSUE_B(nn) do { LAS unsigned char* sl_ = lds + ((nn) % 3) * SLOT + O_KT + p0 * 1024; const unsigned char* fb_ = FB + (size_t)(itq0 + (nn)) * FB_STRIDE + 16384 + p0 * 1024 + lane * 16; \
                DMA4((const unsigned*)(fb_), (LAS unsigned*)(sl_)); __builtin_amdgcn_global_load_lds((const unsigned*)(fb_ + 4096), (LAS unsigned*)(sl_ + 4096), 16, 0, DN_AUX); \
                if (wave == 2) __builtin_amdgcn_global_load_lds((const unsigned*)(fb_ + 4096), (LAS unsigned*)(sl_ + 4096), 16, 1024, DN_AUX); } while (0)
#define DN_WAIT_B(k) do { if ((k) == 0) VMW(0); else if (wave == 2) { if ((k) == 2) VMW(12); else VMW(6); } else { if ((k) == 2) VMW(10); else VMW(5); } } while (0)
            DN_ISSUE_B(0); DN_ISSUE_B(1);
#pragma unroll 1
            for (int n = 0; n < 256; ++n) {
                WGBAR();
                if (n + 2 < 256) { DN_ISSUE_B(n + 2); DN_WAIT_B(2); }
                else if (n + 1 < 256) DN_WAIT_B(1);
                else DN_WAIT_B(0);
                WGBAR();
            }
#undef DN_ISSUE_B
#undef DN_WAIT_B
        } else {
        f32x4 S[8];
#pragma unroll
        for (int dt = 0; dt < 8; ++dt) S[dt] = (f32x4){0.f, 0.f, 0.f, 0.f};
        bf16x8 sf[4];
#pragma unroll
        for (int ks = 0; ks < 4; ++ks) sf[ks] = (bf16x8){0, 0, 0, 0, 0, 0, 0, 0};
        int slot = 0;
#pragma unroll 1
        for (int n = 0; n < 256; ++n) {
            WGBAR();
            const LAS unsigned char* sbase = lds + slot * SLOT; const LAS unsigned char* base = sbase + lane * 16;
#pragma unroll
            for (int ks = 0; ks < 4; ++ks) *(LAS bf16x8*)(lds + STG_S + (n & 1) * 4096 + ks * 1024 + lane * 16) = sf[ks];
            const LAS float* tbl = (const LAS float*)(sbase + O_TB);
            f32x4 ekd[4], av[4];
#pragma unroll
            for (int m = 0; m < 4; ++m) { ekd[m] = *(const LAS f32x4*)(tbl + 64 + 16 * m + 4 * fq);
                const v2u u2 = *(const LAS v2u*)(sbase + O_U + (m * 64 + lane) * 8); av[m] = (f32x4){bflo(u2.x), bfhi(u2.x), bflo(u2.y), bfhi(u2.y)}; }
            const float gl = tbl[128 + lane];
            SB();
            bf16x8 Aw[16];
#pragma unroll
            for (int f = 0; f < 16; ++f) Aw[f] = *(const LAS bf16x8*)(base + f * 1024);
            SB();
#pragma unroll
            for (int ks = 0; ks < 4; ++ks) {
#pragma unroll
                for (int m = 0; m < 4; ++m) av[m] = __builtin_amdgcn_mfma_f32_16x16x32_bf16(Aw[m * 4 + ks], sf[ks], av[m], 0, 0, 0);
                SB(); }
            asm volatile("s_waitcnt lgkmcnt(0)" ::: "memory");
            WGBAR();
            bf16x8 Ck[16];
#pragma unroll
            for (int f = 0; f < 16; ++f) Ck[f] = *(const LAS bf16x8*)(base + O_KT + f * 1024);
#pragma unroll
            for (int dt = 0; dt < 8; ++dt) S[dt] = S[dt] * gl;
            bf16x8 vf[2], vpf[2];
#pragma unroll
            for (int k2 = 0; k2 < 2; ++k2) { v4u w; w.x = pk2(av[2 * k2][0], av[2 * k2][1]); w.y = pk2(av[2 * k2][2], av[2 * k2][3]); w.z = pk2(av[2 * k2 + 1][0], av[2 * k2 + 1][1]); w.w = pk2(av[2 * k2 + 1][2], av[2 * k2 + 1][3]); vf[k2] = __builtin_bit_cast(bf16x8, w);
                const f32x4 p0 = av[2 * k2] * ekd[2 * k2], p1 = av[2 * k2 + 1] * ekd[2 * k2 + 1];
                v4u x; x.x = pk2(p0[0], p0[1]); x.y = pk2(p0[2], p0[3]); x.z = pk2(p1[0], p1[1]); x.w = pk2(p1[2], p1[3]); vpf[k2] = __builtin_bit_cast(bf16x8, x); }
#pragma unroll
            for (int k2 = 0; k2 < 2; ++k2) *(LAS bf16x8*)(lds + STG_V + (n & 1) * 2048 + k2 * 1024 + lane * 16) = vf[k2];
            SB();
#pragma unroll
            for (int k2 = 0; k2 < 2; ++k2)
#pragma unroll
                for (int dt = 0; dt < 8; ++dt) S[dt] = __builtin_amdgcn_mfma_f32_16x16x32_bf16(Ck[dt * 2 + k2], vpf[k2], S[dt], 0, 0, 0);
            SB();
#pragma unroll
            for (int ks = 0; ks < 4; ++ks) { v4u w; w.x = pk2(S[2 * ks][0], S[2 * ks][1]); w.y = pk2(S[2 * ks][2], S[2 * ks][3]); w.z = pk2(S[2 * ks + 1][0], S[2 * ks + 1][1]); w.w = pk2(S[2 * ks + 1][2], S[2 * ks + 1][3]); sf[ks] = __builtin_bit_cast(bf16x8, w); }
            asm volatile("s_waitcnt lgkmcnt(0)" ::: "memory");
            slot = (slot == 2) ? 0 : slot + 1;
        }
        }
        __syncthreads();
        if (wave == 7) { unsigned char* vfo = VFR + ((size_t)(it0 + 255) * 8 + j) * 2048 + lane * 16; const LAS unsigned char* sv_ = lds + STG_V + 2048 + lane * 16;
#pragma unroll
            for (int k2 = 0; k2 < 2; ++k2) *(bf16x8*)(vfo + k2 * 1024) = *(const LAS bf16x8*)(sv_ + k2 * 1024); }
        __syncthreads();
    }
#undef SB
#undef DMA4
#undef WGBAR
#undef DN_AUX
#undef VMW
}
__device__ __forceinline__ void phase_dn_out(const Args& args, LAS unsigned char* lds) {
    int tid_ = threadIdx.x; asm volatile("" : "+v"(tid_)); const int tid = tid_, lane = tid & 63, wave = __builtin_amdgcn_readfirstlane(tid >> 6), G = gridDim.x, bid = blockIdx.x; (void)tid;
    unsigned char* ws = uni_ptr(args.ws); const float* o_norm = args.in[23];
    const bf16* QN = (const bf16*)(ws + WS_ACT + A_QN); const unsigned char* FA = ws + WS_ACT + A_FA; const unsigned char* SFR = ws + WS_ACT + A_SFR; const unsigned char* VFR = ws + WS_ACT + A_VFR;
    const bf16* Z = (const bf16*)(ws + WS_ACT + A_Z); bf16* GT = (bf16*)(ws + WS_ACT + A_H);
    LAS bf16* ot = (LAS bf16*)(lds + wave * 16384);
    const int fr = lane & 15, fq = lane >> 4;
    float on[8];
#pragma unroll
    for (int e = 0; e < 8; ++e) on[e] = o_norm[8 * fr + e];
    for (int it = bid * NWAVES + wave; it < 4096; it += G * NWAVES) {
        const int b = it >> 11, hv = (it >> 8) & 7, n = it & 255, hq = hv >> 1; const unsigned t0 = (unsigned)b * SEQ + (unsigned)n * 64;
        const unsigned char* fa = FA + (size_t)it * FA_STRIDE;
        bf16x8 qf[4][4], qk[4][2]; f32x4 egc[4];
#pragma unroll
        for (int m = 0; m < 4; ++m) {
#pragma unroll
            for (int ks = 0; ks < 4; ++ks) { const bf16* qp = QN + (t0 + 16 * m + fr) * 512 + hq * 128 + 32 * ks + 4 * fq; const v2u lo = *(const v2u*)qp, hi = *(const v2u*)(qp + 16); v4u w; w.x = lo.x; w.y = lo.y; w.z = hi.x; w.w = hi.y; qf[m][ks] = __builtin_bit_cast(bf16x8, w); }
#pragma unroll
            for (int k2 = 0; k2 < 2; ++k2) qk[m][k2] = *(const bf16x8*)(fa + 16384 + (m * 2 + k2) * 1024 + lane * 16);
            egc[m] = *(const f32x4*)((const float*)(fa + 24576) + 16 * m + 4 * fq); }
#pragma unroll 1
        for (int j = 0; j < 8; ++j) {
            bf16x8 sf[4], vf[2];
#pragma unroll
            for (int ks = 0; ks < 4; ++ks) sf[ks] = *(const bf16x8*)(SFR + ((size_t)it * 8 + j) * 4096 + ks * 1024 + lane * 16);
#pragma unroll
            for (int k2 = 0; k2 < 2; ++k2) vf[k2] = *(const bf16x8*)(VFR + ((size_t)it * 8 + j) * 2048 + k2 * 1024 + lane * 16);
            f32x4 ao[4];
#pragma unroll
            for (int m = 0; m < 4; ++m) { ao[m] = (f32x4){0.f, 0.f, 0.f, 0.f};
#pragma unroll
                for (int ks = 0; ks < 4; ++ks) ao[m] = __builtin_amdgcn_mfma_f32_16x16x32_bf16(qf[m][ks], sf[ks], ao[m], 0, 0, 0);
                ao[m] = ao[m] * egc[m];
#pragma unroll
                for (int k2 = 0; k2 < 2; ++k2) ao[m] = __builtin_amdgcn_mfma_f32_16x16x32_bf16(qk[m][k2], vf[k2], ao[m], 0, 0, 0); }
#pragma unroll
            for (int m = 0; m < 4; ++m)
#pragma unroll
                for (int r = 0; r < 4; ++r) ot[(16 * m + 4 * fq + r) * 128 + 16 * j + fr] = (bf16)(pk2(ao[m][r], 0.f) & 0xffffu);
        }
        asm volatile("s_waitcnt lgkmcnt(0)" ::: "memory");
#pragma unroll 4
        for (int i = 0; i < 16; ++i) { const int tk = 4 * i + fq; const v4u q = *(const LAS v4u*)(ot + tk * 128 + 8 * fr); const v4u zq = *(const v4u*)(Z + (size_t)(t0 + tk) * 1024 + hv * 128 + 8 * fr);
            float o[8] = {bflo(q.x), bfhi(q.x), bflo(q.y), bfhi(q.y), bflo(q.z), bfhi(q.z), bflo(q.w), bfhi(q.w)}; const float zz[8] = {bflo(zq.x), bfhi(zq.x), bflo(zq.y), bfhi(zq.y), bflo(zq.z), bfhi(zq.z), bflo(zq.w), bfhi(zq.w)};
            float ss = 0.f;
#pragma unroll
            for (int e = 0; e < 8; ++e) ss += o[e] * o[e];
            ss += __shfl_xor(ss, 1); ss += __shfl_xor(ss, 2); ss += __shfl_xor(ss, 4); ss += __shfl_xor(ss, 8);
            const float rr = __builtin_amdgcn_rsqf(ss * (1.0f / 128.0f) + EPS);
#pragma unroll
            for (int e = 0; e < 8; ++e) o[e] = o[e] * rr * on[e] * siluf_(zz[e]);
            v4u w; w.x = pk2(o[0], o[1]); w.y = pk2(o[2], o[3]); w.z = pk2(o[4], o[5]); w.w = pk2(o[6], o[7]); *(v4u*)(GT + (size_t)(t0 + tk) * 1024 + hv * 128 + 8 * fr) = w; }
        asm volatile("s_waitcnt lgkmcnt(0)" ::: "memory");
    }
}
__device__ __forceinline__ void phase_dn_ogate(const Args& args) {
    int tid_ = threadIdx.x; asm volatile("" : "+v"(tid_)); const int tid = tid_, lane = tid & 63, wave = __builtin_amdgcn_readfirstlane(tid >> 6), G = gridDim.x, bid = blockIdx.x; (void)tid;
    unsigned char* ws = uni_ptr(args.ws); const float* o_norm = args.in[23];
    const bf16* O = (const bf16*)(ws + WS_ACT + A_O); const bf16* Z = (const bf16*)(ws + WS_ACT + A_Z); bf16* GT = (bf16*)(ws + WS_ACT + A_H);
    float on[2][8];
#pragma unroll
    for (int j = 0; j < 2; ++j)
#pragma unroll
        for (int e = 0; e < 8; ++e) on[j][e] = o_norm[((8 * lane + 512 * j) & 127) + e];
    const int NW = G * NWAVES;
    for (int t0 = bid * NWAVES + wave; t0 < T; t0 += 4 * NW) {
        v4u q[4][2], z[4][2];
#pragma unroll
        for (int k = 0; k < 4; ++k) { const int t = (t0 + k * NW < T) ? t0 + k * NW : t0;
#pragma unroll
            for (int j = 0; j < 2; ++j) { const int ch = 8 * lane + 512 * j; q[k][j] = *(const v4u*)(O + (size_t)t * 1024 + ch); z[k][j] = *(const v4u*)(Z + (size_t)t * 1024 + ch); } }
#pragma unroll
        for (int k = 0; k < 4; ++k) { const int t = t0 + k * NW; if (t >= T) break;
#pragma unroll
            for (int j = 0; j < 2; ++j) { const int ch = 8 * lane + 512 * j; const v4u qq = q[k][j], zq = z[k][j];
                float o[8] = {bflo(qq.x), bfhi(qq.x), bflo(qq.y), bfhi(qq.y), bflo(qq.z), bfhi(qq.z), bflo(qq.w), bfhi(qq.w)}; const float zz[8] = {bflo(zq.x), bfhi(zq.x), bflo(zq.y), bfhi(zq.y), bflo(zq.z), bfhi(zq.z), bflo(zq.w), bfhi(zq.w)};
                float ss = 0.f;
#pragma unroll
                for (int e = 0; e < 8; ++e) ss += o[e] * o[e];
                ss += __shfl_xor(ss, 1); ss += __shfl_xor(ss, 2); ss += __shfl_xor(ss, 4); ss += __shfl_xor(ss, 8);
                const float r = __builtin_amdgcn_rsqf(ss * (1.0f / 128.0f) + EPS);
#pragma unroll
                for (int e = 0; e < 8; ++e) o[e] = o[e] * r * on[j][e] * siluf_(zz[e]);
                v4u w; w.x = pk2(o[0], o[1]); w.y = pk2(o[2], o[3]); w.z = pk2(o[4], o[5]); w.w = pk2(o[6], o[7]); *(v4u*)(GT + (size_t)t * 1024 + ch) = w; } }
    }
}
__device__ __forceinline__ void phase_moe_router(const Args& args, int L, LAS unsigned char* lds) {
    int tid_ = threadIdx.x; asm volatile("" : "+v"(tid_)); const int tid = tid_, lane = tid & 63, wave = __builtin_amdgcn_readfirstlane(tid >> 6), G = gridDim.x, bid = blockIdx.x;
    unsigned char* ws = uni_ptr(args.ws); const int ib = LBASE(L) + 4 + NMIX(L);
    const bf16* X = L == 3 ? (const bf16*)(ws + WS_X16B) : (const bf16*)args.out; unsigned char* H8 = ws + WS_ACT + A_H; const float* MOD = (const float*)(ws + WS_MOD) + (size_t)L * 2 * 6144;
    const float* nf = args.in[LBASE(L) + 1]; const float* rb = args.in[ib + 1];
    const bf16* RH = (const bf16*)(ws + WS_RTR + (size_t)L * 196608); const bf16* RLo = RH + 49152;
    int* EID = (int*)(ws + WS_EID); float* GATE = (float*)(ws + WS_GATE);
    LAS float* gs = (LAS float*)lds; LAS float* sh = gs + 1024; LAS int* lcnt = (LAS int*)(lds + 8192);
    LAS float* ssp = (LAS float*)(lds + 8448);
    LAS float* part = (LAS float*)(lds + 9472);
    LAS float* logit = (LAS float*)(lds + 58624);
    LAS int* leid = (LAS int*)(lds + 64768); LAS int* lrk = leid + 256; LAS int* lbase = leid + 512;
    int* CUR = (int*)(ws + WS_CTL + 524288) + L * 32; int* TOKE = (int*)(ws + WS_TOK); int* POS = (int*)(ws + WS_SLOT);
    const int r = lane & 15, q = lane >> 4, kw = 128 * wave;
    bf16x8 bh[4][3], bl[4][3];
#pragma unroll
    for (int ks = 0; ks < 4; ++ks)
#pragma unroll
        for (int nt = 0; nt < 3; ++nt) { bh[ks][nt] = *(const bf16x8*)(RH + (size_t)(nt * 16 + r) * 1024 + kw + 32 * ks + 8 * q); bl[ks][nt] = *(const bf16x8*)(RLo + (size_t)(nt * 16 + r) * 1024 + kw + 32 * ks + 8 * q); }
    for (int item = bid; item < T / 128; item += G) {
        const int r0 = item * 128, b = r0 / SEQ; const float* m = MOD + (size_t)b * 6144;
        __syncthreads();
        for (int k = tid; k < 1024; k += NTHR) { gs[k] = nf[k] * (1.0f + m[4096 + k]); sh[k] = m[3072 + k]; }
        if (tid < 32) lcnt[tid] = 0;
        f32x4 xv[8];
        { const bf16* xp = X + (size_t)(r0 + r) * 1024 + kw + 8 * q;
#pragma unroll
          for (int ks = 0; ks < 4; ++ks) { const v4u w = *(const v4u*)(xp + 32 * ks); xv[2 * ks] = (f32x4){bflo(w.x), bfhi(w.x), bflo(w.y), bfhi(w.y)}; xv[2 * ks + 1] = (f32x4){bflo(w.z), bfhi(w.z), bflo(w.w), bfhi(w.w)}; } }
        __syncthreads();
#pragma unroll 1
        for (int g = 0; g < 8; ++g) {
            const int row = r0 + 16 * g + r, pb = g & 1;
            v4u xn[4];
            { const bf16* xp = X + (size_t)(g < 7 ? row + 16 : row) * 1024 + kw + 8 * q;
#pragma unroll
                for (int ks = 0; ks < 4; ++ks) xn[ks] = *(const v4u*)(xp + 32 * ks); }
            float ss = 0.f;
#pragma unroll
            for (int i = 0; i < 8; ++i) ss += (xv[i][0] * xv[i][0] + xv[i][1] * xv[i][1]) + (xv[i][2] * xv[i][2] + xv[i][3] * xv[i][3]);
            ss += __shfl_xor(ss, 16); ss += __shfl_xor(ss, 32);
            if (q == 0) ssp[(pb * 8 + wave) * 16 + r] = ss;
            __syncthreads();
            float tot = 0.f;
#pragma unroll
            for (int w = 0; w < 8; ++w) tot += ssp[(pb * 8 + w) * 16 + r];
            const float rstd = __builtin_amdgcn_rsqf(tot * (1.0f / 1024.0f) + EPS);
            f32x4 acc[3];
#pragma unroll
            for (int nt = 0; nt < 3; ++nt) acc[nt] = (f32x4){0.f, 0.f, 0.f, 0.f};
#pragma unroll
            for (int ks = 0; ks < 4; ++ks) { const int k0 = kw + 32 * ks + 8 * q;
                const f32x4 g0 = *(const LAS f32x4*)(gs + k0), g1 = *(const LAS f32x4*)(gs + k0 + 4), s0 = *(const LAS f32x4*)(sh + k0), s1 = *(const LAS f32x4*)(sh + k0 + 4);
                const f32x4 h0 = xv[2 * ks] * rstd * g0 + s0, h1 = xv[2 * ks + 1] * rstd * g1 + s1;
                v4u hi; hi.x = pk2(h0[0], h0[1]); hi.y = pk2(h0[2], h0[3]); hi.z = pk2(h1[0], h1[1]); hi.w = pk2(h1[2], h1[3]);
                v4u lo; lo.x = pk2(h0[0] - bflo(hi.x), h0[1] - bfhi(hi.x)); lo.y = pk2(h0[2] - bflo(hi.y), h0[3] - bfhi(hi.y)); lo.z = pk2(h1[0] - bflo(hi.z), h1[1] - bfhi(hi.z)); lo.w = pk2(h1[2] - bflo(hi.w), h1[3] - bfhi(hi.w));
                { v2u h8; h8.x = pk4_fp8(h0[0], h0[1], h0[2], h0[3]); h8.y = pk4_fp8(h1[0], h1[1], h1[2], h1[3]); *(v2u*)(H8 + (size_t)row * 1024 + k0) = h8; }
                const bf16x8 ahi = __builtin_bit_cast(bf16x8, hi), alo = __builtin_bit_cast(bf16x8, lo);
#pragma unroll
                for (int nt = 0; nt < 3; ++nt) { acc[nt] = __builtin_amdgcn_mfma_f32_16x16x32_bf16(bh[ks][nt], ahi, acc[nt], 0, 0, 0); acc[nt] = __builtin_amdgcn_mfma_f32_16x16x32_bf16(bl[ks][nt], ahi, acc[nt], 0, 0, 0); acc[nt] = __builtin_amdgcn_mfma_f32_16x16x32_bf16(bh[ks][nt], alo, acc[nt], 0, 0, 0); } }
#pragma unroll
            for (int nt = 0; nt < 3; ++nt) *(LAS f32x4*)(part + ((pb * 8 + wave) * 16 + r) * 48 + 16 * nt + 4 * q) = acc[nt];
            __syncthreads();
            for (int o = tid; o < 768; o += NTHR) { float sacc = 0.f;
#pragma unroll
                for (int w = 0; w < 8; ++w) sacc += part[(pb * 8 + w) * 768 + o];
                const int n = o % 48; logit[pb * 768 + o] = sacc + (n < 36 ? rb[n] : 0.f); }
            __syncthreads();
            if (wave == g && lane < 16) { float lg[36]; const int trow = r0 + 16 * g + lane;
#pragma unroll
                for (int i = 0; i < 9; ++i) { const f32x4 v = *(const LAS f32x4*)(logit + pb * 768 + lane * 48 + 4 * i); lg[4 * i] = v[0]; lg[4 * i + 1] = v[1]; lg[4 * i + 2] = v[2]; lg[4 * i + 3] = v[3]; }
                int gsel = 0; float gm = lg[0];
#pragma unroll
                for (int i = 1; i < 4; ++i) if (lg[i] > gm) { gm = lg[i]; gsel = i; }
                float gsum = 0.f;
#pragma unroll
                for (int i = 0; i < 4; ++i) gsum += expf(lg[i] - gm);
                const float pg = 1.0f / gsum;
                float le[8];
#pragma unroll
                for (int i = 0; i < 8; ++i) le[i] = gsel == 0 ? lg[4 + i] : (gsel == 1 ? lg[12 + i] : (gsel == 2 ? lg[20 + i] : lg[28 + i]));
                int j1 = 0; float m1 = le[0];
#pragma unroll
                for (int i = 1; i < 8; ++i) if (le[i] > m1) { m1 = le[i]; j1 = i; }
                int j2 = -1; float m2 = -INFINITY;
#pragma unroll
                for (int i = 0; i < 8; ++i) if (i != j1 && le[i] > m2) { m2 = le[i]; j2 = i; }
                const float p2 = expf(m2 - m1), den = 1.0f / (1.0f + p2);
                const int e1 = gsel * 8 + j1, e2 = gsel * 8 + j2;
                EID[(size_t)trow * 2] = e1; EID[(size_t)trow * 2 + 1] = e2; GATE[(size_t)trow * 2] = pg * den; GATE[(size_t)trow * 2 + 1] = pg * p2 * den;
                const int li = 2 * (16 * g + lane); leid[li] = e1; leid[li + 1] = e2;
                lrk[li] = __hip_atomic_fetch_add(lcnt + e1, 1, __ATOMIC_RELAXED, __HIP_MEMORY_SCOPE_WORKGROUP); lrk[li + 1] = __hip_atomic_fetch_add(lcnt + e2, 1, __ATOMIC_RELAXED, __HIP_MEMORY_SCOPE_WORKGROUP); }
#pragma unroll
            for (int ks = 0; ks < 4; ++ks) { xv[2 * ks] = (f32x4){bflo(xn[ks].x), bfhi(xn[ks].x), bflo(xn[ks].y), bfhi(xn[ks].y)}; xv[2 * ks + 1] = (f32x4){bflo(xn[ks].z), bfhi(xn[ks].z), bflo(xn[ks].w), bfhi(xn[ks].w)}; }
        }
        __syncthreads();
        if (tid < 32) lbase[tid] = __hip_atomic_fetch_add(CUR + tid, lcnt[tid], __ATOMIC_RELAXED, __HIP_MEMORY_SCOPE_AGENT);
        __syncthreads();
        if (tid < 256) { const int e = leid[tid], pos = lbase[e] + lrk[tid]; TOKE[(size_t)e * 32768 + pos] = r0 + (tid >> 1); POS[(size_t)r0 * 2 + tid] = pos; }
        if (item == 0 && tid < 64) *(v4u*)(H8 + (size_t)T * 1024 + 16 * tid) = (v4u){0u, 0u, 0u, 0u};
    }
}
__device__ __forceinline__ void moe_tables(const int* CUR, LAS int* tbl) {
    const int tid = threadIdx.x;
    __syncthreads();
    if (tid < 32) tbl[tid] = __hip_atomic_load(CUR + tid, __ATOMIC_RELAXED, __HIP_MEMORY_SCOPE_AGENT);
    __syncthreads();
    if (tid < 33) { int p = 0; for (int e = 0; e < tid; ++e) p += (tbl[e] + 255) >> 8; tbl[32 + tid] = p; }
    __syncthreads();
    if (tid < 32) { const int t0 = tbl[32 + tid], nt = (tbl[tid] + 255) >> 8; for (int i = 0; i < nt; ++i) tbl[80 + t0 + i] = tid; }
    __syncthreads();
}
__device__ __forceinline__ void phase_moe_combine(const Args& args, int L, LAS unsigned char* lds) {
    int tid_ = threadIdx.x; asm volatile("" : "+v"(tid_)); const int tid = tid_, lane = tid & 63, wave = __builtin_amdgcn_readfirstlane(tid >> 6), G = gridDim.x, bid = blockIdx.x;
    unsigned char* ws = uni_ptr(args.ws); bf16* X = L == 3 ? (bf16*)(ws + WS_X16B) : (bf16*)args.out; float* OUT = args.out; const unsigned char* Y = ws + WS_ACT + A_Y; bf16* H = (bf16*)(ws + WS_ACT + A_H);
    const int* POS = (const int*)(ws + WS_SLOT); const int* EID = (const int*)(ws + WS_EID); const float* GATE = (const float*)(ws + WS_GATE); const float* MOD = (const float*)(ws + WS_MOD);
    LAS int* tbl = (LAS int*)(lds + LDSCTL_OFF + 7168); moe_tables((const int*)(ws + WS_CTL + 524288) + L * 32, tbl);
    LAS float* vgf = (LAS float*)lds; LAS float* vgs = vgf + 2048; LAS float* vsh = vgf + 4096;
    for (int i = tid; i < 2048; i += NTHR) { const int b = i >> 10, k = i & 1023; vgf[i] = MOD[(size_t)(L * 2 + b) * 6144 + 5120 + k];
        if (L < 3) { const float* m = MOD + (size_t)((L + 1) * 2 + b) * 6144; vgs[i] = args.in[LBASE(L < 3 ? L + 1 : 3)][k] * (1.0f + m[1024 + k]); vsh[i] = m[k]; } }
    __syncthreads();
    const int NW = G * NWAVES;
    for (int t = bid * NWAVES + wave; t < T; t += 2 * NW) {
        const int tb = t + NW; const bool two = tb < T; const int t1 = two ? tb : t;
        const int ta[2] = {t, t1};
        v2u xv[2][4]; unsigned y0[2][4], y1[2][4]; float g0[2], g1[2];
#pragma unroll
        for (int k = 0; k < 2; ++k) { const int tt = ta[k];
            const int s0 = 256 * tbl[32 + EID[(size_t)tt * 2]] + POS[(size_t)tt * 2], s1 = 256 * tbl[32 + EID[(size_t)tt * 2 + 1]] + POS[(size_t)tt * 2 + 1]; g0[k] = 0.125f * GATE[(size_t)tt * 2]; g1[k] = 0.125f * GATE[(size_t)tt * 2 + 1];
#pragma unroll
            for (int j = 0; j < 4; ++j) { const int c = 4 * lane + 256 * j; xv[k][j] = *(const v2u*)(X + (size_t)tt * 1024 + c);
                y0[k][j] = *(const unsigned*)(Y + (size_t)s0 * 1024 + c); y1[k][j] = *(const unsigned*)(Y + (size_t)s1 * 1024 + c); } }
#pragma unroll
        for (int k = 0; k < 2; ++k) { if (k == 1 && !two) break; const int tt = ta[k]; const int b = tt / SEQ; f32x4 v[4]; float ss = 0.f;
#pragma unroll
            for (int j = 0; j < 4; ++j) { const int c = 4 * lane + 256 * j; f32x4 mo; const f32x4 gg = *(const LAS f32x4*)(vgf + b * 1024 + c);
                { const auto a0 = __builtin_amdgcn_cvt_pk_f32_fp8((int)y0[k][j], false), a1 = __builtin_amdgcn_cvt_pk_f32_fp8((int)y0[k][j], true), b0 = __builtin_amdgcn_cvt_pk_f32_fp8((int)y1[k][j], false), b1 = __builtin_amdgcn_cvt_pk_f32_fp8((int)y1[k][j], true);
                  mo[0] = g0[k] * a0[0] + g1[k] * b0[0]; mo[1] = g0[k] * a0[1] + g1[k] * b0[1]; mo[2] = g0[k] * a1[0] + g1[k] * b1[0]; mo[3] = g0[k] * a1[1] + g1[k] * b1[1]; }
                v[j] = (f32x4){bflo(xv[k][j].x), bfhi(xv[k][j].x), bflo(xv[k][j].y), bfhi(xv[k][j].y)} + gg * mo;
                if (L < 3) { v2u w; w.x = pk2(v[j][0], v[j][1]); w.y = pk2(v[j][2], v[j][3]); *(v2u*)(X + (size_t)tt * 1024 + c) = w; } else *(f32x4*)(OUT + (size_t)tt * 1024 + c) = v[j];
                ss += (v[j][0] * v[j][0] + v[j][1] * v[j][1]) + (v[j][2] * v[j][2] + v[j][3] * v[j][3]); }
            if (L < 3) { const float rstd = __builtin_amdgcn_rsqf(wave_sum(ss) * (1.0f / 1024.0f) + EPS);
#pragma unroll
                for (int j = 0; j < 4; ++j) { const int c = 4 * lane + 256 * j; const f32x4 gsv = *(const LAS f32x4*)(vgs + b * 1024 + c), shv = *(const LAS f32x4*)(vsh + b * 1024 + c);
                    const f32x4 h = v[j] * rstd * gsv + shv; v2u w; w.x = pk2(h[0], h[1]); w.y = pk2(h[2], h[3]); *(v2u*)(H + (size_t)tt * 1024 + c) = w; } } }
    }
}

constexpr int N_PHASES = 33;

#ifndef DUP_MASK
#define DUP_MASK 0
#endif
#ifndef STAGGER_TICKS
#define STAGGER_TICKS 0
#endif
__device__ __forceinline__ void gemm_stagger() { if (STAGGER_TICKS > 0) { const unsigned long long t0 = __builtin_amdgcn_s_memrealtime(); const unsigned long long w = (unsigned long long)((blockIdx.x >> 3) & 3) * STAGGER_TICKS; while (__builtin_amdgcn_s_memrealtime() - t0 < w) __builtin_amdgcn_s_sleep(8); } }
#define PHASE(k) if ((lo <= (k) && (k) < hi) && ((started ? (xcd_barrier(bar), 0) : 0), started = true, true))
#define NREP(g) (1 + ((DUP_MASK >> (g)) & 1))
#define PHASE_G(k, g) PHASE(k) for (int rep_ = 0; rep_ < NREP(g); ++rep_, ((rep_ < NREP(g)) ? (xcd_barrier(bar), 0) : 0))
template <int L> __device__ __forceinline__ void run_layer(const Args& args, LAS unsigned char* lds, const XcdBarrier& bar, bool& started, const int lo, const int hi) {
    const int G = gridDim.x, bid = blockIdx.x;
    unsigned char* ws = uni_ptr(args.ws);
    const float* MOD = (const float*)(ws + WS_MOD);
    bf16* Hb = (bf16*)(ws + WS_ACT + A_H);

        const int pb = (L == 0) ? 1 : (L == 1 ? 9 : (L == 2 ? 19 : 26));
        bf16* X16 = (L == 3) ? (bf16*)(ws + WS_X16B) : (bf16*)args.out; const void* xsrc = (L == 0) ? (const void*)args.in[0] : (const void*)args.out;
        const float* gate_m = MOD + (size_t)L * 2 * 6144 + 2048;
        int mb;
        if constexpr (L == 0 || L == 3) {
            int g0 = pb;
            if (L == 0) { PHASE_G(pb, 8) { phase_norm0(args, lds); } g0 = pb + 1; }
            const bf16* Win = (const bf16*)(ws + WS_WMIX + (L == 0 ? WMIX_GM_IN0 : WMIX_GM_IN3)); const bf16* Wout = (const bf16*)(ws + WS_WMIX + (L == 0 ? WMIX_GM_OUT0 : WMIX_GM_OUT3));
            PHASE_G(g0, 1) { pg8::Gemm g{Hb, Win, T, 2048, 1024}; pg8::StaticOrder S; S.init(T, 2048, G, bid);
                EpiGm1 E{(bf16*)(ws + WS_ACT + A_U), (bf16*)(ws + WS_ACT + A_V), (float*)(ws + WS_VSSP)};
                (gemm_stagger(), 0); pg8::gemm_phase<EpiGm1, pg8::StaticOrder, true, true, false, false, true>(lds, g, S, E); }
            PHASE_G(g0 + 1, 2) { phase_gm_spatial(args, L, lds); }
            PHASE_G(g0 + 2, (L == 0 ? 1 : 31)) { pg8::Gemm g{(const bf16*)(ws + WS_ACT + A_GATED), Wout, T, 1024, 1024}; pg8::StaticOrder S; S.init(T, 1024, G, bid);
                EpiRes<L != 0> E{xsrc, X16, gate_m};
                (gemm_stagger(), 0); pg8::gemm_phase<EpiRes<L != 0>, pg8::StaticOrder, true, true, false, false, true>(lds, g, S, E); }
            mb = g0 + 3;
        } else if constexpr (L == 1) {
            PHASE_G(pb, 1) { pg8::Gemm g{Hb, (const bf16*)(ws + WS_WMIX + WMIX_DN_IN), T, 3072, 1024}; pg8::StaticOrder S; S.init(T, 3072, G, bid);
                EpiDn1 E{(bf16*)(ws + WS_ACT + A_QKV), (bf16*)(ws + WS_ACT + A_Z), (float*)(ws + WS_BA)};
                (gemm_stagger(), 0); pg8::gemm_phase<EpiDn1, pg8::StaticOrder, true, true, false, false, true>(lds, g, S, E); dn_ba_tail(args, lds); }
            PHASE_G(pb + 1, 3) { phase_dn_prep(args, lds); }
            PHASE_G(pb + 2, 4) { phase_dn_chunk(args, lds); }
            PHASE_G(pb + 3, 5) { phase_dn_scan(args, lds); }
            PHASE_G(pb + 4, 3) { phase_dn_out(args, lds); }
            PHASE(pb + 5) { pg8::Gemm g{Hb, (const bf16*)(ws + WS_WMIX + WMIX_DN_OUT), T, 1024, 1024}; pg8::StaticOrder S; S.init(T, 1024, G, bid);
                EpiRes<L != 0> E{xsrc, X16, gate_m};
                (gemm_stagger(), 0); pg8::gemm_phase<EpiRes<L != 0>, pg8::StaticOrder, true, true, false, false, true>(lds, g, S, E); }
            mb = pb + 6;
        } else {
            PHASE_G(pb, 1) { pg8::Gemm g{Hb, (const bf16*)(ws + WS_WMIX + WMIX_SWA_IN), T, 1536, 1024}; pg8::StaticOrder S; S.init(T, 1536, G, bid);
                EpiBf E{(bf16*)(ws + WS_ACT + A_QKV), 1536, 0xffff, 1.0f};
                (gemm_stagger(), 0); pg8::gemm_phase<EpiBf, pg8::StaticOrder, true, true, false, false, true>(lds, g, S, E); }
            PHASE_G(pb + 1, 2) { phase_swa_attn(args, lds); }
            PHASE(pb + 2) { pg8::Gemm g{Hb, (const bf16*)(ws + WS_WMIX + WMIX_SWA_OUT), T, 1024, 1024}; pg8::StaticOrder S; S.init(T, 1024, G, bid);
                EpiRes<L != 0> E{xsrc, X16, gate_m};
                (gemm_stagger(), 0); pg8::gemm_phase<EpiRes<L != 0>, pg8::StaticOrder, true, true, false, false, true>(lds, g, S, E); }
            mb = pb + 3;
        }
        PHASE_G(mb, 6) { phase_moe_router(args, L, lds); }
        const int* CUR = (const int*)(ws + WS_CTL + 524288) + L * 32; LAS int* tbl = (LAS int*)(lds + LDSCTL_OFF + 7168); LAS int* lidx = (LAS int*)(lds + LDSCTL_OFF + 2048);
        PHASE_G(mb + 1, 7) { moe_tables(CUR, tbl); const int ntiles = tbl[64];
            pg8::Gemm g{(const bf16*)(ws + WS_ACT + A_H), (const bf16*)(ws + WS_W + (size_t)L * WL_STRIDE), MAXROWS, 1024, 512};
            MoeOrder S; S.init(tbl + 80, ntiles, G, bid); EpiMoe1 E{ws + WS_ACT + A_ACTV};
            const int* TOKE = (const int*)(ws + WS_TOK);
            for (int ui = 0; ui < 5; ++ui) { pg8::Unit u; if (S.next(ui, u) && threadIdx.x < 256) { const int e = tbl[80 + u.pm], p = 256 * (u.pm - tbl[32 + e]) + (int)threadIdx.x; lidx[ui * 256 + threadIdx.x] = p < tbl[e] ? TOKE[(size_t)e * 32768 + p] : T; } }
            __syncthreads();
            pg8::gemm_phase_gather<EpiMoe1, MoeOrder, true, true, true, false, true>(lds, g, S, E, lidx); }
        PHASE_G(mb + 2, 7) { moe_tables(CUR, tbl); const int ntiles = tbl[64];
            pg8::Gemm g{(const bf16*)(ws + WS_ACT + A_ACTV), (const bf16*)(ws + WS_W + (size_t)L * WL_STRIDE + WL_OUT), MAXROWS, 1024, 256};
            MoeOrder S; S.init(tbl + 80, ntiles, G, bid); EpiF8 E{ws + WS_ACT + A_Y, 1024, 3, 0.5f};
            pg8::gemm_phase<EpiF8, MoeOrder, true, true, true, false, true>(lds, g, S, E); }
        PHASE(mb + 3) { phase_moe_combine(args, L, lds); }

}
__global__ void __launch_bounds__(NTHR, 2) fwd_kernel(Args args) {
    extern __shared__ __attribute__((aligned(16))) unsigned char lds_raw[];
    LAS unsigned char* lds = (LAS unsigned char*)lds_raw;
    const int tid = threadIdx.x;
    unsigned char* ws = uni_ptr(args.ws);
    for (int u = tid; u < (LDS_BYTES - LDSCTL_OFF) / 4; u += NTHR) ((LAS unsigned*)(lds + LDSCTL_OFF))[u] = 0u;
    __syncthreads();
    volatile LAS unsigned* MISC = (volatile LAS unsigned*)(lds + MISC_OFF);
    XcdBarrier bar = xcd_barrier_post((unsigned*)(ws + WS_CTL) + 4096 + (size_t)args.li * XCD_BAR_WORDS, MISC + 8);
    const int lo = args.ph_lo, hi = args.ph_hi; bool started = false;
    const float* MOD = (const float*)(ws + WS_MOD);
    bf16* Hb = (bf16*)(ws + WS_ACT + A_H);

    PHASE_G(0, 0) { phase_prologue(args, lds); }

    run_layer<0>(args, lds, bar, started, lo, hi);
    run_layer<1>(args, lds, bar, started, lo, hi);
    run_layer<2>(args, lds, bar, started, lo, hi);
    run_layer<3>(args, lds, bar, started, lo, hi);
#undef PHASE
#undef PHASE_G
}

extern "C" void kernel_launch(void* const* d_in, const int* in_sizes, int n_in, void* d_out, int out_size, void* d_ws, size_t ws_size, hipStream_t stream) {
    static int grid = 0;
    if (grid == 0) {
        if (n_in != N_IN || in_sizes[0] != T * D || out_size != T * D || ws_size < WS_END) { fprintf(stderr, "kernel_launch: unexpected shapes (n_in %d, in0 %d, out %d, ws %zu < %zu)\n", n_in, n_in > 0 ? in_sizes[0] : -1, out_size, ws_size, (size_t)WS_END); grid = -1; return; }
        int dev = 0, cus = 0, per_cu = 0;
        if (hipGetDevice(&dev) != hipSuccess || hipDeviceGetAttribute(&cus, hipDeviceAttributeMultiprocessorCount, dev) != hipSuccess) { grid = -1; return; }
        if (hipFuncSetAttribute((const void*)fwd_kernel, hipFuncAttributeMaxDynamicSharedMemorySize, LDS_BYTES) != hipSuccess) { fprintf(stderr, "kernel_launch: hipFuncSetAttribute failed\n"); grid = -1; return; }
        if (hipOccupancyMaxActiveBlocksPerMultiprocessor(&per_cu, (const void*)fwd_kernel, NTHR, LDS_BYTES) != hipSuccess || per_cu < 1) fprintf(stderr, "kernel_launch: occupancy query reports %d\n", per_cu);
        (void)hipGetLastError();
        grid = cus;
    }
    if (grid < 0) return;
    if (hipMemsetAsync((char*)d_ws + WS_CTL, 0, CTL_ZERO_BYTES, stream) != hipSuccess) return;
    Args a{};
    for (int i = 0; i < N_IN; ++i) a.in[i] = (const float*)d_in[i];
    a.out = (float*)d_out; a.ws = (unsigned char*)d_ws; a.pad = 0;
#if MK_LAUNCH_MODE == 1
    a.ph_lo = 0; a.ph_hi = N_PHASES; a.li = 0;
    hipLaunchKernelGGL(fwd_kernel, dim3(grid), dim3(NTHR), LDS_BYTES, stream, a);
#else
#ifndef PROBE_PHASE
#define PROBE_PHASE -1
#endif
    for (int p = 0; p < N_PHASES; ++p) { a.ph_lo = p; a.ph_hi = p + 1; a.li = 0;
        for (int rep = 0; rep < (p == PROBE_PHASE ? 2 : 1); ++rep) hipLaunchKernelGGL(fwd_kernel, dim3(grid), dim3(NTHR), LDS_BYTES, stream, a); }
#endif
}
```

```cpp
#include <hip/hip_runtime.h>
#include <cstdio>
#include <cstdint>
#ifndef MK_LAUNCH_MODE
#define MK_LAUNCH_MODE 1
#endif
namespace pg8 {
#define PG8_LAS __attribute__((address_space(3)))
typedef unsigned short bf16_t;
typedef short bf16x8 __attribute__((ext_vector_type(8)));
typedef float f32x4 __attribute__((ext_vector_type(4)));
typedef unsigned u32x4 __attribute__((ext_vector_type(4)));
constexpr int BM = 256, BK = 64, HALF = 128, HTB = HALF * BK * 2  , STAGE_BYTES = 8 * HTB, NXCD = 8, WGM = 8;

__host__ __device__ __forceinline__ int lds_byte(int r, int c) { const int st = (r >> 4) * 2 + (c >> 5), rr = r & 15, cc = c & 31, ob = rr * 64 + cc * 2; return st * 1024 + (ob ^ (((ob >> 9) & 1) << 5)); }
__host__ __device__ __forceinline__ void stage_rc(int b, int& R, int& C) { const int st = b / 1024, sb = b % 1024, swz = sb ^ (((sb >> 9) & 1) << 5); R = (st >> 1) * 16 + swz / 64; C = (st & 1) * 32 + (swz % 64) / 2; }
__host__ __device__ __forceinline__ int perm32(int rho) { const int n = rho >> 4, i = rho & 15; return 8 * (i >> 2) + 4 * n + (i & 3); }

struct Unit { int pm, pn; };
struct Gemm { const bf16_t* A; const bf16_t* Bt; int M, N, K; };

struct StaticOrder {
    int nM, nN, nwg, G, c;
    __host__ __device__ void init(int M, int N, int G_, int c_) { nM = M / BM; nN = N / BM; nwg = nM * nN; G = G_; c = c_; }
    __host__ __device__ bool next(int i, Unit& u) const {
        const long L = (long)i * G + c; if (L >= nwg) return false;
        int wgid = (int)L; { const int q = nwg / NXCD, r = nwg % NXCD, xcd = wgid % NXCD, off = wgid / NXCD; wgid = (xcd < r ? xcd * (q + 1) : r * (q + 1) + (xcd - r) * q) + off; }
        const int nig = WGM * nN, gid = wgid / nig, fm = gid * WGM, gsz = (nM - fm) < WGM ? (nM - fm) : WGM;
        u.pm = fm + ((wgid % nig) % gsz); u.pn = (wgid % nig) / gsz; return true;
    }
    __device__ __forceinline__ void a_ready(const Unit&) const {}
    __device__ __forceinline__ void done(const Unit&) const {}
};
typedef float f32x2_ __attribute__((ext_vector_type(2))); typedef __bf16 bf16x2_ __attribute__((ext_vector_type(2)));
__device__ __forceinline__ unsigned cvt_pk_bf16(float lo, float hi) { const f32x2_ v = {lo, hi}; return __builtin_bit_cast(unsigned, __builtin_convertvector(v, bf16x2_)); }
typedef float f32x2 __attribute__((ext_vector_type(2)));
typedef int pg8_v8i __attribute__((ext_vector_type(8))); typedef int pg8_v4i __attribute__((ext_vector_type(4)));
struct pg8_FragA { bf16x8 v[4][2]; pg8_v8i w[4]; }; struct pg8_FragB { bf16x8 v[2][2]; pg8_v8i w[2]; };
__device__ __forceinline__ pg8_v8i pg8_cat(bf16x8 lo, bf16x8 hi) { const pg8_v4i a = __builtin_bit_cast(pg8_v4i, lo), c = __builtin_bit_cast(pg8_v4i, hi); return (pg8_v8i){a[0], a[1], a[2], a[3], c[0], c[1], c[2], c[3]}; }
__device__ __forceinline__ unsigned pg8_touch_lines(const char* base, int nlines) {
    unsigned a = 0; for (int l = threadIdx.x; l < nlines; l += 512) a += *(const unsigned*)(base + (size_t)l * 128); return a;
}
__device__ __forceinline__ unsigned pg8_touch_rows(const char* base, const PG8_LAS int* idx, int rowbytes) {
    const int lpr = rowbytes >> 7; unsigned a = 0; for (int l = threadIdx.x; l < 256 * lpr; l += 512) a += *(const unsigned*)(base + (size_t)idx[l / lpr] * rowbytes + (size_t)(l % lpr) * 128); return a;
}
template <class Epi, class Sched, bool ALIGN_EPI = false, bool SP2 = false, bool FP8 = false, bool TOUCH = false, bool BT = false, bool AT = false>
__device__ __forceinline__ void gemm_phase(PG8_LAS unsigned char* lds, const Gemm g, const Sched& S, const Epi& E) {
    const int tid = threadIdx.x, wid = __builtin_amdgcn_readfirstlane(tid >> 6), lane = tid & 63, wr = wid >> 2, wc = wid & 3, fr = lane & 15, fq = lane >> 4;
    const int K = g.K, nt = K / BK;
    unsigned voffA[2], voffB[2];
#pragma unroll
    for (int i = 0; i < 2; ++i) { int R, C; stage_rc(tid * 16 + i * 8192, R, C); const int Rb = Epi::PERM ? ((R & ~31) + perm32(R & 31)) : R;
        voffA[i] = (unsigned)(R * (AT ? 64 : K) + C) * 2u; voffB[i] = (unsigned)(Rb * (BT ? 64 : K) + C) * 2u; }
    const size_t kstep = (size_t)(BK * 2);
    const size_t hstep = (size_t)HALF * K * 2;
    const size_t tstep = 2 * hstep;
    const size_t kstepB = BT ? (size_t)32768 : kstep, hstepB = BT ? (size_t)16384 : hstep;
    const size_t kstepA = AT ? (size_t)32768 : kstep, hstepA = AT ? (size_t)16384 : hstep;
    const unsigned ldsw = (unsigned)wid * 1024u;
    const int aoff = lds_byte(wr * 64 + fr, fq * 8), boff = lds_byte(wc * 32 + fr, fq * 8);
#define PG8_SA(b, h) (((b) * 2 + (h)) * HTB)
#define PG8_SB(b, h) ((4 + (b) * 2 + (h)) * HTB)
#define PG8_STAGE(bufoff, gbase, voff) do { _Pragma("unroll") for (int _i = 0; _i < 2; ++_i) \
        __builtin_amdgcn_global_load_lds((const unsigned*)((const char*)(gbase) + (voff)[_i]), (PG8_LAS unsigned*)(lds + (bufoff) + ldsw + _i * 8192), 16, 0, 0); } while (0)
#define PG8_LDA(dst, b, h) do { _Pragma("unroll") for (int m = 0; m < 4; ++m) { if constexpr (FP8) dst.w[m] = pg8_cat(*(const PG8_LAS bf16x8*)(lds + PG8_SA(b, h) + aoff + m * 2048), *(const PG8_LAS bf16x8*)(lds + PG8_SA(b, h) + aoff + m * 2048 + 1024)); \
        else { _Pragma("unroll") for (int k = 0; k < 2; ++k) dst.v[m][k] = *(const PG8_LAS bf16x8*)(lds + PG8_SA(b, h) + aoff + m * 2048 + k * 1024); } } } while (0)
#define PG8_LDB(dst, b, h) do { _Pragma("unroll") for (int n = 0; n < 2; ++n) { if constexpr (FP8) dst.w[n] = pg8_cat(*(const PG8_LAS bf16x8*)(lds + PG8_SB(b, h) + boff + n * 2048), *(const PG8_LAS bf16x8*)(lds + PG8_SB(b, h) + boff + n * 2048 + 1024)); \
        else { _Pragma("unroll") for (int k = 0; k < 2; ++k) dst.v[n][k] = *(const PG8_LAS bf16x8*)(lds + PG8_SB(b, h) + boff + n * 2048 + k * 1024); } } } while (0)
#define PG8_MMA(ai, bj, At, Bt) do { __builtin_amdgcn_s_setprio(1); if constexpr (FP8) { _Pragma("unroll") for (int m = 0; m < 4; ++m) _Pragma("unroll") for (int n = 0; n < 2; ++n) \
        asm volatile("v_mfma_f32_16x16x128_f8f6f4 %0, %1, %2, %0" : "+v"(acc[ai][bj][m][n]) : "v"(Bt.w[n]), "v"(At.w[m])); } \
        else { _Pragma("unroll") for (int m = 0; m < 4; ++m) _Pragma("unroll") for (int n = 0; n < 2; ++n) _Pragma("unroll") for (int k = 0; k < 2; ++k) \
        acc[ai][bj][m][n] = __builtin_amdgcn_mfma_f32_16x16x32_bf16(Bt.v[n][k], At.v[m][k], acc[ai][bj][m][n], 0, 0, 0); } __builtin_amdgcn_s_setprio(0); } while (0)
#define PG8_WAIT_V(n) asm volatile("s_waitcnt vmcnt(" #n ")" ::: "memory")
#define PG8_WAIT_L(n) asm volatile("s_waitcnt lgkmcnt(" #n ")" ::: "memory")
#define PG8_BAR __builtin_amdgcn_s_barrier()
#define PG8_SCHED __builtin_amdgcn_sched_barrier(0)
    Unit cur, nxt; int ui = 0;
    if (!S.next(0, cur)) return;
    if constexpr (TOUCH) { unsigned a_ = pg8_touch_lines((const char*)g.A + (size_t)cur.pm * (512 * (size_t)g.K), 4 * g.K) + pg8_touch_lines((const char*)g.Bt + (size_t)cur.pn * (512 * (size_t)g.K), 4 * g.K);
        Unit u1_; if (S.next(1, u1_)) a_ += pg8_touch_lines((const char*)g.A + (size_t)u1_.pm * (512 * (size_t)g.K), 4 * g.K) + pg8_touch_lines((const char*)g.Bt + (size_t)u1_.pn * (512 * (size_t)g.K), 4 * g.K);
        asm volatile("" :: "v"(a_)); }
    f32x4 acc[2][2][4][2];
#pragma unroll
    for (int a = 0; a < 2; ++a)
#pragma unroll
        for (int b = 0; b < 2; ++b)
#pragma unroll
            for (int m = 0; m < 4; ++m)
#pragma unroll
                for (int n = 0; n < 2; ++n) acc[a][b][m][n] = (f32x4){0.f, 0.f, 0.f, 0.f};
    pg8_FragA At; pg8_FragB B0, B1;
    const char* cA = (const char*)g.A + (size_t)cur.pm * tstep; const char* cB = (const char*)g.Bt + (size_t)cur.pn * tstep;
    S.a_ready(cur);
    if constexpr (SP2) {
        PG8_STAGE(PG8_SB(0, 0), cB, voffB); PG8_STAGE(PG8_SB(0, 1), cB + hstepB, voffB); PG8_STAGE(PG8_SA(0, 0), cA, voffA); PG8_STAGE(PG8_SA(0, 1), cA + hstepA, voffA);
        if (wr == 1) PG8_BAR;
        PG8_WAIT_V(2); PG8_BAR;
        PG8_STAGE(PG8_SB(1, 0), cB + kstepB, voffB); PG8_STAGE(PG8_SA(1, 0), cA + kstepA, voffA); PG8_STAGE(PG8_SB(1, 1), cB + hstepB + kstepB, voffB);
        PG8_WAIT_V(6); PG8_BAR;
    } else {
        PG8_STAGE(PG8_SB(0, 0), cB, voffB); PG8_STAGE(PG8_SA(0, 0), cA, voffA); PG8_STAGE(PG8_SB(0, 1), cB + hstepB, voffB); PG8_STAGE(PG8_SA(0, 1), cA + hstepA, voffA);
        if (wr == 1) PG8_BAR;
        PG8_WAIT_V(4); PG8_BAR;
        PG8_STAGE(PG8_SB(1, 0), cB + kstepB, voffB); PG8_STAGE(PG8_SA(1, 0), cA + kstepA, voffA); PG8_STAGE(PG8_SB(1, 1), cB + hstepB + kstepB, voffB);
        PG8_WAIT_V(6); PG8_BAR;
    }
    for (;;) {
        const bool has_next = S.next(ui + 1, nxt);
        const char* nA = has_next ? (const char*)g.A + (size_t)nxt.pm * tstep : cA; const char* nB = has_next ? (const char*)g.Bt + (size_t)nxt.pn * tstep : cB;
#pragma unroll 1
        for (int t = 0; t < nt; t += 2) {
            const bool last = (t == nt - 2);
            const char* a1 = cA + (size_t)(t + 1) * kstepA;
            const char* a2 = last ? nA : cA + (size_t)(t + 2) * kstepA; const char* b2 = last ? nB : cB + (size_t)(t + 2) * kstepB;
            const char* a3 = a2 + kstepA; const char* b3 = b2 + kstepB;
            if (last && has_next) S.a_ready(nxt);
            if constexpr (SP2) {
            PG8_LDB(B0, 0, 0); PG8_LDB(B1, 0, 1); PG8_SCHED; PG8_LDA(At, 0, 0); PG8_STAGE(PG8_SA(1, 1), a1 + hstepA, voffA);
            PG8_WAIT_V(8); PG8_WAIT_L(0); PG8_BAR; PG8_MMA(0, 0, At, B0); PG8_MMA(0, 1, At, B1); PG8_BAR; PG8_SCHED;
            PG8_LDA(At, 0, 1); PG8_STAGE(PG8_SB(0, 0), b2, voffB); PG8_STAGE(PG8_SB(0, 1), b2 + hstepB, voffB); PG8_STAGE(PG8_SA(0, 0), a2, voffA);
            PG8_WAIT_V(8); PG8_WAIT_L(0); PG8_BAR; PG8_MMA(1, 0, At, B0); PG8_MMA(1, 1, At, B1); PG8_BAR; PG8_SCHED;
            PG8_LDB(B0, 1, 0); PG8_LDB(B1, 1, 1); PG8_SCHED; PG8_LDA(At, 1, 0); PG8_STAGE(PG8_SA(0, 1), a2 + hstepA, voffA);
            PG8_WAIT_V(8); PG8_WAIT_L(0); PG8_BAR; PG8_MMA(0, 0, At, B0); PG8_MMA(0, 1, At, B1); PG8_BAR; PG8_SCHED;
            PG8_LDA(At, 1, 1); PG8_STAGE(PG8_SB(1, 0), b3, voffB); PG8_STAGE(PG8_SB(1, 1), b3 + hstepB, voffB); PG8_STAGE(PG8_SA(1, 0), a3, voffA);
            PG8_WAIT_V(8); PG8_WAIT_L(0); PG8_BAR; PG8_MMA(1, 0, At, B0); PG8_MMA(1, 1, At, B1); PG8_BAR; PG8_SCHED;
            } else {
            PG8_LDB(B0, 0, 0); PG8_SCHED; PG8_LDA(At, 0, 0); PG8_STAGE(PG8_SA(1, 1), a1 + hstepA, voffA);
            PG8_WAIT_L(8); PG8_BAR; PG8_WAIT_L(0); PG8_MMA(0, 0, At, B0); PG8_BAR; PG8_SCHED;
            PG8_LDB(B1, 0, 1); PG8_STAGE(PG8_SB(0, 0), b2, voffB);
            PG8_BAR; PG8_WAIT_L(0); PG8_MMA(0, 1, At, B1); PG8_BAR;
            PG8_LDA(At, 0, 1); PG8_STAGE(PG8_SA(0, 0), a2, voffA);
            PG8_BAR; PG8_WAIT_L(0); PG8_MMA(1, 0, At, B0); PG8_BAR; PG8_SCHED;
            PG8_STAGE(PG8_SB(0, 1), b2 + hstepB, voffB);
            PG8_WAIT_V(6); PG8_BAR; PG8_MMA(1, 1, At, B1); PG8_BAR;
            PG8_LDB(B0, 1, 0); PG8_SCHED; PG8_LDA(At, 1, 0); PG8_STAGE(PG8_SA(0, 1), a2 + hstepA, voffA);
            PG8_WAIT_L(8); PG8_BAR; PG8_WAIT_L(0); PG8_MMA(0, 0, At, B0); PG8_BAR; PG8_SCHED;
            PG8_LDB(B1, 1, 1); PG8_STAGE(PG8_SB(1, 0), b3, voffB);
            PG8_BAR; PG8_WAIT_L(0); PG8_MMA(0, 1, At, B1); PG8_BAR;
            PG8_LDA(At, 1, 1); PG8_STAGE(PG8_SA(1, 0), a3, voffA);
            PG8_BAR; PG8_WAIT_L(0); PG8_MMA(1, 0, At, B0); PG8_BAR; PG8_SCHED;
            PG8_STAGE(PG8_SB(1, 1), b3 + hstepB, voffB);
            PG8_WAIT_V(6); PG8_BAR; PG8_MMA(1, 1, At, B1); PG8_BAR;
            }
        }
        if constexpr (ALIGN_EPI) { if (wr == 0) PG8_BAR; }
        if constexpr (FP8) asm volatile("s_nop 15\n\ts_nop 15" ::: "memory");
        if constexpr (!Epi::AFTER_DRAIN) { const int ln_ = (int)__builtin_amdgcn_mbcnt_hi(~0u, __builtin_amdgcn_mbcnt_lo(~0u, 0u)); int fr_ = ln_ & 15, fq_ = ln_ >> 4; asm volatile("" : "+v"(fr_), "+v"(fq_)); E(acc, cur, wr, wc, fr_, fq_); S.done(cur);
            if constexpr (TOUCH) { Unit u2_; if (S.next(ui + 2, u2_)) { const unsigned a_ = pg8_touch_lines((const char*)g.A + (size_t)u2_.pm * (512 * (size_t)g.K), 4 * g.K) + pg8_touch_lines((const char*)g.Bt + (size_t)u2_.pn * (512 * (size_t)g.K), 4 * g.K); asm volatile("" :: "v"(a_)); } } }
        if (!has_next) break;
#pragma unroll
        for (int a = 0; a < 2; ++a)
#pragma unroll
            for (int b = 0; b < 2; ++b)
#pragma unroll
                for (int m = 0; m < 4; ++m)
#pragma unroll
                    for (int n = 0; n < 2; ++n) acc[a][b][m][n] = (f32x4){0.f, 0.f, 0.f, 0.f};
        cur = nxt; cA = nA; cB = nB; ++ui;
        if constexpr (ALIGN_EPI) { if (wr == 1) PG8_BAR; }
    }
    PG8_WAIT_V(0);
    if constexpr (!ALIGN_EPI) { if (wr == 0) PG8_BAR; }
    PG8_BAR;
    if constexpr (Epi::AFTER_DRAIN) { E.fused(acc, cur, wr, wc, fr, fq, lds, wid, lane); S.done(cur); }
#undef PG8_SA
#undef PG8_SB
#undef PG8_STAGE
#undef PG8_LDA
#undef PG8_LDB
#undef PG8_MMA
#undef PG8_WAIT_V
#undef PG8_WAIT_L
#undef PG8_BAR
#undef PG8_SCHED
}

template <class Epi, class Sched, bool ALIGN_EPI = true, bool SP2 = true, bool FP8 = false, bool TOUCH = false, bool BT = false>
__device__ __forceinline__ void gemm_phase_gather(PG8_LAS unsigned char* lds, const Gemm g, const Sched& S, const Epi& E, const PG8_LAS int* lidx) {
    static_assert(SP2 && ALIGN_EPI, "gather variant: SP2 + ALIGN_EPI only");
    const int tid = threadIdx.x, wid = __builtin_amdgcn_readfirstlane(tid >> 6), lane = tid & 63, wr = wid >> 2, wc = wid & 3, fr = lane & 15, fq = lane >> 4;
    const int K = g.K, nt = K / BK;
    unsigned voffB[2]; int RA[2]; unsigned CA[2];
#pragma unroll
    for (int i = 0; i < 2; ++i) { int R, C; stage_rc(tid * 16 + i * 8192, R, C); const int Rb = Epi::PERM ? ((R & ~31) + perm32(R & 31)) : R;
        RA[i] = R; CA[i] = (unsigned)C * 2u; voffB[i] = (unsigned)(Rb * (BT ? 64 : K) + C) * 2u; }
    unsigned ca[2][2], na[2][2];
#define PG8_ROWOFF(dst, ui_) do { _Pragma("unroll") for (int h_ = 0; h_ < 2; ++h_) _Pragma("unroll") for (int i_ = 0; i_ < 2; ++i_) dst[h_][i_] = (unsigned)lidx[(ui_) * 256 + h_ * 128 + RA[i_]] * (unsigned)(K * 2) + CA[i_]; } while (0)
#define PG8_STAGEA(bufoff, kb, vo) do { _Pragma("unroll") for (int _i = 0; _i < 2; ++_i) \
        __builtin_amdgcn_global_load_lds((const unsigned*)((const char*)g.A + (size_t)(kb) + (vo)[_i]), (PG8_LAS unsigned*)(lds + (bufoff) + ldsw + _i * 8192), 16, 0, 0); } while (0)
    const size_t kstep = (size_t)(BK * 2);
    const size_t hstep = (size_t)HALF * K * 2;
    const size_t tstep = 2 * hstep;
    const size_t kstepB = BT ? (size_t)32768 : kstep, hstepB = BT ? (size_t)16384 : hstep;
    const unsigned ldsw = (unsigned)wid * 1024u;
    const int aoff = lds_byte(wr * 64 + fr, fq * 8), boff = lds_byte(wc * 32 + fr, fq * 8);
#define PG8_SA(b, h) (((b) * 2 + (h)) * HTB)
#define PG8_SB(b, h) ((4 + (b) * 2 + (h)) * HTB)
#define PG8_STAGE(bufoff, gbase, voff) do { _Pragma("unroll") for (int _i = 0; _i < 2; ++_i) \
        __builtin_amdgcn_global_load_lds((const unsigned*)((const char*)(gbase) + (voff)[_i]), (PG8_LAS unsigned*)(lds + (bufoff) + ldsw + _i * 8192), 16, 0, 0); } while (0)
#define PG8_LDA(dst, b, h) do { _Pragma("unroll") for (int m = 0; m < 4; ++m) { if constexpr (FP8) dst.w[m] = pg8_cat(*(const PG8_LAS bf16x8*)(lds + PG8_SA(b, h) + aoff + m * 2048), *(const PG8_LAS bf16x8*)(lds + PG8_SA(b, h) + aoff + m * 2048 + 1024)); \
        else { _Pragma("unroll") for (int k = 0; k < 2; ++k) dst.v[m][k] = *(const PG8_LAS bf16x8*)(lds + PG8_SA(b, h) + aoff + m * 2048 + k * 1024); } } } while (0)
#define PG8_LDB(dst, b, h) do { _Pragma("unroll") for (int n = 0; n < 2; ++n) { if constexpr (FP8) dst.w[n] = pg8_cat(*(const PG8_LAS bf16x8*)(lds + PG8_SB(b, h) + boff + n * 2048), *(const PG8_LAS bf16x8*)(lds + PG8_SB(b, h) + boff + n * 2048 + 1024)); \
        else { _Pragma("unroll") for (int k = 0; k < 2; ++k) dst.v[n][k] = *(const PG8_LAS bf16x8*)(lds + PG8_SB(b, h) + boff + n * 2048 + k * 1024); } } } while (0)
#define PG8_MMA(ai, bj, At, Bt) do { __builtin_amdgcn_s_setprio(1); if constexpr (FP8) { _Pragma("unroll") for (int m = 0; m < 4; ++m) _Pragma("unroll") for (int n = 0; n < 2; ++n) \
        asm volatile("v_mfma_f32_16x16x128_f8f6f4 %0, %1, %2, %0" : "+v"(acc[ai][bj][m][n]) : "v"(Bt.w[n]), "v"(At.w[m])); } \
        else { _Pragma("unroll") for (int m = 0; m < 4; ++m) _Pragma("unroll") for (int n = 0; n < 2; ++n) _Pragma("unroll") for (int k = 0; k < 2; ++k) \
        acc[ai][bj][m][n] = __builtin_amdgcn_mfma_f32_16x16x32_bf16(Bt.v[n][k], At.v[m][k], acc[ai][bj][m][n], 0, 0, 0); } __builtin_amdgcn_s_setprio(0); } while (0)
#define PG8_WAIT_V(n) asm volatile("s_waitcnt vmcnt(" #n ")" ::: "memory")
#define PG8_WAIT_L(n) asm volatile("s_waitcnt lgkmcnt(" #n ")" ::: "memory")
#define PG8_BAR __builtin_amdgcn_s_barrier()
#define PG8_SCHED __builtin_amdgcn_sched_barrier(0)
    Unit cur, nxt; int ui = 0;
    if (!S.next(0, cur)) return;
    if constexpr (TOUCH) { unsigned a_ = pg8_touch_rows((const char*)g.A, lidx, 2 * g.K) + pg8_touch_lines((const char*)g.Bt + (size_t)cur.pn * (512 * (size_t)g.K), 4 * g.K);
        Unit u1_; if (S.next(1, u1_)) a_ += pg8_touch_rows((const char*)g.A, lidx + 256, 2 * g.K) + pg8_touch_lines((const char*)g.Bt + (size_t)u1_.pn * (512 * (size_t)g.K), 4 * g.K);
        asm volatile("" :: "v"(a_)); }
    f32x4 acc[2][2][4][2];
#pragma unroll
    for (int a = 0; a < 2; ++a)
#pragma unroll
        for (int b = 0; b < 2; ++b)
#pragma unroll
            for (int m = 0; m < 4; ++m)
#pragma unroll
                for (int n = 0; n < 2; ++n) acc[a][b][m][n] = (f32x4){0.f, 0.f, 0.f, 0.f};
    pg8_FragA At; pg8_FragB B0, B1;
    const char* cB = (const char*)g.Bt + (size_t)cur.pn * tstep; PG8_ROWOFF(ca, 0);
    S.a_ready(cur);
    if constexpr (SP2) {
        PG8_STAGE(PG8_SB(0, 0), cB, voffB); PG8_STAGE(PG8_SB(0, 1), cB + hstepB, voffB); PG8_STAGEA(PG8_SA(0, 0), 0, ca[0]); PG8_STAGEA(PG8_SA(0, 1), 0, ca[1]);
        if (wr == 1) PG8_BAR;
        PG8_WAIT_V(2); PG8_BAR;
        PG8_STAGE(PG8_SB(1, 0), cB + kstepB, voffB); PG8_STAGEA(PG8_SA(1, 0), kstep, ca[0]); PG8_STAGE(PG8_SB(1, 1), cB + hstepB + kstepB, voffB);
        PG8_WAIT_V(6); PG8_BAR;
    }
    for (;;) {
        const bool has_next = S.next(ui + 1, nxt);
        const char* nB = has_next ? (const char*)g.Bt + (size_t)nxt.pn * tstep : cB;
        if (has_next) PG8_ROWOFF(na, ui + 1); else { _Pragma("unroll") for (int h_ = 0; h_ < 2; ++h_) _Pragma("unroll") for (int i_ = 0; i_ < 2; ++i_) na[h_][i_] = ca[h_][i_]; }
#pragma unroll 1
        for (int t = 0; t < nt; t += 2) {
            const bool last = (t == nt - 2);
            const size_t k1 = (size_t)(t + 1) * kstep, k2 = last ? (size_t)0 : (size_t)(t + 2) * kstep, k3 = k2 + kstep;
            unsigned o2[2][2];
#pragma unroll
            for (int h_ = 0; h_ < 2; ++h_)
#pragma unroll
                for (int i_ = 0; i_ < 2; ++i_) o2[h_][i_] = last ? na[h_][i_] : ca[h_][i_];
            const char* b2 = last ? nB : cB + (size_t)(t + 2) * kstepB; const char* b3 = b2 + kstepB;
            if (last && has_next) S.a_ready(nxt);
            if constexpr (SP2) {
            PG8_LDB(B0, 0, 0); PG8_LDB(B1, 0, 1); PG8_SCHED; PG8_LDA(At, 0, 0); PG8_STAGEA(PG8_SA(1, 1), k1, ca[1]);
            PG8_WAIT_V(8); PG8_WAIT_L(0); PG8_BAR; PG8_MMA(0, 0, At, B0); PG8_MMA(0, 1, At, B1); PG8_BAR; PG8_SCHED;
            PG8_LDA(At, 0, 1); PG8_STAGE(PG8_SB(0, 0), b2, voffB); PG8_STAGE(PG8_SB(0, 1), b2 + hstepB, voffB); PG8_STAGEA(PG8_SA(0, 0), k2, o2[0]);
            PG8_WAIT_V(8); PG8_WAIT_L(0); PG8_BAR; PG8_MMA(1, 0, At, B0); PG8_MMA(1, 1, At, B1); PG8_BAR; PG8_SCHED;
            PG8_LDB(B0, 1, 0); PG8_LDB(B1, 1, 1); PG8_SCHED; PG8_LDA(At, 1, 0); PG8_STAGEA(PG8_SA(0, 1), k2, o2[1]);
            PG8_WAIT_V(8); PG8_WAIT_L(0); PG8_BAR; PG8_MMA(0, 0, At, B0); PG8_MMA(0, 1, At, B1); PG8_BAR; PG8_SCHED;
            PG8_LDA(At, 1, 1); PG8_STAGE(PG8_SB(1, 0), b3, voffB); PG8_STAGE(PG8_SB(1, 1), b3 + hstepB, voffB); PG8_STAGEA(PG8_SA(1, 0), k3, o2[0]);
            PG8_WAIT_V(8); PG8_WAIT_L(0); PG8_BAR; PG8_MMA(1, 0, At, B0); PG8_MMA(1, 1, At, B1); PG8_BAR; PG8_SCHED;
            }
        }
        if constexpr (ALIGN_EPI) { if (wr == 0) PG8_BAR; }
        if constexpr (FP8) asm volatile("s_nop 15\n\ts_nop 15" ::: "memory");
        if constexpr (!Epi::AFTER_DRAIN) { const int ln_ = (int)__builtin_amdgcn_mbcnt_hi(~0u, __builtin_amdgcn_mbcnt_lo(~0u, 0u)); int fr_ = ln_ & 15, fq_ = ln_ >> 4; asm volatile("" : "+v"(fr_), "+v"(fq_)); E(acc, cur, wr, wc, fr_, fq_); S.done(cur);
            if constexpr (TOUCH) { Unit u2_; if (S.next(ui + 2, u2_)) { const unsigned a_ = pg8_touch_rows((const char*)g.A, lidx + (ui + 2) * 256, 2 * g.K) + pg8_touch_lines((const char*)g.Bt + (size_t)u2_.pn * (512 * (size_t)g.K), 4 * g.K); asm volatile("" :: "v"(a_)); } } }
        if (!has_next) break;
#pragma unroll
        for (int a = 0; a < 2; ++a)
#pragma unroll
            for (int b = 0; b < 2; ++b)
#pragma unroll
                for (int m = 0; m < 4; ++m)
#pragma unroll
                    for (int n = 0; n < 2; ++n) acc[a][b][m][n] = (f32x4){0.f, 0.f, 0.f, 0.f};
        cur = nxt; cB = nB; ++ui;
        { _Pragma("unroll") for (int h_ = 0; h_ < 2; ++h_) _Pragma("unroll") for (int i_ = 0; i_ < 2; ++i_) ca[h_][i_] = na[h_][i_]; }
        if constexpr (ALIGN_EPI) { if (wr == 1) PG8_BAR; }
    }
    PG8_WAIT_V(0);
    if constexpr (!ALIGN_EPI) { if (wr == 0) PG8_BAR; }
    PG8_BAR;
    if constexpr (Epi::AFTER_DRAIN) { E.fused(acc, cur, wr, wc, fr, fq, lds, wid, lane); S.done(cur); }
#undef PG8_SA
#undef PG8_ROWOFF
#undef PG8_STAGEA
#undef PG8_SB
#undef PG8_STAGE
#undef PG8_LDA
#undef PG8_LDB
#undef PG8_MMA
#undef PG8_WAIT_V
#undef PG8_WAIT_L
#undef PG8_BAR
#undef PG8_SCHED
}
}

constexpr int NB = 2, SEQ = 16384, T = NB * SEQ, D = 1024;
constexpr float EPS = 1e-6f;
constexpr int NWAVES = 8, NTHR = 512;
constexpr int N_IN = 55;
__host__ __device__ constexpr int LBASE(int L) { return L == 0 ? 2 : (L == 1 ? 15 : (L == 2 ? 29 : 42)); }
__host__ __device__ constexpr int NMIX(int L) { return L == 1 ? 6 : 5; }

constexpr size_t MiB = 1u << 20;
constexpr size_t WS_CTL = 0, CTL_ZERO_BYTES = 1 * MiB;
constexpr size_t WS_MOD = 1 * MiB;
constexpr size_t WS_CNT = WS_MOD + 256 * 1024;
constexpr size_t WS_TILEE = WS_CNT + 64 * 1024;
constexpr size_t WS_EID = 2 * MiB;
constexpr size_t WS_GATE = WS_EID + 256 * 1024;
constexpr size_t WS_SLOT = WS_GATE + 256 * 1024;
constexpr size_t WS_VSSP = 3 * MiB;
constexpr size_t WS_BA = 5 * MiB;
constexpr size_t WS_DNB = 7 * MiB;
constexpr size_t WS_RTR = 9 * MiB;
constexpr size_t WS_WBA = 11 * MiB;
constexpr size_t WS_TOK = 12 * MiB;
constexpr size_t WS_W = 16 * MiB;
constexpr size_t WL_STRIDE = 48 * MiB, WL_OUT = 32 * MiB;
constexpr size_t WS_WMIX = WS_W + 4 * WL_STRIDE;
constexpr size_t WMIX_GM_IN0 = 0, WMIX_GM_OUT0 = 4 * MiB, WMIX_DN_IN = 6 * MiB, WMIX_DN_OUT = 13 * MiB, WMIX_SWA_IN = 15 * MiB, WMIX_SWA_OUT = 18 * MiB, WMIX_GM_IN3 = 20 * MiB, WMIX_GM_OUT3 = 24 * MiB;
constexpr size_t WS_ACT = 240 * MiB;
constexpr size_t A_H = 0;
constexpr size_t A_U = 64 * MiB, A_V = 128 * MiB, A_GATED = 192 * MiB;
constexpr size_t A_QKV = 64 * MiB, A_Z = 192 * MiB, A_QN = 256 * MiB, A_KN = 288 * MiB, A_VV = 320 * MiB, A_FA = 384 * MiB, A_FB = 484 * MiB, A_FU = 64 * MiB, A_O = 128 * MiB, A_SFR = 548 * MiB, A_VFR = 676 * MiB;
constexpr size_t A_XG = 64 * MiB, A_ACTV = 208 * MiB, A_Y = 280 * MiB;
constexpr size_t WS_X16B = WS_ACT + 548 * MiB;
constexpr size_t WS_END = WS_ACT + 740 * MiB;
constexpr int MAXROWS = 73728;

constexpr int RING_BYTES = 131072;
constexpr int LDSCTL_OFF = RING_BYTES, MISC_OFF = LDSCTL_OFF + 320;
constexpr int LDS_BYTES = 147456;

#define LAS __attribute__((address_space(3)))
typedef unsigned short bf16;
typedef unsigned v4u __attribute__((ext_vector_type(4)));
typedef unsigned v2u __attribute__((ext_vector_type(2)));
typedef float f32x4 __attribute__((ext_vector_type(4)));
typedef short bf16x8 __attribute__((ext_vector_type(8)));
typedef short bf16x4 __attribute__((ext_vector_type(4)));
#define LDS_WAIT() asm volatile("s_waitcnt lgkmcnt(0)" ::: "memory")
#define VM_WAIT() asm volatile("s_waitcnt vmcnt(0)" ::: "memory")
__device__ __forceinline__ unsigned pk2(float lo, float hi) { return pg8::cvt_pk_bf16(lo, hi); }
__device__ __forceinline__ float bflo(unsigned w) { return __uint_as_float(w << 16); }
__device__ __forceinline__ float bfhi(unsigned w) { return __uint_as_float(w & 0xffff0000u); }
__device__ __forceinline__ float bf1(unsigned short b) { return __uint_as_float(((unsigned)b) << 16); }
__device__ __forceinline__ float wave_sum(float v) {
#pragma unroll
    for (int o = 1; o < 64; o <<= 1) v += __shfl_xor(v, o);
    return v;
}
__device__ __forceinline__ float fast_exp(float x) { return __builtin_amdgcn_exp2f(x * 1.44269504089f); }
__device__ __forceinline__ float sigmoidf_(float x) { return __builtin_amdgcn_rcpf(1.0f + fast_exp(-x)); }
__device__ __forceinline__ float siluf_(float x) { return x * sigmoidf_(x); }
__device__ __forceinline__ float gelu_tanh(float x) { const float y = 1.5957691216057308f * (x + 0.044715f * x * x * x); return x * __builtin_amdgcn_rcpf(1.0f + fast_exp(-y)); }

__device__ __forceinline__ f32x4 gelu_tanh4(const f32x4 x) { const f32x4 t = x * x; const f32x4 p = t * -0.10294324f + -2.30220819f; const f32x4 ea = p * x; f32x4 e;
#pragma unroll
    for (int j = 0; j < 4; ++j) e[j] = __builtin_amdgcn_exp2f(ea[j]);
    const f32x4 d = e + 1.0f; f32x4 rc;
#pragma unroll
    for (int j = 0; j < 4; ++j) rc[j] = __builtin_amdgcn_rcpf(d[j]);
    return x * rc; }
#define RLX_AGENT __ATOMIC_RELAXED, __HIP_MEMORY_SCOPE_AGENT
__device__ __forceinline__ unsigned char* uni_ptr(unsigned char* p) { const unsigned long long w = (unsigned long long)p; const unsigned lo = __builtin_amdgcn_readfirstlane((unsigned)w), hi = __builtin_amdgcn_readfirstlane((unsigned)(w >> 32)); return (unsigned char*)(__attribute__((address_space(1))) unsigned char*)(((unsigned long long)hi << 32) | lo); }
__device__ __forceinline__ unsigned pk4_fp8(float a, float b, float c, float d) { int w = __builtin_amdgcn_cvt_pk_fp8_f32(a, b, 0, false); w = __builtin_amdgcn_cvt_pk_fp8_f32(c, d, w, true); return (unsigned)w; }
#define XB_TMO      128
#define XB_XCNT(j)  (256  + 64 * (j))
#define XB_XSUB(j)  (1280 + 64 * (j))
#define XB_XGEN(j)  (2304 + 64 * (j))
#define XB_TOP      3328
#define XB_TOPGEN   3392
#define XCD_BAR_WORDS 3456
#define XB_SPIN_CAP (1u << 18)

__device__ __forceinline__ unsigned xb_ld(unsigned* p)              { return __hip_atomic_load(p, __ATOMIC_RELAXED, __HIP_MEMORY_SCOPE_AGENT); }
__device__ __forceinline__ unsigned xb_add(unsigned* p, unsigned v) { return __hip_atomic_fetch_add(p, v, __ATOMIC_RELAXED, __HIP_MEMORY_SCOPE_AGENT); }
__device__ __forceinline__ unsigned xb_xcc_id() { return (unsigned)__builtin_amdgcn_s_getreg((3 << 11) | 20) & 0xFu; }
#define XB_SPIN(cond, bar) do { unsigned _sp = 0; while (cond) { __builtin_amdgcn_s_sleep(1); \
    if ((++_sp & 255u) == 0u) { if (xb_ld(&(bar)[XB_TMO])) break; if (_sp > XB_SPIN_CAP) { atomicAdd(&(bar)[XB_TMO], 1u); break; } } } } while (0)

struct XcdBarrier {
    unsigned* bar; unsigned x;
    volatile LAS unsigned* st;
};

__device__ __forceinline__ XcdBarrier xcd_barrier_post(unsigned* bar, volatile LAS unsigned* st) {
    XcdBarrier b; b.bar = bar; b.x = xb_xcc_id(); b.st = st;
    if (threadIdx.x == 0) (void)xb_add(&bar[XB_XCNT(b.x)], 1u);
    return b;
}
__device__ __forceinline__ void xcd_barrier_complete(unsigned* bar, unsigned x, unsigned& nloc, unsigned& nx) {
    const unsigned G = gridDim.x * gridDim.y * gridDim.z;
    unsigned sum, cnt, mine, sp = 0u;
    for (;;) {
        sum = 0u; cnt = 0u; mine = 0u;
#pragma unroll
        for (unsigned j = 0; j < 16; ++j) { const unsigned c = xb_ld(&bar[XB_XCNT(j)]); sum += c; cnt += (c > 0u) ? 1u : 0u; mine = (j == x) ? c : mine; }
        if (sum == G) break;
        __builtin_amdgcn_s_sleep(1);
        if ((++sp & 255u) == 0u) { if (xb_ld(&bar[XB_TMO])) break; if (sp > XB_SPIN_CAP) { atomicAdd(&bar[XB_TMO], 1u); break; } }
    }
    nloc = mine > 0u ? mine : 1u; nx = cnt > 0u ? cnt : 1u;
}

__device__ __forceinline__ void xcd_barrier(const XcdBarrier& b) {
    asm volatile("s_waitcnt vmcnt(0)" ::: "memory");
    __syncthreads();
    if (threadIdx.x == 0) {
        unsigned* bar = b.bar;
        __builtin_amdgcn_s_waitcnt(0);
        unsigned nloc = b.st[0], nx = b.st[1];
        if (nloc == 0u) { xcd_barrier_complete(bar, b.x, nloc, nx); b.st[0] = nloc; b.st[1] = nx; }
        const unsigned old = xb_add(&bar[XB_XSUB(b.x)], 1u);
        const unsigned gen = old / nloc;
        if (old + 1u == (gen + 1u) * nloc) {
            __builtin_amdgcn_fence(__ATOMIC_RELEASE, "agent");
            asm volatile("s_waitcnt vmcnt(0)" ::: "memory");
            const unsigned og = xb_add(&bar[XB_TOP], 1u);
            const unsigned tg = og / nx;
            if (og + 1u == (tg + 1u) * nx) xb_add(&bar[XB_TOPGEN], 1u);
            else XB_SPIN(xb_ld(&bar[XB_TOPGEN]) == tg, bar);
            __builtin_amdgcn_fence(__ATOMIC_ACQUIRE, "agent");
            xb_add(&bar[XB_XGEN(b.x)], 1u);
            asm volatile("s_waitcnt vmcnt(0)" ::: "memory");
        } else {
            XB_SPIN(xb_ld(&bar[XB_XGEN(b.x)]) == gen, bar);
            __builtin_amdgcn_fence(__ATOMIC_ACQUIRE, "agent");
            asm volatile("s_waitcnt vmcnt(0)" ::: "memory");
        }
    }
    __syncthreads();
}

typedef const pg8::f32x4 (&AccRef)[2][2][4][2];

struct EpiGm1 {
    static constexpr bool PERM = true, AFTER_DRAIN = false;
    bf16* U; bf16* V; float* vssp;
    __device__ __forceinline__ void operator()(AccRef acc, const pg8::Unit& u, int wr, int wc, int fr, int fq) const {
        const int row0 = u.pm * 256 + wr * 64 + fr; const bool isV = u.pn >= 4; const int col0 = (u.pn & 3) * 256 + wc * 32 + 8 * fq;
        bf16* base = isV ? V : U;
#pragma unroll
        for (int ai = 0; ai < 2; ++ai)
#pragma unroll
            for (int m = 0; m < 4; ++m) { const int row = row0 + ai * 128 + m * 16; bf16* rowp = base + (size_t)row * 1024 + col0; float ss = 0.f;
#pragma unroll
                for (int bj = 0; bj < 2; ++bj) { const f32x4 v0 = gelu_tanh4(acc[ai][bj][m][0]), v1 = gelu_tanh4(acc[ai][bj][m][1]);
                    { const f32x4 s4 = v0 * v0 + v1 * v1; ss += (s4[0] + s4[1]) + (s4[2] + s4[3]); }
                    v4u w; w.x = pk2(v0[0], v0[1]); w.y = pk2(v0[2], v0[3]); w.z = pk2(v1[0], v1[1]); w.w = pk2(v1[2], v1[3]);
                    *(v4u*)(rowp + bj * 128) = w; }
                if (isV) { ss += __shfl_xor(ss, 16); ss += __shfl_xor(ss, 32); if (fq == 0) vssp[(size_t)row * 16 + (u.pn - 4) * 4 + wc] = ss; } }
    }
};
template <bool SRC16>
struct EpiRes {
    static constexpr bool PERM = true, AFTER_DRAIN = false;
    const void* src; bf16* dst; const float* gate;
    __device__ __forceinline__ void operator()(AccRef acc, const pg8::Unit& u, int wr, int wc, int fr, int fq) const {
        const int row0 = u.pm * 256 + wr * 64 + fr, col0 = u.pn * 256 + wc * 32 + 8 * fq; const int b = (u.pm * 256) / SEQ;
        f32x4 gv[2][2];
#pragma unroll
        for (int bj = 0; bj < 2; ++bj)
#pragma unroll
            for (int n = 0; n < 2; ++n) gv[bj][n] = *(const f32x4*)(gate + (size_t)b * 6144 + col0 + bj * 128 + n * 4);
#pragma unroll
        for (int ai = 0; ai < 2; ++ai)
#pragma unroll
            for (int m = 0; m < 4; ++m) { const size_t off = (size_t)(row0 + ai * 128 + m * 16) * 1024 + col0;
#pragma unroll
                for (int bj = 0; bj < 2; ++bj) { f32x4 x0, x1;
                    if constexpr (SRC16) { const v4u w = *(const v4u*)((const bf16*)src + off + bj * 128); x0 = (f32x4){bflo(w.x), bfhi(w.x), bflo(w.y), bfhi(w.y)}; x1 = (f32x4){bflo(w.z), bfhi(w.z), bflo(w.w), bfhi(w.w)}; }
                    else { x0 = *(const f32x4*)((const float*)src + off + bj * 128); x1 = *(const f32x4*)((const float*)src + off + bj * 128 + 4); }
                    const f32x4 v0 = x0 + gv[bj][0] * acc[ai][bj][m][0], v1 = x1 + gv[bj][1] * acc[ai][bj][m][1];
                    v4u o; o.x = pk2(v0[0], v0[1]); o.y = pk2(v0[2], v0[3]); o.z = pk2(v1[0], v1[1]); o.w = pk2(v1[2], v1[3]);
                    *(v4u*)(dst + off + bj * 128) = o; } }
    }
};
struct EpiBf {
    static constexpr bool PERM = true, AFTER_DRAIN = false;
    bf16* O; int ldc; int nmask; float scale;
    __device__ __forceinline__ void operator()(AccRef acc, const pg8::Unit& u, int wr, int wc, int fr, int fq) const {
        const int row0 = u.pm * 256 + wr * 64 + fr, col0 = (u.pn & nmask) * 256 + wc * 32 + 8 * fq;
#pragma unroll
        for (int ai = 0; ai < 2; ++ai)
#pragma unroll
            for (int m = 0; m < 4; ++m) { bf16* rowp = O + (size_t)(row0 + ai * 128 + m * 16) * ldc + col0;
#pragma unroll
                for (int bj = 0; bj < 2; ++bj) { const f32x4 v0 = acc[ai][bj][m][0] * scale, v1 = acc[ai][bj][m][1] * scale;
                    v4u w; w.x = pk2(v0[0], v0[1]); w.y = pk2(v0[2], v0[3]); w.z = pk2(v1[0], v1[1]); w.w = pk2(v1[2], v1[3]);
                    *(v4u*)(rowp + bj * 128) = w; } }
    }
};
struct EpiF8 {
    static constexpr bool PERM = true, AFTER_DRAIN = false;
    unsigned char* O; int ldc; int nmask; float scale;
    __device__ __forceinline__ void operator()(AccRef acc, const pg8::Unit& u, int wr, int wc, int fr, int fq) const {
        const int row0 = u.pm * 256 + wr * 64 + fr, col0 = (u.pn & nmask) * 256 + wc * 32 + 8 * fq;
#pragma unroll
        for (int ai = 0; ai < 2; ++ai)
#pragma unroll
            for (int m = 0; m < 4; ++m) { unsigned char* rowp = O + (size_t)(row0 + ai * 128 + m * 16) * ldc + col0;
#pragma unroll
                for (int bj = 0; bj < 2; ++bj) { const f32x4 v0 = acc[ai][bj][m][0] * scale, v1 = acc[ai][bj][m][1] * scale;
                    v2u w; w.x = pk4_fp8(v0[0], v0[1], v0[2], v0[3]); w.y = pk4_fp8(v1[0], v1[1], v1[2], v1[3]);
                    *(v2u*)(rowp + bj * 128) = w; } }
    }
};
struct EpiDn1 {
    static constexpr bool PERM = true, AFTER_DRAIN = false;
    bf16* QKV; bf16* Z; float* BA;
    __device__ __forceinline__ void operator()(AccRef acc, const pg8::Unit& u, int wr, int wc, int fr, int fq) const {
        const int row0 = u.pm * 256 + wr * 64 + fr;
        if (u.pn < 12) {
            bf16* base = u.pn < 8 ? QKV : Z; const int ldc = u.pn < 8 ? 2048 : 1024; const int col0 = (u.pn < 8 ? u.pn : u.pn - 8) * 256 + wc * 32 + 8 * fq;
#pragma unroll
            for (int ai = 0; ai < 2; ++ai)
#pragma unroll
                for (int m = 0; m < 4; ++m) { bf16* rowp = base + (size_t)(row0 + ai * 128 + m * 16) * ldc + col0;
#pragma unroll
                    for (int bj = 0; bj < 2; ++bj) { const f32x4 v0 = acc[ai][bj][m][0], v1 = acc[ai][bj][m][1];
                        v4u w; w.x = pk2(v0[0], v0[1]); w.y = pk2(v0[2], v0[3]); w.z = pk2(v1[0], v1[1]); w.w = pk2(v1[2], v1[3]);
                        *(v4u*)(rowp + bj * 128) = w; } }
        } else if (wc == 0 && fq < 2) {
#pragma unroll
            for (int ai = 0; ai < 2; ++ai)
#pragma unroll
                for (int m = 0; m < 4; ++m) { float* rowp = BA + (size_t)(row0 + ai * 128 + m * 16) * 16 + 8 * fq;
                    *(f32x4*)(rowp) = acc[ai][0][m][0]; *(f32x4*)(rowp + 4) = acc[ai][0][m][1]; }
        }
    }
};
struct EpiMoe1 {
    static constexpr bool PERM = true, AFTER_DRAIN = false;
    unsigned char* O;
    __device__ __forceinline__ void operator()(AccRef acc, const pg8::Unit& u, int wr, int wc, int fr, int fq) const {
        const int row0 = u.pm * 256 + wr * 64 + fr, col0 = (u.pn & 3) * 128 + wc * 32 + 8 * fq;
#pragma unroll
        for (int ai = 0; ai < 2; ++ai)
#pragma unroll
            for (int m = 0; m < 4; ++m) { unsigned char* rowp = O + (size_t)(row0 + ai * 128 + m * 16) * 512 + col0; float r[8];
#pragma unroll
                for (int n = 0; n < 2; ++n) {
                    const f32x4 A = acc[ai][0][m][n], Gv = acc[ai][1][m][n]; const f32x4 ea = A * (-1.44269504089f * 0.03125f); f32x4 e;
#pragma unroll
                    for (int j = 0; j < 4; ++j) e[j] = __builtin_amdgcn_exp2f(ea[j]);
                    const f32x4 d = e * 1024.0f + 1024.0f; f32x4 rc;
#pragma unroll
                    for (int j = 0; j < 4; ++j) rc[j] = __builtin_amdgcn_rcpf(d[j]);
                    const f32x4 o = (A * Gv) * rc;
#pragma unroll
                    for (int j = 0; j < 4; ++j) r[4 * n + j] = o[j]; }
                v2u w; w.x = pk4_fp8(r[0], r[1], r[2], r[3]); w.y = pk4_fp8(r[4], r[5], r[6], r[7]);
                *(v2u*)rowp = w; }
    }
};
struct MoeOrder {
    const LAS int* tile_e; int total, G, c;
    __device__ __forceinline__ void init(const LAS int* te, int ntiles, int G_, int c_) { tile_e = te; total = ntiles * 4; G = G_; c = c_; }
    __device__ __forceinline__ bool next(int i, pg8::Unit& u) const {
        const long Lx = (long)i * G + c; if (Lx >= total) return false;
        const int w0 = (int)Lx, q = total / 8, r = total % 8, xcd = w0 % 8, off = w0 / 8;
        const int wgid = (xcd < r ? xcd * (q + 1) : r * (q + 1) + (xcd - r) * q) + off;
        const int rt = wgid >> 2; u.pm = rt; u.pn = tile_e[rt] * 4 + (wgid & 3); return true;
    }
    __device__ __forceinline__ void a_ready(const pg8::Unit&) const {}
    __device__ __forceinline__ void done(const pg8::Unit&) const {}
};

struct EpiMoe1P {
    static constexpr bool PERM = true, AFTER_DRAIN = false;
    bf16* O;
    __device__ __forceinline__ void operator()(AccRef acc, const pg8::Unit& u, int wr, int wc, int fr, int fq) const {
        const int row0 = u.pm * 256 + wr * 64 + fr, col0 = (u.pn & 3) * 128 + wc * 32 + 8 * fq;
#pragma unroll
        for (int ai = 0; ai < 2; ++ai)
#pragma unroll
            for (int m = 0; m < 4; ++m) { unsigned long long* rowp = (unsigned long long*)(O + (size_t)(row0 + ai * 128 + m * 16) * 512 + col0); float r[8];
#pragma unroll
                for (int n = 0; n < 2; ++n)
#pragma unroll
                    for (int j = 0; j < 4; ++j) { const float a = acc[ai][0][m][n][j], g = acc[ai][1][m][n][j]; r[4 * n + j] = siluf_(a) * g; }
                const unsigned long long w0 = (unsigned long long)pk2(r[0], r[1]) | ((unsigned long long)pk2(r[2], r[3]) << 32), w1 = (unsigned long long)pk2(r[4], r[5]) | ((unsigned long long)pk2(r[6], r[7]) << 32);
                __hip_atomic_store(rowp, w0, __ATOMIC_RELAXED, __HIP_MEMORY_SCOPE_AGENT); __hip_atomic_store(rowp + 1, w1, __ATOMIC_RELAXED, __HIP_MEMORY_SCOPE_AGENT); }
    }
};
struct MoeOrderPub : MoeOrder {
    unsigned* cnt;
    __device__ __forceinline__ void done(const pg8::Unit& u) const {
        asm volatile("s_waitcnt vmcnt(0)" ::: "memory");
        if ((threadIdx.x & 63) == 0) __hip_atomic_fetch_add(cnt + 64 * u.pm, 1u, __ATOMIC_RELAXED, __HIP_MEMORY_SCOPE_AGENT);
    }
};
struct MoeOrderWait : MoeOrder {
    const unsigned* cnt; unsigned* tmo;
    __device__ __forceinline__ void a_ready(const pg8::Unit& u) const {
        if (threadIdx.x < 64) {
            const unsigned long long t0 = __builtin_amdgcn_s_memrealtime(); unsigned polls = 0;
            while ((unsigned)__builtin_amdgcn_readfirstlane(__hip_atomic_load(cnt + 64 * u.pm, __ATOMIC_RELAXED, __HIP_MEMORY_SCOPE_AGENT)) < 32u) {
                if ((++polls & 255u) == 0u && __builtin_amdgcn_readfirstlane(__hip_atomic_load(tmo, __ATOMIC_RELAXED, __HIP_MEMORY_SCOPE_AGENT)) != 0u) break;
                if (__builtin_amdgcn_s_memrealtime() - t0 > 2000000ull) { if (threadIdx.x == 0) __hip_atomic_store(tmo, 1u, __ATOMIC_RELAXED, __HIP_MEMORY_SCOPE_AGENT); break; }
                __builtin_amdgcn_s_sleep(2); }
            __builtin_amdgcn_fence(__ATOMIC_ACQUIRE, "agent");
            asm volatile("s_waitcnt vmcnt(0)" ::: "memory");
        }
        asm volatile("" ::: "memory"); __builtin_amdgcn_s_barrier(); asm volatile("" ::: "memory");
    }
};

struct Args { const float* in[N_IN]; float* out; unsigned char* ws; int ph_lo, ph_hi, li, pad; };

__device__ __forceinline__ void tr_item(const float* __restrict__ W, int ldn, int k0, int n0, bf16* __restrict__ WT, int Kd, int drow0, LAS float* scr, int lane) {
#pragma unroll 8
    for (int i = 0; i < 32; ++i) { const int kk = 2 * i + (lane >> 5); scr[kk * 33 + (lane & 31)] = W[(size_t)(k0 + kk) * ldn + n0 + (lane & 31)]; }
    LDS_WAIT(); asm volatile("" ::: "memory");
    const int c = lane & 7;
#pragma unroll
    for (int j = 0; j < 4; ++j) { const int n = (lane >> 3) + 8 * j; const LAS float* s = scr + (8 * c) * 33 + n;
        v4u o; o.x = pk2(s[0 * 33], s[1 * 33]); o.y = pk2(s[2 * 33], s[3 * 33]); o.z = pk2(s[4 * 33], s[5 * 33]); o.w = pk2(s[6 * 33], s[7 * 33]);
        *(v4u*)(WT + (size_t)(drow0 + n) * Kd + k0 + 8 * c) = o; }
    LDS_WAIT(); asm volatile("" ::: "memory");
}

constexpr int CV_PER_L = 24576, CV_N_EXP = 4 * CV_PER_L, CV_MIX_L01 = 3584, CV_N_MIXI = 1536 + 2048 + 1280 + 1536;
#ifndef CV_SPLIT
#define CV_SPLIT CV_PER_L
#endif
struct CvItem { const float* src; bf16* dst; int ldn, Kd; float qs; };
__device__ __forceinline__ CvItem cv_decode(const Args& args, unsigned char* ws, int it) {
    CvItem c; const float* src; bf16* dst; int ldn, k0, n0, Kd, drow0;
    constexpr int PER_L = CV_PER_L, N_EXP = CV_N_EXP;
    if (it < N_EXP) {
        const int L = it / PER_L; int r = it % PER_L; const int ib = LBASE(L) + 4 + NMIX(L);
        if (r < 16384) { const int e = r >> 9, rr = r & 511; k0 = (rr >> 5) * 64; n0 = (rr & 31) * 32; ldn = 1024; Kd = 1024;
            src = args.in[ib + 2] + (size_t)e * 1048576; dst = (bf16*)(ws + WS_W + (size_t)L * WL_STRIDE + (size_t)e * 1048576);
            drow0 = (n0 < 512) ? ((n0 >> 7) * 256 + (n0 & 127)) : ((((n0 - 512) >> 7) * 256) + 128 + ((n0 - 512) & 127)); }
        else { r -= 16384; const int e = r >> 8, rr = r & 255; k0 = (rr >> 5) * 64; n0 = (rr & 31) * 32; ldn = 1024; Kd = 512;
            src = args.in[ib + 3] + (size_t)e * 524288; dst = (bf16*)(ws + WS_W + (size_t)L * WL_STRIDE + WL_OUT + (size_t)e * 524288); drow0 = n0; }
    } else {
        int r = it - N_EXP; int idx, nblk; size_t woff;
        if (r < 1024) { idx = 6; ldn = 2048; nblk = 64; woff = WMIX_GM_IN0; }
        else if ((r -= 1024) < 512) { idx = 10; ldn = 1024; nblk = 32; woff = WMIX_GM_OUT0; }
        else if ((r -= 512) < 1536) { idx = 19; ldn = 3088; nblk = 96; woff = WMIX_DN_IN; }
        else if ((r -= 1536) < 512) { idx = 24; ldn = 1024; nblk = 32; woff = WMIX_DN_OUT; }
        else if ((r -= 512) < 768) { idx = 33; ldn = 1536; nblk = 48; woff = WMIX_SWA_IN; }
        else if ((r -= 768) < 512) { idx = 37; ldn = 1024; nblk = 32; woff = WMIX_SWA_OUT; }
        else if ((r -= 512) < 1024) { idx = 46; ldn = 2048; nblk = 64; woff = WMIX_GM_IN3; }
        else { r -= 1024; idx = 50; ldn = 1024; nblk = 32; woff = WMIX_GM_OUT3; }
        src = args.in[idx]; dst = (bf16*)(ws + WS_WMIX + woff); k0 = (r / nblk) * 64; n0 = (r % nblk) * 32; Kd = 1024; drow0 = n0;
    }
    c.src = src + (size_t)k0 * ldn + n0; c.ldn = ldn; c.Kd = Kd;
    if (it < N_EXP) { c.qs = ((it % PER_L) < 16384) ? 32.f : 16.f;
        c.dst = (bf16*)((unsigned char*)dst + (size_t)(drow0 >> 8) * (256 * (size_t)Kd) + (size_t)(k0 >> 7) * 32768 + (size_t)(drow0 & 255) * 128 + (k0 & 127)); }
    else { c.qs = 0.f; c.dst = (bf16*)((unsigned char*)dst + (size_t)(drow0 >> 8) * (512 * (size_t)Kd) + (size_t)(k0 >> 6) * 32768 + (size_t)(drow0 & 255) * 128 + (size_t)(k0 & 63) * 2); }
    return c;
}
__device__ __forceinline__ void cv_load(const CvItem& c, f32x4 (&v)[8], int lane) {
    if (c.qs > 0.f) { const float* p = c.src + (size_t)(4 * (lane >> 3)) * c.ldn + 4 * (lane & 7);
#pragma unroll
        for (int i = 0; i < 2; ++i)
#pragma unroll
            for (int r = 0; r < 4; ++r) v[4 * i + r] = __builtin_nontemporal_load((const f32x4*)(p + (size_t)(32 * i + r) * c.ldn)); }
    else { const float* p = c.src + (size_t)(2 * (lane >> 3)) * c.ldn + 4 * (lane & 7);
#pragma unroll
        for (int i = 0; i < 4; ++i) { v[2 * i] = __builtin_nontemporal_load((const f32x4*)(p + (size_t)(16 * i) * c.ldn)); v[2 * i + 1] = __builtin_nontemporal_load((const f32x4*)(p + (size_t)(16 * i + 1) * c.ldn)); } }
}
__device__ __forceinline__ void cv_store(const CvItem& c, const f32x4 (&v)[8], LAS float* scr, int lane) {
    LAS unsigned* su = (LAS unsigned*)scr; const int kp = lane >> 3, n4 = 4 * (lane & 7);
    if (c.qs > 0.f) {
#pragma unroll
        for (int i = 0; i < 2; ++i) { LAS unsigned* q = su + (kp + 8 * i) * 33 + n4;
#pragma unroll
            for (int e = 0; e < 4; ++e) q[e] = pk4_fp8(v[4 * i][e] * c.qs, v[4 * i + 1][e] * c.qs, v[4 * i + 2][e] * c.qs, v[4 * i + 3][e] * c.qs); }
        LDS_WAIT(); asm volatile("" ::: "memory");
        const int n = lane >> 1, hf = lane & 1; const LAS unsigned* s = su + (8 * hf) * 33 + n;
        v4u o0, o1; o0.x = s[0]; o0.y = s[33]; o0.z = s[66]; o0.w = s[99]; o1.x = s[132]; o1.y = s[165]; o1.z = s[198]; o1.w = s[231];
        unsigned char* d = (unsigned char*)c.dst + (size_t)n * 128 + 32 * hf; *(v4u*)d = o0; *(v4u*)(d + 16) = o1;
        LDS_WAIT(); asm volatile("" ::: "memory");
        return; }
#pragma unroll
    for (int i = 0; i < 4; ++i) { LAS unsigned* q = su + (kp + 8 * i) * 33 + n4;
#pragma unroll
        for (int e = 0; e < 4; ++e) q[e] = pk2(v[2 * i][e], v[2 * i + 1][e]); }
    LDS_WAIT(); asm volatile("" ::: "memory");
    const int ck = lane & 7;
#pragma unroll
    for (int j = 0; j < 4; ++j) { const int n = (lane >> 3) + 8 * j; const LAS unsigned* s = su + (4 * ck) * 33 + n;
        v4u o; o.x = s[0]; o.y = s[33]; o.z = s[66]; o.w = s[99];
        *(v4u*)((unsigned char*)c.dst + (size_t)n * 128 + 16 * ck) = o; }
    LDS_WAIT(); asm volatile("" ::: "memory");
}
__device__ __forceinline__ void convert_weights(const Args& args, LAS unsigned char* lds, int it_lo, int it_hi, int gw, int NGW) {
    int tid_ = threadIdx.x; asm volatile("" : "+v"(tid_)); const int lane = tid_ & 63, wave = __builtin_amdgcn_readfirstlane(tid_ >> 6);
    unsigned char* ws = uni_ptr(args.ws);
    LAS float* scr = (LAS float*)(lds + wave * 8448);
    for (int it = it_lo + 4 * gw; it < it_hi; it += 4 * NGW) {
        const CvItem c0 = cv_decode(args, ws, it);
        const size_t dstep = (size_t)32 * 128;
        f32x4 v[4][8];
#pragma unroll
        for (int j = 0; j < 4; ++j) { CvItem c = c0; c.src = c0.src + 32 * j; cv_load(c, v[j], lane); }
#pragma unroll
        for (int j = 0; j < 4; ++j) { CvItem c = c0; c.dst = (bf16*)((unsigned char*)c0.dst + j * dstep); cv_store(c, v[j], scr, lane); }
    }
}
__device__ __forceinline__ void phase_prologue(const Args& args, LAS unsigned char* lds) {
    int tid_ = threadIdx.x; asm volatile("" : "+v"(tid_)); const int tid = tid_, lane = tid & 63, wave = __builtin_amdgcn_readfirstlane(tid >> 6), G = gridDim.x, bid = blockIdx.x; (void)tid; (void)lane; (void)wave;
    unsigned char* ws = uni_ptr(args.ws);
    LAS float* cact = (LAS float*)(lds + 69632);
    LAS float* red = (LAS float*)(lds + 77824);
    for (int k = tid; k < 2048; k += NTHR) cact[k] = siluf_(args.in[1][k]);
    __syncthreads();
    float* MOD = (float*)(ws + WS_MOD);
    for (int item = bid; item < 384; item += G) {
        const int L = item / 96, cg = item % 96, c4 = tid & 15, ks = tid >> 4;
        const float* w = args.in[LBASE(L) + 2] + (size_t)(ks * 32) * 6144 + cg * 64 + c4 * 4;
        f32x4 a0 = {0.f, 0.f, 0.f, 0.f}, a1 = {0.f, 0.f, 0.f, 0.f};
#pragma unroll 8
        for (int kk = 0; kk < 32; ++kk) { const f32x4 wv = *(const f32x4*)(w + (size_t)kk * 6144); a0 += cact[ks * 32 + kk] * wv; a1 += cact[1024 + ks * 32 + kk] * wv; }
        *(LAS f32x4*)(red + (ks * 2 + 0) * 64 + c4 * 4) = a0; *(LAS f32x4*)(red + (ks * 2 + 1) * 64 + c4 * 4) = a1;
        __syncthreads();
        if (tid < 128) { const int b = tid >> 6, col = tid & 63; float s = 0.f;
#pragma unroll
            for (int k2 = 0; k2 < 32; ++k2) s += red[(k2 * 2 + b) * 64 + col];
            MOD[(size_t)(L * 2 + b) * 6144 + cg * 64 + col] = s + args.in[LBASE(L) + 3][cg * 64 + col]; }
        __syncthreads();
    }
    { const int gw = bid * NWAVES + wave, NGW = G * NWAVES;
      if (G > 128) { convert_weights(args, lds, 0, CV_SPLIT, gw, NGW); convert_weights(args, lds, CV_N_EXP, CV_N_EXP + CV_MIX_L01, gw, NGW); }
      else convert_weights(args, lds, 0, CV_N_EXP + CV_N_MIXI, gw, NGW); }
    const int gt = bid * NTHR + tid, NGT = G * NTHR;
    { bf16* dst = (bf16*)(ws + WS_WBA); const float* w = args.in[19];
      for (int i = gt; i < 16 * 1024; i += NGT) { const int n = i >> 10, k = i & 1023; dst[i] = (bf16)(pk2(w[(size_t)k * 3088 + 3072 + n], 0.f) & 0xffffu); } }
    for (int i = gt; i < 4 * 48 * 1024; i += NGT) {
        const int L = i / 49152, rem = i % 49152, n = rem >> 10, k = rem & 1023;
        const float w = n < 36 ? args.in[LBASE(L) + 4 + NMIX(L)][(size_t)k * 36 + n] : 0.f;
        const unsigned hi = pk2(w, 0.f) & 0xffffu; const float lo = w - bf1((unsigned short)hi);
        bf16* RH = (bf16*)(ws + WS_RTR + (size_t)L * 196608); RH[rem] = (bf16)hi; RH[49152 + rem] = (bf16)(pk2(lo, 0.f) & 0xffffu);
    }
}

__device__ __forceinline__ void dn_ba_tail(const Args& args, LAS unsigned char* lds) {
    int tid_ = threadIdx.x; asm volatile("" : "+v"(tid_)); const int tid = tid_, lane = tid & 63, wave = __builtin_amdgcn_readfirstlane(tid >> 6), G = gridDim.x, bid = blockIdx.x;
    unsigned char* ws = uni_ptr(args.ws); const bf16* H = (const bf16*)(ws + WS_ACT + A_H); const bf16* W = (const bf16*)(ws + WS_WBA); float* BA = (float*)(ws + WS_BA);
    const int r = lane & 15, q = lane >> 4;
    bool staged = false;
    for (int g0 = bid * NWAVES; g0 < T / 16; g0 += G * NWAVES) {
        const int grp = g0 + wave; const bool act = grp < T / 16;
        const bf16* hp = H + (size_t)((act ? grp : 0) * 16 + r) * 1024 + 8 * q;
        bf16x8 hf[32];
#pragma unroll
        for (int s = 0; s < 32; ++s) hf[s] = *(const bf16x8*)(hp + 32 * s);
        if (!staged) { staged = true;
#pragma unroll
            for (int i = 0; i < 4; ++i) { const int idx = tid * 4 + i, n = idx >> 7, c = idx & 127; *(LAS v4u*)(lds + n * 2064 + c * 16) = *(const v4u*)(W + (size_t)n * 1024 + c * 8); }
            __syncthreads(); }
        f32x4 acc = {0.f, 0.f, 0.f, 0.f};
#pragma unroll
        for (int s = 0; s < 32; ++s) acc = __builtin_amdgcn_mfma_f32_16x16x32_bf16(*(const LAS bf16x8*)(lds + r * 2064 + 64 * s + 16 * q), hf[s], acc, 0, 0, 0);
        if (act) *(f32x4*)(BA + (size_t)(grp * 16 + r) * 16 + 4 * q) = acc;
    }
    __syncthreads();
}
__device__ __forceinline__ void norm_store_row(const f32x4 (&v)[4], const float* __restrict__ gain, const float* __restrict__ shift, const float* __restrict__ scale, bf16* __restrict__ hrow, int lane) {
    float ss = 0.f;
#pragma unroll
    for (int j = 0; j < 4; ++j) ss += (v[j][0] * v[j][0] + v[j][1] * v[j][1]) + (v[j][2] * v[j][2] + v[j][3] * v[j][3]);
    const float rstd = __builtin_amdgcn_rsqf(wave_sum(ss) * (1.0f / 1024.0f) + EPS);
#pragma unroll
    for (int j = 0; j < 4; ++j) { const int c = 4 * lane + 256 * j;
        const f32x4 g = *(const f32x4*)(gain + c), sc = *(const f32x4*)(scale + c), sh = *(const f32x4*)(shift + c);
        const f32x4 h = v[j] * rstd * (g * (1.0f + sc)) + sh;
        v2u w; w.x = pk2(h[0], h[1]); w.y = pk2(h[2], h[3]); *(v2u*)(hrow + c) = w; }
}
__device__ __forceinline__ void phase_norm0(const Args& args, LAS unsigned char* lds) {
    int tid_ = threadIdx.x; asm volatile("" : "+v"(tid_)); const int tid = tid_, lane = tid & 63, wave = __builtin_amdgcn_readfirstlane(tid >> 6), G = gridDim.x, bid = blockIdx.x;
    unsigned char* ws = uni_ptr(args.ws);
    const float* X = args.in[0]; bf16* H = (bf16*)(ws + WS_ACT + A_H); const float* MOD = (const float*)(ws + WS_MOD);
    LAS float* vgs = (LAS float*)lds; LAS float* vsh = vgs + 2048;
    for (int i = tid; i < 2048; i += NTHR) { const int b = i >> 10, k = i & 1023; const float* m = MOD + (size_t)b * 6144; vgs[i] = args.in[2][k] * (1.0f + m[1024 + k]); vsh[i] = m[k]; }
    __syncthreads();
    for (int t = bid * NWAVES + wave; t < T; t += G * NWAVES) { const int b = t / SEQ; f32x4 v[4]; float ss = 0.f;
#pragma unroll
        for (int j = 0; j < 4; ++j) { v[j] = *(const f32x4*)(X + (size_t)t * 1024 + 4 * lane + 256 * j); ss += (v[j][0] * v[j][0] + v[j][1] * v[j][1]) + (v[j][2] * v[j][2] + v[j][3] * v[j][3]); }
        const float rstd = __builtin_amdgcn_rsqf(wave_sum(ss) * (1.0f / 1024.0f) + EPS);
#pragma unroll
        for (int j = 0; j < 4; ++j) { const int c = 4 * lane + 256 * j; const f32x4 gsv = *(const LAS f32x4*)(vgs + b * 1024 + c), shv = *(const LAS f32x4*)(vsh + b * 1024 + c);
            const f32x4 h = v[j] * rstd * gsv + shv; v2u w; w.x = pk2(h[0], h[1]); w.y = pk2(h[2], h[3]); *(v2u*)(H + (size_t)t * 1024 + c) = w; } }
}

__device__ __forceinline__ void phase_gm_spatial(const Args& args, int L, LAS unsigned char* lds) {
    int tid_ = threadIdx.x; asm volatile("" : "+v"(tid_)); const int tid = tid_, lane = tid & 63, wave = __builtin_amdgcn_readfirstlane(tid >> 6), G = gridDim.x, bid = blockIdx.x;
    unsigned char* ws = uni_ptr(args.ws); const int ib = LBASE(L) + 4;
    const float* v_norm = args.in[ib + 1]; const float* w_s = args.in[ib + 2]; const float* b_s = args.in[ib + 3];
    const bf16* U = (const bf16*)(ws + WS_ACT + A_U); const bf16* V = (const bf16*)(ws + WS_ACT + A_V); bf16* GT = (bf16*)(ws + WS_ACT + A_GATED);
    const float* VSSP = (const float*)(ws + WS_VSSP);
    LAS bf16* WL = (LAS bf16*)lds;
    LAS unsigned char* VT = lds + 34816;
    LAS float* rs = (LAS float*)(lds + 67584);
    typedef short s16x4 __attribute__((ext_vector_type(4)));
    const int wr = wave >> 2, wc = wave & 3, fr = lane & 15, fq = lane >> 4;
    const int trw = tid >> 2, sq = (tid & 3) * 32;
    v4u vq[4]; f32x4 wq[8]; float ssq = 0.f;
#define GS_LOAD(u_) do { const int c_ = (u_) >> 3, g_ = (u_) & 7; const unsigned tok0_ = (unsigned)c_ * 128u; \
        _Pragma("unroll") for (int i_ = 0; i_ < 4; ++i_) { const int p_ = tid + 512 * i_, row_ = p_ >> 4, c16_ = p_ & 15; vq[i_] = *(const v4u*)(V + (size_t)(tok0_ + row_) * 1024 + g_ * 128 + c16_ * 8); } \
        const float* wp_ = w_s + ((size_t)g_ * 128 + trw) * 128 + sq; _Pragma("unroll") for (int i_ = 0; i_ < 8; ++i_) wq[i_] = *(const f32x4*)(wp_ + 4 * i_); \
        if (tid < 128) { const float* p_ = VSSP + (size_t)(tok0_ + tid) * 16; float s_ = 0.f; _Pragma("unroll") for (int i_ = 0; i_ < 4; ++i_) { const f32x4 q_ = *(const f32x4*)(p_ + 4 * i_); s_ += (q_[0] + q_[1]) + (q_[2] + q_[3]); } ssq = s_; } } while (0)
    if (bid < 2048) GS_LOAD(bid);
    for (int u = bid; u < 2048; u += G) {
        const int c = u >> 3, g = u & 7; const size_t tok0 = (size_t)c * 128;
        __syncthreads();
        if (tid < 128) rs[tid] = __builtin_amdgcn_rsqf(ssq * (1.0f / 1024.0f) + EPS);
#pragma unroll
        for (int i = 0; i < 4; ++i) { const int p = tid + 512 * i, row = p >> 4, c16 = p & 15; *(LAS v4u*)(VT + row * 256 + (((c16 >> 1) ^ (row & 7)) << 5) + ((c16 & 1) << 4)) = vq[i]; }
        __syncthreads();
#pragma unroll
        for (int i = 0; i < 8; ++i) { float o[4];
#pragma unroll
            for (int e = 0; e < 4; ++e) { const int s = sq + 4 * i + e; o[e] = (s <= trw) ? wq[i][e] * rs[s] : 0.f; }
            v2u w; w.x = pk2(o[0], o[1]); w.y = pk2(o[2], o[3]); *(LAS v2u*)(WL + trw * 136 + sq + 4 * i) = w; }
        __syncthreads();
        if (u + G < 2048) GS_LOAD(u + G);
        f32x4 acc[2][4];
#pragma unroll
        for (int n = 0; n < 2; ++n)
#pragma unroll
            for (int m = 0; m < 4; ++m) acc[n][m] = (f32x4){0.f, 0.f, 0.f, 0.f};
#pragma unroll
        for (int ks = 0; ks < 4; ++ks) {
            if (32 * ks <= 64 * wr + 63) {
                bf16x8 vf[2], wf[4];
#pragma unroll
                for (int n = 0; n < 2; ++n) { const int ct = 2 * wc + n, r0 = 32 * ks + 4 * fq + (fr >> 2), r1 = r0 + 16;
                    const s16x4 lo = __builtin_amdgcn_ds_read_tr16_b64_v4i16((LAS s16x4*)(VT + r0 * 256 + ((ct ^ (r0 & 7)) << 5) + ((fr & 3) << 3)));
                    const s16x4 hi = __builtin_amdgcn_ds_read_tr16_b64_v4i16((LAS s16x4*)(VT + r1 * 256 + ((ct ^ (r1 & 7)) << 5) + ((fr & 3) << 3)));
                    vf[n] = (bf16x8){lo[0], lo[1], lo[2], lo[3], hi[0], hi[1], hi[2], hi[3]}; }
#pragma unroll
                for (int m = 0; m < 4; ++m) { const LAS bf16* wp = WL + (64 * wr + 16 * m + fr) * 136 + 32 * ks + 4 * fq; const v2u lo = *(const LAS v2u*)wp, hi = *(const LAS v2u*)(wp + 16);
                    v4u w; w.x = lo.x; w.y = lo.y; w.z = hi.x; w.w = hi.y; wf[m] = __builtin_bit_cast(bf16x8, w); }
#pragma unroll
                for (int n = 0; n < 2; ++n)
#pragma unroll
                    for (int m = 0; m < 4; ++m) if (32 * ks <= 64 * wr + 16 * m + 15) acc[n][m] = __builtin_amdgcn_mfma_f32_16x16x32_bf16(vf[n], wf[m], acc[n][m], 0, 0, 0);
            } }
#pragma unroll
        for (int m = 0; m < 4; ++m) { const int t = 64 * wr + 16 * m + fr; const float bs = b_s[g * 128 + t];
#pragma unroll
            for (int n = 0; n < 2; ++n) { const int d0 = g * 128 + 32 * wc + 16 * n + 4 * fq; const size_t off = (tok0 + t) * 1024 + d0;
                const v2u uu = *(const v2u*)(U + off); const f32x4 vn = *(const f32x4*)(v_norm + d0);
                const float o0 = bflo(uu.x) * (acc[n][m][0] * vn[0] + bs), o1 = bfhi(uu.x) * (acc[n][m][1] * vn[1] + bs), o2 = bflo(uu.y) * (acc[n][m][2] * vn[2] + bs), o3 = bfhi(uu.y) * (acc[n][m][3] * vn[3] + bs);
                v2u w; w.x = pk2(o0, o1); w.y = pk2(o2, o3); *(v2u*)(GT + off) = w; } }
    }
#undef GS_LOAD
}

__device__ __forceinline__ void phase_swa_attn(const Args& args, LAS unsigned char* lds) {
    int tid_ = threadIdx.x; asm volatile("" : "+v"(tid_)); const int tid = tid_, lane = tid & 63, wave = __builtin_amdgcn_readfirstlane(tid >> 6), G = gridDim.x, bid = blockIdx.x;
    unsigned char* ws = uni_ptr(args.ws);
    const float* q_norm = args.in[34]; const float* k_norm = args.in[35]; const float* sinks = args.in[36];
    const bf16* QKV = (const bf16*)(ws + WS_ACT + A_QKV); bf16* O = (bf16*)(ws + WS_ACT + A_H);
    LAS bf16* KL = (LAS bf16*)lds; LAS unsigned char* VL = lds + 36864; LAS float* nrm = (LAS float*)(lds + 69632);
    if (tid < 64) { nrm[tid] = q_norm[tid]; nrm[64 + tid] = k_norm[tid]; }
    typedef short s16x4 __attribute__((ext_vector_type(4)));
    const int fr = lane & 15, fq = lane >> 4, g = wave >> 1, qh = wave & 1;
    const int kkey = tid >> 1, khalf = tid & 1;
    v4u kq[4], qq[4][2];
#define SW_LOAD(u_) do { const int n_ = (u_) & 127, kvh_ = ((u_) >> 7) & 3, b_ = (u_) >> 9; const unsigned tok0_ = (unsigned)b_ * SEQ + (unsigned)n_ * 128u; \
        { const bool ok_ = (n_ > 0) || (kkey >= 128); const bf16* kp_ = QKV + ((ok_ ? tok0_ - 128u + (unsigned)kkey : tok0_) * 1536u + 1024u + (unsigned)(kvh_ * 64 + khalf * 32)); _Pragma("unroll") for (int i_ = 0; i_ < 4; ++i_) kq[i_] = *(const v4u*)(kp_ + 8 * i_); } \
        } while (0)
#define SW_LOADQ(u_, mt_) do { const int n_ = (u_) & 127, kvh_ = ((u_) >> 7) & 3, b_ = (u_) >> 9; const unsigned tok0_ = (unsigned)b_ * SEQ + (unsigned)n_ * 128u; \
        const bf16* qp_ = QKV + ((tok0_ + (unsigned)(qh * 64 + (mt_) * 16 + fr)) * 1536u + (unsigned)((kvh_ * 4 + g) * 64 + 8 * fq)); qq[mt_][0] = *(const v4u*)qp_; qq[mt_][1] = *(const v4u*)(qp_ + 32); } while (0)
    if (bid < 1024) { SW_LOAD(bid); SW_LOADQ(bid, 0); SW_LOADQ(bid, 1); SW_LOADQ(bid, 2); SW_LOADQ(bid, 3); }
    for (int u = bid; u < 1024; u += G) {
        const int n = u & 127, kvh = (u >> 7) & 3, b = u >> 9; const unsigned tok0 = (unsigned)b * SEQ + (unsigned)n * 128u;
        __syncthreads(); asm volatile("" ::: "memory");
        { float x[32]; float ss = 0.f; const bool ok = (n > 0) || (kkey >= 128);
#pragma unroll
          for (int i = 0; i < 4; ++i) { const unsigned w[4] = {kq[i].x, kq[i].y, kq[i].z, kq[i].w};
#pragma unroll
              for (int e = 0; e < 4; ++e) { x[8 * i + 2 * e] = bflo(w[e]); x[8 * i + 2 * e + 1] = bfhi(w[e]); } }
#pragma unroll
          for (int i = 0; i < 32; ++i) ss += x[i] * x[i];
          ss += __shfl_xor(ss, 1);
          const float rstd = ok ? __builtin_amdgcn_rsqf(ss * (1.0f / 64.0f) + EPS) : 0.f;
#pragma unroll
          for (int i = 0; i < 4; ++i) { float o[8];
#pragma unroll
              for (int e = 0; e < 8; ++e) o[e] = x[8 * i + e] * rstd * nrm[64 + khalf * 32 + 8 * i + e];
              v4u w; w.x = pk2(o[0], o[1]); w.y = pk2(o[2], o[3]); w.z = pk2(o[4], o[5]); w.w = pk2(o[6], o[7]);
              *(LAS v4u*)(KL + kkey * 72 + khalf * 32 + 8 * i) = w; } }
        { v4u vq[4];
#pragma unroll
          for (int i = 0; i < 4; ++i) { const int p = tid + 512 * i, key = p >> 3, c16 = p & 7; const bool ok = (n > 0) || (key >= 128);
              vq[i] = *(const v4u*)(QKV + ((ok ? tok0 - 128u + (unsigned)key : tok0) * 1536u + 1280u + (unsigned)(kvh * 64 + c16 * 8))); if (!ok) vq[i] = (v4u){0u, 0u, 0u, 0u}; }
#pragma unroll
          for (int i = 0; i < 4; ++i) { const int p = tid + 512 * i, key = p >> 3, c16 = p & 7; *(LAS v4u*)(VL + key * 128 + (((c16 >> 1) ^ ((key >> 1) & 3)) << 5) + ((c16 & 1) << 4)) = vq[i]; } }
        __syncthreads();
        if (u + G < 1024) SW_LOAD(u + G);
        const int hq = kvh * 4 + g; const float sink = sinks[hq];
#pragma unroll
        for (int mt = 0; mt < 4; ++mt) {
            asm volatile("" ::: "memory"); __builtin_amdgcn_sched_barrier(0);
            const int qi = qh * 64 + mt * 16 + fr, nb = qh * 4 + mt;
            bf16x8 qf[2];
            { float x[16]; float ss = 0.f;
#pragma unroll
              for (int ks = 0; ks < 2; ++ks) { const unsigned w[4] = {qq[mt][ks].x, qq[mt][ks].y, qq[mt][ks].z, qq[mt][ks].w};
#pragma unroll
                  for (int e = 0; e < 4; ++e) { x[8 * ks + 2 * e] = bflo(w[e]); x[8 * ks + 2 * e + 1] = bfhi(w[e]); } }
#pragma unroll
              for (int i = 0; i < 16; ++i) ss += x[i] * x[i];
              ss += __shfl_xor(ss, 16); ss += __shfl_xor(ss, 32);
              const float rstd = __builtin_amdgcn_rsqf(ss * (1.0f / 64.0f) + EPS) * 0.125f;
#pragma unroll
              for (int ks = 0; ks < 2; ++ks) { float o[8];
#pragma unroll
                  for (int e = 0; e < 8; ++e) o[e] = x[8 * ks + e] * rstd * nrm[32 * ks + 8 * fq + e];
                  v4u w; w.x = pk2(o[0], o[1]); w.y = pk2(o[2], o[3]); w.z = pk2(o[4], o[5]); w.w = pk2(o[6], o[7]); qf[ks] = __builtin_bit_cast(bf16x8, w); } }
            if (u + G < 1024) SW_LOADQ(u + G, mt);
            f32x4 s[10]; float mx = -INFINITY;
#pragma unroll
            for (int i = 0; i < 9; ++i) { const int nt = nb + i; f32x4 a = {0.f, 0.f, 0.f, 0.f};
#pragma unroll
                for (int ks = 0; ks < 2; ++ks) { const bf16x8 kf = *(const LAS bf16x8*)(KL + (16 * nt + fr) * 72 + 32 * ks + 8 * fq); a = __builtin_amdgcn_mfma_f32_16x16x32_bf16(kf, qf[ks], a, 0, 0, 0); }
#pragma unroll
                for (int r = 0; r < 4; ++r) { const int kj = 16 * nt + 4 * fq + r; const bool valid = (kj > qi) && (kj <= qi + 128) && ((n > 0) || (kj >= 128)); a[r] = valid ? a[r] : -INFINITY; mx = fmaxf(mx, a[r]); }
                s[i] = a; }
            mx = fmaxf(mx, __shfl_xor(mx, 16)); mx = fmaxf(mx, __shfl_xor(mx, 32)); mx = fmaxf(mx, sink);
            float l = 0.f;
#pragma unroll
            for (int i = 0; i < 9; ++i)
#pragma unroll
                for (int r = 0; r < 4; ++r) { const float p = fast_exp(s[i][r] - mx); s[i][r] = p; l += p; }
            s[9] = (f32x4){0.f, 0.f, 0.f, 0.f};
            l += __shfl_xor(l, 16); l += __shfl_xor(l, 32); l += fast_exp(sink - mx);
            f32x4 o[4];
#pragma unroll
            for (int dt = 0; dt < 4; ++dt) o[dt] = (f32x4){0.f, 0.f, 0.f, 0.f};
#pragma unroll
            for (int st = 0; st < 5; ++st) {
                v4u pw; pw.x = pk2(s[2 * st][0], s[2 * st][1]); pw.y = pk2(s[2 * st][2], s[2 * st][3]); pw.z = pk2(s[2 * st + 1][0], s[2 * st + 1][1]); pw.w = pk2(s[2 * st + 1][2], s[2 * st + 1][3]);
                const bf16x8 pf = __builtin_bit_cast(bf16x8, pw);
                const int k0 = 16 * (nb + 2 * st) + 4 * fq + (fr >> 2); const int k1r = k0 + 16, k1 = k1r > 255 ? 255 : k1r;
#pragma unroll
                for (int dt = 0; dt < 4; ++dt) {
                    const s16x4 lo = __builtin_amdgcn_ds_read_tr16_b64_v4i16((LAS s16x4*)(VL + k0 * 128 + ((dt ^ ((k0 >> 1) & 3)) << 5) + ((fr & 3) << 3)));
                    const s16x4 hi = __builtin_amdgcn_ds_read_tr16_b64_v4i16((LAS s16x4*)(VL + k1 * 128 + ((dt ^ ((k1 >> 1) & 3)) << 5) + ((fr & 3) << 3)));
                    const bf16x8 vf = (bf16x8){lo[0], lo[1], lo[2], lo[3], hi[0], hi[1], hi[2], hi[3]};
                    o[dt] = __builtin_amdgcn_mfma_f32_16x16x32_bf16(vf, pf, o[dt], 0, 0, 0); } }
            const float inv = 1.0f / l;
#pragma unroll
            for (int dt = 0; dt < 4; ++dt) { v2u w; w.x = pk2(o[dt][0] * inv, o[dt][1] * inv); w.y = pk2(o[dt][2] * inv, o[dt][3] * inv);
                *(v2u*)(O + ((tok0 + (unsigned)qi) * 1024u + (unsigned)(hq * 64 + 16 * dt + 4 * fq))) = w; }
            __builtin_amdgcn_sched_barrier(0);
        }
    }
#undef SW_LOAD
#undef SW_LOADQ
}

__device__ __forceinline__ void phase_dn_prep(const Args& args, LAS unsigned char* lds) {
    int tid_ = threadIdx.x; asm volatile("" : "+v"(tid_)); const int tid = tid_, lane = tid & 63, wave = __builtin_amdgcn_readfirstlane(tid >> 6), G = gridDim.x, bid = blockIdx.x;
    unsigned char* ws = uni_ptr(args.ws); const float* conv_w = args.in[20]; const float* a_log = args.in[21]; const float* dt_bias = args.in[22];
    const bf16* QKV = (const bf16*)(ws + WS_ACT + A_QKV); bf16* QN = (bf16*)(ws + WS_ACT + A_QN); bf16* KN = (bf16*)(ws + WS_ACT + A_KN); bf16* VV = (bf16*)(ws + WS_ACT + A_VV);
    const float* BA = (const float*)(ws + WS_BA); float* DNB = (float*)(ws + WS_DNB);
    constexpr int RUN = 16;
    LAS float* cwl = (LAS float*)lds;
    for (int i = tid; i < 2048; i += NTHR) *(LAS f32x4*)(cwl + 4 * i) = *(const f32x4*)(conv_w + 4 * i);
    __syncthreads();
    const float alg = lane < 8 ? -expf(a_log[lane]) : 0.f, dtb = lane < 8 ? dt_bias[lane] : 0.f;
    for (int run = bid * NWAVES + wave; run < T / RUN; run += G * NWAVES) {
        const int tbeg = run * RUN, pos0 = tbeg % SEQ;
        v4u rows[3][4];
#pragma unroll
        for (int d = 0; d < 3; ++d)
#pragma unroll
            for (int j = 0; j < 4; ++j) rows[d][j] = (pos0 - 3 + d >= 0) ? *(const v4u*)(QKV + (size_t)(tbeg - 3 + d) * 2048 + 8 * lane + 512 * j) : (v4u){0u, 0u, 0u, 0u};
#pragma unroll 1
        for (int i = 0; i < RUN; ++i) { const int t = tbeg + i;
            v4u cur[4];
#pragma unroll
            for (int j = 0; j < 4; ++j) cur[j] = *(const v4u*)(QKV + (size_t)t * 2048 + 8 * lane + 512 * j);
            float bi = 0.f, ai = 0.f; if (lane < 8) { bi = BA[(size_t)t * 16 + lane]; ai = BA[(size_t)t * 16 + 8 + lane] + dtb; }
#pragma unroll
            for (int j = 0; j < 4; ++j) { float a[8];
#pragma unroll
                for (int e = 0; e < 8; ++e) a[e] = 0.f;
#pragma unroll
                for (int tap = 0; tap < 4; ++tap) { const v4u q = tap < 3 ? rows[tap][j] : cur[j]; const f32x4 w0 = *(const LAS f32x4*)(cwl + tap * 2048 + 8 * lane + 512 * j), w1 = *(const LAS f32x4*)(cwl + tap * 2048 + 8 * lane + 512 * j + 4);
                    a[0] += w0[0] * bflo(q.x); a[1] += w0[1] * bfhi(q.x); a[2] += w0[2] * bflo(q.y); a[3] += w0[3] * bfhi(q.y); a[4] += w1[0] * bflo(q.z); a[5] += w1[1] * bfhi(q.z); a[6] += w1[2] * bflo(q.w); a[7] += w1[3] * bfhi(q.w); }
                float ss = 0.f;
#pragma unroll
                for (int e = 0; e < 8; ++e) { a[e] = siluf_(a[e]); ss += a[e] * a[e]; }
                if (j < 2) { ss += __shfl_xor(ss, 1); ss += __shfl_xor(ss, 2); ss += __shfl_xor(ss, 4); ss += __shfl_xor(ss, 8);
                    const float r = __builtin_amdgcn_rsqf(ss + EPS); bf16* dst = (j == 0 ? QN : KN) + (size_t)t * 512 + 8 * lane;
                    v4u w; w.x = pk2(a[0] * r, a[1] * r); w.y = pk2(a[2] * r, a[3] * r); w.z = pk2(a[4] * r, a[5] * r); w.w = pk2(a[6] * r, a[7] * r); *(v4u*)dst = w; }
                else { v4u w; w.x = pk2(a[0], a[1]); w.y = pk2(a[2], a[3]); w.z = pk2(a[4], a[5]); w.w = pk2(a[6], a[7]); *(v4u*)(VV + (size_t)t * 1024 + 8 * lane + 512 * (j - 2)) = w; } }
            if (lane < 8) { const float sp = fmaxf(ai, 0.f) + log1pf(expf(-fabsf(ai)));
                DNB[(size_t)t * 16 + lane] = 1.0f / (1.0f + expf(-bi)); DNB[(size_t)t * 16 + 8 + lane] = alg * sp; }
#pragma unroll
            for (int j = 0; j < 4; ++j) { rows[0][j] = rows[1][j]; rows[1][j] = rows[2][j]; rows[2][j] = cur[j]; }
        }
    }
}
constexpr int FA_STRIDE = 25600, FB_STRIDE = 32768, FU_STRIDE = 16384;
constexpr float DN_SCALE = 0.08838834764831845f;
__device__ __forceinline__ void phase_dn_chunk(const Args& args, LAS unsigned char* lds) {
    int tid_ = threadIdx.x; asm volatile("" : "+v"(tid_)); const int tid = tid_, lane = tid & 63, wave = __builtin_amdgcn_readfirstlane(tid >> 6), G = gridDim.x, bid = blockIdx.x;
    unsigned char* ws = uni_ptr(args.ws);
    const bf16* QN = (const bf16*)(ws + WS_ACT + A_QN); const bf16* KN = (const bf16*)(ws + WS_ACT + A_KN); const bf16* VV = (const bf16*)(ws + WS_ACT + A_VV);
    const float* DNB = (const float*)(ws + WS_DNB);
    unsigned char* FA = ws + WS_ACT + A_FA; unsigned char* FB = ws + WS_ACT + A_FB; unsigned char* FU = ws + WS_ACT + A_FU;
    LAS float* Al = (LAS float*)(lds + wave * 16384);
    LAS float* tb = (LAS float*)(lds + LDSCTL_OFF + 2048 + wave * 512);
    const int fr = lane & 15, fq = lane >> 4;
    for (int it = bid * NWAVES + wave; it < 4096; it += G * NWAVES) {
        const int b = it >> 11, hv = (it >> 8) & 7, n = it & 255, hq = hv >> 1; const unsigned t0 = (unsigned)b * SEQ + (unsigned)n * 64; const int itq = (b * 4 + hq) * 256 + n;
        unsigned char* fa = FA + (size_t)it * FA_STRIDE; unsigned char* fb = FB + (size_t)itq * FB_STRIDE;
        const float bv = DNB[(t0 + lane) * 16 + hv]; float gcv = DNB[(t0 + lane) * 16 + 8 + hv];
#pragma unroll
        for (int o = 1; o < 64; o <<= 1) { const float t = __shfl_up(gcv, o); if (lane >= o) gcv += t; }
        const float gll = __shfl(gcv, 63);
        tb[lane] = gcv; tb[64 + lane] = bv;
        { float* fe = (float*)(fa + 24576); fe[lane] = DN_SCALE * expf(gcv); fe[64 + lane] = expf(gll - gcv); fe[128 + lane] = expf(gll); }
        asm volatile("" ::: "memory");
        bf16x8 kf[4][4];
#pragma unroll
        for (int t = 0; t < 4; ++t)
#pragma unroll
            for (int ks = 0; ks < 4; ++ks) kf[t][ks] = *(const bf16x8*)(KN + (t0 + 16 * t + fr) * 512 + hq * 128 + 32 * ks + 8 * fq);
#pragma unroll
        for (int m = 0; m < 4; ++m) { const int c = 16 * m + fr; const float bm = tb[64 + c], gm = tb[c];
            bf16x8 qf[4];
#pragma unroll
            for (int ks = 0; ks < 4; ++ks) qf[ks] = *(const bf16x8*)(QN + (t0 + c) * 512 + hq * 128 + 32 * ks + 8 * fq);
            f32x4 tl[4];
#pragma unroll
            for (int t = 0; t < 4; ++t) {
                if (t <= m) { f32x4 ak = {0.f, 0.f, 0.f, 0.f}, aq = {0.f, 0.f, 0.f, 0.f};
#pragma unroll
                    for (int ks = 0; ks < 4; ++ks) { ak = __builtin_amdgcn_mfma_f32_16x16x32_bf16(kf[t][ks], kf[m][ks], ak, 0, 0, 0); aq = __builtin_amdgcn_mfma_f32_16x16x32_bf16(kf[t][ks], qf[ks], aq, 0, 0, 0); }
                    const f32x4 gs4 = *(const LAS f32x4*)(tb + 16 * t + 4 * fq); f32x4 av;
#pragma unroll
                    for (int r = 0; r < 4; ++r) { const int s = 16 * t + 4 * fq + r; const float dec = fast_exp(fminf(gm - gs4[r], 0.f)); av[r] = (s < c) ? bm * ak[r] * dec : 0.f; tl[t][r] = (s <= c) ? DN_SCALE * aq[r] * dec : 0.f; }
                    *(LAS f32x4*)(Al + c * 64 + 16 * t + 4 * fq) = av; }
                else tl[t] = (f32x4){0.f, 0.f, 0.f, 0.f}; }
#pragma unroll
            for (int k2 = 0; k2 < 2; ++k2) { v4u w; w.x = pk2(tl[2 * k2][0], tl[2 * k2][1]); w.y = pk2(tl[2 * k2][2], tl[2 * k2][3]); w.z = pk2(tl[2 * k2 + 1][0], tl[2 * k2 + 1][1]); w.w = pk2(tl[2 * k2 + 1][2], tl[2 * k2 + 1][3]);
                *(v4u*)(fa + 16384 + (m * 2 + k2) * 1024 + lane * 16) = w; } }
        asm volatile("s_waitcnt lgkmcnt(0)" ::: "memory");
        float Tc[64];
#pragma unroll
        for (int m = 0; m < 64; ++m) Tc[m] = (m == lane) ? 1.f : 0.f;
#pragma unroll
        for (int r = 1; r < 64; ++r) { float acc = 0.f;
#pragma unroll
            for (int m4 = 0; m4 < (r + 3) / 4; ++m4) { const f32x4 a4 = *(const LAS f32x4*)(Al + r * 64 + 4 * m4);
#pragma unroll
                for (int e = 0; e < 4; ++e) if (4 * m4 + e < r) acc += a4[e] * Tc[4 * m4 + e]; }
            Tc[r] -= acc; if ((r & 3) == 3) __builtin_amdgcn_sched_barrier(0); }
        asm volatile("s_waitcnt lgkmcnt(0)" ::: "memory");
        LAS bf16* T1l = (LAS bf16*)Al; LAS bf16* T2l = T1l + 4096;
        { const float c1 = bv, c2 = bv * expf(gcv);
#pragma unroll
          for (int i = 0; i < 64; ++i) { T1l[i * 64 + lane] = (bf16)(pk2(Tc[i] * c1, 0.f) & 0xffffu); T2l[i * 64 + lane] = (bf16)(pk2(Tc[i] * c2, 0.f) & 0xffffu); } }
        asm volatile("s_waitcnt lgkmcnt(0)" ::: "memory");
        bf16x8 t1f[4][2], t2f[4][2];
#pragma unroll
        for (int m = 0; m < 4; ++m)
#pragma unroll
            for (int k2 = 0; k2 < 2; ++k2) { const int o = (16 * m + fr) * 64 + 32 * k2 + 4 * fq;
                { const v2u lo = *(const LAS v2u*)(T1l + o), hi = *(const LAS v2u*)(T1l + o + 16); v4u w; w.x = lo.x; w.y = lo.y; w.z = hi.x; w.w = hi.y; t1f[m][k2] = __builtin_bit_cast(bf16x8, w); }
                { const v2u lo = *(const LAS v2u*)(T2l + o), hi = *(const LAS v2u*)(T2l + o + 16); v4u w; w.x = lo.x; w.y = lo.y; w.z = hi.x; w.w = hi.y; t2f[m][k2] = __builtin_bit_cast(bf16x8, w); } }
        asm volatile("s_waitcnt lgkmcnt(0)" ::: "memory");
        LAS unsigned char* tile = (LAS unsigned char*)Al;
        typedef short s16x4 __attribute__((ext_vector_type(4)));
#define DN_STAGE_TILE(src, pitch, coff) do { _Pragma("unroll") for (int hb_ = 0; hb_ < 2; ++hb_) { v4u pv[8]; _Pragma("unroll") for (int it_ = 0; it_ < 8; ++it_) { const int p_ = lane + 64 * (it_ + 8 * hb_), row_ = p_ >> 4, c16_ = p_ & 15; pv[it_] = *(const v4u*)((src) + (t0 + row_) * (pitch) + (coff) + c16_ * 8); } \
            _Pragma("unroll") for (int it_ = 0; it_ < 8; ++it_) { const int p_ = lane + 64 * (it_ + 8 * hb_), row_ = p_ >> 4, c16_ = p_ & 15; *(LAS v4u*)(tile + row_ * 256 + (((c16_ >> 1) ^ (row_ & 7)) << 5) + ((c16_ & 1) << 4)) = pv[it_]; } } } while (0)
#define DN_TR_FRAG(dst, ct, k2) do { const int r0_ = 32 * (k2) + 4 * fq + (fr >> 2), r1_ = r0_ + 16; \
            const s16x4 lo_ = __builtin_amdgcn_ds_read_tr16_b64_v4i16((LAS s16x4*)(tile + r0_ * 256 + ((((ct)) ^ (r0_ & 7)) << 5) + ((fr & 3) << 3))); \
            const s16x4 hi_ = __builtin_amdgcn_ds_read_tr16_b64_v4i16((LAS s16x4*)(tile + r1_ * 256 + ((((ct)) ^ (r1_ & 7)) << 5) + ((fr & 3) << 3))); \
            dst = (bf16x8){lo_[0], lo_[1], lo_[2], lo_[3], hi_[0], hi_[1], hi_[2], hi_[3]}; } while (0)
        DN_STAGE_TILE(VV, 1024, hv * 128);
        asm volatile("s_waitcnt lgkmcnt(0)" ::: "memory");
#pragma unroll 1
        for (int j = 0; j < 8; ++j) { bf16x8 vf[2];
            DN_TR_FRAG(vf[0], j, 0); DN_TR_FRAG(vf[1], j, 1);
#pragma unroll
            for (int m = 0; m < 4; ++m) { f32x4 a = {0.f, 0.f, 0.f, 0.f};
#pragma unroll
                for (int k2 = 0; k2 < 2; ++k2) a = __builtin_amdgcn_mfma_f32_16x16x32_bf16(t1f[m][k2], vf[k2], a, 0, 0, 0);
                v2u w; w.x = pk2(a[0], a[1]); w.y = pk2(a[2], a[3]); *(v2u*)(FU + (size_t)it * FU_STRIDE + ((j * 4 + m) * 64 + lane) * 8) = w; } }
        asm volatile("s_waitcnt lgkmcnt(0)" ::: "memory");
        DN_STAGE_TILE(KN, 512, hq * 128);
        asm volatile("s_waitcnt lgkmcnt(0)" ::: "memory");
        if ((hv & 1) == 0) { int fr2 = fr, fq2 = fq; asm volatile("" : "+v"(fr2), "+v"(fq2));
#pragma unroll
            for (int m = 0; m < 4; ++m)
#pragma unroll
                for (int ks = 0; ks < 4; ++ks) { const bf16* qp = QN + (t0 + 16 * m + fr2) * 512 + hq * 128 + 32 * ks + 4 * fq2; const v2u lo = *(const v2u*)qp, hi = *(const v2u*)(qp + 16);
                    v4u w; w.x = lo.x; w.y = lo.y; w.z = hi.x; w.w = hi.y; *(v4u*)(fb + (m * 4 + ks) * 1024 + lane * 16) = w; } }
#pragma unroll 1
        for (int dh = 0; dh < 2; ++dh) { bf16x8 ktf[4][2];
#pragma unroll
            for (int d4 = 0; d4 < 4; ++d4) { DN_TR_FRAG(ktf[d4][0], 4 * dh + d4, 0); DN_TR_FRAG(ktf[d4][1], 4 * dh + d4, 1); }
            if ((hv & 1) == 0) {
#pragma unroll
                for (int d4 = 0; d4 < 4; ++d4)
#pragma unroll
                    for (int k2 = 0; k2 < 2; ++k2) *(bf16x8*)(fb + 16384 + ((4 * dh + d4) * 2 + k2) * 1024 + lane * 16) = ktf[d4][k2]; }
#pragma unroll
            for (int m = 0; m < 4; ++m) { f32x4 acc[4];
#pragma unroll
                for (int d4 = 0; d4 < 4; ++d4) { acc[d4] = (f32x4){0.f, 0.f, 0.f, 0.f};
#pragma unroll
                    for (int k2 = 0; k2 < 2; ++k2) acc[d4] = __builtin_amdgcn_mfma_f32_16x16x32_bf16(ktf[d4][k2], t2f[m][k2], acc[d4], 0, 0, 0); }
#pragma unroll
                for (int kk = 0; kk < 2; ++kk) { v4u w; w.x = pk2(-acc[2 * kk][0], -acc[2 * kk][1]); w.y = pk2(-acc[2 * kk][2], -acc[2 * kk][3]); w.z = pk2(-acc[2 * kk + 1][0], -acc[2 * kk + 1][1]); w.w = pk2(-acc[2 * kk + 1][2], -acc[2 * kk + 1][3]);
                    *(v4u*)(fa + (m * 4 + 2 * dh + kk) * 1024 + lane * 16) = w; } } }
        asm volatile("s_waitcnt lgkmcnt(0)" ::: "memory");
#undef DN_STAGE_TILE
#undef DN_TR_FRAG
    }
}
__device__ __forceinline__ void phase_dn_scan(const Args& args, LAS unsigned char* lds) {
    int tid_ = threadIdx.x; asm volatile("" : "+v"(tid_)); const int tid = tid_, lane = tid & 63, wave = __builtin_amdgcn_readfirstlane(tid >> 6), G = gridDim.x, bid = blockIdx.x;
    if (bid >= 128) {
        const int gw = (bid - 128) * NWAVES + wave, NGW = (G - 128) * NWAVES;
        convert_weights(args, lds, CV_SPLIT, CV_N_EXP, gw, NGW); convert_weights(args, lds, CV_N_EXP + CV_MIX_L01, CV_N_EXP + CV_N_MIXI, gw, NGW); return; }
    unsigned char* ws = uni_ptr(args.ws);
    const unsigned char* FA = ws + WS_ACT + A_FA; const unsigned char* FB = ws + WS_ACT + A_FB; const unsigned char* FU = ws + WS_ACT + A_FU;
    unsigned char* SFR = ws + WS_ACT + A_SFR; unsigned char* VFR = ws + WS_ACT + A_VFR;
    const int fq = lane >> 4;
    constexpr int SLOT = 35840, O_TB = 16384, O_KT = 17408, O_U = 33792;
#define SB() __builtin_amdgcn_sched_barrier(0)
#define WGBAR() do { asm volatile("" ::: "memory"); __builtin_amdgcn_s_barrier(); asm volatile("" ::: "memory"); } while (0)
#define DN_AUX 0
#define DMA4(g, l) do { __builtin_amdgcn_global_load_lds((g), (l), 16, 0, DN_AUX); __builtin_amdgcn_global_load_lds((g), (l), 16, 1024, DN_AUX); __builtin_amdgcn_global_load_lds((g), (l), 16, 2048, DN_AUX); __builtin_amdgcn_global_load_lds((g), (l), 16, 3072, DN_AUX); } while (0)
    for (int sidx = bid; sidx < 128; sidx += G) {
        const int bh = (sidx & 7) * 2 + (sidx >> 6), j = (sidx >> 3) & 7, b = bh >> 3, hv = bh & 7, hq = hv >> 1;
        const int it0 = bh * 256, itq0 = (b * 4 + hq) * 256;
#define VMW(n_) asm volatile("s_waitcnt vmcnt(" #n_ ")" ::: "memory")
        if (wave == 1 || wave == 4 || wave == 6 || wave == 7) {
            const int qa = wave == 1 ? 0 : (wave == 4 ? 1 : (wave == 6 ? 2 : 3));
#define DN_ISSUE_A(nn) do { LAS unsigned char* sl_ = lds + ((nn) % 3) * SLOT; const unsigned char* fa_ = FA + (size_t)(it0 + (nn)) * FA_STRIDE + lane * 16; \
                DMA4((const unsigned*)(fa_ + qa * 4096), (LAS unsigned*)(sl_ + qa * 4096)); \
                if (wave == 1) __builtin_amdgcn_global_load_lds((const unsigned*)(fa_ + 24576), (LAS unsigned*)(sl_ + O_TB), 16, 0, DN_AUX); \
                if (wave == 4) { const unsigned char* fu_ = FU + (size_t)(it0 + (nn)) * FU_STRIDE + j * 2048 + lane * 16; \
                    __builtin_amdgcn_global_load_lds((const unsigned*)(fu_), (LAS unsigned*)(sl_ + O_U), 16, 0, DN_AUX); __builtin_amdgcn_global_load_lds((const unsigned*)(fu_), (LAS unsigned*)(sl_ + O_U), 16, 1024, DN_AUX); } } while (0)
#define DN_WAIT_A(k) do { if ((k) == 0) VMW(0); else if (wave == 1) { if ((k) == 2) VMW(10); else VMW(5); } else if (wave == 4) { if ((k) == 2) VMW(12); else VMW(6); } else { if ((k) == 2) VMW(8); else VMW(4); } } while (0)
            DN_ISSUE_A(0); DN_ISSUE_A(1); DN_ISSUE_A(2);
            DN_WAIT_A(2);
#pragma unroll 1
            for (int n = 0; n < 256; ++n) {
                WGBAR();
                WGBAR();
                if (n + 3 < 256) { DN_ISSUE_A(n + 3); DN_WAIT_A(2); }
                else if (n + 2 < 256) DN_WAIT_A(1);
                else DN_WAIT_A(0);
            }
#undef DN_ISSUE_A
#undef DN_WAIT_A
        } else if (wave == 2 || wave == 3 || wave == 5) {
            const int p0 = wave == 2 ? 0 : (wave == 3 ? 6 : 11);
#define DN_ISSUE_B(nn) do { LAS unsigned char* sl_ = lds + ((nn) % 3) * SLOT + O_KT + p0 * 1024; const unsigned char* fb_ = FB + (size_t)(itq0 + (nn)) * FB_STRIDE + 16384 + p0 * 1024 + lane * 16; \
                DMA4((const unsigned*)(fb_), (LAS unsigned*)(sl_)); __builtin_amdgcn_global_load_lds((const unsigned*)(fb_ + 4096), (LAS unsigned*)(sl_ + 4096), 16, 0, DN_AUX); \
                if (wave == 2) __builtin_amdgcn_global_load_lds((const unsigned*)(fb_ + 4096), (LAS unsigned*)(sl_ + 4096), 16, 1024, DN_AUX); } while (0)
#define DN_WAIT_B(k) do { if ((k) == 0) VMW(0); else if (wave == 2) { if ((k) == 2) VMW(12); else VMW(6); } else { if ((k) == 2) VMW(10); else VMW(5); } } while (0)
            DN_ISSUE_B(0); DN_ISSUE_B(1);
#pragma unroll 1
            for (int n = 0; n < 256; ++n) {
                WGBAR();
                if (n + 2 < 256) { DN_ISSUE_B(n + 2); DN_WAIT_B(2); }
                else if (n + 1 < 256) DN_WAIT_B(1);
                else DN_WAIT_B(0);
                WGBAR();
            }
#undef DN_ISSUE_B
#undef DN_WAIT_B
        } else {
        f32x4 S[8];
#pragma unroll
        for (int dt = 0; dt < 8; ++dt) S[dt] = (f32x4){0.f, 0.f, 0.f, 0.f};
        bf16x8 sf[4];
#pragma unroll
        for (int ks = 0; ks < 4; ++ks) sf[ks] = (bf16x8){0, 0, 0, 0, 0, 0, 0, 0};
        int slot = 0;
#pragma unroll 1
        for (int n = 0; n < 256; ++n) {
            WGBAR();
            const LAS unsigned char* sbase = lds + slot * SLOT; const LAS unsigned char* base = sbase + lane * 16;
            unsigned char* sfo = SFR + ((size_t)(it0 + n) * 8 + j) * 4096 + lane * 16; unsigned char* vfo = VFR + ((size_t)(it0 + n) * 8 + j) * 2048 + lane * 16;
#pragma unroll
            for (int ks = 0; ks < 4; ++ks) *(bf16x8*)(sfo + ks * 1024) = sf[ks];
            const LAS float* tbl = (const LAS float*)(sbase + O_TB);
            f32x4 ekd[4], av[4];
#pragma unroll
            for (int m = 0; m < 4; ++m) { ekd[m] = *(const LAS f32x4*)(tbl + 64 + 16 * m + 4 * fq);
                const v2u u2 = *(const LAS v2u*)(sbase + O_U + (m * 64 + lane) * 8); av[m] = (f32x4){bflo(u2.x), bfhi(u2.x), bflo(u2.y), bfhi(u2.y)}; }
            const float gl = tbl[128 + lane];
            SB();
            bf16x8 Aw[16];
#pragma unroll
            for (int f = 0; f < 16; ++f) Aw[f] = *(const LAS bf16x8*)(base + f * 1024);
            SB();
#pragma unroll
            for (int ks = 0; ks < 4; ++ks) {
#pragma unroll
                for (int m = 0; m < 4; ++m) av[m] = __builtin_amdgcn_mfma_f32_16x16x32_bf16(Aw[m * 4 + ks], sf[ks], av[m], 0, 0, 0);
                SB(); }
            asm volatile("s_waitcnt lgkmcnt(0)" ::: "memory");
            WGBAR();
            bf16x8 Ck[16];
#pragma unroll
            for (int f = 0; f < 16; ++f) Ck[f] = *(const LAS bf16x8*)(base + O_KT + f * 1024);
#pragma unroll
            for (int dt = 0; dt < 8; ++dt) S[dt] = S[dt] * gl;
            bf16x8 vf[2], vpf[2];
#pragma unroll
            for (int k2 = 0; k2 < 2; ++k2) { v4u w; w.x = pk2(av[2 * k2][0], av[2 * k2][1]); w.y = pk2(av[2 * k2][2], av[2 * k2][3]); w.z = pk2(av[2 * k2 + 1][0], av[2 * k2 + 1][1]); w.w = pk2(av[2 * k2 + 1][2], av[2 * k2 + 1][3]); vf[k2] = __builtin_bit_cast(bf16x8, w);
                const f32x4 p0 = av[2 * k2] * ekd[2 * k2], p1 = av[2 * k2 + 1] * ekd[2 * k2 + 1];
                v4u x; x.x = pk2(p0[0], p0[1]); x.y = pk2(p0[2], p0[3]); x.z = pk2(p1[0], p1[1]); x.w = pk2(p1[2], p1[3]); vpf[k2] = __builtin_bit_cast(bf16x8, x); }
#pragma unroll
            for (int k2 = 0; k2 < 2; ++k2) *(bf16x8*)(vfo + k2 * 1024) = vf[k2];
            SB();
#pragma unroll
            for (int k2 = 0; k2 < 2; ++k2)
#pragma unroll
                for (int dt = 0; dt < 8; ++dt) S[dt] = __builtin_amdgcn_mfma_f32_16x16x32_bf16(Ck[dt * 2 + k2], vpf[k2], S[dt], 0, 0, 0);
            SB();
#pragma unroll
            for (int ks = 0; ks < 4; ++ks) { v4u w; w.x = pk2(S[2 * ks][0], S[2 * ks][1]); w.y = pk2(S[2 * ks][2], S[2 * ks][3]); w.z = pk2(S[2 * ks + 1][0], S[2 * ks + 1][1]); w.w = pk2(S[2 * ks + 1][2], S[2 * ks + 1][3]); sf[ks] = __builtin_bit_cast(bf16x8, w); }
            asm volatile("s_waitcnt lgkmcnt(0)" ::: "memory");
            slot = (slot == 2) ? 0 : slot + 1;
        }
        }
        __syncthreads();
    }
#undef SB
#undef DMA4
#undef WGBAR
#undef DN_AUX
#undef VMW
}
__device__ __forceinline__ void phase_dn_out(const Args& args, LAS unsigned char* lds) {
    int tid_ = threadIdx.x; asm volatile("" : "+v"(tid_)); const int tid = tid_, lane = tid & 63, wave = __builtin_amdgcn_readfirstlane(tid >> 6), G = gridDim.x, bid = blockIdx.x; (void)tid;
    unsigned char* ws = uni_ptr(args.ws); const float* o_norm = args.in[23];
    const bf16* QN = (const bf16*)(ws + WS_ACT + A_QN); const unsigned char* FA = ws + WS_ACT + A_FA; const unsigned char* SFR = ws + WS_ACT + A_SFR; const unsigned char* VFR = ws + WS_ACT + A_VFR;
    const bf16* Z = (const bf16*)(ws + WS_ACT + A_Z); bf16* GT = (bf16*)(ws + WS_ACT + A_H);
    LAS bf16* ot = (LAS bf16*)(lds + wave * 16384);
    const int fr = lane & 15, fq = lane >> 4;
    float on[8];
#pragma unroll
    for (int e = 0; e < 8; ++e) on[e] = o_norm[8 * fr + e];
    for (int it = bid * NWAVES + wave; it < 4096; it += G * NWAVES) {
        const int b = it >> 11, hv = (it >> 8) & 7, n = it & 255, hq = hv >> 1; const unsigned t0 = (unsigned)b * SEQ + (unsigned)n * 64;
        const unsigned char* fa = FA + (size_t)it * FA_STRIDE;
        bf16x8 qf[4][4], qk[4][2]; f32x4 egc[4];
#pragma unroll
        for (int m = 0; m < 4; ++m) {
#pragma unroll
            for (int ks = 0; ks < 4; ++ks) { const bf16* qp = QN + (t0 + 16 * m + fr) * 512 + hq * 128 + 32 * ks + 4 * fq; const v2u lo = *(const v2u*)qp, hi = *(const v2u*)(qp + 16); v4u w; w.x = lo.x; w.y = lo.y; w.z = hi.x; w.w = hi.y; qf[m][ks] = __builtin_bit_cast(bf16x8, w); }
#pragma unroll
            for (int k2 = 0; k2 < 2; ++k2) qk[m][k2] = *(const bf16x8*)(fa + 16384 + (m * 2 + k2) * 1024 + lane * 16);
            egc[m] = *(const f32x4*)((const float*)(fa + 24576) + 16 * m + 4 * fq); }
#pragma unroll 1
        for (int j = 0; j < 8; ++j) {
            bf16x8 sf[4], vf[2];
#pragma unroll
            for (int ks = 0; ks < 4; ++ks) sf[ks] = *(const bf16x8*)(SFR + ((size_t)it * 8 + j) * 4096 + ks * 1024 + lane * 16);
#pragma unroll
            for (int k2 = 0; k2 < 2; ++k2) vf[k2] = *(const bf16x8*)(VFR + ((size_t)it * 8 + j) * 2048 + k2 * 1024 + lane * 16);
            f32x4 ao[4];
#pragma unroll
            for (int m = 0; m < 4; ++m) { ao[m] = (f32x4){0.f, 0.f, 0.f, 0.f};
#pragma unroll
                for (int ks = 0; ks < 4; ++ks) ao[m] = __builtin_amdgcn_mfma_f32_16x16x32_bf16(qf[m][ks], sf[ks], ao[m], 0, 0, 0);
                ao[m] = ao[m] * egc[m];
#pragma unroll
                for (int k2 = 0; k2 < 2; ++k2) ao[m] = __builtin_amdgcn_mfma_f32_16x16x32_bf16(qk[m][k2], vf[k2], ao[m], 0, 0, 0); }
#pragma unroll
            for (int m = 0; m < 4; ++m)
#pragma unroll
                for (int r = 0; r < 4; ++r) ot[(16 * m + 4 * fq + r) * 128 + 16 * j + fr] = (bf16)(pk2(ao[m][r], 0.f) & 0xffffu);
        }
        asm volatile("s_waitcnt lgkmcnt(0)" ::: "memory");
#pragma unroll 4
        for (int i = 0; i < 16; ++i) { const int tk = 4 * i + fq; const v4u q = *(const LAS v4u*)(ot + tk * 128 + 8 * fr); const v4u zq = *(const v4u*)(Z + (size_t)(t0 + tk) * 1024 + hv * 128 + 8 * fr);
            float o[8] = {bflo(q.x), bfhi(q.x), bflo(q.y), bfhi(q.y), bflo(q.z), bfhi(q.z), bflo(q.w), bfhi(q.w)}; const float zz[8] = {bflo(zq.x), bfhi(zq.x), bflo(zq.y), bfhi(zq.y), bflo(zq.z), bfhi(zq.z), bflo(zq.w), bfhi(zq.w)};
            float ss = 0.f;
#pragma unroll
            for (int e = 0; e < 8; ++e) ss += o[e] * o[e];
            ss += __shfl_xor(ss, 1); ss += __shfl_xor(ss, 2); ss += __shfl_xor(ss, 4); ss += __shfl_xor(ss, 8);
            const float rr = __builtin_amdgcn_rsqf(ss * (1.0f / 128.0f) + EPS);
#pragma unroll
            for (int e = 0; e < 8; ++e) o[e] = o[e] * rr * on[e] * siluf_(zz[e]);
            v4u w; w.x = pk2(o[0], o[1]); w.y = pk2(o[2], o[3]); w.z = pk2(o[4], o[5]); w.w = pk2(o[6], o[7]); *(v4u*)(GT + (size_t)(t0 + tk) * 1024 + hv * 128 + 8 * fr) = w; }
        asm volatile("s_waitcnt lgkmcnt(0)" ::: "memory");
    }
}
__device__ __forceinline__ void phase_dn_ogate(const Args& args) {
    int tid_ = threadIdx.x; asm volatile("" : "+v"(tid_)); const int tid = tid_, lane = tid & 63, wave = __builtin_amdgcn_readfirstlane(tid >> 6), G = gridDim.x, bid = blockIdx.x; (void)tid;
    unsigned char* ws = uni_ptr(args.ws); const float* o_norm = args.in[23];
    const bf16* O = (const bf16*)(ws + WS_ACT + A_O); const bf16* Z = (const bf16*)(ws + WS_ACT + A_Z); bf16* GT = (bf16*)(ws + WS_ACT + A_H);
    float on[2][8];
#pragma unroll
    for (int j = 0; j < 2; ++j)
#pragma unroll
        for (int e = 0; e < 8; ++e) on[j][e] = o_norm[((8 * lane + 512 * j) & 127) + e];
    const int NW = G * NWAVES;
    for (int t0 = bid * NWAVES + wave; t0 < T; t0 += 4 * NW) {
        v4u q[4][2], z[4][2];
#pragma unroll
        for (int k = 0; k < 4; ++k) { const int t = (t0 + k * NW < T) ? t0 + k * NW : t0;
#pragma unroll
            for (int j = 0; j < 2; ++j) { const int ch = 8 * lane + 512 * j; q[k][j] = *(const v4u*)(O + (size_t)t * 1024 + ch); z[k][j] = *(const v4u*)(Z + (size_t)t * 1024 + ch); } }
#pragma unroll
        for (int k = 0; k < 4; ++k) { const int t = t0 + k * NW; if (t >= T) break;
#pragma unroll
            for (int j = 0; j < 2; ++j) { const int ch = 8 * lane + 512 * j; const v4u qq = q[k][j], zq = z[k][j];
                float o[8] = {bflo(qq.x), bfhi(qq.x), bflo(qq.y), bfhi(qq.y), bflo(qq.z), bfhi(qq.z), bflo(qq.w), bfhi(qq.w)}; const float zz[8] = {bflo(zq.x), bfhi(zq.x), bflo(zq.y), bfhi(zq.y), bflo(zq.z), bfhi(zq.z), bflo(zq.w), bfhi(zq.w)};
                float ss = 0.f;
#pragma unroll
                for (int e = 0; e < 8; ++e) ss += o[e] * o[e];
                ss += __shfl_xor(ss, 1); ss += __shfl_xor(ss, 2); ss += __shfl_xor(ss, 4); ss += __shfl_xor(ss, 8);
                const float r = __builtin_amdgcn_rsqf(ss * (1.0f / 128.0f) + EPS);
#pragma unroll
                for (int e = 0; e < 8; ++e) o[e] = o[e] * r * on[j][e] * siluf_(zz[e]);
                v4u w; w.x = pk2(o[0], o[1]); w.y = pk2(o[2], o[3]); w.z = pk2(o[4], o[5]); w.w = pk2(o[6], o[7]); *(v4u*)(GT + (size_t)t * 1024 + ch) = w; } }
    }
}
__device__ __forceinline__ void phase_moe_router(const Args& args, int L, LAS unsigned char* lds) {
    int tid_ = threadIdx.x; asm volatile("" : "+v"(tid_)); const int tid = tid_, lane = tid & 63, wave = __builtin_amdgcn_readfirstlane(tid >> 6), G = gridDim.x, bid = blockIdx.x;
    unsigned char* ws = uni_ptr(args.ws); const int ib = LBASE(L) + 4 + NMIX(L);
    const bf16* X = L == 3 ? (const bf16*)(ws + WS_X16B) : (const bf16*)args.out; unsigned char* H8 = ws + WS_ACT + A_H; const float* MOD = (const float*)(ws + WS_MOD) + (size_t)L * 2 * 6144;
    const float* nf = args.in[LBASE(L) + 1]; const float* rb = args.in[ib + 1];
    const bf16* RH = (const bf16*)(ws + WS_RTR + (size_t)L * 196608); const bf16* RLo = RH + 49152;
    int* EID = (int*)(ws + WS_EID); float* GATE = (float*)(ws + WS_GATE);
    LAS float* gs = (LAS float*)lds; LAS float* sh = gs + 1024; LAS int* lcnt = (LAS int*)(lds + 8192);
    LAS float* ssp = (LAS float*)(lds + 8448);
    LAS float* part = (LAS float*)(lds + 9472);
    LAS float* logit = (LAS float*)(lds + 58624);
    LAS int* leid = (LAS int*)(lds + 64768); LAS int* lrk = leid + 256; LAS int* lbase = leid + 512;
    int* CUR = (int*)(ws + WS_CTL + 524288) + L * 32; int* TOKE = (int*)(ws + WS_TOK); int* POS = (int*)(ws + WS_SLOT);
    const int r = lane & 15, q = lane >> 4, kw = 128 * wave;
    bf16x8 bh[4][3], bl[4][3];
#pragma unroll
    for (int ks = 0; ks < 4; ++ks)
#pragma unroll
        for (int nt = 0; nt < 3; ++nt) { bh[ks][nt] = *(const bf16x8*)(RH + (size_t)(nt * 16 + r) * 1024 + kw + 32 * ks + 8 * q); bl[ks][nt] = *(const bf16x8*)(RLo + (size_t)(nt * 16 + r) * 1024 + kw + 32 * ks + 8 * q); }
    for (int item = bid; item < T / 128; item += G) {
        const int r0 = item * 128, b = r0 / SEQ; const float* m = MOD + (size_t)b * 6144;
        __syncthreads();
        for (int k = tid; k < 1024; k += NTHR) { gs[k] = nf[k] * (1.0f + m[4096 + k]); sh[k] = m[3072 + k]; }
        if (tid < 32) lcnt[tid] = 0;
        f32x4 xv[8];
        { const bf16* xp = X + (size_t)(r0 + r) * 1024 + kw + 8 * q;
#pragma unroll
          for (int ks = 0; ks < 4; ++ks) { const v4u w = *(const v4u*)(xp + 32 * ks); xv[2 * ks] = (f32x4){bflo(w.x), bfhi(w.x), bflo(w.y), bfhi(w.y)}; xv[2 * ks + 1] = (f32x4){bflo(w.z), bfhi(w.z), bflo(w.w), bfhi(w.w)}; } }
        __syncthreads();
#pragma unroll 1
        for (int g = 0; g < 8; ++g) {
            const int row = r0 + 16 * g + r, pb = g & 1;
            v4u xn[4];
            { const bf16* xp = X + (size_t)(g < 7 ? row + 16 : row) * 1024 + kw + 8 * q;
#pragma unroll
                for (int ks = 0; ks < 4; ++ks) xn[ks] = *(const v4u*)(xp + 32 * ks); }
            float ss = 0.f;
#pragma unroll
            for (int i = 0; i < 8; ++i) ss += (xv[i][0] * xv[i][0] + xv[i][1] * xv[i][1]) + (xv[i][2] * xv[i][2] + xv[i][3] * xv[i][3]);
            ss += __shfl_xor(ss, 16); ss += __shfl_xor(ss, 32);
            if (q == 0) ssp[(pb * 8 + wave) * 16 + r] = ss;
            __syncthreads();
            float tot = 0.f;
#pragma unroll
            for (int w = 0; w < 8; ++w) tot += ssp[(pb * 8 + w) * 16 + r];
            const float rstd = __builtin_amdgcn_rsqf(tot * (1.0f / 1024.0f) + EPS);
            f32x4 acc[3];
#pragma unroll
            for (int nt = 0; nt < 3; ++nt) acc[nt] = (f32x4){0.f, 0.f, 0.f, 0.f};
#pragma unroll
            for (int ks = 0; ks < 4; ++ks) { const int k0 = kw + 32 * ks + 8 * q;
                const f32x4 g0 = *(const LAS f32x4*)(gs + k0), g1 = *(const LAS f32x4*)(gs + k0 + 4), s0 = *(const LAS f32x4*)(sh + k0), s1 = *(const LAS f32x4*)(sh + k0 + 4);
                const f32x4 h0 = xv[2 * ks] * rstd * g0 + s0, h1 = xv[2 * ks + 1] * rstd * g1 + s1;
                v4u hi; hi.x = pk2(h0[0], h0[1]); hi.y = pk2(h0[2], h0[3]); hi.z = pk2(h1[0], h1[1]); hi.w = pk2(h1[2], h1[3]);
                v4u lo; lo.x = pk2(h0[0] - bflo(hi.x), h0[1] - bfhi(hi.x)); lo.y = pk2(h0[2] - bflo(hi.y), h0[3] - bfhi(hi.y)); lo.z = pk2(h1[0] - bflo(hi.z), h1[1] - bfhi(hi.z)); lo.w = pk2(h1[2] - bflo(hi.w), h1[3] - bfhi(hi.w));
                { v2u h8; h8.x = pk4_fp8(h0[0], h0[1], h0[2], h0[3]); h8.y = pk4_fp8(h1[0], h1[1], h1[2], h1[3]); *(v2u*)(H8 + (size_t)row * 1024 + k0) = h8; }
                const bf16x8 ahi = __builtin_bit_cast(bf16x8, hi), alo = __builtin_bit_cast(bf16x8, lo);
#pragma unroll
                for (int nt = 0; nt < 3; ++nt) { acc[nt] = __builtin_amdgcn_mfma_f32_16x16x32_bf16(bh[ks][nt], ahi, acc[nt], 0, 0, 0); acc[nt] = __builtin_amdgcn_mfma_f32_16x16x32_bf16(bl[ks][nt], ahi, acc[nt], 0, 0, 0); acc[nt] = __builtin_amdgcn_mfma_f32_16x16x32_bf16(bh[ks][nt], alo, acc[nt], 0, 0, 0); } }
#pragma unroll
            for (int nt = 0; nt < 3; ++nt) *(LAS f32x4*)(part + ((pb * 8 + wave) * 16 + r) * 48 + 16 * nt + 4 * q) = acc[nt];
            __syncthreads();
            for (int o = tid; o < 768; o += NTHR) { float sacc = 0.f;
#pragma unroll
                for (int w = 0; w < 8; ++w) sacc += part[(pb * 8 + w) * 768 + o];
                const int n = o % 48; logit[pb * 768 + o] = sacc + (n < 36 ? rb[n] : 0.f); }
            __syncthreads();
            if (wave == g && lane < 16) { float lg[36]; const int trow = r0 + 16 * g + lane;
#pragma unroll
                for (int i = 0; i < 9; ++i) { const f32x4 v = *(const LAS f32x4*)(logit + pb * 768 + lane * 48 + 4 * i); lg[4 * i] = v[0]; lg[4 * i + 1] = v[1]; lg[4 * i + 2] = v[2]; lg[4 * i + 3] = v[3]; }
                int gsel = 0; float gm = lg[0];
#pragma unroll
                for (int i = 1; i < 4; ++i) if (lg[i] > gm) { gm = lg[i]; gsel = i; }
                float gsum = 0.f;
#pragma unroll
                for (int i = 0; i < 4; ++i) gsum += expf(lg[i] - gm);
                const float pg = 1.0f / gsum;
                float le[8];
#pragma unroll
                for (int i = 0; i < 8; ++i) le[i] = gsel == 0 ? lg[4 + i] : (gsel == 1 ? lg[12 + i] : (gsel == 2 ? lg[20 + i] : lg[28 + i]));
                int j1 = 0; float m1 = le[0];
#pragma unroll
                for (int i = 1; i < 8; ++i) if (le[i] > m1) { m1 = le[i]; j1 = i; }
                int j2 = -1; float m2 = -INFINITY;
#pragma unroll
                for (int i = 0; i < 8; ++i) if (i != j1 && le[i] > m2) { m2 = le[i]; j2 = i; }
                const float p2 = expf(m2 - m1), den = 1.0f / (1.0f + p2);
                const int e1 = gsel * 8 + j1, e2 = gsel * 8 + j2;
                EID[(size_t)trow * 2] = e1; EID[(size_t)trow * 2 + 1] = e2; GATE[(size_t)trow * 2] = pg * den; GATE[(size_t)trow * 2 + 1] = pg * p2 * den;
                const int li = 2 * (16 * g + lane); leid[li] = e1; leid[li + 1] = e2;
                lrk[li] = __hip_atomic_fetch_add(lcnt + e1, 1, __ATOMIC_RELAXED, __HIP_MEMORY_SCOPE_WORKGROUP); lrk[li + 1] = __hip_atomic_fetch_add(lcnt + e2, 1, __ATOMIC_RELAXED, __HIP_MEMORY_SCOPE_WORKGROUP); }
#pragma unroll
            for (int ks = 0; ks < 4; ++ks) { xv[2 * ks] = (f32x4){bflo(xn[ks].x), bfhi(xn[ks].x), bflo(xn[ks].y), bfhi(xn[ks].y)}; xv[2 * ks + 1] = (f32x4){bflo(xn[ks].z), bfhi(xn[ks].z), bflo(xn[ks].w), bfhi(xn[ks].w)}; }
        }
        __syncthreads();
        if (tid < 32) lbase[tid] = __hip_atomic_fetch_add(CUR + tid, lcnt[tid], __ATOMIC_RELAXED, __HIP_MEMORY_SCOPE_AGENT);
        __syncthreads();
        if (tid < 256) { const int e = leid[tid], pos = lbase[e] + lrk[tid]; TOKE[(size_t)e * 32768 + pos] = r0 + (tid >> 1); POS[(size_t)r0 * 2 + tid] = pos; }
        if (item == 0 && tid < 64) *(v4u*)(H8 + (size_t)T * 1024 + 16 * tid) = (v4u){0u, 0u, 0u, 0u};
    }
}
__device__ __forceinline__ void moe_tables(const int* CUR, LAS int* tbl) {
    const int tid = threadIdx.x;
    __syncthreads();
    if (tid < 64) {
        const int cnt = tid < 32 ? __hip_atomic_load(CUR + tid, __ATOMIC_RELAXED, __HIP_MEMORY_SCOPE_AGENT) : 0;
        const int nt = (cnt + 255) >> 8; int incl = nt;
#pragma unroll
        for (int o = 1; o < 32; o <<= 1) { const int t = __shfl_up(incl, o); if (tid >= o) incl += t; }
        const int t0 = incl - nt;
        if (tid < 32) { tbl[tid] = cnt; tbl[32 + tid] = t0; for (int i = 0; i < nt; ++i) tbl[80 + t0 + i] = tid; }
        if (tid == 31) tbl[64] = incl;
    }
    __syncthreads();
}
__device__ __forceinline__ void phase_moe_combine(const Args& args, int L, LAS unsigned char* lds) {
    int tid_ = threadIdx.x; asm volatile("" : "+v"(tid_)); const int tid = tid_, lane = tid & 63, wave = __builtin_amdgcn_readfirstlane(tid >> 6), G = gridDim.x, bid = blockIdx.x;
    unsigned char* ws = uni_ptr(args.ws); bf16* X = L == 3 ? (bf16*)(ws + WS_X16B) : (bf16*)args.out; float* OUT = args.out; const unsigned char* Y = ws + WS_ACT + A_Y; bf16* H = (bf16*)(ws + WS_ACT + A_H);
    const int* POS = (const int*)(ws + WS_SLOT); const int* EID = (const int*)(ws + WS_EID); const float* GATE = (const float*)(ws + WS_GATE); const float* MOD = (const float*)(ws + WS_MOD);
    LAS int* tbl = (LAS int*)(lds + LDSCTL_OFF + 7168); moe_tables((const int*)(ws + WS_CTL + 524288) + L * 32, tbl);
    LAS float* vgf = (LAS float*)lds; LAS float* vgs = vgf + 2048; LAS float* vsh = vgf + 4096;
    for (int i = tid; i < 2048; i += NTHR) { const int b = i >> 10, k = i & 1023; vgf[i] = MOD[(size_t)(L * 2 + b) * 6144 + 5120 + k];
        if (L < 3) { const float* m = MOD + (size_t)((L + 1) * 2 + b) * 6144; vgs[i] = args.in[LBASE(L < 3 ? L + 1 : 3)][k] * (1.0f + m[1024 + k]); vsh[i] = m[k]; } }
    __syncthreads();
    const int NW = G * NWAVES;
    for (int t = bid * NWAVES + wave; t < T; t += 2 * NW) {
        const int tb = t + NW; const bool two = tb < T; const int t1 = two ? tb : t;
        const int ta[2] = {t, t1};
        v2u xv[2][4]; unsigned y0[2][4], y1[2][4]; float g0[2], g1[2];
#pragma unroll
        for (int k = 0; k < 2; ++k) { const int tt = ta[k];
            const int s0 = 256 * tbl[32 + EID[(size_t)tt * 2]] + POS[(size_t)tt * 2], s1 = 256 * tbl[32 + EID[(size_t)tt * 2 + 1]] + POS[(size_t)tt * 2 + 1]; g0[k] = 0.125f * GATE[(size_t)tt * 2]; g1[k] = 0.125f * GATE[(size_t)tt * 2 + 1];
#pragma unroll
            for (int j = 0; j < 4; ++j) { const int c = 4 * lane + 256 * j; xv[k][j] = *(const v2u*)(X + (size_t)tt * 1024 + c);
                y0[k][j] = *(const unsigned*)(Y + (size_t)s0 * 1024 + c); y1[k][j] = *(const unsigned*)(Y + (size_t)s1 * 1024 + c); } }
#pragma unroll
        for (int k = 0; k < 2; ++k) { if (k == 1 && !two) break; const int tt = ta[k]; const int b = tt / SEQ; f32x4 v[4]; float ss = 0.f;
#pragma unroll
            for (int j = 0; j < 4; ++j) { const int c = 4 * lane + 256 * j; f32x4 mo; const f32x4 gg = *(const LAS f32x4*)(vgf + b * 1024 + c);
                { const auto a0 = __builtin_amdgcn_cvt_pk_f32_fp8((int)y0[k][j], false), a1 = __builtin_amdgcn_cvt_pk_f32_fp8((int)y0[k][j], true), b0 = __builtin_amdgcn_cvt_pk_f32_fp8((int)y1[k][j], false), b1 = __builtin_amdgcn_cvt_pk_f32_fp8((int)y1[k][j], true);
                  mo[0] = g0[k] * a0[0] + g1[k] * b0[0]; mo[1] = g0[k] * a0[1] + g1[k] * b0[1]; mo[2] = g0[k] * a1[0] + g1[k] * b1[0]; mo[3] = g0[k] * a1[1] + g1[k] * b1[1]; }
                v[j] = (f32x4){bflo(xv[k][j].x), bfhi(xv[k][j].x), bflo(xv[k][j].y), bfhi(xv[k][j].y)} + gg * mo;
                if (L < 3) { v2u w; w.x = pk2(v[j][0], v[j][1]); w.y = pk2(v[j][2], v[j][3]); *(v2u*)(X + (size_t)tt * 1024 + c) = w; } else *(f32x4*)(OUT + (size_t)tt * 1024 + c) = v[j];
                ss += (v[j][0] * v[j][0] + v[j][1] * v[j][1]) + (v[j][2] * v[j][2] + v[j][3] * v[j][3]); }
            if (L < 3) { const float rstd = __builtin_amdgcn_rsqf(wave_sum(ss) * (1.0f / 1024.0f) + EPS);
#pragma unroll
                for (int j = 0; j < 4; ++j) { const int c = 4 * lane + 256 * j; const f32x4 gsv = *(const LAS f32x4*)(vgs + b * 1024 + c), shv = *(const LAS f32x4*)(vsh + b * 1024 + c);
                    const f32x4 h = v[j] * rstd * gsv + shv; v2u w; w.x = pk2(h[0], h[1]); w.y = pk2(h[2], h[3]); *(v2u*)(H + (size_t)tt * 1024 + c) = w; } } }
    }
}

constexpr int N_PHASES = 33;

#ifndef DUP_MASK
#define DUP_MASK 0
#endif
#ifndef STAGGER_TICKS
#define STAGGER_TICKS 0
#endif
__device__ __forceinline__ void gemm_stagger() { if (STAGGER_TICKS > 0) { const unsigned long long t0 = __builtin_amdgcn_s_memrealtime(); const unsigned long long w = (unsigned long long)((blockIdx.x >> 3) & 3) * STAGGER_TICKS; while (__builtin_amdgcn_s_memrealtime() - t0 < w) __builtin_amdgcn_s_sleep(8); } }
#define PHASE(k) if ((lo <= (k) && (k) < hi) && ((started ? (xcd_barrier(bar), 0) : 0), started = true, true))
#define NREP(g) (1 + ((DUP_MASK >> (g)) & 1))
#define PHASE_G(k, g) PHASE(k) for (int rep_ = 0; rep_ < NREP(g); ++rep_, ((rep_ < NREP(g)) ? (xcd_barrier(bar), 0) : 0))
template <int L> __device__ __forceinline__ void run_layer(const Args& args, LAS unsigned char* lds, const XcdBarrier& bar, bool& started, const int lo, const int hi) {
    const int G = gridDim.x, bid = blockIdx.x;
    unsigned char* ws = uni_ptr(args.ws);
    const float* MOD = (const float*)(ws + WS_MOD);
    bf16* Hb = (bf16*)(ws + WS_ACT + A_H);

        const int pb = (L == 0) ? 1 : (L == 1 ? 9 : (L == 2 ? 19 : 26));
        bf16* X16 = (L == 3) ? (bf16*)(ws + WS_X16B) : (bf16*)args.out; const void* xsrc = (L == 0) ? (const void*)args.in[0] : (const void*)args.out;
        const float* gate_m = MOD + (size_t)L * 2 * 6144 + 2048;
        int mb;
        if constexpr (L == 0 || L == 3) {
            int g0 = pb;
            if (L == 0) { PHASE_G(pb, 8) { phase_norm0(args, lds); } g0 = pb + 1; }
            const bf16* Win = (const bf16*)(ws + WS_WMIX + (L == 0 ? WMIX_GM_IN0 : WMIX_GM_IN3)); const bf16* Wout = (const bf16*)(ws + WS_WMIX + (L == 0 ? WMIX_GM_OUT0 : WMIX_GM_OUT3));
            PHASE_G(g0, 1) { pg8::Gemm g{Hb, Win, T, 2048, 1024}; pg8::StaticOrder S; S.init(T, 2048, G, bid);
                EpiGm1 E{(bf16*)(ws + WS_ACT + A_U), (bf16*)(ws + WS_ACT + A_V), (float*)(ws + WS_VSSP)};
                (gemm_stagger(), 0); pg8::gemm_phase<EpiGm1, pg8::StaticOrder, true, true, false, false, true>(lds, g, S, E); }
            PHASE_G(g0 + 1, 2) { phase_gm_spatial(args, L, lds); }
            PHASE_G(g0 + 2, (L == 0 ? 1 : 31)) { pg8::Gemm g{(const bf16*)(ws + WS_ACT + A_GATED), Wout, T, 1024, 1024}; pg8::StaticOrder S; S.init(T, 1024, G, bid);
                EpiRes<L != 0> E{xsrc, X16, gate_m};
                (gemm_stagger(), 0); pg8::gemm_phase<EpiRes<L != 0>, pg8::StaticOrder, true, true, false, false, true>(lds, g, S, E); }
            mb = g0 + 3;
        } else if constexpr (L == 1) {
            PHASE_G(pb, 1) { pg8::Gemm g{Hb, (const bf16*)(ws + WS_WMIX + WMIX_DN_IN), T, 3072, 1024}; pg8::StaticOrder S; S.init(T, 3072, G, bid);
                EpiDn1 E{(bf16*)(ws + WS_ACT + A_QKV), (bf16*)(ws + WS_ACT + A_Z), (float*)(ws + WS_BA)};
                (gemm_stagger(), 0); pg8::gemm_phase<EpiDn1, pg8::StaticOrder, true, true, false, false, true>(lds, g, S, E); dn_ba_tail(args, lds); }
            PHASE_G(pb + 1, 3) { phase_dn_prep(args, lds); }
            PHASE_G(pb + 2, 4) { phase_dn_chunk(args, lds); }
            PHASE_G(pb + 3, 5) { phase_dn_scan(args, lds); }
            PHASE_G(pb + 4, 3) { phase_dn_out(args, lds); }
            PHASE(pb + 5) { pg8::Gemm g{Hb, (const bf16*)(ws + WS_WMIX + WMIX_DN_OUT), T, 1024, 1024}; pg8::StaticOrder S; S.init(T, 1024, G, bid);
                EpiRes<L != 0> E{xsrc, X16, gate_m};
                (gemm_stagger(), 0); pg8::gemm_phase<EpiRes<L != 0>, pg8::StaticOrder, true, true, false, false, true>(lds, g, S, E); }
            mb = pb + 6;
        } else {
            PHASE_G(pb, 1) { pg8::Gemm g{Hb, (const bf16*)(ws + WS_WMIX + WMIX_SWA_IN), T, 1536, 1024}; pg8::StaticOrder S; S.init(T, 1536, G, bid);
                EpiBf E{(bf16*)(ws + WS_ACT + A_QKV), 1536, 0xffff, 1.0f};
                (gemm_stagger(), 0); pg8::gemm_phase<EpiBf, pg8::StaticOrder, true, true, false, false, true>(lds, g, S, E); }
            PHASE_G(pb + 1, 2) { phase_swa_attn(args, lds); }
            PHASE(pb + 2) { pg8::Gemm g{Hb, (const bf16*)(ws + WS_WMIX + WMIX_SWA_OUT), T, 1024, 1024}; pg8::StaticOrder S; S.init(T, 1024, G, bid);
                EpiRes<L != 0> E{xsrc, X16, gate_m};
                (gemm_stagger(), 0); pg8::gemm_phase<EpiRes<L != 0>, pg8::StaticOrder, true, true, false, false, true>(lds, g, S, E); }
            mb = pb + 3;
        }
        PHASE_G(mb, 6) { phase_moe_router(args, L, lds); }
        const int* CUR = (const int*)(ws + WS_CTL + 524288) + L * 32; LAS int* tbl = (LAS int*)(lds + LDSCTL_OFF + 7168); LAS int* lidx = (LAS int*)(lds + LDSCTL_OFF + 2048);
        PHASE_G(mb + 1, 7) { moe_tables(CUR, tbl); const int ntiles = tbl[64];
            pg8::Gemm g{(const bf16*)(ws + WS_ACT + A_H), (const bf16*)(ws + WS_W + (size_t)L * WL_STRIDE), MAXROWS, 1024, 512};
            MoeOrder S; S.init(tbl + 80, ntiles, G, bid); EpiMoe1 E{ws + WS_ACT + A_ACTV};
            const int* TOKE = (const int*)(ws + WS_TOK);
            for (int ui = 0; ui < 5; ++ui) { pg8::Unit u; if (S.next(ui, u) && threadIdx.x < 256) { const int e = tbl[80 + u.pm], p = 256 * (u.pm - tbl[32 + e]) + (int)threadIdx.x; lidx[ui * 256 + threadIdx.x] = p < tbl[e] ? TOKE[(size_t)e * 32768 + p] : T; } }
            __syncthreads();
            pg8::gemm_phase_gather<EpiMoe1, MoeOrder, true, true, true, false, true>(lds, g, S, E, lidx); }
        PHASE_G(mb + 2, 7) { moe_tables(CUR, tbl); const int ntiles = tbl[64];
            pg8::Gemm g{(const bf16*)(ws + WS_ACT + A_ACTV), (const bf16*)(ws + WS_W + (size_t)L * WL_STRIDE + WL_OUT), MAXROWS, 1024, 256};
            MoeOrder S; S.init(tbl + 80, ntiles, G, bid); EpiF8 E{ws + WS_ACT + A_Y, 1024, 3, 0.5f};
            pg8::gemm_phase<EpiF8, MoeOrder, true, true, true, false, true>(lds, g, S, E); }
        PHASE(mb + 3) { phase_moe_combine(args, L, lds); }

}
__global__ void __launch_bounds__(NTHR, 2) fwd_kernel(Args args) {
    extern __shared__ __attribute__((aligned(16))) unsigned char lds_raw[];
    LAS unsigned char* lds = (LAS unsigned char*)lds_raw;
    const int tid = threadIdx.x;
    unsigned char* ws = uni_ptr(args.ws);
    for (int u = tid; u < (LDS_BYTES - LDSCTL_OFF) / 4; u += NTHR) ((LAS unsigned*)(lds + LDSCTL_OFF))[u] = 0u;
    __syncthreads();
    volatile LAS unsigned* MISC = (volatile LAS unsigned*)(lds + MISC_OFF);
    XcdBarrier bar = xcd_barrier_post((unsigned*)(ws + WS_CTL) + 4096 + (size_t)args.li * XCD_BAR_WORDS, MISC + 8);
    const int lo = args.ph_lo, hi = args.ph_hi; bool started = false;
    const float* MOD = (const float*)(ws + WS_MOD);
    bf16* Hb = (bf16*)(ws + WS_ACT + A_H);

    PHASE_G(0, 0) { phase_prologue(args, lds); }

    run_layer<0>(args, lds, bar, started, lo, hi);
    run_layer<1>(args, lds, bar, started, lo, hi);
    run_layer<2>(args, lds, bar, started, lo, hi);
    run_layer<3>(args, lds, bar, started, lo, hi);
#undef PHASE
#undef PHASE_G
}

extern "C" void kernel_launch(void* const* d_in, const int* in_sizes, int n_in, void* d_out, int out_size, void* d_ws, size_t ws_size, hipStream_t stream) {
    static int grid = 0;
    if (grid == 0) {
        if (n_in != N_IN || in_sizes[0] != T * D || out_size != T * D || ws_size < WS_END) { fprintf(stderr, "kernel_launch: unexpected shapes (n_in %d, in0 %d, out %d, ws %zu < %zu)\n", n_in, n_in > 0 ? in_sizes[0] : -1, out_size, ws_size, (size_t)WS_END); grid = -1; return; }
        int dev = 0, cus = 0, per_cu = 0;
        if (hipGetDevice(&dev) != hipSuccess || hipDeviceGetAttribute(&cus, hipDeviceAttributeMultiprocessorCount, dev) != hipSuccess) { grid = -1; return; }
        if (hipFuncSetAttribute((const void*)fwd_kernel, hipFuncAttributeMaxDynamicSharedMemorySize, LDS_BYTES) != hipSuccess) { fprintf(stderr, "kernel_launch: hipFuncSetAttribute failed\n"); grid = -1; return; }
        if (hipOccupancyMaxActiveBlocksPerMultiprocessor(&per_cu, (const void*)fwd_kernel, NTHR, LDS_BYTES) != hipSuccess || per_cu < 1) fprintf(stderr, "kernel_launch: occupancy query reports %d\n", per_cu);
        (void)hipGetLastError();
        grid = cus;
    }
    if (grid < 0) return;
    if (hipMemsetAsync((char*)d_ws + WS_CTL, 0, CTL_ZERO_BYTES, stream) != hipSuccess) return;
    Args a{};
    for (int i = 0; i < N_IN; ++i) a.in[i] = (const float*)d_in[i];
    a.out = (float*)d_out; a.ws = (unsigned char*)d_ws; a.pad = 0;
#if MK_LAUNCH_MODE == 1
    a.ph_lo = 0; a.ph_hi = N_PHASES; a.li = 0;
    hipLaunchKernelGGL(fwd_kernel, dim3(grid), dim3(NTHR), LDS_BYTES, stream, a);
#else
#ifndef PROBE_PHASE
#define PROBE_PHASE -1
#endif
    for (int p = 0; p < N_PHASES; ++p) { a.ph_lo = p; a.ph_hi = p + 1; a.li = 0;
        for (int rep = 0; rep < (p == PROBE_PHASE ? 2 : 1); ++rep) hipLaunchKernelGGL(fwd_kernel, dim3(grid), dim3(NTHR), LDS_BYTES, stream, a); }
#endif
}
```

```cpp
#include <hip/hip_runtime.h>
#include <cstdio>
#include <cstdint>
#ifndef MK_LAUNCH_MODE
#define MK_LAUNCH_MODE 1
#endif
namespace pg8 {
#define PG8_LAS __attribute__((address_space(3)))
typedef unsigned short bf16_t;
typedef short bf16x8 __attribute__((ext_vector_type(8)));
typedef float f32x4 __attribute__((ext_vector_type(4)));
typedef unsigned u32x4 __attribute__((ext_vector_type(4)));
constexpr int BM = 256, BK = 64, HALF = 128, HTB = HALF * BK * 2  , STAGE_BYTES = 8 * HTB, NXCD = 8, WGM = 8;

__host__ __device__ __forceinline__ int lds_byte(int r, int c) { const int st = (r >> 4) * 2 + (c >> 5), rr = r & 15, cc = c & 31, ob = rr * 64 + cc * 2; return st * 1024 + (ob ^ (((ob >> 9) & 1) << 5)); }
__host__ __device__ __forceinline__ void stage_rc(int b, int& R, int& C) { const int st = b / 1024, sb = b % 1024, swz = sb ^ (((sb >> 9) & 1) << 5); R = (st >> 1) * 16 + swz / 64; C = (st & 1) * 32 + (swz % 64) / 2; }
__host__ __device__ __forceinline__ int perm32(int rho) { const int n = rho >> 4, i = rho & 15; return 8 * (i >> 2) + 4 * n + (i & 3); }

struct Unit { int pm, pn; };
struct Gemm { const bf16_t* A; const bf16_t* Bt; int M, N, K; };

struct StaticOrder {
    int nM, nN, nwg, G, c;
    __host__ __device__ void init(int M, int N, int G_, int c_) { nM = M / BM; nN = N / BM; nwg = nM * nN; G = G_; c = c_; }
    __host__ __device__ bool next(int i, Unit& u) const {
        const long L = (long)i * G + c; if (L >= nwg) return false;
        int wgid = (int)L; { const int q = nwg / NXCD, r = nwg % NXCD, xcd = wgid % NXCD, off = wgid / NXCD; wgid = (xcd < r ? xcd * (q + 1) : r * (q + 1) + (xcd - r) * q) + off; }
        const int nig = WGM * nN, gid = wgid / nig, fm = gid * WGM, gsz = (nM - fm) < WGM ? (nM - fm) : WGM;
        u.pm = fm + ((wgid % nig) % gsz); u.pn = (wgid % nig) / gsz; return true;
    }
    __device__ __forceinline__ void a_ready(const Unit&) const {}
    __device__ __forceinline__ void done(const Unit&) const {}
};
typedef float f32x2_ __attribute__((ext_vector_type(2))); typedef __bf16 bf16x2_ __attribute__((ext_vector_type(2)));
__device__ __forceinline__ unsigned cvt_pk_bf16(float lo, float hi) { const f32x2_ v = {lo, hi}; return __builtin_bit_cast(unsigned, __builtin_convertvector(v, bf16x2_)); }
typedef float f32x2 __attribute__((ext_vector_type(2)));
typedef int pg8_v8i __attribute__((ext_vector_type(8))); typedef int pg8_v4i __attribute__((ext_vector_type(4)));
struct pg8_FragA { bf16x8 v[4][2]; pg8_v8i w[4]; }; struct pg8_FragB { bf16x8 v[2][2]; pg8_v8i w[2]; };
__device__ __forceinline__ pg8_v8i pg8_cat(bf16x8 lo, bf16x8 hi) { const pg8_v4i a = __builtin_bit_cast(pg8_v4i, lo), c = __builtin_bit_cast(pg8_v4i, hi); return (pg8_v8i){a[0], a[1], a[2], a[3], c[0], c[1], c[2], c[3]}; }
__device__ __forceinline__ unsigned pg8_touch_lines(const char* base, int nlines) {
    unsigned a = 0; for (int l = threadIdx.x; l < nlines; l += 512) a += *(const unsigned*)(base + (size_t)l * 128); return a;
}
__device__ __forceinline__ unsigned pg8_touch_rows(const char* base, const PG8_LAS int* idx, int rowbytes) {
    const int lpr = rowbytes >> 7; unsigned a = 0; for (int l = threadIdx.x; l < 256 * lpr; l += 512) a += *(const unsigned*)(base + (size_t)idx[l / lpr] * rowbytes + (size_t)(l % lpr) * 128); return a;
}
template <class Epi, class Sched, bool ALIGN_EPI = false, bool SP2 = false, bool FP8 = false, bool TOUCH = false, bool BT = false, bool AT = false>
__device__ __forceinline__ void gemm_phase(PG8_LAS unsigned char* lds, const Gemm g, const Sched& S, const Epi& E) {
    const int tid = threadIdx.x, wid = __builtin_amdgcn_readfirstlane(tid >> 6), lane = tid & 63, wr = wid >> 2, wc = wid & 3, fr = lane & 15, fq = lane >> 4;
    const int K = g.K, nt = K / BK;
    unsigned voffA[2], voffB[2];
#pragma unroll
    for (int i = 0; i < 2; ++i) { int R, C; stage_rc(tid * 16 + i * 8192, R, C); const int Rb = Epi::PERM ? ((R & ~31) + perm32(R & 31)) : R;
        voffA[i] = (unsigned)(R * (AT ? 64 : K) + C) * 2u; voffB[i] = (unsigned)(Rb * (BT ? 64 : K) + C) * 2u; }
    const size_t kstep = (size_t)(BK * 2);
    const size_t hstep = (size_t)HALF * K * 2;
    const size_t tstep = 2 * hstep;
    const size_t kstepB = BT ? (size_t)32768 : kstep, hstepB = BT ? (size_t)16384 : hstep;
    const size_t kstepA = AT ? (size_t)32768 : kstep, hstepA = AT ? (size_t)16384 : hstep;
    const unsigned ldsw = (unsigned)wid * 1024u;
    const int aoff = lds_byte(wr * 64 + fr, fq * 8), boff = lds_byte(wc * 32 + fr, fq * 8);
#define PG8_SA(b, h) (((b) * 2 + (h)) * HTB)
#define PG8_SB(b, h) ((4 + (b) * 2 + (h)) * HTB)
#define PG8_STAGE(bufoff, gbase, voff) do { _Pragma("unroll") for (int _i = 0; _i < 2; ++_i) \
        __builtin_amdgcn_global_load_lds((const unsigned*)((const char*)(gbase) + (voff)[_i]), (PG8_LAS unsigned*)(lds + (bufoff) + ldsw + _i * 8192), 16, 0, 0); } while (0)
#define PG8_LDA(dst, b, h) do { _Pragma("unroll") for (int m = 0; m < 4; ++m) { if constexpr (FP8) dst.w[m] = pg8_cat(*(const PG8_LAS bf16x8*)(lds + PG8_SA(b, h) + aoff + m * 2048), *(const PG8_LAS bf16x8*)(lds + PG8_SA(b, h) + aoff + m * 2048 + 1024)); \
        else { _Pragma("unroll") for (int k = 0; k < 2; ++k) dst.v[m][k] = *(const PG8_LAS bf16x8*)(lds + PG8_SA(b, h) + aoff + m * 2048 + k * 1024); } } } while (0)
#define PG8_LDB(dst, b, h) do { _Pragma("unroll") for (int n = 0; n < 2; ++n) { if constexpr (FP8) dst.w[n] = pg8_cat(*(const PG8_LAS bf16x8*)(lds + PG8_SB(b, h) + boff + n * 2048), *(const PG8_LAS bf16x8*)(lds + PG8_SB(b, h) + boff + n * 2048 + 1024)); \
        else { _Pragma("unroll") for (int k = 0; k < 2; ++k) dst.v[n][k] = *(const PG8_LAS bf16x8*)(lds + PG8_SB(b, h) + boff + n * 2048 + k * 1024); } } } while (0)
#define PG8_MMA(ai, bj, At, Bt) do { __builtin_amdgcn_s_setprio(1); if constexpr (FP8) { _Pragma("unroll") for (int m = 0; m < 4; ++m) _Pragma("unroll") for (int n = 0; n < 2; ++n) \
        asm volatile("v_mfma_f32_16x16x128_f8f6f4 %0, %1, %2, %0" : "+v"(acc[ai][bj][m][n]) : "v"(Bt.w[n]), "v"(At.w[m])); } \
        else { _Pragma("unroll") for (int m = 0; m < 4; ++m) _Pragma("unroll") for (int n = 0; n < 2; ++n) _Pragma("unroll") for (int k = 0; k < 2; ++k) \
        acc[ai][bj][m][n] = __builtin_amdgcn_mfma_f32_16x16x32_bf16(Bt.v[n][k], At.v[m][k], acc[ai][bj][m][n], 0, 0, 0); } __builtin_amdgcn_s_setprio(0); } while (0)
#define PG8_WAIT_V(n) asm volatile("s_waitcnt vmcnt(" #n ")" ::: "memory")
#define PG8_WAIT_L(n) asm volatile("s_waitcnt lgkmcnt(" #n ")" ::: "memory")
#define PG8_BAR __builtin_amdgcn_s_barrier()
#define PG8_SCHED __builtin_amdgcn_sched_barrier(0)
    Unit cur, nxt; int ui = 0;
    if (!S.next(0, cur)) return;
    if constexpr (TOUCH) { unsigned a_ = pg8_touch_lines((const char*)g.A + (size_t)cur.pm * (512 * (size_t)g.K), 4 * g.K) + pg8_touch_lines((const char*)g.Bt + (size_t)cur.pn * (512 * (size_t)g.K), 4 * g.K);
        Unit u1_; if (S.next(1, u1_)) a_ += pg8_touch_lines((const char*)g.A + (size_t)u1_.pm * (512 * (size_t)g.K), 4 * g.K) + pg8_touch_lines((const char*)g.Bt + (size_t)u1_.pn * (512 * (size_t)g.K), 4 * g.K);
        asm volatile("" :: "v"(a_)); }
    f32x4 acc[2][2][4][2];
#pragma unroll
    for (int a = 0; a < 2; ++a)
#pragma unroll
        for (int b = 0; b < 2; ++b)
#pragma unroll
            for (int m = 0; m < 4; ++m)
#pragma unroll
                for (int n = 0; n < 2; ++n) acc[a][b][m][n] = (f32x4){0.f, 0.f, 0.f, 0.f};
    pg8_FragA At; pg8_FragB B0, B1;
    const char* cA = (const char*)g.A + (size_t)cur.pm * tstep; const char* cB = (const char*)g.Bt + (size_t)cur.pn * tstep;
    S.a_ready(cur);
    if constexpr (SP2) {
        PG8_STAGE(PG8_SB(0, 0), cB, voffB); PG8_STAGE(PG8_SB(0, 1), cB + hstepB, voffB); PG8_STAGE(PG8_SA(0, 0), cA, voffA); PG8_STAGE(PG8_SA(0, 1), cA + hstepA, voffA);
        if (wr == 1) PG8_BAR;
        PG8_WAIT_V(2); PG8_BAR;
        PG8_STAGE(PG8_SB(1, 0), cB + kstepB, voffB); PG8_STAGE(PG8_SA(1, 0), cA + kstepA, voffA); PG8_STAGE(PG8_SB(1, 1), cB + hstepB + kstepB, voffB);
        PG8_WAIT_V(6); PG8_BAR;
    } else {
        PG8_STAGE(PG8_SB(0, 0), cB, voffB); PG8_STAGE(PG8_SA(0, 0), cA, voffA); PG8_STAGE(PG8_SB(0, 1), cB + hstepB, voffB); PG8_STAGE(PG8_SA(0, 1), cA + hstepA, voffA);
        if (wr == 1) PG8_BAR;
        PG8_WAIT_V(4); PG8_BAR;
        PG8_STAGE(PG8_SB(1, 0), cB + kstepB, voffB); PG8_STAGE(PG8_SA(1, 0), cA + kstepA, voffA); PG8_STAGE(PG8_SB(1, 1), cB + hstepB + kstepB, voffB);
        PG8_WAIT_V(6); PG8_BAR;
    }
    for (;;) {
        const bool has_next = S.next(ui + 1, nxt);
        const char* nA = has_next ? (const char*)g.A + (size_t)nxt.pm * tstep : cA; const char* nB = has_next ? (const char*)g.Bt + (size_t)nxt.pn * tstep : cB;
#pragma unroll 1
        for (int t = 0; t < nt; t += 2) {
            const bool last = (t == nt - 2);
            const char* a1 = cA + (size_t)(t + 1) * kstepA;
            const char* a2 = last ? nA : cA + (size_t)(t + 2) * kstepA; const char* b2 = last ? nB : cB + (size_t)(t + 2) * kstepB;
            const char* a3 = a2 + kstepA; const char* b3 = b2 + kstepB;
            if (last && has_next) S.a_ready(nxt);
            if constexpr (SP2) {
            PG8_LDB(B0, 0, 0); PG8_LDB(B1, 0, 1); PG8_SCHED; PG8_LDA(At, 0, 0); PG8_STAGE(PG8_SA(1, 1), a1 + hstepA, voffA);
            PG8_WAIT_V(8); PG8_WAIT_L(0); PG8_BAR; PG8_MMA(0, 0, At, B0); PG8_MMA(0, 1, At, B1); PG8_BAR; PG8_SCHED;
            PG8_LDA(At, 0, 1); PG8_STAGE(PG8_SB(0, 0), b2, voffB); PG8_STAGE(PG8_SB(0, 1), b2 + hstepB, voffB); PG8_STAGE(PG8_SA(0, 0), a2, voffA);
            PG8_WAIT_V(8); PG8_WAIT_L(0); PG8_BAR; PG8_MMA(1, 0, At, B0); PG8_MMA(1, 1, At, B1); PG8_BAR; PG8_SCHED;
            PG8_LDB(B0, 1, 0); PG8_LDB(B1, 1, 1); PG8_SCHED; PG8_LDA(At, 1, 0); PG8_STAGE(PG8_SA(0, 1), a2 + hstepA, voffA);
            PG8_WAIT_V(8); PG8_WAIT_L(0); PG8_BAR; PG8_MMA(0, 0, At, B0); PG8_MMA(0, 1, At, B1); PG8_BAR; PG8_SCHED;
            PG8_LDA(At, 1, 1); PG8_STAGE(PG8_SB(1, 0), b3, voffB); PG8_STAGE(PG8_SB(1, 1), b3 + hstepB, voffB); PG8_STAGE(PG8_SA(1, 0), a3, voffA);
            PG8_WAIT_V(8); PG8_WAIT_L(0); PG8_BAR; PG8_MMA(1, 0, At, B0); PG8_MMA(1, 1, At, B1); PG8_BAR; PG8_SCHED;
            } else {
            PG8_LDB(B0, 0, 0); PG8_SCHED; PG8_LDA(At, 0, 0); PG8_STAGE(PG8_SA(1, 1), a1 + hstepA, voffA);
            PG8_WAIT_L(8); PG8_BAR; PG8_WAIT_L(0); PG8_MMA(0, 0, At, B0); PG8_BAR; PG8_SCHED;
            PG8_LDB(B1, 0, 1); PG8_STAGE(PG8_SB(0, 0), b2, voffB);
            PG8_BAR; PG8_WAIT_L(0); PG8_MMA(0, 1, At, B1); PG8_BAR;
            PG8_LDA(At, 0, 1); PG8_STAGE(PG8_SA(0, 0), a2, voffA);
            PG8_BAR; PG8_WAIT_L(0); PG8_MMA(1, 0, At, B0); PG8_BAR; PG8_SCHED;
            PG8_STAGE(PG8_SB(0, 1), b2 + hstepB, voffB);
            PG8_WAIT_V(6); PG8_BAR; PG8_MMA(1, 1, At, B1); PG8_BAR;
            PG8_LDB(B0, 1, 0); PG8_SCHED; PG8_LDA(At, 1, 0); PG8_STAGE(PG8_SA(0, 1), a2 + hstepA, voffA);
            PG8_WAIT_L(8); PG8_BAR; PG8_WAIT_L(0); PG8_MMA(0, 0, At, B0); PG8_BAR; PG8_SCHED;
            PG8_LDB(B1, 1, 1); PG8_STAGE(PG8_SB(1, 0), b3, voffB);
            PG8_BAR; PG8_WAIT_L(0); PG8_MMA(0, 1, At, B1); PG8_BAR;
            PG8_LDA(At, 1, 1); PG8_STAGE(PG8_SA(1, 0), a3, voffA);
            PG8_BAR; PG8_WAIT_L(0); PG8_MMA(1, 0, At, B0); PG8_BAR; PG8_SCHED;
            PG8_STAGE(PG8_SB(1, 1), b3 + hstepB, voffB);
            PG8_WAIT_V(6); PG8_BAR; PG8_MMA(1, 1, At, B1); PG8_BAR;
            }
        }
        if constexpr (ALIGN_EPI) { if (wr == 0) PG8_BAR; }
        if constexpr (FP8) asm volatile("s_nop 15\n\ts_nop 15" ::: "memory");
        if constexpr (!Epi::AFTER_DRAIN) { const int ln_ = (int)__builtin_amdgcn_mbcnt_hi(~0u, __builtin_amdgcn_mbcnt_lo(~0u, 0u)); int fr_ = ln_ & 15, fq_ = ln_ >> 4; asm volatile("" : "+v"(fr_), "+v"(fq_)); E(acc, cur, wr, wc, fr_, fq_); S.done(cur);
            if constexpr (TOUCH) { Unit u2_; if (S.next(ui + 2, u2_)) { const unsigned a_ = pg8_touch_lines((const char*)g.A + (size_t)u2_.pm * (512 * (size_t)g.K), 4 * g.K) + pg8_touch_lines((const char*)g.Bt + (size_t)u2_.pn * (512 * (size_t)g.K), 4 * g.K); asm volatile("" :: "v"(a_)); } } }
        if (!has_next) break;
#pragma unroll
        for (int a = 0; a < 2; ++a)
#pragma unroll
            for (int b = 0; b < 2; ++b)
#pragma unroll
                for (int m = 0; m < 4; ++m)
#pragma unroll
                    for (int n = 0; n < 2; ++n) acc[a][b][m][n] = (f32x4){0.f, 0.f, 0.f, 0.f};
        cur = nxt; cA = nA; cB = nB; ++ui;
        if constexpr (ALIGN_EPI) { if (wr == 1) PG8_BAR; }
    }
    PG8_WAIT_V(0);
    if constexpr (!ALIGN_EPI) { if (wr == 0) PG8_BAR; }
    PG8_BAR;
    if constexpr (Epi::AFTER_DRAIN) { E.fused(acc, cur, wr, wc, fr, fq, lds, wid, lane); S.done(cur); }
#undef PG8_SA
#undef PG8_SB
#undef PG8_STAGE
#undef PG8_LDA
#undef PG8_LDB
#undef PG8_MMA
#undef PG8_WAIT_V
#undef PG8_WAIT_L
#undef PG8_BAR
#undef PG8_SCHED
}

template <class Epi, class Sched, bool ALIGN_EPI = true, bool SP2 = true, bool FP8 = false, bool TOUCH = false, bool BT = false>
__device__ __forceinline__ void gemm_phase_gather(PG8_LAS unsigned char* lds, const Gemm g, const Sched& S, const Epi& E, const PG8_LAS int* lidx) {
    static_assert(SP2 && ALIGN_EPI, "gather variant: SP2 + ALIGN_EPI only");
    const int tid = threadIdx.x, wid = __builtin_amdgcn_readfirstlane(tid >> 6), lane = tid & 63, wr = wid >> 2, wc = wid & 3, fr = lane & 15, fq = lane >> 4;
    const int K = g.K, nt = K / BK;
    unsigned voffB[2]; int RA[2]; unsigned CA[2];
#pragma unroll
    for (int i = 0; i < 2; ++i) { int R, C; stage_rc(tid * 16 + i * 8192, R, C); const int Rb = Epi::PERM ? ((R & ~31) + perm32(R & 31)) : R;
        RA[i] = R; CA[i] = (unsigned)C * 2u; voffB[i] = (unsigned)(Rb * (BT ? 64 : K) + C) * 2u; }
    unsigned ca[2][2], na[2][2];
#define PG8_ROWOFF(dst, ui_) do { _Pragma("unroll") for (int h_ = 0; h_ < 2; ++h_) _Pragma("unroll") for (int i_ = 0; i_ < 2; ++i_) dst[h_][i_] = (unsigned)lidx[(ui_) * 256 + h_ * 128 + RA[i_]] * (unsigned)(K * 2) + CA[i_]; } while (0)
#define PG8_STAGEA(bufoff, kb, vo) do { _Pragma("unroll") for (int _i = 0; _i < 2; ++_i) \
        __builtin_amdgcn_global_load_lds((const unsigned*)((const char*)g.A + (size_t)(kb) + (vo)[_i]), (PG8_LAS unsigned*)(lds + (bufoff) + ldsw + _i * 8192), 16, 0, 0); } while (0)
    const size_t kstep = (size_t)(BK * 2);
    const size_t hstep = (size_t)HALF * K * 2;
    const size_t tstep = 2 * hstep;
    const size_t kstepB = BT ? (size_t)32768 : kstep, hstepB = BT ? (size_t)16384 : hstep;
    const unsigned ldsw = (unsigned)wid * 1024u;
    const int aoff = lds_byte(wr * 64 + fr, fq * 8), boff = lds_byte(wc * 32 + fr, fq * 8);
#define PG8_SA(b, h) (((b) * 2 + (h)) * HTB)
#define PG8_SB(b, h) ((4 + (b) * 2 + (h)) * HTB)
#define PG8_STAGE(bufoff, gbase, voff) do { _Pragma("unroll") for (int _i = 0; _i < 2; ++_i) \
        __builtin_amdgcn_global_load_lds((const unsigned*)((const char*)(gbase) + (voff)[_i]), (PG8_LAS unsigned*)(lds + (bufoff) + ldsw + _i * 8192), 16, 0, 0); } while (0)
#define PG8_LDA(dst, b, h) do { _Pragma("unroll") for (int m = 0; m < 4; ++m) { if constexpr (FP8) dst.w[m] = pg8_cat(*(const PG8_LAS bf16x8*)(lds + PG8_SA(b, h) + aoff + m * 2048), *(const PG8_LAS bf16x8*)(lds + PG8_SA(b, h) + aoff + m * 2048 + 1024)); \
        else { _Pragma("unroll") for (int k = 0; k < 2; ++k) dst.v[m][k] = *(const PG8_LAS bf16x8*)(lds + PG8_SA(b, h) + aoff + m * 2048 + k * 1024); } } } while (0)
#define PG8_LDB(dst, b, h) do { _Pragma("unroll") for (int n = 0; n < 2; ++n) { if constexpr (FP8) dst.w[n] = pg8_cat(*(const PG8_LAS bf16x8*)(lds + PG8_SB(b, h) + boff + n * 2048), *(const PG8_LAS bf16x8*)(lds + PG8_SB(b, h) + boff + n * 2048 + 1024)); \
        else { _Pragma("unroll") for (int k = 0; k < 2; ++k) dst.v[n][k] = *(const PG8_LAS bf16x8*)(lds + PG8_SB(b, h) + boff + n * 2048 + k * 1024); } } } while (0)
#define PG8_MMA(ai, bj, At, Bt) do { __builtin_amdgcn_s_setprio(1); if constexpr (FP8) { _Pragma("unroll") for (int m = 0; m < 4; ++m) _Pragma("unroll") for (int n = 0; n < 2; ++n) \
        asm volatile("v_mfma_f32_16x16x128_f8f6f4 %0, %1, %2, %0" : "+v"(acc[ai][bj][m][n]) : "v"(Bt.w[n]), "v"(At.w[m])); } \
        else { _Pragma("unroll") for (int m = 0; m < 4; ++m) _Pragma("unroll") for (int n = 0; n < 2; ++n) _Pragma("unroll") for (int k = 0; k < 2; ++k) \
        acc[ai][bj][m][n] = __builtin_amdgcn_mfma_f32_16x16x32_bf16(Bt.v[n][k], At.v[m][k], acc[ai][bj][m][n], 0, 0, 0); } __builtin_amdgcn_s_setprio(0); } while (0)
#define PG8_WAIT_V(n) asm volatile("s_waitcnt vmcnt(" #n ")" ::: "memory")
#define PG8_WAIT_L(n) asm volatile("s_waitcnt lgkmcnt(" #n ")" ::: "memory")
#define PG8_BAR __builtin_amdgcn_s_barrier()
#define PG8_SCHED __builtin_amdgcn_sched_barrier(0)
    Unit cur, nxt; int ui = 0;
    if (!S.next(0, cur)) return;
    if constexpr (TOUCH) { unsigned a_ = pg8_touch_rows((const char*)g.A, lidx, 2 * g.K) + pg8_touch_lines((const char*)g.Bt + (size_t)cur.pn * (512 * (size_t)g.K), 4 * g.K);
        Unit u1_; if (S.next(1, u1_)) a_ += pg8_touch_rows((const char*)g.A, lidx + 256, 2 * g.K) + pg8_touch_lines((const char*)g.Bt + (size_t)u1_.pn * (512 * (size_t)g.K), 4 * g.K);
        asm volatile("" :: "v"(a_)); }
    f32x4 acc[2][2][4][2];
#pragma unroll
    for (int a = 0; a < 2; ++a)
#pragma unroll
        for (int b = 0; b < 2; ++b)
#pragma unroll
            for (int m = 0; m < 4; ++m)
#pragma unroll
                for (int n = 0; n < 2; ++n) acc[a][b][m][n] = (f32x4){0.f, 0.f, 0.f, 0.f};
    pg8_FragA At; pg8_FragB B0, B1;
    const char* cB = (const char*)g.Bt + (size_t)cur.pn * tstep; PG8_ROWOFF(ca, 0);
    S.a_ready(cur);
    if constexpr (SP2) {
        PG8_STAGE(PG8_SB(0, 0), cB, voffB); PG8_STAGE(PG8_SB(0, 1), cB + hstepB, voffB); PG8_STAGEA(PG8_SA(0, 0), 0, ca[0]); PG8_STAGEA(PG8_SA(0, 1), 0, ca[1]);
        if (wr == 1) PG8_BAR;
        PG8_WAIT_V(2); PG8_BAR;
        PG8_STAGE(PG8_SB(1, 0), cB + kstepB, voffB); PG8_STAGEA(PG8_SA(1, 0), kstep, ca[0]); PG8_STAGE(PG8_SB(1, 1), cB + hstepB + kstepB, voffB);
        PG8_WAIT_V(6); PG8_BAR;
    }
    for (;;) {
        const bool has_next = S.next(ui + 1, nxt);
        const char* nB = has_next ? (const char*)g.Bt + (size_t)nxt.pn * tstep : cB;
        if (has_next) PG8_ROWOFF(na, ui + 1); else { _Pragma("unroll") for (int h_ = 0; h_ < 2; ++h_) _Pragma("unroll") for (int i_ = 0; i_ < 2; ++i_) na[h_][i_] = ca[h_][i_]; }
#pragma unroll 1
        for (int t = 0; t < nt; t += 2) {
            const bool last = (t == nt - 2);
            const size_t k1 = (size_t)(t + 1) * kstep, k2 = last ? (size_t)0 : (size_t)(t + 2) * kstep, k3 = k2 + kstep;
            unsigned o2[2][2];
#pragma unroll
            for (int h_ = 0; h_ < 2; ++h_)
#pragma unroll
                for (int i_ = 0; i_ < 2; ++i_) o2[h_][i_] = last ? na[h_][i_] : ca[h_][i_];
            const char* b2 = last ? nB : cB + (size_t)(t + 2) * kstepB; const char* b3 = b2 + kstepB;
            if (last && has_next) S.a_ready(nxt);
            if constexpr (SP2) {
            PG8_LDB(B0, 0, 0); PG8_LDB(B1, 0, 1); PG8_SCHED; PG8_LDA(At, 0, 0); PG8_STAGEA(PG8_SA(1, 1), k1, ca[1]);
            PG8_WAIT_V(8); PG8_WAIT_L(0); PG8_BAR; PG8_MMA(0, 0, At, B0); PG8_MMA(0, 1, At, B1); PG8_BAR; PG8_SCHED;
            PG8_LDA(At, 0, 1); PG8_STAGE(PG8_SB(0, 0), b2, voffB); PG8_STAGE(PG8_SB(0, 1), b2 + hstepB, voffB); PG8_STAGEA(PG8_SA(0, 0), k2, o2[0]);
            PG8_WAIT_V(8); PG8_WAIT_L(0); PG8_BAR; PG8_MMA(1, 0, At, B0); PG8_MMA(1, 1, At, B1); PG8_BAR; PG8_SCHED;
            PG8_LDB(B0, 1, 0); PG8_LDB(B1, 1, 1); PG8_SCHED; PG8_LDA(At, 1, 0); PG8_STAGEA(PG8_SA(0, 1), k2, o2[1]);
            PG8_WAIT_V(8); PG8_WAIT_L(0); PG8_BAR; PG8_MMA(0, 0, At, B0); PG8_MMA(0, 1, At, B1); PG8_BAR; PG8_SCHED;
            PG8_LDA(At, 1, 1); PG8_STAGE(PG8_SB(1, 0), b3, voffB); PG8_STAGE(PG8_SB(1, 1), b3 + hstepB, voffB); PG8_STAGEA(PG8_SA(1, 0), k3, o2[0]);
            PG8_WAIT_V(8); PG8_WAIT_L(0); PG8_BAR; PG8_MMA(1, 0, At, B0); PG8_MMA(1, 1, At, B1); PG8_BAR; PG8_SCHED;
            }
        }
        if constexpr (ALIGN_EPI) { if (wr == 0) PG8_BAR; }
        if constexpr (FP8) asm volatile("s_nop 15\n\ts_nop 15" ::: "memory");
        if constexpr (!Epi::AFTER_DRAIN) { const int ln_ = (int)__builtin_amdgcn_mbcnt_hi(~0u, __builtin_amdgcn_mbcnt_lo(~0u, 0u)); int fr_ = ln_ & 15, fq_ = ln_ >> 4; asm volatile("" : "+v"(fr_), "+v"(fq_)); E(acc, cur, wr, wc, fr_, fq_); S.done(cur);
            if constexpr (TOUCH) { Unit u2_; if (S.next(ui + 2, u2_)) { const unsigned a_ = pg8_touch_rows((const char*)g.A, lidx + (ui + 2) * 256, 2 * g.K) + pg8_touch_lines((const char*)g.Bt + (size_t)u2_.pn * (512 * (size_t)g.K), 4 * g.K); asm volatile("" :: "v"(a_)); } } }
        if (!has_next) break;
#pragma unroll
        for (int a = 0; a < 2; ++a)
#pragma unroll
            for (int b = 0; b < 2; ++b)
#pragma unroll
                for (int m = 0; m < 4; ++m)
#pragma unroll
                    for (int n = 0; n < 2; ++n) acc[a][b][m][n] = (f32x4){0.f, 0.f, 0.f, 0.f};
        cur = nxt; cB = nB; ++ui;
        { _Pragma("unroll") for (int h_ = 0; h_ < 2; ++h_) _Pragma("unroll") for (int i_ = 0; i_ < 2; ++i_) ca[h_][i_] = na[h_][i_]; }
        if constexpr (ALIGN_EPI) { if (wr == 1) PG8_BAR; }
    }
    PG8_WAIT_V(0);
    if constexpr (!ALIGN_EPI) { if (wr == 0) PG8_BAR; }
    PG8_BAR;
    if constexpr (Epi::AFTER_DRAIN) { E.fused(acc, cur, wr, wc, fr, fq, lds, wid, lane); S.done(cur); }
#undef PG8_SA
#undef PG8_ROWOFF
#undef PG8_STAGEA
#undef PG8_SB
#undef PG8_STAGE
#undef PG8_LDA
#undef PG8_LDB
#undef PG8_MMA
#undef PG8_WAIT_V
#undef PG8_WAIT_L
#undef PG8_BAR
#undef PG8_SCHED
}
}

constexpr int NB = 2, SEQ = 16384, T = NB * SEQ, D = 1024;
constexpr float EPS = 1e-6f;
constexpr int NWAVES = 8, NTHR = 512;
constexpr int N_IN = 55;
__host__ __device__ constexpr int LBASE(int L) { return L == 0 ? 2 : (L == 1 ? 15 : (L == 2 ? 29 : 42)); }
__host__ __device__ constexpr int NMIX(int L) { return L == 1 ? 6 : 5; }

constexpr size_t MiB = 1u << 20;
constexpr size_t WS_CTL = 0, CTL_ZERO_BYTES = 1 * MiB;
constexpr size_t WS_MOD = 1 * MiB;
constexpr size_t WS_CNT = WS_MOD + 256 * 1024;
constexpr size_t WS_TILEE = WS_CNT + 64 * 1024;
constexpr size_t WS_EID = 2 * MiB;
constexpr size_t WS_GATE = WS_EID + 256 * 1024;
constexpr size_t WS_SLOT = WS_GATE + 256 * 1024;
constexpr size_t WS_VSSP = 3 * MiB;
constexpr size_t WS_BA = 5 * MiB;
constexpr size_t WS_DNB = 7 * MiB;
constexpr size_t WS_RTR = 9 * MiB;
constexpr size_t WS_WBA = 11 * MiB;
constexpr size_t WS_TOK = 12 * MiB;
constexpr size_t WS_W = 16 * MiB;
constexpr size_t WL_STRIDE = 48 * MiB, WL_OUT = 32 * MiB;
constexpr size_t WS_WMIX = WS_W + 4 * WL_STRIDE;
constexpr size_t WMIX_GM_IN0 = 0, WMIX_GM_OUT0 = 4 * MiB, WMIX_DN_IN = 6 * MiB, WMIX_DN_OUT = 13 * MiB, WMIX_SWA_IN = 15 * MiB, WMIX_SWA_OUT = 18 * MiB, WMIX_GM_IN3 = 20 * MiB, WMIX_GM_OUT3 = 24 * MiB;
constexpr size_t WS_ACT = 240 * MiB;
constexpr size_t A_H = 0;
constexpr size_t A_U = 64 * MiB, A_V = 128 * MiB, A_GATED = 192 * MiB;
constexpr size_t A_QKV = 64 * MiB, A_Z = 192 * MiB, A_QN = 256 * MiB, A_KN = 288 * MiB, A_VV = 320 * MiB, A_FA = 384 * MiB, A_FB = 484 * MiB, A_FU = 64 * MiB, A_O = 128 * MiB, A_SFR = 548 * MiB, A_VFR = 676 * MiB;
constexpr size_t A_XG = 64 * MiB, A_ACTV = 208 * MiB, A_Y = 280 * MiB;
constexpr size_t WS_X16B = WS_ACT + 548 * MiB;
constexpr size_t WS_END = WS_ACT + 740 * MiB;
constexpr int MAXROWS = 73728;

constexpr int RING_BYTES = 131072;
constexpr int LDSCTL_OFF = RING_BYTES, MISC_OFF = LDSCTL_OFF + 320;
constexpr int LDS_BYTES = 147456;

#define LAS __attribute__((address_space(3)))
typedef unsigned short bf16;
typedef unsigned v4u __attribute__((ext_vector_type(4)));
typedef unsigned v2u __attribute__((ext_vector_type(2)));
typedef float f32x4 __attribute__((ext_vector_type(4)));
typedef short bf16x8 __attribute__((ext_vector_type(8)));
typedef short bf16x4 __attribute__((ext_vector_type(4)));
#define LDS_WAIT() asm volatile("s_waitcnt lgkmcnt(0)" ::: "memory")
#define VM_WAIT() asm volatile("s_waitcnt vmcnt(0)" ::: "memory")
__device__ __forceinline__ unsigned pk2(float lo, float hi) { return pg8::cvt_pk_bf16(lo, hi); }
__device__ __forceinline__ float bflo(unsigned w) { return __uint_as_float(w << 16); }
__device__ __forceinline__ float bfhi(unsigned w) { return __uint_as_float(w & 0xffff0000u); }
__device__ __forceinline__ float bf1(unsigned short b) { return __uint_as_float(((unsigned)b) << 16); }
__device__ __forceinline__ float wave_sum(float v) {
#pragma unroll
    for (int o = 1; o < 64; o <<= 1) v += __shfl_xor(v, o);
    return v;
}
__device__ __forceinline__ float fast_exp(float x) { return __builtin_amdgcn_exp2f(x * 1.44269504089f); }
__device__ __forceinline__ float sigmoidf_(float x) { return __builtin_amdgcn_rcpf(1.0f + fast_exp(-x)); }
__device__ __forceinline__ float siluf_(float x) { return x * sigmoidf_(x); }
__device__ __forceinline__ float gelu_tanh(float x) { const float y = 1.5957691216057308f * (x + 0.044715f * x * x * x); return x * __builtin_amdgcn_rcpf(1.0f + fast_exp(-y)); }

__device__ __forceinline__ f32x4 gelu_tanh4(const f32x4 x) { const f32x4 t = x * x; const f32x4 p = t * -0.10294324f + -2.30220819f; const f32x4 ea = p * x; f32x4 e;
#pragma unroll
    for (int j = 0; j < 4; ++j) e[j] = __builtin_amdgcn_exp2f(ea[j]);
    const f32x4 d = e + 1.0f; f32x4 rc;
#pragma unroll
    for (int j = 0; j < 4; ++j) rc[j] = __builtin_amdgcn_rcpf(d[j]);
    return x * rc; }
#define RLX_AGENT __ATOMIC_RELAXED, __HIP_MEMORY_SCOPE_AGENT
__device__ __forceinline__ unsigned char* uni_ptr(unsigned char* p) { const unsigned long long w = (unsigned long long)p; const unsigned lo = __builtin_amdgcn_readfirstlane((unsigned)w), hi = __builtin_amdgcn_readfirstlane((unsigned)(w >> 32)); return (unsigned char*)(__attribute__((address_space(1))) unsigned char*)(((unsigned long long)hi << 32) | lo); }
__device__ __forceinline__ unsigned pk4_fp8(float a, float b, float c, float d) { int w = __builtin_amdgcn_cvt_pk_fp8_f32(a, b, 0, false); w = __builtin_amdgcn_cvt_pk_fp8_f32(c, d, w, true); return (unsigned)w; }
#define XB_TMO      128
#define XB_XCNT(j)  (256  + 64 * (j))
#define XB_XSUB(j)  (1280 + 64 * (j))
#define XB_XGEN(j)  (2304 + 64 * (j))
#define XB_TOP      3328
#define XB_TOPGEN   3392
#define XCD_BAR_WORDS 3456
#define XB_SPIN_CAP (1u << 18)

__device__ __forceinline__ unsigned xb_ld(unsigned* p)              { return __hip_atomic_load(p, __ATOMIC_RELAXED, __HIP_MEMORY_SCOPE_AGENT); }
__device__ __forceinline__ unsigned xb_add(unsigned* p, unsigned v) { return __hip_atomic_fetch_add(p, v, __ATOMIC_RELAXED, __HIP_MEMORY_SCOPE_AGENT); }
__device__ __forceinline__ unsigned xb_xcc_id() { return (unsigned)__builtin_amdgcn_s_getreg((3 << 11) | 20) & 0xFu; }
#define XB_SPIN(cond, bar) do { unsigned _sp = 0; while (cond) { __builtin_amdgcn_s_sleep(1); \
    if ((++_sp & 255u) == 0u) { if (xb_ld(&(bar)[XB_TMO])) break; if (_sp > XB_SPIN_CAP) { atomicAdd(&(bar)[XB_TMO], 1u); break; } } } } while (0)

struct XcdBarrier {
    unsigned* bar; unsigned x;
    volatile LAS unsigned* st;
};

__device__ __forceinline__ XcdBarrier xcd_barrier_post(unsigned* bar, volatile LAS unsigned* st) {
    XcdBarrier b; b.bar = bar; b.x = xb_xcc_id(); b.st = st;
    if (threadIdx.x == 0) (void)xb_add(&bar[XB_XCNT(b.x)], 1u);
    return b;
}
__device__ __forceinline__ void xcd_barrier_complete(unsigned* bar, unsigned x, unsigned& nloc, unsigned& nx) {
    const unsigned G = gridDim.x * gridDim.y * gridDim.z;
    unsigned sum, cnt, mine, sp = 0u;
    for (;;) {
        sum = 0u; cnt = 0u; mine = 0u;
#pragma unroll
        for (unsigned j = 0; j < 16; ++j) { const unsigned c = xb_ld(&bar[XB_XCNT(j)]); sum += c; cnt += (c > 0u) ? 1u : 0u; mine = (j == x) ? c : mine; }
        if (sum == G) break;
        __builtin_amdgcn_s_sleep(1);
        if ((++sp & 255u) == 0u) { if (xb_ld(&bar[XB_TMO])) break; if (sp > XB_SPIN_CAP) { atomicAdd(&bar[XB_TMO], 1u); break; } }
    }
    nloc = mine > 0u ? mine : 1u; nx = cnt > 0u ? cnt : 1u;
}

__device__ __forceinline__ void xcd_barrier(const XcdBarrier& b) {
    asm volatile("s_waitcnt vmcnt(0)" ::: "memory");
    __syncthreads();
    if (threadIdx.x == 0) {
        unsigned* bar = b.bar;
        __builtin_amdgcn_s_waitcnt(0);
        unsigned nloc = b.st[0], nx = b.st[1];
        if (nloc == 0u) { xcd_barrier_complete(bar, b.x, nloc, nx); b.st[0] = nloc; b.st[1] = nx; }
        const unsigned old = xb_add(&bar[XB_XSUB(b.x)], 1u);
        const unsigned gen = old / nloc;
        if (old + 1u == (gen + 1u) * nloc) {
            __builtin_amdgcn_fence(__ATOMIC_RELEASE, "agent");
            asm volatile("s_waitcnt vmcnt(0)" ::: "memory");
            const unsigned og = xb_add(&bar[XB_TOP], 1u);
            const unsigned tg = og / nx;
            if (og + 1u == (tg + 1u) * nx) xb_add(&bar[XB_TOPGEN], 1u);
            else XB_SPIN(xb_ld(&bar[XB_TOPGEN]) == tg, bar);
            __builtin_amdgcn_fence(__ATOMIC_ACQUIRE, "agent");
            xb_add(&bar[XB_XGEN(b.x)], 1u);
            asm volatile("s_waitcnt vmcnt(0)" ::: "memory");
        } else {
            XB_SPIN(xb_ld(&bar[XB_XGEN(b.x)]) == gen, bar);
            __builtin_amdgcn_fence(__ATOMIC_ACQUIRE, "agent");
            asm volatile("s_waitcnt vmcnt(0)" ::: "memory");
        }
    }
    __syncthreads();
}

typedef const pg8::f32x4 (&AccRef)[2][2][4][2];

struct EpiGm1 {
    static constexpr bool PERM = true, AFTER_DRAIN = false;
    bf16* U; bf16* V; float* vssp;
    __device__ __forceinline__ void operator()(AccRef acc, const pg8::Unit& u, int wr, int wc, int fr, int fq) const {
        const int row0 = u.pm * 256 + wr * 64 + fr; const bool isV = u.pn >= 4; const int col0 = (u.pn & 3) * 256 + wc * 32 + 8 * fq;
        bf16* base = isV ? V : U;
#pragma unroll
        for (int ai = 0; ai < 2; ++ai)
#pragma unroll
            for (int m = 0; m < 4; ++m) { const int row = row0 + ai * 128 + m * 16; bf16* rowp = base + (size_t)row * 1024 + col0; float ss = 0.f;
#pragma unroll
                for (int bj = 0; bj < 2; ++bj) { const f32x4 v0 = gelu_tanh4(acc[ai][bj][m][0]), v1 = gelu_tanh4(acc[ai][bj][m][1]);
                    { const f32x4 s4 = v0 * v0 + v1 * v1; ss += (s4[0] + s4[1]) + (s4[2] + s4[3]); }
                    v4u w; w.x = pk2(v0[0], v0[1]); w.y = pk2(v0[2], v0[3]); w.z = pk2(v1[0], v1[1]); w.w = pk2(v1[2], v1[3]);
                    *(v4u*)(rowp + bj * 128) = w; }
                if (isV) { ss += __shfl_xor(ss, 16); ss += __shfl_xor(ss, 32); if (fq == 0) vssp[(size_t)row * 16 + (u.pn - 4) * 4 + wc] = ss; } }
    }
};
template <bool SRC16>
struct EpiRes {
    static constexpr bool PERM = true, AFTER_DRAIN = false;
    const void* src; bf16* dst; const float* gate;
    __device__ __forceinline__ void operator()(AccRef acc, const pg8::Unit& u, int wr, int wc, int fr, int fq) const {
        const int row0 = u.pm * 256 + wr * 64 + fr, col0 = u.pn * 256 + wc * 32 + 8 * fq; const int b = (u.pm * 256) / SEQ;
        f32x4 gv[2][2];
#pragma unroll
        for (int bj = 0; bj < 2; ++bj)
#pragma unroll
            for (int n = 0; n < 2; ++n) gv[bj][n] = *(const f32x4*)(gate + (size_t)b * 6144 + col0 + bj * 128 + n * 4);
#pragma unroll
        for (int ai = 0; ai < 2; ++ai)
#pragma unroll
            for (int m = 0; m < 4; ++m) { const size_t off = (size_t)(row0 + ai * 128 + m * 16) * 1024 + col0;
#pragma unroll
                for (int bj = 0; bj < 2; ++bj) { f32x4 x0, x1;
                    if constexpr (SRC16) { const v4u w = *(const v4u*)((const bf16*)src + off + bj * 128); x0 = (f32x4){bflo(w.x), bfhi(w.x), bflo(w.y), bfhi(w.y)}; x1 = (f32x4){bflo(w.z), bfhi(w.z), bflo(w.w), bfhi(w.w)}; }
                    else { x0 = *(const f32x4*)((const float*)src + off + bj * 128); x1 = *(const f32x4*)((const float*)src + off + bj * 128 + 4); }
                    const f32x4 v0 = x0 + gv[bj][0] * acc[ai][bj][m][0], v1 = x1 + gv[bj][1] * acc[ai][bj][m][1];
                    v4u o; o.x = pk2(v0[0], v0[1]); o.y = pk2(v0[2], v0[3]); o.z = pk2(v1[0], v1[1]); o.w = pk2(v1[2], v1[3]);
                    *(v4u*)(dst + off + bj * 128) = o; } }
    }
};
struct EpiBf {
    static constexpr bool PERM = true, AFTER_DRAIN = false;
    bf16* O; int ldc; int nmask; float scale;
    __device__ __forceinline__ void operator()(AccRef acc, const pg8::Unit& u, int wr, int wc, int fr, int fq) const {
        const int row0 = u.pm * 256 + wr * 64 + fr, col0 = (u.pn & nmask) * 256 + wc * 32 + 8 * fq;
#pragma unroll
        for (int ai = 0; ai < 2; ++ai)
#pragma unroll
            for (int m = 0; m < 4; ++m) { bf16* rowp = O + (size_t)(row0 + ai * 128 + m * 16) * ldc + col0;
#pragma unroll
                for (int bj = 0; bj < 2; ++bj) { const f32x4 v0 = acc[ai][bj][m][0] * scale, v1 = acc[ai][bj][m][1] * scale;
                    v4u w; w.x = pk2(v0[0], v0[1]); w.y = pk2(v0[2], v0[3]); w.z = pk2(v1[0], v1[1]); w.w = pk2(v1[2], v1[3]);
                    *(v4u*)(rowp + bj * 128) = w; } }
    }
};
struct EpiF8 {
    static constexpr bool PERM = true, AFTER_DRAIN = false;
    unsigned char* O; int ldc; int nmask; float scale;
    __device__ __forceinline__ void operator()(AccRef acc, const pg8::Unit& u, int wr, int wc, int fr, int fq) const {
        const int row0 = u.pm * 256 + wr * 64 + fr, col0 = (u.pn & nmask) * 256 + wc * 32 + 8 * fq;
#pragma unroll
        for (int ai = 0; ai < 2; ++ai)
#pragma unroll
            for (int m = 0; m < 4; ++m) { unsigned char* rowp = O + (size_t)(row0 + ai * 128 + m * 16) * ldc + col0;
#pragma unroll
                for (int bj = 0; bj < 2; ++bj) { const f32x4 v0 = acc[ai][bj][m][0] * scale, v1 = acc[ai][bj][m][1] * scale;
                    v2u w; w.x = pk4_fp8(v0[0], v0[1], v0[2], v0[3]); w.y = pk4_fp8(v1[0], v1[1], v1[2], v1[3]);
                    *(v2u*)(rowp + bj * 128) = w; } }
    }
};
struct EpiDn1 {
    static constexpr bool PERM = true, AFTER_DRAIN = false;
    bf16* QKV; bf16* Z; float* BA;
    __device__ __forceinline__ void operator()(AccRef acc, const pg8::Unit& u, int wr, int wc, int fr, int fq) const {
        const int row0 = u.pm * 256 + wr * 64 + fr;
        if (u.pn < 12) {
            bf16* base = u.pn < 8 ? QKV : Z; const int ldc = u.pn < 8 ? 2048 : 1024; const int col0 = (u.pn < 8 ? u.pn : u.pn - 8) * 256 + wc * 32 + 8 * fq;
#pragma unroll
            for (int ai = 0; ai < 2; ++ai)
#pragma unroll
                for (int m = 0; m < 4; ++m) { bf16* rowp = base + (size_t)(row0 + ai * 128 + m * 16) * ldc + col0;
#pragma unroll
                    for (int bj = 0; bj < 2; ++bj) { const f32x4 v0 = acc[ai][bj][m][0], v1 = acc[ai][bj][m][1];
                        v4u w; w.x = pk2(v0[0], v0[1]); w.y = pk2(v0[2], v0[3]); w.z = pk2(v1[0], v1[1]); w.w = pk2(v1[2], v1[3]);
                        *(v4u*)(rowp + bj * 128) = w; } }
        } else if (wc == 0 && fq < 2) {
#pragma unroll
            for (int ai = 0; ai < 2; ++ai)
#pragma unroll
                for (int m = 0; m < 4; ++m) { float* rowp = BA + (size_t)(row0 + ai * 128 + m * 16) * 16 + 8 * fq;
                    *(f32x4*)(rowp) = acc[ai][0][m][0]; *(f32x4*)(rowp + 4) = acc[ai][0][m][1]; }
        }
    }
};
struct EpiMoe1 {
    static constexpr bool PERM = true, AFTER_DRAIN = false;
    unsigned char* O;
    __device__ __forceinline__ void operator()(AccRef acc, const pg8::Unit& u, int wr, int wc, int fr, int fq) const {
        const int row0 = u.pm * 256 + wr * 64 + fr, col0 = (u.pn & 3) * 128 + wc * 32 + 8 * fq;
#pragma unroll
        for (int ai = 0; ai < 2; ++ai)
#pragma unroll
            for (int m = 0; m < 4; ++m) { unsigned char* rowp = O + (size_t)(row0 + ai * 128 + m * 16) * 512 + col0; float r[8];
#pragma unroll
                for (int n = 0; n < 2; ++n) {
                    const f32x4 A = acc[ai][0][m][n], Gv = acc[ai][1][m][n]; const f32x4 ea = A * (-1.44269504089f * 0.03125f); f32x4 e;
#pragma unroll
                    for (int j = 0; j < 4; ++j) e[j] = __builtin_amdgcn_exp2f(ea[j]);
                    const f32x4 d = e * 1024.0f + 1024.0f; f32x4 rc;
#pragma unroll
                    for (int j = 0; j < 4; ++j) rc[j] = __builtin_amdgcn_rcpf(d[j]);
                    const f32x4 o = (A * Gv) * rc;
#pragma unroll
                    for (int j = 0; j < 4; ++j) r[4 * n + j] = o[j]; }
                v2u w; w.x = pk4_fp8(r[0], r[1], r[2], r[3]); w.y = pk4_fp8(r[4], r[5], r[6], r[7]);
                *(v2u*)rowp = w; }
    }
};
struct MoeOrder {
    const LAS int* tile_e; int total, G, c;
    __device__ __forceinline__ void init(const LAS int* te, int ntiles, int G_, int c_) { tile_e = te; total = ntiles * 4; G = G_; c = c_; }
    __device__ __forceinline__ bool next(int i, pg8::Unit& u) const {
        const long Lx = (long)i * G + c; if (Lx >= total) return false;
        const int w0 = (int)Lx, q = total / 8, r = total % 8, xcd = w0 % 8, off = w0 / 8;
        const int wgid = (xcd < r ? xcd * (q + 1) : r * (q + 1) + (xcd - r) * q) + off;
        const int rt = wgid >> 2; u.pm = rt; u.pn = tile_e[rt] * 4 + (wgid & 3); return true;
    }
    __device__ __forceinline__ void a_ready(const pg8::Unit&) const {}
    __device__ __forceinline__ void done(const pg8::Unit&) const {}
};

struct EpiMoe1P {
    static constexpr bool PERM = true, AFTER_DRAIN = false;
    bf16* O;
    __device__ __forceinline__ void operator()(AccRef acc, const pg8::Unit& u, int wr, int wc, int fr, int fq) const {
        const int row0 = u.pm * 256 + wr * 64 + fr, col0 = (u.pn & 3) * 128 + wc * 32 + 8 * fq;
#pragma unroll
        for (int ai = 0; ai < 2; ++ai)
#pragma unroll
            for (int m = 0; m < 4; ++m) { unsigned long long* rowp = (unsigned long long*)(O + (size_t)(row0 + ai * 128 + m * 16) * 512 + col0); float r[8];
#pragma unroll
                for (int n = 0; n < 2; ++n)
#pragma unroll
                    for (int j = 0; j < 4; ++j) { const float a = acc[ai][0][m][n][j], g = acc[ai][1][m][n][j]; r[4 * n + j] = siluf_(a) * g; }
                const unsigned long long w0 = (unsigned long long)pk2(r[0], r[1]) | ((unsigned long long)pk2(r[2], r[3]) << 32), w1 = (unsigned long long)pk2(r[4], r[5]) | ((unsigned long long)pk2(r[6], r[7]) << 32);
                __hip_atomic_store(rowp, w0, __ATOMIC_RELAXED, __HIP_MEMORY_SCOPE_AGENT); __hip_atomic_store(rowp + 1, w1, __ATOMIC_RELAXED, __HIP_MEMORY_SCOPE_AGENT); }
    }
};
struct MoeOrderPub : MoeOrder {
    unsigned* cnt;
    __device__ __forceinline__ void done(const pg8::Unit& u) const {
        asm volatile("s_waitcnt vmcnt(0)" ::: "memory");
        if ((threadIdx.x & 63) == 0) __hip_atomic_fetch_add(cnt + 64 * u.pm, 1u, __ATOMIC_RELAXED, __HIP_MEMORY_SCOPE_AGENT);
    }
};
struct MoeOrderWait : MoeOrder {
    const unsigned* cnt; unsigned* tmo;
    __device__ __forceinline__ void a_ready(const pg8::Unit& u) const {
        if (threadIdx.x < 64) {
            const unsigned long long t0 = __builtin_amdgcn_s_memrealtime(); unsigned polls = 0;
            while ((unsigned)__builtin_amdgcn_readfirstlane(__hip_atomic_load(cnt + 64 * u.pm, __ATOMIC_RELAXED, __HIP_MEMORY_SCOPE_AGENT)) < 32u) {
                if ((++polls & 255u) == 0u && __builtin_amdgcn_readfirstlane(__hip_atomic_load(tmo, __ATOMIC_RELAXED, __HIP_MEMORY_SCOPE_AGENT)) != 0u) break;
                if (__builtin_amdgcn_s_memrealtime() - t0 > 2000000ull) { if (threadIdx.x == 0) __hip_atomic_store(tmo, 1u, __ATOMIC_RELAXED, __HIP_MEMORY_SCOPE_AGENT); break; }
                __builtin_amdgcn_s_sleep(2); }
            __builtin_amdgcn_fence(__ATOMIC_ACQUIRE, "agent");
            asm volatile("s_waitcnt vmcnt(0)" ::: "memory");
        }
        asm volatile("" ::: "memory"); __builtin_amdgcn_s_barrier(); asm volatile("" ::: "memory");
    }
};

struct Args { const float* in[N_IN]; float* out; unsigned char* ws; int ph_lo, ph_hi, li, pad; };

__device__ __forceinline__ void tr_item(const float* __restrict__ W, int ldn, int k0, int n0, bf16* __restrict__ WT, int Kd, int drow0, LAS float* scr, int lane) {
#pragma unroll 8
    for (int i = 0; i < 32; ++i) { const int kk = 2 * i + (lane >> 5); scr[kk * 33 + (lane & 31)] = W[(size_t)(k0 + kk) * ldn + n0 + (lane & 31)]; }
    LDS_WAIT(); asm volatile("" ::: "memory");
    const int c = lane & 7;
#pragma unroll
    for (int j = 0; j < 4; ++j) { const int n = (lane >> 3) + 8 * j; const LAS float* s = scr + (8 * c) * 33 + n;
        v4u o; o.x = pk2(s[0 * 33], s[1 * 33]); o.y = pk2(s[2 * 33], s[3 * 33]); o.z = pk2(s[4 * 33], s[5 * 33]); o.w = pk2(s[6 * 33], s[7 * 33]);
        *(v4u*)(WT + (size_t)(drow0 + n) * Kd + k0 + 8 * c) = o; }
    LDS_WAIT(); asm volatile("" ::: "memory");
}

constexpr int CV_PER_L = 24576, CV_N_EXP = 4 * CV_PER_L, CV_MIX_L01 = 3584, CV_N_MIXI = 1536 + 2048 + 1280 + 1536;
#ifndef CV_SPLIT
#define CV_SPLIT CV_PER_L
#endif
struct CvItem { const float* src; bf16* dst; int ldn, Kd; float qs; };
__device__ __forceinline__ CvItem cv_decode(const Args& args, unsigned char* ws, int it) {
    CvItem c; const float* src; bf16* dst; int ldn, k0, n0, Kd, drow0;
    constexpr int PER_L = CV_PER_L, N_EXP = CV_N_EXP;
    if (it < N_EXP) {
        const int L = it / PER_L; int r = it % PER_L; const int ib = LBASE(L) + 4 + NMIX(L);
        if (r < 16384) { const int e = r >> 9, rr = r & 511; k0 = (rr >> 5) * 64; n0 = (rr & 31) * 32; ldn = 1024; Kd = 1024;
            src = args.in[ib + 2] + (size_t)e * 1048576; dst = (bf16*)(ws + WS_W + (size_t)L * WL_STRIDE + (size_t)e * 1048576);
            drow0 = (n0 < 512) ? ((n0 >> 7) * 256 + (n0 & 127)) : ((((n0 - 512) >> 7) * 256) + 128 + ((n0 - 512) & 127)); }
        else { r -= 16384; const int e = r >> 8, rr = r & 255; k0 = (rr >> 5) * 64; n0 = (rr & 31) * 32; ldn = 1024; Kd = 512;
            src = args.in[ib + 3] + (size_t)e * 524288; dst = (bf16*)(ws + WS_W + (size_t)L * WL_STRIDE + WL_OUT + (size_t)e * 524288); drow0 = n0; }
    } else {
        int r = it - N_EXP; int idx, nblk; size_t woff;
        if (r < 1024) { idx = 6; ldn = 2048; nblk = 64; woff = WMIX_GM_IN0; }
        else if ((r -= 1024) < 512) { idx = 10; ldn = 1024; nblk = 32; woff = WMIX_GM_OUT0; }
        else if ((r -= 512) < 1536) { idx = 19; ldn = 3088; nblk = 96; woff = WMIX_DN_IN; }
        else if ((r -= 1536) < 512) { idx = 24; ldn = 1024; nblk = 32; woff = WMIX_DN_OUT; }
        else if ((r -= 512) < 768) { idx = 33; ldn = 1536; nblk = 48; woff = WMIX_SWA_IN; }
        else if ((r -= 768) < 512) { idx = 37; ldn = 1024; nblk = 32; woff = WMIX_SWA_OUT; }
        else if ((r -= 512) < 1024) { idx = 46; ldn = 2048; nblk = 64; woff = WMIX_GM_IN3; }
        else { r -= 1024; idx = 50; ldn = 1024; nblk = 32; woff = WMIX_GM_OUT3; }
        src = args.in[idx]; dst = (bf16*)(ws + WS_WMIX + woff); k0 = (r / nblk) * 64; n0 = (r % nblk) * 32; Kd = 1024; drow0 = n0;
    }
    c.src = src + (size_t)k0 * ldn + n0; c.ldn = ldn; c.Kd = Kd;
    if (it < N_EXP) { c.qs = ((it % PER_L) < 16384) ? 32.f : 16.f;
        c.dst = (bf16*)((unsigned char*)dst + (size_t)(drow0 >> 8) * (256 * (size_t)Kd) + (size_t)(k0 >> 7) * 32768 + (size_t)(drow0 & 255) * 128 + (k0 & 127)); }
    else { c.qs = 0.f; c.dst = (bf16*)((unsigned char*)dst + (size_t)(drow0 >> 8) * (512 * (size_t)Kd) + (size_t)(k0 >> 6) * 32768 + (size_t)(drow0 & 255) * 128 + (size_t)(k0 & 63) * 2); }
    return c;
}
__device__ __forceinline__ void cv_load(const CvItem& c, f32x4 (&v)[8], int lane) {
    if (c.qs > 0.f) { const float* p = c.src + (size_t)(4 * (lane >> 3)) * c.ldn + 4 * (lane & 7);
#pragma unroll
        for (int i = 0; i < 2; ++i)
#pragma unroll
            for (int r = 0; r < 4; ++r) v[4 * i + r] = __builtin_nontemporal_load((const f32x4*)(p + (size_t)(32 * i + r) * c.ldn)); }
    else { const float* p = c.src + (size_t)(2 * (lane >> 3)) * c.ldn + 4 * (lane & 7);
#pragma unroll
        for (int i = 0; i < 4; ++i) { v[2 * i] = __builtin_nontemporal_load((const f32x4*)(p + (size_t)(16 * i) * c.ldn)); v[2 * i + 1] = __builtin_nontemporal_load((const f32x4*)(p + (size_t)(16 * i + 1) * c.ldn)); } }
}
__device__ __forceinline__ void cv_store(const CvItem& c, const f32x4 (&v)[8], LAS float* scr, int lane) {
    LAS unsigned* su = (LAS unsigned*)scr; const int kp = lane >> 3, n4 = 4 * (lane & 7);
    if (c.qs > 0.f) {
#pragma unroll
        for (int i = 0; i < 2; ++i) { LAS unsigned* q = su + (kp + 8 * i) * 33 + n4;
#pragma unroll
            for (int e = 0; e < 4; ++e) q[e] = pk4_fp8(v[4 * i][e] * c.qs, v[4 * i + 1][e] * c.qs, v[4 * i + 2][e] * c.qs, v[4 * i + 3][e] * c.qs); }
        LDS_WAIT(); asm volatile("" ::: "memory");
        const int n = lane >> 1, hf = lane & 1; const LAS unsigned* s = su + (8 * hf) * 33 + n;
        v4u o0, o1; o0.x = s[0]; o0.y = s[33]; o0.z = s[66]; o0.w = s[99]; o1.x = s[132]; o1.y = s[165]; o1.z = s[198]; o1.w = s[231];
        unsigned char* d = (unsigned char*)c.dst + (size_t)n * 128 + 32 * hf; *(v4u*)d = o0; *(v4u*)(d + 16) = o1;
        LDS_WAIT(); asm volatile("" ::: "memory");
        return; }
#pragma unroll
    for (int i = 0; i < 4; ++i) { LAS unsigned* q = su + (kp + 8 * i) * 33 + n4;
#pragma unroll
        for (int e = 0; e < 4; ++e) q[e] = pk2(v[2 * i][e], v[2 * i + 1][e]); }
    LDS_WAIT(); asm volatile("" ::: "memory");
    const int ck = lane & 7;
#pragma unroll
    for (int j = 0; j < 4; ++j) { const int n = (lane >> 3) + 8 * j; const LAS unsigned* s = su + (4 * ck) * 33 + n;
        v4u o; o.x = s[0]; o.y = s[33]; o.z = s[66]; o.w = s[99];
        *(v4u*)((unsigned char*)c.dst + (size_t)n * 128 + 16 * ck) = o; }
    LDS_WAIT(); asm volatile("" ::: "memory");
}
__device__ __forceinline__ void convert_weights(const Args& args, LAS unsigned char* lds, int it_lo, int it_hi, int gw, int NGW) {
    int tid_ = threadIdx.x; asm volatile("" : "+v"(tid_)); const int lane = tid_ & 63, wave = __builtin_amdgcn_readfirstlane(tid_ >> 6);
    unsigned char* ws = uni_ptr(args.ws);
    LAS float* scr = (LAS float*)(lds + wave * 8448);
    for (int it = it_lo + 4 * gw; it < it_hi; it += 4 * NGW) {
        const CvItem c0 = cv_decode(args, ws, it);
        const size_t dstep = (size_t)32 * 128;
        f32x4 v[4][8];
#pragma unroll
        for (int j = 0; j < 4; ++j) { CvItem c = c0; c.src = c0.src + 32 * j; cv_load(c, v[j], lane); }
#pragma unroll
        for (int j = 0; j < 4; ++j) { CvItem c = c0; c.dst = (bf16*)((unsigned char*)c0.dst + j * dstep); cv_store(c, v[j], scr, lane); }
    }
}
__device__ __forceinline__ void phase_prologue(const Args& args, LAS unsigned char* lds) {
    int tid_ = threadIdx.x; asm volatile("" : "+v"(tid_)); const int tid = tid_, lane = tid & 63, wave = __builtin_amdgcn_readfirstlane(tid >> 6), G = gridDim.x, bid = blockIdx.x; (void)tid; (void)lane; (void)wave;
    unsigned char* ws = uni_ptr(args.ws);
    LAS float* cact = (LAS float*)(lds + 69632);
    LAS float* red = (LAS float*)(lds + 77824);
    for (int k = tid; k < 2048; k += NTHR) cact[k] = siluf_(args.in[1][k]);
    __syncthreads();
    float* MOD = (float*)(ws + WS_MOD);
    for (int item = bid; item < 384; item += G) {
        const int L = item / 96, cg = item % 96, c4 = tid & 15, ks = tid >> 4;
        const float* w = args.in[LBASE(L) + 2] + (size_t)(ks * 32) * 6144 + cg * 64 + c4 * 4;
        f32x4 a0 = {0.f, 0.f, 0.f, 0.f}, a1 = {0.f, 0.f, 0.f, 0.f};
#pragma unroll 32
        for (int kk = 0; kk < 32; ++kk) { const f32x4 wv = *(const f32x4*)(w + (size_t)kk * 6144); a0 += cact[ks * 32 + kk] * wv; a1 += cact[1024 + ks * 32 + kk] * wv; }
        *(LAS f32x4*)(red + (ks * 2 + 0) * 64 + c4 * 4) = a0; *(LAS f32x4*)(red + (ks * 2 + 1) * 64 + c4 * 4) = a1;
        __syncthreads();
        if (tid < 128) { const int b = tid >> 6, col = tid & 63; float s = 0.f;
#pragma unroll
            for (int k2 = 0; k2 < 32; ++k2) s += red[(k2 * 2 + b) * 64 + col];
            MOD[(size_t)(L * 2 + b) * 6144 + cg * 64 + col] = s + args.in[LBASE(L) + 3][cg * 64 + col]; }
        __syncthreads();
    }
    { const int gw = bid * NWAVES + wave, NGW = G * NWAVES;
      if (G > 128) { convert_weights(args, lds, 0, CV_SPLIT, gw, NGW); convert_weights(args, lds, CV_N_EXP, CV_N_EXP + CV_MIX_L01, gw, NGW); }
      else convert_weights(args, lds, 0, CV_N_EXP + CV_N_MIXI, gw, NGW); }
    const int gt = bid * NTHR + tid, NGT = G * NTHR;
    { bf16* dst = (bf16*)(ws + WS_WBA); const float* w = args.in[19];
      for (int i = gt; i < 16 * 1024; i += NGT) { const int n = i >> 10, k = i & 1023; dst[i] = (bf16)(pk2(w[(size_t)k * 3088 + 3072 + n], 0.f) & 0xffffu); } }
    for (int i = gt; i < 4 * 48 * 1024; i += NGT) {
        const int L = i / 49152, rem = i % 49152, n = rem >> 10, k = rem & 1023;
        const float w = n < 36 ? args.in[LBASE(L) + 4 + NMIX(L)][(size_t)k * 36 + n] : 0.f;
        const unsigned hi = pk2(w, 0.f) & 0xffffu; const float lo = w - bf1((unsigned short)hi);
        bf16* RH = (bf16*)(ws + WS_RTR + (size_t)L * 196608); RH[rem] = (bf16)hi; RH[49152 + rem] = (bf16)(pk2(lo, 0.f) & 0xffffu);
    }
}

__device__ __forceinline__ void dn_ba_tail(const Args& args, LAS unsigned char* lds) {
    int tid_ = threadIdx.x; asm volatile("" : "+v"(tid_)); const int tid = tid_, lane = tid & 63, wave = __builtin_amdgcn_readfirstlane(tid >> 6), G = gridDim.x, bid = blockIdx.x;
    unsigned char* ws = uni_ptr(args.ws); const bf16* H = (const bf16*)(ws + WS_ACT + A_H); const bf16* W = (const bf16*)(ws + WS_WBA); float* BA = (float*)(ws + WS_BA);
    const int r = lane & 15, q = lane >> 4;
    bool staged = false;
    for (int g0 = bid * NWAVES; g0 < T / 16; g0 += G * NWAVES) {
        const int grp = g0 + wave; const bool act = grp < T / 16;
        const bf16* hp = H + (size_t)((act ? grp : 0) * 16 + r) * 1024 + 8 * q;
        bf16x8 hf[32];
#pragma unroll
        for (int s = 0; s < 32; ++s) hf[s] = *(const bf16x8*)(hp + 32 * s);
        if (!staged) { staged = true;
#pragma unroll
            for (int i = 0; i < 4; ++i) { const int idx = tid * 4 + i, n = idx >> 7, c = idx & 127; *(LAS v4u*)(lds + n * 2064 + c * 16) = *(const v4u*)(W + (size_t)n * 1024 + c * 8); }
            __syncthreads(); }
        f32x4 acc = {0.f, 0.f, 0.f, 0.f};
#pragma unroll
        for (int s = 0; s < 32; ++s) acc = __builtin_amdgcn_mfma_f32_16x16x32_bf16(*(const LAS bf16x8*)(lds + r * 2064 + 64 * s + 16 * q), hf[s], acc, 0, 0, 0);
        if (act) *(f32x4*)(BA + (size_t)(grp * 16 + r) * 16 + 4 * q) = acc;
    }
    __syncthreads();
}
__device__ __forceinline__ void norm_store_row(const f32x4 (&v)[4], const float* __restrict__ gain, const float* __restrict__ shift, const float* __restrict__ scale, bf16* __restrict__ hrow, int lane) {
    float ss = 0.f;
#pragma unroll
    for (int j = 0; j < 4; ++j) ss += (v[j][0] * v[j][0] + v[j][1] * v[j][1]) + (v[j][2] * v[j][2] + v[j][3] * v[j][3]);
    const float rstd = __builtin_amdgcn_rsqf(wave_sum(ss) * (1.0f / 1024.0f) + EPS);
#pragma unroll
    for (int j = 0; j < 4; ++j) { const int c = 4 * lane + 256 * j;
        const f32x4 g = *(const f32x4*)(gain + c), sc = *(const f32x4*)(scale + c), sh = *(const f32x4*)(shift + c);
        const f32x4 h = v[j] * rstd * (g * (1.0f + sc)) + sh;
        v2u w; w.x = pk2(h[0], h[1]); w.y = pk2(h[2], h[3]); *(v2u*)(hrow + c) = w; }
}
__device__ __forceinline__ void phase_norm0(const Args& args, LAS unsigned char* lds) {
    int tid_ = threadIdx.x; asm volatile("" : "+v"(tid_)); const int tid = tid_, lane = tid & 63, wave = __builtin_amdgcn_readfirstlane(tid >> 6), G = gridDim.x, bid = blockIdx.x;
    unsigned char* ws = uni_ptr(args.ws);
    const float* X = args.in[0]; bf16* H = (bf16*)(ws + WS_ACT + A_H); const float* MOD = (const float*)(ws + WS_MOD);
    LAS float* vgs = (LAS float*)lds; LAS float* vsh = vgs + 2048;
    for (int i = tid; i < 2048; i += NTHR) { const int b = i >> 10, k = i & 1023; const float* m = MOD + (size_t)b * 6144; vgs[i] = args.in[2][k] * (1.0f + m[1024 + k]); vsh[i] = m[k]; }
    __syncthreads();
    for (int t = bid * NWAVES + wave; t < T; t += G * NWAVES) { const int b = t / SEQ; f32x4 v[4]; float ss = 0.f;
#pragma unroll
        for (int j = 0; j < 4; ++j) { v[j] = *(const f32x4*)(X + (size_t)t * 1024 + 4 * lane + 256 * j); ss += (v[j][0] * v[j][0] + v[j][1] * v[j][1]) + (v[j][2] * v[j][2] + v[j][3] * v[j][3]); }
        const float rstd = __builtin_amdgcn_rsqf(wave_sum(ss) * (1.0f / 1024.0f) + EPS);
#pragma unroll
        for (int j = 0; j < 4; ++j) { const int c = 4 * lane + 256 * j; const f32x4 gsv = *(const LAS f32x4*)(vgs + b * 1024 + c), shv = *(const LAS f32x4*)(vsh + b * 1024 + c);
            const f32x4 h = v[j] * rstd * gsv + shv; v2u w; w.x = pk2(h[0], h[1]); w.y = pk2(h[2], h[3]); *(v2u*)(H + (size_t)t * 1024 + c) = w; } }
}

__device__ __forceinline__ void phase_gm_spatial(const Args& args, int L, LAS unsigned char* lds) {
    int tid_ = threadIdx.x; asm volatile("" : "+v"(tid_)); const int tid = tid_, lane = tid & 63, wave = __builtin_amdgcn_readfirstlane(tid >> 6), G = gridDim.x, bid = blockIdx.x;
    unsigned char* ws = uni_ptr(args.ws); const int ib = LBASE(L) + 4;
    const float* v_norm = args.in[ib + 1]; const float* w_s = args.in[ib + 2]; const float* b_s = args.in[ib + 3];
    const bf16* U = (const bf16*)(ws + WS_ACT + A_U); const bf16* V = (const bf16*)(ws + WS_ACT + A_V); bf16* GT = (bf16*)(ws + WS_ACT + A_GATED);
    const float* VSSP = (const float*)(ws + WS_VSSP);
    LAS bf16* WL = (LAS bf16*)lds;
    LAS unsigned char* VT = lds + 34816;
    LAS float* rs = (LAS float*)(lds + 67584);
    typedef short s16x4 __attribute__((ext_vector_type(4)));
    const int wr = wave >> 2, wc = wave & 3, fr = lane & 15, fq = lane >> 4;
    const int trw = tid >> 2, sq = (tid & 3) * 32;
    v4u vq[4]; f32x4 wq[8]; float ssq = 0.f;
#define GS_LOAD(u_) do { const int c_ = (u_) >> 3, g_ = (u_) & 7; const unsigned tok0_ = (unsigned)c_ * 128u; \
        _Pragma("unroll") for (int i_ = 0; i_ < 4; ++i_) { const int p_ = tid + 512 * i_, row_ = p_ >> 4, c16_ = p_ & 15; vq[i_] = *(const v4u*)(V + (size_t)(tok0_ + row_) * 1024 + g_ * 128 + c16_ * 8); } \
        const float* wp_ = w_s + ((size_t)g_ * 128 + trw) * 128 + sq; _Pragma("unroll") for (int i_ = 0; i_ < 8; ++i_) wq[i_] = *(const f32x4*)(wp_ + 4 * i_); \
        if (tid < 128) { const float* p_ = VSSP + (size_t)(tok0_ + tid) * 16; float s_ = 0.f; _Pragma("unroll") for (int i_ = 0; i_ < 4; ++i_) { const f32x4 q_ = *(const f32x4*)(p_ + 4 * i_); s_ += (q_[0] + q_[1]) + (q_[2] + q_[3]); } ssq = s_; } } while (0)
    if (bid < 2048) GS_LOAD(bid);
    for (int u = bid; u < 2048; u += G) {
        const int c = u >> 3, g = u & 7; const size_t tok0 = (size_t)c * 128;
        __syncthreads();
        if (tid < 128) rs[tid] = __builtin_amdgcn_rsqf(ssq * (1.0f / 1024.0f) + EPS);
#pragma unroll
        for (int i = 0; i < 4; ++i) { const int p = tid + 512 * i, row = p >> 4, c16 = p & 15; *(LAS v4u*)(VT + row * 256 + (((c16 >> 1) ^ (row & 7)) << 5) + ((c16 & 1) << 4)) = vq[i]; }
        __syncthreads();
#pragma unroll
        for (int i = 0; i < 8; ++i) { float o[4];
#pragma unroll
            for (int e = 0; e < 4; ++e) { const int s = sq + 4 * i + e; o[e] = (s <= trw) ? wq[i][e] * rs[s] : 0.f; }
            v2u w; w.x = pk2(o[0], o[1]); w.y = pk2(o[2], o[3]); *(LAS v2u*)(WL + trw * 136 + sq + 4 * i) = w; }
        __syncthreads();
        if (u + G < 2048) GS_LOAD(u + G);
        f32x4 acc[2][4];
#pragma unroll
        for (int n = 0; n < 2; ++n)
#pragma unroll
            for (int m = 0; m < 4; ++m) acc[n][m] = (f32x4){0.f, 0.f, 0.f, 0.f};
#pragma unroll
        for (int ks = 0; ks < 4; ++ks) {
            if (32 * ks <= 64 * wr + 63) {
                bf16x8 vf[2], wf[4];
#pragma unroll
                for (int n = 0; n < 2; ++n) { const int ct = 2 * wc + n, r0 = 32 * ks + 4 * fq + (fr >> 2), r1 = r0 + 16;
                    const s16x4 lo = __builtin_amdgcn_ds_read_tr16_b64_v4i16((LAS s16x4*)(VT + r0 * 256 + ((ct ^ (r0 & 7)) << 5) + ((fr & 3) << 3)));
                    const s16x4 hi = __builtin_amdgcn_ds_read_tr16_b64_v4i16((LAS s16x4*)(VT + r1 * 256 + ((ct ^ (r1 & 7)) << 5) + ((fr & 3) << 3)));
                    vf[n] = (bf16x8){lo[0], lo[1], lo[2], lo[3], hi[0], hi[1], hi[2], hi[3]}; }
#pragma unroll
                for (int m = 0; m < 4; ++m) { const LAS bf16* wp = WL + (64 * wr + 16 * m + fr) * 136 + 32 * ks + 4 * fq; const v2u lo = *(const LAS v2u*)wp, hi = *(const LAS v2u*)(wp + 16);
                    v4u w; w.x = lo.x; w.y = lo.y; w.z = hi.x; w.w = hi.y; wf[m] = __builtin_bit_cast(bf16x8, w); }
#pragma unroll
                for (int n = 0; n < 2; ++n)
#pragma unroll
                    for (int m = 0; m < 4; ++m) if (32 * ks <= 64 * wr + 16 * m + 15) acc[n][m] = __builtin_amdgcn_mfma_f32_16x16x32_bf16(vf[n], wf[m], acc[n][m], 0, 0, 0);
            } }
#pragma unroll
        for (int m = 0; m < 4; ++m) { const int t = 64 * wr + 16 * m + fr; const float bs = b_s[g * 128 + t];
#pragma unroll
            for (int n = 0; n < 2; ++n) { const int d0 = g * 128 + 32 * wc + 16 * n + 4 * fq; const size_t off = (tok0 + t) * 1024 + d0;
                const v2u uu = *(const v2u*)(U + off); const f32x4 vn = *(const f32x4*)(v_norm + d0);
                const float o0 = bflo(uu.x) * (acc[n][m][0] * vn[0] + bs), o1 = bfhi(uu.x) * (acc[n][m][1] * vn[1] + bs), o2 = bflo(uu.y) * (acc[n][m][2] * vn[2] + bs), o3 = bfhi(uu.y) * (acc[n][m][3] * vn[3] + bs);
                v2u w; w.x = pk2(o0, o1); w.y = pk2(o2, o3); *(v2u*)(GT + off) = w; } }
    }
#undef GS_LOAD
}

__device__ __forceinline__ void phase_swa_attn(const Args& args, LAS unsigned char* lds) {
    int tid_ = threadIdx.x; asm volatile("" : "+v"(tid_)); const int tid = tid_, lane = tid & 63, wave = __builtin_amdgcn_readfirstlane(tid >> 6), G = gridDim.x, bid = blockIdx.x;
    unsigned char* ws = uni_ptr(args.ws);
    const float* q_norm = args.in[34]; const float* k_norm = args.in[35]; const float* sinks = args.in[36];
    const bf16* QKV = (const bf16*)(ws + WS_ACT + A_QKV); bf16* O = (bf16*)(ws + WS_ACT + A_H);
    LAS bf16* KL = (LAS bf16*)lds; LAS unsigned char* VL = lds + 36864; LAS float* nrm = (LAS float*)(lds + 69632);
    if (tid < 64) { nrm[tid] = q_norm[tid]; nrm[64 + tid] = k_norm[tid]; }
    typedef short s16x4 __attribute__((ext_vector_type(4)));
    const int fr = lane & 15, fq = lane >> 4, g = wave >> 1, qh = wave & 1;
    const int kkey = tid >> 1, khalf = tid & 1;
    v4u kq[4], qq[4][2];
#define SW_LOAD(u_) do { const int n_ = (u_) & 127, kvh_ = ((u_) >> 7) & 3, b_ = (u_) >> 9; const unsigned tok0_ = (unsigned)b_ * SEQ + (unsigned)n_ * 128u; \
        { const bool ok_ = (n_ > 0) || (kkey >= 128); const bf16* kp_ = QKV + ((ok_ ? tok0_ - 128u + (unsigned)kkey : tok0_) * 1536u + 1024u + (unsigned)(kvh_ * 64 + khalf * 32)); _Pragma("unroll") for (int i_ = 0; i_ < 4; ++i_) kq[i_] = *(const v4u*)(kp_ + 8 * i_); } \
        } while (0)
#define SW_LOADQ(u_, mt_) do { const int n_ = (u_) & 127, kvh_ = ((u_) >> 7) & 3, b_ = (u_) >> 9; const unsigned tok0_ = (unsigned)b_ * SEQ + (unsigned)n_ * 128u; \
        const bf16* qp_ = QKV + ((tok0_ + (unsigned)(qh * 64 + (mt_) * 16 + fr)) * 1536u + (unsigned)((kvh_ * 4 + g) * 64 + 8 * fq)); qq[mt_][0] = *(const v4u*)qp_; qq[mt_][1] = *(const v4u*)(qp_ + 32); } while (0)
    if (bid < 1024) { SW_LOAD(bid); SW_LOADQ(bid, 0); SW_LOADQ(bid, 1); SW_LOADQ(bid, 2); SW_LOADQ(bid, 3); }
    for (int u = bid; u < 1024; u += G) {
        const int n = u & 127, kvh = (u >> 7) & 3, b = u >> 9; const unsigned tok0 = (unsigned)b * SEQ + (unsigned)n * 128u;
        __syncthreads(); asm volatile("" ::: "memory");
        { float x[32]; float ss = 0.f; const bool ok = (n > 0) || (kkey >= 128);
#pragma unroll
          for (int i = 0; i < 4; ++i) { const unsigned w[4] = {kq[i].x, kq[i].y, kq[i].z, kq[i].w};
#pragma unroll
              for (int e = 0; e < 4; ++e) { x[8 * i + 2 * e] = bflo(w[e]); x[8 * i + 2 * e + 1] = bfhi(w[e]); } }
#pragma unroll
          for (int i = 0; i < 32; ++i) ss += x[i] * x[i];
          ss += __shfl_xor(ss, 1);
          const float rstd = ok ? __builtin_amdgcn_rsqf(ss * (1.0f / 64.0f) + EPS) : 0.f;
#pragma unroll
          for (int i = 0; i < 4; ++i) { float o[8];
#pragma unroll
              for (int e = 0; e < 8; ++e) o[e] = x[8 * i + e] * rstd * nrm[64 + khalf * 32 + 8 * i + e];
              v4u w; w.x = pk2(o[0], o[1]); w.y = pk2(o[2], o[3]); w.z = pk2(o[4], o[5]); w.w = pk2(o[6], o[7]);
              *(LAS v4u*)(KL + kkey * 72 + khalf * 32 + 8 * i) = w; } }
        { v4u vq[4];
#pragma unroll
          for (int i = 0; i < 4; ++i) { const int p = tid + 512 * i, key = p >> 3, c16 = p & 7; const bool ok = (n > 0) || (key >= 128);
              vq[i] = *(const v4u*)(QKV + ((ok ? tok0 - 128u + (unsigned)key : tok0) * 1536u + 1280u + (unsigned)(kvh * 64 + c16 * 8))); if (!ok) vq[i] = (v4u){0u, 0u, 0u, 0u}; }
#pragma unroll
          for (int i = 0; i < 4; ++i) { const int p = tid + 512 * i, key = p >> 3, c16 = p & 7; *(LAS v4u*)(VL + key * 128 + (((c16 >> 1) ^ ((key >> 1) & 3)) << 5) + ((c16 & 1) << 4)) = vq[i]; } }
        __syncthreads();
        if (u + G < 1024) SW_LOAD(u + G);
        const int hq = kvh * 4 + g; const float sink = sinks[hq];
#pragma unroll
        for (int mt = 0; mt < 4; ++mt) {
            asm volatile("" ::: "memory"); __builtin_amdgcn_sched_barrier(0);
            const int qi = qh * 64 + mt * 16 + fr, nb = qh * 4 + mt;
            bf16x8 qf[2];
            { float x[16]; float ss = 0.f;
#pragma unroll
              for (int ks = 0; ks < 2; ++ks) { const unsigned w[4] = {qq[mt][ks].x, qq[mt][ks].y, qq[mt][ks].z, qq[mt][ks].w};
#pragma unroll
                  for (int e = 0; e < 4; ++e) { x[8 * ks + 2 * e] = bflo(w[e]); x[8 * ks + 2 * e + 1] = bfhi(w[e]); } }
#pragma unroll
              for (int i = 0; i < 16; ++i) ss += x[i] * x[i];
              ss += __shfl_xor(ss, 16); ss += __shfl_xor(ss, 32);
              const float rstd = __builtin_amdgcn_rsqf(ss * (1.0f / 64.0f) + EPS) * 0.125f;
#pragma unroll
              for (int ks = 0; ks < 2; ++ks) { float o[8];
#pragma unroll
                  for (int e = 0; e < 8; ++e) o[e] = x[8 * ks + e] * rstd * nrm[32 * ks + 8 * fq + e];
                  v4u w; w.x = pk2(o[0], o[1]); w.y = pk2(o[2], o[3]); w.z = pk2(o[4], o[5]); w.w = pk2(o[6], o[7]); qf[ks] = __builtin_bit_cast(bf16x8, w); } }
            if (u + G < 1024) SW_LOADQ(u + G, mt);
            f32x4 s[10]; float mx = -INFINITY;
#pragma unroll
            for (int i = 0; i < 9; ++i) { const int nt = nb + i; f32x4 a = {0.f, 0.f, 0.f, 0.f};
#pragma unroll
                for (int ks = 0; ks < 2; ++ks) { const bf16x8 kf = *(const LAS bf16x8*)(KL + (16 * nt + fr) * 72 + 32 * ks + 8 * fq); a = __builtin_amdgcn_mfma_f32_16x16x32_bf16(kf, qf[ks], a, 0, 0, 0); }
#pragma unroll
                for (int r = 0; r < 4; ++r) { const int kj = 16 * nt + 4 * fq + r; const bool valid = (kj > qi) && (kj <= qi + 128) && ((n > 0) || (kj >= 128)); a[r] = valid ? a[r] : -INFINITY; mx = fmaxf(mx, a[r]); }
                s[i] = a; }
            mx = fmaxf(mx, __shfl_xor(mx, 16)); mx = fmaxf(mx, __shfl_xor(mx, 32)); mx = fmaxf(mx, sink);
            float l = 0.f;
#pragma unroll
            for (int i = 0; i < 9; ++i)
#pragma unroll
                for (int r = 0; r < 4; ++r) { const float p = fast_exp(s[i][r] - mx); s[i][r] = p; l += p; }
            s[9] = (f32x4){0.f, 0.f, 0.f, 0.f};
            l += __shfl_xor(l, 16); l += __shfl_xor(l, 32); l += fast_exp(sink - mx);
            f32x4 o[4];
#pragma unroll
            for (int dt = 0; dt < 4; ++dt) o[dt] = (f32x4){0.f, 0.f, 0.f, 0.f};
#pragma unroll
            for (int st = 0; st < 5; ++st) {
                v4u pw; pw.x = pk2(s[2 * st][0], s[2 * st][1]); pw.y = pk2(s[2 * st][2], s[2 * st][3]); pw.z = pk2(s[2 * st + 1][0], s[2 * st + 1][1]); pw.w = pk2(s[2 * st + 1][2], s[2 * st + 1][3]);
                const bf16x8 pf = __builtin_bit_cast(bf16x8, pw);
                const int k0 = 16 * (nb + 2 * st) + 4 * fq + (fr >> 2); const int k1r = k0 + 16, k1 = k1r > 255 ? 255 : k1r;
#pragma unroll
                for (int dt = 0; dt < 4; ++dt) {
                    const s16x4 lo = __builtin_amdgcn_ds_read_tr16_b64_v4i16((LAS s16x4*)(VL + k0 * 128 + ((dt ^ ((k0 >> 1) & 3)) << 5) + ((fr & 3) << 3)));
                    const s16x4 hi = __builtin_amdgcn_ds_read_tr16_b64_v4i16((LAS s16x4*)(VL + k1 * 128 + ((dt ^ ((k1 >> 1) & 3)) << 5) + ((fr & 3) << 3)));
                    const bf16x8 vf = (bf16x8){lo[0], lo[1], lo[2], lo[3], hi[0], hi[1], hi[2], hi[3]};
                    o[dt] = __builtin_amdgcn_mfma_f32_16x16x32_bf16(vf, pf, o[dt], 0, 0, 0); } }
            const float inv = 1.0f / l;
#pragma unroll
            for (int dt = 0; dt < 4; ++dt) { v2u w; w.x = pk2(o[dt][0] * inv, o[dt][1] * inv); w.y = pk2(o[dt][2] * inv, o[dt][3] * inv);
                *(v2u*)(O + ((tok0 + (unsigned)qi) * 1024u + (unsigned)(hq * 64 + 16 * dt + 4 * fq))) = w; }
            __builtin_amdgcn_sched_barrier(0);
        }
    }
#undef SW_LOAD
#undef SW_LOADQ
}

__device__ __forceinline__ void phase_dn_prep(const Args& args, LAS unsigned char* lds) {
    int tid_ = threadIdx.x; asm volatile("" : "+v"(tid_)); const int tid = tid_, lane = tid & 63, wave = __builtin_amdgcn_readfirstlane(tid >> 6), G = gridDim.x, bid = blockIdx.x;
    unsigned char* ws = uni_ptr(args.ws); const float* conv_w = args.in[20]; const float* a_log = args.in[21]; const float* dt_bias = args.in[22];
    const bf16* QKV = (const bf16*)(ws + WS_ACT + A_QKV); bf16* QN = (bf16*)(ws + WS_ACT + A_QN); bf16* KN = (bf16*)(ws + WS_ACT + A_KN); bf16* VV = (bf16*)(ws + WS_ACT + A_VV);
    const float* BA = (const float*)(ws + WS_BA); float* DNB = (float*)(ws + WS_DNB);
    constexpr int RUN = 16;
    LAS float* cwl = (LAS float*)lds;
    for (int i = tid; i < 2048; i += NTHR) *(LAS f32x4*)(cwl + 4 * i) = *(const f32x4*)(conv_w + 4 * i);
    __syncthreads();
    const float alg = lane < 8 ? -expf(a_log[lane]) : 0.f, dtb = lane < 8 ? dt_bias[lane] : 0.f;
    for (int run = bid * NWAVES + wave; run < T / RUN; run += G * NWAVES) {
        const int tbeg = run * RUN, pos0 = tbeg % SEQ;
        v4u rows[3][4];
#pragma unroll
        for (int d = 0; d < 3; ++d)
#pragma unroll
            for (int j = 0; j < 4; ++j) rows[d][j] = (pos0 - 3 + d >= 0) ? *(const v4u*)(QKV + (size_t)(tbeg - 3 + d) * 2048 + 8 * lane + 512 * j) : (v4u){0u, 0u, 0u, 0u};
#pragma unroll 1
        for (int i = 0; i < RUN; ++i) { const int t = tbeg + i;
            v4u cur[4];
#pragma unroll
            for (int j = 0; j < 4; ++j) cur[j] = *(const v4u*)(QKV + (size_t)t * 2048 + 8 * lane + 512 * j);
            float bi = 0.f, ai = 0.f; if (lane < 8) { bi = BA[(size_t)t * 16 + lane]; ai = BA[(size_t)t * 16 + 8 + lane] + dtb; }
#pragma unroll
            for (int j = 0; j < 4; ++j) { float a[8];
#pragma unroll
                for (int e = 0; e < 8; ++e) a[e] = 0.f;
#pragma unroll
                for (int tap = 0; tap < 4; ++tap) { const v4u q = tap < 3 ? rows[tap][j] : cur[j]; const f32x4 w0 = *(const LAS f32x4*)(cwl + tap * 2048 + 8 * lane + 512 * j), w1 = *(const LAS f32x4*)(cwl + tap * 2048 + 8 * lane + 512 * j + 4);
                    a[0] += w0[0] * bflo(q.x); a[1] += w0[1] * bfhi(q.x); a[2] += w0[2] * bflo(q.y); a[3] += w0[3] * bfhi(q.y); a[4] += w1[0] * bflo(q.z); a[5] += w1[1] * bfhi(q.z); a[6] += w1[2] * bflo(q.w); a[7] += w1[3] * bfhi(q.w); }
                float ss = 0.f;
#pragma unroll
                for (int e = 0; e < 8; ++e) { a[e] = siluf_(a[e]); ss += a[e] * a[e]; }
                if (j < 2) { ss += __shfl_xor(ss, 1); ss += __shfl_xor(ss, 2); ss += __shfl_xor(ss, 4); ss += __shfl_xor(ss, 8);
                    const float r = __builtin_amdgcn_rsqf(ss + EPS); bf16* dst = (j == 0 ? QN : KN) + (size_t)t * 512 + 8 * lane;
                    v4u w; w.x = pk2(a[0] * r, a[1] * r); w.y = pk2(a[2] * r, a[3] * r); w.z = pk2(a[4] * r, a[5] * r); w.w = pk2(a[6] * r, a[7] * r); *(v4u*)dst = w; }
                else { v4u w; w.x = pk2(a[0], a[1]); w.y = pk2(a[2], a[3]); w.z = pk2(a[4], a[5]); w.w = pk2(a[6], a[7]); *(v4u*)(VV + (size_t)t * 1024 + 8 * lane + 512 * (j - 2)) = w; } }
            if (lane < 8) { const float sp = fmaxf(ai, 0.f) + log1pf(expf(-fabsf(ai)));
                DNB[(size_t)t * 16 + lane] = 1.0f / (1.0f + expf(-bi)); DNB[(size_t)t * 16 + 8 + lane] = alg * sp; }
#pragma unroll
            for (int j = 0; j < 4; ++j) { rows[0][j] = rows[1][j]; rows[1][j] = rows[2][j]; rows[2][j] = cur[j]; }
        }
    }
}
constexpr int FA_STRIDE = 25600, FB_STRIDE = 32768, FU_STRIDE = 16384;
constexpr float DN_SCALE = 0.08838834764831845f;
__device__ __forceinline__ void phase_dn_chunk(const Args& args, LAS unsigned char* lds) {
    int tid_ = threadIdx.x; asm volatile("" : "+v"(tid_)); const int tid = tid_, lane = tid & 63, wave = __builtin_amdgcn_readfirstlane(tid >> 6), G = gridDim.x, bid = blockIdx.x;
    unsigned char* ws = uni_ptr(args.ws);
    const bf16* QN = (const bf16*)(ws + WS_ACT + A_QN); const bf16* KN = (const bf16*)(ws + WS_ACT + A_KN); const bf16* VV = (const bf16*)(ws + WS_ACT + A_VV);
    const float* DNB = (const float*)(ws + WS_DNB);
    unsigned char* FA = ws + WS_ACT + A_FA; unsigned char* FB = ws + WS_ACT + A_FB; unsigned char* FU = ws + WS_ACT + A_FU;
    LAS float* Al = (LAS float*)(lds + wave * 16384);
    LAS float* tb = (LAS float*)(lds + LDSCTL_OFF + 2048 + wave * 512);
    const int fr = lane & 15, fq = lane >> 4;
    for (int it = bid * NWAVES + wave; it < 4096; it += G * NWAVES) {
        const int b = it >> 11, hv = (it >> 8) & 7, n = it & 255, hq = hv >> 1; const unsigned t0 = (unsigned)b * SEQ + (unsigned)n * 64; const int itq = (b * 4 + hq) * 256 + n;
        unsigned char* fa = FA + (size_t)it * FA_STRIDE; unsigned char* fb = FB + (size_t)itq * FB_STRIDE;
        const float bv = DNB[(t0 + lane) * 16 + hv]; float gcv = DNB[(t0 + lane) * 16 + 8 + hv];
#pragma unroll
        for (int o = 1; o < 64; o <<= 1) { const float t = __shfl_up(gcv, o); if (lane >= o) gcv += t; }
        const float gll = __shfl(gcv, 63);
        tb[lane] = gcv; tb[64 + lane] = bv;
        { float* fe = (float*)(fa + 24576); fe[lane] = DN_SCALE * expf(gcv); fe[64 + lane] = expf(gll - gcv); fe[128 + lane] = expf(gll); }
        asm volatile("" ::: "memory");
        bf16x8 kf[4][4];
#pragma unroll
        for (int t = 0; t < 4; ++t)
#pragma unroll
            for (int ks = 0; ks < 4; ++ks) kf[t][ks] = *(const bf16x8*)(KN + (t0 + 16 * t + fr) * 512 + hq * 128 + 32 * ks + 8 * fq);
#pragma unroll
        for (int m = 0; m < 4; ++m) { const int c = 16 * m + fr; const float bm = tb[64 + c], gm = tb[c];
            bf16x8 qf[4];
#pragma unroll
            for (int ks = 0; ks < 4; ++ks) qf[ks] = *(const bf16x8*)(QN + (t0 + c) * 512 + hq * 128 + 32 * ks + 8 * fq);
            f32x4 tl[4];
#pragma unroll
            for (int t = 0; t < 4; ++t) {
                if (t <= m) { f32x4 ak = {0.f, 0.f, 0.f, 0.f}, aq = {0.f, 0.f, 0.f, 0.f};
#pragma unroll
                    for (int ks = 0; ks < 4; ++ks) { ak = __builtin_amdgcn_mfma_f32_16x16x32_bf16(kf[t][ks], kf[m][ks], ak, 0, 0, 0); aq = __builtin_amdgcn_mfma_f32_16x16x32_bf16(kf[t][ks], qf[ks], aq, 0, 0, 0); }
                    const f32x4 gs4 = *(const LAS f32x4*)(tb + 16 * t + 4 * fq); f32x4 av;
#pragma unroll
                    for (int r = 0; r < 4; ++r) { const int s = 16 * t + 4 * fq + r; const float dec = fast_exp(fminf(gm - gs4[r], 0.f)); av[r] = (s < c) ? bm * ak[r] * dec : 0.f; tl[t][r] = (s <= c) ? DN_SCALE * aq[r] * dec : 0.f; }
                    *(LAS f32x4*)(Al + c * 64 + 16 * t + 4 * fq) = av; }
                else tl[t] = (f32x4){0.f, 0.f, 0.f, 0.f}; }
#pragma unroll
            for (int k2 = 0; k2 < 2; ++k2) { v4u w; w.x = pk2(tl[2 * k2][0], tl[2 * k2][1]); w.y = pk2(tl[2 * k2][2], tl[2 * k2][3]); w.z = pk2(tl[2 * k2 + 1][0], tl[2 * k2 + 1][1]); w.w = pk2(tl[2 * k2 + 1][2], tl[2 * k2 + 1][3]);
                *(v4u*)(fa + 16384 + (m * 2 + k2) * 1024 + lane * 16) = w; } }
        asm volatile("s_waitcnt lgkmcnt(0)" ::: "memory");
        float Tc[64];
#pragma unroll
        for (int m = 0; m < 64; ++m) Tc[m] = (m == lane) ? 1.f : 0.f;
#pragma unroll
        for (int r = 1; r < 64; ++r) { float acc = 0.f;
#pragma unroll
            for (int m4 = 0; m4 < (r + 3) / 4; ++m4) { const f32x4 a4 = *(const LAS f32x4*)(Al + r * 64 + 4 * m4);
#pragma unroll
                for (int e = 0; e < 4; ++e) if (4 * m4 + e < r) acc += a4[e] * Tc[4 * m4 + e]; }
            Tc[r] -= acc; if ((r & 3) == 3) __builtin_amdgcn_sched_barrier(0); }
        asm volatile("s_waitcnt lgkmcnt(0)" ::: "memory");
        LAS bf16* T1l = (LAS bf16*)Al; LAS bf16* T2l = T1l + 4096;
        { const float c1 = bv, c2 = bv * expf(gcv);
#pragma unroll
          for (int i = 0; i < 64; ++i) { T1l[i * 64 + lane] = (bf16)(pk2(Tc[i] * c1, 0.f) & 0xffffu); T2l[i * 64 + lane] = (bf16)(pk2(Tc[i] * c2, 0.f) & 0xffffu); } }
        asm volatile("s_waitcnt lgkmcnt(0)" ::: "memory");
        bf16x8 t1f[4][2], t2f[4][2];
#pragma unroll
        for (int m = 0; m < 4; ++m)
#pragma unroll
            for (int k2 = 0; k2 < 2; ++k2) { const int o = (16 * m + fr) * 64 + 32 * k2 + 4 * fq;
                { const v2u lo = *(const LAS v2u*)(T1l + o), hi = *(const LAS v2u*)(T1l + o + 16); v4u w; w.x = lo.x; w.y = lo.y; w.z = hi.x; w.w = hi.y; t1f[m][k2] = __builtin_bit_cast(bf16x8, w); }
                { const v2u lo = *(const LAS v2u*)(T2l + o), hi = *(const LAS v2u*)(T2l + o + 16); v4u w; w.x = lo.x; w.y = lo.y; w.z = hi.x; w.w = hi.y; t2f[m][k2] = __builtin_bit_cast(bf16x8, w); } }
        asm volatile("s_waitcnt lgkmcnt(0)" ::: "memory");
        LAS unsigned char* tile = (LAS unsigned char*)Al;
        typedef short s16x4 __attribute__((ext_vector_type(4)));
#define DN_STAGE_TILE(src, pitch, coff) do { _Pragma("unroll") for (int hb_ = 0; hb_ < 2; ++hb_) { v4u pv[8]; _Pragma("unroll") for (int it_ = 0; it_ < 8; ++it_) { const int p_ = lane + 64 * (it_ + 8 * hb_), row_ = p_ >> 4, c16_ = p_ & 15; pv[it_] = *(const v4u*)((src) + (t0 + row_) * (pitch) + (coff) + c16_ * 8); } \
            _Pragma("unroll") for (int it_ = 0; it_ < 8; ++it_) { const int p_ = lane + 64 * (it_ + 8 * hb_), row_ = p_ >> 4, c16_ = p_ & 15; *(LAS v4u*)(tile + row_ * 256 + (((c16_ >> 1) ^ (row_ & 7)) << 5) + ((c16_ & 1) << 4)) = pv[it_]; } } } while (0)
#define DN_TR_FRAG(dst, ct, k2) do { const int r0_ = 32 * (k2) + 4 * fq + (fr >> 2), r1_ = r0_ + 16; \
            const s16x4 lo_ = __builtin_amdgcn_ds_read_tr16_b64_v4i16((LAS s16x4*)(tile + r0_ * 256 + ((((ct)) ^ (r0_ & 7)) << 5) + ((fr & 3) << 3))); \
            const s16x4 hi_ = __builtin_amdgcn_ds_read_tr16_b64_v4i16((LAS s16x4*)(tile + r1_ * 256 + ((((ct)) ^ (r1_ & 7)) << 5) + ((fr & 3) << 3))); \
            dst = (bf16x8){lo_[0], lo_[1], lo_[2], lo_[3], hi_[0], hi_[1], hi_[2], hi_[3]}; } while (0)
        DN_STAGE_TILE(VV, 1024, hv * 128);
        asm volatile("s_waitcnt lgkmcnt(0)" ::: "memory");
#pragma unroll 1
        for (int j = 0; j < 8; ++j) { bf16x8 vf[2];
            DN_TR_FRAG(vf[0], j, 0); DN_TR_FRAG(vf[1], j, 1);
#pragma unroll
            for (int m = 0; m < 4; ++m) { f32x4 a = {0.f, 0.f, 0.f, 0.f};
#pragma unroll
                for (int k2 = 0; k2 < 2; ++k2) a = __builtin_amdgcn_mfma_f32_16x16x32_bf16(t1f[m][k2], vf[k2], a, 0, 0, 0);
                v2u w; w.x = pk2(a[0], a[1]); w.y = pk2(a[2], a[3]); *(v2u*)(FU + (size_t)it * FU_STRIDE + ((j * 4 + m) * 64 + lane) * 8) = w; } }
        asm volatile("s_waitcnt lgkmcnt(0)" ::: "memory");
        DN_STAGE_TILE(KN, 512, hq * 128);
        asm volatile("s_waitcnt lgkmcnt(0)" ::: "memory");
        if ((hv & 1) == 0) { int fr2 = fr, fq2 = fq; asm volatile("" : "+v"(fr2), "+v"(fq2));
#pragma unroll
            for (int m = 0; m < 4; ++m)
#pragma unroll
                for (int ks = 0; ks < 4; ++ks) { const bf16* qp = QN + (t0 + 16 * m + fr2) * 512 + hq * 128 + 32 * ks + 4 * fq2; const v2u lo = *(const v2u*)qp, hi = *(const v2u*)(qp + 16);
                    v4u w; w.x = lo.x; w.y = lo.y; w.z = hi.x; w.w = hi.y; *(v4u*)(fb + (m * 4 + ks) * 1024 + lane * 16) = w; } }
#pragma unroll 1
        for (int dh = 0; dh < 2; ++dh) { bf16x8 ktf[4][2];
#pragma unroll
            for (int d4 = 0; d4 < 4; ++d4) { DN_TR_FRAG(ktf[d4][0], 4 * dh + d4, 0); DN_TR_FRAG(ktf[d4][1], 4 * dh + d4, 1); }
            if ((hv & 1) == 0) {
#pragma unroll
                for (int d4 = 0; d4 < 4; ++d4)
#pragma unroll
                    for (int k2 = 0; k2 < 2; ++k2) *(bf16x8*)(fb + 16384 + ((4 * dh + d4) * 2 + k2) * 1024 + lane * 16) = ktf[d4][k2]; }
#pragma unroll
            for (int m = 0; m < 4; ++m) { f32x4 acc[4];
#pragma unroll
                for (int d4 = 0; d4 < 4; ++d4) { acc[d4] = (f32x4){0.f, 0.f, 0.f, 0.f};
#pragma unroll
                    for (int k2 = 0; k2 < 2; ++k2) acc[d4] = __builtin_amdgcn_mfma_f32_16x16x32_bf16(ktf[d4][k2], t2f[m][k2], acc[d4], 0, 0, 0); }
#pragma unroll
                for (int kk = 0; kk < 2; ++kk) { v4u w; w.x = pk2(-acc[2 * kk][0], -acc[2 * kk][1]); w.y = pk2(-acc[2 * kk][2], -acc[2 * kk][3]); w.z = pk2(-acc[2 * kk + 1][0], -acc[2 * kk + 1][1]); w.w = pk2(-acc[2 * kk + 1][2], -acc[2 * kk + 1][3]);
                    *(v4u*)(fa + (m * 4 + 2 * dh + kk) * 1024 + lane * 16) = w; } } }
        asm volatile("s_waitcnt lgkmcnt(0)" ::: "memory");
#undef DN_STAGE_TILE
#undef DN_TR_FRAG
    }
}
__device__ __forceinline__ void phase_dn_scan(const Args& args, LAS unsigned char* lds) {
    int tid_ = threadIdx.x; asm volatile("" : "+v"(tid_)); const int tid = tid_, lane = tid & 63, wave = __builtin_amdgcn_readfirstlane(tid >> 6), G = gridDim.x, bid = blockIdx.x;
    if (bid >= 128) {
        const int gw = (bid - 128) * NWAVES + wave, NGW = (G - 128) * NWAVES;
        convert_weights(args, lds, CV_SPLIT, CV_N_EXP, gw, NGW); convert_weights(args, lds, CV_N_EXP + CV_MIX_L01, CV_N_EXP + CV_N_MIXI, gw, NGW); return; }
    unsigned char* ws = uni_ptr(args.ws);
    const unsigned char* FA = ws + WS_ACT + A_FA; const unsigned char* FB = ws + WS_ACT + A_FB; const unsigned char* FU = ws + WS_ACT + A_FU;
    unsigned char* SFR = ws + WS_ACT + A_SFR; unsigned char* VFR = ws + WS_ACT + A_VFR;
    const int fq = lane >> 4;
    constexpr int SLOT = 35840, O_TB = 16384, O_KT = 17408, O_U = 33792;
#define SB() __builtin_amdgcn_sched_barrier(0)
#define WGBAR() do { asm volatile("" ::: "memory"); __builtin_amdgcn_s_barrier(); asm volatile("" ::: "memory"); } while (0)
#define DN_AUX 0
#define DMA4(g, l) do { __builtin_amdgcn_global_load_lds((g), (l), 16, 0, DN_AUX); __builtin_amdgcn_global_load_lds((g), (l), 16, 1024, DN_AUX); __builtin_amdgcn_global_load_lds((g), (l), 16, 2048, DN_AUX); __builtin_amdgcn_global_load_lds((g), (l), 16, 3072, DN_AUX); } while (0)
    for (int sidx = bid; sidx < 128; sidx += G) {
        const int bh = (sidx & 7) * 2 + (sidx >> 6), j = (sidx >> 3) & 7, b = bh >> 3, hv = bh & 7, hq = hv >> 1;
        const int it0 = bh * 256, itq0 = (b * 4 + hq) * 256;
#define VMW(n_) asm volatile("s_waitcnt vmcnt(" #n_ ")" ::: "memory")
        if (wave == 1 || wave == 4 || wave == 6 || wave == 7) {
            const int qa = wave == 1 ? 0 : (wave == 4 ? 1 : (wave == 6 ? 2 : 3));
#define DN_ISSUE_A(nn) do { LAS unsigned char* sl_ = lds + ((nn) % 3) * SLOT; const unsigned char* fa_ = FA + (size_t)(it0 + (nn)) * FA_STRIDE + lane * 16; \
                DMA4((const unsigned*)(fa_ + qa * 4096), (LAS unsigned*)(sl_ + qa * 4096)); \
                if (wave == 1) __builtin_amdgcn_global_load_lds((const unsigned*)(fa_ + 24576), (LAS unsigned*)(sl_ + O_TB), 16, 0, DN_AUX); \
                if (wave == 4) { const unsigned char* fu_ = FU + (size_t)(it0 + (nn)) * FU_STRIDE + j * 2048 + lane * 16; \
                    __builtin_amdgcn_global_load_lds((const unsigned*)(fu_), (LAS unsigned*)(sl_ + O_U), 16, 0, DN_AUX); __builtin_amdgcn_global_load_lds((const unsigned*)(fu_), (LAS unsigned*)(sl_ + O_U), 16, 1024, DN_AUX); } } while (0)
#define DN_WAIT_A(k) do { if ((k) == 0) VMW(0); else if (wave == 1) { if ((k) == 2) VMW(10); else VMW(5); } else if (wave == 4) { if ((k) == 2) VMW(12); else VMW(6); } else { if ((k) == 2) VMW(8); else VMW(4); } } while (0)
            DN_ISSUE_A(0); DN_ISSUE_A(1); DN_ISSUE_A(2);
            DN_WAIT_A(2);
#pragma unroll 1
            for (int n = 0; n < 256; ++n) {
                WGBAR();
                WGBAR();
                if (n + 3 < 256) { DN_ISSUE_A(n + 3); DN_WAIT_A(2); }
                else if (n + 2 < 256) DN_WAIT_A(1);
                else DN_WAIT_A(0);
            }
#undef DN_ISSUE_A
#undef DN_WAIT_A
        } else if (wave == 2 || wave == 3 || wave == 5) {
            const int p0 = wave == 2 ? 0 : (wave == 3 ? 6 : 11);
#define DN_ISSUE_B(nn) do { LAS unsigned char* sl_ = lds + ((nn) % 3) * SLOT + O_KT + p0 * 1024; const unsigned char* fb_ = FB + (size_t)(itq0 + (nn)) * FB_STRIDE + 16384 + p0 * 1024 + lane * 16; \
                DMA4((const unsigned*)(fb_), (LAS unsigned*)(sl_)); __builtin_amdgcn_global_load_lds((const unsigned*)(fb_ + 4096), (LAS unsigned*)(sl_ + 4096), 16, 0, DN_AUX); \
                if (wave == 2) __builtin_amdgcn_global_load_lds((const unsigned*)(fb_ + 4096), (LAS unsigned*)(sl_ + 4096), 16, 1024, DN_AUX); } while (0)
#define DN_WAIT_B(k) do { if ((k) == 0) VMW(0); else if (wave == 2) { if ((k) == 2) VMW(12); else VMW(6); } else { if ((k) == 2) VMW(10); else VMW(5); } } while (0)
            DN_ISSUE_B(0); DN_ISSUE_B(1);
#pragma unroll 1
            for (int n = 0; n < 256; ++n) {
                WGBAR();
                if (n + 2 < 256) { DN_ISSUE_B(n + 2); DN_WAIT_B(2); }
                else if (n + 1 < 256) DN_WAIT_B(1);
                else DN_WAIT_B(0);
                WGBAR();
            }
#undef DN_ISSUE_B
#undef DN_WAIT_B
        } else {
        f32x4 S[8];
#pragma unroll
        for (int dt = 0; dt < 8; ++dt) S[dt] = (f32x4){0.f, 0.f, 0.f, 0.f};
        bf16x8 sf[4];
#pragma unroll
        for (int ks = 0; ks < 4; ++ks) sf[ks] = (bf16x8){0, 0, 0, 0, 0, 0, 0, 0};
        int slot = 0;
#pragma unroll 1
        for (int n = 0; n < 256; ++n) {
            WGBAR();
            const LAS unsigned char* sbase = lds + slot * SLOT; const LAS unsigned char* base = sbase + lane * 16;
            unsigned char* sfo = SFR + ((size_t)(it0 + n) * 8 + j) * 4096 + lane * 16; unsigned char* vfo = VFR + ((size_t)(it0 + n) * 8 + j) * 2048 + lane * 16;
#pragma unroll
            for (int ks = 0; ks < 4; ++ks) *(bf16x8*)(sfo + ks * 1024) = sf[ks];
            const LAS float* tbl = (const LAS float*)(sbase + O_TB);
            f32x4 ekd[4], av[4];
#pragma unroll
            for (int m = 0; m < 4; ++m) { ekd[m] = *(const LAS f32x4*)(tbl + 64 + 16 * m + 4 * fq);
                const v2u u2 = *(const LAS v2u*)(sbase + O_U + (m * 64 + lane) * 8); av[m] = (f32x4){bflo(u2.x), bfhi(u2.x), bflo(u2.y), bfhi(u2.y)}; }
            const float gl = tbl[128 + lane];
            SB();
            bf16x8 Aw[16];
#pragma unroll
            for (int f = 0; f < 16; ++f) Aw[f] = *(const LAS bf16x8*)(base + f * 1024);
            SB();
#pragma unroll
            for (int ks = 0; ks < 4; ++ks) {
#pragma unroll
                for (int m = 0; m < 4; ++m) av[m] = __builtin_amdgcn_mfma_f32_16x16x32_bf16(Aw[m * 4 + ks], sf[ks], av[m], 0, 0, 0);
                SB(); }
            asm volatile("s_waitcnt lgkmcnt(0)" ::: "memory");
            WGBAR();
            bf16x8 Ck[16];
#pragma unroll
            for (int f = 0; f < 16; ++f) Ck[f] = *(const LAS bf16x8*)(base + O_KT + f * 1024);
#pragma unroll
            for (int dt = 0; dt < 8; ++dt) S[dt] = S[dt] * gl;
            bf16x8 vf[2], vpf[2];
#pragma unroll
            for (int k2 = 0; k2 < 2; ++k2) { v4u w; w.x = pk2(av[2 * k2][0], av[2 * k2][1]); w.y = pk2(av[2 * k2][2], av[2 * k2][3]); w.z = pk2(av[2 * k2 + 1][0], av[2 * k2 + 1][1]); w.w = pk2(av[2 * k2 + 1][2], av[2 * k2 + 1][3]); vf[k2] = __builtin_bit_cast(bf16x8, w);
                const f32x4 p0 = av[2 * k2] * ekd[2 * k2], p1 = av[2 * k2 + 1] * ekd[2 * k2 + 1];
                v4u x; x.x = pk2(p0[0], p0[1]); x.y = pk2(p0[2], p0[3]); x.z = pk2(p1[0], p1[1]); x.w = pk2(p1[2], p1[3]); vpf[k2] = __builtin_bit_cast(bf16x8, x); }
#pragma unroll
            for (int k2 = 0; k2 < 2; ++k2) *(bf16x8*)(vfo + k2 * 1024) = vf[k2];
            SB();
#pragma unroll
            for (int k2 = 0; k2 < 2; ++k2)
#pragma unroll
                for (int dt = 0; dt < 8; ++dt) S[dt] = __builtin_amdgcn_mfma_f32_16x16x32_bf16(Ck[dt * 2 + k2], vpf[k2], S[dt], 0, 0, 0);
            SB();
#pragma unroll
            for (int ks = 0; ks < 4; ++ks) { v4u w; w.x = pk2(S[2 * ks][0], S[2 * ks][1]); w.y = pk2(S[2 * ks][2], S[2 * ks][3]); w.z = pk2(S[2 * ks + 1][0], S[2 * ks + 1][1]); w.w = pk2(S[2 * ks + 1][2], S[2 * ks + 1][3]); sf[ks] = __builtin_bit_cast(bf16x8, w); }
            asm volatile("s_waitcnt lgkmcnt(0)" ::: "memory");
            slot = (slot == 2) ? 0 : slot + 1;
        }
        }
        __syncthreads();
    }
#undef SB
#undef DMA4
#undef WGBAR
#undef DN_AUX
#undef VMW
}
__device__ __forceinline__ void phase_dn_out(const Args& args, LAS unsigned char* lds) {
    int tid_ = threadIdx.x; asm volatile("" : "+v"(tid_)); const int tid = tid_, lane = tid & 63, wave = __builtin_amdgcn_readfirstlane(tid >> 6), G = gridDim.x, bid = blockIdx.x; (void)tid;
    unsigned char* ws = uni_ptr(args.ws); const float* o_norm = args.in[23];
    const bf16* QN = (const bf16*)(ws + WS_ACT + A_QN); const unsigned char* FA = ws + WS_ACT + A_FA; const unsigned char* SFR = ws + WS_ACT + A_SFR; const unsigned char* VFR = ws + WS_ACT + A_VFR;
    const bf16* Z = (const bf16*)(ws + WS_ACT + A_Z); bf16* GT = (bf16*)(ws + WS_ACT + A_H);
    LAS bf16* ot = (LAS bf16*)(lds + wave * 16384);
    const int fr = lane & 15, fq = lane >> 4;
    float on[8];
#pragma unroll
    for (int e = 0; e < 8; ++e) on[e] = o_norm[8 * fr + e];
    for (int it = bid * NWAVES + wave; it < 4096; it += G * NWAVES) {
        const int b = it >> 11, hv = (it >> 8) & 7, n = it & 255, hq = hv >> 1; const unsigned t0 = (unsigned)b * SEQ + (unsigned)n * 64;
        const unsigned char* fa = FA + (size_t)it * FA_STRIDE;
        bf16x8 qf[4][4], qk[4][2]; f32x4 egc[4];
#pragma unroll
        for (int m = 0; m < 4; ++m) {
#pragma unroll
            for (int ks = 0; ks < 4; ++ks) { const bf16* qp = QN + (t0 + 16 * m + fr) * 512 + hq * 128 + 32 * ks + 4 * fq; const v2u lo = *(const v2u*)qp, hi = *(const v2u*)(qp + 16); v4u w; w.x = lo.x; w.y = lo.y; w.z = hi.x; w.w = hi.y; qf[m][ks] = __builtin_bit_cast(bf16x8, w); }
#pragma unroll
            for (int k2 = 0; k2 < 2; ++k2) qk[m][k2] = *(const bf16x8*)(fa + 16384 + (m * 2 + k2) * 1024 + lane * 16);
            egc[m] = *(const f32x4*)((const float*)(fa + 24576) + 16 * m + 4 * fq); }
#pragma unroll 1
        for (int j = 0; j < 8; ++j) {
            bf16x8 sf[4], vf[2];
#pragma unroll
            for (int ks = 0; ks < 4; ++ks) sf[ks] = *(const bf16x8*)(SFR + ((size_t)it * 8 + j) * 4096 + ks * 1024 + lane * 16);
#pragma unroll
            for (int k2 = 0; k2 < 2; ++k2) vf[k2] = *(const bf16x8*)(VFR + ((size_t)it * 8 + j) * 2048 + k2 * 1024 + lane * 16);
            f32x4 ao[4];
#pragma unroll
            for (int m = 0; m < 4; ++m) { ao[m] = (f32x4){0.f, 0.f, 0.f, 0.f};
#pragma unroll
                for (int ks = 0; ks < 4; ++ks) ao[m] = __builtin_amdgcn_mfma_f32_16x16x32_bf16(qf[m][ks], sf[ks], ao[m], 0, 0, 0);
                ao[m] = ao[m] * egc[m];
#pragma unroll
                for (int k2 = 0; k2 < 2; ++k2) ao[m] = __builtin_amdgcn_mfma_f32_16x16x32_bf16(qk[m][k2], vf[k2], ao[m], 0, 0, 0); }
#pragma unroll
            for (int m = 0; m < 4; ++m)
#pragma unroll
                for (int r = 0; r < 4; ++r) ot[(16 * m + 4 * fq + r) * 128 + 16 * j + fr] = (bf16)(pk2(ao[m][r], 0.f) & 0xffffu);
        }
        asm volatile("s_waitcnt lgkmcnt(0)" ::: "memory");
#pragma unroll 4
        for (int i = 0; i < 16; ++i) { const int tk = 4 * i + fq; const v4u q = *(const LAS v4u*)(ot + tk * 128 + 8 * fr); const v4u zq = *(const v4u*)(Z + (size_t)(t0 + tk) * 1024 + hv * 128 + 8 * fr);
            float o[8] = {bflo(q.x), bfhi(q.x), bflo(q.y), bfhi(q.y), bflo(q.z), bfhi(q.z), bflo(q.w), bfhi(q.w)}; const float zz[8] = {bflo(zq.x), bfhi(zq.x), bflo(zq.y), bfhi(zq.y), bflo(zq.z), bfhi(zq.z), bflo(zq.w), bfhi(zq.w)};
            float ss = 0.f;
#pragma unroll
            for (int e = 0; e < 8; ++e) ss += o[e] * o[e];
            ss += __shfl_xor(ss, 1); ss += __shfl_xor(ss, 2); ss += __shfl_xor(ss, 4); ss += __shfl_xor(ss, 8);
            const float rr = __builtin_amdgcn_rsqf(ss * (1.0f / 128.0f) + EPS);
#pragma unroll
            for (int e = 0; e < 8; ++e) o[e] = o[e] * rr * on[e] * siluf_(zz[e]);
            v4u w; w.x = pk2(o[0], o[1]); w.y = pk2(o[2], o[3]); w.z = pk2(o[4], o[5]); w.w = pk2(o[6], o[7]); *(v4u*)(GT + (size_t)(t0 + tk) * 1024 + hv * 128 + 8 * fr) = w; }
        asm volatile("s_waitcnt lgkmcnt(0)" ::: "memory");
    }
}
__device__ __forceinline__ void phase_dn_ogate(const Args& args) {
    int tid_ = threadIdx.x; asm volatile("" : "+v"(tid_)); const int tid = tid_, lane = tid & 63, wave = __builtin_amdgcn_readfirstlane(tid >> 6), G = gridDim.x, bid = blockIdx.x; (void)tid;
    unsigned char* ws = uni_ptr(args.ws); const float* o_norm = args.in[23];
    const bf16* O = (const bf16*)(ws + WS_ACT + A_O); const bf16* Z = (const bf16*)(ws + WS_ACT + A_Z); bf16* GT = (bf16*)(ws + WS_ACT + A_H);
    float on[2][8];
#pragma unroll
    for (int j = 0; j < 2; ++j)
#pragma unroll
        for (int e = 0; e < 8; ++e) on[j][e] = o_norm[((8 * lane + 512 * j) & 127) + e];
    const int NW = G * NWAVES;
    for (int t0 = bid * NWAVES + wave; t0 < T; t0 += 4 * NW) {
        v4u q[4][2], z[4][2];
#pragma unroll
        for (int k = 0; k < 4; ++k) { const int t = (t0 + k * NW < T) ? t0 + k * NW : t0;
#pragma unroll
            for (int j = 0; j < 2; ++j) { const int ch = 8 * lane + 512 * j; q[k][j] = *(const v4u*)(O + (size_t)t * 1024 + ch); z[k][j] = *(const v4u*)(Z + (size_t)t * 1024 + ch); } }
#pragma unroll
        for (int k = 0; k < 4; ++k) { const int t = t0 + k * NW; if (t >= T) break;
#pragma unroll
            for (int j = 0; j < 2; ++j) { const int ch = 8 * lane + 512 * j; const v4u qq = q[k][j], zq = z[k][j];
                float o[8] = {bflo(qq.x), bfhi(qq.x), bflo(qq.y), bfhi(qq.y), bflo(qq.z), bfhi(qq.z), bflo(qq.w), bfhi(qq.w)}; const float zz[8] = {bflo(zq.x), bfhi(zq.x), bflo(zq.y), bfhi(zq.y), bflo(zq.z), bfhi(zq.z), bflo(zq.w), bfhi(zq.w)};
                float ss = 0.f;
#pragma unroll
                for (int e = 0; e < 8; ++e) ss += o[e] * o[e];
                ss += __shfl_xor(ss, 1); ss += __shfl_xor(ss, 2); ss += __shfl_xor(ss, 4); ss += __shfl_xor(ss, 8);
                const float r = __builtin_amdgcn_rsqf(ss * (1.0f / 128.0f) + EPS);
#pragma unroll
                for (int e = 0; e < 8; ++e) o[e] = o[e] * r * on[j][e] * siluf_(zz[e]);
                v4u w; w.x = pk2(o[0], o[1]); w.y = pk2(o[2], o[3]); w.z = pk2(o[4], o[5]); w.w = pk2(o[6], o[7]); *(v4u*)(GT + (size_t)t * 1024 + ch) = w; } }
    }
}
__device__ __forceinline__ void phase_moe_router(const Args& args, int L, LAS unsigned char* lds) {
    int tid_ = threadIdx.x; asm volatile("" : "+v"(tid_)); const int tid = tid_, lane = tid & 63, wave = __builtin_amdgcn_readfirstlane(tid >> 6), G = gridDim.x, bid = blockIdx.x;
    unsigned char* ws = uni_ptr(args.ws); const int ib = LBASE(L) + 4 + NMIX(L);
    const bf16* X = L == 3 ? (const bf16*)(ws + WS_X16B) : (const bf16*)args.out; unsigned char* H8 = ws + WS_ACT + A_H; const float* MOD = (const float*)(ws + WS_MOD) + (size_t)L * 2 * 6144;
    const float* nf = args.in[LBASE(L) + 1]; const float* rb = args.in[ib + 1];
    const bf16* RH = (const bf16*)(ws + WS_RTR + (size_t)L * 196608); const bf16* RLo = RH + 49152;
    int* EID = (int*)(ws + WS_EID); float* GATE = (float*)(ws + WS_GATE);
    LAS float* gs = (LAS float*)lds; LAS float* sh = gs + 1024; LAS int* lcnt = (LAS int*)(lds + 8192);
    LAS float* ssp = (LAS float*)(lds + 8448);
    LAS float* part = (LAS float*)(lds + 9472);
    LAS float* logit = (LAS float*)(lds + 58624);
    LAS int* leid = (LAS int*)(lds + 83200); LAS int* lrk = leid + 256; LAS int* lbase = leid + 512; LAS float* rbl = (LAS float*)(lds + 86528);
    int* CUR = (int*)(ws + WS_CTL + 524288) + L * 32; int* TOKE = (int*)(ws + WS_TOK); int* POS = (int*)(ws + WS_SLOT);
    const int r = lane & 15, q = lane >> 4, kw = 128 * wave;
    bf16x8 bh[4][3], bl[4][3];
#pragma unroll
    for (int ks = 0; ks < 4; ++ks)
#pragma unroll
        for (int nt = 0; nt < 3; ++nt) { bh[ks][nt] = *(const bf16x8*)(RH + (size_t)(nt * 16 + r) * 1024 + kw + 32 * ks + 8 * q); bl[ks][nt] = *(const bf16x8*)(RLo + (size_t)(nt * 16 + r) * 1024 + kw + 32 * ks + 8 * q); }
    for (int item = bid; item < T / 128; item += G) {
        const int r0 = item * 128, b = r0 / SEQ; const float* m = MOD + (size_t)b * 6144;
        __syncthreads();
        for (int k = tid; k < 1024; k += NTHR) { gs[k] = nf[k] * (1.0f + m[4096 + k]); sh[k] = m[3072 + k]; }
        if (tid < 32) lcnt[tid] = 0;
        if (tid < 48) rbl[tid] = tid < 36 ? rb[tid] : 0.f;
        f32x4 xv[8];
        { const bf16* xp = X + (size_t)(r0 + r) * 1024 + kw + 8 * q;
#pragma unroll
          for (int ks = 0; ks < 4; ++ks) { const v4u w = *(const v4u*)(xp + 32 * ks); xv[2 * ks] = (f32x4){bflo(w.x), bfhi(w.x), bflo(w.y), bfhi(w.y)}; xv[2 * ks + 1] = (f32x4){bflo(w.z), bfhi(w.z), bflo(w.w), bfhi(w.w)}; } }
        v4u xn[4];
        { const bf16* xp = X + (size_t)(r0 + 16 + r) * 1024 + kw + 8 * q;
#pragma unroll
          for (int ks = 0; ks < 4; ++ks) xn[ks] = *(const v4u*)(xp + 32 * ks); }
        { float ss = 0.f;
#pragma unroll
          for (int i = 0; i < 8; ++i) ss += (xv[i][0] * xv[i][0] + xv[i][1] * xv[i][1]) + (xv[i][2] * xv[i][2] + xv[i][3] * xv[i][3]);
          ss += __shfl_xor(ss, 16); ss += __shfl_xor(ss, 32);
          if (q == 0) ssp[wave * 16 + r] = ss; }
        __syncthreads();
#pragma unroll 1
        for (int g = 0; g < 8; ++g) {
            const int row = r0 + 16 * g + r, pb = g & 1;
            float tot = 0.f;
#pragma unroll
            for (int w = 0; w < 8; ++w) tot += ssp[(pb * 8 + w) * 16 + r];
            const float rstd = __builtin_amdgcn_rsqf(tot * (1.0f / 1024.0f) + EPS);
            f32x4 acc[3];
#pragma unroll
            for (int nt = 0; nt < 3; ++nt) acc[nt] = (f32x4){0.f, 0.f, 0.f, 0.f};
#pragma unroll
            for (int ks = 0; ks < 4; ++ks) { const int k0 = kw + 32 * ks + 8 * q;
                const f32x4 g0 = *(const LAS f32x4*)(gs + k0), g1 = *(const LAS f32x4*)(gs + k0 + 4), s0 = *(const LAS f32x4*)(sh + k0), s1 = *(const LAS f32x4*)(sh + k0 + 4);
                const f32x4 h0 = xv[2 * ks] * rstd * g0 + s0, h1 = xv[2 * ks + 1] * rstd * g1 + s1;
                v4u hi; hi.x = pk2(h0[0], h0[1]); hi.y = pk2(h0[2], h0[3]); hi.z = pk2(h1[0], h1[1]); hi.w = pk2(h1[2], h1[3]);
                v4u lo; lo.x = pk2(h0[0] - bflo(hi.x), h0[1] - bfhi(hi.x)); lo.y = pk2(h0[2] - bflo(hi.y), h0[3] - bfhi(hi.y)); lo.z = pk2(h1[0] - bflo(hi.z), h1[1] - bfhi(hi.z)); lo.w = pk2(h1[2] - bflo(hi.w), h1[3] - bfhi(hi.w));
                { v2u h8; h8.x = pk4_fp8(h0[0], h0[1], h0[2], h0[3]); h8.y = pk4_fp8(h1[0], h1[1], h1[2], h1[3]); *(v2u*)(H8 + (size_t)row * 1024 + k0) = h8; }
                const bf16x8 ahi = __builtin_bit_cast(bf16x8, hi), alo = __builtin_bit_cast(bf16x8, lo);
#pragma unroll
                for (int nt = 0; nt < 3; ++nt) { acc[nt] = __builtin_amdgcn_mfma_f32_16x16x32_bf16(bh[ks][nt], ahi, acc[nt], 0, 0, 0); acc[nt] = __builtin_amdgcn_mfma_f32_16x16x32_bf16(bl[ks][nt], ahi, acc[nt], 0, 0, 0); acc[nt] = __builtin_amdgcn_mfma_f32_16x16x32_bf16(bh[ks][nt], alo, acc[nt], 0, 0, 0); } }
#pragma unroll
            for (int nt = 0; nt < 3; ++nt) *(LAS f32x4*)(part + ((pb * 8 + wave) * 16 + r) * 48 + 16 * nt + 4 * q) = acc[nt];
            if (g < 7) {
#pragma unroll
                for (int ks = 0; ks < 4; ++ks) { xv[2 * ks] = (f32x4){bflo(xn[ks].x), bfhi(xn[ks].x), bflo(xn[ks].y), bfhi(xn[ks].y)}; xv[2 * ks + 1] = (f32x4){bflo(xn[ks].z), bfhi(xn[ks].z), bflo(xn[ks].w), bfhi(xn[ks].w)}; }
                float ss = 0.f;
#pragma unroll
                for (int i = 0; i < 8; ++i) ss += (xv[i][0] * xv[i][0] + xv[i][1] * xv[i][1]) + (xv[i][2] * xv[i][2] + xv[i][3] * xv[i][3]);
                ss += __shfl_xor(ss, 16); ss += __shfl_xor(ss, 32);
                if (q == 0) ssp[((pb ^ 1) * 8 + wave) * 16 + r] = ss;
                if (g < 6) { const bf16* xp = X + (size_t)(row + 32) * 1024 + kw + 8 * q;
#pragma unroll
                    for (int ks = 0; ks < 4; ++ks) xn[ks] = *(const v4u*)(xp + 32 * ks); } }
            __syncthreads();
            if (tid < 192) { f32x4 sacc = {0.f, 0.f, 0.f, 0.f};
#pragma unroll
                for (int w = 0; w < 8; ++w) sacc += *(const LAS f32x4*)(part + (pb * 8 + w) * 768 + 4 * tid);
                *(LAS f32x4*)(logit + g * 768 + 4 * tid) = sacc + *(const LAS f32x4*)(rbl + 4 * (tid % 12)); }
        }
        __syncthreads();
        if (tid < 128) { float lg[36]; const int trow = r0 + tid;
#pragma unroll
            for (int i = 0; i < 9; ++i) { const f32x4 v = *(const LAS f32x4*)(logit + tid * 48 + 4 * i); lg[4 * i] = v[0]; lg[4 * i + 1] = v[1]; lg[4 * i + 2] = v[2]; lg[4 * i + 3] = v[3]; }
            int gsel = 0; float gm = lg[0];
#pragma unroll
            for (int i = 1; i < 4; ++i) if (lg[i] > gm) { gm = lg[i]; gsel = i; }
            float gsum = 0.f;
#pragma unroll
            for (int i = 0; i < 4; ++i) gsum += expf(lg[i] - gm);
            const float pg = 1.0f / gsum;
            float le[8];
#pragma unroll
            for (int i = 0; i < 8; ++i) le[i] = gsel == 0 ? lg[4 + i] : (gsel == 1 ? lg[12 + i] : (gsel == 2 ? lg[20 + i] : lg[28 + i]));
            int j1 = 0; float m1 = le[0];
#pragma unroll
            for (int i = 1; i < 8; ++i) if (le[i] > m1) { m1 = le[i]; j1 = i; }
            int j2 = -1; float m2 = -INFINITY;
#pragma unroll
            for (int i = 0; i < 8; ++i) if (i != j1 && le[i] > m2) { m2 = le[i]; j2 = i; }
            const float p2 = expf(m2 - m1), den = 1.0f / (1.0f + p2);
            const int e1 = gsel * 8 + j1, e2 = gsel * 8 + j2;
            EID[(size_t)trow * 2] = e1; EID[(size_t)trow * 2 + 1] = e2; GATE[(size_t)trow * 2] = pg * den; GATE[(size_t)trow * 2 + 1] = pg * p2 * den;
            const int li = 2 * tid; leid[li] = e1; leid[li + 1] = e2;
            lrk[li] = __hip_atomic_fetch_add(lcnt + e1, 1, __ATOMIC_RELAXED, __HIP_MEMORY_SCOPE_WORKGROUP); lrk[li + 1] = __hip_atomic_fetch_add(lcnt + e2, 1, __ATOMIC_RELAXED, __HIP_MEMORY_SCOPE_WORKGROUP); }
        __syncthreads();
        if (tid < 32) lbase[tid] = __hip_atomic_fetch_add(CUR + tid, lcnt[tid], __ATOMIC_RELAXED, __HIP_MEMORY_SCOPE_AGENT);
        __syncthreads();
        if (tid < 256) { const int e = leid[tid], pos = lbase[e] + lrk[tid]; TOKE[(size_t)e * 32768 + pos] = r0 + (tid >> 1); POS[(size_t)r0 * 2 + tid] = pos; }
        if (item == 0 && tid < 64) *(v4u*)(H8 + (size_t)T * 1024 + 16 * tid) = (v4u){0u, 0u, 0u, 0u};
    }
}
__device__ __forceinline__ void moe_tables(const int* CUR, LAS int* tbl) {
    const int tid = threadIdx.x;
    __syncthreads();
    if (tid < 32) tbl[tid] = __hip_atomic_load(CUR + tid, __ATOMIC_RELAXED, __HIP_MEMORY_SCOPE_AGENT);
    __syncthreads();
    if (tid < 33) { int p = 0; for (int e = 0; e < tid; ++e) p += (tbl[e] + 255) >> 8; tbl[32 + tid] = p; }
    __syncthreads();
    if (tid < 32) { const int t0 = tbl[32 + tid], nt = (tbl[tid] + 255) >> 8; for (int i = 0; i < nt; ++i) tbl[80 + t0 + i] = tid; }
    __syncthreads();
}
__device__ __forceinline__ void phase_moe_combine(const Args& args, int L, LAS unsigned char* lds) {
    int tid_ = threadIdx.x; asm volatile("" : "+v"(tid_)); const int tid = tid_, lane = tid & 63, wave = __builtin_amdgcn_readfirstlane(tid >> 6), G = gridDim.x, bid = blockIdx.x;
    unsigned char* ws = uni_ptr(args.ws); bf16* X = L == 3 ? (bf16*)(ws + WS_X16B) : (bf16*)args.out; float* OUT = args.out; const unsigned char* Y = ws + WS_ACT + A_Y; bf16* H = (bf16*)(ws + WS_ACT + A_H);
    const int* POS = (const int*)(ws + WS_SLOT); const int* EID = (const int*)(ws + WS_EID); const float* GATE = (const float*)(ws + WS_GATE); const float* MOD = (const float*)(ws + WS_MOD);
    LAS int* tbl = (LAS int*)(lds + LDSCTL_OFF + 7168); moe_tables((const int*)(ws + WS_CTL + 524288) + L * 32, tbl);
    LAS float* vgf = (LAS float*)lds; LAS float* vgs = vgf + 2048; LAS float* vsh = vgf + 4096;
    for (int i = tid; i < 2048; i += NTHR) { const int b = i >> 10, k = i & 1023; vgf[i] = MOD[(size_t)(L * 2 + b) * 6144 + 5120 + k];
        if (L < 3) { const float* m = MOD + (size_t)((L + 1) * 2 + b) * 6144; vgs[i] = args.in[LBASE(L < 3 ? L + 1 : 3)][k] * (1.0f + m[1024 + k]); vsh[i] = m[k]; } }
    __syncthreads();
    const int NW = G * NWAVES;
#define CB_IDX(tq, S0, S1, G0, G1) do { const int tb_ = (tq) + NW; const int t1_ = tb_ < T ? tb_ : (tq); _Pragma("unroll") for (int k = 0; k < 2; ++k) { const int tt = k ? t1_ : (tq); \
        S0[k] = 256 * tbl[32 + EID[(size_t)tt * 2]] + POS[(size_t)tt * 2]; S1[k] = 256 * tbl[32 + EID[(size_t)tt * 2 + 1]] + POS[(size_t)tt * 2 + 1]; G0[k] = 0.125f * GATE[(size_t)tt * 2]; G1[k] = 0.125f * GATE[(size_t)tt * 2 + 1]; } } while (0)
    int s0c[2], s1c[2]; float g0[2], g1[2];
    { const int t0_ = bid * NWAVES + wave; if (t0_ < T) CB_IDX(t0_, s0c, s1c, g0, g1); }
    for (int t = bid * NWAVES + wave; t < T; t += 2 * NW) {
        const int tb = t + NW; const bool two = tb < T; const int t1 = two ? tb : t;
        const int ta[2] = {t, t1};
        v2u xv[2][4]; unsigned y0[2][4], y1[2][4];
#pragma unroll
        for (int k = 0; k < 2; ++k) { const int tt = ta[k];
#pragma unroll
            for (int j = 0; j < 4; ++j) { const int c = 4 * lane + 256 * j; xv[k][j] = *(const v2u*)(X + (size_t)tt * 1024 + c);
                y0[k][j] = *(const unsigned*)(Y + (size_t)s0c[k] * 1024 + c); y1[k][j] = *(const unsigned*)(Y + (size_t)s1c[k] * 1024 + c); } }
        int s0n[2], s1n[2]; float g0n[2], g1n[2];
        if (t + 2 * NW < T) CB_IDX(t + 2 * NW, s0n, s1n, g0n, g1n); else {
#pragma unroll
            for (int k = 0; k < 2; ++k) { s0n[k] = s0c[k]; s1n[k] = s1c[k]; g0n[k] = g0[k]; g1n[k] = g1[k]; } }
#pragma unroll
        for (int k = 0; k < 2; ++k) { if (k == 1 && !two) break; const int tt = ta[k]; const int b = tt / SEQ; f32x4 v[4]; float ss = 0.f;
#pragma unroll
            for (int j = 0; j < 4; ++j) { const int c = 4 * lane + 256 * j; f32x4 mo; const f32x4 gg = *(const LAS f32x4*)(vgf + b * 1024 + c);
                { const auto a0 = __builtin_amdgcn_cvt_pk_f32_fp8((int)y0[k][j], false), a1 = __builtin_amdgcn_cvt_pk_f32_fp8((int)y0[k][j], true), b0 = __builtin_amdgcn_cvt_pk_f32_fp8((int)y1[k][j], false), b1 = __builtin_amdgcn_cvt_pk_f32_fp8((int)y1[k][j], true);
                  mo[0] = g0[k] * a0[0] + g1[k] * b0[0]; mo[1] = g0[k] * a0[1] + g1[k] * b0[1]; mo[2] = g0[k] * a1[0] + g1[k] * b1[0]; mo[3] = g0[k] * a1[1] + g1[k] * b1[1]; }
                v[j] = (f32x4){bflo(xv[k][j].x), bfhi(xv[k][j].x), bflo(xv[k][j].y), bfhi(xv[k][j].y)} + gg * mo;
                if (L < 3) { v2u w; w.x = pk2(v[j][0], v[j][1]); w.y = pk2(v[j][2], v[j][3]); *(v2u*)(X + (size_t)tt * 1024 + c) = w; } else *(f32x4*)(OUT + (size_t)tt * 1024 + c) = v[j];
                ss += (v[j][0] * v[j][0] + v[j][1] * v[j][1]) + (v[j][2] * v[j][2] + v[j][3] * v[j][3]); }
            if (L < 3) { const float rstd = __builtin_amdgcn_rsqf(wave_sum(ss) * (1.0f / 1024.0f) + EPS);
#pragma unroll
                for (int j = 0; j < 4; ++j) { const int c = 4 * lane + 256 * j; const f32x4 gsv = *(const LAS f32x4*)(vgs + b * 1024 + c), shv = *(const LAS f32x4*)(vsh + b * 1024 + c);
                    const f32x4 h = v[j] * rstd * gsv + shv; v2u w; w.x = pk2(h[0], h[1]); w.y = pk2(h[2], h[3]); *(v2u*)(H + (size_t)tt * 1024 + c) = w; } } }
#pragma unroll
        for (int k = 0; k < 2; ++k) { s0c[k] = s0n[k]; s1c[k] = s1n[k]; g0[k] = g0n[k]; g1[k] = g1n[k]; }
    }
#undef CB_IDX
}

constexpr int N_PHASES = 33;

#ifndef DUP_MASK
#define DUP_MASK 0
#endif
#ifndef STAGGER_TICKS
#define STAGGER_TICKS 0
#endif
__device__ __forceinline__ void gemm_stagger() { if (STAGGER_TICKS > 0) { const unsigned long long t0 = __builtin_amdgcn_s_memrealtime(); const unsigned long long w = (unsigned long long)((blockIdx.x >> 3) & 3) * STAGGER_TICKS; while (__builtin_amdgcn_s_memrealtime() - t0 < w) __builtin_amdgcn_s_sleep(8); } }
#define PHASE(k) if ((lo <= (k) && (k) < hi) && ((started ? (xcd_barrier(bar), 0) : 0), started = true, true))
#define NREP(g) (1 + ((DUP_MASK >> (g)) & 1))
#define PHASE_G(k, g) PHASE(k) for (int rep_ = 0; rep_ < NREP(g); ++rep_, ((rep_ < NREP(g)) ? (xcd_barrier(bar), 0) : 0))
template <int L> __device__ __forceinline__ void run_layer(const Args& args, LAS unsigned char* lds, const XcdBarrier& bar, bool& started, const int lo, const int hi) {
    const int G = gridDim.x, bid = blockIdx.x;
    unsigned char* ws = uni_ptr(args.ws);
    const float* MOD = (const float*)(ws + WS_MOD);
    bf16* Hb = (bf16*)(ws + WS_ACT + A_H);

        const int pb = (L == 0) ? 1 : (L == 1 ? 9 : (L == 2 ? 19 : 26));
        bf16* X16 = (L == 3) ? (bf16*)(ws + WS_X16B) : (bf16*)args.out; const void* xsrc = (L == 0) ? (const void*)args.in[0] : (const void*)args.out;
        const float* gate_m = MOD + (size_t)L * 2 * 6144 + 2048;
        int mb;
        if constexpr (L == 0 || L == 3) {
            int g0 = pb;
            if (L == 0) { PHASE_G(pb, 8) { phase_norm0(args, lds); } g0 = pb + 1; }
            const bf16* Win = (const bf16*)(ws + WS_WMIX + (L == 0 ? WMIX_GM_IN0 : WMIX_GM_IN3)); const bf16* Wout = (const bf16*)(ws + WS_WMIX + (L == 0 ? WMIX_GM_OUT0 : WMIX_GM_OUT3));
            PHASE_G(g0, 1) { pg8::Gemm g{Hb, Win, T, 2048, 1024}; pg8::StaticOrder S; S.init(T, 2048, G, bid);
                EpiGm1 E{(bf16*)(ws + WS_ACT + A_U), (bf16*)(ws + WS_ACT + A_V), (float*)(ws + WS_VSSP)};
                (gemm_stagger(), 0); pg8::gemm_phase<EpiGm1, pg8::StaticOrder, true, true, false, false, true>(lds, g, S, E); }
            PHASE_G(g0 + 1, 2) { phase_gm_spatial(args, L, lds); }
            PHASE_G(g0 + 2, (L == 0 ? 1 : 31)) { pg8::Gemm g{(const bf16*)(ws + WS_ACT + A_GATED), Wout, T, 1024, 1024}; pg8::StaticOrder S; S.init(T, 1024, G, bid);
                EpiRes<L != 0> E{xsrc, X16, gate_m};
                (gemm_stagger(), 0); pg8::gemm_phase<EpiRes<L != 0>, pg8::StaticOrder, true, true, false, false, true>(lds, g, S, E); }
            mb = g0 + 3;
        } else if constexpr (L == 1) {
            PHASE_G(pb, 1) { pg8::Gemm g{Hb, (const bf16*)(ws + WS_WMIX + WMIX_DN_IN), T, 3072, 1024}; pg8::StaticOrder S; S.init(T, 3072, G, bid);
                EpiDn1 E{(bf16*)(ws + WS_ACT + A_QKV), (bf16*)(ws + WS_ACT + A_Z), (float*)(ws + WS_BA)};
                (gemm_stagger(), 0); pg8::gemm_phase<EpiDn1, pg8::StaticOrder, true, true, false, false, true>(lds, g, S, E); dn_ba_tail(args, lds); }
            PHASE_G(pb + 1, 3) { phase_dn_prep(args, lds); }
            PHASE_G(pb + 2, 4) { phase_dn_chunk(args, lds); }
            PHASE_G(pb + 3, 5) { phase_dn_scan(args, lds); }
            PHASE_G(pb + 4, 3) { phase_dn_out(args, lds); }
            PHASE(pb + 5) { pg8::Gemm g{Hb, (const bf16*)(ws + WS_WMIX + WMIX_DN_OUT), T, 1024, 1024}; pg8::StaticOrder S; S.init(T, 1024, G, bid);
                EpiRes<L != 0> E{xsrc, X16, gate_m};
                (gemm_stagger(), 0); pg8::gemm_phase<EpiRes<L != 0>, pg8::StaticOrder, true, true, false, false, true>(lds, g, S, E); }
            mb = pb + 6;
        } else {
            PHASE_G(pb, 1) { pg8::Gemm g{Hb, (const bf16*)(ws + WS_WMIX + WMIX_SWA_IN), T, 1536, 1024}; pg8::StaticOrder S; S.init(T, 1536, G, bid);
                EpiBf E{(bf16*)(ws + WS_ACT + A_QKV), 1536, 0xffff, 1.0f};
                (gemm_stagger(), 0); pg8::gemm_phase<EpiBf, pg8::StaticOrder, true, true, false, false, true>(lds, g, S, E); }
            PHASE_G(pb + 1, 2) { phase_swa_attn(args, lds); }
            PHASE(pb + 2) { pg8::Gemm g{Hb, (const bf16*)(ws + WS_WMIX + WMIX_SWA_OUT), T, 1024, 1024}; pg8::StaticOrder S; S.init(T, 1024, G, bid);
                EpiRes<L != 0> E{xsrc, X16, gate_m};
                (gemm_stagger(), 0); pg8::gemm_phase<EpiRes<L != 0>, pg8::StaticOrder, true, true, false, false, true>(lds, g, S, E); }
            mb = pb + 3;
        }
        PHASE_G(mb, 6) { phase_moe_router(args, L, lds); }
        const int* CUR = (const int*)(ws + WS_CTL + 524288) + L * 32; LAS int* tbl = (LAS int*)(lds + LDSCTL_OFF + 7168); LAS int* lidx = (LAS int*)(lds + LDSCTL_OFF + 2048);
        PHASE_G(mb + 1, 7) { moe_tables(CUR, tbl); const int ntiles = tbl[64];
            pg8::Gemm g{(const bf16*)(ws + WS_ACT + A_H), (const bf16*)(ws + WS_W + (size_t)L * WL_STRIDE), MAXROWS, 1024, 512};
            MoeOrder S; S.init(tbl + 80, ntiles, G, bid); EpiMoe1 E{ws + WS_ACT + A_ACTV};
            const int* TOKE = (const int*)(ws + WS_TOK);
            for (int ui = 0; ui < 5; ++ui) { pg8::Unit u; if (S.next(ui, u) && threadIdx.x < 256) { const int e = tbl[80 + u.pm], p = 256 * (u.pm - tbl[32 + e]) + (int)threadIdx.x; lidx[ui * 256 + threadIdx.x] = p < tbl[e] ? TOKE[(size_t)e * 32768 + p] : T; } }
            __syncthreads();
            pg8::gemm_phase_gather<EpiMoe1, MoeOrder, true, true, true, false, true>(lds, g, S, E, lidx); }
        PHASE_G(mb + 2, 7) { moe_tables(CUR, tbl); const int ntiles = tbl[64];
            pg8::Gemm g{(const bf16*)(ws + WS_ACT + A_ACTV), (const bf16*)(ws + WS_W + (size_t)L * WL_STRIDE + WL_OUT), MAXROWS, 1024, 256};
            MoeOrder S; S.init(tbl + 80, ntiles, G, bid); EpiF8 E{ws + WS_ACT + A_Y, 1024, 3, 0.5f};
            pg8::gemm_phase<EpiF8, MoeOrder, true, true, true, false, true>(lds, g, S, E); }
        PHASE(mb + 3) { phase_moe_combine(args, L, lds); }

}
__global__ void __launch_bounds__(NTHR, 2) fwd_kernel(Args args) {
    extern __shared__ __attribute__((aligned(16))) unsigned char lds_raw[];
    LAS unsigned char* lds = (LAS unsigned char*)lds_raw;
    const int tid = threadIdx.x;
    unsigned char* ws = uni_ptr(args.ws);
    for (int u = tid; u < (LDS_BYTES - LDSCTL_OFF) / 4; u += NTHR) ((LAS unsigned*)(lds + LDSCTL_OFF))[u] = 0u;
    __syncthreads();
    volatile LAS unsigned* MISC = (volatile LAS unsigned*)(lds + MISC_OFF);
    XcdBarrier bar = xcd_barrier_post((unsigned*)(ws + WS_CTL) + 4096 + (size_t)args.li * XCD_BAR_WORDS, MISC + 8);
    const int lo = args.ph_lo, hi = args.ph_hi; bool started = false;
    const float* MOD = (const float*)(ws + WS_MOD);
    bf16* Hb = (bf16*)(ws + WS_ACT + A_H);

    PHASE_G(0, 0) { phase_prologue(args, lds); }

    run_layer<0>(args, lds, bar, started, lo, hi);
    run_layer<1>(args, lds, bar, started, lo, hi);
    run_layer<2>(args, lds, bar, started, lo, hi);
    run_layer<3>(args, lds, bar, started, lo, hi);
#undef PHASE
#undef PHASE_G
}

extern "C" void kernel_launch(void* const* d_in, const int* in_sizes, int n_in, void* d_out, int out_size, void* d_ws, size_t ws_size, hipStream_t stream) {
    static int grid = 0;
    if (grid == 0) {
        if (n_in != N_IN || in_sizes[0] != T * D || out_size != T * D || ws_size < WS_END) { fprintf(stderr, "kernel_launch: unexpected shapes (n_in %d, in0 %d, out %d, ws %zu < %zu)\n", n_in, n_in > 0 ? in_sizes[0] : -1, out_size, ws_size, (size_t)WS_END); grid = -1; return; }
        int dev = 0, cus = 0, per_cu = 0;
        if (hipGetDevice(&dev) != hipSuccess || hipDeviceGetAttribute(&cus, hipDeviceAttributeMultiprocessorCount, dev) != hipSuccess) { grid = -1; return; }
        if (hipFuncSetAttribute((const void*)fwd_kernel, hipFuncAttributeMaxDynamicSharedMemorySize, LDS_BYTES) != hipSuccess) { fprintf(stderr, "kernel_launch: hipFuncSetAttribute failed\n"); grid = -1; return; }
        if (hipOccupancyMaxActiveBlocksPerMultiprocessor(&per_cu, (const void*)fwd_kernel, NTHR, LDS_BYTES) != hipSuccess || per_cu < 1) fprintf(stderr, "kernel_launch: occupancy query reports %d\n", per_cu);
        (void)hipGetLastError();
        grid = cus;
    }
    if (grid < 0) return;
    if (hipMemsetAsync((char*)d_ws + WS_CTL, 0, CTL_ZERO_BYTES, stream) != hipSuccess) return;
    Args a{};
    for (int i = 0; i < N_IN; ++i) a.in[i] = (const float*)d_in[i];
    a.out = (float*)d_out; a.ws = (unsigned char*)d_ws; a.pad = 0;
#if MK_LAUNCH_MODE == 1
    a.ph_lo = 0; a.ph_hi = N_PHASES; a.li = 0;
    hipLaunchKernelGGL(fwd_kernel, dim3(grid), dim3(NTHR), LDS_BYTES, stream, a);
#else
#ifndef PROBE_PHASE
#define PROBE_PHASE -1
#endif
    for (int p = 0; p < N_PHASES; ++p) { a.ph_lo = p; a.ph_hi = p + 1; a.li = 0;
        for (int rep = 0; rep < (p == PROBE_PHASE ? 2 : 1); ++rep) hipLaunchKernelGGL(fwd_kernel, dim3(grid), dim3(NTHR), LDS_BYTES, stream, a); }
#endif
}
```
